# Optimizing an MI355X kernel written in HIP

```python
import jax, jax.numpy as jnp
from jax import lax
import numpy as np

D_MODEL = 2048
BATCH = 1
SEQ = 8192
DEPTH = 4

N_MIXERS = 3
HEAD_DIM = 128
ROPE_THETA = 500000.0
ROPE_DIM = HEAD_DIM // 4
EPS = 1e-6
Q_CHUNK = 128
NEG = -1e30
POS_BIG = 1e30

MOBA_HEADS = D_MODEL // HEAD_DIM
MOBA_BLOCK = 256
MOBA_TOPK = 3
MOBA_IN = 4 * MOBA_HEADS * HEAD_DIM

NSA_HEADS = D_MODEL // HEAD_DIM
NSA_KV_GROUPS = NSA_HEADS // 4
NSA_CMP_LEN = 32
NSA_CMP_STRIDE = 16
NSA_CMP_HIDDEN = 256
NSA_SLC_BLOCK = 64
NSA_SLC_TOPK = 16
NSA_WINDOW = 512
NSA_IN = 2 * NSA_HEADS * HEAD_DIM + 6 * NSA_KV_GROUPS * HEAD_DIM + 3 * NSA_HEADS

RET_HEADS = 8
RET_QK_DIM = D_MODEL // RET_HEADS
RET_V_DIM = 2 * D_MODEL // RET_HEADS
RET_CHUNK = 128
RET_ROT_THETA = 10000.0
RET_IN = 2 * RET_HEADS * RET_QK_DIM + 2 * RET_HEADS * RET_V_DIM

kernel_name = 'hybrid_moba_nsa_retention_trunk'

f32 = jnp.float32


def rms_norm(x, g):
    xf = x.astype(f32)
    y = xf * lax.rsqrt(jnp.mean(xf * xf, axis=-1, keepdims=True) + EPS)
    return (y * g.astype(f32)).astype(x.dtype)


def rotate(x, pos, rot_dim, theta):
    half = rot_dim // 2
    inv = theta ** (-jnp.arange(half, dtype=f32) / half)
    ang = pos.astype(f32)[..., None] * inv
    cos = jnp.cos(ang)[:, :, None, :]
    sin = jnp.sin(ang)[:, :, None, :]
    xr = x[..., :rot_dim].astype(f32)
    x1, x2 = xr[..., :half], xr[..., half:]
    rot = jnp.concatenate([x1 * cos - x2 * sin, x1 * sin + x2 * cos], axis=-1).astype(x.dtype)
    return jnp.concatenate([rot, x[..., rot_dim:]], axis=-1)


def masked_softmax(s, mask):
    s = jnp.where(mask, s.astype(f32), NEG)
    m = jnp.max(s, axis=-1, keepdims=True)
    p = jnp.where(mask, jnp.exp(s - m), 0.0)
    return p / jnp.maximum(jnp.sum(p, axis=-1, keepdims=True), 1e-30)


def moba_mixer(h, pos, w_in, w_out):
    B, S, _ = h.shape
    H, Dh, L = MOBA_HEADS, HEAD_DIM, MOBA_BLOCK
    q, k, v, z = jnp.split(h @ w_in, 4, axis=-1)
    q = rotate(q.reshape(B, S, H, Dh), pos, ROPE_DIM, ROPE_THETA) * (Dh ** -0.5)
    k = rotate(k.reshape(B, S, H, Dh), pos, ROPE_DIM, ROPE_THETA)
    v = v.reshape(B, S, H, Dh)
    nb = -(-S // L)
    pad = ((0, 0), (0, nb * L - S), (0, 0), (0, 0))
    kb = jnp.pad(k, pad).reshape(B, nb, L, H, Dh).transpose(0, 3, 1, 2, 4)
    vb = jnp.pad(v, pad).reshape(B, nb, L, H, Dh).transpose(0, 3, 1, 2, 4)
    k_mean = jnp.mean(kb.astype(f32), axis=3)
    topk = min(MOBA_TOPK, nb)
    nq = S // Q_CHUNK
    qc = q.reshape(B, nq, Q_CHUNK, H, Dh).transpose(1, 0, 3, 2, 4)
    bi = jnp.arange(B)[:, None, None]
    hi = jnp.arange(H)[None, :, None]
    bshape = (B, H, Q_CHUNK, L)

    def chunk(args):
        qi, ci = args
        q0 = ci * Q_CHUNK
        blk = q0 // L
        qpos = q0 + jnp.arange(Q_CHUNK)
        gate_s = jnp.einsum('bhqd,bhnd->bhqn', qi.astype(f32), k_mean)
        gate_s = jnp.where(jnp.arange(nb) < blk, gate_s, NEG)
        _, idx = lax.top_k(gate_s, topk)
        slot_ok = jnp.arange(topk) < blk
        k_own = lax.dynamic_index_in_dim(kb, blk, axis=2, keepdims=False)
        v_own = lax.dynamic_index_in_dim(vb, blk, axis=2, keepdims=False)
        own_mask = (blk * L + jnp.arange(L))[None, :] <= qpos[:, None]
        scores = [jnp.einsum('bhqd,bhld->bhql', qi, k_own)]
        masks = [jnp.broadcast_to(own_mask, bshape)]
        for s in range(topk):
            k_sel = kb[bi, hi, idx[..., s]]
            scores.append(jnp.einsum('bhqd,bhqld->bhql', qi, k_sel))
            masks.append(jnp.broadcast_to(slot_ok[s], bshape))
        p = masked_softmax(jnp.concatenate(scores, -1), jnp.concatenate(masks, -1))
        p = p.reshape(B, H, Q_CHUNK, topk + 1, L)
        o = jnp.einsum('bhql,bhld->bhqd', p[:, :, :, 0], v_own.astype(f32))
        for s in range(topk):
            v_sel = vb[bi, hi, idx[..., s]]
            o = o + jnp.einsum('bhql,bhqld->bhqd', p[:, :, :, s + 1], v_sel.astype(f32))
        return o.astype(h.dtype)

    o = lax.map(chunk, (qc, jnp.arange(nq)))
    o = o.transpose(1, 0, 3, 2, 4).reshape(B, S, H * Dh)
    return ((o * jax.nn.silu(z)) @ w_out).astype(h.dtype)


def nsa_compress(t, pe, w1, w2):
    B, S, G, Dh = t.shape
    n_sub = NSA_CMP_LEN // NSA_CMP_STRIDE
    sub = t.reshape(B, S // NSA_CMP_STRIDE, NSA_CMP_STRIDE, G, Dh)
    nc = S // NSA_CMP_STRIDE - n_sub + 1
    blocks = jnp.concatenate([sub[:, j:j + nc] for j in range(n_sub)], axis=2)
    blocks = blocks + pe[None, None, :, None, :]
    flat = blocks.transpose(0, 1, 3, 2, 4).reshape(B, nc, G, NSA_CMP_LEN * Dh)
    return jax.nn.silu(flat @ w1) @ w2


def nsa_overlap(nc, ns):
    cs = np.arange(nc)[:, None] * NSA_CMP_STRIDE
    ss = np.arange(ns)[None, :] * NSA_SLC_BLOCK
    ov = np.clip(np.minimum(cs + NSA_CMP_LEN, ss + NSA_SLC_BLOCK) - np.maximum(cs, ss), 0, None)
    return (ov / NSA_CMP_LEN).astype(np.float32)


def nsa_mixer(h, pos, w_in, w_out, cmp_pe, wk1, wk2, wv1, wv2):
    B, S, _ = h.shape
    H, G, Dh, W, SL = NSA_HEADS, NSA_KV_GROUPS, HEAD_DIM, NSA_WINDOW, NSA_SLC_BLOCK
    R = H // G
    sizes = (H * Dh,) + (G * Dh,) * 6 + (3 * H, H * Dh)
    q, k_c, v_c, k_s, v_s, k_w, v_w, gate_logits, z = jnp.split(
        h @ w_in, np.cumsum(sizes)[:-1].tolist(), axis=-1)
    q = rotate(q.reshape(B, S, H, Dh), pos, ROPE_DIM, ROPE_THETA) * (Dh ** -0.5)
    k_c, k_s, k_w = [rotate(t.reshape(B, S, G, Dh), pos, ROPE_DIM, ROPE_THETA) for t in (k_c, k_s, k_w)]
    v_c, v_s, v_w = [t.reshape(B, S, G, Dh) for t in (v_c, v_s, v_w)]
    gates = jax.nn.sigmoid(gate_logits.astype(f32)).reshape(B, S, G, R, 3)
    k_cmp = nsa_compress(k_c, cmp_pe, wk1, wk2)
    v_cmp = nsa_compress(v_c, cmp_pe, wv1, wv2).astype(f32)
    nc = k_cmp.shape[1]
    cmp_end = jnp.arange(nc) * NSA_CMP_STRIDE + NSA_CMP_LEN - 1
    ns = S // SL
    ks_b = k_s.reshape(B, ns, SL, G, Dh).transpose(0, 3, 1, 2, 4)
    vs_b = v_s.reshape(B, ns, SL, G, Dh).transpose(0, 3, 1, 2, 4)
    overlap = jnp.asarray(nsa_overlap(nc, ns))
    n_sel = min(NSA_SLC_TOPK, ns)
    blk_id = jnp.arange(ns)
    k_wp = jnp.pad(k_w, ((0, 0), (W, 0), (0, 0), (0, 0)))
    v_wp = jnp.pad(v_w, ((0, 0), (W, 0), (0, 0), (0, 0)))
    nq = S // Q_CHUNK
    qc = q.reshape(B, nq, Q_CHUNK, G, R, Dh).transpose(1, 0, 2, 3, 4, 5)
    gc = gates.reshape(B, nq, Q_CHUNK, G, R, 3).transpose(1, 0, 2, 3, 4, 5)
    bi = jnp.arange(B)[:, None, None, None]
    gi = jnp.arange(G)[None, :, None, None]

    def chunk(args):
        qi, g_i, ci = args
        q0 = ci * Q_CHUNK
        qpos = q0 + jnp.arange(Q_CHUNK)
        s_c = jnp.einsum('bqgrd,bngd->bgrqn', qi, k_cmp)
        p_c = masked_softmax(s_c, cmp_end[None, :] <= qpos[:, None])
        o_c = jnp.einsum('bgrqn,bngd->bqgrd', p_c, v_cmp)
        imp = jnp.einsum('bgrqn,ns->bgqs', p_c, overlap)
        cur = qpos // SL
        valid = (blk_id * SL)[None, :] <= qpos[:, None]
        forced = (blk_id[None, :] == 0) | (blk_id[None, :] == cur[:, None]) | (blk_id[None, :] == cur[:, None] - 1)
        sel = jnp.where(valid, jnp.where(forced, POS_BIG, imp), NEG)
        top_val, idx = lax.top_k(sel, n_sel)
        slot_ok = top_val > NEG / 2
        k_sel = ks_b[bi, gi, idx]
        v_sel = vs_b[bi, gi, idx].astype(f32)
        tok = idx[..., None] * SL + jnp.arange(SL)
        m_s = slot_ok[..., None] & (tok <= qpos[None, None, :, None, None])
        s_s = jnp.einsum('bqgrd,bgqnld->bgrqnl', qi, k_sel).reshape(B, G, R, Q_CHUNK, n_sel * SL)
        p_s = masked_softmax(s_s, m_s.reshape(B, G, 1, Q_CHUNK, n_sel * SL))
        o_s = jnp.einsum('bgrqnl,bgqnld->bqgrd', p_s.reshape(B, G, R, Q_CHUNK, n_sel, SL), v_sel)
        kw = lax.dynamic_slice_in_dim(k_wp, q0, W + Q_CHUNK, axis=1)
        vw = lax.dynamic_slice_in_dim(v_wp, q0, W + Q_CHUNK, axis=1).astype(f32)
        kpos = q0 - W + jnp.arange(W + Q_CHUNK)
        m_w = (kpos[None, :] <= qpos[:, None]) & (kpos[None, :] > qpos[:, None] - W) & (kpos[None, :] >= 0)
        p_w = masked_softmax(jnp.einsum('bqgrd,bkgd->bgrqk', qi, kw), m_w)
        o_w = jnp.einsum('bgrqk,bkgd->bqgrd', p_w, vw)
        o = g_i[..., 0:1] * o_c + g_i[..., 1:2] * o_s + g_i[..., 2:3] * o_w
        return o.astype(h.dtype)

    o = lax.map(chunk, (qc, gc, jnp.arange(nq)))
    o = o.transpose(1, 0, 2, 3, 4, 5).reshape(B, S, H * Dh)
    return ((o * jax.nn.silu(z)) @ w_out).astype(h.dtype)


def retention_mixer(h, pos, w_in, w_out):
    B, S, _ = h.shape
    H, Dk, Dv, C = RET_HEADS, RET_QK_DIM, RET_V_DIM, RET_CHUNK
    q, k, v, g = jnp.split(h @ w_in, [H * Dk, 2 * H * Dk, 2 * H * Dk + H * Dv], axis=-1)
    q = rotate(q.reshape(B, S, H, Dk), pos, Dk, RET_ROT_THETA).astype(f32)
    k = rotate(k.reshape(B, S, H, Dk), pos, Dk, RET_ROT_THETA).astype(f32) * (Dk ** -0.5)
    v = v.reshape(B, S, H, Dv).astype(f32)
    n = S // C
    to_chunks = lambda t: t.reshape(B, n, C, H, t.shape[-1]).transpose(1, 0, 3, 2, 4)
    log_gamma = jnp.log(1.0 - 2.0 ** (-5.0 - jnp.arange(H, dtype=f32)))
    i = jnp.arange(C, dtype=f32)
    diff = i[:, None] - i[None, :]
    intra = jnp.where(diff >= 0, jnp.exp(log_gamma[:, None, None] * jnp.maximum(diff, 0.0)), 0.0)
    read_decay = jnp.exp(log_gamma[:, None] * (i + 1.0))[..., None]
    write_decay = jnp.exp(log_gamma[:, None] * (C - 1.0 - i))[..., None]
    carry_decay = jnp.exp(log_gamma * C)[:, None, None]

    def step(state, inp):
        qi, ki, vi = inp
        inner = jnp.einsum('bhid,bhjd->bhij', qi, ki) * intra
        o = jnp.einsum('bhij,bhjv->bhiv', inner, vi) + jnp.einsum('bhid,bhdv->bhiv', qi, state) * read_decay
        state = carry_decay * state + jnp.einsum('bhjd,bhjv->bhdv', ki * write_decay, vi)
        return state, o

    state0 = jnp.zeros((B, H, Dk, Dv), f32)
    _, o = lax.scan(step, state0, (to_chunks(q), to_chunks(k), to_chunks(v)))
    o = o.transpose(1, 0, 3, 2, 4).reshape(B, S, H, Dv)
    mu = jnp.mean(o, axis=-1, keepdims=True)
    var = jnp.mean(jnp.square(o - mu), axis=-1, keepdims=True)
    o = ((o - mu) * lax.rsqrt(var + EPS)).reshape(B, S, H * Dv).astype(h.dtype)
    return ((jax.nn.silu(g) * o) @ w_out).astype(h.dtype)


def setup_inputs(seed: int = 0) -> dict:
    key = jax.random.key(seed)
    ks = jax.random.split(key, 20)
    n_moba = len(range(0, DEPTH, N_MIXERS))
    n_nsa = len(range(1, DEPTH, N_MIXERS))
    n_ret = len(range(2, DEPTH, N_MIXERS))

    def w(k, shape, fan_in):
        return jax.random.normal(k, shape, f32) * (fan_in ** -0.5)

    D = D_MODEL
    offset = jax.random.randint(ks[2], (BATCH, 1), 0, 4096, dtype=jnp.int32)
    return {
        'x': jax.random.normal(ks[0], (BATCH, SEQ, D), f32),
        'c': jax.random.normal(ks[1], (BATCH, D), f32),
        'positions': offset + jnp.arange(SEQ, dtype=jnp.int32)[None, :],
        'ada_w': w(ks[3], (DEPTH, D, 3 * D), D),
        'ada_b': 0.01 * jax.random.normal(ks[4], (DEPTH, 3 * D), f32),
        'norm_pre': 1.0 + 0.05 * jax.random.normal(ks[5], (DEPTH, D), f32),
        'norm_post': 1.0 + 0.05 * jax.random.normal(ks[6], (DEPTH, D), f32),
        'moba_w_in': w(ks[7], (n_moba, D, MOBA_IN), D),
        'moba_w_out': w(ks[8], (n_moba, MOBA_HEADS * HEAD_DIM, D), MOBA_HEADS * HEAD_DIM),
        'nsa_w_in': w(ks[9], (n_nsa, D, NSA_IN), D),
        'nsa_w_out': w(ks[10], (n_nsa, NSA_HEADS * HEAD_DIM, D), NSA_HEADS * HEAD_DIM),
        'nsa_cmp_pe': 0.1 * jax.random.normal(ks[11], (n_nsa, NSA_CMP_LEN, HEAD_DIM), f32),
        'nsa_cmp_wk1': w(ks[12], (n_nsa, NSA_CMP_LEN * HEAD_DIM, NSA_CMP_HIDDEN), NSA_CMP_LEN * HEAD_DIM),
        'nsa_cmp_wk2': w(ks[13], (n_nsa, NSA_CMP_HIDDEN, HEAD_DIM), NSA_CMP_HIDDEN),
        'nsa_cmp_wv1': w(ks[14], (n_nsa, NSA_CMP_LEN * HEAD_DIM, NSA_CMP_HIDDEN), NSA_CMP_LEN * HEAD_DIM),
        'nsa_cmp_wv2': w(ks[15], (n_nsa, NSA_CMP_HIDDEN, HEAD_DIM), NSA_CMP_HIDDEN),
        'ret_w_in': w(ks[16], (n_ret, D, RET_IN), D),
        'ret_w_out': w(ks[17], (n_ret, RET_HEADS * RET_V_DIM, D), RET_HEADS * RET_V_DIM),
    }


def reference(x, c, positions, ada_w, ada_b, norm_pre, norm_post, moba_w_in, moba_w_out,
              nsa_w_in, nsa_w_out, nsa_cmp_pe, nsa_cmp_wk1, nsa_cmp_wk2, nsa_cmp_wv1, nsa_cmp_wv2,
              ret_w_in, ret_w_out):
    for i in range(DEPTH):
        kind, j = i % N_MIXERS, i // N_MIXERS
        mod = jax.nn.silu(c) @ ada_w[i] + ada_b[i]
        shift, scale, gate = jnp.split(mod, 3, axis=-1)
        h = rms_norm(x, norm_pre[i]) * (1.0 + scale[:, None, :]) + shift[:, None, :]
        if kind == 0:
            y = moba_mixer(h, positions, moba_w_in[j], moba_w_out[j])
        elif kind == 1:
            y = nsa_mixer(h, positions, nsa_w_in[j], nsa_w_out[j], nsa_cmp_pe[j],
                          nsa_cmp_wk1[j], nsa_cmp_wk2[j], nsa_cmp_wv1[j], nsa_cmp_wv2[j])
        else:
            y = retention_mixer(h, positions, ret_w_in[j], ret_w_out[j])
        x = x + gate[:, None, :] * rms_norm(y, norm_post[i])
    return x
```

```cpp
#include <hip/hip_runtime.h>
#include <hip/hip_cooperative_groups.h>
#include <cstdio>
#include <cstdint>
#include <cmath>
namespace cg = cooperative_groups;

#ifndef ONE_LAUNCH
#define ONE_LAUNCH 0
#endif

#define LAS __attribute__((address_space(3)))
typedef _Float16 h16;
typedef _Float16 h16x2 __attribute__((ext_vector_type(2)));
typedef _Float16 h16x4 __attribute__((ext_vector_type(4)));
typedef _Float16 h16x8 __attribute__((ext_vector_type(8)));
typedef float f32x2 __attribute__((ext_vector_type(2)));
typedef float f32x4 __attribute__((ext_vector_type(4)));
typedef unsigned u32x4 __attribute__((ext_vector_type(4)));

constexpr int S = 8192, D = 2048, DEPTH = 4;
constexpr float EPS = 1e-6f;
constexpr float NEGF = -1e30f, BIGF = 1e30f;
constexpr int NSA_NP = 7424;
constexpr int NC = 511;

constexpr size_t MiB = 1u << 20;
constexpr size_t WS_CTL = 0, CTL_ZERO_BYTES = 1 * MiB;
constexpr size_t WS_MODP = 1 * MiB;
constexpr size_t WS_KMEAN = 1 * MiB + 768 * 1024;
constexpr size_t WS_GATES = 3 * MiB;
constexpr size_t WS_KCMP = 5 * MiB;
constexpr size_t WS_VCMP = 5 * MiB + 512 * 1024;
constexpr size_t WS_ROPE16 = 6 * MiB;
constexpr size_t WS_ROPE128 = 7 * MiB;
constexpr size_t WS_WTIN = 16 * MiB;
constexpr size_t WS_WTOUT = 64 * MiB;
constexpr size_t WS_H = 80 * MiB;
constexpr size_t WS_P = 112 * MiB;
constexpr size_t WS_QKV = 304 * MiB;
constexpr size_t WS_OZ = 496 * MiB;
constexpr size_t WS_Y = 560 * MiB;
constexpr size_t WS_OR = 624 * MiB;
constexpr size_t WS_END = 752 * MiB;

constexpr int LDS_BYTES = 147456;
constexpr int MISC_OFF = 135168;
constexpr int NTHREADS = 512;

struct Args {
    const float* in[18];
    float* out;
    unsigned char* ws;
    double inv16[16];
    double inv128[128];
    int ph_lo, ph_hi;
};

#define XB_TMO      128
#define XB_XCNT(j)  (256  + 64 * (j))
#define XB_XSUB(j)  (1280 + 64 * (j))
#define XB_XGEN(j)  (2304 + 64 * (j))
#define XB_TOP      3328
#define XB_TOPGEN   3392
#define XCD_BAR_WORDS 3456
#define XB_SPIN_CAP (1u << 24)
constexpr int CW_BAR = 4096;

__device__ __forceinline__ unsigned xb_ld(unsigned* p)              { return __hip_atomic_load(p, __ATOMIC_RELAXED, __HIP_MEMORY_SCOPE_AGENT); }
__device__ __forceinline__ unsigned xb_add(unsigned* p, unsigned v) { return __hip_atomic_fetch_add(p, v, __ATOMIC_RELAXED, __HIP_MEMORY_SCOPE_AGENT); }
__device__ __forceinline__ unsigned xb_xcc_id() { return (unsigned)__builtin_amdgcn_s_getreg((3 << 11) | 20) & 0xFu; }
#define XB_SPIN(cond, bar) do { unsigned _sp = 0; while (cond) { __builtin_amdgcn_s_sleep(1); \
    if ((++_sp & 255u) == 0u) { if (xb_ld(&(bar)[XB_TMO])) break; if (_sp > XB_SPIN_CAP) { atomicAdd(&(bar)[XB_TMO], 1u); break; } } } } while (0)

struct XcdBarrier { unsigned* bar; unsigned x; volatile LAS unsigned* st; };

__device__ __forceinline__ XcdBarrier xcd_barrier_post(unsigned* bar, volatile LAS unsigned* st) {
    XcdBarrier b; b.bar = bar; b.x = xb_xcc_id(); b.st = st;
    if (threadIdx.x == 0) (void)xb_add(&bar[XB_XCNT(b.x)], 1u);
    return b;
}
__device__ __forceinline__ void xcd_barrier_complete(unsigned* bar, unsigned x, unsigned& nloc, unsigned& nx) {
    const unsigned G = gridDim.x * gridDim.y * gridDim.z;
    unsigned sum, cnt, mine, sp = 0u;
    for (;;) {
        sum = 0u; cnt = 0u; mine = 0u;
#pragma unroll
        for (unsigned j = 0; j < 16; ++j) { const unsigned c = xb_ld(&bar[XB_XCNT(j)]); sum += c; cnt += (c > 0u) ? 1u : 0u; mine = (j == x) ? c : mine; }
        if (sum == G) break;
        __builtin_amdgcn_s_sleep(1);
        if ((++sp & 255u) == 0u) { if (xb_ld(&bar[XB_TMO])) break; if (sp > XB_SPIN_CAP) { atomicAdd(&bar[XB_TMO], 1u); break; } }
    }
    nloc = mine > 0u ? mine : 1u; nx = cnt > 0u ? cnt : 1u;
}
__device__ __forceinline__ void xcd_barrier(const XcdBarrier& b) {
    asm volatile("s_waitcnt vmcnt(0)" ::: "memory");
    __syncthreads();
    if (threadIdx.x == 0) {
        unsigned* bar = b.bar;
        __builtin_amdgcn_s_waitcnt(0);
        unsigned nloc = b.st[0], nx = b.st[1];
        if (nloc == 0u) { xcd_barrier_complete(bar, b.x, nloc, nx); b.st[0] = nloc; b.st[1] = nx; }
        const unsigned old = xb_add(&bar[XB_XSUB(b.x)], 1u);
        const unsigned gen = old / nloc;
        if (old + 1u == (gen + 1u) * nloc) {
            __builtin_amdgcn_fence(__ATOMIC_RELEASE, "agent");
            asm volatile("s_waitcnt vmcnt(0)" ::: "memory");
            const unsigned og = xb_add(&bar[XB_TOP], 1u);
            const unsigned tg = og / nx;
            if (og + 1u == (tg + 1u) * nx) xb_add(&bar[XB_TOPGEN], 1u);
            else XB_SPIN(xb_ld(&bar[XB_TOPGEN]) == tg, bar);
            __builtin_amdgcn_fence(__ATOMIC_ACQUIRE, "agent");
            xb_add(&bar[XB_XGEN(b.x)], 1u);
            asm volatile("s_waitcnt vmcnt(0)" ::: "memory");
        } else {
            XB_SPIN(xb_ld(&bar[XB_XGEN(b.x)]) == gen, bar);
            __builtin_amdgcn_fence(__ATOMIC_ACQUIRE, "agent");
            asm volatile("s_waitcnt vmcnt(0)" ::: "memory");
        }
    }
    __syncthreads();
}

namespace pg8 {
constexpr int BM = 256, BK = 64, HALF = 128, HTB = HALF * BK * 2, STAGE_BYTES = 8 * HTB, NXCD = 8, WGM = 8;
__host__ __device__ __forceinline__ int lds_byte(int r, int c) { const int st = (r >> 4) * 2 + (c >> 5), rr = r & 15, cc = c & 31, ob = rr * 64 + cc * 2; return st * 1024 + (ob ^ (((ob >> 9) & 1) << 5)); }
__host__ __device__ __forceinline__ void stage_rc(int b, int& R, int& C) { const int st = b / 1024, sb = b % 1024, swz = sb ^ (((sb >> 9) & 1) << 5); R = (st >> 1) * 16 + swz / 64; C = (st & 1) * 32 + (swz % 64) / 2; }
__host__ __device__ __forceinline__ int perm32(int rho) { const int n = rho >> 4, i = rho & 15; return 8 * (i >> 2) + 4 * n + (i & 3); }

struct Unit { int pm, pn; };
struct Gemm { const h16* A; const h16* Bt; int M, N, K; };

struct StaticOrder {
    int nM, nN, nwg, G, c;
    __host__ __device__ void init(int M, int N, int G_, int c_) { nM = M / BM; nN = N / BM; nwg = nM * nN; G = G_; c = c_; }
    __host__ __device__ bool next(int i, Unit& u) const {
        const long L = (long)i * G + c; if (L >= nwg) return false;
        int wgid = (int)L; { const int q = nwg / NXCD, r = nwg % NXCD, xcd = wgid % NXCD, off = wgid / NXCD; wgid = (xcd < r ? xcd * (q + 1) : r * (q + 1) + (xcd - r) * q) + off; }
        const int nig = WGM * nN, gid = wgid / nig, fm = gid * WGM, gsz = (nM - fm) < WGM ? (nM - fm) : WGM;
        u.pm = fm + ((wgid % nig) % gsz); u.pn = (wgid % nig) / gsz; return true;
    }
    __device__ __forceinline__ void a_ready(const Unit&) const {}
    __device__ __forceinline__ void done(const Unit&) const {}
};

struct EpiStore {
    static constexpr bool PERM = true, AFTER_DRAIN = false;
    void* O; int ldc; int f32out;
    __device__ __forceinline__ void operator()(const f32x4 (&acc)[2][2][4][2], const Unit& u, int wr, int wc, int fr, int fq) const {
        const int row0 = u.pm * BM + wr * 64 + fr, col0 = u.pn * BM + wc * 32 + 8 * fq;
#pragma unroll
        for (int ai = 0; ai < 2; ++ai)
#pragma unroll
            for (int m = 0; m < 4; ++m) {
                const size_t roff = (size_t)(row0 + ai * HALF + m * 16) * ldc + col0;
#pragma unroll
                for (int bj = 0; bj < 2; ++bj) {
                    const f32x4 v0 = acc[ai][bj][m][0], v1 = acc[ai][bj][m][1];
                    if (f32out) {
                        float* p = (float*)O + roff + bj * HALF;
                        *(f32x4*)p = v0; *(f32x4*)(p + 4) = v1;
                    } else {
                        h16x8 w; w[0] = (h16)v0[0]; w[1] = (h16)v0[1]; w[2] = (h16)v0[2]; w[3] = (h16)v0[3]; w[4] = (h16)v1[0]; w[5] = (h16)v1[1]; w[6] = (h16)v1[2]; w[7] = (h16)v1[3];
                        *(h16x8*)((h16*)O + roff + bj * HALF) = w;
                    }
                }
            }
    }
};

template <class Epi, class Sched, bool ALIGN_EPI = false, bool SP2 = false>
__device__ __forceinline__ void gemm_phase(LAS unsigned char* lds, const Gemm g, const Sched& S, const Epi& E) {
    const int tid = threadIdx.x, wid = __builtin_amdgcn_readfirstlane(tid >> 6), lane = tid & 63, wr = wid >> 2, wc = wid & 3, fr = lane & 15, fq = lane >> 4;
    const int K = g.K, nt = K / BK;
    unsigned voffA[2], voffB[2];
#pragma unroll
    for (int i = 0; i < 2; ++i) { int R, C; stage_rc(tid * 16 + i * 8192, R, C); const int Rb = Epi::PERM ? ((R & ~31) + perm32(R & 31)) : R;
        voffA[i] = (unsigned)(R * K + C) * 2u; voffB[i] = (unsigned)(Rb * K + C) * 2u; }
    const size_t kstep = (size_t)(BK * 2);
    const size_t hstep = (size_t)HALF * K * 2;
    const size_t tstep = 2 * hstep;
    const unsigned ldsw = (unsigned)wid * 1024u;
    const int aoff = lds_byte(wr * 64 + fr, fq * 8), boff = lds_byte(wc * 32 + fr, fq * 8);
#define PG8_SA(b, h) (((b) * 2 + (h)) * HTB)
#define PG8_SB(b, h) ((4 + (b) * 2 + (h)) * HTB)
#define PG8_STAGE(bufoff, gbase, voff) do { _Pragma("unroll") for (int _i = 0; _i < 2; ++_i) \
        __builtin_amdgcn_global_load_lds((const unsigned*)((const char*)(gbase) + (voff)[_i]), (LAS unsigned*)(lds + (bufoff) + ldsw + _i * 8192), 16, 0, 0); } while (0)
#define PG8_LDA(dst, b, h) do { _Pragma("unroll") for (int m = 0; m < 4; ++m) _Pragma("unroll") for (int k = 0; k < 2; ++k) dst[m][k] = *(const LAS h16x8*)(lds + PG8_SA(b, h) + aoff + m * 2048 + k * 1024); } while (0)
#define PG8_LDB(dst, b, h) do { _Pragma("unroll") for (int n = 0; n < 2; ++n) _Pragma("unroll") for (int k = 0; k < 2; ++k) dst[n][k] = *(const LAS h16x8*)(lds + PG8_SB(b, h) + boff + n * 2048 + k * 1024); } while (0)
#define PG8_MMA(ai, bj, At, Bt) do { __builtin_amdgcn_s_setprio(1); _Pragma("unroll") for (int m = 0; m < 4; ++m) _Pragma("unroll") for (int n = 0; n < 2; ++n) _Pragma("unroll") for (int k = 0; k < 2; ++k) \
        acc[ai][bj][m][n] = __builtin_amdgcn_mfma_f32_16x16x32_f16(Bt[n][k], At[m][k], acc[ai][bj][m][n], 0, 0, 0); __builtin_amdgcn_s_setprio(0); } while (0)
#define PG8_WAIT_V(n) asm volatile("s_waitcnt vmcnt(" #n ")" ::: "memory")
#define PG8_WAIT_L(n) asm volatile("s_waitcnt lgkmcnt(" #n ")" ::: "memory")
#define PG8_BAR __builtin_amdgcn_s_barrier()
#define PG8_SCHED __builtin_amdgcn_sched_barrier(0)
    Unit cur, nxt; int ui = 0;
    if (!S.next(0, cur)) return;
    f32x4 acc[2][2][4][2];
#pragma unroll
    for (int a = 0; a < 2; ++a)
#pragma unroll
        for (int b = 0; b < 2; ++b)
#pragma unroll
            for (int m = 0; m < 4; ++m)
#pragma unroll
                for (int n = 0; n < 2; ++n) acc[a][b][m][n] = (f32x4){0.f, 0.f, 0.f, 0.f};
    h16x8 At[4][2], B0[2][2], B1[2][2];
    const char* cA = (const char*)g.A + (size_t)cur.pm * tstep; const char* cB = (const char*)g.Bt + (size_t)cur.pn * tstep;
    S.a_ready(cur);
    if constexpr (SP2) {
        PG8_STAGE(PG8_SB(0, 0), cB, voffB); PG8_STAGE(PG8_SB(0, 1), cB + hstep, voffB); PG8_STAGE(PG8_SA(0, 0), cA, voffA); PG8_STAGE(PG8_SA(0, 1), cA + hstep, voffA);
        if (wr == 1) PG8_BAR;
        PG8_WAIT_V(2); PG8_BAR;
        PG8_STAGE(PG8_SB(1, 0), cB + kstep, voffB); PG8_STAGE(PG8_SA(1, 0), cA + kstep, voffA); PG8_STAGE(PG8_SB(1, 1), cB + hstep + kstep, voffB);
        PG8_WAIT_V(6); PG8_BAR;
    } else {
        PG8_STAGE(PG8_SB(0, 0), cB, voffB); PG8_STAGE(PG8_SA(0, 0), cA, voffA); PG8_STAGE(PG8_SB(0, 1), cB + hstep, voffB); PG8_STAGE(PG8_SA(0, 1), cA + hstep, voffA);
        if (wr == 1) PG8_BAR;
        PG8_WAIT_V(4); PG8_BAR;
        PG8_STAGE(PG8_SB(1, 0), cB + kstep, voffB); PG8_STAGE(PG8_SA(1, 0), cA + kstep, voffA); PG8_STAGE(PG8_SB(1, 1), cB + hstep + kstep, voffB);
        PG8_WAIT_V(6); PG8_BAR;
    }
    for (;;) {
        const bool has_next = S.next(ui + 1, nxt);
        const char* nA = has_next ? (const char*)g.A + (size_t)nxt.pm * tstep : cA; const char* nB = has_next ? (const char*)g.Bt + (size_t)nxt.pn * tstep : cB;
        for (int t = 0; t < nt; t += 2) {
            const bool last = (t == nt - 2);
            const char* a1 = cA + (size_t)(t + 1) * kstep;
            const char* a2 = last ? nA : cA + (size_t)(t + 2) * kstep; const char* b2 = last ? nB : cB + (size_t)(t + 2) * kstep;
            const char* a3 = a2 + kstep; const char* b3 = b2 + kstep;
            if (last && has_next) S.a_ready(nxt);
            if constexpr (SP2) {
            PG8_LDB(B0, 0, 0); PG8_LDB(B1, 0, 1); PG8_SCHED; PG8_LDA(At, 0, 0); PG8_STAGE(PG8_SA(1, 1), a1 + hstep, voffA);
            PG8_WAIT_V(8); PG8_WAIT_L(0); PG8_BAR; PG8_MMA(0, 0, At, B0); PG8_MMA(0, 1, At, B1); PG8_BAR; PG8_SCHED;
            PG8_LDA(At, 0, 1); PG8_STAGE(PG8_SB(0, 0), b2, voffB); PG8_STAGE(PG8_SB(0, 1), b2 + hstep, voffB); PG8_STAGE(PG8_SA(0, 0), a2, voffA);
            PG8_WAIT_V(8); PG8_WAIT_L(0); PG8_BAR; PG8_MMA(1, 0, At, B0); PG8_MMA(1, 1, At, B1); PG8_BAR; PG8_SCHED;
            PG8_LDB(B0, 1, 0); PG8_LDB(B1, 1, 1); PG8_SCHED; PG8_LDA(At, 1, 0); PG8_STAGE(PG8_SA(0, 1), a2 + hstep, voffA);
            PG8_WAIT_V(8); PG8_WAIT_L(0); PG8_BAR; PG8_MMA(0, 0, At, B0); PG8_MMA(0, 1, At, B1); PG8_BAR; PG8_SCHED;
            PG8_LDA(At, 1, 1); PG8_STAGE(PG8_SB(1, 0), b3, voffB); PG8_STAGE(PG8_SB(1, 1), b3 + hstep, voffB); PG8_STAGE(PG8_SA(1, 0), a3, voffA);
            PG8_WAIT_V(8); PG8_WAIT_L(0); PG8_BAR; PG8_MMA(1, 0, At, B0); PG8_MMA(1, 1, At, B1); PG8_BAR; PG8_SCHED;
            } else {
            PG8_LDB(B0, 0, 0); PG8_SCHED; PG8_LDA(At, 0, 0); PG8_STAGE(PG8_SA(1, 1), a1 + hstep, voffA);
            PG8_WAIT_L(8); PG8_BAR; PG8_WAIT_L(0); PG8_MMA(0, 0, At, B0); PG8_BAR; PG8_SCHED;
            PG8_LDB(B1, 0, 1); PG8_STAGE(PG8_SB(0, 0), b2, voffB);
            PG8_BAR; PG8_WAIT_L(0); PG8_MMA(0, 1, At, B1); PG8_BAR;
            PG8_LDA(At, 0, 1); PG8_STAGE(PG8_SA(0, 0), a2, voffA);
            PG8_BAR; PG8_WAIT_L(0); PG8_MMA(1, 0, At, B0); PG8_BAR; PG8_SCHED;
            PG8_STAGE(PG8_SB(0, 1), b2 + hstep, voffB);
            PG8_WAIT_V(6); PG8_BAR; PG8_MMA(1, 1, At, B1); PG8_BAR;
            PG8_LDB(B0, 1, 0); PG8_SCHED; PG8_LDA(At, 1, 0); PG8_STAGE(PG8_SA(0, 1), a2 + hstep, voffA);
            PG8_WAIT_L(8); PG8_BAR; PG8_WAIT_L(0); PG8_MMA(0, 0, At, B0); PG8_BAR; PG8_SCHED;
            PG8_LDB(B1, 1, 1); PG8_STAGE(PG8_SB(1, 0), b3, voffB);
            PG8_BAR; PG8_WAIT_L(0); PG8_MMA(0, 1, At, B1); PG8_BAR;
            PG8_LDA(At, 1, 1); PG8_STAGE(PG8_SA(1, 0), a3, voffA);
            PG8_BAR; PG8_WAIT_L(0); PG8_MMA(1, 0, At, B0); PG8_BAR; PG8_SCHED;
            PG8_STAGE(PG8_SB(1, 1), b3 + hstep, voffB);
            PG8_WAIT_V(6); PG8_BAR; PG8_MMA(1, 1, At, B1); PG8_BAR;
            }
        }
        if constexpr (ALIGN_EPI) { if (wr == 0) PG8_BAR; }
        if constexpr (!Epi::AFTER_DRAIN) { E(acc, cur, wr, wc, fr, fq); S.done(cur); }
        if (!has_next) break;
#pragma unroll
        for (int a = 0; a < 2; ++a)
#pragma unroll
            for (int b = 0; b < 2; ++b)
#pragma unroll
                for (int m = 0; m < 4; ++m)
#pragma unroll
                    for (int n = 0; n < 2; ++n) acc[a][b][m][n] = (f32x4){0.f, 0.f, 0.f, 0.f};
        cur = nxt; cA = nA; cB = nB; ++ui;
        if constexpr (ALIGN_EPI) { if (wr == 1) PG8_BAR; }
    }
    PG8_WAIT_V(0);
    if constexpr (!ALIGN_EPI) { if (wr == 0) PG8_BAR; }
    PG8_BAR;
#undef PG8_SA
#undef PG8_SB
#undef PG8_STAGE
#undef PG8_LDA
#undef PG8_LDB
#undef PG8_MMA
#undef PG8_WAIT_V
#undef PG8_WAIT_L
#undef PG8_BAR
#undef PG8_SCHED
}
}

struct Frame {
    float* out;
    unsigned char* ws;
    char* lds;
    int tid, lane, wave, G, bid;
};

__device__ __forceinline__ float silu_f(float x) { return x / (1.f + __expf(-x)); }
__device__ __forceinline__ float sigmoid_f(float x) { return 1.f / (1.f + __expf(-x)); }
__device__ __forceinline__ float wave_sum(float v) {
#pragma unroll
    for (int o = 32; o >= 1; o >>= 1) v += __shfl_xor(v, o);
    return v;
}
__device__ __forceinline__ float wave_max(float v) {
#pragma unroll
    for (int o = 32; o >= 1; o >>= 1) v = fmaxf(v, __shfl_xor(v, o));
    return v;
}
__device__ __forceinline__ void wave_lds_fence() { __builtin_amdgcn_wave_barrier(); asm volatile("s_waitcnt lgkmcnt(0)" ::: "memory"); __builtin_amdgcn_wave_barrier(); }

__device__ __forceinline__ void sincos_d(double x, float& c, float& s) {
    const double TWO_OVER_PI = 0.63661977236758134308;
    const double PIO2_HI = 1.57079632679489655800e+00, PIO2_LO = 6.12323399573676603587e-17;
    const double q = __builtin_rint(x * TWO_OVER_PI);
    double y = __builtin_fma(-q, PIO2_HI, x); y = __builtin_fma(-q, PIO2_LO, y);
    const double y2 = y * y;
    double sp = 1.0 / 6227020800.0;
    sp = sp * y2 - 1.0 / 39916800.0; sp = sp * y2 + 1.0 / 362880.0; sp = sp * y2 - 1.0 / 5040.0; sp = sp * y2 + 1.0 / 120.0; sp = sp * y2 - 1.0 / 6.0; sp = sp * y2 * y + y;
    double cp = -1.0 / 87178291200.0;
    cp = cp * y2 + 1.0 / 479001600.0; cp = cp * y2 - 1.0 / 3628800.0; cp = cp * y2 + 1.0 / 40320.0; cp = cp * y2 - 1.0 / 720.0; cp = cp * y2 + 1.0 / 24.0; cp = cp * y2 - 0.5; cp = cp * y2 + 1.0;
    const long long qi = (long long)q; const int quad = (int)(qi & 3);
    double sv, cv;
    if (quad == 0) { sv = sp; cv = cp; } else if (quad == 1) { sv = cp; cv = -sp; } else if (quad == 2) { sv = -sp; cv = -cp; } else { sv = -cp; cv = sp; }
    c = (float)cv; s = (float)sv;
}

__device__ __forceinline__ int nsa_src_col(int n) { return n < 5120 ? n : (n < 7168 ? n + 48 : (n < 7216 ? n - 2048 : -1)); }
__device__ __forceinline__ void conv_transpose(const Frame& F, const float* W, int K, int Nsrc, h16* Wt, int Npad, int mapmode, int item0, int& items_done) {
    float* tile = (float*)F.lds;
    const int tk_n = K / 64, tn_n = Npad / 64, ntiles = tk_n * tn_n;
    for (int it = F.bid; it < ntiles; it += F.G) {
        const int tk = it / tn_n, tn = it % tn_n;
        __syncthreads();
#pragma unroll
        for (int i = 0; i < 8; ++i) {
            const int idx = F.tid + i * NTHREADS, k = idx >> 6, n = idx & 63;
            const int nn = tn * 64 + n; const int src = mapmode ? nsa_src_col(nn) : nn;
            float v = 0.f; if (src >= 0 && src < Nsrc) v = W[(size_t)(tk * 64 + k) * Nsrc + src];
            tile[k * 65 + n] = v;
        }
        __syncthreads();
#pragma unroll
        for (int i = 0; i < 8; ++i) {
            const int idx = F.tid + i * NTHREADS, n = idx >> 6, k = idx & 63;
            Wt[(size_t)(tn * 64 + n) * K + tk * 64 + k] = (h16)tile[k * 65 + n];
        }
    }
    __syncthreads();
}
__device__ __forceinline__ void conv_layer_weights(const Frame& F, const Args& A, int L) {
    const int kind = L % 3, j = L / 3; int dummy = 0;
    h16* wtin = (h16*)(F.ws + WS_WTIN); h16* wtout = (h16*)(F.ws + WS_WTOUT);
    if (kind == 0) {
        conv_transpose(F, A.in[7] + (size_t)j * 2048 * 8192, 2048, 8192, wtin, 8192, 0, 0, dummy);
        conv_transpose(F, A.in[8] + (size_t)j * 2048 * 2048, 2048, 2048, wtout, 2048, 0, 0, dummy);
    } else if (kind == 1) {
        conv_transpose(F, A.in[9], 2048, 7216, wtin, NSA_NP, 1, 0, dummy);
        conv_transpose(F, A.in[10], 2048, 2048, wtout, 2048, 0, 0, dummy);
    } else {
        conv_transpose(F, A.in[16], 2048, 12288, wtin, 12288, 0, 0, dummy);
        conv_transpose(F, A.in[17], 4096, 2048, wtout, 2048, 0, 0, dummy);
    }
}

__device__ __forceinline__ void phase_prologue(const Frame& F, const Args& A) {
    {
        float* modp = (float*)(F.ws + WS_MODP);
        const float* c = A.in[1]; const float* aw = A.in[3];
        for (int it = F.bid; it < 384; it += F.G) {
            const int layer = it / 96, r = it % 96, slice = r / 12, nch = r % 12, n = nch * 512 + F.tid;
            const float* w = aw + (size_t)layer * 2048 * 6144 + (size_t)(slice * 256) * 6144 + n;
            float acc = 0.f;
#pragma unroll 8
            for (int k = 0; k < 256; ++k) acc += silu_f(c[slice * 256 + k]) * w[(size_t)k * 6144];
            modp[(size_t)(slice * 4 + layer) * 6144 + n] = acc;
        }
    }
    {
        const int* pos = (const int*)A.in[2];
        f32x2* r16 = (f32x2*)(F.ws + WS_ROPE16); f32x2* r128 = (f32x2*)(F.ws + WS_ROPE128);
        for (int idx = F.bid * NTHREADS + F.tid; idx < S * 16; idx += F.G * NTHREADS) {
            const int t = idx >> 4, j = idx & 15; float cs, sn; sincos_d((double)pos[t] * A.inv16[j], cs, sn); r16[idx] = (f32x2){cs, sn};
        }
        for (int idx = F.bid * NTHREADS + F.tid; idx < S * 128; idx += F.G * NTHREADS) {
            const int t = idx >> 7, j = idx & 127; float cs, sn; sincos_d((double)pos[t] * A.inv128[j], cs, sn); r128[idx] = (f32x2){cs, sn};
        }
    }
    conv_layer_weights(F, A, 0);
}

__device__ __forceinline__ void phase_norm(const Frame& F, const Args& A, int Lprev, int Lnext) {
    float* modl = (float*)F.lds;
    const float* modp = (const float*)(F.ws + WS_MODP); const float* ab = A.in[4];
    __syncthreads();
    for (int i = F.tid; i < 6144; i += NTHREADS) {
        const int which = i >> 11, col = i & 2047;
        int layer, mcol;
        if (which == 0) { layer = Lprev; mcol = 4096 + col; } else if (which == 1) { layer = Lnext; mcol = 2048 + col; } else { layer = Lnext; mcol = col; }
        float v = 0.f;
        if (layer >= 0) { v = ab[layer * 6144 + mcol];
#pragma unroll
            for (int s = 0; s < 8; ++s) v += modp[(size_t)(s * 4 + layer) * 6144 + mcol]; }
        modl[i] = v;
    }
    __syncthreads();
    const float* xin = (Lprev <= 0) ? A.in[0] : F.out;
    const float* Y = (const float*)(F.ws + WS_Y);
    h16* H = (h16*)(F.ws + WS_H);
    const float* npost = A.in[6] + (Lprev >= 0 ? Lprev : 0) * 2048;
    const float* npre = A.in[5] + (Lnext >= 0 ? Lnext : 0) * 2048;
    for (int t = F.bid * 8 + F.wave; t < S; t += F.G * 8) {
        f32x4 x[8];
#pragma unroll
        for (int i = 0; i < 8; ++i) x[i] = *(const f32x4*)(xin + (size_t)t * D + i * 256 + F.lane * 4);
        if (Lprev >= 0) {
            f32x4 y[8]; float ss = 0.f;
#pragma unroll
            for (int i = 0; i < 8; ++i) { y[i] = *(const f32x4*)(Y + (size_t)t * D + i * 256 + F.lane * 4); ss += y[i][0] * y[i][0] + y[i][1] * y[i][1] + y[i][2] * y[i][2] + y[i][3] * y[i][3]; }
            ss = wave_sum(ss);
            const float r = 1.0f / sqrtf(ss * (1.0f / D) + EPS);
#pragma unroll
            for (int i = 0; i < 8; ++i) {
                const int col = i * 256 + F.lane * 4;
                const f32x4 g = *(const f32x4*)(npost + col); const f32x4 gt = *(const f32x4*)(modl + col);
#pragma unroll
                for (int e = 0; e < 4; ++e) x[i][e] += gt[e] * (y[i][e] * r * g[e]);
                *(f32x4*)(F.out + (size_t)t * D + col) = x[i];
            }
        }
        if (Lnext >= 0) {
            float ss = 0.f;
#pragma unroll
            for (int i = 0; i < 8; ++i) ss += x[i][0] * x[i][0] + x[i][1] * x[i][1] + x[i][2] * x[i][2] + x[i][3] * x[i][3];
            ss = wave_sum(ss);
            const float r = 1.0f / sqrtf(ss * (1.0f / D) + EPS);
#pragma unroll
            for (int i = 0; i < 8; ++i) {
                const int col = i * 256 + F.lane * 4;
                const f32x4 g = *(const f32x4*)(npre + col); const f32x4 sc = *(const f32x4*)(modl + 2048 + col); const f32x4 sh = *(const f32x4*)(modl + 4096 + col);
                h16x4 hv;
#pragma unroll
                for (int e = 0; e < 4; ++e) hv[e] = (h16)((x[i][e] * r * g[e]) * (1.0f + sc[e]) + sh[e]);
                *(h16x4*)(H + (size_t)t * D + col) = hv;
            }
        }
    }
    if (Lnext > 0) conv_layer_weights(F, A, Lnext);
}

__device__ __forceinline__ void load16(const h16* p, float (&v)[16]) {
    const h16x8 a = *(const h16x8*)p, b = *(const h16x8*)(p + 8);
#pragma unroll
    for (int i = 0; i < 8; ++i) { v[i] = (float)a[i]; v[8 + i] = (float)b[i]; }
}
__device__ __forceinline__ void store16(h16* p, const float (&v)[16]) {
    h16x8 a, b;
#pragma unroll
    for (int i = 0; i < 8; ++i) { a[i] = (h16)v[i]; b[i] = (h16)v[8 + i]; }
    *(h16x8*)p = a; *(h16x8*)(p + 8) = b;
}
__device__ __forceinline__ void rope32(float (&v)[16], int d0, const f32x2* cs  ) {
#pragma unroll
    for (int i = 0; i < 16; ++i) {
        const float o = __shfl_xor(v[i], 1);
        if (d0 < 32) {
            const f32x2 c = cs[i];
            v[i] = (d0 == 0) ? (v[i] * c[0] - o * c[1]) : (o * c[1] + v[i] * c[0]);
        }
    }
}

__device__ __forceinline__ void phase_moba_post(const Frame& F) {
    const h16* P = (const h16*)(F.ws + WS_P);
    h16* Q = (h16*)(F.ws + WS_QKV); h16* K = Q + (size_t)16 * S * 128; h16* V = K + (size_t)16 * S * 128; h16* Z = V + (size_t)16 * S * 128;
    const f32x2* r16 = (const f32x2*)(F.ws + WS_ROPE16);
    float* kmean = (float*)(F.ws + WS_KMEAN);
    float* red = (float*)F.lds;
    for (int it = F.bid; it < 256; it += F.G) {
        const int blk = it >> 3, part = it & 7, sect = part >> 1;
        const int cs0 = (part & 1) * 1024 + F.lane * 16;
        const int head = cs0 >> 7, d0 = cs0 & 127;
        float ksum[16];
#pragma unroll
        for (int i = 0; i < 16; ++i) ksum[i] = 0.f;
        for (int i = 0; i < 32; ++i) {
            const int t = blk * 256 + F.wave * 32 + i;
            float v[16]; load16(P + (size_t)t * 8192 + part * 1024 + F.lane * 16, v);
            if (sect <= 1) {
                rope32(v, d0, r16 + (size_t)t * 16);
                if (sect == 0) {
#pragma unroll
                    for (int e = 0; e < 16; ++e) v[e] *= 0.08838834764831845f;
                    store16(Q + ((size_t)head * S + t) * 128 + d0, v);
                } else {
#pragma unroll
                    for (int e = 0; e < 16; ++e) ksum[e] += v[e];
                    store16(K + ((size_t)head * S + t) * 128 + d0, v);
                }
            } else if (sect == 2) {
                store16(V + ((size_t)head * S + t) * 128 + d0, v);
            } else {
#pragma unroll
                for (int e = 0; e < 16; ++e) v[e] = silu_f(v[e]);
                store16(Z + (size_t)t * 2048 + cs0, v);
            }
        }
        if (sect == 1) {
            __syncthreads();
#pragma unroll
            for (int e = 0; e < 16; ++e) red[F.wave * 1024 + F.lane * 16 + e] = ksum[e];
            __syncthreads();
            for (int c = F.tid; c < 1024; c += NTHREADS) {
                float s = 0.f;
#pragma unroll
                for (int w = 0; w < 8; ++w) s += red[w * 1024 + c];
                const int cc = (part & 1) * 1024 + c;
                kmean[((size_t)(cc >> 7) * 32 + blk) * 128 + (cc & 127)] = s * (1.0f / 256.0f);
            }
            __syncthreads();
        }
    }
}

__device__ __forceinline__ void wave_attend(const h16* __restrict__ K, const h16* __restrict__ V, int nslots, const int* starts, int limit,
                                            const float* qf, float* pbuf, int lane, float& o0, float& o1) {
    float sc[16]; float mx = NEGF;
#pragma unroll
    for (int k = 0; k < 16; ++k) {
        sc[k] = NEGF;
        if (k < nslots) {
            const int key = starts[k] + lane;
            if (key >= 0 && key <= limit) {
                const h16x8* kr = (const h16x8*)(K + (size_t)key * 128);
                float d = 0.f;
#pragma unroll
                for (int i = 0; i < 16; ++i) {
                    const h16x8 kv = kr[i]; const f32x4 qa = *(const f32x4*)(qf + i * 8), qb = *(const f32x4*)(qf + i * 8 + 4);
                    d += (float)kv[0] * qa[0] + (float)kv[1] * qa[1] + (float)kv[2] * qa[2] + (float)kv[3] * qa[3] + (float)kv[4] * qb[0] + (float)kv[5] * qb[1] + (float)kv[6] * qb[2] + (float)kv[7] * qb[3];
                }
                sc[k] = d;
            }
            mx = fmaxf(mx, sc[k]);
        }
    }
    mx = wave_max(mx);
    float sum = 0.f;
#pragma unroll
    for (int k = 0; k < 16; ++k) { const float p = (sc[k] > 0.5f * NEGF) ? __expf(sc[k] - mx) : 0.f; sc[k] = p; sum += p; }
    sum = wave_sum(sum);
    const float inv = 1.0f / fmaxf(sum, 1e-30f);
    wave_lds_fence();
#pragma unroll
    for (int k = 0; k < 16; ++k) if (k < nslots) pbuf[k * 64 + lane] = sc[k] * inv;
    wave_lds_fence();
    float a0 = 0.f, a1 = 0.f;
    for (int k = 0; k < nslots; ++k) {
        const int base = starts[k];
        for (int i = 0; i < 64; ++i) {
            const int key = base + i;
            if (key >= 0 && key <= limit) {
                const float p = pbuf[k * 64 + i];
                const h16x2 vv = *(const h16x2*)(V + (size_t)key * 128 + 2 * lane);
                a0 += p * (float)vv[0]; a1 += p * (float)vv[1];
            }
        }
    }
    o0 = a0; o1 = a1;
}

constexpr int WS_QF = 0, WS_PB = 2048, WS_PC = 6144, WS_SEL = 14336, WS_ST = 14848, WS_LIST = 14912;
constexpr int WSCR_STRIDE = 16384;

__device__ __forceinline__ void phase_moba_attn(const Frame& F) {
    const h16* Q = (const h16*)(F.ws + WS_QKV); const h16* K = Q + (size_t)16 * S * 128; const h16* V = K + (size_t)16 * S * 128; const h16* Z = V + (size_t)16 * S * 128;
    const float* kmean = (const float*)(F.ws + WS_KMEAN);
    h16* OZ = (h16*)(F.ws + WS_OZ);
    char* wl = F.lds + F.wave * WSCR_STRIDE;
    float* qf = (float*)(wl + WS_QF); float* pbuf = (float*)(wl + WS_PB); int* starts = (int*)(wl + WS_ST);
    const int lane = F.lane;
    for (int task = F.bid * 8 + F.wave; task < 16 * S; task += F.G * 8) {
        const int head = task >> 13, t = task & (S - 1), blk = t >> 8;
        wave_lds_fence();
        { const h16x2 qv = *(const h16x2*)(Q + ((size_t)head * S + t) * 128 + 2 * lane); qf[2 * lane] = (float)qv[0]; qf[2 * lane + 1] = (float)qv[1]; }
        wave_lds_fence();
        float gs = NEGF;
        if (lane < blk) {
            const float* km = kmean + ((size_t)head * 32 + lane) * 128; float d = 0.f;
#pragma unroll 8
            for (int i = 0; i < 128; ++i) d += qf[i] * km[i];
            gs = d;
        }
        int sel[3];
#pragma unroll
        for (int r = 0; r < 3; ++r) {
            float bv = gs; int bi = lane;
#pragma unroll
            for (int o = 32; o >= 1; o >>= 1) { const float ov = __shfl_xor(bv, o); const int oi = __shfl_xor(bi, o); if (ov > bv || (ov == bv && oi < bi)) { bv = ov; bi = oi; } }
            sel[r] = bi; if (lane == bi) gs = -3.0e38f;
        }
        const int nsel = blk < 3 ? blk : 3;
        if (lane < 16) {
            const int grp = lane >> 2, sub = lane & 3;
            const int b = (grp == 0) ? blk : (grp == 1 ? sel[0] : (grp == 2 ? sel[1] : sel[2]));
            starts[lane] = b * 256 + sub * 64;
        }
        wave_lds_fence();
        float o0, o1;
        wave_attend(K + (size_t)head * S * 128, V + (size_t)head * S * 128, 4 + 4 * nsel, starts, t, qf, pbuf, lane, o0, o1);
        const h16x2 zz = *(const h16x2*)(Z + (size_t)t * 2048 + head * 128 + 2 * lane);
        h16x2 ov; ov[0] = (h16)(o0 * (float)zz[0]); ov[1] = (h16)(o1 * (float)zz[1]);
        *(h16x2*)(OZ + (size_t)t * 2048 + head * 128 + 2 * lane) = ov;
    }
}

__device__ __forceinline__ void phase_nsa_post(const Frame& F) {
    const h16* P = (const h16*)(F.ws + WS_P);
    h16* Q = (h16*)(F.ws + WS_QKV); h16* KV = Q + (size_t)16 * S * 128;
    h16* Z = (h16*)(F.ws + WS_QKV + 96 * MiB);
    float* gates = (float*)(F.ws + WS_GATES);
    const f32x2* r16 = (const f32x2*)(F.ws + WS_ROPE16);
    for (int it = F.bid; it < 256; it += F.G) {
        const int blk = it >> 3, part = it & 7;
        for (int i = 0; i < 32; ++i) {
            const int t = blk * 256 + F.wave * 32 + i;
            float v[16]; load16(P + (size_t)t * NSA_NP + part * 1024 + F.lane * 16, v);
            if (part <= 1) {
                const int cs0 = part * 1024 + F.lane * 16, head = cs0 >> 7, d0 = cs0 & 127;
                rope32(v, d0, r16 + (size_t)t * 16);
#pragma unroll
                for (int e = 0; e < 16; ++e) v[e] *= 0.08838834764831845f;
                store16(Q + ((size_t)head * S + t) * 128 + d0, v);
            } else if (part <= 4) {
                const int x = part - 2, isv = F.lane >> 5, grp = (F.lane & 31) >> 3, d0 = (F.lane & 7) * 16;
                rope32(v, isv ? 64 : d0, r16 + (size_t)t * 16);
                store16(KV + ((size_t)(2 * x + isv) * 4 + grp) * S * 128 + (size_t)t * 128 + d0, v);
            } else if (part <= 6) {
                const int cs0 = (part - 5) * 1024 + F.lane * 16;
#pragma unroll
                for (int e = 0; e < 16; ++e) v[e] = silu_f(v[e]);
                store16(Z + (size_t)t * 2048 + cs0, v);
            } else {
                if (F.lane < 3) {
#pragma unroll
                    for (int e = 0; e < 16; ++e) gates[(size_t)t * 48 + F.lane * 16 + e] = sigmoid_f(v[e]);
                }
            }
        }
    }
}

__device__ __forceinline__ void phase_nsa_cmp(const Frame& F, const Args& A) {
    const h16* KVb = (const h16*)(F.ws + WS_QKV) + (size_t)16 * S * 128;
    const float* pe_g = A.in[11];
    h16* xs = (h16*)F.lds;
    float* pe = (float*)(F.lds + 36864);
    float* hid = (float*)(F.lds + 36864 + 16384);
    for (int it = F.bid; it < 512; it += F.G) {
        const int kv = it >> 8, g = (it >> 6) & 3, nb = it & 63;
        const h16* src = KVb + ((size_t)kv * 4 + g) * S * 128;
        const float* W1 = kv ? A.in[14] : A.in[12]; const float* W2 = kv ? A.in[15] : A.in[13];
        h16* dst = (h16*)(F.ws + (kv ? WS_VCMP : WS_KCMP)) + (size_t)g * 512 * 128;
        __syncthreads();
        for (int i = F.tid; i < 144 * 16; i += NTHREADS) {
            const int r = i >> 4, c8 = (i & 15) * 8, tok = nb * 128 + r;
            h16x8 v;
#pragma unroll
            for (int e = 0; e < 8; ++e) v[e] = (h16)0.f;
            if (tok < S) v = *(const h16x8*)(src + (size_t)tok * 128 + c8);
            *(h16x8*)(xs + r * 128 + c8) = v;
        }
        for (int i = F.tid; i < 4096; i += NTHREADS) pe[i] = pe_g[i];
        __syncthreads();
        {
            const int j = F.tid & 255, rh = F.tid >> 8;
            float acc[4] = {0.f, 0.f, 0.f, 0.f};
            for (int pos = 0; pos < 32; ++pos) {
#pragma unroll 4
                for (int d = 0; d < 128; ++d) {
                    const float w = W1[(size_t)(pos * 128 + d) * 256 + j]; const float pv = pe[pos * 128 + d];
#pragma unroll
                    for (int rr = 0; rr < 4; ++rr) acc[rr] += ((float)xs[(16 * (rh * 4 + rr) + pos) * 128 + d] + pv) * w;
                }
            }
#pragma unroll
            for (int rr = 0; rr < 4; ++rr) hid[(rh * 4 + rr) * 256 + j] = silu_f(acc[rr]);
        }
        __syncthreads();
        {
            const int d = F.tid & 127, rq = F.tid >> 7;
            float a0 = 0.f, a1 = 0.f;
#pragma unroll 4
            for (int j = 0; j < 256; ++j) { const float w = W2[j * 128 + d]; a0 += hid[rq * 256 + j] * w; a1 += hid[(rq + 4) * 256 + j] * w; }
            const int n0 = nb * 8 + rq, n1 = nb * 8 + rq + 4;
            if (n0 < NC) dst[(size_t)n0 * 128 + d] = (h16)a0;
            if (n1 < NC) dst[(size_t)n1 * 128 + d] = (h16)a1;
        }
    }
    __syncthreads();
}

__device__ __forceinline__ void phase_nsa_attn(const Frame& F) {
    const h16* Q = (const h16*)(F.ws + WS_QKV); const h16* KVb = Q + (size_t)16 * S * 128;
    const h16* Z = (const h16*)(F.ws + WS_QKV + 96 * MiB);
    const float* gates = (const float*)(F.ws + WS_GATES);
    const h16* KCMP = (const h16*)(F.ws + WS_KCMP); const h16* VCMP = (const h16*)(F.ws + WS_VCMP);
    h16* OZ = (h16*)(F.ws + WS_OZ);
    char* wl = F.lds + F.wave * WSCR_STRIDE;
    float* qf = (float*)(wl + WS_QF); float* pbuf = (float*)(wl + WS_PB); float* pc = (float*)(wl + WS_PC);
    float* selbuf = (float*)(wl + WS_SEL); int* starts = (int*)(wl + WS_ST); int* list = (int*)(wl + WS_LIST);
    const int lane = F.lane;
    for (int task = F.bid * 8 + F.wave; task < 4 * S; task += F.G * 8) {
        const int g = task >> 13, t = task & (S - 1);
        wave_lds_fence();
#pragma unroll
        for (int hh = 0; hh < 4; ++hh) { const h16x2 qv = *(const h16x2*)(Q + ((size_t)(4 * g + hh) * S + t) * 128 + 2 * lane); qf[hh * 128 + 2 * lane] = (float)qv[0]; qf[hh * 128 + 2 * lane + 1] = (float)qv[1]; }
        if (lane < 8) starts[lane] = lane * 64;
        wave_lds_fence();
        float acc0[4], acc1[4];
        const int nvalid = (t >= 31) ? (((t - 31) >> 4) + 1 < NC ? ((t - 31) >> 4) + 1 : NC) : 0;
#pragma unroll
        for (int hh = 0; hh < 4; ++hh) {
            float o0, o1;
            wave_attend(KCMP + (size_t)g * 512 * 128, VCMP + (size_t)g * 512 * 128, 8, starts, nvalid - 1, qf + hh * 128, pc + hh * 512, lane, o0, o1);
            const float g0 = gates[(size_t)t * 48 + (4 * g + hh) * 3 + 0];
            acc0[hh] = g0 * o0; acc1[hh] = g0 * o1;
        }
        wave_lds_fence();
        const int cur = t >> 6;
        float myv[2];
#pragma unroll
        for (int c = 0; c < 2; ++c) {
            const int s = lane + 64 * c; float imp = 0.f;
#pragma unroll
            for (int hh = 0; hh < 4; ++hh) {
                const float* p = pc + hh * 512 + 4 * s;
                const float pm1 = (s > 0) ? p[-1] : 0.f;
                imp += 0.5f * pm1 + p[0] + p[1] + p[2] + 0.5f * p[3];
            }
            const bool valid = s <= cur, forced = (s == 0) || (s == cur) || (s == cur - 1);
            myv[c] = valid ? (forced ? BIGF : imp) : NEGF;
            selbuf[s] = myv[c];
        }
        wave_lds_fence();
        int rank0 = 0, rank1 = 0;
        for (int s2 = 0; s2 < 128; ++s2) {
            const float v2 = selbuf[s2];
            rank0 += (v2 > myv[0] || (v2 == myv[0] && s2 < lane)) ? 1 : 0;
            rank1 += (v2 > myv[1] || (v2 == myv[1] && s2 < lane + 64)) ? 1 : 0;
        }
        const bool sel0 = rank0 < 16 && lane <= cur, sel1 = rank1 < 16 && (lane + 64) <= cur;
        const unsigned long long m0 = __ballot(sel0), m1 = __ballot(sel1);
        const int n0 = __popcll(m0), nsel = n0 + __popcll(m1);
        const unsigned long long below = (lane == 0) ? 0ull : (~0ull >> (64 - lane));
        if (sel0) list[__popcll(m0 & below)] = lane;
        if (sel1) list[n0 + __popcll(m1 & below)] = lane + 64;
        wave_lds_fence();
        if (lane < 16) starts[lane] = (lane < nsel) ? list[lane] * 64 : 0;
        wave_lds_fence();
#pragma unroll
        for (int hh = 0; hh < 4; ++hh) {
            float o0, o1;
            wave_attend(KVb + ((size_t)2 * 4 + g) * S * 128, KVb + ((size_t)3 * 4 + g) * S * 128, nsel, starts, t, qf + hh * 128, pbuf, lane, o0, o1);
            const float g1 = gates[(size_t)t * 48 + (4 * g + hh) * 3 + 1];
            acc0[hh] += g1 * o0; acc1[hh] += g1 * o1;
        }
        wave_lds_fence();
        if (lane < 8) starts[lane] = t - 511 + lane * 64;
        wave_lds_fence();
#pragma unroll
        for (int hh = 0; hh < 4; ++hh) {
            float o0, o1;
            wave_attend(KVb + ((size_t)4 * 4 + g) * S * 128, KVb + ((size_t)5 * 4 + g) * S * 128, 8, starts, t, qf + hh * 128, pbuf, lane, o0, o1);
            const float g2 = gates[(size_t)t * 48 + (4 * g + hh) * 3 + 2];
            acc0[hh] += g2 * o0; acc1[hh] += g2 * o1;
        }
#pragma unroll
        for (int hh = 0; hh < 4; ++hh) {
            const int col = (4 * g + hh) * 128 + 2 * lane;
            const h16x2 zz = *(const h16x2*)(Z + (size_t)t * 2048 + col);
            h16x2 ov; ov[0] = (h16)(acc0[hh] * (float)zz[0]); ov[1] = (h16)(acc1[hh] * (float)zz[1]);
            *(h16x2*)(OZ + (size_t)t * 2048 + col) = ov;
        }
    }
}

__device__ __forceinline__ void phase_ret_post(const Frame& F) {
    const h16* P = (const h16*)(F.ws + WS_P);
    h16* RQ = (h16*)(F.ws + WS_QKV); h16* RK = RQ + (size_t)8 * S * 256; h16* RV = RK + (size_t)8 * S * 256; h16* RG = RV + (size_t)8 * S * 512;
    const f32x2* r128 = (const f32x2*)(F.ws + WS_ROPE128);
    for (int it = F.bid; it < 384; it += F.G) {
        const int blk = it / 12, part = it % 12;
        for (int i = 0; i < 32; ++i) {
            const int t = blk * 256 + F.wave * 32 + i;
            float v[16]; load16(P + (size_t)t * 12288 + part * 1024 + F.lane * 16, v);
            if (part <= 3) {
                const int head = (part & 1) * 4 + (F.lane >> 4), dl = (F.lane & 15) * 16, hi = (F.lane >> 3) & 1, j0 = (F.lane & 7) * 16;
                const f32x2* cs = r128 + (size_t)t * 128 + j0;
                const float scale = (part >= 2) ? 0.0625f : 1.0f;
#pragma unroll
                for (int e = 0; e < 16; ++e) {
                    const float o = __shfl_xor(v[e], 8); const f32x2 c = cs[e];
                    v[e] = (hi == 0 ? (v[e] * c[0] - o * c[1]) : (o * c[1] + v[e] * c[0])) * scale;
                }
                store16((part >= 2 ? RK : RQ) + ((size_t)head * S + t) * 256 + dl, v);
            } else if (part <= 7) {
                const int cs0 = (part - 4) * 1024 + F.lane * 16, head = cs0 >> 9, dv = cs0 & 511;
                store16(RV + ((size_t)head * S + t) * 512 + dv, v);
            } else {
                const int cs0 = (part - 8) * 1024 + F.lane * 16;
#pragma unroll
                for (int e = 0; e < 16; ++e) v[e] = silu_f(v[e]);
                store16(RG + (size_t)t * 4096 + cs0, v);
            }
        }
    }
}

__device__ __forceinline__ double gamma_of(int h) { return 1.0 - 1.0 / (double)(32 << h); }
__device__ __forceinline__ double dpow_int(double b, int n) { double p = 1.0; for (int i = 0; i < n; ++i) p *= b; return p; }

__device__ __forceinline__ void phase_ret_scan(const Frame& F) {
    const h16* RQ = (const h16*)(F.ws + WS_QKV); const h16* RK = RQ + (size_t)8 * S * 256; const h16* RV = RK + (size_t)8 * S * 256;
    h16* SB = (h16*)(F.ws + WS_P);
    float* ks = (float*)F.lds;
    h16* vs = (h16*)(F.lds + 32768);
    float* wd = (float*)(F.lds + 49152);
    for (int it = F.bid; it < 256; it += F.G) {
        const int h = it >> 5, dk0 = ((it >> 3) & 3) * 64, dv0 = (it & 7) * 64;
        const double gam = gamma_of(h);
        __syncthreads();
        if (F.tid < 128) wd[F.tid] = (float)dpow_int(gam, 127 - F.tid);
        const float carry = (float)dpow_int(gam, 128);
        const int tk = F.tid >> 3, tv = F.tid & 7;
        float st[8];
#pragma unroll
        for (int e = 0; e < 8; ++e) st[e] = 0.f;
        __syncthreads();
        for (int c = 0; c < 64; ++c) {
            { h16x8 o;
#pragma unroll
              for (int e = 0; e < 8; ++e) o[e] = (h16)st[e];
              *(h16x8*)(SB + (((size_t)h * 64 + c) * 256 + dk0 + tk) * 512 + dv0 + tv * 8) = o; }
            for (int i = F.tid; i < 128 * 8; i += NTHREADS) {
                const int j = i >> 3, c8 = (i & 7) * 8;
                const h16x8 kk = *(const h16x8*)(RK + ((size_t)h * S + c * 128 + j) * 256 + dk0 + c8);
                const h16x8 vv = *(const h16x8*)(RV + ((size_t)h * S + c * 128 + j) * 512 + dv0 + c8);
                const float w = wd[j];
#pragma unroll
                for (int e = 0; e < 8; ++e) ks[j * 64 + c8 + e] = (float)kk[e] * w;
                *(h16x8*)(vs + j * 64 + c8) = vv;
            }
            __syncthreads();
#pragma unroll
            for (int e = 0; e < 8; ++e) st[e] *= carry;
#pragma unroll 4
            for (int j = 0; j < 128; ++j) {
                const float kf = ks[j * 64 + tk]; const h16x8 vv = *(const h16x8*)(vs + j * 64 + tv * 8);
#pragma unroll
                for (int e = 0; e < 8; ++e) st[e] += kf * (float)vv[e];
            }
            __syncthreads();
        }
    }
}

__device__ __forceinline__ void phase_ret_out(const Frame& F) {
    const h16* RQ = (const h16*)(F.ws + WS_QKV); const h16* RK = RQ + (size_t)8 * S * 256; const h16* RV = RK + (size_t)8 * S * 256;
    const h16* SB = (const h16*)(F.ws + WS_P);
    float* OR_ = (float*)(F.ws + WS_OR);
    h16* Qs = (h16*)F.lds;
    float* AsT = (float*)(F.lds + 65536);
    float* rd = (float*)(F.lds + 131072);
    for (int it = F.bid; it < 512; it += F.G) {
        const int h = it >> 6, c = it & 63;
        const double gam = gamma_of(h);
        __syncthreads();
        if (F.tid < 130) rd[F.tid] = (float)dpow_int(gam, F.tid);
        for (int i = F.tid; i < 128 * 32; i += NTHREADS) {
            const int r = i >> 5, c8 = (i & 31) * 8;
            *(h16x8*)(Qs + r * 256 + c8) = *(const h16x8*)(RQ + ((size_t)h * S + c * 128 + r) * 256 + c8);
        }
        __syncthreads();
        {
            const int j = F.tid & 127, ig = F.tid >> 7;
            float acc[32];
#pragma unroll
            for (int ii = 0; ii < 32; ++ii) acc[ii] = 0.f;
            const h16* krow = RK + ((size_t)h * S + c * 128 + j) * 256;
            for (int d8 = 0; d8 < 32; ++d8) {
                const h16x8 kv = *(const h16x8*)(krow + d8 * 8);
                const h16x2 k0 = {kv[0], kv[1]}, k1 = {kv[2], kv[3]}, k2 = {kv[4], kv[5]}, k3 = {kv[6], kv[7]};
#pragma unroll
                for (int ii = 0; ii < 32; ++ii) {
                    const h16x8 qv = *(const h16x8*)(Qs + (ig * 32 + ii) * 256 + d8 * 8);
                    float a = acc[ii];
                    a = __builtin_amdgcn_fdot2((h16x2){qv[0], qv[1]}, k0, a, false); a = __builtin_amdgcn_fdot2((h16x2){qv[2], qv[3]}, k1, a, false);
                    a = __builtin_amdgcn_fdot2((h16x2){qv[4], qv[5]}, k2, a, false); a = __builtin_amdgcn_fdot2((h16x2){qv[6], qv[7]}, k3, a, false);
                    acc[ii] = a;
                }
            }
#pragma unroll
            for (int ii = 0; ii < 32; ++ii) { const int i = ig * 32 + ii; AsT[j * 128 + i] = (i >= j) ? acc[ii] * rd[i - j] : 0.f; }
        }
        __syncthreads();
        for (int i = F.tid; i < 128 * 32; i += NTHREADS) {
            const int r = i >> 5, c8 = (i & 31) * 8; const float w = rd[r + 1];
            h16x8 q = *(h16x8*)(Qs + r * 256 + c8);
#pragma unroll
            for (int e = 0; e < 8; ++e) q[e] = (h16)((float)q[e] * w);
            *(h16x8*)(Qs + r * 256 + c8) = q;
        }
        __syncthreads();
        {
            const int dv = F.tid;
            float acc[128];
#pragma unroll
            for (int i = 0; i < 128; ++i) acc[i] = 0.f;
            const h16* vcol = RV + ((size_t)h * S + c * 128) * 512 + dv;
            for (int j = 0; j < 128; ++j) {
                const float v = (float)vcol[(size_t)j * 512];
#pragma unroll
                for (int i4 = 0; i4 < 32; ++i4) {
                    const f32x4 a = *(const f32x4*)(AsT + j * 128 + i4 * 4);
                    acc[i4 * 4 + 0] += a[0] * v; acc[i4 * 4 + 1] += a[1] * v; acc[i4 * 4 + 2] += a[2] * v; acc[i4 * 4 + 3] += a[3] * v;
                }
            }
            const h16* scol = SB + (((size_t)h * 64 + c) * 256) * 512 + dv;
            for (int d8 = 0; d8 < 32; ++d8) {
                h16x2 s0, s1, s2, s3;
                s0[0] = scol[(size_t)(d8 * 8 + 0) * 512]; s0[1] = scol[(size_t)(d8 * 8 + 1) * 512]; s1[0] = scol[(size_t)(d8 * 8 + 2) * 512]; s1[1] = scol[(size_t)(d8 * 8 + 3) * 512];
                s2[0] = scol[(size_t)(d8 * 8 + 4) * 512]; s2[1] = scol[(size_t)(d8 * 8 + 5) * 512]; s3[0] = scol[(size_t)(d8 * 8 + 6) * 512]; s3[1] = scol[(size_t)(d8 * 8 + 7) * 512];
#pragma unroll
                for (int i = 0; i < 128; ++i) {
                    const h16x8 qv = *(const h16x8*)(Qs + i * 256 + d8 * 8);
                    float a = acc[i];
                    a = __builtin_amdgcn_fdot2((h16x2){qv[0], qv[1]}, s0, a, false); a = __builtin_amdgcn_fdot2((h16x2){qv[2], qv[3]}, s1, a, false);
                    a = __builtin_amdgcn_fdot2((h16x2){qv[4], qv[5]}, s2, a, false); a = __builtin_amdgcn_fdot2((h16x2){qv[6], qv[7]}, s3, a, false);
                    acc[i] = a;
                }
            }
#pragma unroll
            for (int i = 0; i < 128; ++i) OR_[(size_t)(c * 128 + i) * 4096 + h * 512 + dv] = acc[i];
        }
    }
    __syncthreads();
}

__device__ __forceinline__ void phase_ret_gn(const Frame& F) {
    const float* OR_ = (const float*)(F.ws + WS_OR);
    const h16* RG = (const h16*)(F.ws + WS_QKV) + (size_t)8 * S * 256 * 2 + (size_t)8 * S * 512;
    h16* OZ = (h16*)(F.ws + WS_OZ);
    for (int task = F.bid * 8 + F.wave; task < S * 8; task += F.G * 8) {
        const int t = task >> 3, h = task & 7;
        const size_t off = (size_t)t * 4096 + h * 512 + F.lane * 8;
        const f32x4 a = *(const f32x4*)(OR_ + off), b = *(const f32x4*)(OR_ + off + 4);
        float s = a[0] + a[1] + a[2] + a[3] + b[0] + b[1] + b[2] + b[3];
        s = wave_sum(s); const float mu = s * (1.0f / 512.0f);
        float q = 0.f;
#pragma unroll
        for (int e = 0; e < 4; ++e) { const float d0 = a[e] - mu, d1 = b[e] - mu; q += d0 * d0 + d1 * d1; }
        q = wave_sum(q); const float r = 1.0f / sqrtf(q * (1.0f / 512.0f) + EPS);
        const h16x8 gv = *(const h16x8*)(RG + off);
        h16x8 o;
#pragma unroll
        for (int e = 0; e < 4; ++e) { o[e] = (h16)((float)gv[e] * ((a[e] - mu) * r)); o[4 + e] = (h16)((float)gv[4 + e] * ((b[e] - mu) * r)); }
        *(h16x8*)(OZ + off) = o;
    }
}

__device__ __forceinline__ void phase_gemm(const Frame& F, const h16* A, const h16* Bt, int N, int K, void* O, int ldc, int f32out) {
    pg8::Gemm g{A, Bt, S, N, K}; pg8::StaticOrder So; So.init(S, N, F.G, F.bid);
    pg8::EpiStore E{O, ldc, f32out};
    pg8::gemm_phase<pg8::EpiStore, pg8::StaticOrder, true, true>((LAS unsigned char*)F.lds, g, So, E);
}

constexpr int NPHASE = 2 + 8 * DEPTH;
__host__ __device__ inline bool phase_exists(int p) {
    if (p < 2) return true;
    const int L = (p - 2) / 8, s = (p - 2) % 8, kind = L % 3;
    if (s == 7) return false;
    if (s == 2) return kind != 0;
    if (s == 4) return kind == 2;
    return true;
}

__global__ void __launch_bounds__(NTHREADS, 2) trunk_fwd(Args args) {
    extern __shared__ __attribute__((aligned(16))) unsigned char lds_raw[];
    Frame F;
    F.out = args.out; F.ws = args.ws; F.lds = (char*)lds_raw;
    F.tid = threadIdx.x; F.lane = F.tid & 63; F.wave = __builtin_amdgcn_readfirstlane(F.tid >> 6); F.G = gridDim.x; F.bid = blockIdx.x;
    volatile LAS unsigned* misc = (volatile LAS unsigned*)((LAS unsigned char*)lds_raw + MISC_OFF);
    if (F.tid < 16) misc[F.tid] = 0u;
    __syncthreads();
    XcdBarrier bar; bar.bar = (unsigned*)(F.ws + WS_CTL) + CW_BAR; bar.x = 0; bar.st = misc;
#if ONE_LAUNCH
    bar = xcd_barrier_post((unsigned*)(F.ws + WS_CTL) + CW_BAR, misc);
    cg::grid_group grid = cg::this_grid();
#endif
    const int lo = args.ph_lo, hi = args.ph_hi;
#if ONE_LAUNCH
    grid.sync();
#define SEAM(p) do { if ((p) > lo) xcd_barrier(bar); } while (0)
#else
#define SEAM(p) do { } while (0)
#endif
#define IN(p) (lo <= (p) && (p) < hi)
#ifndef PHMASK
#define PHMASK 0xFFFF
#endif
#define EN(b) ((PHMASK >> (b)) & 1)
    if (EN(0) && IN(0)) { SEAM(0); phase_prologue(F, args); }
    if (EN(1) && IN(1)) { SEAM(1); phase_norm(F, args, -1, 0); }
#define LAYER(L) do { \
        constexpr int kind = (L) % 3, base = 2 + 8 * (L); \
        constexpr int Nin = kind == 0 ? 8192 : (kind == 1 ? NSA_NP : 12288); \
        constexpr int Kout = kind == 2 ? 4096 : 2048; \
        if (EN(2) && IN(base + 0)) { SEAM(base + 0); phase_gemm(F, (const h16*)(F.ws + WS_H), (const h16*)(F.ws + WS_WTIN), Nin, 2048, F.ws + WS_P, Nin, 0); } \
        if (IN(base + 1)) { SEAM(base + 1); if (EN(3) && kind == 0) phase_moba_post(F); else if (EN(4) && kind == 1) phase_nsa_post(F); else if (EN(5) && kind == 2) phase_ret_post(F); } \
        if (kind != 0 && IN(base + 2)) { SEAM(base + 2); if (EN(6) && kind == 1) phase_nsa_cmp(F, args); else if (EN(7) && kind == 2) phase_ret_scan(F); } \
        if (IN(base + 3)) { SEAM(base + 3); if (EN(8) && kind == 0) phase_moba_attn(F); else if (EN(9) && kind == 1) phase_nsa_attn(F); else if (EN(10) && kind == 2) phase_ret_out(F); } \
        if (EN(11) && kind == 2 && IN(base + 4)) { SEAM(base + 4); phase_ret_gn(F); } \
        if (EN(2) && IN(base + 5)) { SEAM(base + 5); phase_gemm(F, (const h16*)(F.ws + WS_OZ), (const h16*)(F.ws + WS_WTOUT), 2048, Kout, F.ws + WS_Y, 2048, 1); } \
        if (EN(1) && IN(base + 6)) { SEAM(base + 6); phase_norm(F, args, (L), (L) + 1 < DEPTH ? (L) + 1 : -1); } \
    } while (0)
    LAYER(0); LAYER(1); LAYER(2); LAYER(3);
#undef LAYER
#undef EN
#undef IN
#undef SEAM
}

extern "C" void kernel_launch(void* const* d_in, const int* in_sizes, int n_in, void* d_out, int out_size, void* d_ws, size_t ws_size, hipStream_t stream) {
    static int grid = 0;
    if (grid == 0) {
        if (n_in != 18 || out_size != S * D || ws_size < WS_END) { fprintf(stderr, "kernel_launch: unexpected shapes (n_in %d, out %d, ws %zu)\n", n_in, out_size, ws_size); grid = -1; return; }
        int dev = 0, cus = 0, per_cu = 0;
        if (hipGetDevice(&dev) != hipSuccess || hipDeviceGetAttribute(&cus, hipDeviceAttributeMultiprocessorCount, dev) != hipSuccess) { grid = -1; return; }
        if (hipFuncSetAttribute((const void*)trunk_fwd, hipFuncAttributeMaxDynamicSharedMemorySize, LDS_BYTES) != hipSuccess) { fprintf(stderr, "kernel_launch: hipFuncSetAttribute failed\n"); grid = -1; return; }
        if (hipOccupancyMaxActiveBlocksPerMultiprocessor(&per_cu, (const void*)trunk_fwd, NTHREADS, LDS_BYTES) != hipSuccess || per_cu < 1) { fprintf(stderr, "kernel_launch: occupancy query says %d\n", per_cu); per_cu = 1; }
        (void)hipGetLastError();
        grid = cus;
    }
    if (grid < 0) return;
    (void)hipMemsetAsync((char*)d_ws + WS_CTL, 0, CTL_ZERO_BYTES, stream);
    Args a{};
    for (int i = 0; i < 18; ++i) a.in[i] = (const float*)d_in[i];
    a.out = (float*)d_out; a.ws = (unsigned char*)d_ws;
    for (int j = 0; j < 16; ++j) a.inv16[j] = pow(500000.0, -(double)j / 16.0);
    for (int j = 0; j < 128; ++j) a.inv128[j] = pow(10000.0, -(double)j / 128.0);
#if ONE_LAUNCH
    a.ph_lo = 0; a.ph_hi = NPHASE;
    void* kargs[] = {&a};
    hipError_t e = hipLaunchCooperativeKernel((const void*)trunk_fwd, dim3(grid), dim3(NTHREADS), kargs, LDS_BYTES, stream);
    if (e != hipSuccess) fprintf(stderr, "kernel_launch: cooperative launch failed: %s (grid %d)\n", hipGetErrorString(e), grid);
#else
    for (int p = 0; p < NPHASE; ++p) {
        if (!phase_exists(p)) continue;
        a.ph_lo = p; a.ph_hi = p + 1;
        hipLaunchKernelGGL(trunk_fwd, dim3(grid), dim3(NTHREADS), LDS_BYTES, stream, a);
    }
#endif
}
```

```cpp
#include <hip/hip_runtime.h>
#include <hip/hip_cooperative_groups.h>
#include <cstdio>
#include <cstdint>
#include <cmath>
namespace cg = cooperative_groups;

#ifndef ONE_LAUNCH
#define ONE_LAUNCH 1
#endif

#define LAS __attribute__((address_space(3)))
typedef _Float16 h16;
typedef _Float16 h16x2 __attribute__((ext_vector_type(2)));
typedef _Float16 h16x4 __attribute__((ext_vector_type(4)));
typedef _Float16 h16x8 __attribute__((ext_vector_type(8)));
typedef float f32x2 __attribute__((ext_vector_type(2)));
typedef float f32x4 __attribute__((ext_vector_type(4)));
typedef unsigned u32x4 __attribute__((ext_vector_type(4)));

constexpr int S = 8192, D = 2048, DEPTH = 4;
constexpr float EPS = 1e-6f;
constexpr float NEGF = -1e30f, BIGF = 1e30f;
constexpr int NSA_NP = 7424;
constexpr int NC = 511;

constexpr size_t MiB = 1u << 20;
constexpr size_t WS_CTL = 0, CTL_ZERO_BYTES = 1 * MiB;
constexpr size_t WS_MODP = 1 * MiB;
constexpr size_t WS_KMEAN = 1 * MiB + 768 * 1024;
constexpr size_t WS_GATES = 3 * MiB;
constexpr size_t WS_KCMP = 5 * MiB;
constexpr size_t WS_VCMP = 5 * MiB + 512 * 1024;
constexpr size_t WS_ROPE16 = 6 * MiB;
constexpr size_t WS_ROPE128 = 7 * MiB;
constexpr size_t WS_WTIN = 16 * MiB;
constexpr size_t WS_WTOUT = 64 * MiB;
constexpr size_t WS_H = 80 * MiB;
constexpr size_t WS_P = 112 * MiB;
constexpr size_t WS_QKV = 304 * MiB;
constexpr size_t WS_OZ = 496 * MiB;
constexpr size_t WS_Y = 560 * MiB;
constexpr size_t WS_OR = 624 * MiB;
constexpr size_t WS_END = 752 * MiB;

constexpr int LDS_BYTES = 147456;
constexpr int MISC_OFF = 135168;
constexpr int NTHREADS = 512;

struct Args {
    const float* in[18];
    float* out;
    unsigned char* ws;
    double inv16[16];
    double inv128[128];
    int ph_lo, ph_hi;
};

#define XB_TMO      128
#define XB_XCNT(j)  (256  + 64 * (j))
#define XB_XSUB(j)  (1280 + 64 * (j))
#define XB_XGEN(j)  (2304 + 64 * (j))
#define XB_TOP      3328
#define XB_TOPGEN   3392
#define XCD_BAR_WORDS 3456
#define XB_SPIN_CAP (1u << 24)
constexpr int CW_BAR = 4096;

__device__ __forceinline__ unsigned xb_ld(unsigned* p)              { return __hip_atomic_load(p, __ATOMIC_RELAXED, __HIP_MEMORY_SCOPE_AGENT); }
__device__ __forceinline__ unsigned xb_add(unsigned* p, unsigned v) { return __hip_atomic_fetch_add(p, v, __ATOMIC_RELAXED, __HIP_MEMORY_SCOPE_AGENT); }
__device__ __forceinline__ unsigned xb_xcc_id() { return (unsigned)__builtin_amdgcn_s_getreg((3 << 11) | 20) & 0xFu; }
#define XB_SPIN(cond, bar) do { unsigned _sp = 0; while (cond) { __builtin_amdgcn_s_sleep(1); \
    if ((++_sp & 255u) == 0u) { if (xb_ld(&(bar)[XB_TMO])) break; if (_sp > XB_SPIN_CAP) { atomicAdd(&(bar)[XB_TMO], 1u); break; } } } } while (0)

struct XcdBarrier { unsigned* bar; unsigned x; volatile LAS unsigned* st; };

__device__ __forceinline__ XcdBarrier xcd_barrier_post(unsigned* bar, volatile LAS unsigned* st) {
    XcdBarrier b; b.bar = bar; b.x = xb_xcc_id(); b.st = st;
    if (threadIdx.x == 0) (void)xb_add(&bar[XB_XCNT(b.x)], 1u);
    return b;
}
__device__ __forceinline__ void xcd_barrier_complete(unsigned* bar, unsigned x, unsigned& nloc, unsigned& nx) {
    const unsigned G = gridDim.x * gridDim.y * gridDim.z;
    unsigned sum, cnt, mine, sp = 0u;
    for (;;) {
        sum = 0u; cnt = 0u; mine = 0u;
#pragma unroll
        for (unsigned j = 0; j < 16; ++j) { const unsigned c = xb_ld(&bar[XB_XCNT(j)]); sum += c; cnt += (c > 0u) ? 1u : 0u; mine = (j == x) ? c : mine; }
        if (sum == G) break;
        __builtin_amdgcn_s_sleep(1);
        if ((++sp & 255u) == 0u) { if (xb_ld(&bar[XB_TMO])) break; if (sp > XB_SPIN_CAP) { atomicAdd(&bar[XB_TMO], 1u); break; } }
    }
    nloc = mine > 0u ? mine : 1u; nx = cnt > 0u ? cnt : 1u;
}
__device__ __forceinline__ void xcd_barrier(const XcdBarrier& b) {
    asm volatile("s_waitcnt vmcnt(0)" ::: "memory");
    __syncthreads();
    if (threadIdx.x == 0) {
        unsigned* bar = b.bar;
        __builtin_amdgcn_s_waitcnt(0);
        unsigned nloc = b.st[0], nx = b.st[1];
        if (nloc == 0u) { xcd_barrier_complete(bar, b.x, nloc, nx); b.st[0] = nloc; b.st[1] = nx; }
        const unsigned old = xb_add(&bar[XB_XSUB(b.x)], 1u);
        const unsigned gen = old / nloc;
        if (old + 1u == (gen + 1u) * nloc) {
            __builtin_amdgcn_fence(__ATOMIC_RELEASE, "agent");
            asm volatile("s_waitcnt vmcnt(0)" ::: "memory");
            const unsigned og = xb_add(&bar[XB_TOP], 1u);
            const unsigned tg = og / nx;
            if (og + 1u == (tg + 1u) * nx) xb_add(&bar[XB_TOPGEN], 1u);
            else XB_SPIN(xb_ld(&bar[XB_TOPGEN]) == tg, bar);
            __builtin_amdgcn_fence(__ATOMIC_ACQUIRE, "agent");
            xb_add(&bar[XB_XGEN(b.x)], 1u);
            asm volatile("s_waitcnt vmcnt(0)" ::: "memory");
        } else {
            XB_SPIN(xb_ld(&bar[XB_XGEN(b.x)]) == gen, bar);
            __builtin_amdgcn_fence(__ATOMIC_ACQUIRE, "agent");
            asm volatile("s_waitcnt vmcnt(0)" ::: "memory");
        }
    }
    __syncthreads();
}

namespace pg8 {
constexpr int BM = 256, BK = 64, HALF = 128, HTB = HALF * BK * 2, STAGE_BYTES = 8 * HTB, NXCD = 8, WGM = 8;
__host__ __device__ __forceinline__ int lds_byte(int r, int c) { const int st = (r >> 4) * 2 + (c >> 5), rr = r & 15, cc = c & 31, ob = rr * 64 + cc * 2; return st * 1024 + (ob ^ (((ob >> 9) & 1) << 5)); }
__host__ __device__ __forceinline__ void stage_rc(int b, int& R, int& C) { const int st = b / 1024, sb = b % 1024, swz = sb ^ (((sb >> 9) & 1) << 5); R = (st >> 1) * 16 + swz / 64; C = (st & 1) * 32 + (swz % 64) / 2; }
__host__ __device__ __forceinline__ int perm32(int rho) { const int n = rho >> 4, i = rho & 15; return 8 * (i >> 2) + 4 * n + (i & 3); }

struct Unit { int pm, pn; };
struct Gemm { const h16* A; const h16* Bt; int M, N, K; };

struct StaticOrder {
    int nM, nN, nwg, G, c;
    __host__ __device__ void init(int M, int N, int G_, int c_) { nM = M / BM; nN = N / BM; nwg = nM * nN; G = G_; c = c_; }
    __host__ __device__ bool next(int i, Unit& u) const {
        const long L = (long)i * G + c; if (L >= nwg) return false;
        int wgid = (int)L; { const int q = nwg / NXCD, r = nwg % NXCD, xcd = wgid % NXCD, off = wgid / NXCD; wgid = (xcd < r ? xcd * (q + 1) : r * (q + 1) + (xcd - r) * q) + off; }
        const int nig = WGM * nN, gid = wgid / nig, fm = gid * WGM, gsz = (nM - fm) < WGM ? (nM - fm) : WGM;
        u.pm = fm + ((wgid % nig) % gsz); u.pn = (wgid % nig) / gsz; return true;
    }
    __device__ __forceinline__ void a_ready(const Unit&) const {}
    __device__ __forceinline__ void done(const Unit&) const {}
};

struct EpiStore {
    static constexpr bool PERM = true, AFTER_DRAIN = false;
    void* O; int ldc; int f32out;
    __device__ __forceinline__ void operator()(const f32x4 (&acc)[2][2][4][2], const Unit& u, int wr, int wc, int fr, int fq) const {
        const int row0 = u.pm * BM + wr * 64 + fr, col0 = u.pn * BM + wc * 32 + 8 * fq;
#pragma unroll
        for (int ai = 0; ai < 2; ++ai)
#pragma unroll
            for (int m = 0; m < 4; ++m) {
                const size_t roff = (size_t)(row0 + ai * HALF + m * 16) * ldc + col0;
#pragma unroll
                for (int bj = 0; bj < 2; ++bj) {
                    const f32x4 v0 = acc[ai][bj][m][0], v1 = acc[ai][bj][m][1];
                    if (f32out) {
                        float* p = (float*)O + roff + bj * HALF;
                        *(f32x4*)p = v0; *(f32x4*)(p + 4) = v1;
                    } else {
                        h16x8 w; w[0] = (h16)v0[0]; w[1] = (h16)v0[1]; w[2] = (h16)v0[2]; w[3] = (h16)v0[3]; w[4] = (h16)v1[0]; w[5] = (h16)v1[1]; w[6] = (h16)v1[2]; w[7] = (h16)v1[3];
                        *(h16x8*)((h16*)O + roff + bj * HALF) = w;
                    }
                }
            }
    }
};

template <class Epi, class Sched, bool ALIGN_EPI = false, bool SP2 = false>
__device__ __forceinline__ void gemm_phase(LAS unsigned char* lds, const Gemm g, const Sched& S, const Epi& E) {
    const int tid = threadIdx.x, wid = __builtin_amdgcn_readfirstlane(tid >> 6), lane = tid & 63, wr = wid >> 2, wc = wid & 3, fr = lane & 15, fq = lane >> 4;
    const int K = g.K, nt = K / BK;
    unsigned voffA[2], voffB[2];
#pragma unroll
    for (int i = 0; i < 2; ++i) { int R, C; stage_rc(tid * 16 + i * 8192, R, C); const int Rb = Epi::PERM ? ((R & ~31) + perm32(R & 31)) : R;
        voffA[i] = (unsigned)(R * K + C) * 2u; voffB[i] = (unsigned)(Rb * K + C) * 2u; }
    const size_t kstep = (size_t)(BK * 2);
    const size_t hstep = (size_t)HALF * K * 2;
    const size_t tstep = 2 * hstep;
    const unsigned ldsw = (unsigned)wid * 1024u;
    const int aoff = lds_byte(wr * 64 + fr, fq * 8), boff = lds_byte(wc * 32 + fr, fq * 8);
#define PG8_SA(b, h) (((b) * 2 + (h)) * HTB)
#define PG8_SB(b, h) ((4 + (b) * 2 + (h)) * HTB)
#define PG8_STAGE(bufoff, gbase, voff) do { _Pragma("unroll") for (int _i = 0; _i < 2; ++_i) \
        __builtin_amdgcn_global_load_lds((const unsigned*)((const char*)(gbase) + (voff)[_i]), (LAS unsigned*)(lds + (bufoff) + ldsw + _i * 8192), 16, 0, 0); } while (0)
#define PG8_LDA(dst, b, h) do { _Pragma("unroll") for (int m = 0; m < 4; ++m) _Pragma("unroll") for (int k = 0; k < 2; ++k) dst[m][k] = *(const LAS h16x8*)(lds + PG8_SA(b, h) + aoff + m * 2048 + k * 1024); } while (0)
#define PG8_LDB(dst, b, h) do { _Pragma("unroll") for (int n = 0; n < 2; ++n) _Pragma("unroll") for (int k = 0; k < 2; ++k) dst[n][k] = *(const LAS h16x8*)(lds + PG8_SB(b, h) + boff + n * 2048 + k * 1024); } while (0)
#define PG8_MMA(ai, bj, At, Bt) do { __builtin_amdgcn_s_setprio(1); _Pragma("unroll") for (int m = 0; m < 4; ++m) _Pragma("unroll") for (int n = 0; n < 2; ++n) _Pragma("unroll") for (int k = 0; k < 2; ++k) \
        acc[ai][bj][m][n] = __builtin_amdgcn_mfma_f32_16x16x32_f16(Bt[n][k], At[m][k], acc[ai][bj][m][n], 0, 0, 0); __builtin_amdgcn_s_setprio(0); } while (0)
#define PG8_WAIT_V(n) asm volatile("s_waitcnt vmcnt(" #n ")" ::: "memory")
#define PG8_WAIT_L(n) asm volatile("s_waitcnt lgkmcnt(" #n ")" ::: "memory")
#define PG8_BAR __builtin_amdgcn_s_barrier()
#define PG8_SCHED __builtin_amdgcn_sched_barrier(0)
    Unit cur, nxt; int ui = 0;
    if (!S.next(0, cur)) return;
    f32x4 acc[2][2][4][2];
#pragma unroll
    for (int a = 0; a < 2; ++a)
#pragma unroll
        for (int b = 0; b < 2; ++b)
#pragma unroll
            for (int m = 0; m < 4; ++m)
#pragma unroll
                for (int n = 0; n < 2; ++n) acc[a][b][m][n] = (f32x4){0.f, 0.f, 0.f, 0.f};
    h16x8 At[4][2], B0[2][2], B1[2][2];
    const char* cA = (const char*)g.A + (size_t)cur.pm * tstep; const char* cB = (const char*)g.Bt + (size_t)cur.pn * tstep;
    S.a_ready(cur);
    if constexpr (SP2) {
        PG8_STAGE(PG8_SB(0, 0), cB, voffB); PG8_STAGE(PG8_SB(0, 1), cB + hstep, voffB); PG8_STAGE(PG8_SA(0, 0), cA, voffA); PG8_STAGE(PG8_SA(0, 1), cA + hstep, voffA);
        if (wr == 1) PG8_BAR;
        PG8_WAIT_V(2); PG8_BAR;
        PG8_STAGE(PG8_SB(1, 0), cB + kstep, voffB); PG8_STAGE(PG8_SA(1, 0), cA + kstep, voffA); PG8_STAGE(PG8_SB(1, 1), cB + hstep + kstep, voffB);
        PG8_WAIT_V(6); PG8_BAR;
    } else {
        PG8_STAGE(PG8_SB(0, 0), cB, voffB); PG8_STAGE(PG8_SA(0, 0), cA, voffA); PG8_STAGE(PG8_SB(0, 1), cB + hstep, voffB); PG8_STAGE(PG8_SA(0, 1), cA + hstep, voffA);
        if (wr == 1) PG8_BAR;
        PG8_WAIT_V(4); PG8_BAR;
        PG8_STAGE(PG8_SB(1, 0), cB + kstep, voffB); PG8_STAGE(PG8_SA(1, 0), cA + kstep, voffA); PG8_STAGE(PG8_SB(1, 1), cB + hstep + kstep, voffB);
        PG8_WAIT_V(6); PG8_BAR;
    }
    for (;;) {
        const bool has_next = S.next(ui + 1, nxt);
        const char* nA = has_next ? (const char*)g.A + (size_t)nxt.pm * tstep : cA; const char* nB = has_next ? (const char*)g.Bt + (size_t)nxt.pn * tstep : cB;
        for (int t = 0; t < nt; t += 2) {
            const bool last = (t == nt - 2);
            const char* a1 = cA + (size_t)(t + 1) * kstep;
            const char* a2 = last ? nA : cA + (size_t)(t + 2) * kstep; const char* b2 = last ? nB : cB + (size_t)(t + 2) * kstep;
            const char* a3 = a2 + kstep; const char* b3 = b2 + kstep;
            if (last && has_next) S.a_ready(nxt);
            if constexpr (SP2) {
            PG8_LDB(B0, 0, 0); PG8_LDB(B1, 0, 1); PG8_SCHED; PG8_LDA(At, 0, 0); PG8_STAGE(PG8_SA(1, 1), a1 + hstep, voffA);
            PG8_WAIT_V(8); PG8_WAIT_L(0); PG8_BAR; PG8_MMA(0, 0, At, B0); PG8_MMA(0, 1, At, B1); PG8_BAR; PG8_SCHED;
            PG8_LDA(At, 0, 1); PG8_STAGE(PG8_SB(0, 0), b2, voffB); PG8_STAGE(PG8_SB(0, 1), b2 + hstep, voffB); PG8_STAGE(PG8_SA(0, 0), a2, voffA);
            PG8_WAIT_V(8); PG8_WAIT_L(0); PG8_BAR; PG8_MMA(1, 0, At, B0); PG8_MMA(1, 1, At, B1); PG8_BAR; PG8_SCHED;
            PG8_LDB(B0, 1, 0); PG8_LDB(B1, 1, 1); PG8_SCHED; PG8_LDA(At, 1, 0); PG8_STAGE(PG8_SA(0, 1), a2 + hstep, voffA);
            PG8_WAIT_V(8); PG8_WAIT_L(0); PG8_BAR; PG8_MMA(0, 0, At, B0); PG8_MMA(0, 1, At, B1); PG8_BAR; PG8_SCHED;
            PG8_LDA(At, 1, 1); PG8_STAGE(PG8_SB(1, 0), b3, voffB); PG8_STAGE(PG8_SB(1, 1), b3 + hstep, voffB); PG8_STAGE(PG8_SA(1, 0), a3, voffA);
            PG8_WAIT_V(8); PG8_WAIT_L(0); PG8_BAR; PG8_MMA(1, 0, At, B0); PG8_MMA(1, 1, At, B1); PG8_BAR; PG8_SCHED;
            } else {
            PG8_LDB(B0, 0, 0); PG8_SCHED; PG8_LDA(At, 0, 0); PG8_STAGE(PG8_SA(1, 1), a1 + hstep, voffA);
            PG8_WAIT_L(8); PG8_BAR; PG8_WAIT_L(0); PG8_MMA(0, 0, At, B0); PG8_BAR; PG8_SCHED;
            PG8_LDB(B1, 0, 1); PG8_STAGE(PG8_SB(0, 0), b2, voffB);
            PG8_BAR; PG8_WAIT_L(0); PG8_MMA(0, 1, At, B1); PG8_BAR;
            PG8_LDA(At, 0, 1); PG8_STAGE(PG8_SA(0, 0), a2, voffA);
            PG8_BAR; PG8_WAIT_L(0); PG8_MMA(1, 0, At, B0); PG8_BAR; PG8_SCHED;
            PG8_STAGE(PG8_SB(0, 1), b2 + hstep, voffB);
            PG8_WAIT_V(6); PG8_BAR; PG8_MMA(1, 1, At, B1); PG8_BAR;
            PG8_LDB(B0, 1, 0); PG8_SCHED; PG8_LDA(At, 1, 0); PG8_STAGE(PG8_SA(0, 1), a2 + hstep, voffA);
            PG8_WAIT_L(8); PG8_BAR; PG8_WAIT_L(0); PG8_MMA(0, 0, At, B0); PG8_BAR; PG8_SCHED;
            PG8_LDB(B1, 1, 1); PG8_STAGE(PG8_SB(1, 0), b3, voffB);
            PG8_BAR; PG8_WAIT_L(0); PG8_MMA(0, 1, At, B1); PG8_BAR;
            PG8_LDA(At, 1, 1); PG8_STAGE(PG8_SA(1, 0), a3, voffA);
            PG8_BAR; PG8_WAIT_L(0); PG8_MMA(1, 0, At, B0); PG8_BAR; PG8_SCHED;
            PG8_STAGE(PG8_SB(1, 1), b3 + hstep, voffB);
            PG8_WAIT_V(6); PG8_BAR; PG8_MMA(1, 1, At, B1); PG8_BAR;
            }
        }
        if constexpr (ALIGN_EPI) { if (wr == 0) PG8_BAR; }
        if constexpr (!Epi::AFTER_DRAIN) { E(acc, cur, wr, wc, fr, fq); S.done(cur); }
        if (!has_next) break;
#pragma unroll
        for (int a = 0; a < 2; ++a)
#pragma unroll
            for (int b = 0; b < 2; ++b)
#pragma unroll
                for (int m = 0; m < 4; ++m)
#pragma unroll
                    for (int n = 0; n < 2; ++n) acc[a][b][m][n] = (f32x4){0.f, 0.f, 0.f, 0.f};
        cur = nxt; cA = nA; cB = nB; ++ui;
        if constexpr (ALIGN_EPI) { if (wr == 1) PG8_BAR; }
    }
    PG8_WAIT_V(0);
    if constexpr (!ALIGN_EPI) { if (wr == 0) PG8_BAR; }
    PG8_BAR;
#undef PG8_SA
#undef PG8_SB
#undef PG8_STAGE
#undef PG8_LDA
#undef PG8_LDB
#undef PG8_MMA
#undef PG8_WAIT_V
#undef PG8_WAIT_L
#undef PG8_BAR
#undef PG8_SCHED
}
}

struct Frame {
    float* out;
    unsigned char* ws;
    char* lds;
    int tid, lane, wave, G, bid;
};

__device__ __forceinline__ float silu_f(float x) { return x / (1.f + __expf(-x)); }
__device__ __forceinline__ float sigmoid_f(float x) { return 1.f / (1.f + __expf(-x)); }
__device__ __forceinline__ float wave_sum(float v) {
#pragma unroll
    for (int o = 32; o >= 1; o >>= 1) v += __shfl_xor(v, o);
    return v;
}
__device__ __forceinline__ float wave_max(float v) {
#pragma unroll
    for (int o = 32; o >= 1; o >>= 1) v = fmaxf(v, __shfl_xor(v, o));
    return v;
}
__device__ __forceinline__ void wave_lds_fence() { __builtin_amdgcn_wave_barrier(); asm volatile("s_waitcnt lgkmcnt(0)" ::: "memory"); __builtin_amdgcn_wave_barrier(); }

__device__ __forceinline__ void sincos_d(double x, float& c, float& s) {
    const double TWO_OVER_PI = 0.63661977236758134308;
    const double PIO2_HI = 1.57079632679489655800e+00, PIO2_LO = 6.12323399573676603587e-17;
    const double q = __builtin_rint(x * TWO_OVER_PI);
    double y = __builtin_fma(-q, PIO2_HI, x); y = __builtin_fma(-q, PIO2_LO, y);
    const double y2 = y * y;
    double sp = 1.0 / 6227020800.0;
    sp = sp * y2 - 1.0 / 39916800.0; sp = sp * y2 + 1.0 / 362880.0; sp = sp * y2 - 1.0 / 5040.0; sp = sp * y2 + 1.0 / 120.0; sp = sp * y2 - 1.0 / 6.0; sp = sp * y2 * y + y;
    double cp = -1.0 / 87178291200.0;
    cp = cp * y2 + 1.0 / 479001600.0; cp = cp * y2 - 1.0 / 3628800.0; cp = cp * y2 + 1.0 / 40320.0; cp = cp * y2 - 1.0 / 720.0; cp = cp * y2 + 1.0 / 24.0; cp = cp * y2 - 0.5; cp = cp * y2 + 1.0;
    const long long qi = (long long)q; const int quad = (int)(qi & 3);
    double sv, cv;
    if (quad == 0) { sv = sp; cv = cp; } else if (quad == 1) { sv = cp; cv = -sp; } else if (quad == 2) { sv = -sp; cv = -cp; } else { sv = -cp; cv = sp; }
    c = (float)cv; s = (float)sv;
}

__device__ __forceinline__ int nsa_src_col(int n) { return n < 5120 ? n : (n < 7168 ? n + 48 : (n < 7216 ? n - 2048 : -1)); }
__device__ __forceinline__ void conv_transpose(const Frame& F, const float* W, int K, int Nsrc, h16* Wt, int Npad, int mapmode, int item0, int& items_done) {
    float* tile = (float*)F.lds;
    const int tk_n = K / 64, tn_n = Npad / 64, ntiles = tk_n * tn_n;
    for (int it = F.bid; it < ntiles; it += F.G) {
        const int tk = it / tn_n, tn = it % tn_n;
        __syncthreads();
#pragma unroll
        for (int i = 0; i < 8; ++i) {
            const int idx = F.tid + i * NTHREADS, k = idx >> 6, n = idx & 63;
            const int nn = tn * 64 + n; const int src = mapmode ? nsa_src_col(nn) : nn;
            float v = 0.f; if (src >= 0 && src < Nsrc) v = W[(size_t)(tk * 64 + k) * Nsrc + src];
            tile[k * 65 + n] = v;
        }
        __syncthreads();
#pragma unroll
        for (int i = 0; i < 8; ++i) {
            const int idx = F.tid + i * NTHREADS, n = idx >> 6, k = idx & 63;
            Wt[(size_t)(tn * 64 + n) * K + tk * 64 + k] = (h16)tile[k * 65 + n];
        }
    }
    __syncthreads();
}
__device__ __forceinline__ void conv_layer_weights(const Frame& F, const Args& A, int L) {
    const int kind = L % 3, j = L / 3; int dummy = 0;
    h16* wtin = (h16*)(F.ws + WS_WTIN); h16* wtout = (h16*)(F.ws + WS_WTOUT);
    if (kind == 0) {
        conv_transpose(F, A.in[7] + (size_t)j * 2048 * 8192, 2048, 8192, wtin, 8192, 0, 0, dummy);
        conv_transpose(F, A.in[8] + (size_t)j * 2048 * 2048, 2048, 2048, wtout, 2048, 0, 0, dummy);
    } else if (kind == 1) {
        conv_transpose(F, A.in[9], 2048, 7216, wtin, NSA_NP, 1, 0, dummy);
        conv_transpose(F, A.in[10], 2048, 2048, wtout, 2048, 0, 0, dummy);
    } else {
        conv_transpose(F, A.in[16], 2048, 12288, wtin, 12288, 0, 0, dummy);
        conv_transpose(F, A.in[17], 4096, 2048, wtout, 2048, 0, 0, dummy);
    }
}

__device__ __forceinline__ void phase_prologue(const Frame& F, const Args& A) {
    {
        float* modp = (float*)(F.ws + WS_MODP);
        const float* c = A.in[1]; const float* aw = A.in[3];
        for (int it = F.bid; it < 384; it += F.G) {
            const int layer = it / 96, r = it % 96, slice = r / 12, nch = r % 12, n = nch * 512 + F.tid;
            const float* w = aw + (size_t)layer * 2048 * 6144 + (size_t)(slice * 256) * 6144 + n;
            float acc = 0.f;
#pragma unroll 8
            for (int k = 0; k < 256; ++k) acc += silu_f(c[slice * 256 + k]) * w[(size_t)k * 6144];
            modp[(size_t)(slice * 4 + layer) * 6144 + n] = acc;
        }
    }
    {
        const int* pos = (const int*)A.in[2];
        f32x2* r16 = (f32x2*)(F.ws + WS_ROPE16); f32x2* r128 = (f32x2*)(F.ws + WS_ROPE128);
        for (int idx = F.bid * NTHREADS + F.tid; idx < S * 16; idx += F.G * NTHREADS) {
            const int t = idx >> 4, j = idx & 15; float cs, sn; sincos_d((double)pos[t] * A.inv16[j], cs, sn); r16[idx] = (f32x2){cs, sn};
        }
        for (int idx = F.bid * NTHREADS + F.tid; idx < S * 128; idx += F.G * NTHREADS) {
            const int t = idx >> 7, j = idx & 127; float cs, sn; sincos_d((double)pos[t] * A.inv128[j], cs, sn); r128[idx] = (f32x2){cs, sn};
        }
    }
    conv_layer_weights(F, A, 0);
}

__device__ __forceinline__ void phase_norm(const Frame& F, const Args& A, int Lprev, int Lnext) {
    float* modl = (float*)F.lds;
    const float* modp = (const float*)(F.ws + WS_MODP); const float* ab = A.in[4];
    __syncthreads();
    for (int i = F.tid; i < 6144; i += NTHREADS) {
        const int which = i >> 11, col = i & 2047;
        int layer, mcol;
        if (which == 0) { layer = Lprev; mcol = 4096 + col; } else if (which == 1) { layer = Lnext; mcol = 2048 + col; } else { layer = Lnext; mcol = col; }
        float v = 0.f;
        if (layer >= 0) { v = ab[layer * 6144 + mcol];
#pragma unroll
            for (int s = 0; s < 8; ++s) v += modp[(size_t)(s * 4 + layer) * 6144 + mcol]; }
        modl[i] = v;
    }
    __syncthreads();
    const float* xin = (Lprev <= 0) ? A.in[0] : F.out;
    const float* Y = (const float*)(F.ws + WS_Y);
    h16* H = (h16*)(F.ws + WS_H);
    const float* npost = A.in[6] + (Lprev >= 0 ? Lprev : 0) * 2048;
    const float* npre = A.in[5] + (Lnext >= 0 ? Lnext : 0) * 2048;
    for (int t = F.bid * 8 + F.wave; t < S; t += F.G * 8) {
        f32x4 x[8];
#pragma unroll
        for (int i = 0; i < 8; ++i) x[i] = *(const f32x4*)(xin + (size_t)t * D + i * 256 + F.lane * 4);
        if (Lprev >= 0) {
            f32x4 y[8]; float ss = 0.f;
#pragma unroll
            for (int i = 0; i < 8; ++i) { y[i] = *(const f32x4*)(Y + (size_t)t * D + i * 256 + F.lane * 4); ss += y[i][0] * y[i][0] + y[i][1] * y[i][1] + y[i][2] * y[i][2] + y[i][3] * y[i][3]; }
            ss = wave_sum(ss);
            const float r = 1.0f / sqrtf(ss * (1.0f / D) + EPS);
#pragma unroll
            for (int i = 0; i < 8; ++i) {
                const int col = i * 256 + F.lane * 4;
                const f32x4 g = *(const f32x4*)(npost + col); const f32x4 gt = *(const f32x4*)(modl + col);
#pragma unroll
                for (int e = 0; e < 4; ++e) x[i][e] += gt[e] * (y[i][e] * r * g[e]);
                *(f32x4*)(F.out + (size_t)t * D + col) = x[i];
            }
        }
        if (Lnext >= 0) {
            float ss = 0.f;
#pragma unroll
            for (int i = 0; i < 8; ++i) ss += x[i][0] * x[i][0] + x[i][1] * x[i][1] + x[i][2] * x[i][2] + x[i][3] * x[i][3];
            ss = wave_sum(ss);
            const float r = 1.0f / sqrtf(ss * (1.0f / D) + EPS);
#pragma unroll
            for (int i = 0; i < 8; ++i) {
                const int col = i * 256 + F.lane * 4;
                const f32x4 g = *(const f32x4*)(npre + col); const f32x4 sc = *(const f32x4*)(modl + 2048 + col); const f32x4 sh = *(const f32x4*)(modl + 4096 + col);
                h16x4 hv;
#pragma unroll
                for (int e = 0; e < 4; ++e) hv[e] = (h16)((x[i][e] * r * g[e]) * (1.0f + sc[e]) + sh[e]);
                *(h16x4*)(H + (size_t)t * D + col) = hv;
            }
        }
    }
    if (Lnext > 0) conv_layer_weights(F, A, Lnext);
}

__device__ __forceinline__ void load16(const h16* p, float (&v)[16]) {
    const h16x8 a = *(const h16x8*)p, b = *(const h16x8*)(p + 8);
#pragma unroll
    for (int i = 0; i < 8; ++i) { v[i] = (float)a[i]; v[8 + i] = (float)b[i]; }
}
__device__ __forceinline__ void store16(h16* p, const float (&v)[16]) {
    h16x8 a, b;
#pragma unroll
    for (int i = 0; i < 8; ++i) { a[i] = (h16)v[i]; b[i] = (h16)v[8 + i]; }
    *(h16x8*)p = a; *(h16x8*)(p + 8) = b;
}
__device__ __forceinline__ void rope32(float (&v)[16], int d0, const f32x2* cs  ) {
#pragma unroll
    for (int i = 0; i < 16; ++i) {
        const float o = __shfl_xor(v[i], 1);
        if (d0 < 32) {
            const f32x2 c = cs[i];
            v[i] = (d0 == 0) ? (v[i] * c[0] - o * c[1]) : (o * c[1] + v[i] * c[0]);
        }
    }
}

__device__ __forceinline__ void phase_moba_post(const Frame& F) {
    const h16* P = (const h16*)(F.ws + WS_P);
    h16* Q = (h16*)(F.ws + WS_QKV); h16* K = Q + (size_t)16 * S * 128; h16* V = K + (size_t)16 * S * 128; h16* Z = V + (size_t)16 * S * 128;
    const f32x2* r16 = (const f32x2*)(F.ws + WS_ROPE16);
    float* kmean = (float*)(F.ws + WS_KMEAN);
    float* red = (float*)F.lds;
    for (int it = F.bid; it < 256; it += F.G) {
        const int blk = it >> 3, part = it & 7, sect = part >> 1;
        const int cs0 = (part & 1) * 1024 + F.lane * 16;
        const int head = cs0 >> 7, d0 = cs0 & 127;
        float ksum[16];
#pragma unroll
        for (int i = 0; i < 16; ++i) ksum[i] = 0.f;
        for (int i = 0; i < 32; ++i) {
            const int t = blk * 256 + F.wave * 32 + i;
            float v[16]; load16(P + (size_t)t * 8192 + part * 1024 + F.lane * 16, v);
            if (sect <= 1) {
                rope32(v, d0, r16 + (size_t)t * 16);
                if (sect == 0) {
#pragma unroll
                    for (int e = 0; e < 16; ++e) v[e] *= 0.08838834764831845f;
                    store16(Q + ((size_t)head * S + t) * 128 + d0, v);
                } else {
#pragma unroll
                    for (int e = 0; e < 16; ++e) ksum[e] += v[e];
                    store16(K + ((size_t)head * S + t) * 128 + d0, v);
                }
            } else if (sect == 2) {
                store16(V + ((size_t)head * S + t) * 128 + d0, v);
            } else {
#pragma unroll
                for (int e = 0; e < 16; ++e) v[e] = silu_f(v[e]);
                store16(Z + (size_t)t * 2048 + cs0, v);
            }
        }
        if (sect == 1) {
            __syncthreads();
#pragma unroll
            for (int e = 0; e < 16; ++e) red[F.wave * 1024 + F.lane * 16 + e] = ksum[e];
            __syncthreads();
            for (int c = F.tid; c < 1024; c += NTHREADS) {
                float s = 0.f;
#pragma unroll
                for (int w = 0; w < 8; ++w) s += red[w * 1024 + c];
                const int cc = (part & 1) * 1024 + c;
                kmean[((size_t)(cc >> 7) * 32 + blk) * 128 + (cc & 127)] = s * (1.0f / 256.0f);
            }
            __syncthreads();
        }
    }
}

__device__ __forceinline__ void wave_attend(const h16* __restrict__ K, const h16* __restrict__ V, int nslots, const int* starts, int limit,
                                            const float* qf, float* pbuf, int lane, float& o0, float& o1) {
    float sc[16]; float mx = NEGF;
#pragma unroll
    for (int k = 0; k < 16; ++k) {
        sc[k] = NEGF;
        if (k < nslots) {
            const int key = starts[k] + lane;
            if (key >= 0 && key <= limit) {
                const h16x8* kr = (const h16x8*)(K + (size_t)key * 128);
                float d = 0.f;
#pragma unroll
                for (int i = 0; i < 16; ++i) {
                    const h16x8 kv = kr[i]; const f32x4 qa = *(const f32x4*)(qf + i * 8), qb = *(const f32x4*)(qf + i * 8 + 4);
                    d += (float)kv[0] * qa[0] + (float)kv[1] * qa[1] + (float)kv[2] * qa[2] + (float)kv[3] * qa[3] + (float)kv[4] * qb[0] + (float)kv[5] * qb[1] + (float)kv[6] * qb[2] + (float)kv[7] * qb[3];
                }
                sc[k] = d;
            }
            mx = fmaxf(mx, sc[k]);
        }
    }
    mx = wave_max(mx);
    float sum = 0.f;
#pragma unroll
    for (int k = 0; k < 16; ++k) { const float p = (sc[k] > 0.5f * NEGF) ? __expf(sc[k] - mx) : 0.f; sc[k] = p; sum += p; }
    sum = wave_sum(sum);
    const float inv = 1.0f / fmaxf(sum, 1e-30f);
    wave_lds_fence();
#pragma unroll
    for (int k = 0; k < 16; ++k) if (k < nslots) pbuf[k * 64 + lane] = sc[k] * inv;
    wave_lds_fence();
    float a0 = 0.f, a1 = 0.f;
    for (int k = 0; k < nslots; ++k) {
        const int base = starts[k];
        for (int i = 0; i < 64; ++i) {
            const int key = base + i;
            if (key >= 0 && key <= limit) {
                const float p = pbuf[k * 64 + i];
                const h16x2 vv = *(const h16x2*)(V + (size_t)key * 128 + 2 * lane);
                a0 += p * (float)vv[0]; a1 += p * (float)vv[1];
            }
        }
    }
    o0 = a0; o1 = a1;
}

constexpr int WS_QF = 0, WS_PB = 2048, WS_PC = 6144, WS_SEL = 14336, WS_ST = 14848, WS_LIST = 14912;
constexpr int WSCR_STRIDE = 16384;

__device__ __forceinline__ void phase_moba_attn(const Frame& F) {
    const h16* Q = (const h16*)(F.ws + WS_QKV); const h16* K = Q + (size_t)16 * S * 128; const h16* V = K + (size_t)16 * S * 128; const h16* Z = V + (size_t)16 * S * 128;
    const float* kmean = (const float*)(F.ws + WS_KMEAN);
    h16* OZ = (h16*)(F.ws + WS_OZ);
    char* wl = F.lds + F.wave * WSCR_STRIDE;
    float* qf = (float*)(wl + WS_QF); float* pbuf = (float*)(wl + WS_PB); int* starts = (int*)(wl + WS_ST);
    const int lane = F.lane;
    for (int task = F.bid * 8 + F.wave; task < 16 * S; task += F.G * 8) {
        const int head = task >> 13, t = task & (S - 1), blk = t >> 8;
        wave_lds_fence();
        { const h16x2 qv = *(const h16x2*)(Q + ((size_t)head * S + t) * 128 + 2 * lane); qf[2 * lane] = (float)qv[0]; qf[2 * lane + 1] = (float)qv[1]; }
        wave_lds_fence();
        float gs = NEGF;
        if (lane < blk) {
            const float* km = kmean + ((size_t)head * 32 + lane) * 128; float d = 0.f;
#pragma unroll 8
            for (int i = 0; i < 128; ++i) d += qf[i] * km[i];
            gs = d;
        }
        int sel[3];
#pragma unroll
        for (int r = 0; r < 3; ++r) {
            float bv = gs; int bi = lane;
#pragma unroll
            for (int o = 32; o >= 1; o >>= 1) { const float ov = __shfl_xor(bv, o); const int oi = __shfl_xor(bi, o); if (ov > bv || (ov == bv && oi < bi)) { bv = ov; bi = oi; } }
            sel[r] = bi; if (lane == bi) gs = -3.0e38f;
        }
        const int nsel = blk < 3 ? blk : 3;
        if (lane < 16) {
            const int grp = lane >> 2, sub = lane & 3;
            const int b = (grp == 0) ? blk : (grp == 1 ? sel[0] : (grp == 2 ? sel[1] : sel[2]));
            starts[lane] = b * 256 + sub * 64;
        }
        wave_lds_fence();
        float o0, o1;
        wave_attend(K + (size_t)head * S * 128, V + (size_t)head * S * 128, 4 + 4 * nsel, starts, t, qf, pbuf, lane, o0, o1);
        const h16x2 zz = *(const h16x2*)(Z + (size_t)t * 2048 + head * 128 + 2 * lane);
        h16x2 ov; ov[0] = (h16)(o0 * (float)zz[0]); ov[1] = (h16)(o1 * (float)zz[1]);
        *(h16x2*)(OZ + (size_t)t * 2048 + head * 128 + 2 * lane) = ov;
    }
}

__device__ __forceinline__ void phase_nsa_post(const Frame& F) {
    const h16* P = (const h16*)(F.ws + WS_P);
    h16* Q = (h16*)(F.ws + WS_QKV); h16* KV = Q + (size_t)16 * S * 128;
    h16* Z = (h16*)(F.ws + WS_QKV + 96 * MiB);
    float* gates = (float*)(F.ws + WS_GATES);
    const f32x2* r16 = (const f32x2*)(F.ws + WS_ROPE16);
    for (int it = F.bid; it < 256; it += F.G) {
        const int blk = it >> 3, part = it & 7;
        for (int i = 0; i < 32; ++i) {
            const int t = blk * 256 + F.wave * 32 + i;
            float v[16]; load16(P + (size_t)t * NSA_NP + part * 1024 + F.lane * 16, v);
            if (part <= 1) {
                const int cs0 = part * 1024 + F.lane * 16, head = cs0 >> 7, d0 = cs0 & 127;
                rope32(v, d0, r16 + (size_t)t * 16);
#pragma unroll
                for (int e = 0; e < 16; ++e) v[e] *= 0.08838834764831845f;
                store16(Q + ((size_t)head * S + t) * 128 + d0, v);
            } else if (part <= 4) {
                const int x = part - 2, isv = F.lane >> 5, grp = (F.lane & 31) >> 3, d0 = (F.lane & 7) * 16;
                rope32(v, isv ? 64 : d0, r16 + (size_t)t * 16);
                store16(KV + ((size_t)(2 * x + isv) * 4 + grp) * S * 128 + (size_t)t * 128 + d0, v);
            } else if (part <= 6) {
                const int cs0 = (part - 5) * 1024 + F.lane * 16;
#pragma unroll
                for (int e = 0; e < 16; ++e) v[e] = silu_f(v[e]);
                store16(Z + (size_t)t * 2048 + cs0, v);
            } else {
                if (F.lane < 3) {
#pragma unroll
                    for (int e = 0; e < 16; ++e) gates[(size_t)t * 48 + F.lane * 16 + e] = sigmoid_f(v[e]);
                }
            }
        }
    }
}

__device__ __forceinline__ void phase_nsa_cmp(const Frame& F, const Args& A) {
    const h16* KVb = (const h16*)(F.ws + WS_QKV) + (size_t)16 * S * 128;
    const float* pe_g = A.in[11];
    h16* xs = (h16*)F.lds;
    float* pe = (float*)(F.lds + 36864);
    float* hid = (float*)(F.lds + 36864 + 16384);
    for (int it = F.bid; it < 512; it += F.G) {
        const int kv = it >> 8, g = (it >> 6) & 3, nb = it & 63;
        const h16* src = KVb + ((size_t)kv * 4 + g) * S * 128;
        const float* W1 = kv ? A.in[14] : A.in[12]; const float* W2 = kv ? A.in[15] : A.in[13];
        h16* dst = (h16*)(F.ws + (kv ? WS_VCMP : WS_KCMP)) + (size_t)g * 512 * 128;
        __syncthreads();
        for (int i = F.tid; i < 144 * 16; i += NTHREADS) {
            const int r = i >> 4, c8 = (i & 15) * 8, tok = nb * 128 + r;
            h16x8 v;
#pragma unroll
            for (int e = 0; e < 8; ++e) v[e] = (h16)0.f;
            if (tok < S) v = *(const h16x8*)(src + (size_t)tok * 128 + c8);
            *(h16x8*)(xs + r * 128 + c8) = v;
        }
        for (int i = F.tid; i < 4096; i += NTHREADS) pe[i] = pe_g[i];
        __syncthreads();
        {
            const int j = F.tid & 255, rh = F.tid >> 8;
            float acc[4] = {0.f, 0.f, 0.f, 0.f};
            for (int pos = 0; pos < 32; ++pos) {
#pragma unroll 4
                for (int d = 0; d < 128; ++d) {
                    const float w = W1[(size_t)(pos * 128 + d) * 256 + j]; const float pv = pe[pos * 128 + d];
#pragma unroll
                    for (int rr = 0; rr < 4; ++rr) acc[rr] += ((float)xs[(16 * (rh * 4 + rr) + pos) * 128 + d] + pv) * w;
                }
            }
#pragma unroll
            for (int rr = 0; rr < 4; ++rr) hid[(rh * 4 + rr) * 256 + j] = silu_f(acc[rr]);
        }
        __syncthreads();
        {
            const int d = F.tid & 127, rq = F.tid >> 7;
            float a0 = 0.f, a1 = 0.f;
#pragma unroll 4
            for (int j = 0; j < 256; ++j) { const float w = W2[j * 128 + d]; a0 += hid[rq * 256 + j] * w; a1 += hid[(rq + 4) * 256 + j] * w; }
            const int n0 = nb * 8 + rq, n1 = nb * 8 + rq + 4;
            if (n0 < NC) dst[(size_t)n0 * 128 + d] = (h16)a0;
            if (n1 < NC) dst[(size_t)n1 * 128 + d] = (h16)a1;
        }
    }
    __syncthreads();
}

__device__ __forceinline__ void phase_nsa_attn(const Frame& F) {
    const h16* Q = (const h16*)(F.ws + WS_QKV); const h16* KVb = Q + (size_t)16 * S * 128;
    const h16* Z = (const h16*)(F.ws + WS_QKV + 96 * MiB);
    const float* gates = (const float*)(F.ws + WS_GATES);
    const h16* KCMP = (const h16*)(F.ws + WS_KCMP); const h16* VCMP = (const h16*)(F.ws + WS_VCMP);
    h16* OZ = (h16*)(F.ws + WS_OZ);
    char* wl = F.lds + F.wave * WSCR_STRIDE;
    float* qf = (float*)(wl + WS_QF); float* pbuf = (float*)(wl + WS_PB); float* pc = (float*)(wl + WS_PC);
    float* selbuf = (float*)(wl + WS_SEL); int* starts = (int*)(wl + WS_ST); int* list = (int*)(wl + WS_LIST);
    const int lane = F.lane;
    for (int task = F.bid * 8 + F.wave; task < 4 * S; task += F.G * 8) {
        const int g = task >> 13, t = task & (S - 1);
        wave_lds_fence();
#pragma unroll
        for (int hh = 0; hh < 4; ++hh) { const h16x2 qv = *(const h16x2*)(Q + ((size_t)(4 * g + hh) * S + t) * 128 + 2 * lane); qf[hh * 128 + 2 * lane] = (float)qv[0]; qf[hh * 128 + 2 * lane + 1] = (float)qv[1]; }
        if (lane < 8) starts[lane] = lane * 64;
        wave_lds_fence();
        float acc0[4], acc1[4];
        const int nvalid = (t >= 31) ? (((t - 31) >> 4) + 1 < NC ? ((t - 31) >> 4) + 1 : NC) : 0;
#pragma unroll
        for (int hh = 0; hh < 4; ++hh) {
            float o0, o1;
            wave_attend(KCMP + (size_t)g * 512 * 128, VCMP + (size_t)g * 512 * 128, 8, starts, nvalid - 1, qf + hh * 128, pc + hh * 512, lane, o0, o1);
            const float g0 = gates[(size_t)t * 48 + (4 * g + hh) * 3 + 0];
            acc0[hh] = g0 * o0; acc1[hh] = g0 * o1;
        }
        wave_lds_fence();
        const int cur = t >> 6;
        float myv[2];
#pragma unroll
        for (int c = 0; c < 2; ++c) {
            const int s = lane + 64 * c; float imp = 0.f;
#pragma unroll
            for (int hh = 0; hh < 4; ++hh) {
                const float* p = pc + hh * 512 + 4 * s;
                const float pm1 = (s > 0) ? p[-1] : 0.f;
                imp += 0.5f * pm1 + p[0] + p[1] + p[2] + 0.5f * p[3];
            }
            const bool valid = s <= cur, forced = (s == 0) || (s == cur) || (s == cur - 1);
            myv[c] = valid ? (forced ? BIGF : imp) : NEGF;
            selbuf[s] = myv[c];
        }
        wave_lds_fence();
        int rank0 = 0, rank1 = 0;
        for (int s2 = 0; s2 < 128; ++s2) {
            const float v2 = selbuf[s2];
            rank0 += (v2 > myv[0] || (v2 == myv[0] && s2 < lane)) ? 1 : 0;
            rank1 += (v2 > myv[1] || (v2 == myv[1] && s2 < lane + 64)) ? 1 : 0;
        }
        const bool sel0 = rank0 < 16 && lane <= cur, sel1 = rank1 < 16 && (lane + 64) <= cur;
        const unsigned long long m0 = __ballot(sel0), m1 = __ballot(sel1);
        const int n0 = __popcll(m0), nsel = n0 + __popcll(m1);
        const unsigned long long below = (lane == 0) ? 0ull : (~0ull >> (64 - lane));
        if (sel0) list[__popcll(m0 & below)] = lane;
        if (sel1) list[n0 + __popcll(m1 & below)] = lane + 64;
        wave_lds_fence();
        if (lane < 16) starts[lane] = (lane < nsel) ? list[lane] * 64 : 0;
        wave_lds_fence();
#pragma unroll
        for (int hh = 0; hh < 4; ++hh) {
            float o0, o1;
            wave_attend(KVb + ((size_t)2 * 4 + g) * S * 128, KVb + ((size_t)3 * 4 + g) * S * 128, nsel, starts, t, qf + hh * 128, pbuf, lane, o0, o1);
            const float g1 = gates[(size_t)t * 48 + (4 * g + hh) * 3 + 1];
            acc0[hh] += g1 * o0; acc1[hh] += g1 * o1;
        }
        wave_lds_fence();
        if (lane < 8) starts[lane] = t - 511 + lane * 64;
        wave_lds_fence();
#pragma unroll
        for (int hh = 0; hh < 4; ++hh) {
            float o0, o1;
            wave_attend(KVb + ((size_t)4 * 4 + g) * S * 128, KVb + ((size_t)5 * 4 + g) * S * 128, 8, starts, t, qf + hh * 128, pbuf, lane, o0, o1);
            const float g2 = gates[(size_t)t * 48 + (4 * g + hh) * 3 + 2];
            acc0[hh] += g2 * o0; acc1[hh] += g2 * o1;
        }
#pragma unroll
        for (int hh = 0; hh < 4; ++hh) {
            const int col = (4 * g + hh) * 128 + 2 * lane;
            const h16x2 zz = *(const h16x2*)(Z + (size_t)t * 2048 + col);
            h16x2 ov; ov[0] = (h16)(acc0[hh] * (float)zz[0]); ov[1] = (h16)(acc1[hh] * (float)zz[1]);
            *(h16x2*)(OZ + (size_t)t * 2048 + col) = ov;
        }
    }
}

__device__ __forceinline__ void phase_ret_post(const Frame& F) {
    const h16* P = (const h16*)(F.ws + WS_P);
    h16* RQ = (h16*)(F.ws + WS_QKV); h16* RK = RQ + (size_t)8 * S * 256; h16* RV = RK + (size_t)8 * S * 256; h16* RG = RV + (size_t)8 * S * 512;
    const f32x2* r128 = (const f32x2*)(F.ws + WS_ROPE128);
    for (int it = F.bid; it < 384; it += F.G) {
        const int blk = it / 12, part = it % 12;
        for (int i = 0; i < 32; ++i) {
            const int t = blk * 256 + F.wave * 32 + i;
            float v[16]; load16(P + (size_t)t * 12288 + part * 1024 + F.lane * 16, v);
            if (part <= 3) {
                const int head = (part & 1) * 4 + (F.lane >> 4), dl = (F.lane & 15) * 16, hi = (F.lane >> 3) & 1, j0 = (F.lane & 7) * 16;
                const f32x2* cs = r128 + (size_t)t * 128 + j0;
                const float scale = (part >= 2) ? 0.0625f : 1.0f;
#pragma unroll
                for (int e = 0; e < 16; ++e) {
                    const float o = __shfl_xor(v[e], 8); const f32x2 c = cs[e];
                    v[e] = (hi == 0 ? (v[e] * c[0] - o * c[1]) : (o * c[1] + v[e] * c[0])) * scale;
                }
                store16((part >= 2 ? RK : RQ) + ((size_t)head * S + t) * 256 + dl, v);
            } else if (part <= 7) {
                const int cs0 = (part - 4) * 1024 + F.lane * 16, head = cs0 >> 9, dv = cs0 & 511;
                store16(RV + ((size_t)head * S + t) * 512 + dv, v);
            } else {
                const int cs0 = (part - 8) * 1024 + F.lane * 16;
#pragma unroll
                for (int e = 0; e < 16; ++e) v[e] = silu_f(v[e]);
                store16(RG + (size_t)t * 4096 + cs0, v);
            }
        }
    }
}

__device__ __forceinline__ double gamma_of(int h) { return 1.0 - 1.0 / (double)(32 << h); }
__device__ __forceinline__ double dpow_int(double b, int n) { double p = 1.0; for (int i = 0; i < n; ++i) p *= b; return p; }

__device__ __forceinline__ void phase_ret_scan(const Frame& F) {
    const h16* RQ = (const h16*)(F.ws + WS_QKV); const h16* RK = RQ + (size_t)8 * S * 256; const h16* RV = RK + (size_t)8 * S * 256;
    h16* SB = (h16*)(F.ws + WS_P);
    float* ks = (float*)F.lds;
    h16* vs = (h16*)(F.lds + 32768);
    float* wd = (float*)(F.lds + 49152);
    for (int it = F.bid; it < 256; it += F.G) {
        const int h = it >> 5, dk0 = ((it >> 3) & 3) * 64, dv0 = (it & 7) * 64;
        const double gam = gamma_of(h);
        __syncthreads();
        if (F.tid < 128) wd[F.tid] = (float)dpow_int(gam, 127 - F.tid);
        const float carry = (float)dpow_int(gam, 128);
        const int tk = F.tid >> 3, tv = F.tid & 7;
        float st[8];
#pragma unroll
        for (int e = 0; e < 8; ++e) st[e] = 0.f;
        __syncthreads();
        for (int c = 0; c < 64; ++c) {
            { h16x8 o;
#pragma unroll
              for (int e = 0; e < 8; ++e) o[e] = (h16)st[e];
              *(h16x8*)(SB + (((size_t)h * 64 + c) * 256 + dk0 + tk) * 512 + dv0 + tv * 8) = o; }
            for (int i = F.tid; i < 128 * 8; i += NTHREADS) {
                const int j = i >> 3, c8 = (i & 7) * 8;
                const h16x8 kk = *(const h16x8*)(RK + ((size_t)h * S + c * 128 + j) * 256 + dk0 + c8);
                const h16x8 vv = *(const h16x8*)(RV + ((size_t)h * S + c * 128 + j) * 512 + dv0 + c8);
                const float w = wd[j];
#pragma unroll
                for (int e = 0; e < 8; ++e) ks[j * 64 + c8 + e] = (float)kk[e] * w;
                *(h16x8*)(vs + j * 64 + c8) = vv;
            }
            __syncthreads();
#pragma unroll
            for (int e = 0; e < 8; ++e) st[e] *= carry;
#pragma unroll 4
            for (int j = 0; j < 128; ++j) {
                const float kf = ks[j * 64 + tk]; const h16x8 vv = *(const h16x8*)(vs + j * 64 + tv * 8);
#pragma unroll
                for (int e = 0; e < 8; ++e) st[e] += kf * (float)vv[e];
            }
            __syncthreads();
        }
    }
}

__device__ __forceinline__ void phase_ret_out(const Frame& F) {
    const h16* RQ = (const h16*)(F.ws + WS_QKV); const h16* RK = RQ + (size_t)8 * S * 256; const h16* RV = RK + (size_t)8 * S * 256;
    const h16* SB = (const h16*)(F.ws + WS_P);
    float* OR_ = (float*)(F.ws + WS_OR);
    h16* Qs = (h16*)F.lds;
    float* AsT = (float*)(F.lds + 65536);
    float* rd = (float*)(F.lds + 131072);
    for (int it = F.bid; it < 512; it += F.G) {
        const int h = it >> 6, c = it & 63;
        const double gam = gamma_of(h);
        __syncthreads();
        if (F.tid < 130) rd[F.tid] = (float)dpow_int(gam, F.tid);
        for (int i = F.tid; i < 128 * 32; i += NTHREADS) {
            const int r = i >> 5, c8 = (i & 31) * 8;
            *(h16x8*)(Qs + r * 256 + c8) = *(const h16x8*)(RQ + ((size_t)h * S + c * 128 + r) * 256 + c8);
        }
        __syncthreads();
        {
            const int j = F.tid & 127, ig = F.tid >> 7;
            float acc[32];
#pragma unroll
            for (int ii = 0; ii < 32; ++ii) acc[ii] = 0.f;
            const h16* krow = RK + ((size_t)h * S + c * 128 + j) * 256;
            for (int d8 = 0; d8 < 32; ++d8) {
                const h16x8 kv = *(const h16x8*)(krow + d8 * 8);
                const h16x2 k0 = {kv[0], kv[1]}, k1 = {kv[2], kv[3]}, k2 = {kv[4], kv[5]}, k3 = {kv[6], kv[7]};
#pragma unroll
                for (int ii = 0; ii < 32; ++ii) {
                    const h16x8 qv = *(const h16x8*)(Qs + (ig * 32 + ii) * 256 + d8 * 8);
                    float a = acc[ii];
                    a = __builtin_amdgcn_fdot2((h16x2){qv[0], qv[1]}, k0, a, false); a = __builtin_amdgcn_fdot2((h16x2){qv[2], qv[3]}, k1, a, false);
                    a = __builtin_amdgcn_fdot2((h16x2){qv[4], qv[5]}, k2, a, false); a = __builtin_amdgcn_fdot2((h16x2){qv[6], qv[7]}, k3, a, false);
                    acc[ii] = a;
                }
            }
#pragma unroll
            for (int ii = 0; ii < 32; ++ii) { const int i = ig * 32 + ii; AsT[j * 128 + i] = (i >= j) ? acc[ii] * rd[i - j] : 0.f; }
        }
        __syncthreads();
        for (int i = F.tid; i < 128 * 32; i += NTHREADS) {
            const int r = i >> 5, c8 = (i & 31) * 8; const float w = rd[r + 1];
            h16x8 q = *(h16x8*)(Qs + r * 256 + c8);
#pragma unroll
            for (int e = 0; e < 8; ++e) q[e] = (h16)((float)q[e] * w);
            *(h16x8*)(Qs + r * 256 + c8) = q;
        }
        __syncthreads();
        {
            const int dv = F.tid;
            float acc[128];
#pragma unroll
            for (int i = 0; i < 128; ++i) acc[i] = 0.f;
            const h16* vcol = RV + ((size_t)h * S + c * 128) * 512 + dv;
            for (int j = 0; j < 128; ++j) {
                const float v = (float)vcol[(size_t)j * 512];
#pragma unroll
                for (int i4 = 0; i4 < 32; ++i4) {
                    const f32x4 a = *(const f32x4*)(AsT + j * 128 + i4 * 4);
                    acc[i4 * 4 + 0] += a[0] * v; acc[i4 * 4 + 1] += a[1] * v; acc[i4 * 4 + 2] += a[2] * v; acc[i4 * 4 + 3] += a[3] * v;
                }
            }
            const h16* scol = SB + (((size_t)h * 64 + c) * 256) * 512 + dv;
            for (int d8 = 0; d8 < 32; ++d8) {
                h16x2 s0, s1, s2, s3;
                s0[0] = scol[(size_t)(d8 * 8 + 0) * 512]; s0[1] = scol[(size_t)(d8 * 8 + 1) * 512]; s1[0] = scol[(size_t)(d8 * 8 + 2) * 512]; s1[1] = scol[(size_t)(d8 * 8 + 3) * 512];
                s2[0] = scol[(size_t)(d8 * 8 + 4) * 512]; s2[1] = scol[(size_t)(d8 * 8 + 5) * 512]; s3[0] = scol[(size_t)(d8 * 8 + 6) * 512]; s3[1] = scol[(size_t)(d8 * 8 + 7) * 512];
#pragma unroll
                for (int i = 0; i < 128; ++i) {
                    const h16x8 qv = *(const h16x8*)(Qs + i * 256 + d8 * 8);
                    float a = acc[i];
                    a = __builtin_amdgcn_fdot2((h16x2){qv[0], qv[1]}, s0, a, false); a = __builtin_amdgcn_fdot2((h16x2){qv[2], qv[3]}, s1, a, false);
                    a = __builtin_amdgcn_fdot2((h16x2){qv[4], qv[5]}, s2, a, false); a = __builtin_amdgcn_fdot2((h16x2){qv[6], qv[7]}, s3, a, false);
                    acc[i] = a;
                }
            }
#pragma unroll
            for (int i = 0; i < 128; ++i) OR_[(size_t)(c * 128 + i) * 4096 + h * 512 + dv] = acc[i];
        }
    }
    __syncthreads();
}

__device__ __forceinline__ void phase_ret_gn(const Frame& F) {
    const float* OR_ = (const float*)(F.ws + WS_OR);
    const h16* RG = (const h16*)(F.ws + WS_QKV) + (size_t)8 * S * 256 * 2 + (size_t)8 * S * 512;
    h16* OZ = (h16*)(F.ws + WS_OZ);
    for (int task = F.bid * 8 + F.wave; task < S * 8; task += F.G * 8) {
        const int t = task >> 3, h = task & 7;
        const size_t off = (size_t)t * 4096 + h * 512 + F.lane * 8;
        const f32x4 a = *(const f32x4*)(OR_ + off), b = *(const f32x4*)(OR_ + off + 4);
        float s = a[0] + a[1] + a[2] + a[3] + b[0] + b[1] + b[2] + b[3];
        s = wave_sum(s); const float mu = s * (1.0f / 512.0f);
        float q = 0.f;
#pragma unroll
        for (int e = 0; e < 4; ++e) { const float d0 = a[e] - mu, d1 = b[e] - mu; q += d0 * d0 + d1 * d1; }
        q = wave_sum(q); const float r = 1.0f / sqrtf(q * (1.0f / 512.0f) + EPS);
        const h16x8 gv = *(const h16x8*)(RG + off);
        h16x8 o;
#pragma unroll
        for (int e = 0; e < 4; ++e) { o[e] = (h16)((float)gv[e] * ((a[e] - mu) * r)); o[4 + e] = (h16)((float)gv[4 + e] * ((b[e] - mu) * r)); }
        *(h16x8*)(OZ + off) = o;
    }
}

__device__ __forceinline__ void phase_gemm(const Frame& F, const h16* A, const h16* Bt, int N, int K, void* O, int ldc, int f32out) {
    pg8::Gemm g{A, Bt, S, N, K}; pg8::StaticOrder So; So.init(S, N, F.G, F.bid);
    pg8::EpiStore E{O, ldc, f32out};
    pg8::gemm_phase<pg8::EpiStore, pg8::StaticOrder, true, true>((LAS unsigned char*)F.lds, g, So, E);
}

constexpr int NPHASE = 2 + 8 * DEPTH;
__host__ __device__ inline bool phase_exists(int p) {
    if (p < 2) return true;
    const int L = (p - 2) / 8, s = (p - 2) % 8, kind = L % 3;
    if (s == 7) return false;
    if (s == 2) return kind != 0;
    if (s == 4) return kind == 2;
    return true;
}

__global__ void __launch_bounds__(NTHREADS, 2) trunk_fwd(Args args) {
    extern __shared__ __attribute__((aligned(16))) unsigned char lds_raw[];
    Frame F;
    F.out = args.out; F.ws = args.ws; F.lds = (char*)lds_raw;
    F.tid = threadIdx.x; F.lane = F.tid & 63; F.wave = __builtin_amdgcn_readfirstlane(F.tid >> 6); F.G = gridDim.x; F.bid = blockIdx.x;
    volatile LAS unsigned* misc = (volatile LAS unsigned*)((LAS unsigned char*)lds_raw + MISC_OFF);
    if (F.tid < 16) misc[F.tid] = 0u;
    __syncthreads();
    XcdBarrier bar; bar.bar = (unsigned*)(F.ws + WS_CTL) + CW_BAR; bar.x = 0; bar.st = misc;
#if ONE_LAUNCH
    bar = xcd_barrier_post((unsigned*)(F.ws + WS_CTL) + CW_BAR, misc);
    cg::grid_group grid = cg::this_grid();
#endif
    const int lo = args.ph_lo, hi = args.ph_hi;
#if ONE_LAUNCH
    grid.sync();
#define SEAM(p) do { if ((p) > lo) xcd_barrier(bar); } while (0)
#else
#define SEAM(p) do { } while (0)
#endif
#define IN(p) (lo <= (p) && (p) < hi)
#ifndef PHMASK
#define PHMASK 0xFFFF
#endif
#define EN(b) ((PHMASK >> (b)) & 1)
    if (EN(0) && IN(0)) { SEAM(0); phase_prologue(F, args); }
    if (EN(1) && IN(1)) { SEAM(1); phase_norm(F, args, -1, 0); }
#define LAYER(L) do { \
        constexpr int kind = (L) % 3, base = 2 + 8 * (L); \
        constexpr int Nin = kind == 0 ? 8192 : (kind == 1 ? NSA_NP : 12288); \
        constexpr int Kout = kind == 2 ? 4096 : 2048; \
        if (EN(2) && IN(base + 0)) { SEAM(base + 0); phase_gemm(F, (const h16*)(F.ws + WS_H), (const h16*)(F.ws + WS_WTIN), Nin, 2048, F.ws + WS_P, Nin, 0); } \
        if (IN(base + 1)) { SEAM(base + 1); if (EN(3) && kind == 0) phase_moba_post(F); else if (EN(4) && kind == 1) phase_nsa_post(F); else if (EN(5) && kind == 2) phase_ret_post(F); } \
        if (kind != 0 && IN(base + 2)) { SEAM(base + 2); if (EN(6) && kind == 1) phase_nsa_cmp(F, args); else if (EN(7) && kind == 2) phase_ret_scan(F); } \
        if (IN(base + 3)) { SEAM(base + 3); if (EN(8) && kind == 0) phase_moba_attn(F); else if (EN(9) && kind == 1) phase_nsa_attn(F); else if (EN(10) && kind == 2) phase_ret_out(F); } \
        if (EN(11) && kind == 2 && IN(base + 4)) { SEAM(base + 4); phase_ret_gn(F); } \
        if (EN(2) && IN(base + 5)) { SEAM(base + 5); phase_gemm(F, (const h16*)(F.ws + WS_OZ), (const h16*)(F.ws + WS_WTOUT), 2048, Kout, F.ws + WS_Y, 2048, 1); } \
        if (EN(1) && IN(base + 6)) { SEAM(base + 6); phase_norm(F, args, (L), (L) + 1 < DEPTH ? (L) + 1 : -1); } \
    } while (0)
    LAYER(0); LAYER(1); LAYER(2); LAYER(3);
#undef LAYER
#undef EN
#undef IN
#undef SEAM
}

extern "C" void kernel_launch(void* const* d_in, const int* in_sizes, int n_in, void* d_out, int out_size, void* d_ws, size_t ws_size, hipStream_t stream) {
    static int grid = 0;
    if (grid == 0) {
        if (n_in != 18 || out_size != S * D || ws_size < WS_END) { fprintf(stderr, "kernel_launch: unexpected shapes (n_in %d, out %d, ws %zu)\n", n_in, out_size, ws_size); grid = -1; return; }
        int dev = 0, cus = 0, per_cu = 0;
        if (hipGetDevice(&dev) != hipSuccess || hipDeviceGetAttribute(&cus, hipDeviceAttributeMultiprocessorCount, dev) != hipSuccess) { grid = -1; return; }
        if (hipFuncSetAttribute((const void*)trunk_fwd, hipFuncAttributeMaxDynamicSharedMemorySize, LDS_BYTES) != hipSuccess) { fprintf(stderr, "kernel_launch: hipFuncSetAttribute failed\n"); grid = -1; return; }
        if (hipOccupancyMaxActiveBlocksPerMultiprocessor(&per_cu, (const void*)trunk_fwd, NTHREADS, LDS_BYTES) != hipSuccess || per_cu < 1) { fprintf(stderr, "kernel_launch: occupancy query says %d\n", per_cu); per_cu = 1; }
        (void)hipGetLastError();
        grid = cus;
    }
    if (grid < 0) return;
    (void)hipMemsetAsync((char*)d_ws + WS_CTL, 0, CTL_ZERO_BYTES, stream);
    Args a{};
    for (int i = 0; i < 18; ++i) a.in[i] = (const float*)d_in[i];
    a.out = (float*)d_out; a.ws = (unsigned char*)d_ws;
    for (int j = 0; j < 16; ++j) a.inv16[j] = pow(500000.0, -(double)j / 16.0);
    for (int j = 0; j < 128; ++j) a.inv128[j] = pow(10000.0, -(double)j / 128.0);
#if ONE_LAUNCH
    a.ph_lo = 0; a.ph_hi = NPHASE;
    void* kargs[] = {&a};
    hipError_t e = hipLaunchCooperativeKernel((const void*)trunk_fwd, dim3(grid), dim3(NTHREADS), kargs, LDS_BYTES, stream);
    if (e != hipSuccess) fprintf(stderr, "kernel_launch: cooperative launch failed: %s (grid %d)\n", hipGetErrorString(e), grid);
#else
    for (int p = 0; p < NPHASE; ++p) {
        if (!phase_exists(p)) continue;
        a.ph_lo = p; a.ph_hi = p + 1;
        hipLaunchKernelGGL(trunk_fwd, dim3(grid), dim3(NTHREADS), LDS_BYTES, stream, a);
    }
#endif
}
```

```cpp
#include <hip/hip_runtime.h>
#include <hip/hip_cooperative_groups.h>
#include <cstdio>
#include <cstdint>
#include <cmath>
namespace cg = cooperative_groups;

#ifndef ONE_LAUNCH
#define ONE_LAUNCH 1
#endif
#ifndef MOBA_MFMA
#define MOBA_MFMA 1
#endif
#ifndef NSA_MFMA
#define NSA_MFMA 1
#endif

#define LAS __attribute__((address_space(3)))
typedef _Float16 h16;
typedef _Float16 h16x2 __attribute__((ext_vector_type(2)));
typedef _Float16 h16x4 __attribute__((ext_vector_type(4)));
typedef _Float16 h16x8 __attribute__((ext_vector_type(8)));
typedef float f32x2 __attribute__((ext_vector_type(2)));
typedef float f32x4 __attribute__((ext_vector_type(4)));
typedef unsigned u32x4 __attribute__((ext_vector_type(4)));

constexpr int S = 8192, D = 2048, DEPTH = 4;
constexpr float EPS = 1e-6f;
constexpr float NEGF = -1e30f, BIGF = 1e30f;
constexpr int NSA_NP = 7424;
constexpr int NC = 511;

constexpr size_t MiB = 1u << 20;
constexpr size_t WS_CTL = 0, CTL_ZERO_BYTES = 1 * MiB;
constexpr size_t WS_MODP = 1 * MiB;
constexpr size_t WS_KMEAN = 1 * MiB + 768 * 1024;
constexpr size_t WS_GATES = 3 * MiB;
constexpr size_t WS_KCMP = 5 * MiB;
constexpr size_t WS_VCMP = 5 * MiB + 512 * 1024;
constexpr size_t WS_ROPE16 = 6 * MiB;
constexpr size_t WS_ROPE128 = 7 * MiB;
constexpr size_t WS_WTIN = 16 * MiB;
constexpr size_t WS_WTOUT = 64 * MiB;
constexpr size_t WS_H = 80 * MiB;
constexpr size_t WS_P = 112 * MiB;
constexpr size_t WS_QKV = 304 * MiB;
constexpr size_t WS_OZ = 496 * MiB;
constexpr size_t WS_Y = 560 * MiB;
constexpr size_t WS_OR = 624 * MiB;
constexpr size_t WS_END = 752 * MiB;

constexpr int LDS_BYTES = 147456;
constexpr int MISC_OFF = 135168;
constexpr int NTHREADS = 512;

struct Args {
    const float* in[18];
    float* out;
    unsigned char* ws;
    double inv16[16];
    double inv128[128];
    int ph_lo, ph_hi;
};

#define XB_TMO      128
#define XB_XCNT(j)  (256  + 64 * (j))
#define XB_XSUB(j)  (1280 + 64 * (j))
#define XB_XGEN(j)  (2304 + 64 * (j))
#define XB_TOP      3328
#define XB_TOPGEN   3392
#define XCD_BAR_WORDS 3456
#define XB_SPIN_CAP (1u << 24)
constexpr int CW_BAR = 4096;

__device__ __forceinline__ unsigned xb_ld(unsigned* p)              { return __hip_atomic_load(p, __ATOMIC_RELAXED, __HIP_MEMORY_SCOPE_AGENT); }
__device__ __forceinline__ unsigned xb_add(unsigned* p, unsigned v) { return __hip_atomic_fetch_add(p, v, __ATOMIC_RELAXED, __HIP_MEMORY_SCOPE_AGENT); }
__device__ __forceinline__ unsigned xb_xcc_id() { return (unsigned)__builtin_amdgcn_s_getreg((3 << 11) | 20) & 0xFu; }
#define XB_SPIN(cond, bar) do { unsigned _sp = 0; while (cond) { __builtin_amdgcn_s_sleep(1); \
    if ((++_sp & 255u) == 0u) { if (xb_ld(&(bar)[XB_TMO])) break; if (_sp > XB_SPIN_CAP) { atomicAdd(&(bar)[XB_TMO], 1u); break; } } } } while (0)

struct XcdBarrier { unsigned* bar; unsigned x; volatile LAS unsigned* st; };

__device__ __forceinline__ XcdBarrier xcd_barrier_post(unsigned* bar, volatile LAS unsigned* st) {
    XcdBarrier b; b.bar = bar; b.x = xb_xcc_id(); b.st = st;
    if (threadIdx.x == 0) (void)xb_add(&bar[XB_XCNT(b.x)], 1u);
    return b;
}
__device__ __forceinline__ void xcd_barrier_complete(unsigned* bar, unsigned x, unsigned& nloc, unsigned& nx) {
    const unsigned G = gridDim.x * gridDim.y * gridDim.z;
    unsigned sum, cnt, mine, sp = 0u;
    for (;;) {
        sum = 0u; cnt = 0u; mine = 0u;
#pragma unroll
        for (unsigned j = 0; j < 16; ++j) { const unsigned c = xb_ld(&bar[XB_XCNT(j)]); sum += c; cnt += (c > 0u) ? 1u : 0u; mine = (j == x) ? c : mine; }
        if (sum == G) break;
        __builtin_amdgcn_s_sleep(1);
        if ((++sp & 255u) == 0u) { if (xb_ld(&bar[XB_TMO])) break; if (sp > XB_SPIN_CAP) { atomicAdd(&bar[XB_TMO], 1u); break; } }
    }
    nloc = mine > 0u ? mine : 1u; nx = cnt > 0u ? cnt : 1u;
}
__device__ __forceinline__ void xcd_barrier(const XcdBarrier& b) {
    asm volatile("s_waitcnt vmcnt(0)" ::: "memory");
    __syncthreads();
    if (threadIdx.x == 0) {
        unsigned* bar = b.bar;
        __builtin_amdgcn_s_waitcnt(0);
        unsigned nloc = b.st[0], nx = b.st[1];
        if (nloc == 0u) { xcd_barrier_complete(bar, b.x, nloc, nx); b.st[0] = nloc; b.st[1] = nx; }
        const unsigned old = xb_add(&bar[XB_XSUB(b.x)], 1u);
        const unsigned gen = old / nloc;
        if (old + 1u == (gen + 1u) * nloc) {
            __builtin_amdgcn_fence(__ATOMIC_RELEASE, "agent");
            asm volatile("s_waitcnt vmcnt(0)" ::: "memory");
            const unsigned og = xb_add(&bar[XB_TOP], 1u);
            const unsigned tg = og / nx;
            if (og + 1u == (tg + 1u) * nx) xb_add(&bar[XB_TOPGEN], 1u);
            else XB_SPIN(xb_ld(&bar[XB_TOPGEN]) == tg, bar);
            __builtin_amdgcn_fence(__ATOMIC_ACQUIRE, "agent");
            xb_add(&bar[XB_XGEN(b.x)], 1u);
            asm volatile("s_waitcnt vmcnt(0)" ::: "memory");
        } else {
            XB_SPIN(xb_ld(&bar[XB_XGEN(b.x)]) == gen, bar);
            __builtin_amdgcn_fence(__ATOMIC_ACQUIRE, "agent");
            asm volatile("s_waitcnt vmcnt(0)" ::: "memory");
        }
    }
    __syncthreads();
}

namespace pg8 {
constexpr int BM = 256, BK = 64, HALF = 128, HTB = HALF * BK * 2, STAGE_BYTES = 8 * HTB, NXCD = 8, WGM = 8;
__host__ __device__ __forceinline__ int lds_byte(int r, int c) { const int st = (r >> 4) * 2 + (c >> 5), rr = r & 15, cc = c & 31, ob = rr * 64 + cc * 2; return st * 1024 + (ob ^ (((ob >> 9) & 1) << 5)); }
__host__ __device__ __forceinline__ void stage_rc(int b, int& R, int& C) { const int st = b / 1024, sb = b % 1024, swz = sb ^ (((sb >> 9) & 1) << 5); R = (st >> 1) * 16 + swz / 64; C = (st & 1) * 32 + (swz % 64) / 2; }
__host__ __device__ __forceinline__ int perm32(int rho) { const int n = rho >> 4, i = rho & 15; return 8 * (i >> 2) + 4 * n + (i & 3); }

struct Unit { int pm, pn; };
struct Gemm { const h16* A; const h16* Bt; int M, N, K; };

struct StaticOrder {
    int nM, nN, nwg, G, c;
    __host__ __device__ void init(int M, int N, int G_, int c_) { nM = M / BM; nN = N / BM; nwg = nM * nN; G = G_; c = c_; }
    __host__ __device__ bool next(int i, Unit& u) const {
        const long L = (long)i * G + c; if (L >= nwg) return false;
        int wgid = (int)L; { const int q = nwg / NXCD, r = nwg % NXCD, xcd = wgid % NXCD, off = wgid / NXCD; wgid = (xcd < r ? xcd * (q + 1) : r * (q + 1) + (xcd - r) * q) + off; }
        const int nig = WGM * nN, gid = wgid / nig, fm = gid * WGM, gsz = (nM - fm) < WGM ? (nM - fm) : WGM;
        u.pm = fm + ((wgid % nig) % gsz); u.pn = (wgid % nig) / gsz; return true;
    }
    __device__ __forceinline__ void a_ready(const Unit&) const {}
    __device__ __forceinline__ void done(const Unit&) const {}
};

struct EpiStore {
    static constexpr bool PERM = true, AFTER_DRAIN = false;
    void* O; int ldc; int f32out;
    __device__ __forceinline__ void operator()(const f32x4 (&acc)[2][2][4][2], const Unit& u, int wr, int wc, int fr, int fq) const {
        const int row0 = u.pm * BM + wr * 64 + fr, col0 = u.pn * BM + wc * 32 + 8 * fq;
#pragma unroll
        for (int ai = 0; ai < 2; ++ai)
#pragma unroll
            for (int m = 0; m < 4; ++m) {
                const size_t roff = (size_t)(row0 + ai * HALF + m * 16) * ldc + col0;
#pragma unroll
                for (int bj = 0; bj < 2; ++bj) {
                    const f32x4 v0 = acc[ai][bj][m][0], v1 = acc[ai][bj][m][1];
                    if (f32out) {
                        float* p = (float*)O + roff + bj * HALF;
                        *(f32x4*)p = v0; *(f32x4*)(p + 4) = v1;
                    } else {
                        h16x8 w; w[0] = (h16)v0[0]; w[1] = (h16)v0[1]; w[2] = (h16)v0[2]; w[3] = (h16)v0[3]; w[4] = (h16)v1[0]; w[5] = (h16)v1[1]; w[6] = (h16)v1[2]; w[7] = (h16)v1[3];
                        *(h16x8*)((h16*)O + roff + bj * HALF) = w;
                    }
                }
            }
    }
};

template <class Epi, class Sched, bool ALIGN_EPI = false, bool SP2 = false>
__device__ __forceinline__ void gemm_phase(LAS unsigned char* lds, const Gemm g, const Sched& S, const Epi& E) {
    const int tid = threadIdx.x, wid = __builtin_amdgcn_readfirstlane(tid >> 6), lane = tid & 63, wr = wid >> 2, wc = wid & 3, fr = lane & 15, fq = lane >> 4;
    const int K = g.K, nt = K / BK;
    unsigned voffA[2], voffB[2];
#pragma unroll
    for (int i = 0; i < 2; ++i) { int R, C; stage_rc(tid * 16 + i * 8192, R, C); const int Rb = Epi::PERM ? ((R & ~31) + perm32(R & 31)) : R;
        voffA[i] = (unsigned)(R * K + C) * 2u; voffB[i] = (unsigned)(Rb * K + C) * 2u; }
    const size_t kstep = (size_t)(BK * 2);
    const size_t hstep = (size_t)HALF * K * 2;
    const size_t tstep = 2 * hstep;
    const unsigned ldsw = (unsigned)wid * 1024u;
    const int aoff = lds_byte(wr * 64 + fr, fq * 8), boff = lds_byte(wc * 32 + fr, fq * 8);
#define PG8_SA(b, h) (((b) * 2 + (h)) * HTB)
#define PG8_SB(b, h) ((4 + (b) * 2 + (h)) * HTB)
#define PG8_STAGE(bufoff, gbase, voff) do { _Pragma("unroll") for (int _i = 0; _i < 2; ++_i) \
        __builtin_amdgcn_global_load_lds((const unsigned*)((const char*)(gbase) + (voff)[_i]), (LAS unsigned*)(lds + (bufoff) + ldsw + _i * 8192), 16, 0, 0); } while (0)
#define PG8_LDA(dst, b, h) do { _Pragma("unroll") for (int m = 0; m < 4; ++m) _Pragma("unroll") for (int k = 0; k < 2; ++k) dst[m][k] = *(const LAS h16x8*)(lds + PG8_SA(b, h) + aoff + m * 2048 + k * 1024); } while (0)
#define PG8_LDB(dst, b, h) do { _Pragma("unroll") for (int n = 0; n < 2; ++n) _Pragma("unroll") for (int k = 0; k < 2; ++k) dst[n][k] = *(const LAS h16x8*)(lds + PG8_SB(b, h) + boff + n * 2048 + k * 1024); } while (0)
#define PG8_MMA(ai, bj, At, Bt) do { __builtin_amdgcn_s_setprio(1); _Pragma("unroll") for (int m = 0; m < 4; ++m) _Pragma("unroll") for (int n = 0; n < 2; ++n) _Pragma("unroll") for (int k = 0; k < 2; ++k) \
        acc[ai][bj][m][n] = __builtin_amdgcn_mfma_f32_16x16x32_f16(Bt[n][k], At[m][k], acc[ai][bj][m][n], 0, 0, 0); __builtin_amdgcn_s_setprio(0); } while (0)
#define PG8_WAIT_V(n) asm volatile("s_waitcnt vmcnt(" #n ")" ::: "memory")
#define PG8_WAIT_L(n) asm volatile("s_waitcnt lgkmcnt(" #n ")" ::: "memory")
#define PG8_BAR __builtin_amdgcn_s_barrier()
#define PG8_SCHED __builtin_amdgcn_sched_barrier(0)
    Unit cur, nxt; int ui = 0;
    if (!S.next(0, cur)) return;
    f32x4 acc[2][2][4][2];
#pragma unroll
    for (int a = 0; a < 2; ++a)
#pragma unroll
        for (int b = 0; b < 2; ++b)
#pragma unroll
            for (int m = 0; m < 4; ++m)
#pragma unroll
                for (int n = 0; n < 2; ++n) acc[a][b][m][n] = (f32x4){0.f, 0.f, 0.f, 0.f};
    h16x8 At[4][2], B0[2][2], B1[2][2];
    const char* cA = (const char*)g.A + (size_t)cur.pm * tstep; const char* cB = (const char*)g.Bt + (size_t)cur.pn * tstep;
    S.a_ready(cur);
    if constexpr (SP2) {
        PG8_STAGE(PG8_SB(0, 0), cB, voffB); PG8_STAGE(PG8_SB(0, 1), cB + hstep, voffB); PG8_STAGE(PG8_SA(0, 0), cA, voffA); PG8_STAGE(PG8_SA(0, 1), cA + hstep, voffA);
        if (wr == 1) PG8_BAR;
        PG8_WAIT_V(2); PG8_BAR;
        PG8_STAGE(PG8_SB(1, 0), cB + kstep, voffB); PG8_STAGE(PG8_SA(1, 0), cA + kstep, voffA); PG8_STAGE(PG8_SB(1, 1), cB + hstep + kstep, voffB);
        PG8_WAIT_V(6); PG8_BAR;
    } else {
        PG8_STAGE(PG8_SB(0, 0), cB, voffB); PG8_STAGE(PG8_SA(0, 0), cA, voffA); PG8_STAGE(PG8_SB(0, 1), cB + hstep, voffB); PG8_STAGE(PG8_SA(0, 1), cA + hstep, voffA);
        if (wr == 1) PG8_BAR;
        PG8_WAIT_V(4); PG8_BAR;
        PG8_STAGE(PG8_SB(1, 0), cB + kstep, voffB); PG8_STAGE(PG8_SA(1, 0), cA + kstep, voffA); PG8_STAGE(PG8_SB(1, 1), cB + hstep + kstep, voffB);
        PG8_WAIT_V(6); PG8_BAR;
    }
    for (;;) {
        const bool has_next = S.next(ui + 1, nxt);
        const char* nA = has_next ? (const char*)g.A + (size_t)nxt.pm * tstep : cA; const char* nB = has_next ? (const char*)g.Bt + (size_t)nxt.pn * tstep : cB;
        for (int t = 0; t < nt; t += 2) {
            const bool last = (t == nt - 2);
            const char* a1 = cA + (size_t)(t + 1) * kstep;
            const char* a2 = last ? nA : cA + (size_t)(t + 2) * kstep; const char* b2 = last ? nB : cB + (size_t)(t + 2) * kstep;
            const char* a3 = a2 + kstep; const char* b3 = b2 + kstep;
            if (last && has_next) S.a_ready(nxt);
            if constexpr (SP2) {
            PG8_LDB(B0, 0, 0); PG8_LDB(B1, 0, 1); PG8_SCHED; PG8_LDA(At, 0, 0); PG8_STAGE(PG8_SA(1, 1), a1 + hstep, voffA);
            PG8_WAIT_V(8); PG8_WAIT_L(0); PG8_BAR; PG8_MMA(0, 0, At, B0); PG8_MMA(0, 1, At, B1); PG8_BAR; PG8_SCHED;
            PG8_LDA(At, 0, 1); PG8_STAGE(PG8_SB(0, 0), b2, voffB); PG8_STAGE(PG8_SB(0, 1), b2 + hstep, voffB); PG8_STAGE(PG8_SA(0, 0), a2, voffA);
            PG8_WAIT_V(8); PG8_WAIT_L(0); PG8_BAR; PG8_MMA(1, 0, At, B0); PG8_MMA(1, 1, At, B1); PG8_BAR; PG8_SCHED;
            PG8_LDB(B0, 1, 0); PG8_LDB(B1, 1, 1); PG8_SCHED; PG8_LDA(At, 1, 0); PG8_STAGE(PG8_SA(0, 1), a2 + hstep, voffA);
            PG8_WAIT_V(8); PG8_WAIT_L(0); PG8_BAR; PG8_MMA(0, 0, At, B0); PG8_MMA(0, 1, At, B1); PG8_BAR; PG8_SCHED;
            PG8_LDA(At, 1, 1); PG8_STAGE(PG8_SB(1, 0), b3, voffB); PG8_STAGE(PG8_SB(1, 1), b3 + hstep, voffB); PG8_STAGE(PG8_SA(1, 0), a3, voffA);
            PG8_WAIT_V(8); PG8_WAIT_L(0); PG8_BAR; PG8_MMA(1, 0, At, B0); PG8_MMA(1, 1, At, B1); PG8_BAR; PG8_SCHED;
            } else {
            PG8_LDB(B0, 0, 0); PG8_SCHED; PG8_LDA(At, 0, 0); PG8_STAGE(PG8_SA(1, 1), a1 + hstep, voffA);
            PG8_WAIT_L(8); PG8_BAR; PG8_WAIT_L(0); PG8_MMA(0, 0, At, B0); PG8_BAR; PG8_SCHED;
            PG8_LDB(B1, 0, 1); PG8_STAGE(PG8_SB(0, 0), b2, voffB);
            PG8_BAR; PG8_WAIT_L(0); PG8_MMA(0, 1, At, B1); PG8_BAR;
            PG8_LDA(At, 0, 1); PG8_STAGE(PG8_SA(0, 0), a2, voffA);
            PG8_BAR; PG8_WAIT_L(0); PG8_MMA(1, 0, At, B0); PG8_BAR; PG8_SCHED;
            PG8_STAGE(PG8_SB(0, 1), b2 + hstep, voffB);
            PG8_WAIT_V(6); PG8_BAR; PG8_MMA(1, 1, At, B1); PG8_BAR;
            PG8_LDB(B0, 1, 0); PG8_SCHED; PG8_LDA(At, 1, 0); PG8_STAGE(PG8_SA(0, 1), a2 + hstep, voffA);
            PG8_WAIT_L(8); PG8_BAR; PG8_WAIT_L(0); PG8_MMA(0, 0, At, B0); PG8_BAR; PG8_SCHED;
            PG8_LDB(B1, 1, 1); PG8_STAGE(PG8_SB(1, 0), b3, voffB);
            PG8_BAR; PG8_WAIT_L(0); PG8_MMA(0, 1, At, B1); PG8_BAR;
            PG8_LDA(At, 1, 1); PG8_STAGE(PG8_SA(1, 0), a3, voffA);
            PG8_BAR; PG8_WAIT_L(0); PG8_MMA(1, 0, At, B0); PG8_BAR; PG8_SCHED;
            PG8_STAGE(PG8_SB(1, 1), b3 + hstep, voffB);
            PG8_WAIT_V(6); PG8_BAR; PG8_MMA(1, 1, At, B1); PG8_BAR;
            }
        }
        if constexpr (ALIGN_EPI) { if (wr == 0) PG8_BAR; }
        if constexpr (!Epi::AFTER_DRAIN) { E(acc, cur, wr, wc, fr, fq); S.done(cur); }
        if (!has_next) break;
#pragma unroll
        for (int a = 0; a < 2; ++a)
#pragma unroll
            for (int b = 0; b < 2; ++b)
#pragma unroll
                for (int m = 0; m < 4; ++m)
#pragma unroll
                    for (int n = 0; n < 2; ++n) acc[a][b][m][n] = (f32x4){0.f, 0.f, 0.f, 0.f};
        cur = nxt; cA = nA; cB = nB; ++ui;
        if constexpr (ALIGN_EPI) { if (wr == 1) PG8_BAR; }
    }
    PG8_WAIT_V(0);
    if constexpr (!ALIGN_EPI) { if (wr == 0) PG8_BAR; }
    PG8_BAR;
#undef PG8_SA
#undef PG8_SB
#undef PG8_STAGE
#undef PG8_LDA
#undef PG8_LDB
#undef PG8_MMA
#undef PG8_WAIT_V
#undef PG8_WAIT_L
#undef PG8_BAR
#undef PG8_SCHED
}
}

struct Frame {
    float* out;
    unsigned char* ws;
    char* lds;
    int tid, lane, wave, G, bid;
};

__device__ __forceinline__ float silu_f(float x) { return x / (1.f + __expf(-x)); }
__device__ __forceinline__ float sigmoid_f(float x) { return 1.f / (1.f + __expf(-x)); }
__device__ __forceinline__ float wave_sum(float v) {
#pragma unroll
    for (int o = 32; o >= 1; o >>= 1) v += __shfl_xor(v, o);
    return v;
}
__device__ __forceinline__ float wave_max(float v) {
#pragma unroll
    for (int o = 32; o >= 1; o >>= 1) v = fmaxf(v, __shfl_xor(v, o));
    return v;
}
__device__ __forceinline__ void wave_lds_fence() { __builtin_amdgcn_wave_barrier(); asm volatile("s_waitcnt lgkmcnt(0)" ::: "memory"); __builtin_amdgcn_wave_barrier(); }

__device__ __forceinline__ void sincos_d(double x, float& c, float& s) {
    const double TWO_OVER_PI = 0.63661977236758134308;
    const double PIO2_HI = 1.57079632679489655800e+00, PIO2_LO = 6.12323399573676603587e-17;
    const double q = __builtin_rint(x * TWO_OVER_PI);
    double y = __builtin_fma(-q, PIO2_HI, x); y = __builtin_fma(-q, PIO2_LO, y);
    const double y2 = y * y;
    double sp = 1.0 / 6227020800.0;
    sp = sp * y2 - 1.0 / 39916800.0; sp = sp * y2 + 1.0 / 362880.0; sp = sp * y2 - 1.0 / 5040.0; sp = sp * y2 + 1.0 / 120.0; sp = sp * y2 - 1.0 / 6.0; sp = sp * y2 * y + y;
    double cp = -1.0 / 87178291200.0;
    cp = cp * y2 + 1.0 / 479001600.0; cp = cp * y2 - 1.0 / 3628800.0; cp = cp * y2 + 1.0 / 40320.0; cp = cp * y2 - 1.0 / 720.0; cp = cp * y2 + 1.0 / 24.0; cp = cp * y2 - 0.5; cp = cp * y2 + 1.0;
    const long long qi = (long long)q; const int quad = (int)(qi & 3);
    double sv, cv;
    if (quad == 0) { sv = sp; cv = cp; } else if (quad == 1) { sv = cp; cv = -sp; } else if (quad == 2) { sv = -sp; cv = -cp; } else { sv = -cp; cv = sp; }
    c = (float)cv; s = (float)sv;
}

__device__ __forceinline__ int nsa_src_col(int n) { return n < 5120 ? n : (n < 7168 ? n + 48 : (n < 7216 ? n - 2048 : -1)); }
__device__ __forceinline__ void conv_transpose(const Frame& F, const float* W, int K, int Nsrc, h16* Wt, int Npad, int mapmode, int item0, int& items_done) {
    float* tile = (float*)F.lds;
    const int tk_n = K / 64, tn_n = Npad / 64, ntiles = tk_n * tn_n;
    for (int it = F.bid; it < ntiles; it += F.G) {
        const int tk = it / tn_n, tn = it % tn_n;
        __syncthreads();
#pragma unroll
        for (int i = 0; i < 8; ++i) {
            const int idx = F.tid + i * NTHREADS, k = idx >> 6, n = idx & 63;
            const int nn = tn * 64 + n; const int src = mapmode ? nsa_src_col(nn) : nn;
            float v = 0.f; if (src >= 0 && src < Nsrc) v = W[(size_t)(tk * 64 + k) * Nsrc + src];
            tile[k * 65 + n] = v;
        }
        __syncthreads();
#pragma unroll
        for (int i = 0; i < 8; ++i) {
            const int idx = F.tid + i * NTHREADS, n = idx >> 6, k = idx & 63;
            Wt[(size_t)(tn * 64 + n) * K + tk * 64 + k] = (h16)tile[k * 65 + n];
        }
    }
    __syncthreads();
}
__device__ __forceinline__ void conv_layer_weights(const Frame& F, const Args& A, int L) {
    const int kind = L % 3, j = L / 3; int dummy = 0;
    h16* wtin = (h16*)(F.ws + WS_WTIN); h16* wtout = (h16*)(F.ws + WS_WTOUT);
    if (kind == 0) {
        conv_transpose(F, A.in[7] + (size_t)j * 2048 * 8192, 2048, 8192, wtin, 8192, 0, 0, dummy);
        conv_transpose(F, A.in[8] + (size_t)j * 2048 * 2048, 2048, 2048, wtout, 2048, 0, 0, dummy);
    } else if (kind == 1) {
        conv_transpose(F, A.in[9], 2048, 7216, wtin, NSA_NP, 1, 0, dummy);
        conv_transpose(F, A.in[10], 2048, 2048, wtout, 2048, 0, 0, dummy);
    } else {
        conv_transpose(F, A.in[16], 2048, 12288, wtin, 12288, 0, 0, dummy);
        conv_transpose(F, A.in[17], 4096, 2048, wtout, 2048, 0, 0, dummy);
    }
}

__device__ __forceinline__ void phase_prologue(const Frame& F, const Args& A) {
    {
        float* modp = (float*)(F.ws + WS_MODP);
        const float* c = A.in[1]; const float* aw = A.in[3];
        for (int it = F.bid; it < 384; it += F.G) {
            const int layer = it / 96, r = it % 96, slice = r / 12, nch = r % 12, n = nch * 512 + F.tid;
            const float* w = aw + (size_t)layer * 2048 * 6144 + (size_t)(slice * 256) * 6144 + n;
            float acc = 0.f;
#pragma unroll 8
            for (int k = 0; k < 256; ++k) acc += silu_f(c[slice * 256 + k]) * w[(size_t)k * 6144];
            modp[(size_t)(slice * 4 + layer) * 6144 + n] = acc;
        }
    }
    {
        const int* pos = (const int*)A.in[2];
        f32x2* r16 = (f32x2*)(F.ws + WS_ROPE16); f32x2* r128 = (f32x2*)(F.ws + WS_ROPE128);
        for (int idx = F.bid * NTHREADS + F.tid; idx < S * 16; idx += F.G * NTHREADS) {
            const int t = idx >> 4, j = idx & 15; float cs, sn; sincos_d((double)pos[t] * A.inv16[j], cs, sn); r16[idx] = (f32x2){cs, sn};
        }
        for (int idx = F.bid * NTHREADS + F.tid; idx < S * 128; idx += F.G * NTHREADS) {
            const int t = idx >> 7, j = idx & 127; float cs, sn; sincos_d((double)pos[t] * A.inv128[j], cs, sn); r128[idx] = (f32x2){cs, sn};
        }
    }
    conv_layer_weights(F, A, 0);
}

__device__ __forceinline__ void phase_norm(const Frame& F, const Args& A, int Lprev, int Lnext) {
    float* modl = (float*)F.lds;
    const float* modp = (const float*)(F.ws + WS_MODP); const float* ab = A.in[4];
    __syncthreads();
    for (int i = F.tid; i < 6144; i += NTHREADS) {
        const int which = i >> 11, col = i & 2047;
        int layer, mcol;
        if (which == 0) { layer = Lprev; mcol = 4096 + col; } else if (which == 1) { layer = Lnext; mcol = 2048 + col; } else { layer = Lnext; mcol = col; }
        float v = 0.f;
        if (layer >= 0) { v = ab[layer * 6144 + mcol];
#pragma unroll
            for (int s = 0; s < 8; ++s) v += modp[(size_t)(s * 4 + layer) * 6144 + mcol]; }
        modl[i] = v;
    }
    __syncthreads();
    const float* xin = (Lprev <= 0) ? A.in[0] : F.out;
    const float* Y = (const float*)(F.ws + WS_Y);
    h16* H = (h16*)(F.ws + WS_H);
    const float* npost = A.in[6] + (Lprev >= 0 ? Lprev : 0) * 2048;
    const float* npre = A.in[5] + (Lnext >= 0 ? Lnext : 0) * 2048;
    for (int t = F.bid * 8 + F.wave; t < S; t += F.G * 8) {
        f32x4 x[8];
#pragma unroll
        for (int i = 0; i < 8; ++i) x[i] = *(const f32x4*)(xin + (size_t)t * D + i * 256 + F.lane * 4);
        if (Lprev >= 0) {
            f32x4 y[8]; float ss = 0.f;
#pragma unroll
            for (int i = 0; i < 8; ++i) { y[i] = *(const f32x4*)(Y + (size_t)t * D + i * 256 + F.lane * 4); ss += y[i][0] * y[i][0] + y[i][1] * y[i][1] + y[i][2] * y[i][2] + y[i][3] * y[i][3]; }
            ss = wave_sum(ss);
            const float r = 1.0f / sqrtf(ss * (1.0f / D) + EPS);
#pragma unroll
            for (int i = 0; i < 8; ++i) {
                const int col = i * 256 + F.lane * 4;
                const f32x4 g = *(const f32x4*)(npost + col); const f32x4 gt = *(const f32x4*)(modl + col);
#pragma unroll
                for (int e = 0; e < 4; ++e) x[i][e] += gt[e] * (y[i][e] * r * g[e]);
                *(f32x4*)(F.out + (size_t)t * D + col) = x[i];
            }
        }
        if (Lnext >= 0) {
            float ss = 0.f;
#pragma unroll
            for (int i = 0; i < 8; ++i) ss += x[i][0] * x[i][0] + x[i][1] * x[i][1] + x[i][2] * x[i][2] + x[i][3] * x[i][3];
            ss = wave_sum(ss);
            const float r = 1.0f / sqrtf(ss * (1.0f / D) + EPS);
#pragma unroll
            for (int i = 0; i < 8; ++i) {
                const int col = i * 256 + F.lane * 4;
                const f32x4 g = *(const f32x4*)(npre + col); const f32x4 sc = *(const f32x4*)(modl + 2048 + col); const f32x4 sh = *(const f32x4*)(modl + 4096 + col);
                h16x4 hv;
#pragma unroll
                for (int e = 0; e < 4; ++e) hv[e] = (h16)((x[i][e] * r * g[e]) * (1.0f + sc[e]) + sh[e]);
                *(h16x4*)(H + (size_t)t * D + col) = hv;
            }
        }
    }
    if (Lnext > 0) conv_layer_weights(F, A, Lnext);
}

__device__ __forceinline__ void load16(const h16* p, float (&v)[16]) {
    const h16x8 a = *(const h16x8*)p, b = *(const h16x8*)(p + 8);
#pragma unroll
    for (int i = 0; i < 8; ++i) { v[i] = (float)a[i]; v[8 + i] = (float)b[i]; }
}
__device__ __forceinline__ void store16(h16* p, const float (&v)[16]) {
    h16x8 a, b;
#pragma unroll
    for (int i = 0; i < 8; ++i) { a[i] = (h16)v[i]; b[i] = (h16)v[8 + i]; }
    *(h16x8*)p = a; *(h16x8*)(p + 8) = b;
}
__device__ __forceinline__ void rope32(float (&v)[16], int d0, const f32x2* cs  ) {
#pragma unroll
    for (int i = 0; i < 16; ++i) {
        const float o = __shfl_xor(v[i], 1);
        if (d0 < 32) {
            const f32x2 c = cs[i];
            v[i] = (d0 == 0) ? (v[i] * c[0] - o * c[1]) : (o * c[1] + v[i] * c[0]);
        }
    }
}

__device__ __forceinline__ void phase_moba_post(const Frame& F) {
    const h16* P = (const h16*)(F.ws + WS_P);
    h16* Q = (h16*)(F.ws + WS_QKV); h16* K = Q + (size_t)16 * S * 128; h16* V = K + (size_t)16 * S * 128; h16* Z = V + (size_t)16 * S * 128;
    const f32x2* r16 = (const f32x2*)(F.ws + WS_ROPE16);
    float* kmean = (float*)(F.ws + WS_KMEAN);
    float* red = (float*)F.lds;
    for (int it = F.bid; it < 256; it += F.G) {
        const int blk = it >> 3, part = it & 7, sect = part >> 1;
        const int cs0 = (part & 1) * 1024 + F.lane * 16;
        const int head = cs0 >> 7, d0 = cs0 & 127;
        float ksum[16];
#pragma unroll
        for (int i = 0; i < 16; ++i) ksum[i] = 0.f;
        for (int i = 0; i < 32; ++i) {
            const int t = blk * 256 + F.wave * 32 + i;
            float v[16]; load16(P + (size_t)t * 8192 + part * 1024 + F.lane * 16, v);
            if (sect <= 1) {
                rope32(v, d0, r16 + (size_t)t * 16);
                if (sect == 0) {
#pragma unroll
                    for (int e = 0; e < 16; ++e) v[e] *= 0.08838834764831845f;
                    store16(Q + ((size_t)head * S + t) * 128 + d0, v);
                } else {
#pragma unroll
                    for (int e = 0; e < 16; ++e) ksum[e] += v[e];
                    store16(K + ((size_t)head * S + t) * 128 + d0, v);
                }
            } else if (sect == 2) {
#if MOBA_MFMA
#pragma unroll
                for (int e = 0; e < 16; ++e) V[((size_t)head * 128 + d0 + e) * S + t] = (h16)v[e];
#else
                store16(V + ((size_t)head * S + t) * 128 + d0, v);
#endif
            } else {
#pragma unroll
                for (int e = 0; e < 16; ++e) v[e] = silu_f(v[e]);
                store16(Z + (size_t)t * 2048 + cs0, v);
            }
        }
        if (sect == 1) {
            __syncthreads();
#pragma unroll
            for (int e = 0; e < 16; ++e) red[F.wave * 1024 + F.lane * 16 + e] = ksum[e];
            __syncthreads();
            for (int c = F.tid; c < 1024; c += NTHREADS) {
                float s = 0.f;
#pragma unroll
                for (int w = 0; w < 8; ++w) s += red[w * 1024 + c];
                const int cc = (part & 1) * 1024 + c;
                kmean[((size_t)(cc >> 7) * 32 + blk) * 128 + (cc & 127)] = s * (1.0f / 256.0f);
            }
            __syncthreads();
        }
    }
}

__device__ __forceinline__ void wave_attend(const h16* __restrict__ K, const h16* __restrict__ V, int nslots, const int* starts, int limit,
                                            const float* qf, float* pbuf, int lane, float& o0, float& o1) {
    float sc[16]; float mx = NEGF;
#pragma unroll
    for (int k = 0; k < 16; ++k) {
        sc[k] = NEGF;
        if (k < nslots) {
            const int key = starts[k] + lane;
            if (key >= 0 && key <= limit) {
                const h16x8* kr = (const h16x8*)(K + (size_t)key * 128);
                float d = 0.f;
#pragma unroll
                for (int i = 0; i < 16; ++i) {
                    const h16x8 kv = kr[i]; const f32x4 qa = *(const f32x4*)(qf + i * 8), qb = *(const f32x4*)(qf + i * 8 + 4);
                    d += (float)kv[0] * qa[0] + (float)kv[1] * qa[1] + (float)kv[2] * qa[2] + (float)kv[3] * qa[3] + (float)kv[4] * qb[0] + (float)kv[5] * qb[1] + (float)kv[6] * qb[2] + (float)kv[7] * qb[3];
                }
                sc[k] = d;
            }
            mx = fmaxf(mx, sc[k]);
        }
    }
    mx = wave_max(mx);
    float sum = 0.f;
#pragma unroll
    for (int k = 0; k < 16; ++k) { const float p = (sc[k] > 0.5f * NEGF) ? __expf(sc[k] - mx) : 0.f; sc[k] = p; sum += p; }
    sum = wave_sum(sum);
    const float inv = 1.0f / fmaxf(sum, 1e-30f);
    wave_lds_fence();
#pragma unroll
    for (int k = 0; k < 16; ++k) if (k < nslots) pbuf[k * 64 + lane] = sc[k] * inv;
    wave_lds_fence();
    float a0 = 0.f, a1 = 0.f;
    for (int k = 0; k < nslots; ++k) {
        const int base = starts[k];
        for (int i = 0; i < 64; ++i) {
            const int key = base + i;
            if (key >= 0 && key <= limit) {
                const float p = pbuf[k * 64 + i];
                const h16x2 vv = *(const h16x2*)(V + (size_t)key * 128 + 2 * lane);
                a0 += p * (float)vv[0]; a1 += p * (float)vv[1];
            }
        }
    }
    o0 = a0; o1 = a1;
}

constexpr int WS_QF = 0, WS_PB = 2048, WS_PC = 6144, WS_SEL = 14336, WS_ST = 14848, WS_LIST = 14912;
constexpr int WSCR_STRIDE = 16384;

__device__ __forceinline__ void phase_moba_attn(const Frame& F) {
    const h16* Q = (const h16*)(F.ws + WS_QKV); const h16* K = Q + (size_t)16 * S * 128; const h16* V = K + (size_t)16 * S * 128; const h16* Z = V + (size_t)16 * S * 128;
    const float* kmean = (const float*)(F.ws + WS_KMEAN);
    h16* OZ = (h16*)(F.ws + WS_OZ);
    char* wl = F.lds + F.wave * WSCR_STRIDE;
    float* qf = (float*)(wl + WS_QF); float* pbuf = (float*)(wl + WS_PB); int* starts = (int*)(wl + WS_ST);
    const int lane = F.lane;
    for (int task = F.bid * 8 + F.wave; task < 16 * S; task += F.G * 8) {
        const int head = task >> 13, t = task & (S - 1), blk = t >> 8;
        wave_lds_fence();
        { const h16x2 qv = *(const h16x2*)(Q + ((size_t)head * S + t) * 128 + 2 * lane); qf[2 * lane] = (float)qv[0]; qf[2 * lane + 1] = (float)qv[1]; }
        wave_lds_fence();
        float gs = NEGF;
        if (lane < blk) {
            const float* km = kmean + ((size_t)head * 32 + lane) * 128; float d = 0.f;
#pragma unroll 8
            for (int i = 0; i < 128; ++i) d += qf[i] * km[i];
            gs = d;
        }
        int sel[3];
#pragma unroll
        for (int r = 0; r < 3; ++r) {
            float bv = gs; int bi = lane;
#pragma unroll
            for (int o = 32; o >= 1; o >>= 1) { const float ov = __shfl_xor(bv, o); const int oi = __shfl_xor(bi, o); if (ov > bv || (ov == bv && oi < bi)) { bv = ov; bi = oi; } }
            sel[r] = bi; if (lane == bi) gs = -3.0e38f;
        }
        const int nsel = blk < 3 ? blk : 3;
        if (lane < 16) {
            const int grp = lane >> 2, sub = lane & 3;
            const int b = (grp == 0) ? blk : (grp == 1 ? sel[0] : (grp == 2 ? sel[1] : sel[2]));
            starts[lane] = b * 256 + sub * 64;
        }
        wave_lds_fence();
        float o0, o1;
        wave_attend(K + (size_t)head * S * 128, V + (size_t)head * S * 128, 4 + 4 * nsel, starts, t, qf, pbuf, lane, o0, o1);
        const h16x2 zz = *(const h16x2*)(Z + (size_t)t * 2048 + head * 128 + 2 * lane);
        h16x2 ov; ov[0] = (h16)(o0 * (float)zz[0]); ov[1] = (h16)(o1 * (float)zz[1]);
        *(h16x2*)(OZ + (size_t)t * 2048 + head * 128 + 2 * lane) = ov;
    }
}

__device__ __forceinline__ void phase_nsa_post(const Frame& F) {
    const h16* P = (const h16*)(F.ws + WS_P);
    h16* Q = (h16*)(F.ws + WS_QKV); h16* KV = Q + (size_t)16 * S * 128;
    h16* Z = (h16*)(F.ws + WS_QKV + 96 * MiB);
    float* gates = (float*)(F.ws + WS_GATES);
    const f32x2* r16 = (const f32x2*)(F.ws + WS_ROPE16);
    for (int it = F.bid; it < 256; it += F.G) {
        const int blk = it >> 3, part = it & 7;
        for (int i = 0; i < 32; ++i) {
            const int t = blk * 256 + F.wave * 32 + i;
            float v[16]; load16(P + (size_t)t * NSA_NP + part * 1024 + F.lane * 16, v);
            if (part <= 1) {
                const int cs0 = part * 1024 + F.lane * 16, head = cs0 >> 7, d0 = cs0 & 127;
                rope32(v, d0, r16 + (size_t)t * 16);
#pragma unroll
                for (int e = 0; e < 16; ++e) v[e] *= 0.08838834764831845f;
                store16(Q + ((size_t)head * S + t) * 128 + d0, v);
            } else if (part <= 4) {
                const int x = part - 2, isv = F.lane >> 5, grp = (F.lane & 31) >> 3, d0 = (F.lane & 7) * 16;
                rope32(v, isv ? 64 : d0, r16 + (size_t)t * 16);
#if NSA_MFMA
                if (isv && x >= 1) {
                    h16* vt = KV + ((size_t)(2 * x + 1) * 4 + grp) * S * 128;
#pragma unroll
                    for (int e = 0; e < 16; ++e) vt[(size_t)(d0 + e) * S + t] = (h16)v[e];
                } else
#endif
                store16(KV + ((size_t)(2 * x + isv) * 4 + grp) * S * 128 + (size_t)t * 128 + d0, v);
            } else if (part <= 6) {
                const int cs0 = (part - 5) * 1024 + F.lane * 16;
#pragma unroll
                for (int e = 0; e < 16; ++e) v[e] = silu_f(v[e]);
                store16(Z + (size_t)t * 2048 + cs0, v);
            } else {
                if (F.lane < 3) {
#pragma unroll
                    for (int e = 0; e < 16; ++e) gates[(size_t)t * 48 + F.lane * 16 + e] = sigmoid_f(v[e]);
                }
            }
        }
    }
}

__device__ __forceinline__ void phase_nsa_cmp(const Frame& F, const Args& A) {
    const h16* KVb = (const h16*)(F.ws + WS_QKV) + (size_t)16 * S * 128;
    const float* pe_g = A.in[11];
    h16* xs = (h16*)F.lds;
    float* pe = (float*)(F.lds + 36864);
    float* hid = (float*)(F.lds + 36864 + 16384);
    for (int it = F.bid; it < 512; it += F.G) {
        const int kv = it >> 8, g = (it >> 6) & 3, nb = it & 63;
        const h16* src = KVb + ((size_t)kv * 4 + g) * S * 128;
        const float* W1 = kv ? A.in[14] : A.in[12]; const float* W2 = kv ? A.in[15] : A.in[13];
        h16* dst = (h16*)(F.ws + (kv ? WS_VCMP : WS_KCMP)) + (size_t)g * 512 * 128;
        __syncthreads();
        for (int i = F.tid; i < 144 * 16; i += NTHREADS) {
            const int r = i >> 4, c8 = (i & 15) * 8, tok = nb * 128 + r;
            h16x8 v;
#pragma unroll
            for (int e = 0; e < 8; ++e) v[e] = (h16)0.f;
            if (tok < S) v = *(const h16x8*)(src + (size_t)tok * 128 + c8);
            *(h16x8*)(xs + r * 128 + c8) = v;
        }
        for (int i = F.tid; i < 4096; i += NTHREADS) pe[i] = pe_g[i];
        __syncthreads();
        {
            const int j = F.tid & 255, rh = F.tid >> 8;
            float acc[4] = {0.f, 0.f, 0.f, 0.f};
            for (int pos = 0; pos < 32; ++pos) {
#pragma unroll 4
                for (int d = 0; d < 128; ++d) {
                    const float w = W1[(size_t)(pos * 128 + d) * 256 + j]; const float pv = pe[pos * 128 + d];
#pragma unroll
                    for (int rr = 0; rr < 4; ++rr) acc[rr] += ((float)xs[(16 * (rh * 4 + rr) + pos) * 128 + d] + pv) * w;
                }
            }
#pragma unroll
            for (int rr = 0; rr < 4; ++rr) hid[(rh * 4 + rr) * 256 + j] = silu_f(acc[rr]);
        }
        __syncthreads();
        {
            const int d = F.tid & 127, rq = F.tid >> 7;
            float a0 = 0.f, a1 = 0.f;
#pragma unroll 4
            for (int j = 0; j < 256; ++j) { const float w = W2[j * 128 + d]; a0 += hid[rq * 256 + j] * w; a1 += hid[(rq + 4) * 256 + j] * w; }
            const int n0 = nb * 8 + rq, n1 = nb * 8 + rq + 4;
#if NSA_MFMA
            if (kv) { dst[(size_t)d * 512 + n0] = (n0 < NC) ? (h16)a0 : (h16)0.f; dst[(size_t)d * 512 + n1] = (n1 < NC) ? (h16)a1 : (h16)0.f; }
            else    { dst[(size_t)n0 * 128 + d] = (n0 < NC) ? (h16)a0 : (h16)0.f; dst[(size_t)n1 * 128 + d] = (n1 < NC) ? (h16)a1 : (h16)0.f; }
#else
            if (n0 < NC) dst[(size_t)n0 * 128 + d] = (h16)a0;
            if (n1 < NC) dst[(size_t)n1 * 128 + d] = (h16)a1;
#endif
        }
    }
    __syncthreads();
}

__device__ __forceinline__ void phase_nsa_attn(const Frame& F) {
    const h16* Q = (const h16*)(F.ws + WS_QKV); const h16* KVb = Q + (size_t)16 * S * 128;
    const h16* Z = (const h16*)(F.ws + WS_QKV + 96 * MiB);
    const float* gates = (const float*)(F.ws + WS_GATES);
    const h16* KCMP = (const h16*)(F.ws + WS_KCMP); const h16* VCMP = (const h16*)(F.ws + WS_VCMP);
    h16* OZ = (h16*)(F.ws + WS_OZ);
    char* wl = F.lds + F.wave * WSCR_STRIDE;
    float* qf = (float*)(wl + WS_QF); float* pbuf = (float*)(wl + WS_PB); float* pc = (float*)(wl + WS_PC);
    float* selbuf = (float*)(wl + WS_SEL); int* starts = (int*)(wl + WS_ST); int* list = (int*)(wl + WS_LIST);
    const int lane = F.lane;
    for (int task = F.bid * 8 + F.wave; task < 4 * S; task += F.G * 8) {
        const int g = task >> 13, t = task & (S - 1);
        wave_lds_fence();
#pragma unroll
        for (int hh = 0; hh < 4; ++hh) { const h16x2 qv = *(const h16x2*)(Q + ((size_t)(4 * g + hh) * S + t) * 128 + 2 * lane); qf[hh * 128 + 2 * lane] = (float)qv[0]; qf[hh * 128 + 2 * lane + 1] = (float)qv[1]; }
        if (lane < 8) starts[lane] = lane * 64;
        wave_lds_fence();
        float acc0[4], acc1[4];
        const int nvalid = (t >= 31) ? (((t - 31) >> 4) + 1 < NC ? ((t - 31) >> 4) + 1 : NC) : 0;
#pragma unroll
        for (int hh = 0; hh < 4; ++hh) {
            float o0, o1;
            wave_attend(KCMP + (size_t)g * 512 * 128, VCMP + (size_t)g * 512 * 128, 8, starts, nvalid - 1, qf + hh * 128, pc + hh * 512, lane, o0, o1);
            const float g0 = gates[(size_t)t * 48 + (4 * g + hh) * 3 + 0];
            acc0[hh] = g0 * o0; acc1[hh] = g0 * o1;
        }
        wave_lds_fence();
        const int cur = t >> 6;
        float myv[2];
#pragma unroll
        for (int c = 0; c < 2; ++c) {
            const int s = lane + 64 * c; float imp = 0.f;
#pragma unroll
            for (int hh = 0; hh < 4; ++hh) {
                const float* p = pc + hh * 512 + 4 * s;
                const float pm1 = (s > 0) ? p[-1] : 0.f;
                imp += 0.5f * pm1 + p[0] + p[1] + p[2] + 0.5f * p[3];
            }
            const bool valid = s <= cur, forced = (s == 0) || (s == cur) || (s == cur - 1);
            myv[c] = valid ? (forced ? BIGF : imp) : NEGF;
            selbuf[s] = myv[c];
        }
        wave_lds_fence();
        int rank0 = 0, rank1 = 0;
        for (int s2 = 0; s2 < 128; ++s2) {
            const float v2 = selbuf[s2];
            rank0 += (v2 > myv[0] || (v2 == myv[0] && s2 < lane)) ? 1 : 0;
            rank1 += (v2 > myv[1] || (v2 == myv[1] && s2 < lane + 64)) ? 1 : 0;
        }
        const bool sel0 = rank0 < 16 && lane <= cur, sel1 = rank1 < 16 && (lane + 64) <= cur;
        const unsigned long long m0 = __ballot(sel0), m1 = __ballot(sel1);
        const int n0 = __popcll(m0), nsel = n0 + __popcll(m1);
        const unsigned long long below = (lane == 0) ? 0ull : (~0ull >> (64 - lane));
        if (sel0) list[__popcll(m0 & below)] = lane;
        if (sel1) list[n0 + __popcll(m1 & below)] = lane + 64;
        wave_lds_fence();
        if (lane < 16) starts[lane] = (lane < nsel) ? list[lane] * 64 : 0;
        wave_lds_fence();
#pragma unroll
        for (int hh = 0; hh < 4; ++hh) {
            float o0, o1;
            wave_attend(KVb + ((size_t)2 * 4 + g) * S * 128, KVb + ((size_t)3 * 4 + g) * S * 128, nsel, starts, t, qf + hh * 128, pbuf, lane, o0, o1);
            const float g1 = gates[(size_t)t * 48 + (4 * g + hh) * 3 + 1];
            acc0[hh] += g1 * o0; acc1[hh] += g1 * o1;
        }
        wave_lds_fence();
        if (lane < 8) starts[lane] = t - 511 + lane * 64;
        wave_lds_fence();
#pragma unroll
        for (int hh = 0; hh < 4; ++hh) {
            float o0, o1;
            wave_attend(KVb + ((size_t)4 * 4 + g) * S * 128, KVb + ((size_t)5 * 4 + g) * S * 128, 8, starts, t, qf + hh * 128, pbuf, lane, o0, o1);
            const float g2 = gates[(size_t)t * 48 + (4 * g + hh) * 3 + 2];
            acc0[hh] += g2 * o0; acc1[hh] += g2 * o1;
        }
#pragma unroll
        for (int hh = 0; hh < 4; ++hh) {
            const int col = (4 * g + hh) * 128 + 2 * lane;
            const h16x2 zz = *(const h16x2*)(Z + (size_t)t * 2048 + col);
            h16x2 ov; ov[0] = (h16)(acc0[hh] * (float)zz[0]); ov[1] = (h16)(acc1[hh] * (float)zz[1]);
            *(h16x2*)(OZ + (size_t)t * 2048 + col) = ov;
        }
    }
}


namespace fa {
typedef float f32x16 __attribute__((ext_vector_type(16)));
typedef unsigned u32x2 __attribute__((ext_vector_type(2)));
constexpr float LOG2E = 1.4426950408889634f;
constexpr int KROW = 272, VROW = 136;
constexpr int KT_BYTES = 64 * KROW, BUF_BYTES = KT_BYTES + 128 * VROW;
constexpr int LDS_IMP = 2 * BUF_BYTES;
constexpr int LDS_SELW = LDS_IMP + 32768;
constexpr int LDS_SV = LDS_SELW + 1024;
static_assert(LDS_SV + 4096 <= MISC_OFF, "attention LDS map");

struct Stage { u32x4 k[2], v[2]; };
__device__ __forceinline__ void stage_load(Stage& st, const h16* Kg, const h16* VTg, int vstride, int j, int tid) {
    asm volatile("" : "+v"(tid));
#pragma unroll
    for (int i = 0; i < 2; ++i) { const int idx = tid + 512 * i;
        st.k[i] = *(const u32x4*)(Kg + (size_t)(j * 64 + (idx >> 4)) * 128 + (idx & 15) * 8);
        st.v[i] = *(const u32x4*)(VTg + (size_t)(idx >> 3) * vstride + j * 64 + (idx & 7) * 8); }
}
__device__ __forceinline__ void stage_write(const Stage& st, LAS unsigned char* buf, int tid) {
    asm volatile("" : "+v"(tid));
#pragma unroll
    for (int i = 0; i < 2; ++i) { const int idx = tid + 512 * i;
        *(LAS u32x4*)(buf + (idx >> 4) * KROW + (idx & 15) * 16) = st.k[i];
        LAS unsigned char* vp = buf + KT_BYTES + (idx >> 3) * VROW + (idx & 7) * 16;
        *(LAS u32x2*)vp = (u32x2){st.v[i][0], st.v[i][1]}; *(LAS u32x2*)(vp + 8) = (u32x2){st.v[i][2], st.v[i][3]}; }
}

template <int MODE>
__device__ __forceinline__ void tile_compute(const LAS unsigned char* buf, int j, const h16x8 (&qf)[8], f32x16 (&o)[4], float& m, float& l,
                                             bool on, int lo, int hi, int lane, float inv_l, LAS float* imp_q) {
    const int r31 = lane & 31, h = lane >> 5, k0 = j * 64;
    const bool need = on && (k0 <= hi) && (k0 + 63 >= lo);
    if (__ballot(need) == 0ull) return;
    f32x16 s0, s1;
#pragma unroll
    for (int r = 0; r < 16; ++r) { s0[r] = 0.f; s1[r] = 0.f; }
    const LAS unsigned char* kp = buf + r31 * KROW + h * 16;
#pragma unroll
    for (int s = 0; s < 8; ++s) {
        const h16x8 a0 = *(const LAS h16x8*)(kp + s * 32);
        const h16x8 a1 = *(const LAS h16x8*)(kp + 32 * KROW + s * 32);
        s0 = __builtin_amdgcn_mfma_f32_32x32x16_f16(a0, qf[s], s0, 0, 0, 0);
        s1 = __builtin_amdgcn_mfma_f32_32x32x16_f16(a1, qf[s], s1, 0, 0, 0);
        if ((s & 1) == 1) __builtin_amdgcn_sched_barrier(0);
    }
    float tmax = NEGF;
#pragma unroll
    for (int r = 0; r < 16; ++r) {
        const int key0 = k0 + (r & 3) + 8 * (r >> 2) + 4 * h, key1 = key0 + 32;
        const bool v0 = on && key0 >= lo && key0 <= hi, v1 = on && key1 >= lo && key1 <= hi;
        s0[r] = v0 ? s0[r] * LOG2E : NEGF; s1[r] = v1 ? s1[r] * LOG2E : NEGF;
        tmax = fmaxf(tmax, fmaxf(s0[r], s1[r]));
    }
    if (MODE != 2) {
        tmax = fmaxf(tmax, __shfl_xor(tmax, 32));
        const float m_new = fmaxf(m, tmax);
        const float alpha = __builtin_amdgcn_exp2f(m - m_new);
        float sum = 0.f;
#pragma unroll
        for (int r = 0; r < 16; ++r) {
            s0[r] = (s0[r] > 0.5f * NEGF) ? __builtin_amdgcn_exp2f(s0[r] - m_new) : 0.f;
            s1[r] = (s1[r] > 0.5f * NEGF) ? __builtin_amdgcn_exp2f(s1[r] - m_new) : 0.f;
            sum += s0[r] + s1[r];
        }
        l = l * alpha + sum; m = m_new;
        if (MODE == 1) return;
#pragma unroll
        for (int dt = 0; dt < 4; ++dt) o[dt] = o[dt] * alpha;
    } else {
#pragma unroll
        for (int r = 0; r < 16; ++r) {
            s0[r] = (s0[r] > 0.5f * NEGF) ? __builtin_amdgcn_exp2f(s0[r] - m) * inv_l : 0.f;
            s1[r] = (s1[r] > 0.5f * NEGF) ? __builtin_amdgcn_exp2f(s1[r] - m) * inv_l : 0.f;
        }
#pragma unroll
        for (int c = 0; c < 4; ++c) {
            const int sa = 16 * j + 2 * c + h, sb = sa + 8;
            const float a0 = s0[4 * c] + s0[4 * c + 1] + s0[4 * c + 2] + 0.5f * s0[4 * c + 3], b0 = 0.5f * s0[4 * c + 3];
            const float a1 = s1[4 * c] + s1[4 * c + 1] + s1[4 * c + 2] + 0.5f * s1[4 * c + 3], b1 = 0.5f * s1[4 * c + 3];
            (void)__hip_atomic_fetch_add(imp_q + sa, a0, __ATOMIC_RELAXED, __HIP_MEMORY_SCOPE_WORKGROUP); if (sa + 1 < 128) (void)__hip_atomic_fetch_add(imp_q + sa + 1, b0, __ATOMIC_RELAXED, __HIP_MEMORY_SCOPE_WORKGROUP);
            (void)__hip_atomic_fetch_add(imp_q + sb, a1, __ATOMIC_RELAXED, __HIP_MEMORY_SCOPE_WORKGROUP); if (sb + 1 < 128) (void)__hip_atomic_fetch_add(imp_q + sb + 1, b1, __ATOMIC_RELAXED, __HIP_MEMORY_SCOPE_WORKGROUP);
        }
    }
    h16x8 pb[2][2];
#pragma unroll
    for (int sp = 0; sp < 2; ++sp)
#pragma unroll
        for (int jj = 0; jj < 8; ++jj) { pb[0][sp][jj] = (h16)s0[8 * sp + jj]; pb[1][sp][jj] = (h16)s1[8 * sp + jj]; }
#pragma unroll
    for (int dt = 0; dt < 4; ++dt) {
        const LAS unsigned char* vp = buf + KT_BYTES + (32 * dt + r31) * VROW + h * 8;
#pragma unroll
        for (int sub = 0; sub < 2; ++sub)
#pragma unroll
            for (int sp = 0; sp < 2; ++sp) {
                const int off = (32 * sub + 16 * sp) * 2;
                const h16x4 lo4 = *(const LAS h16x4*)(vp + off), hi4 = *(const LAS h16x4*)(vp + off + 16);
                h16x8 va; va[0] = lo4[0]; va[1] = lo4[1]; va[2] = lo4[2]; va[3] = lo4[3]; va[4] = hi4[0]; va[5] = hi4[1]; va[6] = hi4[2]; va[7] = hi4[3];
                o[dt] = __builtin_amdgcn_mfma_f32_32x32x16_f16(va, pb[sub][sp], o[dt], 0, 0, 0);
            }
        __builtin_amdgcn_sched_barrier(0);
    }
}

template <int MODE, class OnFn>
__device__ __forceinline__ void stream(LAS unsigned char* lds, const h16* Kg, const h16* VTg, int vstride, int jlo, int jhi, const h16x8 (&qf)[8],
                                       f32x16 (&o)[4], float& m, float& l, int lo, int hi, const OnFn& on_fn, int tid, int lane, float inv_l, LAS float* imp_q) {
    if (jlo >= jhi) return;
    Stage st;
    stage_load(st, Kg, VTg, vstride, jlo, tid);
    stage_write(st, lds, tid);
    __syncthreads();
    for (int j = jlo; j < jhi; ++j) {
        const int cur = (j - jlo) & 1;
        if (j + 1 < jhi) stage_load(st, Kg, VTg, vstride, j + 1, tid);
        tile_compute<MODE>(lds + cur * BUF_BYTES, j, qf, o, m, l, on_fn(j), lo, hi, lane, inv_l, imp_q);
        if (j + 1 < jhi) stage_write(st, lds + (cur ^ 1) * BUF_BYTES, tid);
        __syncthreads();
    }
}

__device__ __forceinline__ void load_q(h16x8 (&qf)[8], const h16* qrow, int h) {
#pragma unroll
    for (int s = 0; s < 8; ++s) qf[s] = *(const h16x8*)(qrow + 16 * s + 8 * h);
}
__device__ __forceinline__ void zero_o(f32x16 (&o)[4]) {
#pragma unroll
    for (int dt = 0; dt < 4; ++dt)
#pragma unroll
        for (int r = 0; r < 16; ++r) o[dt][r] = 0.f;
}
}

struct MobaOn { unsigned selmask; int b; __device__ __forceinline__ bool operator()(int j) const { const int jb = j >> 2; return jb == b ? true : (((selmask >> jb) & 1u) != 0u); } };
__device__ __forceinline__ void phase_moba_attn_mfma(const Frame& F) {
    const h16* Q = (const h16*)(F.ws + WS_QKV); const h16* K = Q + (size_t)16 * S * 128; const h16* VT = K + (size_t)16 * S * 128; const h16* Z = VT + (size_t)16 * S * 128;
    const float* kmean = (const float*)(F.ws + WS_KMEAN);
    h16* OZ = (h16*)(F.ws + WS_OZ);
    LAS unsigned char* lds = (LAS unsigned char*)F.lds;
    const int lane = F.lane, r31 = lane & 31, h = lane >> 5;
    for (int it = F.bid; it < 256; it += F.G) {
        const int head = it >> 4, pi = it & 15;
#pragma unroll 1
        for (int half = 0; half < 2; ++half) {
            const int b = half ? 31 - pi : pi;
            const int t = b * 256 + F.wave * 32 + r31;
            h16x8 qf[8]; fa::load_q(qf, Q + ((size_t)head * S + t) * 128, h);
            float v0 = NEGF, v1 = NEGF, v2 = NEGF; int i0 = -1, i1 = -1, i2 = -1;
            for (int jb = 0; jb < b; ++jb) {
                const float* km = kmean + ((size_t)head * 32 + jb) * 128 + 8 * h;
                float d = 0.f;
#pragma unroll
                for (int s = 0; s < 8; ++s) { const f32x4 ka = *(const f32x4*)(km + 16 * s), kb = *(const f32x4*)(km + 16 * s + 4);
                    d += (float)qf[s][0] * ka[0] + (float)qf[s][1] * ka[1] + (float)qf[s][2] * ka[2] + (float)qf[s][3] * ka[3] + (float)qf[s][4] * kb[0] + (float)qf[s][5] * kb[1] + (float)qf[s][6] * kb[2] + (float)qf[s][7] * kb[3]; }
                d += __shfl_xor(d, 32);
                if (d > v0) { v2 = v1; i2 = i1; v1 = v0; i1 = i0; v0 = d; i0 = jb; }
                else if (d > v1) { v2 = v1; i2 = i1; v1 = d; i1 = jb; }
                else if (d > v2) { v2 = d; i2 = jb; }
            }
            MobaOn on; on.b = b; on.selmask = (i0 >= 0 ? 1u << i0 : 0u) | (i1 >= 0 ? 1u << i1 : 0u) | (i2 >= 0 ? 1u << i2 : 0u);
            fa::f32x16 o[4]; fa::zero_o(o); float m = NEGF, l = 0.f;
            fa::stream<0>(lds, K + (size_t)head * S * 128, VT + (size_t)head * 128 * S, S, 0, 4 * b + 4, qf, o, m, l, 0, t, on, F.tid, lane, 0.f, (LAS float*)nullptr);
            l += __shfl_xor(l, 32);
            const float inv = 1.0f / fmaxf(l, 1e-30f);
#pragma unroll
            for (int dt = 0; dt < 4; ++dt)
#pragma unroll
                for (int c = 0; c < 4; ++c) {
                    const int d = 32 * dt + 8 * c + 4 * h; const size_t off = (size_t)t * 2048 + head * 128 + d;
                    const h16x4 zz = *(const h16x4*)(Z + off); h16x4 ov;
#pragma unroll
                    for (int e = 0; e < 4; ++e) ov[e] = (h16)(o[dt][4 * c + e] * inv * (float)zz[e]);
                    *(h16x4*)(OZ + off) = ov;
                }
        }
    }
}

struct AllOn { __device__ __forceinline__ bool operator()(int) const { return true; } };
struct SelOn { const LAS unsigned* w; __device__ __forceinline__ bool operator()(int j) const { return ((w[j >> 5] >> (j & 31)) & 1u) != 0u; } };
__device__ __forceinline__ void phase_nsa_attn_mfma(const Frame& F) {
    const h16* Q = (const h16*)(F.ws + WS_QKV); const h16* KVb = Q + (size_t)16 * S * 128;
    const h16* Z = (const h16*)(F.ws + WS_QKV + 96 * MiB);
    const float* gates = (const float*)(F.ws + WS_GATES);
    const h16* KCMP = (const h16*)(F.ws + WS_KCMP); const h16* VCMPT = (const h16*)(F.ws + WS_VCMP);
    h16* OZ = (h16*)(F.ws + WS_OZ);
    LAS unsigned char* lds = (LAS unsigned char*)F.lds;
    LAS float* imp = (LAS float*)(lds + fa::LDS_IMP); LAS unsigned* selw = (LAS unsigned*)(lds + fa::LDS_SELW); LAS float* sv = (LAS float*)(lds + fa::LDS_SV) + F.wave * 128;
    const int lane = F.lane, r31 = lane & 31, h = lane >> 5, hh = F.wave & 3, qsub = F.wave >> 2;
    for (int it = F.bid; it < 256; it += F.G) {
        const int g = it >> 6, pi = it & 63, head = 4 * g + hh;
#pragma unroll 1
        for (int half = 0; half < 2; ++half) {
            const int c64 = half ? 127 - pi : pi;
            const int ql = 32 * qsub + r31, t = c64 * 64 + ql;
            h16x8 qf[8]; fa::load_q(qf, Q + ((size_t)head * S + t) * 128, h);
            fa::f32x16 o[4]; float m, l;
            for (int i = F.tid; i < 64 * 128; i += NTHREADS) imp[i] = 0.f;
            const int nval = (t >= 31) ? (((t - 31) >> 4) + 1 < NC ? ((t - 31) >> 4) + 1 : NC) : 0;
            const int tl = c64 * 64 + 63; const int nval_max = (tl >= 31) ? (((tl - 31) >> 4) + 1 < NC ? ((tl - 31) >> 4) + 1 : NC) : 0;
            const int jc = (nval_max + 63) >> 6;
            fa::zero_o(o); m = NEGF; l = 0.f;
            fa::stream<1>(lds, KCMP + (size_t)g * 512 * 128, VCMPT + (size_t)g * 128 * 512, 512, 0, jc, qf, o, m, l, 0, nval - 1, AllOn(), F.tid, lane, 0.f, (LAS float*)nullptr);
            l += __shfl_xor(l, 32);
            { const float invl = 1.0f / fmaxf(l, 1e-30f); float l2 = 0.f;
              fa::stream<2>(lds, KCMP + (size_t)g * 512 * 128, VCMPT + (size_t)g * 128 * 512, 512, 0, jc, qf, o, m, l2, 0, nval - 1, AllOn(), F.tid, lane, invl, imp + ql * 128); }
            const float g0 = gates[(size_t)t * 48 + head * 3 + 0];
#pragma unroll
            for (int dt = 0; dt < 4; ++dt)
#pragma unroll
                for (int c = 0; c < 4; ++c) { h16x4 ov;
#pragma unroll
                    for (int e = 0; e < 4; ++e) ov[e] = (h16)(o[dt][4 * c + e] * g0);
                    *(h16x4*)(OZ + (size_t)t * 2048 + head * 128 + 32 * dt + 8 * c + 4 * h) = ov; }
            __syncthreads();
            for (int qq = 0; qq < 8; ++qq) {
                const int q = F.wave * 8 + qq;
                float myv[2];
#pragma unroll
                for (int c = 0; c < 2; ++c) { const int s = lane + 64 * c; const bool valid = s <= c64, forced = (s == 0) || (s == c64) || (s == c64 - 1);
                    myv[c] = valid ? (forced ? BIGF : imp[q * 128 + s]) : NEGF; sv[s] = myv[c]; }
                wave_lds_fence();
                int rank0 = 0, rank1 = 0;
                for (int s2 = 0; s2 < 128; ++s2) { const float v2 = sv[s2];
                    rank0 += (v2 > myv[0] || (v2 == myv[0] && s2 < lane)) ? 1 : 0; rank1 += (v2 > myv[1] || (v2 == myv[1] && s2 < lane + 64)) ? 1 : 0; }
                const unsigned long long m0 = __ballot(rank0 < 16 && lane <= c64), m1 = __ballot(rank1 < 16 && (lane + 64) <= c64);
                if (lane == 0) { selw[q * 4 + 0] = (unsigned)m0; selw[q * 4 + 1] = (unsigned)(m0 >> 32); selw[q * 4 + 2] = (unsigned)m1; selw[q * 4 + 3] = (unsigned)(m1 >> 32); }
                wave_lds_fence();
            }
            __syncthreads();
            SelOn son; son.w = selw + ql * 4;
            fa::zero_o(o); m = NEGF; l = 0.f;
            fa::stream<0>(lds, KVb + ((size_t)2 * 4 + g) * S * 128, KVb + ((size_t)3 * 4 + g) * S * 128, S, 0, c64 + 1, qf, o, m, l, 0, t, son, F.tid, lane, 0.f, (LAS float*)nullptr);
            l += __shfl_xor(l, 32);
            { const float sc = gates[(size_t)t * 48 + head * 3 + 1] / fmaxf(l, 1e-30f);
#pragma unroll
              for (int dt = 0; dt < 4; ++dt)
#pragma unroll
                  for (int c = 0; c < 4; ++c) { h16* p = OZ + (size_t)t * 2048 + head * 128 + 32 * dt + 8 * c + 4 * h; const h16x4 pv = *(const h16x4*)p; h16x4 ov;
#pragma unroll
                      for (int e = 0; e < 4; ++e) ov[e] = (h16)((float)pv[e] + o[dt][4 * c + e] * sc);
                      *(h16x4*)p = ov; } }
            fa::zero_o(o); m = NEGF; l = 0.f;
            fa::stream<0>(lds, KVb + ((size_t)4 * 4 + g) * S * 128, KVb + ((size_t)5 * 4 + g) * S * 128, S, (c64 >= 8 ? c64 - 8 : 0), c64 + 1, qf, o, m, l, t - 511, t, AllOn(), F.tid, lane, 0.f, (LAS float*)nullptr);
            l += __shfl_xor(l, 32);
            const float sc2 = gates[(size_t)t * 48 + head * 3 + 2] / fmaxf(l, 1e-30f);
#pragma unroll
            for (int dt = 0; dt < 4; ++dt)
#pragma unroll
                for (int c = 0; c < 4; ++c) {
                    const int d = 32 * dt + 8 * c + 4 * h; const size_t off = (size_t)t * 2048 + head * 128 + d;
                    const h16x4 zz = *(const h16x4*)(Z + off); const h16x4 pv = *(const h16x4*)(OZ + off); h16x4 ov;
#pragma unroll
                    for (int e = 0; e < 4; ++e) ov[e] = (h16)(((float)pv[e] + o[dt][4 * c + e] * sc2) * (float)zz[e]);
                    *(h16x4*)(OZ + off) = ov;
                }
        }
    }
}

__device__ __forceinline__ void phase_ret_post(const Frame& F) {
    const h16* P = (const h16*)(F.ws + WS_P);
    h16* RQ = (h16*)(F.ws + WS_QKV); h16* RK = RQ + (size_t)8 * S * 256; h16* RV = RK + (size_t)8 * S * 256; h16* RG = RV + (size_t)8 * S * 512;
    const f32x2* r128 = (const f32x2*)(F.ws + WS_ROPE128);
    for (int it = F.bid; it < 384; it += F.G) {
        const int blk = it / 12, part = it % 12;
        for (int i = 0; i < 32; ++i) {
            const int t = blk * 256 + F.wave * 32 + i;
            float v[16]; load16(P + (size_t)t * 12288 + part * 1024 + F.lane * 16, v);
            if (part <= 3) {
                const int head = (part & 1) * 4 + (F.lane >> 4), dl = (F.lane & 15) * 16, hi = (F.lane >> 3) & 1, j0 = (F.lane & 7) * 16;
                const f32x2* cs = r128 + (size_t)t * 128 + j0;
                const float scale = (part >= 2) ? 0.0625f : 1.0f;
#pragma unroll
                for (int e = 0; e < 16; ++e) {
                    const float o = __shfl_xor(v[e], 8); const f32x2 c = cs[e];
                    v[e] = (hi == 0 ? (v[e] * c[0] - o * c[1]) : (o * c[1] + v[e] * c[0])) * scale;
                }
                store16((part >= 2 ? RK : RQ) + ((size_t)head * S + t) * 256 + dl, v);
            } else if (part <= 7) {
                const int cs0 = (part - 4) * 1024 + F.lane * 16, head = cs0 >> 9, dv = cs0 & 511;
                store16(RV + ((size_t)head * S + t) * 512 + dv, v);
            } else {
                const int cs0 = (part - 8) * 1024 + F.lane * 16;
#pragma unroll
                for (int e = 0; e < 16; ++e) v[e] = silu_f(v[e]);
                store16(RG + (size_t)t * 4096 + cs0, v);
            }
        }
    }
}

__device__ __forceinline__ double gamma_of(int h) { return 1.0 - 1.0 / (double)(32 << h); }
__device__ __forceinline__ double dpow_int(double b, int n) { double p = 1.0; for (int i = 0; i < n; ++i) p *= b; return p; }

__device__ __forceinline__ void phase_ret_scan(const Frame& F) {
    const h16* RQ = (const h16*)(F.ws + WS_QKV); const h16* RK = RQ + (size_t)8 * S * 256; const h16* RV = RK + (size_t)8 * S * 256;
    h16* SB = (h16*)(F.ws + WS_P);
    float* ks = (float*)F.lds;
    h16* vs = (h16*)(F.lds + 32768);
    float* wd = (float*)(F.lds + 49152);
    for (int it = F.bid; it < 256; it += F.G) {
        const int h = it >> 5, dk0 = ((it >> 3) & 3) * 64, dv0 = (it & 7) * 64;
        const double gam = gamma_of(h);
        __syncthreads();
        if (F.tid < 128) wd[F.tid] = (float)dpow_int(gam, 127 - F.tid);
        const float carry = (float)dpow_int(gam, 128);
        const int tk = F.tid >> 3, tv = F.tid & 7;
        float st[8];
#pragma unroll
        for (int e = 0; e < 8; ++e) st[e] = 0.f;
        __syncthreads();
        for (int c = 0; c < 64; ++c) {
            { h16x8 o;
#pragma unroll
              for (int e = 0; e < 8; ++e) o[e] = (h16)st[e];
              *(h16x8*)(SB + (((size_t)h * 64 + c) * 256 + dk0 + tk) * 512 + dv0 + tv * 8) = o; }
            for (int i = F.tid; i < 128 * 8; i += NTHREADS) {
                const int j = i >> 3, c8 = (i & 7) * 8;
                const h16x8 kk = *(const h16x8*)(RK + ((size_t)h * S + c * 128 + j) * 256 + dk0 + c8);
                const h16x8 vv = *(const h16x8*)(RV + ((size_t)h * S + c * 128 + j) * 512 + dv0 + c8);
                const float w = wd[j];
#pragma unroll
                for (int e = 0; e < 8; ++e) ks[j * 64 + c8 + e] = (float)kk[e] * w;
                *(h16x8*)(vs + j * 64 + c8) = vv;
            }
            __syncthreads();
#pragma unroll
            for (int e = 0; e < 8; ++e) st[e] *= carry;
#pragma unroll 4
            for (int j = 0; j < 128; ++j) {
                const float kf = ks[j * 64 + tk]; const h16x8 vv = *(const h16x8*)(vs + j * 64 + tv * 8);
#pragma unroll
                for (int e = 0; e < 8; ++e) st[e] += kf * (float)vv[e];
            }
            __syncthreads();
        }
    }
}

__device__ __forceinline__ void phase_ret_out(const Frame& F) {
    const h16* RQ = (const h16*)(F.ws + WS_QKV); const h16* RK = RQ + (size_t)8 * S * 256; const h16* RV = RK + (size_t)8 * S * 256;
    const h16* SB = (const h16*)(F.ws + WS_P);
    float* OR_ = (float*)(F.ws + WS_OR);
    h16* Qs = (h16*)F.lds;
    float* AsT = (float*)(F.lds + 65536);
    float* rd = (float*)(F.lds + 131072);
    for (int it = F.bid; it < 512; it += F.G) {
        const int h = it >> 6, c = it & 63;
        const double gam = gamma_of(h);
        __syncthreads();
        if (F.tid < 130) rd[F.tid] = (float)dpow_int(gam, F.tid);
        for (int i = F.tid; i < 128 * 32; i += NTHREADS) {
            const int r = i >> 5, c8 = (i & 31) * 8;
            *(h16x8*)(Qs + r * 256 + c8) = *(const h16x8*)(RQ + ((size_t)h * S + c * 128 + r) * 256 + c8);
        }
        __syncthreads();
        {
            const int j = F.tid & 127, ig = F.tid >> 7;
            float acc[32];
#pragma unroll
            for (int ii = 0; ii < 32; ++ii) acc[ii] = 0.f;
            const h16* krow = RK + ((size_t)h * S + c * 128 + j) * 256;
            for (int d8 = 0; d8 < 32; ++d8) {
                const h16x8 kv = *(const h16x8*)(krow + d8 * 8);
                const h16x2 k0 = {kv[0], kv[1]}, k1 = {kv[2], kv[3]}, k2 = {kv[4], kv[5]}, k3 = {kv[6], kv[7]};
#pragma unroll
                for (int ii = 0; ii < 32; ++ii) {
                    const h16x8 qv = *(const h16x8*)(Qs + (ig * 32 + ii) * 256 + d8 * 8);
                    float a = acc[ii];
                    a = __builtin_amdgcn_fdot2((h16x2){qv[0], qv[1]}, k0, a, false); a = __builtin_amdgcn_fdot2((h16x2){qv[2], qv[3]}, k1, a, false);
                    a = __builtin_amdgcn_fdot2((h16x2){qv[4], qv[5]}, k2, a, false); a = __builtin_amdgcn_fdot2((h16x2){qv[6], qv[7]}, k3, a, false);
                    acc[ii] = a;
                }
            }
#pragma unroll
            for (int ii = 0; ii < 32; ++ii) { const int i = ig * 32 + ii; AsT[j * 128 + i] = (i >= j) ? acc[ii] * rd[i - j] : 0.f; }
        }
        __syncthreads();
        for (int i = F.tid; i < 128 * 32; i += NTHREADS) {
            const int r = i >> 5, c8 = (i & 31) * 8; const float w = rd[r + 1];
            h16x8 q = *(h16x8*)(Qs + r * 256 + c8);
#pragma unroll
            for (int e = 0; e < 8; ++e) q[e] = (h16)((float)q[e] * w);
            *(h16x8*)(Qs + r * 256 + c8) = q;
        }
        __syncthreads();
        {
            const int dv = F.tid;
            float acc[128];
#pragma unroll
            for (int i = 0; i < 128; ++i) acc[i] = 0.f;
            const h16* vcol = RV + ((size_t)h * S + c * 128) * 512 + dv;
            for (int j = 0; j < 128; ++j) {
                const float v = (float)vcol[(size_t)j * 512];
#pragma unroll
                for (int i4 = 0; i4 < 32; ++i4) {
                    const f32x4 a = *(const f32x4*)(AsT + j * 128 + i4 * 4);
                    acc[i4 * 4 + 0] += a[0] * v; acc[i4 * 4 + 1] += a[1] * v; acc[i4 * 4 + 2] += a[2] * v; acc[i4 * 4 + 3] += a[3] * v;
                }
            }
            const h16* scol = SB + (((size_t)h * 64 + c) * 256) * 512 + dv;
            for (int d8 = 0; d8 < 32; ++d8) {
                h16x2 s0, s1, s2, s3;
                s0[0] = scol[(size_t)(d8 * 8 + 0) * 512]; s0[1] = scol[(size_t)(d8 * 8 + 1) * 512]; s1[0] = scol[(size_t)(d8 * 8 + 2) * 512]; s1[1] = scol[(size_t)(d8 * 8 + 3) * 512];
                s2[0] = scol[(size_t)(d8 * 8 + 4) * 512]; s2[1] = scol[(size_t)(d8 * 8 + 5) * 512]; s3[0] = scol[(size_t)(d8 * 8 + 6) * 512]; s3[1] = scol[(size_t)(d8 * 8 + 7) * 512];
#pragma unroll
                for (int i = 0; i < 128; ++i) {
                    const h16x8 qv = *(const h16x8*)(Qs + i * 256 + d8 * 8);
                    float a = acc[i];
                    a = __builtin_amdgcn_fdot2((h16x2){qv[0], qv[1]}, s0, a, false); a = __builtin_amdgcn_fdot2((h16x2){qv[2], qv[3]}, s1, a, false);
                    a = __builtin_amdgcn_fdot2((h16x2){qv[4], qv[5]}, s2, a, false); a = __builtin_amdgcn_fdot2((h16x2){qv[6], qv[7]}, s3, a, false);
                    acc[i] = a;
                }
            }
#pragma unroll
            for (int i = 0; i < 128; ++i) OR_[(size_t)(c * 128 + i) * 4096 + h * 512 + dv] = acc[i];
        }
    }
    __syncthreads();
}

__device__ __forceinline__ void phase_ret_gn(const Frame& F) {
    const float* OR_ = (const float*)(F.ws + WS_OR);
    const h16* RG = (const h16*)(F.ws + WS_QKV) + (size_t)8 * S * 256 * 2 + (size_t)8 * S * 512;
    h16* OZ = (h16*)(F.ws + WS_OZ);
    for (int task = F.bid * 8 + F.wave; task < S * 8; task += F.G * 8) {
        const int t = task >> 3, h = task & 7;
        const size_t off = (size_t)t * 4096 + h * 512 + F.lane * 8;
        const f32x4 a = *(const f32x4*)(OR_ + off), b = *(const f32x4*)(OR_ + off + 4);
        float s = a[0] + a[1] + a[2] + a[3] + b[0] + b[1] + b[2] + b[3];
        s = wave_sum(s); const float mu = s * (1.0f / 512.0f);
        float q = 0.f;
#pragma unroll
        for (int e = 0; e < 4; ++e) { const float d0 = a[e] - mu, d1 = b[e] - mu; q += d0 * d0 + d1 * d1; }
        q = wave_sum(q); const float r = 1.0f / sqrtf(q * (1.0f / 512.0f) + EPS);
        const h16x8 gv = *(const h16x8*)(RG + off);
        h16x8 o;
#pragma unroll
        for (int e = 0; e < 4; ++e) { o[e] = (h16)((float)gv[e] * ((a[e] - mu) * r)); o[4 + e] = (h16)((float)gv[4 + e] * ((b[e] - mu) * r)); }
        *(h16x8*)(OZ + off) = o;
    }
}

__device__ __forceinline__ void phase_gemm(const Frame& F, const h16* A, const h16* Bt, int N, int K, void* O, int ldc, int f32out) {
    pg8::Gemm g{A, Bt, S, N, K}; pg8::StaticOrder So; So.init(S, N, F.G, F.bid);
    pg8::EpiStore E{O, ldc, f32out};
    pg8::gemm_phase<pg8::EpiStore, pg8::StaticOrder, true, true>((LAS unsigned char*)F.lds, g, So, E);
}

constexpr int NPHASE = 2 + 8 * DEPTH;
__host__ __device__ inline bool phase_exists(int p) {
    if (p < 2) return true;
    const int L = (p - 2) / 8, s = (p - 2) % 8, kind = L % 3;
    if (s == 7) return false;
    if (s == 2) return kind != 0;
    if (s == 4) return kind == 2;
    return true;
}

__global__ void __launch_bounds__(NTHREADS, 2) trunk_fwd(Args args) {
    extern __shared__ __attribute__((aligned(16))) unsigned char lds_raw[];
    Frame F;
    F.out = args.out; F.ws = args.ws; F.lds = (char*)lds_raw;
    F.tid = threadIdx.x; F.lane = F.tid & 63; F.wave = __builtin_amdgcn_readfirstlane(F.tid >> 6); F.G = gridDim.x; F.bid = blockIdx.x;
    volatile LAS unsigned* misc = (volatile LAS unsigned*)((LAS unsigned char*)lds_raw + MISC_OFF);
    if (F.tid < 16) misc[F.tid] = 0u;
    __syncthreads();
    XcdBarrier bar; bar.bar = (unsigned*)(F.ws + WS_CTL) + CW_BAR; bar.x = 0; bar.st = misc;
#if ONE_LAUNCH
    bar = xcd_barrier_post((unsigned*)(F.ws + WS_CTL) + CW_BAR, misc);
    cg::grid_group grid = cg::this_grid();
#endif
    const int lo = args.ph_lo, hi = args.ph_hi;
#if ONE_LAUNCH
    grid.sync();
#define SEAM(p) do { if ((p) > lo) xcd_barrier(bar); } while (0)
#else
#define SEAM(p) do { } while (0)
#endif
#define IN(p) (lo <= (p) && (p) < hi)
#ifndef PHMASK
#define PHMASK 0xFFFF
#endif
#define EN(b) ((PHMASK >> (b)) & 1)
    if (EN(0) && IN(0)) { SEAM(0); phase_prologue(F, args); }
    if (EN(1) && IN(1)) { SEAM(1); phase_norm(F, args, -1, 0); }
#define LAYER(L) do { \
        constexpr int kind = (L) % 3, base = 2 + 8 * (L); \
        constexpr int Nin = kind == 0 ? 8192 : (kind == 1 ? NSA_NP : 12288); \
        constexpr int Kout = kind == 2 ? 4096 : 2048; \
        if (EN(2) && IN(base + 0)) { SEAM(base + 0); phase_gemm(F, (const h16*)(F.ws + WS_H), (const h16*)(F.ws + WS_WTIN), Nin, 2048, F.ws + WS_P, Nin, 0); } \
        if (IN(base + 1)) { SEAM(base + 1); if (EN(3) && kind == 0) phase_moba_post(F); else if (EN(4) && kind == 1) phase_nsa_post(F); else if (EN(5) && kind == 2) phase_ret_post(F); } \
        if (kind != 0 && IN(base + 2)) { SEAM(base + 2); if (EN(6) && kind == 1) phase_nsa_cmp(F, args); else if (EN(7) && kind == 2) phase_ret_scan(F); } \
        if (IN(base + 3)) { SEAM(base + 3); if (EN(8) && kind == 0) { if (MOBA_MFMA) phase_moba_attn_mfma(F); else phase_moba_attn(F); } else if (EN(9) && kind == 1) { if (NSA_MFMA) phase_nsa_attn_mfma(F); else phase_nsa_attn(F); } else if (EN(10) && kind == 2) phase_ret_out(F); } \
        if (EN(11) && kind == 2 && IN(base + 4)) { SEAM(base + 4); phase_ret_gn(F); } \
        if (EN(2) && IN(base + 5)) { SEAM(base + 5); phase_gemm(F, (const h16*)(F.ws + WS_OZ), (const h16*)(F.ws + WS_WTOUT), 2048, Kout, F.ws + WS_Y, 2048, 1); } \
        if (EN(1) && IN(base + 6)) { SEAM(base + 6); phase_norm(F, args, (L), (L) + 1 < DEPTH ? (L) + 1 : -1); } \
    } while (0)
    LAYER(0); LAYER(1); LAYER(2); LAYER(3);
#undef LAYER
#undef EN
#undef IN
#undef SEAM
}

extern "C" void kernel_launch(void* const* d_in, const int* in_sizes, int n_in, void* d_out, int out_size, void* d_ws, size_t ws_size, hipStream_t stream) {
    static int grid = 0;
    if (grid == 0) {
        if (n_in != 18 || out_size != S * D || ws_size < WS_END) { fprintf(stderr, "kernel_launch: unexpected shapes (n_in %d, out %d, ws %zu)\n", n_in, out_size, ws_size); grid = -1; return; }
        int dev = 0, cus = 0, per_cu = 0;
        if (hipGetDevice(&dev) != hipSuccess || hipDeviceGetAttribute(&cus, hipDeviceAttributeMultiprocessorCount, dev) != hipSuccess) { grid = -1; return; }
        if (hipFuncSetAttribute((const void*)trunk_fwd, hipFuncAttributeMaxDynamicSharedMemorySize, LDS_BYTES) != hipSuccess) { fprintf(stderr, "kernel_launch: hipFuncSetAttribute failed\n"); grid = -1; return; }
        if (hipOccupancyMaxActiveBlocksPerMultiprocessor(&per_cu, (const void*)trunk_fwd, NTHREADS, LDS_BYTES) != hipSuccess || per_cu < 1) { fprintf(stderr, "kernel_launch: occupancy query says %d\n", per_cu); per_cu = 1; }
        (void)hipGetLastError();
        grid = cus;
    }
    if (grid < 0) return;
    (void)hipMemsetAsync((char*)d_ws + WS_CTL, 0, CTL_ZERO_BYTES, stream);
    Args a{};
    for (int i = 0; i < 18; ++i) a.in[i] = (const float*)d_in[i];
    a.out = (float*)d_out; a.ws = (unsigned char*)d_ws;
    for (int j = 0; j < 16; ++j) a.inv16[j] = pow(500000.0, -(double)j / 16.0);
    for (int j = 0; j < 128; ++j) a.inv128[j] = pow(10000.0, -(double)j / 128.0);
#if ONE_LAUNCH
    a.ph_lo = 0; a.ph_hi = NPHASE;
    void* kargs[] = {&a};
    hipError_t e = hipLaunchCooperativeKernel((const void*)trunk_fwd, dim3(grid), dim3(NTHREADS), kargs, LDS_BYTES, stream);
    if (e != hipSuccess) fprintf(stderr, "kernel_launch: cooperative launch failed: %s (grid %d)\n", hipGetErrorString(e), grid);
#else
    for (int p = 0; p < NPHASE; ++p) {
        if (!phase_exists(p)) continue;
        a.ph_lo = p; a.ph_hi = p + 1;
        hipLaunchKernelGGL(trunk_fwd, dim3(grid), dim3(NTHREADS), LDS_BYTES, stream, a);
    }
#endif
}
```

```cpp
#include <hip/hip_runtime.h>
#include <hip/hip_cooperative_groups.h>
#include <cstdio>
#include <cstdint>
#include <cmath>
namespace cg = cooperative_groups;

#ifndef ONE_LAUNCH
#define ONE_LAUNCH 1
#endif
#ifndef MOBA_MFMA
#define MOBA_MFMA 1
#endif
#ifndef NSA_MFMA
#define NSA_MFMA 1
#endif

#define LAS __attribute__((address_space(3)))
typedef _Float16 h16;
typedef _Float16 h16x2 __attribute__((ext_vector_type(2)));
typedef _Float16 h16x4 __attribute__((ext_vector_type(4)));
typedef _Float16 h16x8 __attribute__((ext_vector_type(8)));
typedef float f32x2 __attribute__((ext_vector_type(2)));
typedef float f32x4 __attribute__((ext_vector_type(4)));
typedef unsigned u32x4 __attribute__((ext_vector_type(4)));

constexpr int S = 8192, D = 2048, DEPTH = 4;
constexpr float EPS = 1e-6f;
constexpr float NEGF = -1e30f, BIGF = 1e30f;
constexpr int NSA_NP = 7424;
constexpr int NC = 511;

constexpr size_t MiB = 1u << 20;
constexpr size_t WS_CTL = 0, CTL_ZERO_BYTES = 1 * MiB;
constexpr size_t WS_MODP = 1 * MiB;
constexpr size_t WS_KMEAN = 1 * MiB + 768 * 1024;
constexpr size_t WS_GATES = 3 * MiB;
constexpr size_t WS_KCMP = 5 * MiB;
constexpr size_t WS_VCMP = 5 * MiB + 512 * 1024;
constexpr size_t WS_ROPE16 = 6 * MiB;
constexpr size_t WS_ROPE128 = 7 * MiB;
constexpr size_t WS_WTIN = 16 * MiB;
constexpr size_t WS_WTOUT = 64 * MiB;
constexpr size_t WS_H = 80 * MiB;
constexpr size_t WS_P = 112 * MiB;
constexpr size_t WS_QKV = 304 * MiB;
constexpr size_t WS_OZ = 496 * MiB;
constexpr size_t WS_Y = 560 * MiB;
constexpr size_t WS_OR = 624 * MiB;
constexpr size_t WS_END = 752 * MiB;

constexpr int LDS_BYTES = 147456;
constexpr int MISC_OFF = 135168;
constexpr int NTHREADS = 512;

struct Args {
    const float* in[18];
    float* out;
    unsigned char* ws;
    double inv16[16];
    double inv128[128];
    int ph_lo, ph_hi;
};

#define XB_TMO      128
#define XB_XCNT(j)  (256  + 64 * (j))
#define XB_XSUB(j)  (1280 + 64 * (j))
#define XB_XGEN(j)  (2304 + 64 * (j))
#define XB_TOP      3328
#define XB_TOPGEN   3392
#define XCD_BAR_WORDS 3456
#define XB_SPIN_CAP (1u << 24)
constexpr int CW_BAR = 4096;

__device__ __forceinline__ unsigned xb_ld(unsigned* p)              { return __hip_atomic_load(p, __ATOMIC_RELAXED, __HIP_MEMORY_SCOPE_AGENT); }
__device__ __forceinline__ unsigned xb_add(unsigned* p, unsigned v) { return __hip_atomic_fetch_add(p, v, __ATOMIC_RELAXED, __HIP_MEMORY_SCOPE_AGENT); }
__device__ __forceinline__ unsigned xb_xcc_id() { return (unsigned)__builtin_amdgcn_s_getreg((3 << 11) | 20) & 0xFu; }
#define XB_SPIN(cond, bar) do { unsigned _sp = 0; while (cond) { __builtin_amdgcn_s_sleep(1); \
    if ((++_sp & 255u) == 0u) { if (xb_ld(&(bar)[XB_TMO])) break; if (_sp > XB_SPIN_CAP) { atomicAdd(&(bar)[XB_TMO], 1u); break; } } } } while (0)

struct XcdBarrier { unsigned* bar; unsigned x; volatile LAS unsigned* st; };

__device__ __forceinline__ XcdBarrier xcd_barrier_post(unsigned* bar, volatile LAS unsigned* st) {
    XcdBarrier b; b.bar = bar; b.x = xb_xcc_id(); b.st = st;
    if (threadIdx.x == 0) (void)xb_add(&bar[XB_XCNT(b.x)], 1u);
    return b;
}
__device__ __forceinline__ void xcd_barrier_complete(unsigned* bar, unsigned x, unsigned& nloc, unsigned& nx) {
    const unsigned G = gridDim.x * gridDim.y * gridDim.z;
    unsigned sum, cnt, mine, sp = 0u;
    for (;;) {
        sum = 0u; cnt = 0u; mine = 0u;
#pragma unroll
        for (unsigned j = 0; j < 16; ++j) { const unsigned c = xb_ld(&bar[XB_XCNT(j)]); sum += c; cnt += (c > 0u) ? 1u : 0u; mine = (j == x) ? c : mine; }
        if (sum == G) break;
        __builtin_amdgcn_s_sleep(1);
        if ((++sp & 255u) == 0u) { if (xb_ld(&bar[XB_TMO])) break; if (sp > XB_SPIN_CAP) { atomicAdd(&bar[XB_TMO], 1u); break; } }
    }
    nloc = mine > 0u ? mine : 1u; nx = cnt > 0u ? cnt : 1u;
}
__device__ __forceinline__ void xcd_barrier(const XcdBarrier& b) {
    asm volatile("s_waitcnt vmcnt(0)" ::: "memory");
    __syncthreads();
    if (threadIdx.x == 0) {
        unsigned* bar = b.bar;
        __builtin_amdgcn_s_waitcnt(0);
        unsigned nloc = b.st[0], nx = b.st[1];
        if (nloc == 0u) { xcd_barrier_complete(bar, b.x, nloc, nx); b.st[0] = nloc; b.st[1] = nx; }
        const unsigned old = xb_add(&bar[XB_XSUB(b.x)], 1u);
        const unsigned gen = old / nloc;
        if (old + 1u == (gen + 1u) * nloc) {
            __builtin_amdgcn_fence(__ATOMIC_RELEASE, "agent");
            asm volatile("s_waitcnt vmcnt(0)" ::: "memory");
            const unsigned og = xb_add(&bar[XB_TOP], 1u);
            const unsigned tg = og / nx;
            if (og + 1u == (tg + 1u) * nx) xb_add(&bar[XB_TOPGEN], 1u);
            else XB_SPIN(xb_ld(&bar[XB_TOPGEN]) == tg, bar);
            __builtin_amdgcn_fence(__ATOMIC_ACQUIRE, "agent");
            xb_add(&bar[XB_XGEN(b.x)], 1u);
            asm volatile("s_waitcnt vmcnt(0)" ::: "memory");
        } else {
            XB_SPIN(xb_ld(&bar[XB_XGEN(b.x)]) == gen, bar);
            __builtin_amdgcn_fence(__ATOMIC_ACQUIRE, "agent");
            asm volatile("s_waitcnt vmcnt(0)" ::: "memory");
        }
    }
    __syncthreads();
}

namespace pg8 {
constexpr int BM = 256, BK = 64, HALF = 128, HTB = HALF * BK * 2, STAGE_BYTES = 8 * HTB, NXCD = 8, WGM = 8;
__host__ __device__ __forceinline__ int lds_byte(int r, int c) { const int st = (r >> 4) * 2 + (c >> 5), rr = r & 15, cc = c & 31, ob = rr * 64 + cc * 2; return st * 1024 + (ob ^ (((ob >> 9) & 1) << 5)); }
__host__ __device__ __forceinline__ void stage_rc(int b, int& R, int& C) { const int st = b / 1024, sb = b % 1024, swz = sb ^ (((sb >> 9) & 1) << 5); R = (st >> 1) * 16 + swz / 64; C = (st & 1) * 32 + (swz % 64) / 2; }
__host__ __device__ __forceinline__ int perm32(int rho) { const int n = rho >> 4, i = rho & 15; return 8 * (i >> 2) + 4 * n + (i & 3); }

struct Unit { int pm, pn; };
struct Gemm { const h16* A; const h16* Bt; int M, N, K; };

struct StaticOrder {
    int nM, nN, nwg, G, c;
    __host__ __device__ void init(int M, int N, int G_, int c_) { nM = M / BM; nN = N / BM; nwg = nM * nN; G = G_; c = c_; }
    __host__ __device__ bool next(int i, Unit& u) const {
        const long L = (long)i * G + c; if (L >= nwg) return false;
        int wgid = (int)L; { const int q = nwg / NXCD, r = nwg % NXCD, xcd = wgid % NXCD, off = wgid / NXCD; wgid = (xcd < r ? xcd * (q + 1) : r * (q + 1) + (xcd - r) * q) + off; }
        const int nig = WGM * nN, gid = wgid / nig, fm = gid * WGM, gsz = (nM - fm) < WGM ? (nM - fm) : WGM;
        u.pm = fm + ((wgid % nig) % gsz); u.pn = (wgid % nig) / gsz; return true;
    }
    __device__ __forceinline__ void a_ready(const Unit&) const {}
    __device__ __forceinline__ void done(const Unit&) const {}
};

struct EpiStore {
    static constexpr bool PERM = true, AFTER_DRAIN = false;
    void* O; int ldc; int f32out;
    __device__ __forceinline__ void operator()(const f32x4 (&acc)[2][2][4][2], const Unit& u, int wr, int wc, int fr, int fq) const {
        const int row0 = u.pm * BM + wr * 64 + fr, col0 = u.pn * BM + wc * 32 + 8 * fq;
#pragma unroll
        for (int ai = 0; ai < 2; ++ai)
#pragma unroll
            for (int m = 0; m < 4; ++m) {
                const size_t roff = (size_t)(row0 + ai * HALF + m * 16) * ldc + col0;
#pragma unroll
                for (int bj = 0; bj < 2; ++bj) {
                    const f32x4 v0 = acc[ai][bj][m][0], v1 = acc[ai][bj][m][1];
                    if (f32out) {
                        float* p = (float*)O + roff + bj * HALF;
                        *(f32x4*)p = v0; *(f32x4*)(p + 4) = v1;
                    } else {
                        h16x8 w; w[0] = (h16)v0[0]; w[1] = (h16)v0[1]; w[2] = (h16)v0[2]; w[3] = (h16)v0[3]; w[4] = (h16)v1[0]; w[5] = (h16)v1[1]; w[6] = (h16)v1[2]; w[7] = (h16)v1[3];
                        *(h16x8*)((h16*)O + roff + bj * HALF) = w;
                    }
                }
            }
    }
};

template <class Epi, class Sched, bool ALIGN_EPI = false, bool SP2 = false>
__device__ __forceinline__ void gemm_phase(LAS unsigned char* lds, const Gemm g, const Sched& S, const Epi& E) {
    const int tid = threadIdx.x, wid = __builtin_amdgcn_readfirstlane(tid >> 6), lane = tid & 63, wr = wid >> 2, wc = wid & 3, fr = lane & 15, fq = lane >> 4;
    const int K = g.K, nt = K / BK;
    unsigned voffA[2], voffB[2];
#pragma unroll
    for (int i = 0; i < 2; ++i) { int R, C; stage_rc(tid * 16 + i * 8192, R, C); const int Rb = Epi::PERM ? ((R & ~31) + perm32(R & 31)) : R;
        voffA[i] = (unsigned)(R * K + C) * 2u; voffB[i] = (unsigned)(Rb * K + C) * 2u; }
    const size_t kstep = (size_t)(BK * 2);
    const size_t hstep = (size_t)HALF * K * 2;
    const size_t tstep = 2 * hstep;
    const unsigned ldsw = (unsigned)wid * 1024u;
    const int aoff = lds_byte(wr * 64 + fr, fq * 8), boff = lds_byte(wc * 32 + fr, fq * 8);
#define PG8_SA(b, h) (((b) * 2 + (h)) * HTB)
#define PG8_SB(b, h) ((4 + (b) * 2 + (h)) * HTB)
#define PG8_STAGE(bufoff, gbase, voff) do { _Pragma("unroll") for (int _i = 0; _i < 2; ++_i) \
        __builtin_amdgcn_global_load_lds((const unsigned*)((const char*)(gbase) + (voff)[_i]), (LAS unsigned*)(lds + (bufoff) + ldsw + _i * 8192), 16, 0, 0); } while (0)
#define PG8_LDA(dst, b, h) do { _Pragma("unroll") for (int m = 0; m < 4; ++m) _Pragma("unroll") for (int k = 0; k < 2; ++k) dst[m][k] = *(const LAS h16x8*)(lds + PG8_SA(b, h) + aoff + m * 2048 + k * 1024); } while (0)
#define PG8_LDB(dst, b, h) do { _Pragma("unroll") for (int n = 0; n < 2; ++n) _Pragma("unroll") for (int k = 0; k < 2; ++k) dst[n][k] = *(const LAS h16x8*)(lds + PG8_SB(b, h) + boff + n * 2048 + k * 1024); } while (0)
#define PG8_MMA(ai, bj, At, Bt) do { __builtin_amdgcn_s_setprio(1); _Pragma("unroll") for (int m = 0; m < 4; ++m) _Pragma("unroll") for (int n = 0; n < 2; ++n) _Pragma("unroll") for (int k = 0; k < 2; ++k) \
        acc[ai][bj][m][n] = __builtin_amdgcn_mfma_f32_16x16x32_f16(Bt[n][k], At[m][k], acc[ai][bj][m][n], 0, 0, 0); __builtin_amdgcn_s_setprio(0); } while (0)
#define PG8_WAIT_V(n) asm volatile("s_waitcnt vmcnt(" #n ")" ::: "memory")
#define PG8_WAIT_L(n) asm volatile("s_waitcnt lgkmcnt(" #n ")" ::: "memory")
#define PG8_BAR __builtin_amdgcn_s_barrier()
#define PG8_SCHED __builtin_amdgcn_sched_barrier(0)
    Unit cur, nxt; int ui = 0;
    if (!S.next(0, cur)) return;
    f32x4 acc[2][2][4][2];
#pragma unroll
    for (int a = 0; a < 2; ++a)
#pragma unroll
        for (int b = 0; b < 2; ++b)
#pragma unroll
            for (int m = 0; m < 4; ++m)
#pragma unroll
                for (int n = 0; n < 2; ++n) acc[a][b][m][n] = (f32x4){0.f, 0.f, 0.f, 0.f};
    h16x8 At[4][2], B0[2][2], B1[2][2];
    const char* cA = (const char*)g.A + (size_t)cur.pm * tstep; const char* cB = (const char*)g.Bt + (size_t)cur.pn * tstep;
    S.a_ready(cur);
    if constexpr (SP2) {
        PG8_STAGE(PG8_SB(0, 0), cB, voffB); PG8_STAGE(PG8_SB(0, 1), cB + hstep, voffB); PG8_STAGE(PG8_SA(0, 0), cA, voffA); PG8_STAGE(PG8_SA(0, 1), cA + hstep, voffA);
        if (wr == 1) PG8_BAR;
        PG8_WAIT_V(2); PG8_BAR;
        PG8_STAGE(PG8_SB(1, 0), cB + kstep, voffB); PG8_STAGE(PG8_SA(1, 0), cA + kstep, voffA); PG8_STAGE(PG8_SB(1, 1), cB + hstep + kstep, voffB);
        PG8_WAIT_V(6); PG8_BAR;
    } else {
        PG8_STAGE(PG8_SB(0, 0), cB, voffB); PG8_STAGE(PG8_SA(0, 0), cA, voffA); PG8_STAGE(PG8_SB(0, 1), cB + hstep, voffB); PG8_STAGE(PG8_SA(0, 1), cA + hstep, voffA);
        if (wr == 1) PG8_BAR;
        PG8_WAIT_V(4); PG8_BAR;
        PG8_STAGE(PG8_SB(1, 0), cB + kstep, voffB); PG8_STAGE(PG8_SA(1, 0), cA + kstep, voffA); PG8_STAGE(PG8_SB(1, 1), cB + hstep + kstep, voffB);
        PG8_WAIT_V(6); PG8_BAR;
    }
    for (;;) {
        const bool has_next = S.next(ui + 1, nxt);
        const char* nA = has_next ? (const char*)g.A + (size_t)nxt.pm * tstep : cA; const char* nB = has_next ? (const char*)g.Bt + (size_t)nxt.pn * tstep : cB;
        for (int t = 0; t < nt; t += 2) {
            const bool last = (t == nt - 2);
            const char* a1 = cA + (size_t)(t + 1) * kstep;
            const char* a2 = last ? nA : cA + (size_t)(t + 2) * kstep; const char* b2 = last ? nB : cB + (size_t)(t + 2) * kstep;
            const char* a3 = a2 + kstep; const char* b3 = b2 + kstep;
            if (last && has_next) S.a_ready(nxt);
            if constexpr (SP2) {
            PG8_LDB(B0, 0, 0); PG8_LDB(B1, 0, 1); PG8_SCHED; PG8_LDA(At, 0, 0); PG8_STAGE(PG8_SA(1, 1), a1 + hstep, voffA);
            PG8_WAIT_V(8); PG8_WAIT_L(0); PG8_BAR; PG8_MMA(0, 0, At, B0); PG8_MMA(0, 1, At, B1); PG8_BAR; PG8_SCHED;
            PG8_LDA(At, 0, 1); PG8_STAGE(PG8_SB(0, 0), b2, voffB); PG8_STAGE(PG8_SB(0, 1), b2 + hstep, voffB); PG8_STAGE(PG8_SA(0, 0), a2, voffA);
            PG8_WAIT_V(8); PG8_WAIT_L(0); PG8_BAR; PG8_MMA(1, 0, At, B0); PG8_MMA(1, 1, At, B1); PG8_BAR; PG8_SCHED;
            PG8_LDB(B0, 1, 0); PG8_LDB(B1, 1, 1); PG8_SCHED; PG8_LDA(At, 1, 0); PG8_STAGE(PG8_SA(0, 1), a2 + hstep, voffA);
            PG8_WAIT_V(8); PG8_WAIT_L(0); PG8_BAR; PG8_MMA(0, 0, At, B0); PG8_MMA(0, 1, At, B1); PG8_BAR; PG8_SCHED;
            PG8_LDA(At, 1, 1); PG8_STAGE(PG8_SB(1, 0), b3, voffB); PG8_STAGE(PG8_SB(1, 1), b3 + hstep, voffB); PG8_STAGE(PG8_SA(1, 0), a3, voffA);
            PG8_WAIT_V(8); PG8_WAIT_L(0); PG8_BAR; PG8_MMA(1, 0, At, B0); PG8_MMA(1, 1, At, B1); PG8_BAR; PG8_SCHED;
            } else {
            PG8_LDB(B0, 0, 0); PG8_SCHED; PG8_LDA(At, 0, 0); PG8_STAGE(PG8_SA(1, 1), a1 + hstep, voffA);
            PG8_WAIT_L(8); PG8_BAR; PG8_WAIT_L(0); PG8_MMA(0, 0, At, B0); PG8_BAR; PG8_SCHED;
            PG8_LDB(B1, 0, 1); PG8_STAGE(PG8_SB(0, 0), b2, voffB);
            PG8_BAR; PG8_WAIT_L(0); PG8_MMA(0, 1, At, B1); PG8_BAR;
            PG8_LDA(At, 0, 1); PG8_STAGE(PG8_SA(0, 0), a2, voffA);
            PG8_BAR; PG8_WAIT_L(0); PG8_MMA(1, 0, At, B0); PG8_BAR; PG8_SCHED;
            PG8_STAGE(PG8_SB(0, 1), b2 + hstep, voffB);
            PG8_WAIT_V(6); PG8_BAR; PG8_MMA(1, 1, At, B1); PG8_BAR;
            PG8_LDB(B0, 1, 0); PG8_SCHED; PG8_LDA(At, 1, 0); PG8_STAGE(PG8_SA(0, 1), a2 + hstep, voffA);
            PG8_WAIT_L(8); PG8_BAR; PG8_WAIT_L(0); PG8_MMA(0, 0, At, B0); PG8_BAR; PG8_SCHED;
            PG8_LDB(B1, 1, 1); PG8_STAGE(PG8_SB(1, 0), b3, voffB);
            PG8_BAR; PG8_WAIT_L(0); PG8_MMA(0, 1, At, B1); PG8_BAR;
            PG8_LDA(At, 1, 1); PG8_STAGE(PG8_SA(1, 0), a3, voffA);
            PG8_BAR; PG8_WAIT_L(0); PG8_MMA(1, 0, At, B0); PG8_BAR; PG8_SCHED;
            PG8_STAGE(PG8_SB(1, 1), b3 + hstep, voffB);
            PG8_WAIT_V(6); PG8_BAR; PG8_MMA(1, 1, At, B1); PG8_BAR;
            }
        }
        if constexpr (ALIGN_EPI) { if (wr == 0) PG8_BAR; }
        if constexpr (!Epi::AFTER_DRAIN) { E(acc, cur, wr, wc, fr, fq); S.done(cur); }
        if (!has_next) break;
#pragma unroll
        for (int a = 0; a < 2; ++a)
#pragma unroll
            for (int b = 0; b < 2; ++b)
#pragma unroll
                for (int m = 0; m < 4; ++m)
#pragma unroll
                    for (int n = 0; n < 2; ++n) acc[a][b][m][n] = (f32x4){0.f, 0.f, 0.f, 0.f};
        cur = nxt; cA = nA; cB = nB; ++ui;
        if constexpr (ALIGN_EPI) { if (wr == 1) PG8_BAR; }
    }
    PG8_WAIT_V(0);
    if constexpr (!ALIGN_EPI) { if (wr == 0) PG8_BAR; }
    PG8_BAR;
#undef PG8_SA
#undef PG8_SB
#undef PG8_STAGE
#undef PG8_LDA
#undef PG8_LDB
#undef PG8_MMA
#undef PG8_WAIT_V
#undef PG8_WAIT_L
#undef PG8_BAR
#undef PG8_SCHED
}
}

struct Frame {
    float* out;
    unsigned char* ws;
    char* lds;
    int tid, lane, wave, G, bid;
};

__device__ __forceinline__ float silu_f(float x) { return x / (1.f + __expf(-x)); }
__device__ __forceinline__ float sigmoid_f(float x) { return 1.f / (1.f + __expf(-x)); }
__device__ __forceinline__ float wave_sum(float v) {
#pragma unroll
    for (int o = 32; o >= 1; o >>= 1) v += __shfl_xor(v, o);
    return v;
}
__device__ __forceinline__ float wave_max(float v) {
#pragma unroll
    for (int o = 32; o >= 1; o >>= 1) v = fmaxf(v, __shfl_xor(v, o));
    return v;
}
__device__ __forceinline__ void wave_lds_fence() { __builtin_amdgcn_wave_barrier(); asm volatile("s_waitcnt lgkmcnt(0)" ::: "memory"); __builtin_amdgcn_wave_barrier(); }

__device__ __forceinline__ void sincos_d(double x, float& c, float& s) {
    const double TWO_OVER_PI = 0.63661977236758134308;
    const double PIO2_HI = 1.57079632679489655800e+00, PIO2_LO = 6.12323399573676603587e-17;
    const double q = __builtin_rint(x * TWO_OVER_PI);
    double y = __builtin_fma(-q, PIO2_HI, x); y = __builtin_fma(-q, PIO2_LO, y);
    const double y2 = y * y;
    double sp = 1.0 / 6227020800.0;
    sp = sp * y2 - 1.0 / 39916800.0; sp = sp * y2 + 1.0 / 362880.0; sp = sp * y2 - 1.0 / 5040.0; sp = sp * y2 + 1.0 / 120.0; sp = sp * y2 - 1.0 / 6.0; sp = sp * y2 * y + y;
    double cp = -1.0 / 87178291200.0;
    cp = cp * y2 + 1.0 / 479001600.0; cp = cp * y2 - 1.0 / 3628800.0; cp = cp * y2 + 1.0 / 40320.0; cp = cp * y2 - 1.0 / 720.0; cp = cp * y2 + 1.0 / 24.0; cp = cp * y2 - 0.5; cp = cp * y2 + 1.0;
    const long long qi = (long long)q; const int quad = (int)(qi & 3);
    double sv, cv;
    if (quad == 0) { sv = sp; cv = cp; } else if (quad == 1) { sv = cp; cv = -sp; } else if (quad == 2) { sv = -sp; cv = -cp; } else { sv = -cp; cv = sp; }
    c = (float)cv; s = (float)sv;
}

__device__ __forceinline__ int nsa_src_col(int n) { return n < 5120 ? n : (n < 7168 ? n + 48 : (n < 7216 ? n - 2048 : -1)); }
__device__ __forceinline__ void conv_transpose(const Frame& F, const float* W, int K, int Nsrc, h16* Wt, int Npad, int mapmode, int item0, int& items_done) {
    float* tile = (float*)F.lds;
    const int tk_n = K / 64, tn_n = Npad / 64, ntiles = tk_n * tn_n;
    for (int it = F.bid; it < ntiles; it += F.G) {
        const int tk = it / tn_n, tn = it % tn_n;
        __syncthreads();
#pragma unroll
        for (int i = 0; i < 8; ++i) {
            const int idx = F.tid + i * NTHREADS, k = idx >> 6, n = idx & 63;
            const int nn = tn * 64 + n; const int src = mapmode ? nsa_src_col(nn) : nn;
            float v = 0.f; if (src >= 0 && src < Nsrc) v = W[(size_t)(tk * 64 + k) * Nsrc + src];
            tile[k * 65 + n] = v;
        }
        __syncthreads();
#pragma unroll
        for (int i = 0; i < 8; ++i) {
            const int idx = F.tid + i * NTHREADS, n = idx >> 6, k = idx & 63;
            Wt[(size_t)(tn * 64 + n) * K + tk * 64 + k] = (h16)tile[k * 65 + n];
        }
    }
    __syncthreads();
}
__device__ __forceinline__ void conv_layer_weights(const Frame& F, const Args& A, int L) {
    const int kind = L % 3, j = L / 3; int dummy = 0;
    h16* wtin = (h16*)(F.ws + WS_WTIN); h16* wtout = (h16*)(F.ws + WS_WTOUT);
    if (kind == 0) {
        conv_transpose(F, A.in[7] + (size_t)j * 2048 * 8192, 2048, 8192, wtin, 8192, 0, 0, dummy);
        conv_transpose(F, A.in[8] + (size_t)j * 2048 * 2048, 2048, 2048, wtout, 2048, 0, 0, dummy);
    } else if (kind == 1) {
        conv_transpose(F, A.in[9], 2048, 7216, wtin, NSA_NP, 1, 0, dummy);
        conv_transpose(F, A.in[10], 2048, 2048, wtout, 2048, 0, 0, dummy);
    } else {
        conv_transpose(F, A.in[16], 2048, 12288, wtin, 12288, 0, 0, dummy);
        conv_transpose(F, A.in[17], 4096, 2048, wtout, 2048, 0, 0, dummy);
    }
}

__device__ __forceinline__ void phase_prologue(const Frame& F, const Args& A) {
    {
        float* modp = (float*)(F.ws + WS_MODP);
        const float* c = A.in[1]; const float* aw = A.in[3];
        for (int it = F.bid; it < 384; it += F.G) {
            const int layer = it / 96, r = it % 96, slice = r / 12, nch = r % 12, n = nch * 512 + F.tid;
            const float* w = aw + (size_t)layer * 2048 * 6144 + (size_t)(slice * 256) * 6144 + n;
            float acc = 0.f;
#pragma unroll 8
            for (int k = 0; k < 256; ++k) acc += silu_f(c[slice * 256 + k]) * w[(size_t)k * 6144];
            modp[(size_t)(slice * 4 + layer) * 6144 + n] = acc;
        }
    }
    {
        const int* pos = (const int*)A.in[2];
        f32x2* r16 = (f32x2*)(F.ws + WS_ROPE16); f32x2* r128 = (f32x2*)(F.ws + WS_ROPE128);
        for (int idx = F.bid * NTHREADS + F.tid; idx < S * 16; idx += F.G * NTHREADS) {
            const int t = idx >> 4, j = idx & 15; float cs, sn; sincos_d((double)pos[t] * A.inv16[j], cs, sn); r16[idx] = (f32x2){cs, sn};
        }
        for (int idx = F.bid * NTHREADS + F.tid; idx < S * 128; idx += F.G * NTHREADS) {
            const int t = idx >> 7, j = idx & 127; float cs, sn; sincos_d((double)pos[t] * A.inv128[j], cs, sn); r128[idx] = (f32x2){cs, sn};
        }
    }
    conv_layer_weights(F, A, 0);
}

__device__ __forceinline__ void phase_norm(const Frame& F, const Args& A, int Lprev, int Lnext) {
    float* modl = (float*)F.lds;
    const float* modp = (const float*)(F.ws + WS_MODP); const float* ab = A.in[4];
    __syncthreads();
    for (int i = F.tid; i < 6144; i += NTHREADS) {
        const int which = i >> 11, col = i & 2047;
        int layer, mcol;
        if (which == 0) { layer = Lprev; mcol = 4096 + col; } else if (which == 1) { layer = Lnext; mcol = 2048 + col; } else { layer = Lnext; mcol = col; }
        float v = 0.f;
        if (layer >= 0) { v = ab[layer * 6144 + mcol];
#pragma unroll
            for (int s = 0; s < 8; ++s) v += modp[(size_t)(s * 4 + layer) * 6144 + mcol]; }
        modl[i] = v;
    }
    __syncthreads();
    const float* xin = (Lprev <= 0) ? A.in[0] : F.out;
    const float* Y = (const float*)(F.ws + WS_Y);
    h16* H = (h16*)(F.ws + WS_H);
    const float* npost = A.in[6] + (Lprev >= 0 ? Lprev : 0) * 2048;
    const float* npre = A.in[5] + (Lnext >= 0 ? Lnext : 0) * 2048;
    for (int t = F.bid * 8 + F.wave; t < S; t += F.G * 8) {
        f32x4 x[8];
#pragma unroll
        for (int i = 0; i < 8; ++i) x[i] = *(const f32x4*)(xin + (size_t)t * D + i * 256 + F.lane * 4);
        if (Lprev >= 0) {
            f32x4 y[8]; float ss = 0.f;
#pragma unroll
            for (int i = 0; i < 8; ++i) { y[i] = *(const f32x4*)(Y + (size_t)t * D + i * 256 + F.lane * 4); ss += y[i][0] * y[i][0] + y[i][1] * y[i][1] + y[i][2] * y[i][2] + y[i][3] * y[i][3]; }
            ss = wave_sum(ss);
            const float r = 1.0f / sqrtf(ss * (1.0f / D) + EPS);
#pragma unroll
            for (int i = 0; i < 8; ++i) {
                const int col = i * 256 + F.lane * 4;
                const f32x4 g = *(const f32x4*)(npost + col); const f32x4 gt = *(const f32x4*)(modl + col);
#pragma unroll
                for (int e = 0; e < 4; ++e) x[i][e] += gt[e] * (y[i][e] * r * g[e]);
                *(f32x4*)(F.out + (size_t)t * D + col) = x[i];
            }
        }
        if (Lnext >= 0) {
            float ss = 0.f;
#pragma unroll
            for (int i = 0; i < 8; ++i) ss += x[i][0] * x[i][0] + x[i][1] * x[i][1] + x[i][2] * x[i][2] + x[i][3] * x[i][3];
            ss = wave_sum(ss);
            const float r = 1.0f / sqrtf(ss * (1.0f / D) + EPS);
#pragma unroll
            for (int i = 0; i < 8; ++i) {
                const int col = i * 256 + F.lane * 4;
                const f32x4 g = *(const f32x4*)(npre + col); const f32x4 sc = *(const f32x4*)(modl + 2048 + col); const f32x4 sh = *(const f32x4*)(modl + 4096 + col);
                h16x4 hv;
#pragma unroll
                for (int e = 0; e < 4; ++e) hv[e] = (h16)((x[i][e] * r * g[e]) * (1.0f + sc[e]) + sh[e]);
                *(h16x4*)(H + (size_t)t * D + col) = hv;
            }
        }
    }
    if (Lnext > 0) conv_layer_weights(F, A, Lnext);
}

__device__ __forceinline__ void load16(const h16* p, float (&v)[16]) {
    const h16x8 a = *(const h16x8*)p, b = *(const h16x8*)(p + 8);
#pragma unroll
    for (int i = 0; i < 8; ++i) { v[i] = (float)a[i]; v[8 + i] = (float)b[i]; }
}
__device__ __forceinline__ void store16(h16* p, const float (&v)[16]) {
    h16x8 a, b;
#pragma unroll
    for (int i = 0; i < 8; ++i) { a[i] = (h16)v[i]; b[i] = (h16)v[8 + i]; }
    *(h16x8*)p = a; *(h16x8*)(p + 8) = b;
}
__device__ __forceinline__ void rope32(float (&v)[16], int d0, const f32x2* cs  ) {
#pragma unroll
    for (int i = 0; i < 16; ++i) {
        const float o = __shfl_xor(v[i], 1);
        if (d0 < 32) {
            const f32x2 c = cs[i];
            v[i] = (d0 == 0) ? (v[i] * c[0] - o * c[1]) : (o * c[1] + v[i] * c[0]);
        }
    }
}

__device__ __forceinline__ void phase_moba_post(const Frame& F) {
    const h16* P = (const h16*)(F.ws + WS_P);
    h16* Q = (h16*)(F.ws + WS_QKV); h16* K = Q + (size_t)16 * S * 128; h16* V = K + (size_t)16 * S * 128; h16* Z = V + (size_t)16 * S * 128;
    const f32x2* r16 = (const f32x2*)(F.ws + WS_ROPE16);
    float* kmean = (float*)(F.ws + WS_KMEAN);
    float* red = (float*)F.lds;
    for (int it = F.bid; it < 256; it += F.G) {
        const int blk = it >> 3, part = it & 7, sect = part >> 1;
        const int cs0 = (part & 1) * 1024 + F.lane * 16;
        const int head = cs0 >> 7, d0 = cs0 & 127;
        float ksum[16];
#pragma unroll
        for (int i = 0; i < 16; ++i) ksum[i] = 0.f;
        for (int i = 0; i < 32; ++i) {
            const int t = blk * 256 + F.wave * 32 + i;
            float v[16]; load16(P + (size_t)t * 8192 + part * 1024 + F.lane * 16, v);
            if (sect <= 1) {
                rope32(v, d0, r16 + (size_t)t * 16);
                if (sect == 0) {
#pragma unroll
                    for (int e = 0; e < 16; ++e) v[e] *= 0.08838834764831845f;
                    store16(Q + ((size_t)head * S + t) * 128 + d0, v);
                } else {
#pragma unroll
                    for (int e = 0; e < 16; ++e) ksum[e] += v[e];
                    store16(K + ((size_t)head * S + t) * 128 + d0, v);
                }
            } else if (sect == 2) {
                store16(V + ((size_t)head * S + t) * 128 + d0, v);
            } else {
#pragma unroll
                for (int e = 0; e < 16; ++e) v[e] = silu_f(v[e]);
                store16(Z + (size_t)t * 2048 + cs0, v);
            }
        }
        if (sect == 1) {
            __syncthreads();
#pragma unroll
            for (int e = 0; e < 16; ++e) red[F.wave * 1024 + F.lane * 16 + e] = ksum[e];
            __syncthreads();
            for (int c = F.tid; c < 1024; c += NTHREADS) {
                float s = 0.f;
#pragma unroll
                for (int w = 0; w < 8; ++w) s += red[w * 1024 + c];
                const int cc = (part & 1) * 1024 + c;
                kmean[((size_t)(cc >> 7) * 32 + blk) * 128 + (cc & 127)] = s * (1.0f / 256.0f);
            }
            __syncthreads();
        }
    }
}

__device__ __forceinline__ void wave_attend(const h16* __restrict__ K, const h16* __restrict__ V, int nslots, const int* starts, int limit,
                                            const float* qf, float* pbuf, int lane, float& o0, float& o1) {
    float sc[16]; float mx = NEGF;
#pragma unroll
    for (int k = 0; k < 16; ++k) {
        sc[k] = NEGF;
        if (k < nslots) {
            const int key = starts[k] + lane;
            if (key >= 0 && key <= limit) {
                const h16x8* kr = (const h16x8*)(K + (size_t)key * 128);
                float d = 0.f;
#pragma unroll
                for (int i = 0; i < 16; ++i) {
                    const h16x8 kv = kr[i]; const f32x4 qa = *(const f32x4*)(qf + i * 8), qb = *(const f32x4*)(qf + i * 8 + 4);
                    d += (float)kv[0] * qa[0] + (float)kv[1] * qa[1] + (float)kv[2] * qa[2] + (float)kv[3] * qa[3] + (float)kv[4] * qb[0] + (float)kv[5] * qb[1] + (float)kv[6] * qb[2] + (float)kv[7] * qb[3];
                }
                sc[k] = d;
            }
            mx = fmaxf(mx, sc[k]);
        }
    }
    mx = wave_max(mx);
    float sum = 0.f;
#pragma unroll
    for (int k = 0; k < 16; ++k) { const float p = (sc[k] > 0.5f * NEGF) ? __expf(sc[k] - mx) : 0.f; sc[k] = p; sum += p; }
    sum = wave_sum(sum);
    const float inv = 1.0f / fmaxf(sum, 1e-30f);
    wave_lds_fence();
#pragma unroll
    for (int k = 0; k < 16; ++k) if (k < nslots) pbuf[k * 64 + lane] = sc[k] * inv;
    wave_lds_fence();
    float a0 = 0.f, a1 = 0.f;
    for (int k = 0; k < nslots; ++k) {
        const int base = starts[k];
        for (int i = 0; i < 64; ++i) {
            const int key = base + i;
            if (key >= 0 && key <= limit) {
                const float p = pbuf[k * 64 + i];
                const h16x2 vv = *(const h16x2*)(V + (size_t)key * 128 + 2 * lane);
                a0 += p * (float)vv[0]; a1 += p * (float)vv[1];
            }
        }
    }
    o0 = a0; o1 = a1;
}

constexpr int WS_QF = 0, WS_PB = 2048, WS_PC = 6144, WS_SEL = 14336, WS_ST = 14848, WS_LIST = 14912;
constexpr int WSCR_STRIDE = 16384;

__device__ __forceinline__ void phase_moba_attn(const Frame& F) {
    const h16* Q = (const h16*)(F.ws + WS_QKV); const h16* K = Q + (size_t)16 * S * 128; const h16* V = K + (size_t)16 * S * 128; const h16* Z = V + (size_t)16 * S * 128;
    const float* kmean = (const float*)(F.ws + WS_KMEAN);
    h16* OZ = (h16*)(F.ws + WS_OZ);
    char* wl = F.lds + F.wave * WSCR_STRIDE;
    float* qf = (float*)(wl + WS_QF); float* pbuf = (float*)(wl + WS_PB); int* starts = (int*)(wl + WS_ST);
    const int lane = F.lane;
    for (int task = F.bid * 8 + F.wave; task < 16 * S; task += F.G * 8) {
        const int head = task >> 13, t = task & (S - 1), blk = t >> 8;
        wave_lds_fence();
        { const h16x2 qv = *(const h16x2*)(Q + ((size_t)head * S + t) * 128 + 2 * lane); qf[2 * lane] = (float)qv[0]; qf[2 * lane + 1] = (float)qv[1]; }
        wave_lds_fence();
        float gs = NEGF;
        if (lane < blk) {
            const float* km = kmean + ((size_t)head * 32 + lane) * 128; float d = 0.f;
#pragma unroll 8
            for (int i = 0; i < 128; ++i) d += qf[i] * km[i];
            gs = d;
        }
        int sel[3];
#pragma unroll
        for (int r = 0; r < 3; ++r) {
            float bv = gs; int bi = lane;
#pragma unroll
            for (int o = 32; o >= 1; o >>= 1) { const float ov = __shfl_xor(bv, o); const int oi = __shfl_xor(bi, o); if (ov > bv || (ov == bv && oi < bi)) { bv = ov; bi = oi; } }
            sel[r] = bi; if (lane == bi) gs = -3.0e38f;
        }
        const int nsel = blk < 3 ? blk : 3;
        if (lane < 16) {
            const int grp = lane >> 2, sub = lane & 3;
            const int b = (grp == 0) ? blk : (grp == 1 ? sel[0] : (grp == 2 ? sel[1] : sel[2]));
            starts[lane] = b * 256 + sub * 64;
        }
        wave_lds_fence();
        float o0, o1;
        wave_attend(K + (size_t)head * S * 128, V + (size_t)head * S * 128, 4 + 4 * nsel, starts, t, qf, pbuf, lane, o0, o1);
        const h16x2 zz = *(const h16x2*)(Z + (size_t)t * 2048 + head * 128 + 2 * lane);
        h16x2 ov; ov[0] = (h16)(o0 * (float)zz[0]); ov[1] = (h16)(o1 * (float)zz[1]);
        *(h16x2*)(OZ + (size_t)t * 2048 + head * 128 + 2 * lane) = ov;
    }
}

__device__ __forceinline__ void phase_nsa_post(const Frame& F) {
    const h16* P = (const h16*)(F.ws + WS_P);
    h16* Q = (h16*)(F.ws + WS_QKV); h16* KV = Q + (size_t)16 * S * 128;
    h16* Z = (h16*)(F.ws + WS_QKV + 96 * MiB);
    float* gates = (float*)(F.ws + WS_GATES);
    const f32x2* r16 = (const f32x2*)(F.ws + WS_ROPE16);
    for (int it = F.bid; it < 256; it += F.G) {
        const int blk = it >> 3, part = it & 7;
        for (int i = 0; i < 32; ++i) {
            const int t = blk * 256 + F.wave * 32 + i;
            float v[16]; load16(P + (size_t)t * NSA_NP + part * 1024 + F.lane * 16, v);
            if (part <= 1) {
                const int cs0 = part * 1024 + F.lane * 16, head = cs0 >> 7, d0 = cs0 & 127;
                rope32(v, d0, r16 + (size_t)t * 16);
#pragma unroll
                for (int e = 0; e < 16; ++e) v[e] *= 0.08838834764831845f;
                store16(Q + ((size_t)head * S + t) * 128 + d0, v);
            } else if (part <= 4) {
                const int x = part - 2, isv = F.lane >> 5, grp = (F.lane & 31) >> 3, d0 = (F.lane & 7) * 16;
                rope32(v, isv ? 64 : d0, r16 + (size_t)t * 16);
                store16(KV + ((size_t)(2 * x + isv) * 4 + grp) * S * 128 + (size_t)t * 128 + d0, v);
            } else if (part <= 6) {
                const int cs0 = (part - 5) * 1024 + F.lane * 16;
#pragma unroll
                for (int e = 0; e < 16; ++e) v[e] = silu_f(v[e]);
                store16(Z + (size_t)t * 2048 + cs0, v);
            } else {
                if (F.lane < 3) {
#pragma unroll
                    for (int e = 0; e < 16; ++e) gates[(size_t)t * 48 + F.lane * 16 + e] = sigmoid_f(v[e]);
                }
            }
        }
    }
}

__device__ __forceinline__ void phase_nsa_cmp(const Frame& F, const Args& A) {
    const h16* KVb = (const h16*)(F.ws + WS_QKV) + (size_t)16 * S * 128;
    const float* pe_g = A.in[11];
    h16* xs = (h16*)F.lds;
    float* pe = (float*)(F.lds + 36864);
    float* hid = (float*)(F.lds + 36864 + 16384);
    for (int it = F.bid; it < 512; it += F.G) {
        const int kv = it >> 8, g = (it >> 6) & 3, nb = it & 63;
        const h16* src = KVb + ((size_t)kv * 4 + g) * S * 128;
        const float* W1 = kv ? A.in[14] : A.in[12]; const float* W2 = kv ? A.in[15] : A.in[13];
        h16* dst = (h16*)(F.ws + (kv ? WS_VCMP : WS_KCMP)) + (size_t)g * 512 * 128;
        __syncthreads();
        for (int i = F.tid; i < 144 * 16; i += NTHREADS) {
            const int r = i >> 4, c8 = (i & 15) * 8, tok = nb * 128 + r;
            h16x8 v;
#pragma unroll
            for (int e = 0; e < 8; ++e) v[e] = (h16)0.f;
            if (tok < S) v = *(const h16x8*)(src + (size_t)tok * 128 + c8);
            *(h16x8*)(xs + r * 128 + c8) = v;
        }
        for (int i = F.tid; i < 4096; i += NTHREADS) pe[i] = pe_g[i];
        __syncthreads();
        {
            const int j = F.tid & 255, rh = F.tid >> 8;
            float acc[4] = {0.f, 0.f, 0.f, 0.f};
            for (int pos = 0; pos < 32; ++pos) {
#pragma unroll 4
                for (int d = 0; d < 128; ++d) {
                    const float w = W1[(size_t)(pos * 128 + d) * 256 + j]; const float pv = pe[pos * 128 + d];
#pragma unroll
                    for (int rr = 0; rr < 4; ++rr) acc[rr] += ((float)xs[(16 * (rh * 4 + rr) + pos) * 128 + d] + pv) * w;
                }
            }
#pragma unroll
            for (int rr = 0; rr < 4; ++rr) hid[(rh * 4 + rr) * 256 + j] = silu_f(acc[rr]);
        }
        __syncthreads();
        {
            const int d = F.tid & 127, rq = F.tid >> 7;
            float a0 = 0.f, a1 = 0.f;
#pragma unroll 4
            for (int j = 0; j < 256; ++j) { const float w = W2[j * 128 + d]; a0 += hid[rq * 256 + j] * w; a1 += hid[(rq + 4) * 256 + j] * w; }
            const int n0 = nb * 8 + rq, n1 = nb * 8 + rq + 4;
            dst[(size_t)n0 * 128 + d] = (n0 < NC) ? (h16)a0 : (h16)0.f; dst[(size_t)n1 * 128 + d] = (n1 < NC) ? (h16)a1 : (h16)0.f;
        }
    }
    __syncthreads();
}

__device__ __forceinline__ void phase_nsa_attn(const Frame& F) {
    const h16* Q = (const h16*)(F.ws + WS_QKV); const h16* KVb = Q + (size_t)16 * S * 128;
    const h16* Z = (const h16*)(F.ws + WS_QKV + 96 * MiB);
    const float* gates = (const float*)(F.ws + WS_GATES);
    const h16* KCMP = (const h16*)(F.ws + WS_KCMP); const h16* VCMP = (const h16*)(F.ws + WS_VCMP);
    h16* OZ = (h16*)(F.ws + WS_OZ);
    char* wl = F.lds + F.wave * WSCR_STRIDE;
    float* qf = (float*)(wl + WS_QF); float* pbuf = (float*)(wl + WS_PB); float* pc = (float*)(wl + WS_PC);
    float* selbuf = (float*)(wl + WS_SEL); int* starts = (int*)(wl + WS_ST); int* list = (int*)(wl + WS_LIST);
    const int lane = F.lane;
    for (int task = F.bid * 8 + F.wave; task < 4 * S; task += F.G * 8) {
        const int g = task >> 13, t = task & (S - 1);
        wave_lds_fence();
#pragma unroll
        for (int hh = 0; hh < 4; ++hh) { const h16x2 qv = *(const h16x2*)(Q + ((size_t)(4 * g + hh) * S + t) * 128 + 2 * lane); qf[hh * 128 + 2 * lane] = (float)qv[0]; qf[hh * 128 + 2 * lane + 1] = (float)qv[1]; }
        if (lane < 8) starts[lane] = lane * 64;
        wave_lds_fence();
        float acc0[4], acc1[4];
        const int nvalid = (t >= 31) ? (((t - 31) >> 4) + 1 < NC ? ((t - 31) >> 4) + 1 : NC) : 0;
#pragma unroll
        for (int hh = 0; hh < 4; ++hh) {
            float o0, o1;
            wave_attend(KCMP + (size_t)g * 512 * 128, VCMP + (size_t)g * 512 * 128, 8, starts, nvalid - 1, qf + hh * 128, pc + hh * 512, lane, o0, o1);
            const float g0 = gates[(size_t)t * 48 + (4 * g + hh) * 3 + 0];
            acc0[hh] = g0 * o0; acc1[hh] = g0 * o1;
        }
        wave_lds_fence();
        const int cur = t >> 6;
        float myv[2];
#pragma unroll
        for (int c = 0; c < 2; ++c) {
            const int s = lane + 64 * c; float imp = 0.f;
#pragma unroll
            for (int hh = 0; hh < 4; ++hh) {
                const float* p = pc + hh * 512 + 4 * s;
                const float pm1 = (s > 0) ? p[-1] : 0.f;
                imp += 0.5f * pm1 + p[0] + p[1] + p[2] + 0.5f * p[3];
            }
            const bool valid = s <= cur, forced = (s == 0) || (s == cur) || (s == cur - 1);
            myv[c] = valid ? (forced ? BIGF : imp) : NEGF;
            selbuf[s] = myv[c];
        }
        wave_lds_fence();
        int rank0 = 0, rank1 = 0;
        for (int s2 = 0; s2 < 128; ++s2) {
            const float v2 = selbuf[s2];
            rank0 += (v2 > myv[0] || (v2 == myv[0] && s2 < lane)) ? 1 : 0;
            rank1 += (v2 > myv[1] || (v2 == myv[1] && s2 < lane + 64)) ? 1 : 0;
        }
        const bool sel0 = rank0 < 16 && lane <= cur, sel1 = rank1 < 16 && (lane + 64) <= cur;
        const unsigned long long m0 = __ballot(sel0), m1 = __ballot(sel1);
        const int n0 = __popcll(m0), nsel = n0 + __popcll(m1);
        const unsigned long long below = (lane == 0) ? 0ull : (~0ull >> (64 - lane));
        if (sel0) list[__popcll(m0 & below)] = lane;
        if (sel1) list[n0 + __popcll(m1 & below)] = lane + 64;
        wave_lds_fence();
        if (lane < 16) starts[lane] = (lane < nsel) ? list[lane] * 64 : 0;
        wave_lds_fence();
#pragma unroll
        for (int hh = 0; hh < 4; ++hh) {
            float o0, o1;
            wave_attend(KVb + ((size_t)2 * 4 + g) * S * 128, KVb + ((size_t)3 * 4 + g) * S * 128, nsel, starts, t, qf + hh * 128, pbuf, lane, o0, o1);
            const float g1 = gates[(size_t)t * 48 + (4 * g + hh) * 3 + 1];
            acc0[hh] += g1 * o0; acc1[hh] += g1 * o1;
        }
        wave_lds_fence();
        if (lane < 8) starts[lane] = t - 511 + lane * 64;
        wave_lds_fence();
#pragma unroll
        for (int hh = 0; hh < 4; ++hh) {
            float o0, o1;
            wave_attend(KVb + ((size_t)4 * 4 + g) * S * 128, KVb + ((size_t)5 * 4 + g) * S * 128, 8, starts, t, qf + hh * 128, pbuf, lane, o0, o1);
            const float g2 = gates[(size_t)t * 48 + (4 * g + hh) * 3 + 2];
            acc0[hh] += g2 * o0; acc1[hh] += g2 * o1;
        }
#pragma unroll
        for (int hh = 0; hh < 4; ++hh) {
            const int col = (4 * g + hh) * 128 + 2 * lane;
            const h16x2 zz = *(const h16x2*)(Z + (size_t)t * 2048 + col);
            h16x2 ov; ov[0] = (h16)(acc0[hh] * (float)zz[0]); ov[1] = (h16)(acc1[hh] * (float)zz[1]);
            *(h16x2*)(OZ + (size_t)t * 2048 + col) = ov;
        }
    }
}


namespace fa {
typedef float f32x16 __attribute__((ext_vector_type(16)));
typedef unsigned u32x2 __attribute__((ext_vector_type(2)));
constexpr float LOG2E = 1.4426950408889634f;
constexpr int KROW = 272, VROW = 320;
constexpr int KT_BYTES = 64 * KROW, BUF_BYTES = KT_BYTES + 64 * VROW;
typedef short s16x4v __attribute__((__vector_size__(4 * sizeof(short))));
constexpr int LDS_IMP = 2 * BUF_BYTES;
constexpr int LDS_SELW = LDS_IMP + 32768;
constexpr int LDS_SV = LDS_SELW + 1024;
static_assert(LDS_SV + 4096 <= MISC_OFF, "attention LDS map");

struct Stage { u32x4 k[2], v[2]; };
__device__ __forceinline__ void stage_load(Stage& st, const h16* Kg, const h16* VTg, int j, int tid) {
    asm volatile("" : "+v"(tid));
#pragma unroll
    for (int i = 0; i < 2; ++i) { const int idx = tid + 512 * i;
        st.k[i] = *(const u32x4*)(Kg + (size_t)(j * 64 + (idx >> 4)) * 128 + (idx & 15) * 8);
        st.v[i] = *(const u32x4*)(VTg + (size_t)(j * 64 + (idx >> 4)) * 128 + (idx & 15) * 8); }
}
__device__ __forceinline__ void stage_write(const Stage& st, LAS unsigned char* buf, int tid) {
    asm volatile("" : "+v"(tid));
#pragma unroll
    for (int i = 0; i < 2; ++i) { const int idx = tid + 512 * i;
        *(LAS u32x4*)(buf + (idx >> 4) * KROW + (idx & 15) * 16) = st.k[i];
        *(LAS u32x4*)(buf + KT_BYTES + (idx >> 4) * VROW + (idx & 15) * 16) = st.v[i]; }
}

template <int MODE>
__device__ __forceinline__ void tile_compute(const LAS unsigned char* buf, int j, const h16x8 (&qf)[8], f32x16 (&o)[4], float& m, float& l,
                                             bool on, int lo, int hi, int lane, float inv_l, LAS float* imp_q) {
    const int r31 = lane & 31, h = lane >> 5, k0 = j * 64;
    const bool need = on && (k0 <= hi) && (k0 + 63 >= lo);
    if (__ballot(need) == 0ull) return;
    f32x16 s0, s1;
#pragma unroll
    for (int r = 0; r < 16; ++r) { s0[r] = 0.f; s1[r] = 0.f; }
    const LAS unsigned char* kp = buf + r31 * KROW + h * 16;
#pragma unroll
    for (int s = 0; s < 8; ++s) {
        const h16x8 a0 = *(const LAS h16x8*)(kp + s * 32);
        const h16x8 a1 = *(const LAS h16x8*)(kp + 32 * KROW + s * 32);
        s0 = __builtin_amdgcn_mfma_f32_32x32x16_f16(a0, qf[s], s0, 0, 0, 0);
        s1 = __builtin_amdgcn_mfma_f32_32x32x16_f16(a1, qf[s], s1, 0, 0, 0);
        if ((s & 1) == 1) __builtin_amdgcn_sched_barrier(0);
    }
    float tmax = NEGF;
#pragma unroll
    for (int r = 0; r < 16; ++r) {
        const int key0 = k0 + (r & 3) + 8 * (r >> 2) + 4 * h, key1 = key0 + 32;
        const bool v0 = on && key0 >= lo && key0 <= hi, v1 = on && key1 >= lo && key1 <= hi;
        s0[r] = v0 ? s0[r] * LOG2E : NEGF; s1[r] = v1 ? s1[r] * LOG2E : NEGF;
        tmax = fmaxf(tmax, fmaxf(s0[r], s1[r]));
    }
    if (MODE != 2) {
        tmax = fmaxf(tmax, __shfl_xor(tmax, 32));
        const float m_new = fmaxf(m, tmax);
        const float alpha = __builtin_amdgcn_exp2f(m - m_new);
        float sum = 0.f;
#pragma unroll
        for (int r = 0; r < 16; ++r) {
            s0[r] = (s0[r] > 0.5f * NEGF) ? __builtin_amdgcn_exp2f(s0[r] - m_new) : 0.f;
            s1[r] = (s1[r] > 0.5f * NEGF) ? __builtin_amdgcn_exp2f(s1[r] - m_new) : 0.f;
            sum += s0[r] + s1[r];
        }
        l = l * alpha + sum; m = m_new;
        if (MODE == 1) return;
#pragma unroll
        for (int dt = 0; dt < 4; ++dt) o[dt] = o[dt] * alpha;
    } else {
#pragma unroll
        for (int r = 0; r < 16; ++r) {
            s0[r] = (s0[r] > 0.5f * NEGF) ? __builtin_amdgcn_exp2f(s0[r] - m) * inv_l : 0.f;
            s1[r] = (s1[r] > 0.5f * NEGF) ? __builtin_amdgcn_exp2f(s1[r] - m) * inv_l : 0.f;
        }
#pragma unroll
        for (int c = 0; c < 4; ++c) {
            const int sa = 16 * j + 2 * c + h, sb = sa + 8;
            const float a0 = s0[4 * c] + s0[4 * c + 1] + s0[4 * c + 2] + 0.5f * s0[4 * c + 3], b0 = 0.5f * s0[4 * c + 3];
            const float a1 = s1[4 * c] + s1[4 * c + 1] + s1[4 * c + 2] + 0.5f * s1[4 * c + 3], b1 = 0.5f * s1[4 * c + 3];
            (void)__hip_atomic_fetch_add(imp_q + sa, a0, __ATOMIC_RELAXED, __HIP_MEMORY_SCOPE_WORKGROUP); if (sa + 1 < 128) (void)__hip_atomic_fetch_add(imp_q + sa + 1, b0, __ATOMIC_RELAXED, __HIP_MEMORY_SCOPE_WORKGROUP);
            (void)__hip_atomic_fetch_add(imp_q + sb, a1, __ATOMIC_RELAXED, __HIP_MEMORY_SCOPE_WORKGROUP); if (sb + 1 < 128) (void)__hip_atomic_fetch_add(imp_q + sb + 1, b1, __ATOMIC_RELAXED, __HIP_MEMORY_SCOPE_WORKGROUP);
        }
    }
    h16x8 pb[2][2];
#pragma unroll
    for (int sp = 0; sp < 2; ++sp)
#pragma unroll
        for (int jj = 0; jj < 8; ++jj) { pb[0][sp][jj] = (h16)s0[8 * sp + jj]; pb[1][sp][jj] = (h16)s1[8 * sp + jj]; }
    const LAS unsigned char* vbase = buf + KT_BYTES + (4 * h + ((lane & 15) >> 2)) * VROW + (16 * ((lane >> 4) & 1) + 4 * (lane & 3)) * 2;
#pragma unroll
    for (int dt = 0; dt < 4; ++dt) {
#pragma unroll
        for (int sub = 0; sub < 2; ++sub)
#pragma unroll
            for (int sp = 0; sp < 2; ++sp) {
                const LAS unsigned char* vp = vbase + (32 * sub + 16 * sp) * VROW + 64 * dt;
                const s16x4v lo4 = __builtin_amdgcn_ds_read_tr16_b64_v4i16((LAS s16x4v*)vp), hi4 = __builtin_amdgcn_ds_read_tr16_b64_v4i16((LAS s16x4v*)(vp + 8 * VROW));
                const h16x4 l4 = __builtin_bit_cast(h16x4, lo4), h4 = __builtin_bit_cast(h16x4, hi4);
                h16x8 va; va[0] = l4[0]; va[1] = l4[1]; va[2] = l4[2]; va[3] = l4[3]; va[4] = h4[0]; va[5] = h4[1]; va[6] = h4[2]; va[7] = h4[3];
                o[dt] = __builtin_amdgcn_mfma_f32_32x32x16_f16(va, pb[sub][sp], o[dt], 0, 0, 0);
            }
        __builtin_amdgcn_sched_barrier(0);
    }
}

template <int MODE, class OnFn>
__device__ __forceinline__ void stream(LAS unsigned char* lds, const h16* Kg, const h16* VTg, int jlo, int jhi, const h16x8 (&qf)[8],
                                       f32x16 (&o)[4], float& m, float& l, int lo, int hi, const OnFn& on_fn, int tid, int lane, float inv_l, LAS float* imp_q) {
    if (jlo >= jhi) return;
    Stage st;
    stage_load(st, Kg, VTg, jlo, tid);
    stage_write(st, lds, tid);
    __syncthreads();
    for (int j = jlo; j < jhi; ++j) {
        const int cur = (j - jlo) & 1;
        if (j + 1 < jhi) stage_load(st, Kg, VTg, j + 1, tid);
        tile_compute<MODE>(lds + cur * BUF_BYTES, j, qf, o, m, l, on_fn(j), lo, hi, lane, inv_l, imp_q);
        if (j + 1 < jhi) stage_write(st, lds + (cur ^ 1) * BUF_BYTES, tid);
        __syncthreads();
    }
}

__device__ __forceinline__ void load_q(h16x8 (&qf)[8], const h16* qrow, int h) {
#pragma unroll
    for (int s = 0; s < 8; ++s) qf[s] = *(const h16x8*)(qrow + 16 * s + 8 * h);
}
__device__ __forceinline__ void zero_o(f32x16 (&o)[4]) {
#pragma unroll
    for (int dt = 0; dt < 4; ++dt)
#pragma unroll
        for (int r = 0; r < 16; ++r) o[dt][r] = 0.f;
}
}

struct MobaOn { unsigned selmask; int b; __device__ __forceinline__ bool operator()(int j) const { const int jb = j >> 2; return jb == b ? true : (((selmask >> jb) & 1u) != 0u); } };
__device__ __forceinline__ void phase_moba_attn_mfma(const Frame& F) {
    const h16* Q = (const h16*)(F.ws + WS_QKV); const h16* K = Q + (size_t)16 * S * 128; const h16* VT = K + (size_t)16 * S * 128; const h16* Z = VT + (size_t)16 * S * 128;
    const float* kmean = (const float*)(F.ws + WS_KMEAN);
    h16* OZ = (h16*)(F.ws + WS_OZ);
    LAS unsigned char* lds = (LAS unsigned char*)F.lds;
    const int lane = F.lane, r31 = lane & 31, h = lane >> 5;
    for (int it = F.bid; it < 256; it += F.G) {
        const int head = it >> 4, pi = it & 15;
#pragma unroll 1
        for (int half = 0; half < 2; ++half) {
            const int b = half ? 31 - pi : pi;
            const int t = b * 256 + F.wave * 32 + r31;
            h16x8 qf[8]; fa::load_q(qf, Q + ((size_t)head * S + t) * 128, h);
            float v0 = NEGF, v1 = NEGF, v2 = NEGF; int i0 = -1, i1 = -1, i2 = -1;
            for (int jb = 0; jb < b; ++jb) {
                const float* km = kmean + ((size_t)head * 32 + jb) * 128 + 8 * h;
                float d = 0.f;
#pragma unroll
                for (int s = 0; s < 8; ++s) { const f32x4 ka = *(const f32x4*)(km + 16 * s), kb = *(const f32x4*)(km + 16 * s + 4);
                    d += (float)qf[s][0] * ka[0] + (float)qf[s][1] * ka[1] + (float)qf[s][2] * ka[2] + (float)qf[s][3] * ka[3] + (float)qf[s][4] * kb[0] + (float)qf[s][5] * kb[1] + (float)qf[s][6] * kb[2] + (float)qf[s][7] * kb[3]; }
                d += __shfl_xor(d, 32);
                if (d > v0) { v2 = v1; i2 = i1; v1 = v0; i1 = i0; v0 = d; i0 = jb; }
                else if (d > v1) { v2 = v1; i2 = i1; v1 = d; i1 = jb; }
                else if (d > v2) { v2 = d; i2 = jb; }
            }
            MobaOn on; on.b = b; on.selmask = (i0 >= 0 ? 1u << i0 : 0u) | (i1 >= 0 ? 1u << i1 : 0u) | (i2 >= 0 ? 1u << i2 : 0u);
            fa::f32x16 o[4]; fa::zero_o(o); float m = NEGF, l = 0.f;
            fa::stream<0>(lds, K + (size_t)head * S * 128, VT + (size_t)head * S * 128, 0, 4 * b + 4, qf, o, m, l, 0, t, on, F.tid, lane, 0.f, (LAS float*)nullptr);
            l += __shfl_xor(l, 32);
            const float inv = 1.0f / fmaxf(l, 1e-30f);
#pragma unroll
            for (int dt = 0; dt < 4; ++dt)
#pragma unroll
                for (int c = 0; c < 4; ++c) {
                    const int d = 32 * dt + 8 * c + 4 * h; const size_t off = (size_t)t * 2048 + head * 128 + d;
                    const h16x4 zz = *(const h16x4*)(Z + off); h16x4 ov;
#pragma unroll
                    for (int e = 0; e < 4; ++e) ov[e] = (h16)(o[dt][4 * c + e] * inv * (float)zz[e]);
                    *(h16x4*)(OZ + off) = ov;
                }
        }
    }
}

struct AllOn { __device__ __forceinline__ bool operator()(int) const { return true; } };
struct SelOn { const LAS unsigned* w; __device__ __forceinline__ bool operator()(int j) const { return ((w[j >> 5] >> (j & 31)) & 1u) != 0u; } };
__device__ __forceinline__ void phase_nsa_attn_mfma(const Frame& F) {
    const h16* Q = (const h16*)(F.ws + WS_QKV); const h16* KVb = Q + (size_t)16 * S * 128;
    const h16* Z = (const h16*)(F.ws + WS_QKV + 96 * MiB);
    const float* gates = (const float*)(F.ws + WS_GATES);
    const h16* KCMP = (const h16*)(F.ws + WS_KCMP); const h16* VCMPT = (const h16*)(F.ws + WS_VCMP);
    h16* OZ = (h16*)(F.ws + WS_OZ);
    LAS unsigned char* lds = (LAS unsigned char*)F.lds;
    LAS float* imp = (LAS float*)(lds + fa::LDS_IMP); LAS unsigned* selw = (LAS unsigned*)(lds + fa::LDS_SELW); LAS float* sv = (LAS float*)(lds + fa::LDS_SV) + F.wave * 128;
    const int lane = F.lane, r31 = lane & 31, h = lane >> 5, hh = F.wave & 3, qsub = F.wave >> 2;
    for (int it = F.bid; it < 256; it += F.G) {
        const int g = it >> 6, pi = it & 63, head = 4 * g + hh;
#pragma unroll 1
        for (int half = 0; half < 2; ++half) {
            const int c64 = half ? 127 - pi : pi;
            const int ql = 32 * qsub + r31, t = c64 * 64 + ql;
            h16x8 qf[8]; fa::load_q(qf, Q + ((size_t)head * S + t) * 128, h);
            fa::f32x16 o[4]; float m, l;
            for (int i = F.tid; i < 64 * 128; i += NTHREADS) imp[i] = 0.f;
            const int nval = (t >= 31) ? (((t - 31) >> 4) + 1 < NC ? ((t - 31) >> 4) + 1 : NC) : 0;
            const int tl = c64 * 64 + 63; const int nval_max = (tl >= 31) ? (((tl - 31) >> 4) + 1 < NC ? ((tl - 31) >> 4) + 1 : NC) : 0;
            const int jc = (nval_max + 63) >> 6;
            fa::zero_o(o); m = NEGF; l = 0.f;
            fa::stream<1>(lds, KCMP + (size_t)g * 512 * 128, VCMPT + (size_t)g * 512 * 128, 0, jc, qf, o, m, l, 0, nval - 1, AllOn(), F.tid, lane, 0.f, (LAS float*)nullptr);
            l += __shfl_xor(l, 32);
            { const float invl = 1.0f / fmaxf(l, 1e-30f); float l2 = 0.f;
              fa::stream<2>(lds, KCMP + (size_t)g * 512 * 128, VCMPT + (size_t)g * 512 * 128, 0, jc, qf, o, m, l2, 0, nval - 1, AllOn(), F.tid, lane, invl, imp + ql * 128); }
            const float g0 = gates[(size_t)t * 48 + head * 3 + 0];
#pragma unroll
            for (int dt = 0; dt < 4; ++dt)
#pragma unroll
                for (int c = 0; c < 4; ++c) { h16x4 ov;
#pragma unroll
                    for (int e = 0; e < 4; ++e) ov[e] = (h16)(o[dt][4 * c + e] * g0);
                    *(h16x4*)(OZ + (size_t)t * 2048 + head * 128 + 32 * dt + 8 * c + 4 * h) = ov; }
            __syncthreads();
            for (int qq = 0; qq < 8; ++qq) {
                const int q = F.wave * 8 + qq;
                float myv[2];
#pragma unroll
                for (int c = 0; c < 2; ++c) { const int s = lane + 64 * c; const bool valid = s <= c64, forced = (s == 0) || (s == c64) || (s == c64 - 1);
                    myv[c] = valid ? (forced ? BIGF : imp[q * 128 + s]) : NEGF; sv[s] = myv[c]; }
                wave_lds_fence();
                int rank0 = 0, rank1 = 0;
                for (int s2 = 0; s2 < 128; ++s2) { const float v2 = sv[s2];
                    rank0 += (v2 > myv[0] || (v2 == myv[0] && s2 < lane)) ? 1 : 0; rank1 += (v2 > myv[1] || (v2 == myv[1] && s2 < lane + 64)) ? 1 : 0; }
                const unsigned long long m0 = __ballot(rank0 < 16 && lane <= c64), m1 = __ballot(rank1 < 16 && (lane + 64) <= c64);
                if (lane == 0) { selw[q * 4 + 0] = (unsigned)m0; selw[q * 4 + 1] = (unsigned)(m0 >> 32); selw[q * 4 + 2] = (unsigned)m1; selw[q * 4 + 3] = (unsigned)(m1 >> 32); }
                wave_lds_fence();
            }
            __syncthreads();
            SelOn son; son.w = selw + ql * 4;
            fa::zero_o(o); m = NEGF; l = 0.f;
            fa::stream<0>(lds, KVb + ((size_t)2 * 4 + g) * S * 128, KVb + ((size_t)3 * 4 + g) * S * 128, 0, c64 + 1, qf, o, m, l, 0, t, son, F.tid, lane, 0.f, (LAS float*)nullptr);
            l += __shfl_xor(l, 32);
            { const float sc = gates[(size_t)t * 48 + head * 3 + 1] / fmaxf(l, 1e-30f);
#pragma unroll
              for (int dt = 0; dt < 4; ++dt)
#pragma unroll
                  for (int c = 0; c < 4; ++c) { h16* p = OZ + (size_t)t * 2048 + head * 128 + 32 * dt + 8 * c + 4 * h; const h16x4 pv = *(const h16x4*)p; h16x4 ov;
#pragma unroll
                      for (int e = 0; e < 4; ++e) ov[e] = (h16)((float)pv[e] + o[dt][4 * c + e] * sc);
                      *(h16x4*)p = ov; } }
            fa::zero_o(o); m = NEGF; l = 0.f;
            fa::stream<0>(lds, KVb + ((size_t)4 * 4 + g) * S * 128, KVb + ((size_t)5 * 4 + g) * S * 128, (c64 >= 8 ? c64 - 8 : 0), c64 + 1, qf, o, m, l, t - 511, t, AllOn(), F.tid, lane, 0.f, (LAS float*)nullptr);
            l += __shfl_xor(l, 32);
            const float sc2 = gates[(size_t)t * 48 + head * 3 + 2] / fmaxf(l, 1e-30f);
#pragma unroll
            for (int dt = 0; dt < 4; ++dt)
#pragma unroll
                for (int c = 0; c < 4; ++c) {
                    const int d = 32 * dt + 8 * c + 4 * h; const size_t off = (size_t)t * 2048 + head * 128 + d;
                    const h16x4 zz = *(const h16x4*)(Z + off); const h16x4 pv = *(const h16x4*)(OZ + off); h16x4 ov;
#pragma unroll
                    for (int e = 0; e < 4; ++e) ov[e] = (h16)(((float)pv[e] + o[dt][4 * c + e] * sc2) * (float)zz[e]);
                    *(h16x4*)(OZ + off) = ov;
                }
        }
    }
}

__device__ __forceinline__ void phase_ret_post(const Frame& F) {
    const h16* P = (const h16*)(F.ws + WS_P);
    h16* RQ = (h16*)(F.ws + WS_QKV); h16* RK = RQ + (size_t)8 * S * 256; h16* RV = RK + (size_t)8 * S * 256; h16* RG = RV + (size_t)8 * S * 512;
    const f32x2* r128 = (const f32x2*)(F.ws + WS_ROPE128);
    for (int it = F.bid; it < 384; it += F.G) {
        const int blk = it / 12, part = it % 12;
        for (int i = 0; i < 32; ++i) {
            const int t = blk * 256 + F.wave * 32 + i;
            float v[16]; load16(P + (size_t)t * 12288 + part * 1024 + F.lane * 16, v);
            if (part <= 3) {
                const int head = (part & 1) * 4 + (F.lane >> 4), dl = (F.lane & 15) * 16, hi = (F.lane >> 3) & 1, j0 = (F.lane & 7) * 16;
                const f32x2* cs = r128 + (size_t)t * 128 + j0;
                const float scale = (part >= 2) ? 0.0625f : 1.0f;
#pragma unroll
                for (int e = 0; e < 16; ++e) {
                    const float o = __shfl_xor(v[e], 8); const f32x2 c = cs[e];
                    v[e] = (hi == 0 ? (v[e] * c[0] - o * c[1]) : (o * c[1] + v[e] * c[0])) * scale;
                }
                store16((part >= 2 ? RK : RQ) + ((size_t)head * S + t) * 256 + dl, v);
            } else if (part <= 7) {
                const int cs0 = (part - 4) * 1024 + F.lane * 16, head = cs0 >> 9, dv = cs0 & 511;
                store16(RV + ((size_t)head * S + t) * 512 + dv, v);
            } else {
                const int cs0 = (part - 8) * 1024 + F.lane * 16;
#pragma unroll
                for (int e = 0; e < 16; ++e) v[e] = silu_f(v[e]);
                store16(RG + (size_t)t * 4096 + cs0, v);
            }
        }
    }
}

__device__ __forceinline__ double gamma_of(int h) { return 1.0 - 1.0 / (double)(32 << h); }
__device__ __forceinline__ double dpow_int(double b, int n) { double p = 1.0; for (int i = 0; i < n; ++i) p *= b; return p; }

__device__ __forceinline__ void phase_ret_scan(const Frame& F) {
    const h16* RQ = (const h16*)(F.ws + WS_QKV); const h16* RK = RQ + (size_t)8 * S * 256; const h16* RV = RK + (size_t)8 * S * 256;
    h16* SB = (h16*)(F.ws + WS_P);
    float* ks = (float*)F.lds;
    h16* vs = (h16*)(F.lds + 32768);
    float* wd = (float*)(F.lds + 49152);
    for (int it = F.bid; it < 256; it += F.G) {
        const int h = it >> 5, dk0 = ((it >> 3) & 3) * 64, dv0 = (it & 7) * 64;
        const double gam = gamma_of(h);
        __syncthreads();
        if (F.tid < 128) wd[F.tid] = (float)dpow_int(gam, 127 - F.tid);
        const float carry = (float)dpow_int(gam, 128);
        const int tk = F.tid >> 3, tv = F.tid & 7;
        float st[8];
#pragma unroll
        for (int e = 0; e < 8; ++e) st[e] = 0.f;
        __syncthreads();
        for (int c = 0; c < 64; ++c) {
            { h16x8 o;
#pragma unroll
              for (int e = 0; e < 8; ++e) o[e] = (h16)st[e];
              *(h16x8*)(SB + (((size_t)h * 64 + c) * 256 + dk0 + tk) * 512 + dv0 + tv * 8) = o; }
            for (int i = F.tid; i < 128 * 8; i += NTHREADS) {
                const int j = i >> 3, c8 = (i & 7) * 8;
                const h16x8 kk = *(const h16x8*)(RK + ((size_t)h * S + c * 128 + j) * 256 + dk0 + c8);
                const h16x8 vv = *(const h16x8*)(RV + ((size_t)h * S + c * 128 + j) * 512 + dv0 + c8);
                const float w = wd[j];
#pragma unroll
                for (int e = 0; e < 8; ++e) ks[j * 64 + c8 + e] = (float)kk[e] * w;
                *(h16x8*)(vs + j * 64 + c8) = vv;
            }
            __syncthreads();
#pragma unroll
            for (int e = 0; e < 8; ++e) st[e] *= carry;
#pragma unroll 4
            for (int j = 0; j < 128; ++j) {
                const float kf = ks[j * 64 + tk]; const h16x8 vv = *(const h16x8*)(vs + j * 64 + tv * 8);
#pragma unroll
                for (int e = 0; e < 8; ++e) st[e] += kf * (float)vv[e];
            }
            __syncthreads();
        }
    }
}

__device__ __forceinline__ void phase_ret_out(const Frame& F) {
    const h16* RQ = (const h16*)(F.ws + WS_QKV); const h16* RK = RQ + (size_t)8 * S * 256; const h16* RV = RK + (size_t)8 * S * 256;
    const h16* SB = (const h16*)(F.ws + WS_P);
    float* OR_ = (float*)(F.ws + WS_OR);
    h16* Qs = (h16*)F.lds;
    float* AsT = (float*)(F.lds + 65536);
    float* rd = (float*)(F.lds + 131072);
    for (int it = F.bid; it < 512; it += F.G) {
        const int h = it >> 6, c = it & 63;
        const double gam = gamma_of(h);
        __syncthreads();
        if (F.tid < 130) rd[F.tid] = (float)dpow_int(gam, F.tid);
        for (int i = F.tid; i < 128 * 32; i += NTHREADS) {
            const int r = i >> 5, c8 = (i & 31) * 8;
            *(h16x8*)(Qs + r * 256 + c8) = *(const h16x8*)(RQ + ((size_t)h * S + c * 128 + r) * 256 + c8);
        }
        __syncthreads();
        {
            const int j = F.tid & 127, ig = F.tid >> 7;
            float acc[32];
#pragma unroll
            for (int ii = 0; ii < 32; ++ii) acc[ii] = 0.f;
            const h16* krow = RK + ((size_t)h * S + c * 128 + j) * 256;
            for (int d8 = 0; d8 < 32; ++d8) {
                const h16x8 kv = *(const h16x8*)(krow + d8 * 8);
                const h16x2 k0 = {kv[0], kv[1]}, k1 = {kv[2], kv[3]}, k2 = {kv[4], kv[5]}, k3 = {kv[6], kv[7]};
#pragma unroll
                for (int ii = 0; ii < 32; ++ii) {
                    const h16x8 qv = *(const h16x8*)(Qs + (ig * 32 + ii) * 256 + d8 * 8);
                    float a = acc[ii];
                    a = __builtin_amdgcn_fdot2((h16x2){qv[0], qv[1]}, k0, a, false); a = __builtin_amdgcn_fdot2((h16x2){qv[2], qv[3]}, k1, a, false);
                    a = __builtin_amdgcn_fdot2((h16x2){qv[4], qv[5]}, k2, a, false); a = __builtin_amdgcn_fdot2((h16x2){qv[6], qv[7]}, k3, a, false);
                    acc[ii] = a;
                }
            }
#pragma unroll
            for (int ii = 0; ii < 32; ++ii) { const int i = ig * 32 + ii; AsT[j * 128 + i] = (i >= j) ? acc[ii] * rd[i - j] : 0.f; }
        }
        __syncthreads();
        for (int i = F.tid; i < 128 * 32; i += NTHREADS) {
            const int r = i >> 5, c8 = (i & 31) * 8; const float w = rd[r + 1];
            h16x8 q = *(h16x8*)(Qs + r * 256 + c8);
#pragma unroll
            for (int e = 0; e < 8; ++e) q[e] = (h16)((float)q[e] * w);
            *(h16x8*)(Qs + r * 256 + c8) = q;
        }
        __syncthreads();
        {
            const int dv = F.tid;
            float acc[128];
#pragma unroll
            for (int i = 0; i < 128; ++i) acc[i] = 0.f;
            const h16* vcol = RV + ((size_t)h * S + c * 128) * 512 + dv;
            for (int j = 0; j < 128; ++j) {
                const float v = (float)vcol[(size_t)j * 512];
#pragma unroll
                for (int i4 = 0; i4 < 32; ++i4) {
                    const f32x4 a = *(const f32x4*)(AsT + j * 128 + i4 * 4);
                    acc[i4 * 4 + 0] += a[0] * v; acc[i4 * 4 + 1] += a[1] * v; acc[i4 * 4 + 2] += a[2] * v; acc[i4 * 4 + 3] += a[3] * v;
                }
            }
            const h16* scol = SB + (((size_t)h * 64 + c) * 256) * 512 + dv;
            for (int d8 = 0; d8 < 32; ++d8) {
                h16x2 s0, s1, s2, s3;
                s0[0] = scol[(size_t)(d8 * 8 + 0) * 512]; s0[1] = scol[(size_t)(d8 * 8 + 1) * 512]; s1[0] = scol[(size_t)(d8 * 8 + 2) * 512]; s1[1] = scol[(size_t)(d8 * 8 + 3) * 512];
                s2[0] = scol[(size_t)(d8 * 8 + 4) * 512]; s2[1] = scol[(size_t)(d8 * 8 + 5) * 512]; s3[0] = scol[(size_t)(d8 * 8 + 6) * 512]; s3[1] = scol[(size_t)(d8 * 8 + 7) * 512];
#pragma unroll
                for (int i = 0; i < 128; ++i) {
                    const h16x8 qv = *(const h16x8*)(Qs + i * 256 + d8 * 8);
                    float a = acc[i];
                    a = __builtin_amdgcn_fdot2((h16x2){qv[0], qv[1]}, s0, a, false); a = __builtin_amdgcn_fdot2((h16x2){qv[2], qv[3]}, s1, a, false);
                    a = __builtin_amdgcn_fdot2((h16x2){qv[4], qv[5]}, s2, a, false); a = __builtin_amdgcn_fdot2((h16x2){qv[6], qv[7]}, s3, a, false);
                    acc[i] = a;
                }
            }
#pragma unroll
            for (int i = 0; i < 128; ++i) OR_[(size_t)(c * 128 + i) * 4096 + h * 512 + dv] = acc[i];
        }
    }
    __syncthreads();
}

__device__ __forceinline__ void phase_ret_gn(const Frame& F) {
    const float* OR_ = (const float*)(F.ws + WS_OR);
    const h16* RG = (const h16*)(F.ws + WS_QKV) + (size_t)8 * S * 256 * 2 + (size_t)8 * S * 512;
    h16* OZ = (h16*)(F.ws + WS_OZ);
    for (int task = F.bid * 8 + F.wave; task < S * 8; task += F.G * 8) {
        const int t = task >> 3, h = task & 7;
        const size_t off = (size_t)t * 4096 + h * 512 + F.lane * 8;
        const f32x4 a = *(const f32x4*)(OR_ + off), b = *(const f32x4*)(OR_ + off + 4);
        float s = a[0] + a[1] + a[2] + a[3] + b[0] + b[1] + b[2] + b[3];
        s = wave_sum(s); const float mu = s * (1.0f / 512.0f);
        float q = 0.f;
#pragma unroll
        for (int e = 0; e < 4; ++e) { const float d0 = a[e] - mu, d1 = b[e] - mu; q += d0 * d0 + d1 * d1; }
        q = wave_sum(q); const float r = 1.0f / sqrtf(q * (1.0f / 512.0f) + EPS);
        const h16x8 gv = *(const h16x8*)(RG + off);
        h16x8 o;
#pragma unroll
        for (int e = 0; e < 4; ++e) { o[e] = (h16)((float)gv[e] * ((a[e] - mu) * r)); o[4 + e] = (h16)((float)gv[4 + e] * ((b[e] - mu) * r)); }
        *(h16x8*)(OZ + off) = o;
    }
}

__device__ __forceinline__ void phase_gemm(const Frame& F, const h16* A, const h16* Bt, int N, int K, void* O, int ldc, int f32out) {
    pg8::Gemm g{A, Bt, S, N, K}; pg8::StaticOrder So; So.init(S, N, F.G, F.bid);
    pg8::EpiStore E{O, ldc, f32out};
    pg8::gemm_phase<pg8::EpiStore, pg8::StaticOrder, true, true>((LAS unsigned char*)F.lds, g, So, E);
}

constexpr int NPHASE = 2 + 8 * DEPTH;
__host__ __device__ inline bool phase_exists(int p) {
    if (p < 2) return true;
    const int L = (p - 2) / 8, s = (p - 2) % 8, kind = L % 3;
    if (s == 7) return false;
    if (s == 2) return kind != 0;
    if (s == 4) return kind == 2;
    return true;
}

__global__ void __launch_bounds__(NTHREADS, 2) trunk_fwd(Args args) {
    extern __shared__ __attribute__((aligned(16))) unsigned char lds_raw[];
    Frame F;
    F.out = args.out; F.ws = args.ws; F.lds = (char*)lds_raw;
    F.tid = threadIdx.x; F.lane = F.tid & 63; F.wave = __builtin_amdgcn_readfirstlane(F.tid >> 6); F.G = gridDim.x; F.bid = blockIdx.x;
    volatile LAS unsigned* misc = (volatile LAS unsigned*)((LAS unsigned char*)lds_raw + MISC_OFF);
    if (F.tid < 16) misc[F.tid] = 0u;
    __syncthreads();
    XcdBarrier bar; bar.bar = (unsigned*)(F.ws + WS_CTL) + CW_BAR; bar.x = 0; bar.st = misc;
#if ONE_LAUNCH
    bar = xcd_barrier_post((unsigned*)(F.ws + WS_CTL) + CW_BAR, misc);
    cg::grid_group grid = cg::this_grid();
#endif
    const int lo = args.ph_lo, hi = args.ph_hi;
#if ONE_LAUNCH
    grid.sync();
#define SEAM(p) do { if ((p) > lo) xcd_barrier(bar); } while (0)
#else
#define SEAM(p) do { } while (0)
#endif
#define IN(p) (lo <= (p) && (p) < hi)
#ifndef PHMASK
#define PHMASK 0xFFFF
#endif
#define EN(b) ((PHMASK >> (b)) & 1)
#ifndef PROBE_DUP
#define PROBE_DUP 0
#endif
#define DUP(b, call) do { if ((PROBE_DUP >> (b)) & 1) { if (ONE_LAUNCH) xcd_barrier(bar); call; } } while (0)
    if (EN(0) && IN(0)) { SEAM(0); phase_prologue(F, args); }
    if (EN(1) && IN(1)) { SEAM(1); phase_norm(F, args, -1, 0); }
#define LAYER(L) do { \
        constexpr int kind = (L) % 3, base = 2 + 8 * (L); \
        constexpr int Nin = kind == 0 ? 8192 : (kind == 1 ? NSA_NP : 12288); \
        constexpr int Kout = kind == 2 ? 4096 : 2048; \
        if (EN(2) && IN(base + 0)) { SEAM(base + 0); phase_gemm(F, (const h16*)(F.ws + WS_H), (const h16*)(F.ws + WS_WTIN), Nin, 2048, F.ws + WS_P, Nin, 0); } \
        if (IN(base + 1)) { SEAM(base + 1); if (EN(3) && kind == 0) { phase_moba_post(F); DUP(3, phase_moba_post(F)); } else if (EN(4) && kind == 1) { phase_nsa_post(F); DUP(4, phase_nsa_post(F)); } else if (EN(5) && kind == 2) { phase_ret_post(F); DUP(5, phase_ret_post(F)); } } \
        if (kind != 0 && IN(base + 2)) { SEAM(base + 2); if (EN(6) && kind == 1) { phase_nsa_cmp(F, args); DUP(6, phase_nsa_cmp(F, args)); } else if (EN(7) && kind == 2) { phase_ret_scan(F); DUP(7, phase_ret_scan(F)); } } \
        if (IN(base + 3)) { SEAM(base + 3); if (EN(8) && kind == 0) { if (MOBA_MFMA) { phase_moba_attn_mfma(F); DUP(8, phase_moba_attn_mfma(F)); } else phase_moba_attn(F); } else if (EN(9) && kind == 1) { if (NSA_MFMA) { phase_nsa_attn_mfma(F); DUP(9, phase_nsa_attn_mfma(F)); } else phase_nsa_attn(F); } else if (EN(10) && kind == 2) { phase_ret_out(F); DUP(10, phase_ret_out(F)); } } \
        if (EN(11) && kind == 2 && IN(base + 4)) { SEAM(base + 4); phase_ret_gn(F); } \
        if (EN(2) && IN(base + 5)) { SEAM(base + 5); phase_gemm(F, (const h16*)(F.ws + WS_OZ), (const h16*)(F.ws + WS_WTOUT), 2048, Kout, F.ws + WS_Y, 2048, 1); } \
        if (EN(1) && IN(base + 6)) { SEAM(base + 6); phase_norm(F, args, (L), (L) + 1 < DEPTH ? (L) + 1 : -1); } \
    } while (0)
    LAYER(0); LAYER(1); LAYER(2); LAYER(3);
#undef LAYER
#undef EN
#undef DUP
#undef IN
#undef SEAM
}

extern "C" void kernel_launch(void* const* d_in, const int* in_sizes, int n_in, void* d_out, int out_size, void* d_ws, size_t ws_size, hipStream_t stream) {
    static int grid = 0;
    if (grid == 0) {
        if (n_in != 18 || out_size != S * D || ws_size < WS_END) { fprintf(stderr, "kernel_launch: unexpected shapes (n_in %d, out %d, ws %zu)\n", n_in, out_size, ws_size); grid = -1; return; }
        int dev = 0, cus = 0, per_cu = 0;
        if (hipGetDevice(&dev) != hipSuccess || hipDeviceGetAttribute(&cus, hipDeviceAttributeMultiprocessorCount, dev) != hipSuccess) { grid = -1; return; }
        if (hipFuncSetAttribute((const void*)trunk_fwd, hipFuncAttributeMaxDynamicSharedMemorySize, LDS_BYTES) != hipSuccess) { fprintf(stderr, "kernel_launch: hipFuncSetAttribute failed\n"); grid = -1; return; }
        if (hipOccupancyMaxActiveBlocksPerMultiprocessor(&per_cu, (const void*)trunk_fwd, NTHREADS, LDS_BYTES) != hipSuccess || per_cu < 1) { fprintf(stderr, "kernel_launch: occupancy query says %d\n", per_cu); per_cu = 1; }
        (void)hipGetLastError();
        grid = cus;
    }
    if (grid < 0) return;
    (void)hipMemsetAsync((char*)d_ws + WS_CTL, 0, CTL_ZERO_BYTES, stream);
    Args a{};
    for (int i = 0; i < 18; ++i) a.in[i] = (const float*)d_in[i];
    a.out = (float*)d_out; a.ws = (unsigned char*)d_ws;
    for (int j = 0; j < 16; ++j) a.inv16[j] = pow(500000.0, -(double)j / 16.0);
    for (int j = 0; j < 128; ++j) a.inv128[j] = pow(10000.0, -(double)j / 128.0);
#if ONE_LAUNCH
    a.ph_lo = 0; a.ph_hi = NPHASE;
    void* kargs[] = {&a};
    hipError_t e = hipLaunchCooperativeKernel((const void*)trunk_fwd, dim3(grid), dim3(NTHREADS), kargs, LDS_BYTES, stream);
    if (e != hipSuccess) fprintf(stderr, "kernel_launch: cooperative launch failed: %s (grid %d)\n", hipGetErrorString(e), grid);
#else
    for (int p = 0; p < NPHASE; ++p) {
        if (!phase_exists(p)) continue;
        a.ph_lo = p; a.ph_hi = p + 1;
        hipLaunchKernelGGL(trunk_fwd, dim3(grid), dim3(NTHREADS), LDS_BYTES, stream, a);
    }
#endif
}
```

```cpp
#include <hip/hip_runtime.h>
#include <hip/hip_cooperative_groups.h>
#include <cstdio>
#include <cstdint>
#include <cmath>
namespace cg = cooperative_groups;

#ifndef ONE_LAUNCH
#define ONE_LAUNCH 1
#endif
#ifndef MOBA_MFMA
#define MOBA_MFMA 1
#endif
#ifndef NSA_MFMA
#define NSA_MFMA 1
#endif

#define LAS __attribute__((address_space(3)))
typedef _Float16 h16;
typedef _Float16 h16x2 __attribute__((ext_vector_type(2)));
typedef _Float16 h16x4 __attribute__((ext_vector_type(4)));
typedef _Float16 h16x8 __attribute__((ext_vector_type(8)));
typedef float f32x2 __attribute__((ext_vector_type(2)));
typedef float f32x4 __attribute__((ext_vector_type(4)));
typedef unsigned u32x4 __attribute__((ext_vector_type(4)));

constexpr int S = 8192, D = 2048, DEPTH = 4;
constexpr float EPS = 1e-6f;
constexpr float NEGF = -1e30f, BIGF = 1e30f;
constexpr int NSA_NP = 7424;
constexpr int NC = 511;

constexpr size_t MiB = 1u << 20;
constexpr size_t WS_CTL = 0, CTL_ZERO_BYTES = 1 * MiB;
constexpr size_t WS_MODP = 1 * MiB;
constexpr size_t WS_KMEAN = 2 * MiB;
constexpr size_t WS_GATES = 3 * MiB;
constexpr size_t WS_KCMP = 5 * MiB;
constexpr size_t WS_VCMP = 5 * MiB + 512 * 1024;
constexpr size_t WS_ROPE16 = 6 * MiB;
constexpr size_t WS_ROPE128 = 7 * MiB;
constexpr size_t WS_WTIN = 16 * MiB;
constexpr size_t WS_WTOUT = 64 * MiB;
constexpr size_t WS_H = 80 * MiB;
constexpr size_t WS_P = 112 * MiB;
constexpr size_t WS_QKV = 304 * MiB;
constexpr size_t WS_OZ = 496 * MiB;
constexpr size_t WS_Y = 560 * MiB;
constexpr size_t WS_OR = 624 * MiB;
constexpr size_t WS_END = 752 * MiB;

constexpr int LDS_BYTES = 147456;
constexpr int MISC_OFF = 135168;
constexpr int NTHREADS = 512;

struct Args {
    const float* in[18];
    float* out;
    unsigned char* ws;
    double inv16[16];
    double inv128[128];
    int ph_lo, ph_hi;
};

#define XB_TMO      128
#define XB_XCNT(j)  (256  + 64 * (j))
#define XB_XSUB(j)  (1280 + 64 * (j))
#define XB_XGEN(j)  (2304 + 64 * (j))
#define XB_TOP      3328
#define XB_TOPGEN   3392
#define XCD_BAR_WORDS 3456
#define XB_SPIN_CAP (1u << 24)
constexpr int CW_BAR = 4096;

__device__ __forceinline__ unsigned xb_ld(unsigned* p)              { return __hip_atomic_load(p, __ATOMIC_RELAXED, __HIP_MEMORY_SCOPE_AGENT); }
__device__ __forceinline__ unsigned xb_add(unsigned* p, unsigned v) { return __hip_atomic_fetch_add(p, v, __ATOMIC_RELAXED, __HIP_MEMORY_SCOPE_AGENT); }
__device__ __forceinline__ unsigned xb_xcc_id() { return (unsigned)__builtin_amdgcn_s_getreg((3 << 11) | 20) & 0xFu; }
#define XB_SPIN(cond, bar) do { unsigned _sp = 0; while (cond) { __builtin_amdgcn_s_sleep(1); \
    if ((++_sp & 255u) == 0u) { if (xb_ld(&(bar)[XB_TMO])) break; if (_sp > XB_SPIN_CAP) { atomicAdd(&(bar)[XB_TMO], 1u); break; } } } } while (0)

struct XcdBarrier { unsigned* bar; unsigned x; volatile LAS unsigned* st; };

__device__ __forceinline__ XcdBarrier xcd_barrier_post(unsigned* bar, volatile LAS unsigned* st) {
    XcdBarrier b; b.bar = bar; b.x = xb_xcc_id(); b.st = st;
    if (threadIdx.x == 0) (void)xb_add(&bar[XB_XCNT(b.x)], 1u);
    return b;
}
__device__ __forceinline__ void xcd_barrier_complete(unsigned* bar, unsigned x, unsigned& nloc, unsigned& nx) {
    const unsigned G = gridDim.x * gridDim.y * gridDim.z;
    unsigned sum, cnt, mine, sp = 0u;
    for (;;) {
        sum = 0u; cnt = 0u; mine = 0u;
#pragma unroll
        for (unsigned j = 0; j < 16; ++j) { const unsigned c = xb_ld(&bar[XB_XCNT(j)]); sum += c; cnt += (c > 0u) ? 1u : 0u; mine = (j == x) ? c : mine; }
        if (sum == G) break;
        __builtin_amdgcn_s_sleep(1);
        if ((++sp & 255u) == 0u) { if (xb_ld(&bar[XB_TMO])) break; if (sp > XB_SPIN_CAP) { atomicAdd(&bar[XB_TMO], 1u); break; } }
    }
    nloc = mine > 0u ? mine : 1u; nx = cnt > 0u ? cnt : 1u;
}
__device__ __forceinline__ void xcd_barrier(const XcdBarrier& b) {
    asm volatile("s_waitcnt vmcnt(0)" ::: "memory");
    __syncthreads();
    if (threadIdx.x == 0) {
        unsigned* bar = b.bar;
        __builtin_amdgcn_s_waitcnt(0);
        unsigned nloc = b.st[0], nx = b.st[1];
        if (nloc == 0u) { xcd_barrier_complete(bar, b.x, nloc, nx); b.st[0] = nloc; b.st[1] = nx; }
        const unsigned old = xb_add(&bar[XB_XSUB(b.x)], 1u);
        const unsigned gen = old / nloc;
        if (old + 1u == (gen + 1u) * nloc) {
            __builtin_amdgcn_fence(__ATOMIC_RELEASE, "agent");
            asm volatile("s_waitcnt vmcnt(0)" ::: "memory");
            const unsigned og = xb_add(&bar[XB_TOP], 1u);
            const unsigned tg = og / nx;
            if (og + 1u == (tg + 1u) * nx) xb_add(&bar[XB_TOPGEN], 1u);
            else XB_SPIN(xb_ld(&bar[XB_TOPGEN]) == tg, bar);
            __builtin_amdgcn_fence(__ATOMIC_ACQUIRE, "agent");
            xb_add(&bar[XB_XGEN(b.x)], 1u);
            asm volatile("s_waitcnt vmcnt(0)" ::: "memory");
        } else {
            XB_SPIN(xb_ld(&bar[XB_XGEN(b.x)]) == gen, bar);
            __builtin_amdgcn_fence(__ATOMIC_ACQUIRE, "agent");
            asm volatile("s_waitcnt vmcnt(0)" ::: "memory");
        }
    }
    __syncthreads();
}

__device__ __forceinline__ float silu_f(float x) { return x / (1.f + __expf(-x)); }
__device__ __forceinline__ float sigmoid_f(float x) { return 1.f / (1.f + __expf(-x)); }

namespace pg8 {
constexpr int BM = 256, BK = 64, HALF = 128, HTB = HALF * BK * 2, STAGE_BYTES = 8 * HTB, NXCD = 8, WGM = 8;
__host__ __device__ __forceinline__ int lds_byte(int r, int c) { const int st = (r >> 4) * 2 + (c >> 5), rr = r & 15, cc = c & 31, ob = rr * 64 + cc * 2; return st * 1024 + (ob ^ (((ob >> 9) & 1) << 5)); }
__host__ __device__ __forceinline__ void stage_rc(int b, int& R, int& C) { const int st = b / 1024, sb = b % 1024, swz = sb ^ (((sb >> 9) & 1) << 5); R = (st >> 1) * 16 + swz / 64; C = (st & 1) * 32 + (swz % 64) / 2; }
__host__ __device__ __forceinline__ int perm32(int rho) { const int n = rho >> 4, i = rho & 15; return 8 * (i >> 2) + 4 * n + (i & 3); }

struct Unit { int pm, pn; };
struct Gemm { const h16* A; const h16* Bt; int M, N, K; };

struct StaticOrder {
    int nM, nN, nwg, G, c;
    __host__ __device__ void init(int M, int N, int G_, int c_) { nM = M / BM; nN = N / BM; nwg = nM * nN; G = G_; c = c_; }
    __host__ __device__ bool next(int i, Unit& u) const {
        const long L = (long)i * G + c; if (L >= nwg) return false;
        int wgid = (int)L; { const int q = nwg / NXCD, r = nwg % NXCD, xcd = wgid % NXCD, off = wgid / NXCD; wgid = (xcd < r ? xcd * (q + 1) : r * (q + 1) + (xcd - r) * q) + off; }
        const int nig = WGM * nN, gid = wgid / nig, fm = gid * WGM, gsz = (nM - fm) < WGM ? (nM - fm) : WGM;
        u.pm = fm + ((wgid % nig) % gsz); u.pn = (wgid % nig) / gsz; return true;
    }
    __device__ __forceinline__ void a_ready(const Unit&) const {}
    __device__ __forceinline__ void done(const Unit&) const {}
};

struct EpiStore {
    static constexpr bool PERM = true, AFTER_DRAIN = false;
    void* O; int ldc; int f32out;
    __device__ __forceinline__ void operator()(const f32x4 (&acc)[2][2][4][2], const Unit& u, int wr, int wc, int fr, int fq) const {
        const int row0 = u.pm * BM + wr * 64 + fr, col0 = u.pn * BM + wc * 32 + 8 * fq;
#pragma unroll
        for (int ai = 0; ai < 2; ++ai)
#pragma unroll
            for (int m = 0; m < 4; ++m) {
                const size_t roff = (size_t)(row0 + ai * HALF + m * 16) * ldc + col0;
#pragma unroll
                for (int bj = 0; bj < 2; ++bj) {
                    const f32x4 v0 = acc[ai][bj][m][0], v1 = acc[ai][bj][m][1];
                    if (f32out) {
                        float* p = (float*)O + roff + bj * HALF;
                        *(f32x4*)p = v0; *(f32x4*)(p + 4) = v1;
                    } else {
                        h16x8 w; w[0] = (h16)v0[0]; w[1] = (h16)v0[1]; w[2] = (h16)v0[2]; w[3] = (h16)v0[3]; w[4] = (h16)v1[0]; w[5] = (h16)v1[1]; w[6] = (h16)v1[2]; w[7] = (h16)v1[3];
                        *(h16x8*)((h16*)O + roff + bj * HALF) = w;
                    }
                }
            }
    }
};


template <int KIND  > struct EpiProj {
    static constexpr bool PERM = true, AFTER_DRAIN = false;
    unsigned char* ws;
    __device__ __forceinline__ static void st8(h16* p, const float (&v)[8]) { h16x8 w;
#pragma unroll
        for (int i = 0; i < 8; ++i) w[i] = (h16)v[i];
        *(h16x8*)p = w; }
    __device__ __forceinline__ void operator()(const f32x4 (&acc)[2][2][4][2], const Unit& u, int wr, int wc, int fr, int fq) const {
        const int pn = u.pn, d0 = 32 * wc + 8 * fq;
        h16* QKV = (h16*)(ws + WS_QKV);
        const f32x2* r16 = (const f32x2*)(ws + WS_ROPE16); const f32x2* r128 = (const f32x2*)(ws + WS_ROPE128);
        float ksum[2][8];
#pragma unroll
        for (int bj = 0; bj < 2; ++bj)
#pragma unroll
            for (int i = 0; i < 8; ++i) ksum[bj][i] = 0.f;
        int mode;
        float scale = 1.f; h16* base = QKV; int ld = 0;
        bool want_ksum = false;
        if (KIND == 0) {
            const int sect = pn >> 3;
            if (sect == 0) { mode = 0; scale = 0.08838834764831845f; base = QKV + (size_t)(2 * (pn & 7)) * S * 128; }
            else if (sect == 1) { mode = 0; want_ksum = true; base = QKV + (size_t)16 * S * 128 + (size_t)(2 * (pn & 7)) * S * 128; }
            else if (sect == 2) { mode = 1; base = QKV + (size_t)32 * S * 128 + (size_t)(2 * (pn & 7)) * S * 128; }
            else { mode = 2; base = QKV + (size_t)48 * S * 128 + (pn & 7) * 256; ld = 2048; }
        } else if (KIND == 1) {
            if (pn < 8) { mode = 0; scale = 0.08838834764831845f; base = QKV + (size_t)(2 * pn) * S * 128; }
            else if (pn < 20) { const int ti = (pn - 8) >> 1; mode = (ti & 1) ? 1 : 0; base = QKV + (size_t)16 * S * 128 + ((size_t)ti * 4 + 2 * ((pn - 8) & 1)) * S * 128; }
            else if (pn < 28) { mode = 2; base = (h16*)(ws + WS_QKV + 96 * MiB) + (pn - 20) * 256; ld = 2048; }
            else mode = 3;
        } else {
            if (pn < 8) { mode = 4; base = QKV + (size_t)pn * S * 256; }
            else if (pn < 16) { mode = 4; scale = 0.0625f; base = QKV + (size_t)8 * S * 256 + (size_t)(pn - 8) * S * 256; }
            else if (pn < 32) { mode = 5; base = QKV + (size_t)16 * S * 256 + (size_t)((pn - 16) >> 1) * S * 512 + ((pn - 16) & 1) * 256; }
            else { mode = 2; base = QKV + (size_t)16 * S * 256 + (size_t)8 * S * 512 + (pn - 32) * 256; ld = 4096; }
        }
#pragma unroll
        for (int ai = 0; ai < 2; ++ai)
#pragma unroll
            for (int m = 0; m < 4; ++m) {
                const int t = u.pm * BM + ai * HALF + wr * 64 + m * 16 + fr;
                float v[2][8];
#pragma unroll
                for (int bj = 0; bj < 2; ++bj)
#pragma unroll
                    for (int i = 0; i < 8; ++i) v[bj][i] = acc[ai][bj][m][i >> 2][i & 3];
                if (mode == 0) {
                    if (wc == 0) {
                        const f32x2* cs = r16 + (size_t)t * 16 + 8 * (fq & 1);
#pragma unroll
                        for (int bj = 0; bj < 2; ++bj)
#pragma unroll
                            for (int i = 0; i < 8; ++i) { const float o = __shfl_xor(v[bj][i], 32); const f32x2 c = cs[i];
                                v[bj][i] = (fq < 2) ? (v[bj][i] * c[0] - o * c[1]) : (o * c[1] + v[bj][i] * c[0]); }
                    }
#pragma unroll
                    for (int bj = 0; bj < 2; ++bj) {
#pragma unroll
                        for (int i = 0; i < 8; ++i) { v[bj][i] *= scale; ksum[bj][i] += v[bj][i]; }
                        st8(base + ((size_t)bj * S + t) * 128 + d0, v[bj]);
                    }
                } else if (mode == 1) {
#pragma unroll
                    for (int bj = 0; bj < 2; ++bj) st8(base + ((size_t)bj * S + t) * 128 + d0, v[bj]);
                } else if (mode == 2) {
#pragma unroll
                    for (int bj = 0; bj < 2; ++bj) {
#pragma unroll
                        for (int i = 0; i < 8; ++i) v[bj][i] = silu_f(v[bj][i]);
                        st8(base + (size_t)t * ld + 128 * bj + d0, v[bj]);
                    }
                } else if (mode == 3) {
                    if (d0 < 48) { float* gp = (float*)(ws + WS_GATES) + (size_t)t * 48 + d0;
#pragma unroll
                        for (int i = 0; i < 8; ++i) gp[i] = sigmoid_f(v[0][i]); }
                } else if (mode == 4) {
                    const f32x2* cs = r128 + (size_t)t * 128 + d0;
#pragma unroll
                    for (int i = 0; i < 8; ++i) { const f32x2 c = cs[i]; const float x1 = v[0][i], x2 = v[1][i];
                        v[0][i] = (x1 * c[0] - x2 * c[1]) * scale; v[1][i] = (x1 * c[1] + x2 * c[0]) * scale; }
                    st8(base + (size_t)t * 256 + d0, v[0]); st8(base + (size_t)t * 256 + 128 + d0, v[1]);
                } else {
#pragma unroll
                    for (int bj = 0; bj < 2; ++bj) st8(base + (size_t)t * 512 + 128 * bj + d0, v[bj]);
                }
            }
        if (KIND == 0 && want_ksum) {
#pragma unroll
            for (int bj = 0; bj < 2; ++bj)
#pragma unroll
                for (int i = 0; i < 8; ++i) { float x = ksum[bj][i]; x += __shfl_xor(x, 1); x += __shfl_xor(x, 2); x += __shfl_xor(x, 4); x += __shfl_xor(x, 8); ksum[bj][i] = x; }
            if (fr == 0) { float* km = (float*)(ws + WS_KMEAN) + (size_t)wr * 65536;
#pragma unroll
                for (int bj = 0; bj < 2; ++bj)
#pragma unroll
                    for (int i = 0; i < 8; ++i) km[((size_t)(2 * (pn & 7) + bj) * 32 + u.pm) * 128 + d0 + i] = ksum[bj][i] * (1.0f / 256.0f); }
        }
    }
};

template <class Epi, class Sched, bool ALIGN_EPI = false, bool SP2 = false>
__device__ __forceinline__ void gemm_phase(LAS unsigned char* lds, const Gemm g, const Sched& S, const Epi& E) {
    const int tid = threadIdx.x, wid = __builtin_amdgcn_readfirstlane(tid >> 6), lane = tid & 63, wr = wid >> 2, wc = wid & 3, fr = lane & 15, fq = lane >> 4;
    const int K = g.K, nt = K / BK;
    unsigned voffA[2], voffB[2];
#pragma unroll
    for (int i = 0; i < 2; ++i) { int R, C; stage_rc(tid * 16 + i * 8192, R, C); const int Rb = Epi::PERM ? ((R & ~31) + perm32(R & 31)) : R;
        voffA[i] = (unsigned)(R * K + C) * 2u; voffB[i] = (unsigned)(Rb * K + C) * 2u; }
    const size_t kstep = (size_t)(BK * 2);
    const size_t hstep = (size_t)HALF * K * 2;
    const size_t tstep = 2 * hstep;
    const unsigned ldsw = (unsigned)wid * 1024u;
    const int aoff = lds_byte(wr * 64 + fr, fq * 8), boff = lds_byte(wc * 32 + fr, fq * 8);
#define PG8_SA(b, h) (((b) * 2 + (h)) * HTB)
#define PG8_SB(b, h) ((4 + (b) * 2 + (h)) * HTB)
#define PG8_STAGE(bufoff, gbase, voff) do { _Pragma("unroll") for (int _i = 0; _i < 2; ++_i) \
        __builtin_amdgcn_global_load_lds((const unsigned*)((const char*)(gbase) + (voff)[_i]), (LAS unsigned*)(lds + (bufoff) + ldsw + _i * 8192), 16, 0, 0); } while (0)
#define PG8_LDA(dst, b, h) do { _Pragma("unroll") for (int m = 0; m < 4; ++m) _Pragma("unroll") for (int k = 0; k < 2; ++k) dst[m][k] = *(const LAS h16x8*)(lds + PG8_SA(b, h) + aoff + m * 2048 + k * 1024); } while (0)
#define PG8_LDB(dst, b, h) do { _Pragma("unroll") for (int n = 0; n < 2; ++n) _Pragma("unroll") for (int k = 0; k < 2; ++k) dst[n][k] = *(const LAS h16x8*)(lds + PG8_SB(b, h) + boff + n * 2048 + k * 1024); } while (0)
#define PG8_MMA(ai, bj, At, Bt) do { __builtin_amdgcn_s_setprio(1); _Pragma("unroll") for (int m = 0; m < 4; ++m) _Pragma("unroll") for (int n = 0; n < 2; ++n) _Pragma("unroll") for (int k = 0; k < 2; ++k) \
        acc[ai][bj][m][n] = __builtin_amdgcn_mfma_f32_16x16x32_f16(Bt[n][k], At[m][k], acc[ai][bj][m][n], 0, 0, 0); __builtin_amdgcn_s_setprio(0); } while (0)
#define PG8_WAIT_V(n) asm volatile("s_waitcnt vmcnt(" #n ")" ::: "memory")
#define PG8_WAIT_L(n) asm volatile("s_waitcnt lgkmcnt(" #n ")" ::: "memory")
#define PG8_BAR __builtin_amdgcn_s_barrier()
#define PG8_SCHED __builtin_amdgcn_sched_barrier(0)
    Unit cur, nxt; int ui = 0;
    if (!S.next(0, cur)) return;
    f32x4 acc[2][2][4][2];
#pragma unroll
    for (int a = 0; a < 2; ++a)
#pragma unroll
        for (int b = 0; b < 2; ++b)
#pragma unroll
            for (int m = 0; m < 4; ++m)
#pragma unroll
                for (int n = 0; n < 2; ++n) acc[a][b][m][n] = (f32x4){0.f, 0.f, 0.f, 0.f};
    h16x8 At[4][2], B0[2][2], B1[2][2];
    const char* cA = (const char*)g.A + (size_t)cur.pm * tstep; const char* cB = (const char*)g.Bt + (size_t)cur.pn * tstep;
    S.a_ready(cur);
    if constexpr (SP2) {
        PG8_STAGE(PG8_SB(0, 0), cB, voffB); PG8_STAGE(PG8_SB(0, 1), cB + hstep, voffB); PG8_STAGE(PG8_SA(0, 0), cA, voffA); PG8_STAGE(PG8_SA(0, 1), cA + hstep, voffA);
        if (wr == 1) PG8_BAR;
        PG8_WAIT_V(2); PG8_BAR;
        PG8_STAGE(PG8_SB(1, 0), cB + kstep, voffB); PG8_STAGE(PG8_SA(1, 0), cA + kstep, voffA); PG8_STAGE(PG8_SB(1, 1), cB + hstep + kstep, voffB);
        PG8_WAIT_V(6); PG8_BAR;
    } else {
        PG8_STAGE(PG8_SB(0, 0), cB, voffB); PG8_STAGE(PG8_SA(0, 0), cA, voffA); PG8_STAGE(PG8_SB(0, 1), cB + hstep, voffB); PG8_STAGE(PG8_SA(0, 1), cA + hstep, voffA);
        if (wr == 1) PG8_BAR;
        PG8_WAIT_V(4); PG8_BAR;
        PG8_STAGE(PG8_SB(1, 0), cB + kstep, voffB); PG8_STAGE(PG8_SA(1, 0), cA + kstep, voffA); PG8_STAGE(PG8_SB(1, 1), cB + hstep + kstep, voffB);
        PG8_WAIT_V(6); PG8_BAR;
    }
    for (;;) {
        const bool has_next = S.next(ui + 1, nxt);
        const char* nA = has_next ? (const char*)g.A + (size_t)nxt.pm * tstep : cA; const char* nB = has_next ? (const char*)g.Bt + (size_t)nxt.pn * tstep : cB;
        for (int t = 0; t < nt; t += 2) {
            const bool last = (t == nt - 2);
            const char* a1 = cA + (size_t)(t + 1) * kstep;
            const char* a2 = last ? nA : cA + (size_t)(t + 2) * kstep; const char* b2 = last ? nB : cB + (size_t)(t + 2) * kstep;
            const char* a3 = a2 + kstep; const char* b3 = b2 + kstep;
            if (last && has_next) S.a_ready(nxt);
            if constexpr (SP2) {
            PG8_LDB(B0, 0, 0); PG8_LDB(B1, 0, 1); PG8_SCHED; PG8_LDA(At, 0, 0); PG8_STAGE(PG8_SA(1, 1), a1 + hstep, voffA);
            PG8_WAIT_V(8); PG8_WAIT_L(0); PG8_BAR; PG8_MMA(0, 0, At, B0); PG8_MMA(0, 1, At, B1); PG8_BAR; PG8_SCHED;
            PG8_LDA(At, 0, 1); PG8_STAGE(PG8_SB(0, 0), b2, voffB); PG8_STAGE(PG8_SB(0, 1), b2 + hstep, voffB); PG8_STAGE(PG8_SA(0, 0), a2, voffA);
            PG8_WAIT_V(8); PG8_WAIT_L(0); PG8_BAR; PG8_MMA(1, 0, At, B0); PG8_MMA(1, 1, At, B1); PG8_BAR; PG8_SCHED;
            PG8_LDB(B0, 1, 0); PG8_LDB(B1, 1, 1); PG8_SCHED; PG8_LDA(At, 1, 0); PG8_STAGE(PG8_SA(0, 1), a2 + hstep, voffA);
            PG8_WAIT_V(8); PG8_WAIT_L(0); PG8_BAR; PG8_MMA(0, 0, At, B0); PG8_MMA(0, 1, At, B1); PG8_BAR; PG8_SCHED;
            PG8_LDA(At, 1, 1); PG8_STAGE(PG8_SB(1, 0), b3, voffB); PG8_STAGE(PG8_SB(1, 1), b3 + hstep, voffB); PG8_STAGE(PG8_SA(1, 0), a3, voffA);
            PG8_WAIT_V(8); PG8_WAIT_L(0); PG8_BAR; PG8_MMA(1, 0, At, B0); PG8_MMA(1, 1, At, B1); PG8_BAR; PG8_SCHED;
            } else {
            PG8_LDB(B0, 0, 0); PG8_SCHED; PG8_LDA(At, 0, 0); PG8_STAGE(PG8_SA(1, 1), a1 + hstep, voffA);
            PG8_WAIT_L(8); PG8_BAR; PG8_WAIT_L(0); PG8_MMA(0, 0, At, B0); PG8_BAR; PG8_SCHED;
            PG8_LDB(B1, 0, 1); PG8_STAGE(PG8_SB(0, 0), b2, voffB);
            PG8_BAR; PG8_WAIT_L(0); PG8_MMA(0, 1, At, B1); PG8_BAR;
            PG8_LDA(At, 0, 1); PG8_STAGE(PG8_SA(0, 0), a2, voffA);
            PG8_BAR; PG8_WAIT_L(0); PG8_MMA(1, 0, At, B0); PG8_BAR; PG8_SCHED;
            PG8_STAGE(PG8_SB(0, 1), b2 + hstep, voffB);
            PG8_WAIT_V(6); PG8_BAR; PG8_MMA(1, 1, At, B1); PG8_BAR;
            PG8_LDB(B0, 1, 0); PG8_SCHED; PG8_LDA(At, 1, 0); PG8_STAGE(PG8_SA(0, 1), a2 + hstep, voffA);
            PG8_WAIT_L(8); PG8_BAR; PG8_WAIT_L(0); PG8_MMA(0, 0, At, B0); PG8_BAR; PG8_SCHED;
            PG8_LDB(B1, 1, 1); PG8_STAGE(PG8_SB(1, 0), b3, voffB);
            PG8_BAR; PG8_WAIT_L(0); PG8_MMA(0, 1, At, B1); PG8_BAR;
            PG8_LDA(At, 1, 1); PG8_STAGE(PG8_SA(1, 0), a3, voffA);
            PG8_BAR; PG8_WAIT_L(0); PG8_MMA(1, 0, At, B0); PG8_BAR; PG8_SCHED;
            PG8_STAGE(PG8_SB(1, 1), b3 + hstep, voffB);
            PG8_WAIT_V(6); PG8_BAR; PG8_MMA(1, 1, At, B1); PG8_BAR;
            }
        }
        if constexpr (ALIGN_EPI) { if (wr == 0) PG8_BAR; }
        if constexpr (!Epi::AFTER_DRAIN) { E(acc, cur, wr, wc, fr, fq); S.done(cur); }
        if (!has_next) break;
#pragma unroll
        for (int a = 0; a < 2; ++a)
#pragma unroll
            for (int b = 0; b < 2; ++b)
#pragma unroll
                for (int m = 0; m < 4; ++m)
#pragma unroll
                    for (int n = 0; n < 2; ++n) acc[a][b][m][n] = (f32x4){0.f, 0.f, 0.f, 0.f};
        cur = nxt; cA = nA; cB = nB; ++ui;
        if constexpr (ALIGN_EPI) { if (wr == 1) PG8_BAR; }
    }
    PG8_WAIT_V(0);
    if constexpr (!ALIGN_EPI) { if (wr == 0) PG8_BAR; }
    PG8_BAR;
#undef PG8_SA
#undef PG8_SB
#undef PG8_STAGE
#undef PG8_LDA
#undef PG8_LDB
#undef PG8_MMA
#undef PG8_WAIT_V
#undef PG8_WAIT_L
#undef PG8_BAR
#undef PG8_SCHED
}
}

struct Frame {
    float* out;
    unsigned char* ws;
    char* lds;
    int tid, lane, wave, G, bid;
};

__device__ __forceinline__ float wave_sum(float v) {
#pragma unroll
    for (int o = 32; o >= 1; o >>= 1) v += __shfl_xor(v, o);
    return v;
}
__device__ __forceinline__ float wave_max(float v) {
#pragma unroll
    for (int o = 32; o >= 1; o >>= 1) v = fmaxf(v, __shfl_xor(v, o));
    return v;
}
__device__ __forceinline__ void wave_lds_fence() { __builtin_amdgcn_wave_barrier(); asm volatile("s_waitcnt lgkmcnt(0)" ::: "memory"); __builtin_amdgcn_wave_barrier(); }

__device__ __forceinline__ void sincos_d(double x, float& c, float& s) {
    const double TWO_OVER_PI = 0.63661977236758134308;
    const double PIO2_HI = 1.57079632679489655800e+00, PIO2_LO = 6.12323399573676603587e-17;
    const double q = __builtin_rint(x * TWO_OVER_PI);
    double y = __builtin_fma(-q, PIO2_HI, x); y = __builtin_fma(-q, PIO2_LO, y);
    const double y2 = y * y;
    double sp = 1.0 / 6227020800.0;
    sp = sp * y2 - 1.0 / 39916800.0; sp = sp * y2 + 1.0 / 362880.0; sp = sp * y2 - 1.0 / 5040.0; sp = sp * y2 + 1.0 / 120.0; sp = sp * y2 - 1.0 / 6.0; sp = sp * y2 * y + y;
    double cp = -1.0 / 87178291200.0;
    cp = cp * y2 + 1.0 / 479001600.0; cp = cp * y2 - 1.0 / 3628800.0; cp = cp * y2 + 1.0 / 40320.0; cp = cp * y2 - 1.0 / 720.0; cp = cp * y2 + 1.0 / 24.0; cp = cp * y2 - 0.5; cp = cp * y2 + 1.0;
    const long long qi = (long long)q; const int quad = (int)(qi & 3);
    double sv, cv;
    if (quad == 0) { sv = sp; cv = cp; } else if (quad == 1) { sv = cp; cv = -sp; } else if (quad == 2) { sv = -sp; cv = -cp; } else { sv = -cp; cv = sp; }
    c = (float)cv; s = (float)sv;
}

__device__ __forceinline__ int nsa_src_col(int n) { return n < 5120 ? n : (n < 7168 ? n + 48 : (n < 7216 ? n - 2048 : -1)); }
__device__ __forceinline__ void conv_transpose(const Frame& F, const float* W, int K, int Nsrc, h16* Wt, int Npad, int mapmode, int item0, int& items_done) {
    float* tile = (float*)F.lds;
    const int tk_n = K / 64, tn_n = Npad / 64, ntiles = tk_n * tn_n;
    for (int it = F.bid; it < ntiles; it += F.G) {
        const int tk = it / tn_n, tn = it % tn_n;
        __syncthreads();
#pragma unroll
        for (int i = 0; i < 8; ++i) {
            const int idx = F.tid + i * NTHREADS, k = idx >> 6, n = idx & 63;
            const int nn = tn * 64 + n; const int src = mapmode ? nsa_src_col(nn) : nn;
            float v = 0.f; if (src >= 0 && src < Nsrc) v = W[(size_t)(tk * 64 + k) * Nsrc + src];
            tile[k * 65 + n] = v;
        }
        __syncthreads();
#pragma unroll
        for (int i = 0; i < 8; ++i) {
            const int idx = F.tid + i * NTHREADS, n = idx >> 6, k = idx & 63;
            Wt[(size_t)(tn * 64 + n) * K + tk * 64 + k] = (h16)tile[k * 65 + n];
        }
    }
    __syncthreads();
}
__device__ __forceinline__ void conv_layer_weights(const Frame& F, const Args& A, int L) {
    const int kind = L % 3, j = L / 3; int dummy = 0;
    h16* wtin = (h16*)(F.ws + WS_WTIN); h16* wtout = (h16*)(F.ws + WS_WTOUT);
    if (kind == 0) {
        conv_transpose(F, A.in[7] + (size_t)j * 2048 * 8192, 2048, 8192, wtin, 8192, 0, 0, dummy);
        conv_transpose(F, A.in[8] + (size_t)j * 2048 * 2048, 2048, 2048, wtout, 2048, 0, 0, dummy);
    } else if (kind == 1) {
        conv_transpose(F, A.in[9], 2048, 7216, wtin, NSA_NP, 1, 0, dummy);
        conv_transpose(F, A.in[10], 2048, 2048, wtout, 2048, 0, 0, dummy);
    } else {
        conv_transpose(F, A.in[16], 2048, 12288, wtin, 12288, 0, 0, dummy);
        conv_transpose(F, A.in[17], 4096, 2048, wtout, 2048, 0, 0, dummy);
    }
}

__device__ __forceinline__ void phase_prologue(const Frame& F, const Args& A) {
    {
        float* modp = (float*)(F.ws + WS_MODP);
        const float* c = A.in[1]; const float* aw = A.in[3];
        for (int it = F.bid; it < 384; it += F.G) {
            const int layer = it / 96, r = it % 96, slice = r / 12, nch = r % 12, n = nch * 512 + F.tid;
            const float* w = aw + (size_t)layer * 2048 * 6144 + (size_t)(slice * 256) * 6144 + n;
            float acc = 0.f;
#pragma unroll 8
            for (int k = 0; k < 256; ++k) acc += silu_f(c[slice * 256 + k]) * w[(size_t)k * 6144];
            modp[(size_t)(slice * 4 + layer) * 6144 + n] = acc;
        }
    }
    {
        const int* pos = (const int*)A.in[2];
        f32x2* r16 = (f32x2*)(F.ws + WS_ROPE16); f32x2* r128 = (f32x2*)(F.ws + WS_ROPE128);
        for (int idx = F.bid * NTHREADS + F.tid; idx < S * 16; idx += F.G * NTHREADS) {
            const int t = idx >> 4, j = idx & 15; float cs, sn; sincos_d((double)pos[t] * A.inv16[j], cs, sn); r16[idx] = (f32x2){cs, sn};
        }
        for (int idx = F.bid * NTHREADS + F.tid; idx < S * 128; idx += F.G * NTHREADS) {
            const int t = idx >> 7, j = idx & 127; float cs, sn; sincos_d((double)pos[t] * A.inv128[j], cs, sn); r128[idx] = (f32x2){cs, sn};
        }
    }
    conv_layer_weights(F, A, 0);
}

__device__ __forceinline__ void phase_norm(const Frame& F, const Args& A, int Lprev, int Lnext) {
    float* modl = (float*)F.lds;
    const float* modp = (const float*)(F.ws + WS_MODP); const float* ab = A.in[4];
    __syncthreads();
    for (int i = F.tid; i < 6144; i += NTHREADS) {
        const int which = i >> 11, col = i & 2047;
        int layer, mcol;
        if (which == 0) { layer = Lprev; mcol = 4096 + col; } else if (which == 1) { layer = Lnext; mcol = 2048 + col; } else { layer = Lnext; mcol = col; }
        float v = 0.f;
        if (layer >= 0) { v = ab[layer * 6144 + mcol];
#pragma unroll
            for (int s = 0; s < 8; ++s) v += modp[(size_t)(s * 4 + layer) * 6144 + mcol]; }
        modl[i] = v;
    }
    __syncthreads();
    const float* xin = (Lprev <= 0) ? A.in[0] : F.out;
    const float* Y = (const float*)(F.ws + WS_Y);
    h16* H = (h16*)(F.ws + WS_H);
    const float* npost = A.in[6] + (Lprev >= 0 ? Lprev : 0) * 2048;
    const float* npre = A.in[5] + (Lnext >= 0 ? Lnext : 0) * 2048;
    for (int t = F.bid * 8 + F.wave; t < S; t += F.G * 8) {
        f32x4 x[8];
#pragma unroll
        for (int i = 0; i < 8; ++i) x[i] = *(const f32x4*)(xin + (size_t)t * D + i * 256 + F.lane * 4);
        if (Lprev >= 0) {
            f32x4 y[8]; float ss = 0.f;
#pragma unroll
            for (int i = 0; i < 8; ++i) { y[i] = *(const f32x4*)(Y + (size_t)t * D + i * 256 + F.lane * 4); ss += y[i][0] * y[i][0] + y[i][1] * y[i][1] + y[i][2] * y[i][2] + y[i][3] * y[i][3]; }
            ss = wave_sum(ss);
            const float r = 1.0f / sqrtf(ss * (1.0f / D) + EPS);
#pragma unroll
            for (int i = 0; i < 8; ++i) {
                const int col = i * 256 + F.lane * 4;
                const f32x4 g = *(const f32x4*)(npost + col); const f32x4 gt = *(const f32x4*)(modl + col);
#pragma unroll
                for (int e = 0; e < 4; ++e) x[i][e] += gt[e] * (y[i][e] * r * g[e]);
                *(f32x4*)(F.out + (size_t)t * D + col) = x[i];
            }
        }
        if (Lnext >= 0) {
            float ss = 0.f;
#pragma unroll
            for (int i = 0; i < 8; ++i) ss += x[i][0] * x[i][0] + x[i][1] * x[i][1] + x[i][2] * x[i][2] + x[i][3] * x[i][3];
            ss = wave_sum(ss);
            const float r = 1.0f / sqrtf(ss * (1.0f / D) + EPS);
#pragma unroll
            for (int i = 0; i < 8; ++i) {
                const int col = i * 256 + F.lane * 4;
                const f32x4 g = *(const f32x4*)(npre + col); const f32x4 sc = *(const f32x4*)(modl + 2048 + col); const f32x4 sh = *(const f32x4*)(modl + 4096 + col);
                h16x4 hv;
#pragma unroll
                for (int e = 0; e < 4; ++e) hv[e] = (h16)((x[i][e] * r * g[e]) * (1.0f + sc[e]) + sh[e]);
                *(h16x4*)(H + (size_t)t * D + col) = hv;
            }
        }
    }
    if (Lnext > 0) conv_layer_weights(F, A, Lnext);
}

__device__ __forceinline__ void phase_nsa_cmp(const Frame& F, const Args& A) {
    const h16* KVb = (const h16*)(F.ws + WS_QKV) + (size_t)16 * S * 128;
    const float* pe_g = A.in[11];
    h16* xs = (h16*)F.lds;
    float* pe = (float*)(F.lds + 36864);
    float* hid = (float*)(F.lds + 36864 + 16384);
    for (int it = F.bid; it < 512; it += F.G) {
        const int kv = it >> 8, g = (it >> 6) & 3, nb = it & 63;
        const h16* src = KVb + ((size_t)kv * 4 + g) * S * 128;
        const float* W1 = kv ? A.in[14] : A.in[12]; const float* W2 = kv ? A.in[15] : A.in[13];
        h16* dst = (h16*)(F.ws + (kv ? WS_VCMP : WS_KCMP)) + (size_t)g * 512 * 128;
        __syncthreads();
        for (int i = F.tid; i < 144 * 16; i += NTHREADS) {
            const int r = i >> 4, c8 = (i & 15) * 8, tok = nb * 128 + r;
            h16x8 v;
#pragma unroll
            for (int e = 0; e < 8; ++e) v[e] = (h16)0.f;
            if (tok < S) v = *(const h16x8*)(src + (size_t)tok * 128 + c8);
            *(h16x8*)(xs + r * 128 + c8) = v;
        }
        for (int i = F.tid; i < 4096; i += NTHREADS) pe[i] = pe_g[i];
        __syncthreads();
        {
            const int j = F.tid & 255, rh = F.tid >> 8;
            float acc[4] = {0.f, 0.f, 0.f, 0.f};
            for (int pos = 0; pos < 32; ++pos) {
#pragma unroll 4
                for (int d = 0; d < 128; ++d) {
                    const float w = W1[(size_t)(pos * 128 + d) * 256 + j]; const float pv = pe[pos * 128 + d];
#pragma unroll
                    for (int rr = 0; rr < 4; ++rr) acc[rr] += ((float)xs[(16 * (rh * 4 + rr) + pos) * 128 + d] + pv) * w;
                }
            }
#pragma unroll
            for (int rr = 0; rr < 4; ++rr) hid[(rh * 4 + rr) * 256 + j] = silu_f(acc[rr]);
        }
        __syncthreads();
        {
            const int d = F.tid & 127, rq = F.tid >> 7;
            float a0 = 0.f, a1 = 0.f;
#pragma unroll 4
            for (int j = 0; j < 256; ++j) { const float w = W2[j * 128 + d]; a0 += hid[rq * 256 + j] * w; a1 += hid[(rq + 4) * 256 + j] * w; }
            const int n0 = nb * 8 + rq, n1 = nb * 8 + rq + 4;
            dst[(size_t)n0 * 128 + d] = (n0 < NC) ? (h16)a0 : (h16)0.f; dst[(size_t)n1 * 128 + d] = (n1 < NC) ? (h16)a1 : (h16)0.f;
        }
    }
    __syncthreads();
}


namespace fa {
typedef float f32x16 __attribute__((ext_vector_type(16)));
typedef unsigned u32x2 __attribute__((ext_vector_type(2)));
constexpr float LOG2E = 1.4426950408889634f;
constexpr int KROW = 272, VROW = 320;
constexpr int KT_BYTES = 64 * KROW, BUF_BYTES = KT_BYTES + 64 * VROW;
typedef short s16x4v __attribute__((__vector_size__(4 * sizeof(short))));
constexpr int LDS_IMP = 2 * BUF_BYTES;
constexpr int LDS_SELW = LDS_IMP + 32768;
constexpr int LDS_SV = LDS_SELW + 1024;
static_assert(LDS_SV + 4096 <= MISC_OFF, "attention LDS map");

struct Stage { u32x4 k[2], v[2]; };
__device__ __forceinline__ void stage_load(Stage& st, const h16* Kg, const h16* VTg, int j, int tid) {
    asm volatile("" : "+v"(tid));
#pragma unroll
    for (int i = 0; i < 2; ++i) { const int idx = tid + 512 * i;
        st.k[i] = *(const u32x4*)(Kg + (size_t)(j * 64 + (idx >> 4)) * 128 + (idx & 15) * 8);
        st.v[i] = *(const u32x4*)(VTg + (size_t)(j * 64 + (idx >> 4)) * 128 + (idx & 15) * 8); }
}
__device__ __forceinline__ void stage_write(const Stage& st, LAS unsigned char* buf, int tid) {
    asm volatile("" : "+v"(tid));
#pragma unroll
    for (int i = 0; i < 2; ++i) { const int idx = tid + 512 * i;
        *(LAS u32x4*)(buf + (idx >> 4) * KROW + (idx & 15) * 16) = st.k[i];
        *(LAS u32x4*)(buf + KT_BYTES + (idx >> 4) * VROW + (idx & 15) * 16) = st.v[i]; }
}

template <int MODE>
__device__ __forceinline__ void tile_compute(const LAS unsigned char* buf, int j, const h16x8 (&qf)[8], f32x16 (&o)[4], float& m, float& l,
                                             bool on, int lo, int hi, int lane, float inv_l, LAS float* imp_q) {
    const int r31 = lane & 31, h = lane >> 5, k0 = j * 64;
    const bool need = on && (k0 <= hi) && (k0 + 63 >= lo);
    if (__ballot(need) == 0ull) return;
    f32x16 s0, s1;
#pragma unroll
    for (int r = 0; r < 16; ++r) { s0[r] = 0.f; s1[r] = 0.f; }
    const LAS unsigned char* kp = buf + r31 * KROW + h * 16;
#pragma unroll
    for (int s = 0; s < 8; ++s) {
        const h16x8 a0 = *(const LAS h16x8*)(kp + s * 32);
        const h16x8 a1 = *(const LAS h16x8*)(kp + 32 * KROW + s * 32);
        s0 = __builtin_amdgcn_mfma_f32_32x32x16_f16(a0, qf[s], s0, 0, 0, 0);
        s1 = __builtin_amdgcn_mfma_f32_32x32x16_f16(a1, qf[s], s1, 0, 0, 0);
        if ((s & 1) == 1) __builtin_amdgcn_sched_barrier(0);
    }
    float tmax = NEGF;
#pragma unroll
    for (int r = 0; r < 16; ++r) {
        const int key0 = k0 + (r & 3) + 8 * (r >> 2) + 4 * h, key1 = key0 + 32;
        const bool v0 = on && key0 >= lo && key0 <= hi, v1 = on && key1 >= lo && key1 <= hi;
        s0[r] = v0 ? s0[r] * LOG2E : NEGF; s1[r] = v1 ? s1[r] * LOG2E : NEGF;
        tmax = fmaxf(tmax, fmaxf(s0[r], s1[r]));
    }
    if (MODE != 2) {
        tmax = fmaxf(tmax, __shfl_xor(tmax, 32));
        const float m_new = fmaxf(m, tmax);
        const float alpha = __builtin_amdgcn_exp2f(m - m_new);
        float sum = 0.f;
#pragma unroll
        for (int r = 0; r < 16; ++r) {
            s0[r] = (s0[r] > 0.5f * NEGF) ? __builtin_amdgcn_exp2f(s0[r] - m_new) : 0.f;
            s1[r] = (s1[r] > 0.5f * NEGF) ? __builtin_amdgcn_exp2f(s1[r] - m_new) : 0.f;
            sum += s0[r] + s1[r];
        }
        l = l * alpha + sum; m = m_new;
        if (MODE == 1) return;
#pragma unroll
        for (int dt = 0; dt < 4; ++dt) o[dt] = o[dt] * alpha;
    } else {
#pragma unroll
        for (int r = 0; r < 16; ++r) {
            s0[r] = (s0[r] > 0.5f * NEGF) ? __builtin_amdgcn_exp2f(s0[r] - m) * inv_l : 0.f;
            s1[r] = (s1[r] > 0.5f * NEGF) ? __builtin_amdgcn_exp2f(s1[r] - m) * inv_l : 0.f;
        }
#pragma unroll
        for (int c = 0; c < 4; ++c) {
            const int sa = 16 * j + 2 * c + h, sb = sa + 8;
            const float a0 = s0[4 * c] + s0[4 * c + 1] + s0[4 * c + 2] + 0.5f * s0[4 * c + 3], b0 = 0.5f * s0[4 * c + 3];
            const float a1 = s1[4 * c] + s1[4 * c + 1] + s1[4 * c + 2] + 0.5f * s1[4 * c + 3], b1 = 0.5f * s1[4 * c + 3];
            (void)__hip_atomic_fetch_add(imp_q + sa, a0, __ATOMIC_RELAXED, __HIP_MEMORY_SCOPE_WORKGROUP); if (sa + 1 < 128) (void)__hip_atomic_fetch_add(imp_q + sa + 1, b0, __ATOMIC_RELAXED, __HIP_MEMORY_SCOPE_WORKGROUP);
            (void)__hip_atomic_fetch_add(imp_q + sb, a1, __ATOMIC_RELAXED, __HIP_MEMORY_SCOPE_WORKGROUP); if (sb + 1 < 128) (void)__hip_atomic_fetch_add(imp_q + sb + 1, b1, __ATOMIC_RELAXED, __HIP_MEMORY_SCOPE_WORKGROUP);
        }
    }
    h16x8 pb[2][2];
#pragma unroll
    for (int sp = 0; sp < 2; ++sp)
#pragma unroll
        for (int jj = 0; jj < 8; ++jj) { pb[0][sp][jj] = (h16)s0[8 * sp + jj]; pb[1][sp][jj] = (h16)s1[8 * sp + jj]; }
    const LAS unsigned char* vbase = buf + KT_BYTES + (4 * h + ((lane & 15) >> 2)) * VROW + (16 * ((lane >> 4) & 1) + 4 * (lane & 3)) * 2;
#pragma unroll
    for (int dt = 0; dt < 4; ++dt) {
#pragma unroll
        for (int sub = 0; sub < 2; ++sub)
#pragma unroll
            for (int sp = 0; sp < 2; ++sp) {
                const LAS unsigned char* vp = vbase + (32 * sub + 16 * sp) * VROW + 64 * dt;
                const s16x4v lo4 = __builtin_amdgcn_ds_read_tr16_b64_v4i16((LAS s16x4v*)vp), hi4 = __builtin_amdgcn_ds_read_tr16_b64_v4i16((LAS s16x4v*)(vp + 8 * VROW));
                const h16x4 l4 = __builtin_bit_cast(h16x4, lo4), h4 = __builtin_bit_cast(h16x4, hi4);
                h16x8 va; va[0] = l4[0]; va[1] = l4[1]; va[2] = l4[2]; va[3] = l4[3]; va[4] = h4[0]; va[5] = h4[1]; va[6] = h4[2]; va[7] = h4[3];
                o[dt] = __builtin_amdgcn_mfma_f32_32x32x16_f16(va, pb[sub][sp], o[dt], 0, 0, 0);
            }
        __builtin_amdgcn_sched_barrier(0);
    }
}

template <int MODE, class OnFn>
__device__ __forceinline__ void stream(LAS unsigned char* lds, const h16* Kg, const h16* VTg, int jlo, int jhi, const h16x8 (&qf)[8],
                                       f32x16 (&o)[4], float& m, float& l, int lo, int hi, const OnFn& on_fn, int tid, int lane, float inv_l, LAS float* imp_q) {
    if (jlo >= jhi) return;
    Stage st;
    stage_load(st, Kg, VTg, jlo, tid);
    stage_write(st, lds, tid);
    __syncthreads();
    for (int j = jlo; j < jhi; ++j) {
        const int cur = (j - jlo) & 1;
        if (j + 1 < jhi) stage_load(st, Kg, VTg, j + 1, tid);
        tile_compute<MODE>(lds + cur * BUF_BYTES, j, qf, o, m, l, on_fn(j), lo, hi, lane, inv_l, imp_q);
        if (j + 1 < jhi) stage_write(st, lds + (cur ^ 1) * BUF_BYTES, tid);
        __syncthreads();
    }
}

__device__ __forceinline__ void load_q(h16x8 (&qf)[8], const h16* qrow, int h) {
#pragma unroll
    for (int s = 0; s < 8; ++s) qf[s] = *(const h16x8*)(qrow + 16 * s + 8 * h);
}
__device__ __forceinline__ void zero_o(f32x16 (&o)[4]) {
#pragma unroll
    for (int dt = 0; dt < 4; ++dt)
#pragma unroll
        for (int r = 0; r < 16; ++r) o[dt][r] = 0.f;
}
}

struct MobaOn { unsigned selmask; int b; __device__ __forceinline__ bool operator()(int j) const { const int jb = j >> 2; return jb == b ? true : (((selmask >> jb) & 1u) != 0u); } };
__device__ __forceinline__ void phase_moba_attn_mfma(const Frame& F) {
    const h16* Q = (const h16*)(F.ws + WS_QKV); const h16* K = Q + (size_t)16 * S * 128; const h16* VT = K + (size_t)16 * S * 128; const h16* Z = VT + (size_t)16 * S * 128;
    const float* kmean = (const float*)(F.ws + WS_KMEAN);
    h16* OZ = (h16*)(F.ws + WS_OZ);
    LAS unsigned char* lds = (LAS unsigned char*)F.lds;
    const int lane = F.lane, r31 = lane & 31, h = lane >> 5;
    for (int it = F.bid; it < 256; it += F.G) {
        const int head = it >> 4, pi = it & 15;
#pragma unroll 1
        for (int half = 0; half < 2; ++half) {
            const int b = half ? 31 - pi : pi;
            const int t = b * 256 + F.wave * 32 + r31;
            h16x8 qf[8]; fa::load_q(qf, Q + ((size_t)head * S + t) * 128, h);
            float v0 = NEGF, v1 = NEGF, v2 = NEGF; int i0 = -1, i1 = -1, i2 = -1;
            for (int jb = 0; jb < b; ++jb) {
                const float* km = kmean + ((size_t)head * 32 + jb) * 128 + 8 * h;
                float d = 0.f;
#pragma unroll
                for (int s = 0; s < 8; ++s) { const f32x4 ka = *(const f32x4*)(km + 16 * s) + *(const f32x4*)(km + 65536 + 16 * s), kb = *(const f32x4*)(km + 16 * s + 4) + *(const f32x4*)(km + 65536 + 16 * s + 4);
                    d += (float)qf[s][0] * ka[0] + (float)qf[s][1] * ka[1] + (float)qf[s][2] * ka[2] + (float)qf[s][3] * ka[3] + (float)qf[s][4] * kb[0] + (float)qf[s][5] * kb[1] + (float)qf[s][6] * kb[2] + (float)qf[s][7] * kb[3]; }
                d += __shfl_xor(d, 32);
                if (d > v0) { v2 = v1; i2 = i1; v1 = v0; i1 = i0; v0 = d; i0 = jb; }
                else if (d > v1) { v2 = v1; i2 = i1; v1 = d; i1 = jb; }
                else if (d > v2) { v2 = d; i2 = jb; }
            }
            MobaOn on; on.b = b; on.selmask = (i0 >= 0 ? 1u << i0 : 0u) | (i1 >= 0 ? 1u << i1 : 0u) | (i2 >= 0 ? 1u << i2 : 0u);
            fa::f32x16 o[4]; fa::zero_o(o); float m = NEGF, l = 0.f;
            fa::stream<0>(lds, K + (size_t)head * S * 128, VT + (size_t)head * S * 128, 0, 4 * b + 4, qf, o, m, l, 0, t, on, F.tid, lane, 0.f, (LAS float*)nullptr);
            l += __shfl_xor(l, 32);
            const float inv = 1.0f / fmaxf(l, 1e-30f);
#pragma unroll
            for (int dt = 0; dt < 4; ++dt)
#pragma unroll
                for (int c = 0; c < 4; ++c) {
                    const int d = 32 * dt + 8 * c + 4 * h; const size_t off = (size_t)t * 2048 + head * 128 + d;
                    const h16x4 zz = *(const h16x4*)(Z + off); h16x4 ov;
#pragma unroll
                    for (int e = 0; e < 4; ++e) ov[e] = (h16)(o[dt][4 * c + e] * inv * (float)zz[e]);
                    *(h16x4*)(OZ + off) = ov;
                }
        }
    }
}

struct AllOn { __device__ __forceinline__ bool operator()(int) const { return true; } };
struct SelOn { const LAS unsigned* w; __device__ __forceinline__ bool operator()(int j) const { return ((w[j >> 5] >> (j & 31)) & 1u) != 0u; } };
__device__ __forceinline__ void phase_nsa_attn_mfma(const Frame& F) {
    const h16* Q = (const h16*)(F.ws + WS_QKV); const h16* KVb = Q + (size_t)16 * S * 128;
    const h16* Z = (const h16*)(F.ws + WS_QKV + 96 * MiB);
    const float* gates = (const float*)(F.ws + WS_GATES);
    const h16* KCMP = (const h16*)(F.ws + WS_KCMP); const h16* VCMPT = (const h16*)(F.ws + WS_VCMP);
    h16* OZ = (h16*)(F.ws + WS_OZ);
    LAS unsigned char* lds = (LAS unsigned char*)F.lds;
    LAS float* imp = (LAS float*)(lds + fa::LDS_IMP); LAS unsigned* selw = (LAS unsigned*)(lds + fa::LDS_SELW); LAS float* sv = (LAS float*)(lds + fa::LDS_SV) + F.wave * 128;
    const int lane = F.lane, r31 = lane & 31, h = lane >> 5, hh = F.wave & 3, qsub = F.wave >> 2;
    for (int it = F.bid; it < 256; it += F.G) {
        const int g = it >> 6, pi = it & 63, head = 4 * g + hh;
#pragma unroll 1
        for (int half = 0; half < 2; ++half) {
            const int c64 = half ? 127 - pi : pi;
            const int ql = 32 * qsub + r31, t = c64 * 64 + ql;
            h16x8 qf[8]; fa::load_q(qf, Q + ((size_t)head * S + t) * 128, h);
            fa::f32x16 o[4]; float m, l;
            for (int i = F.tid; i < 64 * 128; i += NTHREADS) imp[i] = 0.f;
            const int nval = (t >= 31) ? (((t - 31) >> 4) + 1 < NC ? ((t - 31) >> 4) + 1 : NC) : 0;
            const int tl = c64 * 64 + 63; const int nval_max = (tl >= 31) ? (((tl - 31) >> 4) + 1 < NC ? ((tl - 31) >> 4) + 1 : NC) : 0;
            const int jc = (nval_max + 63) >> 6;
            fa::zero_o(o); m = NEGF; l = 0.f;
            fa::stream<1>(lds, KCMP + (size_t)g * 512 * 128, VCMPT + (size_t)g * 512 * 128, 0, jc, qf, o, m, l, 0, nval - 1, AllOn(), F.tid, lane, 0.f, (LAS float*)nullptr);
            l += __shfl_xor(l, 32);
            { const float invl = 1.0f / fmaxf(l, 1e-30f); float l2 = 0.f;
              fa::stream<2>(lds, KCMP + (size_t)g * 512 * 128, VCMPT + (size_t)g * 512 * 128, 0, jc, qf, o, m, l2, 0, nval - 1, AllOn(), F.tid, lane, invl, imp + ql * 128); }
            const float g0 = gates[(size_t)t * 48 + head * 3 + 0];
#pragma unroll
            for (int dt = 0; dt < 4; ++dt)
#pragma unroll
                for (int c = 0; c < 4; ++c) { h16x4 ov;
#pragma unroll
                    for (int e = 0; e < 4; ++e) ov[e] = (h16)(o[dt][4 * c + e] * g0);
                    *(h16x4*)(OZ + (size_t)t * 2048 + head * 128 + 32 * dt + 8 * c + 4 * h) = ov; }
            __syncthreads();
            for (int qq = 0; qq < 8; ++qq) {
                const int q = F.wave * 8 + qq;
                float myv[2];
#pragma unroll
                for (int c = 0; c < 2; ++c) { const int s = lane + 64 * c; const bool valid = s <= c64, forced = (s == 0) || (s == c64) || (s == c64 - 1);
                    myv[c] = valid ? (forced ? BIGF : imp[q * 128 + s]) : NEGF; sv[s] = myv[c]; }
                wave_lds_fence();
                int rank0 = 0, rank1 = 0;
                for (int s2 = 0; s2 < 128; ++s2) { const float v2 = sv[s2];
                    rank0 += (v2 > myv[0] || (v2 == myv[0] && s2 < lane)) ? 1 : 0; rank1 += (v2 > myv[1] || (v2 == myv[1] && s2 < lane + 64)) ? 1 : 0; }
                const unsigned long long m0 = __ballot(rank0 < 16 && lane <= c64), m1 = __ballot(rank1 < 16 && (lane + 64) <= c64);
                if (lane == 0) { selw[q * 4 + 0] = (unsigned)m0; selw[q * 4 + 1] = (unsigned)(m0 >> 32); selw[q * 4 + 2] = (unsigned)m1; selw[q * 4 + 3] = (unsigned)(m1 >> 32); }
                wave_lds_fence();
            }
            __syncthreads();
            SelOn son; son.w = selw + ql * 4;
            fa::zero_o(o); m = NEGF; l = 0.f;
            fa::stream<0>(lds, KVb + ((size_t)2 * 4 + g) * S * 128, KVb + ((size_t)3 * 4 + g) * S * 128, 0, c64 + 1, qf, o, m, l, 0, t, son, F.tid, lane, 0.f, (LAS float*)nullptr);
            l += __shfl_xor(l, 32);
            { const float sc = gates[(size_t)t * 48 + head * 3 + 1] / fmaxf(l, 1e-30f);
#pragma unroll
              for (int dt = 0; dt < 4; ++dt)
#pragma unroll
                  for (int c = 0; c < 4; ++c) { h16* p = OZ + (size_t)t * 2048 + head * 128 + 32 * dt + 8 * c + 4 * h; const h16x4 pv = *(const h16x4*)p; h16x4 ov;
#pragma unroll
                      for (int e = 0; e < 4; ++e) ov[e] = (h16)((float)pv[e] + o[dt][4 * c + e] * sc);
                      *(h16x4*)p = ov; } }
            fa::zero_o(o); m = NEGF; l = 0.f;
            fa::stream<0>(lds, KVb + ((size_t)4 * 4 + g) * S * 128, KVb + ((size_t)5 * 4 + g) * S * 128, (c64 >= 8 ? c64 - 8 : 0), c64 + 1, qf, o, m, l, t - 511, t, AllOn(), F.tid, lane, 0.f, (LAS float*)nullptr);
            l += __shfl_xor(l, 32);
            const float sc2 = gates[(size_t)t * 48 + head * 3 + 2] / fmaxf(l, 1e-30f);
#pragma unroll
            for (int dt = 0; dt < 4; ++dt)
#pragma unroll
                for (int c = 0; c < 4; ++c) {
                    const int d = 32 * dt + 8 * c + 4 * h; const size_t off = (size_t)t * 2048 + head * 128 + d;
                    const h16x4 zz = *(const h16x4*)(Z + off); const h16x4 pv = *(const h16x4*)(OZ + off); h16x4 ov;
#pragma unroll
                    for (int e = 0; e < 4; ++e) ov[e] = (h16)(((float)pv[e] + o[dt][4 * c + e] * sc2) * (float)zz[e]);
                    *(h16x4*)(OZ + off) = ov;
                }
        }
    }
}

__device__ __forceinline__ double gamma_of(int h) { return 1.0 - 1.0 / (double)(32 << h); }
__device__ __forceinline__ double dpow_int(double b, int n) { double p = 1.0; for (int i = 0; i < n; ++i) p *= b; return p; }

__device__ __forceinline__ void phase_ret_scan(const Frame& F) {
    const h16* RQ = (const h16*)(F.ws + WS_QKV); const h16* RK = RQ + (size_t)8 * S * 256; const h16* RV = RK + (size_t)8 * S * 256;
    h16* SB = (h16*)(F.ws + WS_P);
    float* ks = (float*)F.lds;
    h16* vs = (h16*)(F.lds + 32768);
    float* wd = (float*)(F.lds + 49152);
    for (int it = F.bid; it < 256; it += F.G) {
        const int h = it >> 5, dk0 = ((it >> 3) & 3) * 64, dv0 = (it & 7) * 64;
        const double gam = gamma_of(h);
        __syncthreads();
        if (F.tid < 128) wd[F.tid] = (float)dpow_int(gam, 127 - F.tid);
        const float carry = (float)dpow_int(gam, 128);
        const int tk = F.tid >> 3, tv = F.tid & 7;
        float st[8];
#pragma unroll
        for (int e = 0; e < 8; ++e) st[e] = 0.f;
        __syncthreads();
        for (int c = 0; c < 64; ++c) {
            { h16x8 o;
#pragma unroll
              for (int e = 0; e < 8; ++e) o[e] = (h16)st[e];
              *(h16x8*)(SB + (((size_t)h * 64 + c) * 256 + dk0 + tk) * 512 + dv0 + tv * 8) = o; }
            for (int i = F.tid; i < 128 * 8; i += NTHREADS) {
                const int j = i >> 3, c8 = (i & 7) * 8;
                const h16x8 kk = *(const h16x8*)(RK + ((size_t)h * S + c * 128 + j) * 256 + dk0 + c8);
                const h16x8 vv = *(const h16x8*)(RV + ((size_t)h * S + c * 128 + j) * 512 + dv0 + c8);
                const float w = wd[j];
#pragma unroll
                for (int e = 0; e < 8; ++e) ks[j * 64 + c8 + e] = (float)kk[e] * w;
                *(h16x8*)(vs + j * 64 + c8) = vv;
            }
            __syncthreads();
#pragma unroll
            for (int e = 0; e < 8; ++e) st[e] *= carry;
#pragma unroll 4
            for (int j = 0; j < 128; ++j) {
                const float kf = ks[j * 64 + tk]; const h16x8 vv = *(const h16x8*)(vs + j * 64 + tv * 8);
#pragma unroll
                for (int e = 0; e < 8; ++e) st[e] += kf * (float)vv[e];
            }
            __syncthreads();
        }
    }
}

__device__ __forceinline__ void phase_ret_out(const Frame& F) {
    const h16* RQ = (const h16*)(F.ws + WS_QKV); const h16* RK = RQ + (size_t)8 * S * 256; const h16* RV = RK + (size_t)8 * S * 256;
    const h16* SB = (const h16*)(F.ws + WS_P);
    float* OR_ = (float*)(F.ws + WS_OR);
    h16* Qs = (h16*)F.lds;
    float* AsT = (float*)(F.lds + 65536);
    float* rd = (float*)(F.lds + 131072);
    for (int it = F.bid; it < 512; it += F.G) {
        const int h = it >> 6, c = it & 63;
        const double gam = gamma_of(h);
        __syncthreads();
        if (F.tid < 130) rd[F.tid] = (float)dpow_int(gam, F.tid);
        for (int i = F.tid; i < 128 * 32; i += NTHREADS) {
            const int r = i >> 5, c8 = (i & 31) * 8;
            *(h16x8*)(Qs + r * 256 + c8) = *(const h16x8*)(RQ + ((size_t)h * S + c * 128 + r) * 256 + c8);
        }
        __syncthreads();
        {
            const int j = F.tid & 127, ig = F.tid >> 7;
            float acc[32];
#pragma unroll
            for (int ii = 0; ii < 32; ++ii) acc[ii] = 0.f;
            const h16* krow = RK + ((size_t)h * S + c * 128 + j) * 256;
            for (int d8 = 0; d8 < 32; ++d8) {
                const h16x8 kv = *(const h16x8*)(krow + d8 * 8);
                const h16x2 k0 = {kv[0], kv[1]}, k1 = {kv[2], kv[3]}, k2 = {kv[4], kv[5]}, k3 = {kv[6], kv[7]};
#pragma unroll
                for (int ii = 0; ii < 32; ++ii) {
                    const h16x8 qv = *(const h16x8*)(Qs + (ig * 32 + ii) * 256 + d8 * 8);
                    float a = acc[ii];
                    a = __builtin_amdgcn_fdot2((h16x2){qv[0], qv[1]}, k0, a, false); a = __builtin_amdgcn_fdot2((h16x2){qv[2], qv[3]}, k1, a, false);
                    a = __builtin_amdgcn_fdot2((h16x2){qv[4], qv[5]}, k2, a, false); a = __builtin_amdgcn_fdot2((h16x2){qv[6], qv[7]}, k3, a, false);
                    acc[ii] = a;
                }
            }
#pragma unroll
            for (int ii = 0; ii < 32; ++ii) { const int i = ig * 32 + ii; AsT[j * 128 + i] = (i >= j) ? acc[ii] * rd[i - j] : 0.f; }
        }
        __syncthreads();
        for (int i = F.tid; i < 128 * 32; i += NTHREADS) {
            const int r = i >> 5, c8 = (i & 31) * 8; const float w = rd[r + 1];
            h16x8 q = *(h16x8*)(Qs + r * 256 + c8);
#pragma unroll
            for (int e = 0; e < 8; ++e) q[e] = (h16)((float)q[e] * w);
            *(h16x8*)(Qs + r * 256 + c8) = q;
        }
        __syncthreads();
        {
            const int dv = F.tid;
            float acc[128];
#pragma unroll
            for (int i = 0; i < 128; ++i) acc[i] = 0.f;
            const h16* vcol = RV + ((size_t)h * S + c * 128) * 512 + dv;
            for (int j = 0; j < 128; ++j) {
                const float v = (float)vcol[(size_t)j * 512];
#pragma unroll
                for (int i4 = 0; i4 < 32; ++i4) {
                    const f32x4 a = *(const f32x4*)(AsT + j * 128 + i4 * 4);
                    acc[i4 * 4 + 0] += a[0] * v; acc[i4 * 4 + 1] += a[1] * v; acc[i4 * 4 + 2] += a[2] * v; acc[i4 * 4 + 3] += a[3] * v;
                }
            }
            const h16* scol = SB + (((size_t)h * 64 + c) * 256) * 512 + dv;
            for (int d8 = 0; d8 < 32; ++d8) {
                h16x2 s0, s1, s2, s3;
                s0[0] = scol[(size_t)(d8 * 8 + 0) * 512]; s0[1] = scol[(size_t)(d8 * 8 + 1) * 512]; s1[0] = scol[(size_t)(d8 * 8 + 2) * 512]; s1[1] = scol[(size_t)(d8 * 8 + 3) * 512];
                s2[0] = scol[(size_t)(d8 * 8 + 4) * 512]; s2[1] = scol[(size_t)(d8 * 8 + 5) * 512]; s3[0] = scol[(size_t)(d8 * 8 + 6) * 512]; s3[1] = scol[(size_t)(d8 * 8 + 7) * 512];
#pragma unroll
                for (int i = 0; i < 128; ++i) {
                    const h16x8 qv = *(const h16x8*)(Qs + i * 256 + d8 * 8);
                    float a = acc[i];
                    a = __builtin_amdgcn_fdot2((h16x2){qv[0], qv[1]}, s0, a, false); a = __builtin_amdgcn_fdot2((h16x2){qv[2], qv[3]}, s1, a, false);
                    a = __builtin_amdgcn_fdot2((h16x2){qv[4], qv[5]}, s2, a, false); a = __builtin_amdgcn_fdot2((h16x2){qv[6], qv[7]}, s3, a, false);
                    acc[i] = a;
                }
            }
#pragma unroll
            for (int i = 0; i < 128; ++i) OR_[(size_t)(c * 128 + i) * 4096 + h * 512 + dv] = acc[i];
        }
    }
    __syncthreads();
}

__device__ __forceinline__ void phase_ret_gn(const Frame& F) {
    const float* OR_ = (const float*)(F.ws + WS_OR);
    const h16* RG = (const h16*)(F.ws + WS_QKV) + (size_t)8 * S * 256 * 2 + (size_t)8 * S * 512;
    h16* OZ = (h16*)(F.ws + WS_OZ);
    for (int task = F.bid * 8 + F.wave; task < S * 8; task += F.G * 8) {
        const int t = task >> 3, h = task & 7;
        const size_t off = (size_t)t * 4096 + h * 512 + F.lane * 8;
        const f32x4 a = *(const f32x4*)(OR_ + off), b = *(const f32x4*)(OR_ + off + 4);
        float s = a[0] + a[1] + a[2] + a[3] + b[0] + b[1] + b[2] + b[3];
        s = wave_sum(s); const float mu = s * (1.0f / 512.0f);
        float q = 0.f;
#pragma unroll
        for (int e = 0; e < 4; ++e) { const float d0 = a[e] - mu, d1 = b[e] - mu; q += d0 * d0 + d1 * d1; }
        q = wave_sum(q); const float r = 1.0f / sqrtf(q * (1.0f / 512.0f) + EPS);
        const h16x8 gv = *(const h16x8*)(RG + off);
        h16x8 o;
#pragma unroll
        for (int e = 0; e < 4; ++e) { o[e] = (h16)((float)gv[e] * ((a[e] - mu) * r)); o[4 + e] = (h16)((float)gv[4 + e] * ((b[e] - mu) * r)); }
        *(h16x8*)(OZ + off) = o;
    }
}

template <int KIND>
__device__ __forceinline__ void phase_gemm_proj(const Frame& F, int N) {
    pg8::Gemm g{(const h16*)(F.ws + WS_H), (const h16*)(F.ws + WS_WTIN), S, N, 2048}; pg8::StaticOrder So; So.init(S, N, F.G, F.bid);
    pg8::EpiProj<KIND> E{F.ws};
    pg8::gemm_phase<pg8::EpiProj<KIND>, pg8::StaticOrder, true, true>((LAS unsigned char*)F.lds, g, So, E);
}
__device__ __forceinline__ void phase_gemm(const Frame& F, const h16* A, const h16* Bt, int N, int K, void* O, int ldc, int f32out) {
    pg8::Gemm g{A, Bt, S, N, K}; pg8::StaticOrder So; So.init(S, N, F.G, F.bid);
    pg8::EpiStore E{O, ldc, f32out};
    pg8::gemm_phase<pg8::EpiStore, pg8::StaticOrder, true, true>((LAS unsigned char*)F.lds, g, So, E);
}

constexpr int NPHASE = 2 + 8 * DEPTH;
__host__ __device__ inline bool phase_exists(int p) {
    if (p < 2) return true;
    const int L = (p - 2) / 8, s = (p - 2) % 8, kind = L % 3;
    if (s == 7 || s == 1) return false;
    if (s == 2) return kind != 0;
    if (s == 4) return kind == 2;
    return true;
}

__global__ void __launch_bounds__(NTHREADS, 2) trunk_fwd(Args args) {
    extern __shared__ __attribute__((aligned(16))) unsigned char lds_raw[];
    Frame F;
    F.out = args.out; F.ws = args.ws; F.lds = (char*)lds_raw;
    F.tid = threadIdx.x; F.lane = F.tid & 63; F.wave = __builtin_amdgcn_readfirstlane(F.tid >> 6); F.G = gridDim.x; F.bid = blockIdx.x;
    volatile LAS unsigned* misc = (volatile LAS unsigned*)((LAS unsigned char*)lds_raw + MISC_OFF);
    if (F.tid < 16) misc[F.tid] = 0u;
    __syncthreads();
    XcdBarrier bar; bar.bar = (unsigned*)(F.ws + WS_CTL) + CW_BAR; bar.x = 0; bar.st = misc;
#if ONE_LAUNCH
    bar = xcd_barrier_post((unsigned*)(F.ws + WS_CTL) + CW_BAR, misc);
    cg::grid_group grid = cg::this_grid();
#endif
    const int lo = args.ph_lo, hi = args.ph_hi;
#if ONE_LAUNCH
    grid.sync();
#define SEAM(p) do { if ((p) > lo) xcd_barrier(bar); } while (0)
#else
#define SEAM(p) do { } while (0)
#endif
#define IN(p) (lo <= (p) && (p) < hi)
#ifndef PHMASK
#define PHMASK 0xFFFF
#endif
#define EN(b) ((PHMASK >> (b)) & 1)
#ifndef PROBE_DUP
#define PROBE_DUP 0
#endif
#define DUP(b, call) do { if ((PROBE_DUP >> (b)) & 1) { if (ONE_LAUNCH) xcd_barrier(bar); call; } } while (0)
    if (EN(0) && IN(0)) { SEAM(0); phase_prologue(F, args); }
    if (EN(1) && IN(1)) { SEAM(1); phase_norm(F, args, -1, 0); }
#define LAYER(L) do { \
        constexpr int kind = (L) % 3, base = 2 + 8 * (L); \
        constexpr int Nin = kind == 0 ? 8192 : (kind == 1 ? NSA_NP : 12288); \
        constexpr int Kout = kind == 2 ? 4096 : 2048; \
        if (EN(2) && IN(base + 0)) { SEAM(base + 0); phase_gemm_proj<kind>(F, Nin); } \
          \
        if (kind != 0 && IN(base + 2)) { SEAM(base + 2); if (EN(6) && kind == 1) { phase_nsa_cmp(F, args); DUP(6, phase_nsa_cmp(F, args)); } else if (EN(7) && kind == 2) { phase_ret_scan(F); DUP(7, phase_ret_scan(F)); } } \
        if (IN(base + 3)) { SEAM(base + 3); if (EN(8) && kind == 0) { phase_moba_attn_mfma(F); DUP(8, phase_moba_attn_mfma(F)); } else if (EN(9) && kind == 1) { phase_nsa_attn_mfma(F); DUP(9, phase_nsa_attn_mfma(F)); } else if (EN(10) && kind == 2) { phase_ret_out(F); DUP(10, phase_ret_out(F)); } } \
        if (EN(11) && kind == 2 && IN(base + 4)) { SEAM(base + 4); phase_ret_gn(F); } \
        if (EN(2) && IN(base + 5)) { SEAM(base + 5); phase_gemm(F, (const h16*)(F.ws + WS_OZ), (const h16*)(F.ws + WS_WTOUT), 2048, Kout, F.ws + WS_Y, 2048, 1); } \
        if (EN(1) && IN(base + 6)) { SEAM(base + 6); phase_norm(F, args, (L), (L) + 1 < DEPTH ? (L) + 1 : -1); } \
    } while (0)
    LAYER(0); LAYER(1); LAYER(2); LAYER(3);
#undef LAYER
#undef EN
#undef DUP
#undef IN
#undef SEAM
}

extern "C" void kernel_launch(void* const* d_in, const int* in_sizes, int n_in, void* d_out, int out_size, void* d_ws, size_t ws_size, hipStream_t stream) {
    static int grid = 0;
    if (grid == 0) {
        if (n_in != 18 || out_size != S * D || ws_size < WS_END) { fprintf(stderr, "kernel_launch: unexpected shapes (n_in %d, out %d, ws %zu)\n", n_in, out_size, ws_size); grid = -1; return; }
        int dev = 0, cus = 0, per_cu = 0;
        if (hipGetDevice(&dev) != hipSuccess || hipDeviceGetAttribute(&cus, hipDeviceAttributeMultiprocessorCount, dev) != hipSuccess) { grid = -1; return; }
        if (hipFuncSetAttribute((const void*)trunk_fwd, hipFuncAttributeMaxDynamicSharedMemorySize, LDS_BYTES) != hipSuccess) { fprintf(stderr, "kernel_launch: hipFuncSetAttribute failed\n"); grid = -1; return; }
        if (hipOccupancyMaxActiveBlocksPerMultiprocessor(&per_cu, (const void*)trunk_fwd, NTHREADS, LDS_BYTES) != hipSuccess || per_cu < 1) { fprintf(stderr, "kernel_launch: occupancy query says %d\n", per_cu); per_cu = 1; }
        (void)hipGetLastError();
        grid = cus;
    }
    if (grid < 0) return;
    (void)hipMemsetAsync((char*)d_ws + WS_CTL, 0, CTL_ZERO_BYTES, stream);
    Args a{};
    for (int i = 0; i < 18; ++i) a.in[i] = (const float*)d_in[i];
    a.out = (float*)d_out; a.ws = (unsigned char*)d_ws;
    for (int j = 0; j < 16; ++j) a.inv16[j] = pow(500000.0, -(double)j / 16.0);
    for (int j = 0; j < 128; ++j) a.inv128[j] = pow(10000.0, -(double)j / 128.0);
#if ONE_LAUNCH
    a.ph_lo = 0; a.ph_hi = NPHASE;
    void* kargs[] = {&a};
    hipError_t e = hipLaunchCooperativeKernel((const void*)trunk_fwd, dim3(grid), dim3(NTHREADS), kargs, LDS_BYTES, stream);
    if (e != hipSuccess) fprintf(stderr, "kernel_launch: cooperative launch failed: %s (grid %d)\n", hipGetErrorString(e), grid);
#else
    for (int p = 0; p < NPHASE; ++p) {
        if (!phase_exists(p)) continue;
        a.ph_lo = p; a.ph_hi = p + 1;
        hipLaunchKernelGGL(trunk_fwd, dim3(grid), dim3(NTHREADS), LDS_BYTES, stream, a);
    }
#endif
}
```

```cpp
#include <hip/hip_runtime.h>
#include <hip/hip_cooperative_groups.h>
#include <cstdio>
#include <cstdint>
#include <cmath>
namespace cg = cooperative_groups;

#ifndef ONE_LAUNCH
#define ONE_LAUNCH 1
#endif
#ifndef MOBA_MFMA
#define MOBA_MFMA 1
#endif
#ifndef NSA_MFMA
#define NSA_MFMA 1
#endif

#define LAS __attribute__((address_space(3)))
typedef _Float16 h16;
typedef _Float16 h16x2 __attribute__((ext_vector_type(2)));
typedef _Float16 h16x4 __attribute__((ext_vector_type(4)));
typedef _Float16 h16x8 __attribute__((ext_vector_type(8)));
typedef float f32x2 __attribute__((ext_vector_type(2)));
typedef float f32x4 __attribute__((ext_vector_type(4)));
typedef unsigned u32x4 __attribute__((ext_vector_type(4)));

constexpr int S = 8192, D = 2048, DEPTH = 4;
constexpr float EPS = 1e-6f;
constexpr float NEGF = -1e30f, BIGF = 1e30f;
constexpr int NSA_NP = 7424;
constexpr int NC = 511;

constexpr size_t MiB = 1u << 20;
constexpr size_t WS_CTL = 0, CTL_ZERO_BYTES = 1 * MiB;
constexpr size_t WS_MODP = 1 * MiB;
constexpr size_t WS_KMEAN = 2 * MiB;
constexpr size_t WS_CMPB = 2 * MiB + 512 * 1024;
constexpr size_t WS_GATES = 3 * MiB;
constexpr size_t WS_KCMP = 5 * MiB;
constexpr size_t WS_VCMP = 5 * MiB + 512 * 1024;
constexpr size_t WS_ROPE16 = 6 * MiB;
constexpr size_t WS_ROPE128 = 7 * MiB;
constexpr size_t WS_WTIN = 16 * MiB;
constexpr size_t WS_WTOUT = 64 * MiB;
constexpr size_t WS_W1T = 72 * MiB;
constexpr size_t WS_H = 80 * MiB;
constexpr size_t WS_P = 112 * MiB;
constexpr size_t WS_QKV = 304 * MiB;
constexpr size_t WS_OZ = 496 * MiB;
constexpr size_t WS_Y = 560 * MiB;
constexpr size_t WS_OR = 624 * MiB;
constexpr size_t WS_END = 752 * MiB;

constexpr int LDS_BYTES = 147456;
constexpr int MISC_OFF = 135168;
constexpr int NTHREADS = 512;

struct Args {
    const float* in[18];
    float* out;
    unsigned char* ws;
    double inv16[16];
    double inv128[128];
    int ph_lo, ph_hi;
};

#define XB_TMO      128
#define XB_XCNT(j)  (256  + 64 * (j))
#define XB_XSUB(j)  (1280 + 64 * (j))
#define XB_XGEN(j)  (2304 + 64 * (j))
#define XB_TOP      3328
#define XB_TOPGEN   3392
#define XCD_BAR_WORDS 3456
#define XB_SPIN_CAP (1u << 24)
constexpr int CW_BAR = 4096;

__device__ __forceinline__ unsigned xb_ld(unsigned* p)              { return __hip_atomic_load(p, __ATOMIC_RELAXED, __HIP_MEMORY_SCOPE_AGENT); }
__device__ __forceinline__ unsigned xb_add(unsigned* p, unsigned v) { return __hip_atomic_fetch_add(p, v, __ATOMIC_RELAXED, __HIP_MEMORY_SCOPE_AGENT); }
__device__ __forceinline__ unsigned xb_xcc_id() { return (unsigned)__builtin_amdgcn_s_getreg((3 << 11) | 20) & 0xFu; }
#define XB_SPIN(cond, bar) do { unsigned _sp = 0; while (cond) { __builtin_amdgcn_s_sleep(1); \
    if ((++_sp & 255u) == 0u) { if (xb_ld(&(bar)[XB_TMO])) break; if (_sp > XB_SPIN_CAP) { atomicAdd(&(bar)[XB_TMO], 1u); break; } } } } while (0)

struct XcdBarrier { unsigned* bar; unsigned x; volatile LAS unsigned* st; };

__device__ __forceinline__ XcdBarrier xcd_barrier_post(unsigned* bar, volatile LAS unsigned* st) {
    XcdBarrier b; b.bar = bar; b.x = xb_xcc_id(); b.st = st;
    if (threadIdx.x == 0) (void)xb_add(&bar[XB_XCNT(b.x)], 1u);
    return b;
}
__device__ __forceinline__ void xcd_barrier_complete(unsigned* bar, unsigned x, unsigned& nloc, unsigned& nx) {
    const unsigned G = gridDim.x * gridDim.y * gridDim.z;
    unsigned sum, cnt, mine, sp = 0u;
    for (;;) {
        sum = 0u; cnt = 0u; mine = 0u;
#pragma unroll
        for (unsigned j = 0; j < 16; ++j) { const unsigned c = xb_ld(&bar[XB_XCNT(j)]); sum += c; cnt += (c > 0u) ? 1u : 0u; mine = (j == x) ? c : mine; }
        if (sum == G) break;
        __builtin_amdgcn_s_sleep(1);
        if ((++sp & 255u) == 0u) { if (xb_ld(&bar[XB_TMO])) break; if (sp > XB_SPIN_CAP) { atomicAdd(&bar[XB_TMO], 1u); break; } }
    }
    nloc = mine > 0u ? mine : 1u; nx = cnt > 0u ? cnt : 1u;
}
__device__ __forceinline__ void xcd_barrier(const XcdBarrier& b) {
    asm volatile("s_waitcnt vmcnt(0)" ::: "memory");
    __syncthreads();
    if (threadIdx.x == 0) {
        unsigned* bar = b.bar;
        __builtin_amdgcn_s_waitcnt(0);
        unsigned nloc = b.st[0], nx = b.st[1];
        if (nloc == 0u) { xcd_barrier_complete(bar, b.x, nloc, nx); b.st[0] = nloc; b.st[1] = nx; }
        const unsigned old = xb_add(&bar[XB_XSUB(b.x)], 1u);
        const unsigned gen = old / nloc;
        if (old + 1u == (gen + 1u) * nloc) {
            __builtin_amdgcn_fence(__ATOMIC_RELEASE, "agent");
            asm volatile("s_waitcnt vmcnt(0)" ::: "memory");
            const unsigned og = xb_add(&bar[XB_TOP], 1u);
            const unsigned tg = og / nx;
            if (og + 1u == (tg + 1u) * nx) xb_add(&bar[XB_TOPGEN], 1u);
            else XB_SPIN(xb_ld(&bar[XB_TOPGEN]) == tg, bar);
            __builtin_amdgcn_fence(__ATOMIC_ACQUIRE, "agent");
            xb_add(&bar[XB_XGEN(b.x)], 1u);
            asm volatile("s_waitcnt vmcnt(0)" ::: "memory");
        } else {
            XB_SPIN(xb_ld(&bar[XB_XGEN(b.x)]) == gen, bar);
            __builtin_amdgcn_fence(__ATOMIC_ACQUIRE, "agent");
            asm volatile("s_waitcnt vmcnt(0)" ::: "memory");
        }
    }
    __syncthreads();
}

__device__ __forceinline__ float silu_f(float x) { return x / (1.f + __expf(-x)); }
__device__ __forceinline__ float sigmoid_f(float x) { return 1.f / (1.f + __expf(-x)); }

namespace pg8 {
constexpr int BM = 256, BK = 64, HALF = 128, HTB = HALF * BK * 2, STAGE_BYTES = 8 * HTB, NXCD = 8, WGM = 8;
__host__ __device__ __forceinline__ int lds_byte(int r, int c) { const int st = (r >> 4) * 2 + (c >> 5), rr = r & 15, cc = c & 31, ob = rr * 64 + cc * 2; return st * 1024 + (ob ^ (((ob >> 9) & 1) << 5)); }
__host__ __device__ __forceinline__ void stage_rc(int b, int& R, int& C) { const int st = b / 1024, sb = b % 1024, swz = sb ^ (((sb >> 9) & 1) << 5); R = (st >> 1) * 16 + swz / 64; C = (st & 1) * 32 + (swz % 64) / 2; }
__host__ __device__ __forceinline__ int perm32(int rho) { const int n = rho >> 4, i = rho & 15; return 8 * (i >> 2) + 4 * n + (i & 3); }

struct Unit { int pm, pn; };
struct Gemm { const h16* A; const h16* Bt; int M, N, K, lda, ldb; };

struct StaticOrder {
    int nM, nN, nwg, G, c;
    __host__ __device__ void init(int M, int N, int G_, int c_) { nM = M / BM; nN = N / BM; nwg = nM * nN; G = G_; c = c_; }
    __host__ __device__ bool next(int i, Unit& u) const {
        const long L = (long)i * G + c; if (L >= nwg) return false;
        int wgid = (int)L; { const int q = nwg / NXCD, r = nwg % NXCD, xcd = wgid % NXCD, off = wgid / NXCD; wgid = (xcd < r ? xcd * (q + 1) : r * (q + 1) + (xcd - r) * q) + off; }
        const int nig = WGM * nN, gid = wgid / nig, fm = gid * WGM, gsz = (nM - fm) < WGM ? (nM - fm) : WGM;
        u.pm = fm + ((wgid % nig) % gsz); u.pn = (wgid % nig) / gsz; return true;
    }
    __device__ __forceinline__ void a_ready(const Unit&) const {}
    __device__ __forceinline__ void done(const Unit&) const {}
};

struct OneUnit {
    int pm, pn, have;
    __device__ bool next(int i, Unit& u) const { if (i != 0 || !have) return false; u.pm = pm; u.pn = pn; return true; }
    __device__ __forceinline__ void a_ready(const Unit&) const {}
    __device__ __forceinline__ void done(const Unit&) const {}
};
struct EpiStore {
    static constexpr bool PERM = true, AFTER_DRAIN = false;
    void* O; int ldc; int f32out;
    __device__ __forceinline__ void operator()(const f32x4 (&acc)[2][2][4][2], const Unit& u, int wr, int wc, int fr, int fq) const {
        const int row0 = u.pm * BM + wr * 64 + fr, col0 = u.pn * BM + wc * 32 + 8 * fq;
#pragma unroll
        for (int ai = 0; ai < 2; ++ai)
#pragma unroll
            for (int m = 0; m < 4; ++m) {
                const size_t roff = (size_t)(row0 + ai * HALF + m * 16) * ldc + col0;
#pragma unroll
                for (int bj = 0; bj < 2; ++bj) {
                    const f32x4 v0 = acc[ai][bj][m][0], v1 = acc[ai][bj][m][1];
                    if (f32out) {
                        float* p = (float*)O + roff + bj * HALF;
                        *(f32x4*)p = v0; *(f32x4*)(p + 4) = v1;
                    } else {
                        h16x8 w; w[0] = (h16)v0[0]; w[1] = (h16)v0[1]; w[2] = (h16)v0[2]; w[3] = (h16)v0[3]; w[4] = (h16)v1[0]; w[5] = (h16)v1[1]; w[6] = (h16)v1[2]; w[7] = (h16)v1[3];
                        *(h16x8*)((h16*)O + roff + bj * HALF) = w;
                    }
                }
            }
    }
};


template <int KIND  > struct EpiProj {
    static constexpr bool PERM = true, AFTER_DRAIN = false;
    unsigned char* ws;
    __device__ __forceinline__ static void st8(h16* p, const float (&v)[8]) { h16x8 w;
#pragma unroll
        for (int i = 0; i < 8; ++i) w[i] = (h16)v[i];
        *(h16x8*)p = w; }
    __device__ __forceinline__ void operator()(const f32x4 (&acc)[2][2][4][2], const Unit& u, int wr, int wc, int fr, int fq) const {
        const int pn = u.pn, d0 = 32 * wc + 8 * fq;
        h16* QKV = (h16*)(ws + WS_QKV);
        const f32x2* r16 = (const f32x2*)(ws + WS_ROPE16); const f32x2* r128 = (const f32x2*)(ws + WS_ROPE128);
        float ksum[2][8];
#pragma unroll
        for (int bj = 0; bj < 2; ++bj)
#pragma unroll
            for (int i = 0; i < 8; ++i) ksum[bj][i] = 0.f;
        int mode;
        float scale = 1.f; h16* base = QKV; int ld = 0;
        bool want_ksum = false;
        if (KIND == 0) {
            const int sect = pn >> 3;
            if (sect == 0) { mode = 0; scale = 0.08838834764831845f; base = QKV + (size_t)(2 * (pn & 7)) * S * 128; }
            else if (sect == 1) { mode = 0; want_ksum = true; base = QKV + (size_t)16 * S * 128 + (size_t)(2 * (pn & 7)) * S * 128; }
            else if (sect == 2) { mode = 1; base = QKV + (size_t)32 * S * 128 + (size_t)(2 * (pn & 7)) * S * 128; }
            else { mode = 2; base = QKV + (size_t)48 * S * 128 + (pn & 7) * 256; ld = 2048; }
        } else if (KIND == 1) {
            if (pn < 8) { mode = 0; scale = 0.08838834764831845f; base = QKV + (size_t)(2 * pn) * S * 128; }
            else if (pn < 20) { const int ti = (pn - 8) >> 1; mode = (ti & 1) ? 1 : 0; base = QKV + (size_t)16 * S * 128 + ((size_t)ti * 4 + 2 * ((pn - 8) & 1)) * S * 128; }
            else if (pn < 28) { mode = 2; base = (h16*)(ws + WS_QKV + 96 * MiB) + (pn - 20) * 256; ld = 2048; }
            else mode = 3;
        } else {
            if (pn < 8) { mode = 4; base = QKV + (size_t)pn * S * 256; }
            else if (pn < 16) { mode = 4; scale = 0.0625f; base = QKV + (size_t)8 * S * 256 + (size_t)(pn - 8) * S * 256; }
            else if (pn < 32) { mode = 5; base = QKV + (size_t)16 * S * 256 + (size_t)((pn - 16) >> 1) * S * 512 + ((pn - 16) & 1) * 256; }
            else { mode = 2; base = QKV + (size_t)16 * S * 256 + (size_t)8 * S * 512 + (pn - 32) * 256; ld = 4096; }
        }
#pragma unroll
        for (int ai = 0; ai < 2; ++ai)
#pragma unroll
            for (int m = 0; m < 4; ++m) {
                const int t = u.pm * BM + ai * HALF + wr * 64 + m * 16 + fr;
                float v[2][8];
#pragma unroll
                for (int bj = 0; bj < 2; ++bj)
#pragma unroll
                    for (int i = 0; i < 8; ++i) v[bj][i] = acc[ai][bj][m][i >> 2][i & 3];
                if (mode == 0) {
                    if (wc == 0) {
                        const f32x2* cs = r16 + (size_t)t * 16 + 8 * (fq & 1);
#pragma unroll
                        for (int bj = 0; bj < 2; ++bj)
#pragma unroll
                            for (int i = 0; i < 8; ++i) { const float o = __shfl_xor(v[bj][i], 32); const f32x2 c = cs[i];
                                v[bj][i] = (fq < 2) ? (v[bj][i] * c[0] - o * c[1]) : (o * c[1] + v[bj][i] * c[0]); }
                    }
#pragma unroll
                    for (int bj = 0; bj < 2; ++bj) {
#pragma unroll
                        for (int i = 0; i < 8; ++i) { v[bj][i] *= scale; ksum[bj][i] += v[bj][i]; }
                        st8(base + ((size_t)bj * S + t) * 128 + d0, v[bj]);
                    }
                } else if (mode == 1) {
#pragma unroll
                    for (int bj = 0; bj < 2; ++bj) st8(base + ((size_t)bj * S + t) * 128 + d0, v[bj]);
                } else if (mode == 2) {
#pragma unroll
                    for (int bj = 0; bj < 2; ++bj) {
#pragma unroll
                        for (int i = 0; i < 8; ++i) v[bj][i] = silu_f(v[bj][i]);
                        st8(base + (size_t)t * ld + 128 * bj + d0, v[bj]);
                    }
                } else if (mode == 3) {
                    if (d0 < 48) { float* gp = (float*)(ws + WS_GATES) + (size_t)t * 48 + d0;
#pragma unroll
                        for (int i = 0; i < 8; ++i) gp[i] = sigmoid_f(v[0][i]); }
                } else if (mode == 4) {
                    const f32x2* cs = r128 + (size_t)t * 128 + d0;
#pragma unroll
                    for (int i = 0; i < 8; ++i) { const f32x2 c = cs[i]; const float x1 = v[0][i], x2 = v[1][i];
                        v[0][i] = (x1 * c[0] - x2 * c[1]) * scale; v[1][i] = (x1 * c[1] + x2 * c[0]) * scale; }
                    st8(base + (size_t)t * 256 + d0, v[0]); st8(base + (size_t)t * 256 + 128 + d0, v[1]);
                } else {
#pragma unroll
                    for (int bj = 0; bj < 2; ++bj) st8(base + (size_t)t * 512 + 128 * bj + d0, v[bj]);
                }
            }
        if (KIND == 0 && want_ksum) {
#pragma unroll
            for (int bj = 0; bj < 2; ++bj)
#pragma unroll
                for (int i = 0; i < 8; ++i) { float x = ksum[bj][i]; x += __shfl_xor(x, 1); x += __shfl_xor(x, 2); x += __shfl_xor(x, 4); x += __shfl_xor(x, 8); ksum[bj][i] = x; }
            if (fr == 0) { float* km = (float*)(ws + WS_KMEAN) + (size_t)wr * 65536;
#pragma unroll
                for (int bj = 0; bj < 2; ++bj)
#pragma unroll
                    for (int i = 0; i < 8; ++i) km[((size_t)(2 * (pn & 7) + bj) * 32 + u.pm) * 128 + d0 + i] = ksum[bj][i] * (1.0f / 256.0f); }
        }
    }
};

template <class Epi, class Sched, bool ALIGN_EPI = false, bool SP2 = false>
__device__ __forceinline__ void gemm_phase(LAS unsigned char* lds, const Gemm g, const Sched& S, const Epi& E) {
    const int tid = threadIdx.x, wid = __builtin_amdgcn_readfirstlane(tid >> 6), lane = tid & 63, wr = wid >> 2, wc = wid & 3, fr = lane & 15, fq = lane >> 4;
    const int K = g.K, nt = K / BK;
    unsigned voffA[2], voffB[2];
#pragma unroll
    for (int i = 0; i < 2; ++i) { int R, C; stage_rc(tid * 16 + i * 8192, R, C); const int Rb = Epi::PERM ? ((R & ~31) + perm32(R & 31)) : R;
        voffA[i] = (unsigned)(R * g.lda + C) * 2u; voffB[i] = (unsigned)(Rb * g.ldb + C) * 2u; }
    const size_t kstep = (size_t)(BK * 2);
    const size_t hstepA = (size_t)HALF * g.lda * 2, hstepB = (size_t)HALF * g.ldb * 2;
    const size_t tstepA = 2 * hstepA, tstepB = 2 * hstepB;
    const unsigned ldsw = (unsigned)wid * 1024u;
    const int aoff = lds_byte(wr * 64 + fr, fq * 8), boff = lds_byte(wc * 32 + fr, fq * 8);
#define PG8_SA(b, h) (((b) * 2 + (h)) * HTB)
#define PG8_SB(b, h) ((4 + (b) * 2 + (h)) * HTB)
#define PG8_STAGE(bufoff, gbase, voff) do { _Pragma("unroll") for (int _i = 0; _i < 2; ++_i) \
        __builtin_amdgcn_global_load_lds((const unsigned*)((const char*)(gbase) + (voff)[_i]), (LAS unsigned*)(lds + (bufoff) + ldsw + _i * 8192), 16, 0, 0); } while (0)
#define PG8_LDA(dst, b, h) do { _Pragma("unroll") for (int m = 0; m < 4; ++m) _Pragma("unroll") for (int k = 0; k < 2; ++k) dst[m][k] = *(const LAS h16x8*)(lds + PG8_SA(b, h) + aoff + m * 2048 + k * 1024); } while (0)
#define PG8_LDB(dst, b, h) do { _Pragma("unroll") for (int n = 0; n < 2; ++n) _Pragma("unroll") for (int k = 0; k < 2; ++k) dst[n][k] = *(const LAS h16x8*)(lds + PG8_SB(b, h) + boff + n * 2048 + k * 1024); } while (0)
#define PG8_MMA(ai, bj, At, Bt) do { __builtin_amdgcn_s_setprio(1); _Pragma("unroll") for (int m = 0; m < 4; ++m) _Pragma("unroll") for (int n = 0; n < 2; ++n) _Pragma("unroll") for (int k = 0; k < 2; ++k) \
        acc[ai][bj][m][n] = __builtin_amdgcn_mfma_f32_16x16x32_f16(Bt[n][k], At[m][k], acc[ai][bj][m][n], 0, 0, 0); __builtin_amdgcn_s_setprio(0); } while (0)
#define PG8_WAIT_V(n) asm volatile("s_waitcnt vmcnt(" #n ")" ::: "memory")
#define PG8_WAIT_L(n) asm volatile("s_waitcnt lgkmcnt(" #n ")" ::: "memory")
#define PG8_BAR __builtin_amdgcn_s_barrier()
#define PG8_SCHED __builtin_amdgcn_sched_barrier(0)
    Unit cur, nxt; int ui = 0;
    if (!S.next(0, cur)) return;
    f32x4 acc[2][2][4][2];
#pragma unroll
    for (int a = 0; a < 2; ++a)
#pragma unroll
        for (int b = 0; b < 2; ++b)
#pragma unroll
            for (int m = 0; m < 4; ++m)
#pragma unroll
                for (int n = 0; n < 2; ++n) acc[a][b][m][n] = (f32x4){0.f, 0.f, 0.f, 0.f};
    h16x8 At[4][2], B0[2][2], B1[2][2];
    const char* cA = (const char*)g.A + (size_t)cur.pm * tstepA; const char* cB = (const char*)g.Bt + (size_t)cur.pn * tstepB;
    S.a_ready(cur);
    if constexpr (SP2) {
        PG8_STAGE(PG8_SB(0, 0), cB, voffB); PG8_STAGE(PG8_SB(0, 1), cB + hstepB, voffB); PG8_STAGE(PG8_SA(0, 0), cA, voffA); PG8_STAGE(PG8_SA(0, 1), cA + hstepA, voffA);
        if (wr == 1) PG8_BAR;
        PG8_WAIT_V(2); PG8_BAR;
        PG8_STAGE(PG8_SB(1, 0), cB + kstep, voffB); PG8_STAGE(PG8_SA(1, 0), cA + kstep, voffA); PG8_STAGE(PG8_SB(1, 1), cB + hstepB + kstep, voffB);
        PG8_WAIT_V(6); PG8_BAR;
    } else {
        PG8_STAGE(PG8_SB(0, 0), cB, voffB); PG8_STAGE(PG8_SA(0, 0), cA, voffA); PG8_STAGE(PG8_SB(0, 1), cB + hstepB, voffB); PG8_STAGE(PG8_SA(0, 1), cA + hstepA, voffA);
        if (wr == 1) PG8_BAR;
        PG8_WAIT_V(4); PG8_BAR;
        PG8_STAGE(PG8_SB(1, 0), cB + kstep, voffB); PG8_STAGE(PG8_SA(1, 0), cA + kstep, voffA); PG8_STAGE(PG8_SB(1, 1), cB + hstepB + kstep, voffB);
        PG8_WAIT_V(6); PG8_BAR;
    }
    for (;;) {
        const bool has_next = S.next(ui + 1, nxt);
        const char* nA = has_next ? (const char*)g.A + (size_t)nxt.pm * tstepA : cA; const char* nB = has_next ? (const char*)g.Bt + (size_t)nxt.pn * tstepB : cB;
        for (int t = 0; t < nt; t += 2) {
            const bool last = (t == nt - 2);
            const char* a1 = cA + (size_t)(t + 1) * kstep;
            const char* a2 = last ? nA : cA + (size_t)(t + 2) * kstep; const char* b2 = last ? nB : cB + (size_t)(t + 2) * kstep;
            const char* a3 = a2 + kstep; const char* b3 = b2 + kstep;
            if (last && has_next) S.a_ready(nxt);
            if constexpr (SP2) {
            PG8_LDB(B0, 0, 0); PG8_LDB(B1, 0, 1); PG8_SCHED; PG8_LDA(At, 0, 0); PG8_STAGE(PG8_SA(1, 1), a1 + hstepA, voffA);
            PG8_WAIT_V(8); PG8_WAIT_L(0); PG8_BAR; PG8_MMA(0, 0, At, B0); PG8_MMA(0, 1, At, B1); PG8_BAR; PG8_SCHED;
            PG8_LDA(At, 0, 1); PG8_STAGE(PG8_SB(0, 0), b2, voffB); PG8_STAGE(PG8_SB(0, 1), b2 + hstepB, voffB); PG8_STAGE(PG8_SA(0, 0), a2, voffA);
            PG8_WAIT_V(8); PG8_WAIT_L(0); PG8_BAR; PG8_MMA(1, 0, At, B0); PG8_MMA(1, 1, At, B1); PG8_BAR; PG8_SCHED;
            PG8_LDB(B0, 1, 0); PG8_LDB(B1, 1, 1); PG8_SCHED; PG8_LDA(At, 1, 0); PG8_STAGE(PG8_SA(0, 1), a2 + hstepA, voffA);
            PG8_WAIT_V(8); PG8_WAIT_L(0); PG8_BAR; PG8_MMA(0, 0, At, B0); PG8_MMA(0, 1, At, B1); PG8_BAR; PG8_SCHED;
            PG8_LDA(At, 1, 1); PG8_STAGE(PG8_SB(1, 0), b3, voffB); PG8_STAGE(PG8_SB(1, 1), b3 + hstepB, voffB); PG8_STAGE(PG8_SA(1, 0), a3, voffA);
            PG8_WAIT_V(8); PG8_WAIT_L(0); PG8_BAR; PG8_MMA(1, 0, At, B0); PG8_MMA(1, 1, At, B1); PG8_BAR; PG8_SCHED;
            } else {
            PG8_LDB(B0, 0, 0); PG8_SCHED; PG8_LDA(At, 0, 0); PG8_STAGE(PG8_SA(1, 1), a1 + hstepA, voffA);
            PG8_WAIT_L(8); PG8_BAR; PG8_WAIT_L(0); PG8_MMA(0, 0, At, B0); PG8_BAR; PG8_SCHED;
            PG8_LDB(B1, 0, 1); PG8_STAGE(PG8_SB(0, 0), b2, voffB);
            PG8_BAR; PG8_WAIT_L(0); PG8_MMA(0, 1, At, B1); PG8_BAR;
            PG8_LDA(At, 0, 1); PG8_STAGE(PG8_SA(0, 0), a2, voffA);
            PG8_BAR; PG8_WAIT_L(0); PG8_MMA(1, 0, At, B0); PG8_BAR; PG8_SCHED;
            PG8_STAGE(PG8_SB(0, 1), b2 + hstepB, voffB);
            PG8_WAIT_V(6); PG8_BAR; PG8_MMA(1, 1, At, B1); PG8_BAR;
            PG8_LDB(B0, 1, 0); PG8_SCHED; PG8_LDA(At, 1, 0); PG8_STAGE(PG8_SA(0, 1), a2 + hstepA, voffA);
            PG8_WAIT_L(8); PG8_BAR; PG8_WAIT_L(0); PG8_MMA(0, 0, At, B0); PG8_BAR; PG8_SCHED;
            PG8_LDB(B1, 1, 1); PG8_STAGE(PG8_SB(1, 0), b3, voffB);
            PG8_BAR; PG8_WAIT_L(0); PG8_MMA(0, 1, At, B1); PG8_BAR;
            PG8_LDA(At, 1, 1); PG8_STAGE(PG8_SA(1, 0), a3, voffA);
            PG8_BAR; PG8_WAIT_L(0); PG8_MMA(1, 0, At, B0); PG8_BAR; PG8_SCHED;
            PG8_STAGE(PG8_SB(1, 1), b3 + hstepB, voffB);
            PG8_WAIT_V(6); PG8_BAR; PG8_MMA(1, 1, At, B1); PG8_BAR;
            }
        }
        if constexpr (ALIGN_EPI) { if (wr == 0) PG8_BAR; }
        if constexpr (!Epi::AFTER_DRAIN) { E(acc, cur, wr, wc, fr, fq); S.done(cur); }
        if (!has_next) break;
#pragma unroll
        for (int a = 0; a < 2; ++a)
#pragma unroll
            for (int b = 0; b < 2; ++b)
#pragma unroll
                for (int m = 0; m < 4; ++m)
#pragma unroll
                    for (int n = 0; n < 2; ++n) acc[a][b][m][n] = (f32x4){0.f, 0.f, 0.f, 0.f};
        cur = nxt; cA = nA; cB = nB; ++ui;
        if constexpr (ALIGN_EPI) { if (wr == 1) PG8_BAR; }
    }
    PG8_WAIT_V(0);
    if constexpr (!ALIGN_EPI) { if (wr == 0) PG8_BAR; }
    PG8_BAR;
#undef PG8_SA
#undef PG8_SB
#undef PG8_STAGE
#undef PG8_LDA
#undef PG8_LDB
#undef PG8_MMA
#undef PG8_WAIT_V
#undef PG8_WAIT_L
#undef PG8_BAR
#undef PG8_SCHED
}
}

struct Frame {
    float* out;
    unsigned char* ws;
    char* lds;
    int tid, lane, wave, G, bid;
};

__device__ __forceinline__ float wave_sum(float v) {
#pragma unroll
    for (int o = 32; o >= 1; o >>= 1) v += __shfl_xor(v, o);
    return v;
}
__device__ __forceinline__ float wave_max(float v) {
#pragma unroll
    for (int o = 32; o >= 1; o >>= 1) v = fmaxf(v, __shfl_xor(v, o));
    return v;
}
__device__ __forceinline__ void wave_lds_fence() { __builtin_amdgcn_wave_barrier(); asm volatile("s_waitcnt lgkmcnt(0)" ::: "memory"); __builtin_amdgcn_wave_barrier(); }

__device__ __forceinline__ void sincos_d(double x, float& c, float& s) {
    const double TWO_OVER_PI = 0.63661977236758134308;
    const double PIO2_HI = 1.57079632679489655800e+00, PIO2_LO = 6.12323399573676603587e-17;
    const double q = __builtin_rint(x * TWO_OVER_PI);
    double y = __builtin_fma(-q, PIO2_HI, x); y = __builtin_fma(-q, PIO2_LO, y);
    const double y2 = y * y;
    double sp = 1.0 / 6227020800.0;
    sp = sp * y2 - 1.0 / 39916800.0; sp = sp * y2 + 1.0 / 362880.0; sp = sp * y2 - 1.0 / 5040.0; sp = sp * y2 + 1.0 / 120.0; sp = sp * y2 - 1.0 / 6.0; sp = sp * y2 * y + y;
    double cp = -1.0 / 87178291200.0;
    cp = cp * y2 + 1.0 / 479001600.0; cp = cp * y2 - 1.0 / 3628800.0; cp = cp * y2 + 1.0 / 40320.0; cp = cp * y2 - 1.0 / 720.0; cp = cp * y2 + 1.0 / 24.0; cp = cp * y2 - 0.5; cp = cp * y2 + 1.0;
    const long long qi = (long long)q; const int quad = (int)(qi & 3);
    double sv, cv;
    if (quad == 0) { sv = sp; cv = cp; } else if (quad == 1) { sv = cp; cv = -sp; } else if (quad == 2) { sv = -sp; cv = -cp; } else { sv = -cp; cv = sp; }
    c = (float)cv; s = (float)sv;
}

__device__ __forceinline__ int nsa_src_col(int n) { return n < 5120 ? n : (n < 7168 ? n + 48 : (n < 7216 ? n - 2048 : -1)); }
__device__ __forceinline__ void conv_transpose(const Frame& F, const float* W, int K, int Nsrc, h16* Wt, int Npad, int mapmode, int item0, int& items_done) {
    float* tile = (float*)F.lds;
    const int tk_n = K / 64, tn_n = Npad / 64, ntiles = tk_n * tn_n;
    for (int it = F.bid; it < ntiles; it += F.G) {
        const int tk = it / tn_n, tn = it % tn_n;
        __syncthreads();
#pragma unroll
        for (int i = 0; i < 8; ++i) {
            const int idx = F.tid + i * NTHREADS, k = idx >> 6, n = idx & 63;
            const int nn = tn * 64 + n; const int src = mapmode ? nsa_src_col(nn) : nn;
            float v = 0.f; if (src >= 0 && src < Nsrc) v = W[(size_t)(tk * 64 + k) * Nsrc + src];
            tile[k * 65 + n] = v;
        }
        __syncthreads();
#pragma unroll
        for (int i = 0; i < 8; ++i) {
            const int idx = F.tid + i * NTHREADS, n = idx >> 6, k = idx & 63;
            Wt[(size_t)(tn * 64 + n) * K + tk * 64 + k] = (h16)tile[k * 65 + n];
        }
    }
    __syncthreads();
}
__device__ __forceinline__ void conv_layer_weights(const Frame& F, const Args& A, int L) {
    const int kind = L % 3, j = L / 3; int dummy = 0;
    h16* wtin = (h16*)(F.ws + WS_WTIN); h16* wtout = (h16*)(F.ws + WS_WTOUT);
    if (kind == 0) {
        conv_transpose(F, A.in[7] + (size_t)j * 2048 * 8192, 2048, 8192, wtin, 8192, 0, 0, dummy);
        conv_transpose(F, A.in[8] + (size_t)j * 2048 * 2048, 2048, 2048, wtout, 2048, 0, 0, dummy);
    } else if (kind == 1) {
        conv_transpose(F, A.in[9], 2048, 7216, wtin, NSA_NP, 1, 0, dummy);
        conv_transpose(F, A.in[10], 2048, 2048, wtout, 2048, 0, 0, dummy);
        conv_transpose(F, A.in[12], 4096, 256, (h16*)(F.ws + WS_W1T), 256, 0, 0, dummy);
        conv_transpose(F, A.in[14], 4096, 256, (h16*)(F.ws + WS_W1T) + (size_t)256 * 4096, 256, 0, 0, dummy);
    } else {
        conv_transpose(F, A.in[16], 2048, 12288, wtin, 12288, 0, 0, dummy);
        conv_transpose(F, A.in[17], 4096, 2048, wtout, 2048, 0, 0, dummy);
    }
}

__device__ __forceinline__ void phase_prologue(const Frame& F, const Args& A) {
    {
        float* modp = (float*)(F.ws + WS_MODP);
        const float* c = A.in[1]; const float* aw = A.in[3];
        for (int it = F.bid; it < 384; it += F.G) {
            const int layer = it / 96, r = it % 96, slice = r / 12, nch = r % 12, n = nch * 512 + F.tid;
            const float* w = aw + (size_t)layer * 2048 * 6144 + (size_t)(slice * 256) * 6144 + n;
            float acc = 0.f;
#pragma unroll 8
            for (int k = 0; k < 256; ++k) acc += silu_f(c[slice * 256 + k]) * w[(size_t)k * 6144];
            modp[(size_t)(slice * 4 + layer) * 6144 + n] = acc;
        }
    }
    {
        const int* pos = (const int*)A.in[2];
        f32x2* r16 = (f32x2*)(F.ws + WS_ROPE16); f32x2* r128 = (f32x2*)(F.ws + WS_ROPE128);
        for (int idx = F.bid * NTHREADS + F.tid; idx < S * 16; idx += F.G * NTHREADS) {
            const int t = idx >> 4, j = idx & 15; float cs, sn; sincos_d((double)pos[t] * A.inv16[j], cs, sn); r16[idx] = (f32x2){cs, sn};
        }
        for (int idx = F.bid * NTHREADS + F.tid; idx < S * 128; idx += F.G * NTHREADS) {
            const int t = idx >> 7, j = idx & 127; float cs, sn; sincos_d((double)pos[t] * A.inv128[j], cs, sn); r128[idx] = (f32x2){cs, sn};
        }
    }
    if (F.bid == F.G - 1) {
        const int kv = F.tid >> 8, j = F.tid & 255; const float* w1 = kv ? A.in[14] : A.in[12]; const float* pe = A.in[11];
        float acc = 0.f;
#pragma unroll 8
        for (int i = 0; i < 4096; ++i) acc += pe[i] * w1[(size_t)i * 256 + j];
        ((float*)(F.ws + WS_CMPB))[F.tid] = acc;
    }
    conv_layer_weights(F, A, 0);
}

__device__ __forceinline__ void phase_norm(const Frame& F, const Args& A, int Lprev, int Lnext) {
    float* modl = (float*)F.lds;
    const float* modp = (const float*)(F.ws + WS_MODP); const float* ab = A.in[4];
    __syncthreads();
    for (int i = F.tid; i < 6144; i += NTHREADS) {
        const int which = i >> 11, col = i & 2047;
        int layer, mcol;
        if (which == 0) { layer = Lprev; mcol = 4096 + col; } else if (which == 1) { layer = Lnext; mcol = 2048 + col; } else { layer = Lnext; mcol = col; }
        float v = 0.f;
        if (layer >= 0) { v = ab[layer * 6144 + mcol];
#pragma unroll
            for (int s = 0; s < 8; ++s) v += modp[(size_t)(s * 4 + layer) * 6144 + mcol]; }
        modl[i] = v;
    }
    __syncthreads();
    const float* xin = (Lprev <= 0) ? A.in[0] : F.out;
    const float* Y = (const float*)(F.ws + WS_Y);
    h16* H = (h16*)(F.ws + WS_H);
    const float* npost = A.in[6] + (Lprev >= 0 ? Lprev : 0) * 2048;
    const float* npre = A.in[5] + (Lnext >= 0 ? Lnext : 0) * 2048;
    for (int t = F.bid * 8 + F.wave; t < S; t += F.G * 8) {
        f32x4 x[8];
#pragma unroll
        for (int i = 0; i < 8; ++i) x[i] = *(const f32x4*)(xin + (size_t)t * D + i * 256 + F.lane * 4);
        if (Lprev >= 0) {
            f32x4 y[8]; float ss = 0.f;
#pragma unroll
            for (int i = 0; i < 8; ++i) { y[i] = *(const f32x4*)(Y + (size_t)t * D + i * 256 + F.lane * 4); ss += y[i][0] * y[i][0] + y[i][1] * y[i][1] + y[i][2] * y[i][2] + y[i][3] * y[i][3]; }
            ss = wave_sum(ss);
            const float r = 1.0f / sqrtf(ss * (1.0f / D) + EPS);
#pragma unroll
            for (int i = 0; i < 8; ++i) {
                const int col = i * 256 + F.lane * 4;
                const f32x4 g = *(const f32x4*)(npost + col); const f32x4 gt = *(const f32x4*)(modl + col);
#pragma unroll
                for (int e = 0; e < 4; ++e) x[i][e] += gt[e] * (y[i][e] * r * g[e]);
                *(f32x4*)(F.out + (size_t)t * D + col) = x[i];
            }
        }
        if (Lnext >= 0) {
            float ss = 0.f;
#pragma unroll
            for (int i = 0; i < 8; ++i) ss += x[i][0] * x[i][0] + x[i][1] * x[i][1] + x[i][2] * x[i][2] + x[i][3] * x[i][3];
            ss = wave_sum(ss);
            const float r = 1.0f / sqrtf(ss * (1.0f / D) + EPS);
#pragma unroll
            for (int i = 0; i < 8; ++i) {
                const int col = i * 256 + F.lane * 4;
                const f32x4 g = *(const f32x4*)(npre + col); const f32x4 sc = *(const f32x4*)(modl + 2048 + col); const f32x4 sh = *(const f32x4*)(modl + 4096 + col);
                h16x4 hv;
#pragma unroll
                for (int e = 0; e < 4; ++e) hv[e] = (h16)((x[i][e] * r * g[e]) * (1.0f + sc[e]) + sh[e]);
                *(h16x4*)(H + (size_t)t * D + col) = hv;
            }
        }
    }
    if (Lnext > 0) conv_layer_weights(F, A, Lnext);
}

__device__ __forceinline__ void phase_nsa_cmp_a(const Frame& F) {
    const int u = F.bid, have = u < 64, kv = (u >> 5) & 1, mt = (u >> 2) & 7, kp = u & 3;
    const h16* A = (const h16*)(F.ws + WS_QKV) + (size_t)16 * S * 128 + (size_t)kv * 4 * S * 128 + kp * 1024;
    const h16* Bt = (const h16*)(F.ws + WS_W1T) + (size_t)kv * 256 * 4096 + kp * 1024;
    pg8::Gemm g{A, Bt, 2048, 256, 1024, 2048, 4096}; pg8::OneUnit So{mt, 0, have};
    pg8::EpiStore E{(float*)(F.ws + WS_OR) + (size_t)(kv * 4 + kp) * 2048 * 256, 256, 1};
    pg8::gemm_phase<pg8::EpiStore, pg8::OneUnit, true, true>((LAS unsigned char*)F.lds, g, So, E);
}
__device__ __forceinline__ void phase_nsa_cmp_b(const Frame& F, const Args& A) {
    float* hid = (float*)F.lds;
    const float* part = (const float*)(F.ws + WS_OR); const float* b1 = (const float*)(F.ws + WS_CMPB);
    for (int it = F.bid; it < 256; it += F.G) {
        const int kv = it >> 7, r0 = (it & 127) * 16;
        const float* W2 = kv ? A.in[15] : A.in[13];
        h16* dst = (h16*)(F.ws + (kv ? WS_VCMP : WS_KCMP));
        __syncthreads();
        for (int i = F.tid; i < 16 * 256; i += NTHREADS) {
            const int r = r0 + (i >> 8), j = i & 255; float v = b1[kv * 256 + j];
#pragma unroll
            for (int kp = 0; kp < 4; ++kp) v += part[((size_t)(kv * 4 + kp) * 2048 + r) * 256 + j];
            hid[i] = silu_f(v);
        }
        __syncthreads();
        const int d = F.tid & 127, rq = F.tid >> 7;
        float a[4] = {0.f, 0.f, 0.f, 0.f};
#pragma unroll 4
        for (int j = 0; j < 256; ++j) { const float w = W2[j * 128 + d];
#pragma unroll
            for (int e = 0; e < 4; ++e) a[e] += hid[(rq * 4 + e) * 256 + j] * w; }
#pragma unroll
        for (int e = 0; e < 4; ++e) { const int r = r0 + rq * 4 + e; dst[(size_t)r * 128 + d] = ((r & 511) < NC) ? (h16)a[e] : (h16)0.f; }
    }
}

namespace fa {
typedef float f32x16 __attribute__((ext_vector_type(16)));
typedef unsigned u32x2 __attribute__((ext_vector_type(2)));
constexpr float LOG2E = 1.4426950408889634f;
constexpr int KROW = 272, VROW = 320;
constexpr int KT_BYTES = 64 * KROW, BUF_BYTES = KT_BYTES + 64 * VROW;
typedef short s16x4v __attribute__((__vector_size__(4 * sizeof(short))));
constexpr int LDS_IMP = 2 * BUF_BYTES;
constexpr int LDS_SELW = LDS_IMP + 32768;
constexpr int LDS_SV = LDS_SELW + 1024;
static_assert(LDS_SV + 4096 <= MISC_OFF, "attention LDS map");

struct Stage { u32x4 k[2], v[2]; };
__device__ __forceinline__ void stage_load(Stage& st, const h16* Kg, const h16* VTg, int j, int tid) {
    asm volatile("" : "+v"(tid));
#pragma unroll
    for (int i = 0; i < 2; ++i) { const int idx = tid + 512 * i;
        st.k[i] = *(const u32x4*)(Kg + (size_t)(j * 64 + (idx >> 4)) * 128 + (idx & 15) * 8);
        st.v[i] = *(const u32x4*)(VTg + (size_t)(j * 64 + (idx >> 4)) * 128 + (idx & 15) * 8); }
}
__device__ __forceinline__ void stage_write(const Stage& st, LAS unsigned char* buf, int tid) {
    asm volatile("" : "+v"(tid));
#pragma unroll
    for (int i = 0; i < 2; ++i) { const int idx = tid + 512 * i;
        *(LAS u32x4*)(buf + (idx >> 4) * KROW + (idx & 15) * 16) = st.k[i];
        *(LAS u32x4*)(buf + KT_BYTES + (idx >> 4) * VROW + (idx & 15) * 16) = st.v[i]; }
}

template <int MODE>
__device__ __forceinline__ void tile_compute(const LAS unsigned char* buf, int j, const h16x8 (&qf)[8], f32x16 (&o)[4], float& m, float& l,
                                             bool on, int lo, int hi, int lane, float inv_l, LAS float* imp_q) {
    const int r31 = lane & 31, h = lane >> 5, k0 = j * 64;
    const bool need = on && (k0 <= hi) && (k0 + 63 >= lo);
    if (__ballot(need) == 0ull) return;
    f32x16 s0, s1;
#pragma unroll
    for (int r = 0; r < 16; ++r) { s0[r] = 0.f; s1[r] = 0.f; }
    const LAS unsigned char* kp = buf + r31 * KROW + h * 16;
#pragma unroll
    for (int s = 0; s < 8; ++s) {
        const h16x8 a0 = *(const LAS h16x8*)(kp + s * 32);
        const h16x8 a1 = *(const LAS h16x8*)(kp + 32 * KROW + s * 32);
        s0 = __builtin_amdgcn_mfma_f32_32x32x16_f16(a0, qf[s], s0, 0, 0, 0);
        s1 = __builtin_amdgcn_mfma_f32_32x32x16_f16(a1, qf[s], s1, 0, 0, 0);
        if ((s & 1) == 1) __builtin_amdgcn_sched_barrier(0);
    }
    float tmax = NEGF;
#pragma unroll
    for (int r = 0; r < 16; ++r) {
        const int key0 = k0 + (r & 3) + 8 * (r >> 2) + 4 * h, key1 = key0 + 32;
        const bool v0 = on && key0 >= lo && key0 <= hi, v1 = on && key1 >= lo && key1 <= hi;
        s0[r] = v0 ? s0[r] * LOG2E : NEGF; s1[r] = v1 ? s1[r] * LOG2E : NEGF;
        tmax = fmaxf(tmax, fmaxf(s0[r], s1[r]));
    }
    if (MODE != 2) {
        tmax = fmaxf(tmax, __shfl_xor(tmax, 32));
        const float m_new = fmaxf(m, tmax);
        const float alpha = __builtin_amdgcn_exp2f(m - m_new);
        float sum = 0.f;
#pragma unroll
        for (int r = 0; r < 16; ++r) {
            s0[r] = (s0[r] > 0.5f * NEGF) ? __builtin_amdgcn_exp2f(s0[r] - m_new) : 0.f;
            s1[r] = (s1[r] > 0.5f * NEGF) ? __builtin_amdgcn_exp2f(s1[r] - m_new) : 0.f;
            sum += s0[r] + s1[r];
        }
        l = l * alpha + sum; m = m_new;
        if (MODE == 1) return;
#pragma unroll
        for (int dt = 0; dt < 4; ++dt) o[dt] = o[dt] * alpha;
    } else {
#pragma unroll
        for (int r = 0; r < 16; ++r) {
            s0[r] = (s0[r] > 0.5f * NEGF) ? __builtin_amdgcn_exp2f(s0[r] - m) * inv_l : 0.f;
            s1[r] = (s1[r] > 0.5f * NEGF) ? __builtin_amdgcn_exp2f(s1[r] - m) * inv_l : 0.f;
        }
#pragma unroll
        for (int c = 0; c < 4; ++c) {
            const int sa = 16 * j + 2 * c + h, sb = sa + 8;
            const float a0 = s0[4 * c] + s0[4 * c + 1] + s0[4 * c + 2] + 0.5f * s0[4 * c + 3], b0 = 0.5f * s0[4 * c + 3];
            const float a1 = s1[4 * c] + s1[4 * c + 1] + s1[4 * c + 2] + 0.5f * s1[4 * c + 3], b1 = 0.5f * s1[4 * c + 3];
            (void)__hip_atomic_fetch_add(imp_q + sa, a0, __ATOMIC_RELAXED, __HIP_MEMORY_SCOPE_WORKGROUP); if (sa + 1 < 128) (void)__hip_atomic_fetch_add(imp_q + sa + 1, b0, __ATOMIC_RELAXED, __HIP_MEMORY_SCOPE_WORKGROUP);
            (void)__hip_atomic_fetch_add(imp_q + sb, a1, __ATOMIC_RELAXED, __HIP_MEMORY_SCOPE_WORKGROUP); if (sb + 1 < 128) (void)__hip_atomic_fetch_add(imp_q + sb + 1, b1, __ATOMIC_RELAXED, __HIP_MEMORY_SCOPE_WORKGROUP);
        }
    }
    h16x8 pb[2][2];
#pragma unroll
    for (int sp = 0; sp < 2; ++sp)
#pragma unroll
        for (int jj = 0; jj < 8; ++jj) { pb[0][sp][jj] = (h16)s0[8 * sp + jj]; pb[1][sp][jj] = (h16)s1[8 * sp + jj]; }
    const LAS unsigned char* vbase = buf + KT_BYTES + (4 * h + ((lane & 15) >> 2)) * VROW + (16 * ((lane >> 4) & 1) + 4 * (lane & 3)) * 2;
#pragma unroll
    for (int dt = 0; dt < 4; ++dt) {
#pragma unroll
        for (int sub = 0; sub < 2; ++sub)
#pragma unroll
            for (int sp = 0; sp < 2; ++sp) {
                const LAS unsigned char* vp = vbase + (32 * sub + 16 * sp) * VROW + 64 * dt;
                const s16x4v lo4 = __builtin_amdgcn_ds_read_tr16_b64_v4i16((LAS s16x4v*)vp), hi4 = __builtin_amdgcn_ds_read_tr16_b64_v4i16((LAS s16x4v*)(vp + 8 * VROW));
                const h16x4 l4 = __builtin_bit_cast(h16x4, lo4), h4 = __builtin_bit_cast(h16x4, hi4);
                h16x8 va; va[0] = l4[0]; va[1] = l4[1]; va[2] = l4[2]; va[3] = l4[3]; va[4] = h4[0]; va[5] = h4[1]; va[6] = h4[2]; va[7] = h4[3];
                o[dt] = __builtin_amdgcn_mfma_f32_32x32x16_f16(va, pb[sub][sp], o[dt], 0, 0, 0);
            }
        __builtin_amdgcn_sched_barrier(0);
    }
}

template <int MODE, class OnFn>
__device__ __forceinline__ void stream(LAS unsigned char* lds, const h16* Kg, const h16* VTg, int jlo, int jhi, const h16x8 (&qf)[8],
                                       f32x16 (&o)[4], float& m, float& l, int lo, int hi, const OnFn& on_fn, int tid, int lane, float inv_l, LAS float* imp_q) {
    if (jlo >= jhi) return;
    Stage st;
    stage_load(st, Kg, VTg, jlo, tid);
    stage_write(st, lds, tid);
    __syncthreads();
    for (int j = jlo; j < jhi; ++j) {
        const int cur = (j - jlo) & 1;
        if (j + 1 < jhi) stage_load(st, Kg, VTg, j + 1, tid);
        tile_compute<MODE>(lds + cur * BUF_BYTES, j, qf, o, m, l, on_fn(j), lo, hi, lane, inv_l, imp_q);
        if (j + 1 < jhi) stage_write(st, lds + (cur ^ 1) * BUF_BYTES, tid);
        __syncthreads();
    }
}

__device__ __forceinline__ void load_q(h16x8 (&qf)[8], const h16* qrow, int h) {
#pragma unroll
    for (int s = 0; s < 8; ++s) qf[s] = *(const h16x8*)(qrow + 16 * s + 8 * h);
}
__device__ __forceinline__ void zero_o(f32x16 (&o)[4]) {
#pragma unroll
    for (int dt = 0; dt < 4; ++dt)
#pragma unroll
        for (int r = 0; r < 16; ++r) o[dt][r] = 0.f;
}
}

struct MobaOn { unsigned selmask; int b; __device__ __forceinline__ bool operator()(int j) const { const int jb = j >> 2; return jb == b ? true : (((selmask >> jb) & 1u) != 0u); } };
__device__ __forceinline__ void phase_moba_attn_mfma(const Frame& F) {
    const h16* Q = (const h16*)(F.ws + WS_QKV); const h16* K = Q + (size_t)16 * S * 128; const h16* VT = K + (size_t)16 * S * 128; const h16* Z = VT + (size_t)16 * S * 128;
    const float* kmean = (const float*)(F.ws + WS_KMEAN);
    h16* OZ = (h16*)(F.ws + WS_OZ);
    LAS unsigned char* lds = (LAS unsigned char*)F.lds;
    const int lane = F.lane, r31 = lane & 31, h = lane >> 5;
    for (int it = F.bid; it < 256; it += F.G) {
        const int head = it >> 4, pi = it & 15;
#pragma unroll 1
        for (int half = 0; half < 2; ++half) {
            const int b = half ? 31 - pi : pi;
            const int t = b * 256 + F.wave * 32 + r31;
            h16x8 qf[8]; fa::load_q(qf, Q + ((size_t)head * S + t) * 128, h);
            float v0 = NEGF, v1 = NEGF, v2 = NEGF; int i0 = -1, i1 = -1, i2 = -1;
            for (int jb = 0; jb < b; ++jb) {
                const float* km = kmean + ((size_t)head * 32 + jb) * 128 + 8 * h;
                float d = 0.f;
#pragma unroll
                for (int s = 0; s < 8; ++s) { const f32x4 ka = *(const f32x4*)(km + 16 * s) + *(const f32x4*)(km + 65536 + 16 * s), kb = *(const f32x4*)(km + 16 * s + 4) + *(const f32x4*)(km + 65536 + 16 * s + 4);
                    d += (float)qf[s][0] * ka[0] + (float)qf[s][1] * ka[1] + (float)qf[s][2] * ka[2] + (float)qf[s][3] * ka[3] + (float)qf[s][4] * kb[0] + (float)qf[s][5] * kb[1] + (float)qf[s][6] * kb[2] + (float)qf[s][7] * kb[3]; }
                d += __shfl_xor(d, 32);
                if (d > v0) { v2 = v1; i2 = i1; v1 = v0; i1 = i0; v0 = d; i0 = jb; }
                else if (d > v1) { v2 = v1; i2 = i1; v1 = d; i1 = jb; }
                else if (d > v2) { v2 = d; i2 = jb; }
            }
            MobaOn on; on.b = b; on.selmask = (i0 >= 0 ? 1u << i0 : 0u) | (i1 >= 0 ? 1u << i1 : 0u) | (i2 >= 0 ? 1u << i2 : 0u);
            fa::f32x16 o[4]; fa::zero_o(o); float m = NEGF, l = 0.f;
            fa::stream<0>(lds, K + (size_t)head * S * 128, VT + (size_t)head * S * 128, 0, 4 * b + 4, qf, o, m, l, 0, t, on, F.tid, lane, 0.f, (LAS float*)nullptr);
            l += __shfl_xor(l, 32);
            const float inv = 1.0f / fmaxf(l, 1e-30f);
#pragma unroll
            for (int dt = 0; dt < 4; ++dt)
#pragma unroll
                for (int c = 0; c < 4; ++c) {
                    const int d = 32 * dt + 8 * c + 4 * h; const size_t off = (size_t)t * 2048 + head * 128 + d;
                    const h16x4 zz = *(const h16x4*)(Z + off); h16x4 ov;
#pragma unroll
                    for (int e = 0; e < 4; ++e) ov[e] = (h16)(o[dt][4 * c + e] * inv * (float)zz[e]);
                    *(h16x4*)(OZ + off) = ov;
                }
        }
    }
}

struct AllOn { __device__ __forceinline__ bool operator()(int) const { return true; } };
struct SelOn { const LAS unsigned* w; __device__ __forceinline__ bool operator()(int j) const { return ((w[j >> 5] >> (j & 31)) & 1u) != 0u; } };
__device__ __forceinline__ void phase_nsa_attn_mfma(const Frame& F) {
    const h16* Q = (const h16*)(F.ws + WS_QKV); const h16* KVb = Q + (size_t)16 * S * 128;
    const h16* Z = (const h16*)(F.ws + WS_QKV + 96 * MiB);
    const float* gates = (const float*)(F.ws + WS_GATES);
    const h16* KCMP = (const h16*)(F.ws + WS_KCMP); const h16* VCMPT = (const h16*)(F.ws + WS_VCMP);
    h16* OZ = (h16*)(F.ws + WS_OZ);
    LAS unsigned char* lds = (LAS unsigned char*)F.lds;
    LAS float* imp = (LAS float*)(lds + fa::LDS_IMP); LAS unsigned* selw = (LAS unsigned*)(lds + fa::LDS_SELW); LAS float* sv = (LAS float*)(lds + fa::LDS_SV) + F.wave * 128;
    const int lane = F.lane, r31 = lane & 31, h = lane >> 5, hh = F.wave & 3, qsub = F.wave >> 2;
    for (int it = F.bid; it < 256; it += F.G) {
        const int g = it >> 6, pi = it & 63, head = 4 * g + hh;
#pragma unroll 1
        for (int half = 0; half < 2; ++half) {
            const int c64 = half ? 127 - pi : pi;
            const int ql = 32 * qsub + r31, t = c64 * 64 + ql;
            h16x8 qf[8]; fa::load_q(qf, Q + ((size_t)head * S + t) * 128, h);
            fa::f32x16 o[4]; float m, l;
            for (int i = F.tid; i < 64 * 128; i += NTHREADS) imp[i] = 0.f;
            const int nval = (t >= 31) ? (((t - 31) >> 4) + 1 < NC ? ((t - 31) >> 4) + 1 : NC) : 0;
            const int tl = c64 * 64 + 63; const int nval_max = (tl >= 31) ? (((tl - 31) >> 4) + 1 < NC ? ((tl - 31) >> 4) + 1 : NC) : 0;
            const int jc = (nval_max + 63) >> 6;
            fa::zero_o(o); m = NEGF; l = 0.f;
            fa::stream<1>(lds, KCMP + (size_t)g * 512 * 128, VCMPT + (size_t)g * 512 * 128, 0, jc, qf, o, m, l, 0, nval - 1, AllOn(), F.tid, lane, 0.f, (LAS float*)nullptr);
            l += __shfl_xor(l, 32);
            { const float invl = 1.0f / fmaxf(l, 1e-30f); float l2 = 0.f;
              fa::stream<2>(lds, KCMP + (size_t)g * 512 * 128, VCMPT + (size_t)g * 512 * 128, 0, jc, qf, o, m, l2, 0, nval - 1, AllOn(), F.tid, lane, invl, imp + ql * 128); }
            const float g0 = gates[(size_t)t * 48 + head * 3 + 0];
#pragma unroll
            for (int dt = 0; dt < 4; ++dt)
#pragma unroll
                for (int c = 0; c < 4; ++c) { h16x4 ov;
#pragma unroll
                    for (int e = 0; e < 4; ++e) ov[e] = (h16)(o[dt][4 * c + e] * g0);
                    *(h16x4*)(OZ + (size_t)t * 2048 + head * 128 + 32 * dt + 8 * c + 4 * h) = ov; }
            __syncthreads();
            for (int qq = 0; qq < 8; ++qq) {
                const int q = F.wave * 8 + qq;
                float myv[2];
#pragma unroll
                for (int c = 0; c < 2; ++c) { const int s = lane + 64 * c; const bool valid = s <= c64, forced = (s == 0) || (s == c64) || (s == c64 - 1);
                    myv[c] = valid ? (forced ? BIGF : imp[q * 128 + s]) : NEGF; sv[s] = myv[c]; }
                wave_lds_fence();
                int rank0 = 0, rank1 = 0;
                for (int s2 = 0; s2 < 128; ++s2) { const float v2 = sv[s2];
                    rank0 += (v2 > myv[0] || (v2 == myv[0] && s2 < lane)) ? 1 : 0; rank1 += (v2 > myv[1] || (v2 == myv[1] && s2 < lane + 64)) ? 1 : 0; }
                const unsigned long long m0 = __ballot(rank0 < 16 && lane <= c64), m1 = __ballot(rank1 < 16 && (lane + 64) <= c64);
                if (lane == 0) { selw[q * 4 + 0] = (unsigned)m0; selw[q * 4 + 1] = (unsigned)(m0 >> 32); selw[q * 4 + 2] = (unsigned)m1; selw[q * 4 + 3] = (unsigned)(m1 >> 32); }
                wave_lds_fence();
            }
            __syncthreads();
            SelOn son; son.w = selw + ql * 4;
            fa::zero_o(o); m = NEGF; l = 0.f;
            fa::stream<0>(lds, KVb + ((size_t)2 * 4 + g) * S * 128, KVb + ((size_t)3 * 4 + g) * S * 128, 0, c64 + 1, qf, o, m, l, 0, t, son, F.tid, lane, 0.f, (LAS float*)nullptr);
            l += __shfl_xor(l, 32);
            { const float sc = gates[(size_t)t * 48 + head * 3 + 1] / fmaxf(l, 1e-30f);
#pragma unroll
              for (int dt = 0; dt < 4; ++dt)
#pragma unroll
                  for (int c = 0; c < 4; ++c) { h16* p = OZ + (size_t)t * 2048 + head * 128 + 32 * dt + 8 * c + 4 * h; const h16x4 pv = *(const h16x4*)p; h16x4 ov;
#pragma unroll
                      for (int e = 0; e < 4; ++e) ov[e] = (h16)((float)pv[e] + o[dt][4 * c + e] * sc);
                      *(h16x4*)p = ov; } }
            fa::zero_o(o); m = NEGF; l = 0.f;
            fa::stream<0>(lds, KVb + ((size_t)4 * 4 + g) * S * 128, KVb + ((size_t)5 * 4 + g) * S * 128, (c64 >= 8 ? c64 - 8 : 0), c64 + 1, qf, o, m, l, t - 511, t, AllOn(), F.tid, lane, 0.f, (LAS float*)nullptr);
            l += __shfl_xor(l, 32);
            const float sc2 = gates[(size_t)t * 48 + head * 3 + 2] / fmaxf(l, 1e-30f);
#pragma unroll
            for (int dt = 0; dt < 4; ++dt)
#pragma unroll
                for (int c = 0; c < 4; ++c) {
                    const int d = 32 * dt + 8 * c + 4 * h; const size_t off = (size_t)t * 2048 + head * 128 + d;
                    const h16x4 zz = *(const h16x4*)(Z + off); const h16x4 pv = *(const h16x4*)(OZ + off); h16x4 ov;
#pragma unroll
                    for (int e = 0; e < 4; ++e) ov[e] = (h16)(((float)pv[e] + o[dt][4 * c + e] * sc2) * (float)zz[e]);
                    *(h16x4*)(OZ + off) = ov;
                }
        }
    }
}

__device__ __forceinline__ double gamma_of(int h) { return 1.0 - 1.0 / (double)(32 << h); }
__device__ __forceinline__ double dpow_int(double b, int n) { double p = 1.0; for (int i = 0; i < n; ++i) p *= b; return p; }

__device__ __forceinline__ void phase_ret_scan(const Frame& F) {
    const h16* RQ = (const h16*)(F.ws + WS_QKV); const h16* RK = RQ + (size_t)8 * S * 256; const h16* RV = RK + (size_t)8 * S * 256;
    h16* SB = (h16*)(F.ws + WS_P);
    float* ks = (float*)F.lds;
    h16* vs = (h16*)(F.lds + 32768);
    float* wd = (float*)(F.lds + 49152);
    for (int it = F.bid; it < 256; it += F.G) {
        const int h = it >> 5, dk0 = ((it >> 3) & 3) * 64, dv0 = (it & 7) * 64;
        const double gam = gamma_of(h);
        __syncthreads();
        if (F.tid < 128) wd[F.tid] = (float)dpow_int(gam, 127 - F.tid);
        const float carry = (float)dpow_int(gam, 128);
        const int tk = F.tid >> 3, tv = F.tid & 7;
        float st[8];
#pragma unroll
        for (int e = 0; e < 8; ++e) st[e] = 0.f;
        __syncthreads();
        for (int c = 0; c < 64; ++c) {
            { h16x8 o;
#pragma unroll
              for (int e = 0; e < 8; ++e) o[e] = (h16)st[e];
              *(h16x8*)(SB + (((size_t)h * 64 + c) * 256 + dk0 + tk) * 512 + dv0 + tv * 8) = o; }
            for (int i = F.tid; i < 128 * 8; i += NTHREADS) {
                const int j = i >> 3, c8 = (i & 7) * 8;
                const h16x8 kk = *(const h16x8*)(RK + ((size_t)h * S + c * 128 + j) * 256 + dk0 + c8);
                const h16x8 vv = *(const h16x8*)(RV + ((size_t)h * S + c * 128 + j) * 512 + dv0 + c8);
                const float w = wd[j];
#pragma unroll
                for (int e = 0; e < 8; ++e) ks[j * 64 + c8 + e] = (float)kk[e] * w;
                *(h16x8*)(vs + j * 64 + c8) = vv;
            }
            __syncthreads();
#pragma unroll
            for (int e = 0; e < 8; ++e) st[e] *= carry;
#pragma unroll 4
            for (int j = 0; j < 128; ++j) {
                const float kf = ks[j * 64 + tk]; const h16x8 vv = *(const h16x8*)(vs + j * 64 + tv * 8);
#pragma unroll
                for (int e = 0; e < 8; ++e) st[e] += kf * (float)vv[e];
            }
            __syncthreads();
        }
    }
}

__device__ __forceinline__ void phase_ret_out(const Frame& F) {
    const h16* RQ = (const h16*)(F.ws + WS_QKV); const h16* RK = RQ + (size_t)8 * S * 256; const h16* RV = RK + (size_t)8 * S * 256;
    const h16* SB = (const h16*)(F.ws + WS_P);
    float* OR_ = (float*)(F.ws + WS_OR);
    h16* Qs = (h16*)F.lds;
    float* AsT = (float*)(F.lds + 65536);
    float* rd = (float*)(F.lds + 131072);
    for (int it = F.bid; it < 512; it += F.G) {
        const int h = it >> 6, c = it & 63;
        const double gam = gamma_of(h);
        __syncthreads();
        if (F.tid < 130) rd[F.tid] = (float)dpow_int(gam, F.tid);
        for (int i = F.tid; i < 128 * 32; i += NTHREADS) {
            const int r = i >> 5, c8 = (i & 31) * 8;
            *(h16x8*)(Qs + r * 256 + c8) = *(const h16x8*)(RQ + ((size_t)h * S + c * 128 + r) * 256 + c8);
        }
        __syncthreads();
        {
            const int j = F.tid & 127, ig = F.tid >> 7;
            float acc[32];
#pragma unroll
            for (int ii = 0; ii < 32; ++ii) acc[ii] = 0.f;
            const h16* krow = RK + ((size_t)h * S + c * 128 + j) * 256;
            for (int d8 = 0; d8 < 32; ++d8) {
                const h16x8 kv = *(const h16x8*)(krow + d8 * 8);
                const h16x2 k0 = {kv[0], kv[1]}, k1 = {kv[2], kv[3]}, k2 = {kv[4], kv[5]}, k3 = {kv[6], kv[7]};
#pragma unroll
                for (int ii = 0; ii < 32; ++ii) {
                    const h16x8 qv = *(const h16x8*)(Qs + (ig * 32 + ii) * 256 + d8 * 8);
                    float a = acc[ii];
                    a = __builtin_amdgcn_fdot2((h16x2){qv[0], qv[1]}, k0, a, false); a = __builtin_amdgcn_fdot2((h16x2){qv[2], qv[3]}, k1, a, false);
                    a = __builtin_amdgcn_fdot2((h16x2){qv[4], qv[5]}, k2, a, false); a = __builtin_amdgcn_fdot2((h16x2){qv[6], qv[7]}, k3, a, false);
                    acc[ii] = a;
                }
            }
#pragma unroll
            for (int ii = 0; ii < 32; ++ii) { const int i = ig * 32 + ii; AsT[j * 128 + i] = (i >= j) ? acc[ii] * rd[i - j] : 0.f; }
        }
        __syncthreads();
        for (int i = F.tid; i < 128 * 32; i += NTHREADS) {
            const int r = i >> 5, c8 = (i & 31) * 8; const float w = rd[r + 1];
            h16x8 q = *(h16x8*)(Qs + r * 256 + c8);
#pragma unroll
            for (int e = 0; e < 8; ++e) q[e] = (h16)((float)q[e] * w);
            *(h16x8*)(Qs + r * 256 + c8) = q;
        }
        __syncthreads();
        {
            const int dv = F.tid;
            float acc[128];
#pragma unroll
            for (int i = 0; i < 128; ++i) acc[i] = 0.f;
            const h16* vcol = RV + ((size_t)h * S + c * 128) * 512 + dv;
            for (int j = 0; j < 128; ++j) {
                const float v = (float)vcol[(size_t)j * 512];
#pragma unroll
                for (int i4 = 0; i4 < 32; ++i4) {
                    const f32x4 a = *(const f32x4*)(AsT + j * 128 + i4 * 4);
                    acc[i4 * 4 + 0] += a[0] * v; acc[i4 * 4 + 1] += a[1] * v; acc[i4 * 4 + 2] += a[2] * v; acc[i4 * 4 + 3] += a[3] * v;
                }
            }
            const h16* scol = SB + (((size_t)h * 64 + c) * 256) * 512 + dv;
            for (int d8 = 0; d8 < 32; ++d8) {
                h16x2 s0, s1, s2, s3;
                s0[0] = scol[(size_t)(d8 * 8 + 0) * 512]; s0[1] = scol[(size_t)(d8 * 8 + 1) * 512]; s1[0] = scol[(size_t)(d8 * 8 + 2) * 512]; s1[1] = scol[(size_t)(d8 * 8 + 3) * 512];
                s2[0] = scol[(size_t)(d8 * 8 + 4) * 512]; s2[1] = scol[(size_t)(d8 * 8 + 5) * 512]; s3[0] = scol[(size_t)(d8 * 8 + 6) * 512]; s3[1] = scol[(size_t)(d8 * 8 + 7) * 512];
#pragma unroll
                for (int i = 0; i < 128; ++i) {
                    const h16x8 qv = *(const h16x8*)(Qs + i * 256 + d8 * 8);
                    float a = acc[i];
                    a = __builtin_amdgcn_fdot2((h16x2){qv[0], qv[1]}, s0, a, false); a = __builtin_amdgcn_fdot2((h16x2){qv[2], qv[3]}, s1, a, false);
                    a = __builtin_amdgcn_fdot2((h16x2){qv[4], qv[5]}, s2, a, false); a = __builtin_amdgcn_fdot2((h16x2){qv[6], qv[7]}, s3, a, false);
                    acc[i] = a;
                }
            }
#pragma unroll
            for (int i = 0; i < 128; ++i) OR_[(size_t)(c * 128 + i) * 4096 + h * 512 + dv] = acc[i];
        }
    }
    __syncthreads();
}

__device__ __forceinline__ void phase_ret_gn(const Frame& F) {
    const float* OR_ = (const float*)(F.ws + WS_OR);
    const h16* RG = (const h16*)(F.ws + WS_QKV) + (size_t)8 * S * 256 * 2 + (size_t)8 * S * 512;
    h16* OZ = (h16*)(F.ws + WS_OZ);
    for (int task = F.bid * 8 + F.wave; task < S * 8; task += F.G * 8) {
        const int t = task >> 3, h = task & 7;
        const size_t off = (size_t)t * 4096 + h * 512 + F.lane * 8;
        const f32x4 a = *(const f32x4*)(OR_ + off), b = *(const f32x4*)(OR_ + off + 4);
        float s = a[0] + a[1] + a[2] + a[3] + b[0] + b[1] + b[2] + b[3];
        s = wave_sum(s); const float mu = s * (1.0f / 512.0f);
        float q = 0.f;
#pragma unroll
        for (int e = 0; e < 4; ++e) { const float d0 = a[e] - mu, d1 = b[e] - mu; q += d0 * d0 + d1 * d1; }
        q = wave_sum(q); const float r = 1.0f / sqrtf(q * (1.0f / 512.0f) + EPS);
        const h16x8 gv = *(const h16x8*)(RG + off);
        h16x8 o;
#pragma unroll
        for (int e = 0; e < 4; ++e) { o[e] = (h16)((float)gv[e] * ((a[e] - mu) * r)); o[4 + e] = (h16)((float)gv[4 + e] * ((b[e] - mu) * r)); }
        *(h16x8*)(OZ + off) = o;
    }
}

template <int KIND>
__device__ __forceinline__ void phase_gemm_proj(const Frame& F, int N) {
    pg8::Gemm g{(const h16*)(F.ws + WS_H), (const h16*)(F.ws + WS_WTIN), S, N, 2048, 2048, 2048}; pg8::StaticOrder So; So.init(S, N, F.G, F.bid);
    pg8::EpiProj<KIND> E{F.ws};
    pg8::gemm_phase<pg8::EpiProj<KIND>, pg8::StaticOrder, true, true>((LAS unsigned char*)F.lds, g, So, E);
}
__device__ __forceinline__ void phase_gemm(const Frame& F, const h16* A, const h16* Bt, int N, int K, void* O, int ldc, int f32out) {
    pg8::Gemm g{A, Bt, S, N, K, K, K}; pg8::StaticOrder So; So.init(S, N, F.G, F.bid);
    pg8::EpiStore E{O, ldc, f32out};
    pg8::gemm_phase<pg8::EpiStore, pg8::StaticOrder, true, true>((LAS unsigned char*)F.lds, g, So, E);
}

constexpr int NPHASE = 2 + 8 * DEPTH;
__host__ __device__ inline bool phase_exists(int p) {
    if (p < 2) return true;
    const int L = (p - 2) / 8, s = (p - 2) % 8, kind = L % 3;
    if (s == 7) return false;
    if (s == 1) return kind == 1;
    if (s == 2) return kind != 0;
    if (s == 4) return kind == 2;
    return true;
}

__global__ void __launch_bounds__(NTHREADS, 2) trunk_fwd(Args args) {
    extern __shared__ __attribute__((aligned(16))) unsigned char lds_raw[];
    Frame F;
    F.out = args.out; F.ws = args.ws; F.lds = (char*)lds_raw;
    F.tid = threadIdx.x; F.lane = F.tid & 63; F.wave = __builtin_amdgcn_readfirstlane(F.tid >> 6); F.G = gridDim.x; F.bid = blockIdx.x;
    volatile LAS unsigned* misc = (volatile LAS unsigned*)((LAS unsigned char*)lds_raw + MISC_OFF);
    if (F.tid < 16) misc[F.tid] = 0u;
    __syncthreads();
    XcdBarrier bar; bar.bar = (unsigned*)(F.ws + WS_CTL) + CW_BAR; bar.x = 0; bar.st = misc;
#if ONE_LAUNCH
    bar = xcd_barrier_post((unsigned*)(F.ws + WS_CTL) + CW_BAR, misc);
    cg::grid_group grid = cg::this_grid();
#endif
    const int lo = args.ph_lo, hi = args.ph_hi;
#if ONE_LAUNCH
    grid.sync();
#define SEAM(p) do { if ((p) > lo) xcd_barrier(bar); } while (0)
#else
#define SEAM(p) do { } while (0)
#endif
#define IN(p) (lo <= (p) && (p) < hi)
#ifndef PHMASK
#define PHMASK 0xFFFF
#endif
#define EN(b) ((PHMASK >> (b)) & 1)
#ifndef PROBE_DUP
#define PROBE_DUP 0
#endif
#define DUP(b, call) do { if ((PROBE_DUP >> (b)) & 1) { if (ONE_LAUNCH) xcd_barrier(bar); call; } } while (0)
    if (EN(0) && IN(0)) { SEAM(0); phase_prologue(F, args); }
    if (EN(1) && IN(1)) { SEAM(1); phase_norm(F, args, -1, 0); }
#define LAYER(L) do { \
        constexpr int kind = (L) % 3, base = 2 + 8 * (L); \
        constexpr int Nin = kind == 0 ? 8192 : (kind == 1 ? NSA_NP : 12288); \
        constexpr int Kout = kind == 2 ? 4096 : 2048; \
        if (EN(2) && IN(base + 0)) { SEAM(base + 0); phase_gemm_proj<kind>(F, Nin); } \
        if (EN(6) && kind == 1 && IN(base + 1)) { SEAM(base + 1); phase_nsa_cmp_a(F); } \
        if (kind != 0 && IN(base + 2)) { SEAM(base + 2); if (EN(6) && kind == 1) { phase_nsa_cmp_b(F, args); } else if (EN(7) && kind == 2) { phase_ret_scan(F); DUP(7, phase_ret_scan(F)); } } \
        if (IN(base + 3)) { SEAM(base + 3); if (EN(8) && kind == 0) { phase_moba_attn_mfma(F); DUP(8, phase_moba_attn_mfma(F)); } else if (EN(9) && kind == 1) { phase_nsa_attn_mfma(F); DUP(9, phase_nsa_attn_mfma(F)); } else if (EN(10) && kind == 2) { phase_ret_out(F); DUP(10, phase_ret_out(F)); } } \
        if (EN(11) && kind == 2 && IN(base + 4)) { SEAM(base + 4); phase_ret_gn(F); } \
        if (EN(2) && IN(base + 5)) { SEAM(base + 5); phase_gemm(F, (const h16*)(F.ws + WS_OZ), (const h16*)(F.ws + WS_WTOUT), 2048, Kout, F.ws + WS_Y, 2048, 1); } \
        if (EN(1) && IN(base + 6)) { SEAM(base + 6); phase_norm(F, args, (L), (L) + 1 < DEPTH ? (L) + 1 : -1); } \
    } while (0)
    LAYER(0); LAYER(1); LAYER(2); LAYER(3);
#undef LAYER
#undef EN
#undef DUP
#undef IN
#undef SEAM
}

extern "C" void kernel_launch(void* const* d_in, const int* in_sizes, int n_in, void* d_out, int out_size, void* d_ws, size_t ws_size, hipStream_t stream) {
    static int grid = 0;
    if (grid == 0) {
        if (n_in != 18 || out_size != S * D || ws_size < WS_END) { fprintf(stderr, "kernel_launch: unexpected shapes (n_in %d, out %d, ws %zu)\n", n_in, out_size, ws_size); grid = -1; return; }
        int dev = 0, cus = 0, per_cu = 0;
        if (hipGetDevice(&dev) != hipSuccess || hipDeviceGetAttribute(&cus, hipDeviceAttributeMultiprocessorCount, dev) != hipSuccess) { grid = -1; return; }
        if (hipFuncSetAttribute((const void*)trunk_fwd, hipFuncAttributeMaxDynamicSharedMemorySize, LDS_BYTES) != hipSuccess) { fprintf(stderr, "kernel_launch: hipFuncSetAttribute failed\n"); grid = -1; return; }
        if (hipOccupancyMaxActiveBlocksPerMultiprocessor(&per_cu, (const void*)trunk_fwd, NTHREADS, LDS_BYTES) != hipSuccess || per_cu < 1) { fprintf(stderr, "kernel_launch: occupancy query says %d\n", per_cu); per_cu = 1; }
        (void)hipGetLastError();
        grid = cus;
    }
    if (grid < 0) return;
    (void)hipMemsetAsync((char*)d_ws + WS_CTL, 0, CTL_ZERO_BYTES, stream);
    Args a{};
    for (int i = 0; i < 18; ++i) a.in[i] = (const float*)d_in[i];
    a.out = (float*)d_out; a.ws = (unsigned char*)d_ws;
    for (int j = 0; j < 16; ++j) a.inv16[j] = pow(500000.0, -(double)j / 16.0);
    for (int j = 0; j < 128; ++j) a.inv128[j] = pow(10000.0, -(double)j / 128.0);
#if ONE_LAUNCH
    a.ph_lo = 0; a.ph_hi = NPHASE;
    void* kargs[] = {&a};
    hipError_t e = hipLaunchCooperativeKernel((const void*)trunk_fwd, dim3(grid), dim3(NTHREADS), kargs, LDS_BYTES, stream);
    if (e != hipSuccess) fprintf(stderr, "kernel_launch: cooperative launch failed: %s (grid %d)\n", hipGetErrorString(e), grid);
#else
    for (int p = 0; p < NPHASE; ++p) {
        if (!phase_exists(p)) continue;
        a.ph_lo = p; a.ph_hi = p + 1;
        hipLaunchKernelGGL(trunk_fwd, dim3(grid), dim3(NTHREADS), LDS_BYTES, stream, a);
    }
#endif
}
```

```cpp
#include <hip/hip_runtime.h>
#include <hip/hip_cooperative_groups.h>
#include <cstdio>
#include <cstdint>
#include <cmath>
namespace cg = cooperative_groups;

#ifndef ONE_LAUNCH
#define ONE_LAUNCH 1
#endif
#ifndef MOBA_MFMA
#define MOBA_MFMA 1
#endif
#ifndef NSA_MFMA
#define NSA_MFMA 1
#endif

#define LAS __attribute__((address_space(3)))
typedef _Float16 h16;
typedef _Float16 h16x2 __attribute__((ext_vector_type(2)));
typedef _Float16 h16x4 __attribute__((ext_vector_type(4)));
typedef _Float16 h16x8 __attribute__((ext_vector_type(8)));
typedef float f32x2 __attribute__((ext_vector_type(2)));
typedef float f32x4 __attribute__((ext_vector_type(4)));
typedef unsigned u32x4 __attribute__((ext_vector_type(4)));

constexpr int S = 8192, D = 2048, DEPTH = 4;
constexpr float EPS = 1e-6f;
constexpr float NEGF = -1e30f, BIGF = 1e30f;
constexpr int NSA_NP = 7424;
constexpr int NC = 511;

constexpr size_t MiB = 1u << 20;
constexpr size_t WS_CTL = 0, CTL_ZERO_BYTES = 1 * MiB;
constexpr size_t WS_MODP = 1 * MiB;
constexpr size_t WS_KMEAN = 2 * MiB;
constexpr size_t WS_CMPB = 2 * MiB + 512 * 1024;
constexpr size_t WS_GATES = 3 * MiB;
constexpr size_t WS_KCMP = 5 * MiB;
constexpr size_t WS_VCMP = 5 * MiB + 512 * 1024;
constexpr size_t WS_ROPE16 = 6 * MiB;
constexpr size_t WS_ROPE128 = 7 * MiB;
constexpr size_t WS_WTIN = 16 * MiB;
constexpr size_t WS_WTOUT = 64 * MiB;
constexpr size_t WS_W1T = 72 * MiB;
constexpr size_t WS_H = 80 * MiB;
constexpr size_t WS_P = 112 * MiB;
constexpr size_t WS_QKV = 304 * MiB;
constexpr size_t WS_OZ = 496 * MiB;
constexpr size_t WS_Y = 560 * MiB;
constexpr size_t WS_OR = 624 * MiB;
constexpr size_t WS_END = 752 * MiB;

constexpr int LDS_BYTES = 147456;
constexpr int MISC_OFF = 135168;
constexpr int NTHREADS = 512;

struct Args {
    const float* in[18];
    float* out;
    unsigned char* ws;
    double inv16[16];
    double inv128[128];
    float lg2g[8];
    int ph_lo, ph_hi;
};

#define XB_TMO      128
#define XB_XCNT(j)  (256  + 64 * (j))
#define XB_XSUB(j)  (1280 + 64 * (j))
#define XB_XGEN(j)  (2304 + 64 * (j))
#define XB_TOP      3328
#define XB_TOPGEN   3392
#define XCD_BAR_WORDS 3456
#define XB_SPIN_CAP (1u << 24)
constexpr int CW_BAR = 4096;

__device__ __forceinline__ unsigned xb_ld(unsigned* p)              { return __hip_atomic_load(p, __ATOMIC_RELAXED, __HIP_MEMORY_SCOPE_AGENT); }
__device__ __forceinline__ unsigned xb_add(unsigned* p, unsigned v) { return __hip_atomic_fetch_add(p, v, __ATOMIC_RELAXED, __HIP_MEMORY_SCOPE_AGENT); }
__device__ __forceinline__ unsigned xb_xcc_id() { return (unsigned)__builtin_amdgcn_s_getreg((3 << 11) | 20) & 0xFu; }
#define XB_SPIN(cond, bar) do { unsigned _sp = 0; while (cond) { __builtin_amdgcn_s_sleep(1); \
    if ((++_sp & 255u) == 0u) { if (xb_ld(&(bar)[XB_TMO])) break; if (_sp > XB_SPIN_CAP) { atomicAdd(&(bar)[XB_TMO], 1u); break; } } } } while (0)

struct XcdBarrier { unsigned* bar; unsigned x; volatile LAS unsigned* st; };

__device__ __forceinline__ XcdBarrier xcd_barrier_post(unsigned* bar, volatile LAS unsigned* st) {
    XcdBarrier b; b.bar = bar; b.x = xb_xcc_id(); b.st = st;
    if (threadIdx.x == 0) (void)xb_add(&bar[XB_XCNT(b.x)], 1u);
    return b;
}
__device__ __forceinline__ void xcd_barrier_complete(unsigned* bar, unsigned x, unsigned& nloc, unsigned& nx) {
    const unsigned G = gridDim.x * gridDim.y * gridDim.z;
    unsigned sum, cnt, mine, sp = 0u;
    for (;;) {
        sum = 0u; cnt = 0u; mine = 0u;
#pragma unroll
        for (unsigned j = 0; j < 16; ++j) { const unsigned c = xb_ld(&bar[XB_XCNT(j)]); sum += c; cnt += (c > 0u) ? 1u : 0u; mine = (j == x) ? c : mine; }
        if (sum == G) break;
        __builtin_amdgcn_s_sleep(1);
        if ((++sp & 255u) == 0u) { if (xb_ld(&bar[XB_TMO])) break; if (sp > XB_SPIN_CAP) { atomicAdd(&bar[XB_TMO], 1u); break; } }
    }
    nloc = mine > 0u ? mine : 1u; nx = cnt > 0u ? cnt : 1u;
}
__device__ __forceinline__ void xcd_barrier(const XcdBarrier& b) {
    asm volatile("s_waitcnt vmcnt(0)" ::: "memory");
    __syncthreads();
    if (threadIdx.x == 0) {
        unsigned* bar = b.bar;
        __builtin_amdgcn_s_waitcnt(0);
        unsigned nloc = b.st[0], nx = b.st[1];
        if (nloc == 0u) { xcd_barrier_complete(bar, b.x, nloc, nx); b.st[0] = nloc; b.st[1] = nx; }
        const unsigned old = xb_add(&bar[XB_XSUB(b.x)], 1u);
        const unsigned gen = old / nloc;
        if (old + 1u == (gen + 1u) * nloc) {
            __builtin_amdgcn_fence(__ATOMIC_RELEASE, "agent");
            asm volatile("s_waitcnt vmcnt(0)" ::: "memory");
            const unsigned og = xb_add(&bar[XB_TOP], 1u);
            const unsigned tg = og / nx;
            if (og + 1u == (tg + 1u) * nx) xb_add(&bar[XB_TOPGEN], 1u);
            else XB_SPIN(xb_ld(&bar[XB_TOPGEN]) == tg, bar);
            __builtin_amdgcn_fence(__ATOMIC_ACQUIRE, "agent");
            xb_add(&bar[XB_XGEN(b.x)], 1u);
            asm volatile("s_waitcnt vmcnt(0)" ::: "memory");
        } else {
            XB_SPIN(xb_ld(&bar[XB_XGEN(b.x)]) == gen, bar);
            __builtin_amdgcn_fence(__ATOMIC_ACQUIRE, "agent");
            asm volatile("s_waitcnt vmcnt(0)" ::: "memory");
        }
    }
    __syncthreads();
}

__device__ __forceinline__ float silu_f(float x) { return x / (1.f + __expf(-x)); }
__device__ __forceinline__ float sigmoid_f(float x) { return 1.f / (1.f + __expf(-x)); }

namespace pg8 {
constexpr int BM = 256, BK = 64, HALF = 128, HTB = HALF * BK * 2, STAGE_BYTES = 8 * HTB, NXCD = 8, WGM = 8;
__host__ __device__ __forceinline__ int lds_byte(int r, int c) { const int st = (r >> 4) * 2 + (c >> 5), rr = r & 15, cc = c & 31, ob = rr * 64 + cc * 2; return st * 1024 + (ob ^ (((ob >> 9) & 1) << 5)); }
__host__ __device__ __forceinline__ void stage_rc(int b, int& R, int& C) { const int st = b / 1024, sb = b % 1024, swz = sb ^ (((sb >> 9) & 1) << 5); R = (st >> 1) * 16 + swz / 64; C = (st & 1) * 32 + (swz % 64) / 2; }
__host__ __device__ __forceinline__ int perm32(int rho) { const int n = rho >> 4, i = rho & 15; return 8 * (i >> 2) + 4 * n + (i & 3); }

struct Unit { int pm, pn; };
struct Gemm { const h16* A; const h16* Bt; int M, N, K, lda, ldb; };

struct StaticOrder {
    int nM, nN, nwg, G, c;
    __host__ __device__ void init(int M, int N, int G_, int c_) { nM = M / BM; nN = N / BM; nwg = nM * nN; G = G_; c = c_; }
    __host__ __device__ bool next(int i, Unit& u) const {
        const long L = (long)i * G + c; if (L >= nwg) return false;
        int wgid = (int)L; { const int q = nwg / NXCD, r = nwg % NXCD, xcd = wgid % NXCD, off = wgid / NXCD; wgid = (xcd < r ? xcd * (q + 1) : r * (q + 1) + (xcd - r) * q) + off; }
        const int nig = WGM * nN, gid = wgid / nig, fm = gid * WGM, gsz = (nM - fm) < WGM ? (nM - fm) : WGM;
        u.pm = fm + ((wgid % nig) % gsz); u.pn = (wgid % nig) / gsz; return true;
    }
    __device__ __forceinline__ void a_ready(const Unit&) const {}
    __device__ __forceinline__ void done(const Unit&) const {}
};

struct OneUnit {
    int pm, pn, have;
    __device__ bool next(int i, Unit& u) const { if (i != 0 || !have) return false; u.pm = pm; u.pn = pn; return true; }
    __device__ __forceinline__ void a_ready(const Unit&) const {}
    __device__ __forceinline__ void done(const Unit&) const {}
};
struct EpiStore {
    static constexpr bool PERM = true, AFTER_DRAIN = false;
    void* O; int ldc; int f32out;
    __device__ __forceinline__ void operator()(const f32x4 (&acc)[2][2][4][2], const Unit& u, int wr, int wc, int fr, int fq) const {
        const int row0 = u.pm * BM + wr * 64 + fr, col0 = u.pn * BM + wc * 32 + 8 * fq;
#pragma unroll
        for (int ai = 0; ai < 2; ++ai)
#pragma unroll
            for (int m = 0; m < 4; ++m) {
                const size_t roff = (size_t)(row0 + ai * HALF + m * 16) * ldc + col0;
#pragma unroll
                for (int bj = 0; bj < 2; ++bj) {
                    const f32x4 v0 = acc[ai][bj][m][0], v1 = acc[ai][bj][m][1];
                    if (f32out) {
                        float* p = (float*)O + roff + bj * HALF;
                        *(f32x4*)p = v0; *(f32x4*)(p + 4) = v1;
                    } else {
                        h16x8 w; w[0] = (h16)v0[0]; w[1] = (h16)v0[1]; w[2] = (h16)v0[2]; w[3] = (h16)v0[3]; w[4] = (h16)v1[0]; w[5] = (h16)v1[1]; w[6] = (h16)v1[2]; w[7] = (h16)v1[3];
                        *(h16x8*)((h16*)O + roff + bj * HALF) = w;
                    }
                }
            }
    }
};


template <int KIND  > struct EpiProj {
    static constexpr bool PERM = true, AFTER_DRAIN = false;
    unsigned char* ws;
    __device__ __forceinline__ static void st8(h16* p, const float (&v)[8]) { h16x8 w;
#pragma unroll
        for (int i = 0; i < 8; ++i) w[i] = (h16)v[i];
        *(h16x8*)p = w; }
    __device__ __forceinline__ void operator()(const f32x4 (&acc)[2][2][4][2], const Unit& u, int wr, int wc, int fr, int fq) const {
        const int pn = u.pn, d0 = 32 * wc + 8 * fq;
        h16* QKV = (h16*)(ws + WS_QKV);
        const f32x2* r16 = (const f32x2*)(ws + WS_ROPE16); const f32x2* r128 = (const f32x2*)(ws + WS_ROPE128);
        float ksum[2][8];
#pragma unroll
        for (int bj = 0; bj < 2; ++bj)
#pragma unroll
            for (int i = 0; i < 8; ++i) ksum[bj][i] = 0.f;
        int mode;
        float scale = 1.f; h16* base = QKV; int ld = 0;
        bool want_ksum = false;
        if (KIND == 0) {
            const int sect = pn >> 3;
            if (sect == 0) { mode = 0; scale = 0.08838834764831845f; base = QKV + (size_t)(2 * (pn & 7)) * S * 128; }
            else if (sect == 1) { mode = 0; want_ksum = true; base = QKV + (size_t)16 * S * 128 + (size_t)(2 * (pn & 7)) * S * 128; }
            else if (sect == 2) { mode = 1; base = QKV + (size_t)32 * S * 128 + (size_t)(2 * (pn & 7)) * S * 128; }
            else { mode = 2; base = QKV + (size_t)48 * S * 128 + (pn & 7) * 256; ld = 2048; }
        } else if (KIND == 1) {
            if (pn < 8) { mode = 0; scale = 0.08838834764831845f; base = QKV + (size_t)(2 * pn) * S * 128; }
            else if (pn < 20) { const int ti = (pn - 8) >> 1; mode = (ti & 1) ? 1 : 0; base = QKV + (size_t)16 * S * 128 + ((size_t)ti * 4 + 2 * ((pn - 8) & 1)) * S * 128; }
            else if (pn < 28) { mode = 2; base = (h16*)(ws + WS_QKV + 96 * MiB) + (pn - 20) * 256; ld = 2048; }
            else mode = 3;
        } else {
            if (pn < 8) { mode = 4; base = QKV + (size_t)pn * S * 256; }
            else if (pn < 16) { mode = 4; scale = 0.0625f; base = QKV + (size_t)8 * S * 256 + (size_t)(pn - 8) * S * 256; }
            else if (pn < 32) { mode = 5; base = QKV + (size_t)16 * S * 256 + (size_t)((pn - 16) >> 1) * S * 512 + ((pn - 16) & 1) * 256; }
            else { mode = 2; base = QKV + (size_t)16 * S * 256 + (size_t)8 * S * 512 + (pn - 32) * 256; ld = 4096; }
        }
#pragma unroll
        for (int ai = 0; ai < 2; ++ai)
#pragma unroll
            for (int m = 0; m < 4; ++m) {
                const int t = u.pm * BM + ai * HALF + wr * 64 + m * 16 + fr;
                float v[2][8];
#pragma unroll
                for (int bj = 0; bj < 2; ++bj)
#pragma unroll
                    for (int i = 0; i < 8; ++i) v[bj][i] = acc[ai][bj][m][i >> 2][i & 3];
                if (mode == 0) {
                    if (wc == 0) {
                        const f32x2* cs = r16 + (size_t)t * 16 + 8 * (fq & 1);
#pragma unroll
                        for (int bj = 0; bj < 2; ++bj)
#pragma unroll
                            for (int i = 0; i < 8; ++i) { const float o = __shfl_xor(v[bj][i], 32); const f32x2 c = cs[i];
                                v[bj][i] = (fq < 2) ? (v[bj][i] * c[0] - o * c[1]) : (o * c[1] + v[bj][i] * c[0]); }
                    }
#pragma unroll
                    for (int bj = 0; bj < 2; ++bj) {
#pragma unroll
                        for (int i = 0; i < 8; ++i) { v[bj][i] *= scale; ksum[bj][i] += v[bj][i]; }
                        st8(base + ((size_t)bj * S + t) * 128 + d0, v[bj]);
                    }
                } else if (mode == 1) {
#pragma unroll
                    for (int bj = 0; bj < 2; ++bj) st8(base + ((size_t)bj * S + t) * 128 + d0, v[bj]);
                } else if (mode == 2) {
#pragma unroll
                    for (int bj = 0; bj < 2; ++bj) {
#pragma unroll
                        for (int i = 0; i < 8; ++i) v[bj][i] = silu_f(v[bj][i]);
                        st8(base + (size_t)t * ld + 128 * bj + d0, v[bj]);
                    }
                } else if (mode == 3) {
                    if (d0 < 48) { float* gp = (float*)(ws + WS_GATES) + (size_t)t * 48 + d0;
#pragma unroll
                        for (int i = 0; i < 8; ++i) gp[i] = sigmoid_f(v[0][i]); }
                } else if (mode == 4) {
                    const f32x2* cs = r128 + (size_t)t * 128 + d0;
#pragma unroll
                    for (int i = 0; i < 8; ++i) { const f32x2 c = cs[i]; const float x1 = v[0][i], x2 = v[1][i];
                        v[0][i] = (x1 * c[0] - x2 * c[1]) * scale; v[1][i] = (x1 * c[1] + x2 * c[0]) * scale; }
                    st8(base + (size_t)t * 256 + d0, v[0]); st8(base + (size_t)t * 256 + 128 + d0, v[1]);
                } else {
#pragma unroll
                    for (int bj = 0; bj < 2; ++bj) st8(base + (size_t)t * 512 + 128 * bj + d0, v[bj]);
                }
            }
        if (KIND == 0 && want_ksum) {
#pragma unroll
            for (int bj = 0; bj < 2; ++bj)
#pragma unroll
                for (int i = 0; i < 8; ++i) { float x = ksum[bj][i]; x += __shfl_xor(x, 1); x += __shfl_xor(x, 2); x += __shfl_xor(x, 4); x += __shfl_xor(x, 8); ksum[bj][i] = x; }
            if (fr == 0) { float* km = (float*)(ws + WS_KMEAN) + (size_t)wr * 65536;
#pragma unroll
                for (int bj = 0; bj < 2; ++bj)
#pragma unroll
                    for (int i = 0; i < 8; ++i) km[((size_t)(2 * (pn & 7) + bj) * 32 + u.pm) * 128 + d0 + i] = ksum[bj][i] * (1.0f / 256.0f); }
        }
    }
};

template <class Epi, class Sched, bool ALIGN_EPI = false, bool SP2 = false>
__device__ __forceinline__ void gemm_phase(LAS unsigned char* lds, const Gemm g, const Sched& S, const Epi& E) {
    const int tid = threadIdx.x, wid = __builtin_amdgcn_readfirstlane(tid >> 6), lane = tid & 63, wr = wid >> 2, wc = wid & 3, fr = lane & 15, fq = lane >> 4;
    const int K = g.K, nt = K / BK;
    unsigned voffA[2], voffB[2];
#pragma unroll
    for (int i = 0; i < 2; ++i) { int R, C; stage_rc(tid * 16 + i * 8192, R, C); const int Rb = Epi::PERM ? ((R & ~31) + perm32(R & 31)) : R;
        voffA[i] = (unsigned)(R * g.lda + C) * 2u; voffB[i] = (unsigned)(Rb * g.ldb + C) * 2u; }
    const size_t kstep = (size_t)(BK * 2);
    const size_t hstepA = (size_t)HALF * g.lda * 2, hstepB = (size_t)HALF * g.ldb * 2;
    const size_t tstepA = 2 * hstepA, tstepB = 2 * hstepB;
    const unsigned ldsw = (unsigned)wid * 1024u;
    const int aoff = lds_byte(wr * 64 + fr, fq * 8), boff = lds_byte(wc * 32 + fr, fq * 8);
#define PG8_SA(b, h) (((b) * 2 + (h)) * HTB)
#define PG8_SB(b, h) ((4 + (b) * 2 + (h)) * HTB)
#define PG8_STAGE(bufoff, gbase, voff) do { _Pragma("unroll") for (int _i = 0; _i < 2; ++_i) \
        __builtin_amdgcn_global_load_lds((const unsigned*)((const char*)(gbase) + (voff)[_i]), (LAS unsigned*)(lds + (bufoff) + ldsw + _i * 8192), 16, 0, 0); } while (0)
#define PG8_LDA(dst, b, h) do { _Pragma("unroll") for (int m = 0; m < 4; ++m) _Pragma("unroll") for (int k = 0; k < 2; ++k) dst[m][k] = *(const LAS h16x8*)(lds + PG8_SA(b, h) + aoff + m * 2048 + k * 1024); } while (0)
#define PG8_LDB(dst, b, h) do { _Pragma("unroll") for (int n = 0; n < 2; ++n) _Pragma("unroll") for (int k = 0; k < 2; ++k) dst[n][k] = *(const LAS h16x8*)(lds + PG8_SB(b, h) + boff + n * 2048 + k * 1024); } while (0)
#define PG8_MMA(ai, bj, At, Bt) do { __builtin_amdgcn_s_setprio(1); _Pragma("unroll") for (int m = 0; m < 4; ++m) _Pragma("unroll") for (int n = 0; n < 2; ++n) _Pragma("unroll") for (int k = 0; k < 2; ++k) \
        acc[ai][bj][m][n] = __builtin_amdgcn_mfma_f32_16x16x32_f16(Bt[n][k], At[m][k], acc[ai][bj][m][n], 0, 0, 0); __builtin_amdgcn_s_setprio(0); } while (0)
#define PG8_WAIT_V(n) asm volatile("s_waitcnt vmcnt(" #n ")" ::: "memory")
#define PG8_WAIT_L(n) asm volatile("s_waitcnt lgkmcnt(" #n ")" ::: "memory")
#define PG8_BAR __builtin_amdgcn_s_barrier()
#define PG8_SCHED __builtin_amdgcn_sched_barrier(0)
    Unit cur, nxt; int ui = 0;
    if (!S.next(0, cur)) return;
    f32x4 acc[2][2][4][2];
#pragma unroll
    for (int a = 0; a < 2; ++a)
#pragma unroll
        for (int b = 0; b < 2; ++b)
#pragma unroll
            for (int m = 0; m < 4; ++m)
#pragma unroll
                for (int n = 0; n < 2; ++n) acc[a][b][m][n] = (f32x4){0.f, 0.f, 0.f, 0.f};
    h16x8 At[4][2], B0[2][2], B1[2][2];
    const char* cA = (const char*)g.A + (size_t)cur.pm * tstepA; const char* cB = (const char*)g.Bt + (size_t)cur.pn * tstepB;
    S.a_ready(cur);
    if constexpr (SP2) {
        PG8_STAGE(PG8_SB(0, 0), cB, voffB); PG8_STAGE(PG8_SB(0, 1), cB + hstepB, voffB); PG8_STAGE(PG8_SA(0, 0), cA, voffA); PG8_STAGE(PG8_SA(0, 1), cA + hstepA, voffA);
        if (wr == 1) PG8_BAR;
        PG8_WAIT_V(2); PG8_BAR;
        PG8_STAGE(PG8_SB(1, 0), cB + kstep, voffB); PG8_STAGE(PG8_SA(1, 0), cA + kstep, voffA); PG8_STAGE(PG8_SB(1, 1), cB + hstepB + kstep, voffB);
        PG8_WAIT_V(6); PG8_BAR;
    } else {
        PG8_STAGE(PG8_SB(0, 0), cB, voffB); PG8_STAGE(PG8_SA(0, 0), cA, voffA); PG8_STAGE(PG8_SB(0, 1), cB + hstepB, voffB); PG8_STAGE(PG8_SA(0, 1), cA + hstepA, voffA);
        if (wr == 1) PG8_BAR;
        PG8_WAIT_V(4); PG8_BAR;
        PG8_STAGE(PG8_SB(1, 0), cB + kstep, voffB); PG8_STAGE(PG8_SA(1, 0), cA + kstep, voffA); PG8_STAGE(PG8_SB(1, 1), cB + hstepB + kstep, voffB);
        PG8_WAIT_V(6); PG8_BAR;
    }
    for (;;) {
        const bool has_next = S.next(ui + 1, nxt);
        const char* nA = has_next ? (const char*)g.A + (size_t)nxt.pm * tstepA : cA; const char* nB = has_next ? (const char*)g.Bt + (size_t)nxt.pn * tstepB : cB;
        for (int t = 0; t < nt; t += 2) {
            const bool last = (t == nt - 2);
            const char* a1 = cA + (size_t)(t + 1) * kstep;
            const char* a2 = last ? nA : cA + (size_t)(t + 2) * kstep; const char* b2 = last ? nB : cB + (size_t)(t + 2) * kstep;
            const char* a3 = a2 + kstep; const char* b3 = b2 + kstep;
            if (last && has_next) S.a_ready(nxt);
            if constexpr (SP2) {
            PG8_LDB(B0, 0, 0); PG8_LDB(B1, 0, 1); PG8_SCHED; PG8_LDA(At, 0, 0); PG8_STAGE(PG8_SA(1, 1), a1 + hstepA, voffA);
            PG8_WAIT_V(8); PG8_WAIT_L(0); PG8_BAR; PG8_MMA(0, 0, At, B0); PG8_MMA(0, 1, At, B1); PG8_BAR; PG8_SCHED;
            PG8_LDA(At, 0, 1); PG8_STAGE(PG8_SB(0, 0), b2, voffB); PG8_STAGE(PG8_SB(0, 1), b2 + hstepB, voffB); PG8_STAGE(PG8_SA(0, 0), a2, voffA);
            PG8_WAIT_V(8); PG8_WAIT_L(0); PG8_BAR; PG8_MMA(1, 0, At, B0); PG8_MMA(1, 1, At, B1); PG8_BAR; PG8_SCHED;
            PG8_LDB(B0, 1, 0); PG8_LDB(B1, 1, 1); PG8_SCHED; PG8_LDA(At, 1, 0); PG8_STAGE(PG8_SA(0, 1), a2 + hstepA, voffA);
            PG8_WAIT_V(8); PG8_WAIT_L(0); PG8_BAR; PG8_MMA(0, 0, At, B0); PG8_MMA(0, 1, At, B1); PG8_BAR; PG8_SCHED;
            PG8_LDA(At, 1, 1); PG8_STAGE(PG8_SB(1, 0), b3, voffB); PG8_STAGE(PG8_SB(1, 1), b3 + hstepB, voffB); PG8_STAGE(PG8_SA(1, 0), a3, voffA);
            PG8_WAIT_V(8); PG8_WAIT_L(0); PG8_BAR; PG8_MMA(1, 0, At, B0); PG8_MMA(1, 1, At, B1); PG8_BAR; PG8_SCHED;
            } else {
            PG8_LDB(B0, 0, 0); PG8_SCHED; PG8_LDA(At, 0, 0); PG8_STAGE(PG8_SA(1, 1), a1 + hstepA, voffA);
            PG8_WAIT_L(8); PG8_BAR; PG8_WAIT_L(0); PG8_MMA(0, 0, At, B0); PG8_BAR; PG8_SCHED;
            PG8_LDB(B1, 0, 1); PG8_STAGE(PG8_SB(0, 0), b2, voffB);
            PG8_BAR; PG8_WAIT_L(0); PG8_MMA(0, 1, At, B1); PG8_BAR;
            PG8_LDA(At, 0, 1); PG8_STAGE(PG8_SA(0, 0), a2, voffA);
            PG8_BAR; PG8_WAIT_L(0); PG8_MMA(1, 0, At, B0); PG8_BAR; PG8_SCHED;
            PG8_STAGE(PG8_SB(0, 1), b2 + hstepB, voffB);
            PG8_WAIT_V(6); PG8_BAR; PG8_MMA(1, 1, At, B1); PG8_BAR;
            PG8_LDB(B0, 1, 0); PG8_SCHED; PG8_LDA(At, 1, 0); PG8_STAGE(PG8_SA(0, 1), a2 + hstepA, voffA);
            PG8_WAIT_L(8); PG8_BAR; PG8_WAIT_L(0); PG8_MMA(0, 0, At, B0); PG8_BAR; PG8_SCHED;
            PG8_LDB(B1, 1, 1); PG8_STAGE(PG8_SB(1, 0), b3, voffB);
            PG8_BAR; PG8_WAIT_L(0); PG8_MMA(0, 1, At, B1); PG8_BAR;
            PG8_LDA(At, 1, 1); PG8_STAGE(PG8_SA(1, 0), a3, voffA);
            PG8_BAR; PG8_WAIT_L(0); PG8_MMA(1, 0, At, B0); PG8_BAR; PG8_SCHED;
            PG8_STAGE(PG8_SB(1, 1), b3 + hstepB, voffB);
            PG8_WAIT_V(6); PG8_BAR; PG8_MMA(1, 1, At, B1); PG8_BAR;
            }
        }
        if constexpr (ALIGN_EPI) { if (wr == 0) PG8_BAR; }
        if constexpr (!Epi::AFTER_DRAIN) { E(acc, cur, wr, wc, fr, fq); S.done(cur); }
        if (!has_next) break;
#pragma unroll
        for (int a = 0; a < 2; ++a)
#pragma unroll
            for (int b = 0; b < 2; ++b)
#pragma unroll
                for (int m = 0; m < 4; ++m)
#pragma unroll
                    for (int n = 0; n < 2; ++n) acc[a][b][m][n] = (f32x4){0.f, 0.f, 0.f, 0.f};
        cur = nxt; cA = nA; cB = nB; ++ui;
        if constexpr (ALIGN_EPI) { if (wr == 1) PG8_BAR; }
    }
    PG8_WAIT_V(0);
    if constexpr (!ALIGN_EPI) { if (wr == 0) PG8_BAR; }
    PG8_BAR;
#undef PG8_SA
#undef PG8_SB
#undef PG8_STAGE
#undef PG8_LDA
#undef PG8_LDB
#undef PG8_MMA
#undef PG8_WAIT_V
#undef PG8_WAIT_L
#undef PG8_BAR
#undef PG8_SCHED
}
}

struct Frame {
    float* out;
    unsigned char* ws;
    char* lds;
    int tid, lane, wave, G, bid;
};

__device__ __forceinline__ float wave_sum(float v) {
#pragma unroll
    for (int o = 32; o >= 1; o >>= 1) v += __shfl_xor(v, o);
    return v;
}
__device__ __forceinline__ float wave_max(float v) {
#pragma unroll
    for (int o = 32; o >= 1; o >>= 1) v = fmaxf(v, __shfl_xor(v, o));
    return v;
}
__device__ __forceinline__ void wave_lds_fence() { __builtin_amdgcn_wave_barrier(); asm volatile("s_waitcnt lgkmcnt(0)" ::: "memory"); __builtin_amdgcn_wave_barrier(); }

__device__ __forceinline__ void sincos_d(double x, float& c, float& s) {
    const double TWO_OVER_PI = 0.63661977236758134308;
    const double PIO2_HI = 1.57079632679489655800e+00, PIO2_LO = 6.12323399573676603587e-17;
    const double q = __builtin_rint(x * TWO_OVER_PI);
    double y = __builtin_fma(-q, PIO2_HI, x); y = __builtin_fma(-q, PIO2_LO, y);
    const double y2 = y * y;
    double sp = 1.0 / 6227020800.0;
    sp = sp * y2 - 1.0 / 39916800.0; sp = sp * y2 + 1.0 / 362880.0; sp = sp * y2 - 1.0 / 5040.0; sp = sp * y2 + 1.0 / 120.0; sp = sp * y2 - 1.0 / 6.0; sp = sp * y2 * y + y;
    double cp = -1.0 / 87178291200.0;
    cp = cp * y2 + 1.0 / 479001600.0; cp = cp * y2 - 1.0 / 3628800.0; cp = cp * y2 + 1.0 / 40320.0; cp = cp * y2 - 1.0 / 720.0; cp = cp * y2 + 1.0 / 24.0; cp = cp * y2 - 0.5; cp = cp * y2 + 1.0;
    const long long qi = (long long)q; const int quad = (int)(qi & 3);
    double sv, cv;
    if (quad == 0) { sv = sp; cv = cp; } else if (quad == 1) { sv = cp; cv = -sp; } else if (quad == 2) { sv = -sp; cv = -cp; } else { sv = -cp; cv = sp; }
    c = (float)cv; s = (float)sv;
}

__device__ __forceinline__ int nsa_src_col(int n) { return n < 5120 ? n : (n < 7168 ? n + 48 : (n < 7216 ? n - 2048 : -1)); }
__device__ __forceinline__ void conv_transpose(const Frame& F, const float* W, int K, int Nsrc, h16* Wt, int Npad, int mapmode, int item0, int& items_done) {
    float* tile = (float*)F.lds;
    const int tk_n = K / 64, tn_n = Npad / 64, ntiles = tk_n * tn_n;
    for (int it = F.bid; it < ntiles; it += F.G) {
        const int tk = it / tn_n, tn = it % tn_n;
        __syncthreads();
#pragma unroll
        for (int i = 0; i < 8; ++i) {
            const int idx = F.tid + i * NTHREADS, k = idx >> 6, n = idx & 63;
            const int nn = tn * 64 + n; const int src = mapmode ? nsa_src_col(nn) : nn;
            float v = 0.f; if (src >= 0 && src < Nsrc) v = W[(size_t)(tk * 64 + k) * Nsrc + src];
            tile[k * 65 + n] = v;
        }
        __syncthreads();
#pragma unroll
        for (int i = 0; i < 8; ++i) {
            const int idx = F.tid + i * NTHREADS, n = idx >> 6, k = idx & 63;
            Wt[(size_t)(tn * 64 + n) * K + tk * 64 + k] = (h16)tile[k * 65 + n];
        }
    }
    __syncthreads();
}
__device__ __forceinline__ void conv_layer_weights(const Frame& F, const Args& A, int L) {
    const int kind = L % 3, j = L / 3; int dummy = 0;
    h16* wtin = (h16*)(F.ws + WS_WTIN); h16* wtout = (h16*)(F.ws + WS_WTOUT);
    if (kind == 0) {
        conv_transpose(F, A.in[7] + (size_t)j * 2048 * 8192, 2048, 8192, wtin, 8192, 0, 0, dummy);
        conv_transpose(F, A.in[8] + (size_t)j * 2048 * 2048, 2048, 2048, wtout, 2048, 0, 0, dummy);
    } else if (kind == 1) {
        conv_transpose(F, A.in[9], 2048, 7216, wtin, NSA_NP, 1, 0, dummy);
        conv_transpose(F, A.in[10], 2048, 2048, wtout, 2048, 0, 0, dummy);
        conv_transpose(F, A.in[12], 4096, 256, (h16*)(F.ws + WS_W1T), 256, 0, 0, dummy);
        conv_transpose(F, A.in[14], 4096, 256, (h16*)(F.ws + WS_W1T) + (size_t)256 * 4096, 256, 0, 0, dummy);
    } else {
        conv_transpose(F, A.in[16], 2048, 12288, wtin, 12288, 0, 0, dummy);
        conv_transpose(F, A.in[17], 4096, 2048, wtout, 2048, 0, 0, dummy);
    }
}

__device__ __forceinline__ void phase_prologue(const Frame& F, const Args& A) {
    {
        float* modp = (float*)(F.ws + WS_MODP);
        const float* c = A.in[1]; const float* aw = A.in[3];
        for (int it = F.bid; it < 384; it += F.G) {
            const int layer = it / 96, r = it % 96, slice = r / 12, nch = r % 12, n = nch * 512 + F.tid;
            const float* w = aw + (size_t)layer * 2048 * 6144 + (size_t)(slice * 256) * 6144 + n;
            float acc = 0.f;
#pragma unroll 8
            for (int k = 0; k < 256; ++k) acc += silu_f(c[slice * 256 + k]) * w[(size_t)k * 6144];
            modp[(size_t)(slice * 4 + layer) * 6144 + n] = acc;
        }
    }
    {
        const int* pos = (const int*)A.in[2];
        f32x2* r16 = (f32x2*)(F.ws + WS_ROPE16); f32x2* r128 = (f32x2*)(F.ws + WS_ROPE128);
        for (int idx = F.bid * NTHREADS + F.tid; idx < S * 16; idx += F.G * NTHREADS) {
            const int t = idx >> 4, j = idx & 15; float cs, sn; sincos_d((double)pos[t] * A.inv16[j], cs, sn); r16[idx] = (f32x2){cs, sn};
        }
        for (int idx = F.bid * NTHREADS + F.tid; idx < S * 128; idx += F.G * NTHREADS) {
            const int t = idx >> 7, j = idx & 127; float cs, sn; sincos_d((double)pos[t] * A.inv128[j], cs, sn); r128[idx] = (f32x2){cs, sn};
        }
    }
    if (F.bid == F.G - 1) {
        const int kv = F.tid >> 8, j = F.tid & 255; const float* w1 = kv ? A.in[14] : A.in[12]; const float* pe = A.in[11];
        float acc = 0.f;
#pragma unroll 8
        for (int i = 0; i < 4096; ++i) acc += pe[i] * w1[(size_t)i * 256 + j];
        ((float*)(F.ws + WS_CMPB))[F.tid] = acc;
    }
    conv_layer_weights(F, A, 0);
}

__device__ __forceinline__ void phase_norm(const Frame& F, const Args& A, int Lprev, int Lnext) {
    float* modl = (float*)F.lds;
    const float* modp = (const float*)(F.ws + WS_MODP); const float* ab = A.in[4];
    __syncthreads();
    for (int i = F.tid; i < 6144; i += NTHREADS) {
        const int which = i >> 11, col = i & 2047;
        int layer, mcol;
        if (which == 0) { layer = Lprev; mcol = 4096 + col; } else if (which == 1) { layer = Lnext; mcol = 2048 + col; } else { layer = Lnext; mcol = col; }
        float v = 0.f;
        if (layer >= 0) { v = ab[layer * 6144 + mcol];
#pragma unroll
            for (int s = 0; s < 8; ++s) v += modp[(size_t)(s * 4 + layer) * 6144 + mcol]; }
        modl[i] = v;
    }
    __syncthreads();
    const float* xin = (Lprev <= 0) ? A.in[0] : F.out;
    const float* Y = (const float*)(F.ws + WS_Y);
    h16* H = (h16*)(F.ws + WS_H);
    const float* npost = A.in[6] + (Lprev >= 0 ? Lprev : 0) * 2048;
    const float* npre = A.in[5] + (Lnext >= 0 ? Lnext : 0) * 2048;
    for (int t = F.bid * 8 + F.wave; t < S; t += F.G * 8) {
        f32x4 x[8];
#pragma unroll
        for (int i = 0; i < 8; ++i) x[i] = *(const f32x4*)(xin + (size_t)t * D + i * 256 + F.lane * 4);
        if (Lprev >= 0) {
            f32x4 y[8]; float ss = 0.f;
#pragma unroll
            for (int i = 0; i < 8; ++i) { y[i] = *(const f32x4*)(Y + (size_t)t * D + i * 256 + F.lane * 4); ss += y[i][0] * y[i][0] + y[i][1] * y[i][1] + y[i][2] * y[i][2] + y[i][3] * y[i][3]; }
            ss = wave_sum(ss);
            const float r = 1.0f / sqrtf(ss * (1.0f / D) + EPS);
#pragma unroll
            for (int i = 0; i < 8; ++i) {
                const int col = i * 256 + F.lane * 4;
                const f32x4 g = *(const f32x4*)(npost + col); const f32x4 gt = *(const f32x4*)(modl + col);
#pragma unroll
                for (int e = 0; e < 4; ++e) x[i][e] += gt[e] * (y[i][e] * r * g[e]);
                *(f32x4*)(F.out + (size_t)t * D + col) = x[i];
            }
        }
        if (Lnext >= 0) {
            float ss = 0.f;
#pragma unroll
            for (int i = 0; i < 8; ++i) ss += x[i][0] * x[i][0] + x[i][1] * x[i][1] + x[i][2] * x[i][2] + x[i][3] * x[i][3];
            ss = wave_sum(ss);
            const float r = 1.0f / sqrtf(ss * (1.0f / D) + EPS);
#pragma unroll
            for (int i = 0; i < 8; ++i) {
                const int col = i * 256 + F.lane * 4;
                const f32x4 g = *(const f32x4*)(npre + col); const f32x4 sc = *(const f32x4*)(modl + 2048 + col); const f32x4 sh = *(const f32x4*)(modl + 4096 + col);
                h16x4 hv;
#pragma unroll
                for (int e = 0; e < 4; ++e) hv[e] = (h16)((x[i][e] * r * g[e]) * (1.0f + sc[e]) + sh[e]);
                *(h16x4*)(H + (size_t)t * D + col) = hv;
            }
        }
    }
    if (Lnext > 0) conv_layer_weights(F, A, Lnext);
}

__device__ __forceinline__ void phase_nsa_cmp_a(const Frame& F) {
    const int u = F.bid, have = u < 64, kv = (u >> 5) & 1, mt = (u >> 2) & 7, kp = u & 3;
    const h16* A = (const h16*)(F.ws + WS_QKV) + (size_t)16 * S * 128 + (size_t)kv * 4 * S * 128 + kp * 1024;
    const h16* Bt = (const h16*)(F.ws + WS_W1T) + (size_t)kv * 256 * 4096 + kp * 1024;
    pg8::Gemm g{A, Bt, 2048, 256, 1024, 2048, 4096}; pg8::OneUnit So{mt, 0, have};
    pg8::EpiStore E{(float*)(F.ws + WS_OR) + (size_t)(kv * 4 + kp) * 2048 * 256, 256, 1};
    pg8::gemm_phase<pg8::EpiStore, pg8::OneUnit, true, true>((LAS unsigned char*)F.lds, g, So, E);
}
__device__ __forceinline__ void phase_nsa_cmp_b(const Frame& F, const Args& A) {
    float* hid = (float*)F.lds;
    const float* part = (const float*)(F.ws + WS_OR); const float* b1 = (const float*)(F.ws + WS_CMPB);
    for (int it = F.bid; it < 256; it += F.G) {
        const int kv = it >> 7, r0 = (it & 127) * 16;
        const float* W2 = kv ? A.in[15] : A.in[13];
        h16* dst = (h16*)(F.ws + (kv ? WS_VCMP : WS_KCMP));
        __syncthreads();
        for (int i = F.tid; i < 16 * 256; i += NTHREADS) {
            const int r = r0 + (i >> 8), j = i & 255; float v = b1[kv * 256 + j];
#pragma unroll
            for (int kp = 0; kp < 4; ++kp) v += part[((size_t)(kv * 4 + kp) * 2048 + r) * 256 + j];
            hid[i] = silu_f(v);
        }
        __syncthreads();
        const int d = F.tid & 127, rq = F.tid >> 7;
        float a[4] = {0.f, 0.f, 0.f, 0.f};
#pragma unroll 4
        for (int j = 0; j < 256; ++j) { const float w = W2[j * 128 + d];
#pragma unroll
            for (int e = 0; e < 4; ++e) a[e] += hid[(rq * 4 + e) * 256 + j] * w; }
#pragma unroll
        for (int e = 0; e < 4; ++e) { const int r = r0 + rq * 4 + e; dst[(size_t)r * 128 + d] = ((r & 511) < NC) ? (h16)a[e] : (h16)0.f; }
    }
}

namespace fa {
typedef float f32x16 __attribute__((ext_vector_type(16)));
typedef unsigned u32x2 __attribute__((ext_vector_type(2)));
constexpr float LOG2E = 1.4426950408889634f;
constexpr int KROW = 272, VROW = 320;
constexpr int KT_BYTES = 64 * KROW, BUF_BYTES = KT_BYTES + 64 * VROW;
typedef short s16x4v __attribute__((__vector_size__(4 * sizeof(short))));
constexpr int LDS_IMP = 2 * BUF_BYTES;
constexpr int LDS_SELW = LDS_IMP + 32768;
constexpr int LDS_SV = LDS_SELW + 1024;
static_assert(LDS_SV + 4096 <= MISC_OFF, "attention LDS map");

struct Stage { u32x4 k[2], v[2]; };
__device__ __forceinline__ void stage_load(Stage& st, const h16* Kg, const h16* VTg, int j, int tid) {
    asm volatile("" : "+v"(tid));
#pragma unroll
    for (int i = 0; i < 2; ++i) { const int idx = tid + 512 * i;
        st.k[i] = *(const u32x4*)(Kg + (size_t)(j * 64 + (idx >> 4)) * 128 + (idx & 15) * 8);
        st.v[i] = *(const u32x4*)(VTg + (size_t)(j * 64 + (idx >> 4)) * 128 + (idx & 15) * 8); }
}
__device__ __forceinline__ void stage_write(const Stage& st, LAS unsigned char* buf, int tid) {
    asm volatile("" : "+v"(tid));
#pragma unroll
    for (int i = 0; i < 2; ++i) { const int idx = tid + 512 * i;
        *(LAS u32x4*)(buf + (idx >> 4) * KROW + (idx & 15) * 16) = st.k[i];
        *(LAS u32x4*)(buf + KT_BYTES + (idx >> 4) * VROW + (idx & 15) * 16) = st.v[i]; }
}

template <int MODE>
__device__ __forceinline__ void tile_compute(const LAS unsigned char* buf, int j, const h16x8 (&qf)[8], f32x16 (&o)[4], float& m, float& l,
                                             bool on, int lo, int hi, int lane, float inv_l, LAS float* imp_q) {
    const int r31 = lane & 31, h = lane >> 5, k0 = j * 64;
    const bool need = on && (k0 <= hi) && (k0 + 63 >= lo);
    if (__ballot(need) == 0ull) return;
    f32x16 s0, s1;
#pragma unroll
    for (int r = 0; r < 16; ++r) { s0[r] = 0.f; s1[r] = 0.f; }
    const LAS unsigned char* kp = buf + r31 * KROW + h * 16;
#pragma unroll
    for (int s = 0; s < 8; ++s) {
        const h16x8 a0 = *(const LAS h16x8*)(kp + s * 32);
        const h16x8 a1 = *(const LAS h16x8*)(kp + 32 * KROW + s * 32);
        s0 = __builtin_amdgcn_mfma_f32_32x32x16_f16(a0, qf[s], s0, 0, 0, 0);
        s1 = __builtin_amdgcn_mfma_f32_32x32x16_f16(a1, qf[s], s1, 0, 0, 0);
        if ((s & 1) == 1) __builtin_amdgcn_sched_barrier(0);
    }
    float tmax = NEGF;
#pragma unroll
    for (int r = 0; r < 16; ++r) {
        const int key0 = k0 + (r & 3) + 8 * (r >> 2) + 4 * h, key1 = key0 + 32;
        const bool v0 = on && key0 >= lo && key0 <= hi, v1 = on && key1 >= lo && key1 <= hi;
        s0[r] = v0 ? s0[r] * LOG2E : NEGF; s1[r] = v1 ? s1[r] * LOG2E : NEGF;
        tmax = fmaxf(tmax, fmaxf(s0[r], s1[r]));
    }
    if (MODE != 2) {
        tmax = fmaxf(tmax, __shfl_xor(tmax, 32));
        const float m_new = fmaxf(m, tmax);
        const float alpha = __builtin_amdgcn_exp2f(m - m_new);
        float sum = 0.f;
#pragma unroll
        for (int r = 0; r < 16; ++r) {
            s0[r] = (s0[r] > 0.5f * NEGF) ? __builtin_amdgcn_exp2f(s0[r] - m_new) : 0.f;
            s1[r] = (s1[r] > 0.5f * NEGF) ? __builtin_amdgcn_exp2f(s1[r] - m_new) : 0.f;
            sum += s0[r] + s1[r];
        }
        l = l * alpha + sum; m = m_new;
        if (MODE == 1) return;
#pragma unroll
        for (int dt = 0; dt < 4; ++dt) o[dt] = o[dt] * alpha;
    } else {
#pragma unroll
        for (int r = 0; r < 16; ++r) {
            s0[r] = (s0[r] > 0.5f * NEGF) ? __builtin_amdgcn_exp2f(s0[r] - m) * inv_l : 0.f;
            s1[r] = (s1[r] > 0.5f * NEGF) ? __builtin_amdgcn_exp2f(s1[r] - m) * inv_l : 0.f;
        }
#pragma unroll
        for (int c = 0; c < 4; ++c) {
            const int sa = 16 * j + 2 * c + h, sb = sa + 8;
            const float a0 = s0[4 * c] + s0[4 * c + 1] + s0[4 * c + 2] + 0.5f * s0[4 * c + 3], b0 = 0.5f * s0[4 * c + 3];
            const float a1 = s1[4 * c] + s1[4 * c + 1] + s1[4 * c + 2] + 0.5f * s1[4 * c + 3], b1 = 0.5f * s1[4 * c + 3];
            (void)__hip_atomic_fetch_add(imp_q + sa, a0, __ATOMIC_RELAXED, __HIP_MEMORY_SCOPE_WORKGROUP); if (sa + 1 < 128) (void)__hip_atomic_fetch_add(imp_q + sa + 1, b0, __ATOMIC_RELAXED, __HIP_MEMORY_SCOPE_WORKGROUP);
            (void)__hip_atomic_fetch_add(imp_q + sb, a1, __ATOMIC_RELAXED, __HIP_MEMORY_SCOPE_WORKGROUP); if (sb + 1 < 128) (void)__hip_atomic_fetch_add(imp_q + sb + 1, b1, __ATOMIC_RELAXED, __HIP_MEMORY_SCOPE_WORKGROUP);
        }
    }
    h16x8 pb[2][2];
#pragma unroll
    for (int sp = 0; sp < 2; ++sp)
#pragma unroll
        for (int jj = 0; jj < 8; ++jj) { pb[0][sp][jj] = (h16)s0[8 * sp + jj]; pb[1][sp][jj] = (h16)s1[8 * sp + jj]; }
    const LAS unsigned char* vbase = buf + KT_BYTES + (4 * h + ((lane & 15) >> 2)) * VROW + (16 * ((lane >> 4) & 1) + 4 * (lane & 3)) * 2;
#pragma unroll
    for (int dt = 0; dt < 4; ++dt) {
#pragma unroll
        for (int sub = 0; sub < 2; ++sub)
#pragma unroll
            for (int sp = 0; sp < 2; ++sp) {
                const LAS unsigned char* vp = vbase + (32 * sub + 16 * sp) * VROW + 64 * dt;
                const s16x4v lo4 = __builtin_amdgcn_ds_read_tr16_b64_v4i16((LAS s16x4v*)vp), hi4 = __builtin_amdgcn_ds_read_tr16_b64_v4i16((LAS s16x4v*)(vp + 8 * VROW));
                const h16x4 l4 = __builtin_bit_cast(h16x4, lo4), h4 = __builtin_bit_cast(h16x4, hi4);
                h16x8 va; va[0] = l4[0]; va[1] = l4[1]; va[2] = l4[2]; va[3] = l4[3]; va[4] = h4[0]; va[5] = h4[1]; va[6] = h4[2]; va[7] = h4[3];
                o[dt] = __builtin_amdgcn_mfma_f32_32x32x16_f16(va, pb[sub][sp], o[dt], 0, 0, 0);
            }
        __builtin_amdgcn_sched_barrier(0);
    }
}

template <int MODE, class OnFn>
__device__ __forceinline__ void stream(LAS unsigned char* lds, const h16* Kg, const h16* VTg, int jlo, int jhi, const h16x8 (&qf)[8],
                                       f32x16 (&o)[4], float& m, float& l, int lo, int hi, const OnFn& on_fn, int tid, int lane, float inv_l, LAS float* imp_q) {
    if (jlo >= jhi) return;
    Stage st;
    stage_load(st, Kg, VTg, jlo, tid);
    stage_write(st, lds, tid);
    __syncthreads();
    for (int j = jlo; j < jhi; ++j) {
        const int cur = (j - jlo) & 1;
        if (j + 1 < jhi) stage_load(st, Kg, VTg, j + 1, tid);
        tile_compute<MODE>(lds + cur * BUF_BYTES, j, qf, o, m, l, on_fn(j), lo, hi, lane, inv_l, imp_q);
        if (j + 1 < jhi) stage_write(st, lds + (cur ^ 1) * BUF_BYTES, tid);
        __syncthreads();
    }
}

__device__ __forceinline__ void load_q(h16x8 (&qf)[8], const h16* qrow, int h) {
#pragma unroll
    for (int s = 0; s < 8; ++s) qf[s] = *(const h16x8*)(qrow + 16 * s + 8 * h);
}
__device__ __forceinline__ void zero_o(f32x16 (&o)[4]) {
#pragma unroll
    for (int dt = 0; dt < 4; ++dt)
#pragma unroll
        for (int r = 0; r < 16; ++r) o[dt][r] = 0.f;
}
}

struct MobaOn { unsigned selmask; int b; __device__ __forceinline__ bool operator()(int j) const { const int jb = j >> 2; return jb == b ? true : (((selmask >> jb) & 1u) != 0u); } };
__device__ __forceinline__ void phase_moba_attn_mfma(const Frame& F) {
    const h16* Q = (const h16*)(F.ws + WS_QKV); const h16* K = Q + (size_t)16 * S * 128; const h16* VT = K + (size_t)16 * S * 128; const h16* Z = VT + (size_t)16 * S * 128;
    const float* kmean = (const float*)(F.ws + WS_KMEAN);
    h16* OZ = (h16*)(F.ws + WS_OZ);
    LAS unsigned char* lds = (LAS unsigned char*)F.lds;
    const int lane = F.lane, r31 = lane & 31, h = lane >> 5;
    for (int it = F.bid; it < 256; it += F.G) {
        const int head = it >> 4, pi = it & 15;
#pragma unroll 1
        for (int half = 0; half < 2; ++half) {
            const int b = half ? 31 - pi : pi;
            const int t = b * 256 + F.wave * 32 + r31;
            h16x8 qf[8]; fa::load_q(qf, Q + ((size_t)head * S + t) * 128, h);
            float v0 = NEGF, v1 = NEGF, v2 = NEGF; int i0 = -1, i1 = -1, i2 = -1;
            for (int jb = 0; jb < b; ++jb) {
                const float* km = kmean + ((size_t)head * 32 + jb) * 128 + 8 * h;
                float d = 0.f;
#pragma unroll
                for (int s = 0; s < 8; ++s) { const f32x4 ka = *(const f32x4*)(km + 16 * s) + *(const f32x4*)(km + 65536 + 16 * s), kb = *(const f32x4*)(km + 16 * s + 4) + *(const f32x4*)(km + 65536 + 16 * s + 4);
                    d += (float)qf[s][0] * ka[0] + (float)qf[s][1] * ka[1] + (float)qf[s][2] * ka[2] + (float)qf[s][3] * ka[3] + (float)qf[s][4] * kb[0] + (float)qf[s][5] * kb[1] + (float)qf[s][6] * kb[2] + (float)qf[s][7] * kb[3]; }
                d += __shfl_xor(d, 32);
                if (d > v0) { v2 = v1; i2 = i1; v1 = v0; i1 = i0; v0 = d; i0 = jb; }
                else if (d > v1) { v2 = v1; i2 = i1; v1 = d; i1 = jb; }
                else if (d > v2) { v2 = d; i2 = jb; }
            }
            MobaOn on; on.b = b; on.selmask = (i0 >= 0 ? 1u << i0 : 0u) | (i1 >= 0 ? 1u << i1 : 0u) | (i2 >= 0 ? 1u << i2 : 0u);
            fa::f32x16 o[4]; fa::zero_o(o); float m = NEGF, l = 0.f;
            fa::stream<0>(lds, K + (size_t)head * S * 128, VT + (size_t)head * S * 128, 0, 4 * b + 4, qf, o, m, l, 0, t, on, F.tid, lane, 0.f, (LAS float*)nullptr);
            l += __shfl_xor(l, 32);
            const float inv = 1.0f / fmaxf(l, 1e-30f);
#pragma unroll
            for (int dt = 0; dt < 4; ++dt)
#pragma unroll
                for (int c = 0; c < 4; ++c) {
                    const int d = 32 * dt + 8 * c + 4 * h; const size_t off = (size_t)t * 2048 + head * 128 + d;
                    const h16x4 zz = *(const h16x4*)(Z + off); h16x4 ov;
#pragma unroll
                    for (int e = 0; e < 4; ++e) ov[e] = (h16)(o[dt][4 * c + e] * inv * (float)zz[e]);
                    *(h16x4*)(OZ + off) = ov;
                }
        }
    }
}

struct AllOn { __device__ __forceinline__ bool operator()(int) const { return true; } };
struct SelOn { const LAS unsigned* w; __device__ __forceinline__ bool operator()(int j) const { return ((w[j >> 5] >> (j & 31)) & 1u) != 0u; } };
__device__ __forceinline__ void phase_nsa_attn_mfma(const Frame& F) {
    const h16* Q = (const h16*)(F.ws + WS_QKV); const h16* KVb = Q + (size_t)16 * S * 128;
    const h16* Z = (const h16*)(F.ws + WS_QKV + 96 * MiB);
    const float* gates = (const float*)(F.ws + WS_GATES);
    const h16* KCMP = (const h16*)(F.ws + WS_KCMP); const h16* VCMPT = (const h16*)(F.ws + WS_VCMP);
    h16* OZ = (h16*)(F.ws + WS_OZ);
    LAS unsigned char* lds = (LAS unsigned char*)F.lds;
    LAS float* imp = (LAS float*)(lds + fa::LDS_IMP); LAS unsigned* selw = (LAS unsigned*)(lds + fa::LDS_SELW); LAS float* sv = (LAS float*)(lds + fa::LDS_SV) + F.wave * 128;
    const int lane = F.lane, r31 = lane & 31, h = lane >> 5, hh = F.wave & 3, qsub = F.wave >> 2;
    for (int it = F.bid; it < 256; it += F.G) {
        const int g = it >> 6, pi = it & 63, head = 4 * g + hh;
#pragma unroll 1
        for (int half = 0; half < 2; ++half) {
            const int c64 = half ? 127 - pi : pi;
            const int ql = 32 * qsub + r31, t = c64 * 64 + ql;
            h16x8 qf[8]; fa::load_q(qf, Q + ((size_t)head * S + t) * 128, h);
            fa::f32x16 o[4]; float m, l;
            for (int i = F.tid; i < 64 * 128; i += NTHREADS) imp[i] = 0.f;
            const int nval = (t >= 31) ? (((t - 31) >> 4) + 1 < NC ? ((t - 31) >> 4) + 1 : NC) : 0;
            const int tl = c64 * 64 + 63; const int nval_max = (tl >= 31) ? (((tl - 31) >> 4) + 1 < NC ? ((tl - 31) >> 4) + 1 : NC) : 0;
            const int jc = (nval_max + 63) >> 6;
            fa::zero_o(o); m = NEGF; l = 0.f;
            fa::stream<1>(lds, KCMP + (size_t)g * 512 * 128, VCMPT + (size_t)g * 512 * 128, 0, jc, qf, o, m, l, 0, nval - 1, AllOn(), F.tid, lane, 0.f, (LAS float*)nullptr);
            l += __shfl_xor(l, 32);
            { const float invl = 1.0f / fmaxf(l, 1e-30f); float l2 = 0.f;
              fa::stream<2>(lds, KCMP + (size_t)g * 512 * 128, VCMPT + (size_t)g * 512 * 128, 0, jc, qf, o, m, l2, 0, nval - 1, AllOn(), F.tid, lane, invl, imp + ql * 128); }
            const float g0 = gates[(size_t)t * 48 + head * 3 + 0];
#pragma unroll
            for (int dt = 0; dt < 4; ++dt)
#pragma unroll
                for (int c = 0; c < 4; ++c) { h16x4 ov;
#pragma unroll
                    for (int e = 0; e < 4; ++e) ov[e] = (h16)(o[dt][4 * c + e] * g0);
                    *(h16x4*)(OZ + (size_t)t * 2048 + head * 128 + 32 * dt + 8 * c + 4 * h) = ov; }
            __syncthreads();
            for (int qq = 0; qq < 8; ++qq) {
                const int q = F.wave * 8 + qq;
                float myv[2];
#pragma unroll
                for (int c = 0; c < 2; ++c) { const int s = lane + 64 * c; const bool valid = s <= c64, forced = (s == 0) || (s == c64) || (s == c64 - 1);
                    myv[c] = valid ? (forced ? BIGF : imp[q * 128 + s]) : NEGF; sv[s] = myv[c]; }
                wave_lds_fence();
                int rank0 = 0, rank1 = 0;
                for (int s2 = 0; s2 < 128; ++s2) { const float v2 = sv[s2];
                    rank0 += (v2 > myv[0] || (v2 == myv[0] && s2 < lane)) ? 1 : 0; rank1 += (v2 > myv[1] || (v2 == myv[1] && s2 < lane + 64)) ? 1 : 0; }
                const unsigned long long m0 = __ballot(rank0 < 16 && lane <= c64), m1 = __ballot(rank1 < 16 && (lane + 64) <= c64);
                if (lane == 0) { selw[q * 4 + 0] = (unsigned)m0; selw[q * 4 + 1] = (unsigned)(m0 >> 32); selw[q * 4 + 2] = (unsigned)m1; selw[q * 4 + 3] = (unsigned)(m1 >> 32); }
                wave_lds_fence();
            }
            __syncthreads();
            SelOn son; son.w = selw + ql * 4;
            fa::zero_o(o); m = NEGF; l = 0.f;
            fa::stream<0>(lds, KVb + ((size_t)2 * 4 + g) * S * 128, KVb + ((size_t)3 * 4 + g) * S * 128, 0, c64 + 1, qf, o, m, l, 0, t, son, F.tid, lane, 0.f, (LAS float*)nullptr);
            l += __shfl_xor(l, 32);
            { const float sc = gates[(size_t)t * 48 + head * 3 + 1] / fmaxf(l, 1e-30f);
#pragma unroll
              for (int dt = 0; dt < 4; ++dt)
#pragma unroll
                  for (int c = 0; c < 4; ++c) { h16* p = OZ + (size_t)t * 2048 + head * 128 + 32 * dt + 8 * c + 4 * h; const h16x4 pv = *(const h16x4*)p; h16x4 ov;
#pragma unroll
                      for (int e = 0; e < 4; ++e) ov[e] = (h16)((float)pv[e] + o[dt][4 * c + e] * sc);
                      *(h16x4*)p = ov; } }
            fa::zero_o(o); m = NEGF; l = 0.f;
            fa::stream<0>(lds, KVb + ((size_t)4 * 4 + g) * S * 128, KVb + ((size_t)5 * 4 + g) * S * 128, (c64 >= 8 ? c64 - 8 : 0), c64 + 1, qf, o, m, l, t - 511, t, AllOn(), F.tid, lane, 0.f, (LAS float*)nullptr);
            l += __shfl_xor(l, 32);
            const float sc2 = gates[(size_t)t * 48 + head * 3 + 2] / fmaxf(l, 1e-30f);
#pragma unroll
            for (int dt = 0; dt < 4; ++dt)
#pragma unroll
                for (int c = 0; c < 4; ++c) {
                    const int d = 32 * dt + 8 * c + 4 * h; const size_t off = (size_t)t * 2048 + head * 128 + d;
                    const h16x4 zz = *(const h16x4*)(Z + off); const h16x4 pv = *(const h16x4*)(OZ + off); h16x4 ov;
#pragma unroll
                    for (int e = 0; e < 4; ++e) ov[e] = (h16)(((float)pv[e] + o[dt][4 * c + e] * sc2) * (float)zz[e]);
                    *(h16x4*)(OZ + off) = ov;
                }
        }
    }
}

namespace rt {
typedef float f32x16 __attribute__((ext_vector_type(16)));
typedef short s16x4v __attribute__((__vector_size__(4 * sizeof(short))));
constexpr int SP = 144, STILE = 128 * SP;
constexpr int VP = 1088, VTILE = 32 * VP;
__device__ __forceinline__ h16x8 tr16(const LAS unsigned char* p0, const LAS unsigned char* p1) {
    const s16x4v a = __builtin_amdgcn_ds_read_tr16_b64_v4i16((LAS s16x4v*)p0), b = __builtin_amdgcn_ds_read_tr16_b64_v4i16((LAS s16x4v*)p1);
    const h16x4 x = __builtin_bit_cast(h16x4, a), y = __builtin_bit_cast(h16x4, b);
    h16x8 r; r[0] = x[0]; r[1] = x[1]; r[2] = x[2]; r[3] = x[3]; r[4] = y[0]; r[5] = y[1]; r[6] = y[2]; r[7] = y[3]; return r;
}
}
__device__ __forceinline__ void phase_ret_scan_mfma(const Frame& F, const Args& A) {
    const h16* RQ = (const h16*)(F.ws + WS_QKV); const h16* RK = RQ + (size_t)8 * S * 256; const h16* RV = RK + (size_t)8 * S * 256;
    h16* ST = (h16*)(F.ws + WS_P);
    LAS unsigned char* lds = (LAS unsigned char*)F.lds;
    const int lane = F.lane, g = lane >> 4, q = (lane & 15) >> 2, p = lane & 3, mr = F.wave >> 1, nc0 = (F.wave & 1) * 2;
    for (int it = F.bid; it < 256; it += F.G) {
        const int h = it >> 5, dk0 = ((it >> 3) & 3) * 64, dv0 = (it & 7) * 64;
        const float lg = A.lg2g[h], carry = __builtin_amdgcn_exp2f(128.f * lg);
        f32x4 acc[2] = {(f32x4){0.f, 0.f, 0.f, 0.f}, (f32x4){0.f, 0.f, 0.f, 0.f}};
        u32x4 kreg[2], vreg[2];
#define RT_LOAD(c) do { int tid_ = F.tid; asm volatile("" : "+v"(tid_)); _Pragma("unroll") for (int i = 0; i < 2; ++i) { const int idx = tid_ + 512 * i, row = idx >> 3, c16 = idx & 7; \
            kreg[i] = *(const u32x4*)(RK + ((size_t)h * S + (c) * 128 + row) * 256 + dk0 + c16 * 8); vreg[i] = *(const u32x4*)(RV + ((size_t)h * S + (c) * 128 + row) * 512 + dv0 + c16 * 8); } } while (0)
#define RT_WRITE(b) do { int tid_ = F.tid; asm volatile("" : "+v"(tid_)); _Pragma("unroll") for (int i = 0; i < 2; ++i) { const int idx = tid_ + 512 * i, row = idx >> 3, c16 = idx & 7; \
            const float w = __builtin_amdgcn_exp2f((float)(127 - row) * lg); h16x8 kk = __builtin_bit_cast(h16x8, kreg[i]); \
            _Pragma("unroll") for (int e = 0; e < 8; ++e) kk[e] = (h16)((float)kk[e] * w); \
            *(LAS h16x8*)(lds + (b) * 2 * rt::STILE + row * rt::SP + c16 * 16) = kk; *(LAS u32x4*)(lds + (b) * 2 * rt::STILE + rt::STILE + row * rt::SP + c16 * 16) = vreg[i]; } } while (0)
        __syncthreads();
        RT_LOAD(0); RT_WRITE(0);
        __syncthreads();
        for (int c = 0; c < 64; ++c) {
            const int cur = c & 1;
#pragma unroll
            for (int n = 0; n < 2; ++n) { h16x4 o; o[0] = (h16)acc[n][0]; o[1] = (h16)acc[n][1]; o[2] = (h16)acc[n][2]; o[3] = (h16)acc[n][3];
                *(h16x4*)(ST + (((size_t)(h * 64 + c)) * 512 + dv0 + 16 * (nc0 + n) + (lane & 15)) * 256 + dk0 + 16 * mr + 4 * g) = o; }
            if (c + 1 < 64) RT_LOAD(c + 1);
            acc[0] = acc[0] * carry; acc[1] = acc[1] * carry;
            const LAS unsigned char* kt = lds + cur * 2 * rt::STILE + (8 * g + q) * rt::SP + (16 * mr + 4 * p) * 2;
            const LAS unsigned char* vt = lds + cur * 2 * rt::STILE + rt::STILE + (8 * g + q) * rt::SP + (16 * nc0 + 4 * p) * 2;
#pragma unroll
            for (int ks = 0; ks < 4; ++ks) {
                const h16x8 a = rt::tr16(kt + 32 * ks * rt::SP, kt + (32 * ks + 4) * rt::SP);
                const h16x8 b0 = rt::tr16(vt + 32 * ks * rt::SP, vt + (32 * ks + 4) * rt::SP);
                const h16x8 b1 = rt::tr16(vt + 32 * ks * rt::SP + 32, vt + (32 * ks + 4) * rt::SP + 32);
                acc[0] = __builtin_amdgcn_mfma_f32_16x16x32_f16(a, b0, acc[0], 0, 0, 0);
                acc[1] = __builtin_amdgcn_mfma_f32_16x16x32_f16(a, b1, acc[1], 0, 0, 0);
            }
            if (c + 1 < 64) RT_WRITE(cur ^ 1);
            __syncthreads();
        }
#undef RT_LOAD
#undef RT_WRITE
    }
}

__device__ __forceinline__ void phase_ret_out_mfma(const Frame& F, const Args& A) {
    const h16* RQ = (const h16*)(F.ws + WS_QKV); const h16* RK = RQ + (size_t)8 * S * 256; const h16* RV = RK + (size_t)8 * S * 256; const h16* RG = RV + (size_t)8 * S * 512;
    const h16* ST = (const h16*)(F.ws + WS_P);
    h16* OZ = (h16*)(F.ws + WS_OZ);
    LAS unsigned char* lds = (LAS unsigned char*)F.lds;
    LAS float* stats = (LAS float*)(lds + 2 * rt::VTILE);
    const int lane = F.lane, r31 = lane & 31, hh = lane >> 5, itl = F.wave & 3, dvh = F.wave >> 2;
    for (int it = F.bid; it < 512; it += F.G) {
        const int h = it >> 6, c = it & 63, il = 32 * itl + r31, tok = c * 128 + il;
        const float lg = A.lg2g[h];
        rt::f32x16 acc[8];
#pragma unroll
        for (int r = 0; r < 8; ++r)
#pragma unroll
            for (int e = 0; e < 16; ++e) acc[r][e] = 0.f;
        const h16* qrow = RQ + ((size_t)h * S + tok) * 256 + 8 * hh;
        u32x4 vreg[4];
#define RO_LOAD(jt) do { int tid_ = F.tid; asm volatile("" : "+v"(tid_)); _Pragma("unroll") for (int i = 0; i < 4; ++i) { const int idx = tid_ + 512 * i; \
            vreg[i] = *(const u32x4*)(RV + ((size_t)h * S + c * 128 + 32 * (jt) + (idx >> 6)) * 512 + (idx & 63) * 8); } } while (0)
#define RO_WRITE(b) do { int tid_ = F.tid; asm volatile("" : "+v"(tid_)); _Pragma("unroll") for (int i = 0; i < 4; ++i) { const int idx = tid_ + 512 * i; \
            *(LAS u32x4*)(lds + (b) * rt::VTILE + (idx >> 6) * rt::VP + (idx & 63) * 16) = vreg[i]; } } while (0)
        __syncthreads();
        RO_LOAD(0);
        {
            const h16* srow = ST + (((size_t)(h * 64 + c)) * 512 + dvh * 256 + r31) * 256 + 8 * hh;
#pragma unroll 2
            for (int ks = 0; ks < 16; ++ks) {
                const h16x8 qf = *(const h16x8*)(qrow + 16 * ks);
#pragma unroll
                for (int r = 0; r < 8; ++r) { const h16x8 a = *(const h16x8*)(srow + (size_t)r * 32 * 256 + 16 * ks); acc[r] = __builtin_amdgcn_mfma_f32_32x32x16_f16(a, qf, acc[r], 0, 0, 0); }
            }
            const float rdec = __builtin_amdgcn_exp2f((float)(il + 1) * lg);
#pragma unroll
            for (int r = 0; r < 8; ++r) acc[r] = acc[r] * rdec;
        }
        RO_WRITE(0);
        __syncthreads();
        for (int jt = 0; jt < 4; ++jt) {
            const int cur = jt & 1;
            if (jt + 1 < 4) RO_LOAD(jt + 1);
            if (jt <= itl) {
                rt::f32x16 sT;
#pragma unroll
                for (int e = 0; e < 16; ++e) sT[e] = 0.f;
                const h16* krow = RK + ((size_t)h * S + c * 128 + 32 * jt + r31) * 256 + 8 * hh;
#pragma unroll 4
                for (int ks = 0; ks < 16; ++ks) sT = __builtin_amdgcn_mfma_f32_32x32x16_f16(*(const h16x8*)(krow + 16 * ks), *(const h16x8*)(qrow + 16 * ks), sT, 0, 0, 0);
                h16x8 pb[2];
#pragma unroll
                for (int e = 0; e < 16; ++e) { const int kl = 32 * jt + (e & 3) + 8 * (e >> 2) + 4 * hh, df = il - kl;
                    const float pv = (df >= 0) ? sT[e] * __builtin_amdgcn_exp2f((float)df * lg) : 0.f; pb[e >> 3][e & 7] = (h16)pv; }
                const LAS unsigned char* vbase = lds + cur * rt::VTILE + (4 * hh + ((lane & 15) >> 2)) * rt::VP + (dvh * 256 + 16 * ((lane >> 4) & 1) + 4 * (lane & 3)) * 2;
#pragma unroll
                for (int r = 0; r < 8; ++r) {
#pragma unroll
                    for (int sp = 0; sp < 2; ++sp) { const LAS unsigned char* vp = vbase + 16 * sp * rt::VP + 64 * r;
                        acc[r] = __builtin_amdgcn_mfma_f32_32x32x16_f16(rt::tr16(vp, vp + 8 * rt::VP), pb[sp], acc[r], 0, 0, 0); }
                    if (r & 1) __builtin_amdgcn_sched_barrier(0);
                }
            }
            if (jt + 1 < 4) RO_WRITE(cur ^ 1);
            __syncthreads();
        }
#undef RO_LOAD
#undef RO_WRITE
        float s1 = 0.f, s2 = 0.f;
#pragma unroll
        for (int r = 0; r < 8; ++r)
#pragma unroll
            for (int e = 0; e < 16; ++e) { s1 += acc[r][e]; s2 += acc[r][e] * acc[r][e]; }
        s1 += __shfl_xor(s1, 32); s2 += __shfl_xor(s2, 32);
        if (hh == 0) { stats[(F.wave * 32 + r31) * 2] = s1; stats[(F.wave * 32 + r31) * 2 + 1] = s2; }
        __syncthreads();
        s1 += stats[((F.wave ^ 4) * 32 + r31) * 2]; s2 += stats[((F.wave ^ 4) * 32 + r31) * 2 + 1];
        const float mu = s1 * (1.0f / 512.0f), var = fmaxf(s2 * (1.0f / 512.0f) - mu * mu, 0.f), rs = 1.0f / sqrtf(var + EPS);
#pragma unroll
        for (int r = 0; r < 8; ++r)
#pragma unroll
            for (int cq = 0; cq < 4; ++cq) {
                const size_t off = (size_t)tok * 4096 + h * 512 + dvh * 256 + 32 * r + 8 * cq + 4 * hh;
                const h16x4 gv = *(const h16x4*)(RG + off); h16x4 ov;
#pragma unroll
                for (int e = 0; e < 4; ++e) ov[e] = (h16)((float)gv[e] * ((acc[r][4 * cq + e] - mu) * rs));
                *(h16x4*)(OZ + off) = ov;
            }
    }
}

template <int KIND>
__device__ __forceinline__ void phase_gemm_proj(const Frame& F, int N) {
    pg8::Gemm g{(const h16*)(F.ws + WS_H), (const h16*)(F.ws + WS_WTIN), S, N, 2048, 2048, 2048}; pg8::StaticOrder So; So.init(S, N, F.G, F.bid);
    pg8::EpiProj<KIND> E{F.ws};
    pg8::gemm_phase<pg8::EpiProj<KIND>, pg8::StaticOrder, true, true>((LAS unsigned char*)F.lds, g, So, E);
}
__device__ __forceinline__ void phase_gemm(const Frame& F, const h16* A, const h16* Bt, int N, int K, void* O, int ldc, int f32out) {
    pg8::Gemm g{A, Bt, S, N, K, K, K}; pg8::StaticOrder So; So.init(S, N, F.G, F.bid);
    pg8::EpiStore E{O, ldc, f32out};
    pg8::gemm_phase<pg8::EpiStore, pg8::StaticOrder, true, true>((LAS unsigned char*)F.lds, g, So, E);
}

constexpr int NPHASE = 2 + 8 * DEPTH;
__host__ __device__ inline bool phase_exists(int p) {
    if (p < 2) return true;
    const int L = (p - 2) / 8, s = (p - 2) % 8, kind = L % 3;
    if (s == 7) return false;
    if (s == 1) return kind == 1;
    if (s == 2) return kind != 0;
    if (s == 4) return false;
    return true;
}

__global__ void __launch_bounds__(NTHREADS, 2) trunk_fwd(Args args) {
    extern __shared__ __attribute__((aligned(16))) unsigned char lds_raw[];
    Frame F;
    F.out = args.out; F.ws = args.ws; F.lds = (char*)lds_raw;
    F.tid = threadIdx.x; F.lane = F.tid & 63; F.wave = __builtin_amdgcn_readfirstlane(F.tid >> 6); F.G = gridDim.x; F.bid = blockIdx.x;
    volatile LAS unsigned* misc = (volatile LAS unsigned*)((LAS unsigned char*)lds_raw + MISC_OFF);
    if (F.tid < 16) misc[F.tid] = 0u;
    __syncthreads();
    XcdBarrier bar; bar.bar = (unsigned*)(F.ws + WS_CTL) + CW_BAR; bar.x = 0; bar.st = misc;
#if ONE_LAUNCH
    bar = xcd_barrier_post((unsigned*)(F.ws + WS_CTL) + CW_BAR, misc);
    cg::grid_group grid = cg::this_grid();
#endif
    const int lo = args.ph_lo, hi = args.ph_hi;
#if ONE_LAUNCH
    grid.sync();
#define SEAM(p) do { if ((p) > lo) xcd_barrier(bar); } while (0)
#else
#define SEAM(p) do { } while (0)
#endif
#define IN(p) (lo <= (p) && (p) < hi)
#ifndef PHMASK
#define PHMASK 0xFFFF
#endif
#define EN(b) ((PHMASK >> (b)) & 1)
#ifndef PROBE_DUP
#define PROBE_DUP 0
#endif
#define DUP(b, call) do { if ((PROBE_DUP >> (b)) & 1) { if (ONE_LAUNCH) xcd_barrier(bar); call; } } while (0)
    if (EN(0) && IN(0)) { SEAM(0); phase_prologue(F, args); }
    if (EN(1) && IN(1)) { SEAM(1); phase_norm(F, args, -1, 0); }
#define LAYER(L) do { \
        constexpr int kind = (L) % 3, base = 2 + 8 * (L); \
        constexpr int Nin = kind == 0 ? 8192 : (kind == 1 ? NSA_NP : 12288); \
        constexpr int Kout = kind == 2 ? 4096 : 2048; \
        if (EN(2) && IN(base + 0)) { SEAM(base + 0); phase_gemm_proj<kind>(F, Nin); } \
        if (EN(6) && kind == 1 && IN(base + 1)) { SEAM(base + 1); phase_nsa_cmp_a(F); } \
        if (kind != 0 && IN(base + 2)) { SEAM(base + 2); if (EN(6) && kind == 1) { phase_nsa_cmp_b(F, args); } else if (EN(7) && kind == 2) { phase_ret_scan_mfma(F, args); } } \
        if (IN(base + 3)) { SEAM(base + 3); if (EN(8) && kind == 0) { phase_moba_attn_mfma(F); DUP(8, phase_moba_attn_mfma(F)); } else if (EN(9) && kind == 1) { phase_nsa_attn_mfma(F); DUP(9, phase_nsa_attn_mfma(F)); } else if (EN(10) && kind == 2) { phase_ret_out_mfma(F, args); } } \
        if (EN(2) && IN(base + 5)) { SEAM(base + 5); phase_gemm(F, (const h16*)(F.ws + WS_OZ), (const h16*)(F.ws + WS_WTOUT), 2048, Kout, F.ws + WS_Y, 2048, 1); } \
        if (EN(1) && IN(base + 6)) { SEAM(base + 6); phase_norm(F, args, (L), (L) + 1 < DEPTH ? (L) + 1 : -1); } \
    } while (0)
    LAYER(0); LAYER(1); LAYER(2); LAYER(3);
#undef LAYER
#undef EN
#undef DUP
#undef IN
#undef SEAM
}

extern "C" void kernel_launch(void* const* d_in, const int* in_sizes, int n_in, void* d_out, int out_size, void* d_ws, size_t ws_size, hipStream_t stream) {
    static int grid = 0;
    if (grid == 0) {
        if (n_in != 18 || out_size != S * D || ws_size < WS_END) { fprintf(stderr, "kernel_launch: unexpected shapes (n_in %d, out %d, ws %zu)\n", n_in, out_size, ws_size); grid = -1; return; }
        int dev = 0, cus = 0, per_cu = 0;
        if (hipGetDevice(&dev) != hipSuccess || hipDeviceGetAttribute(&cus, hipDeviceAttributeMultiprocessorCount, dev) != hipSuccess) { grid = -1; return; }
        if (hipFuncSetAttribute((const void*)trunk_fwd, hipFuncAttributeMaxDynamicSharedMemorySize, LDS_BYTES) != hipSuccess) { fprintf(stderr, "kernel_launch: hipFuncSetAttribute failed\n"); grid = -1; return; }
        if (hipOccupancyMaxActiveBlocksPerMultiprocessor(&per_cu, (const void*)trunk_fwd, NTHREADS, LDS_BYTES) != hipSuccess || per_cu < 1) { fprintf(stderr, "kernel_launch: occupancy query says %d\n", per_cu); per_cu = 1; }
        (void)hipGetLastError();
        grid = cus;
    }
    if (grid < 0) return;
    (void)hipMemsetAsync((char*)d_ws + WS_CTL, 0, CTL_ZERO_BYTES, stream);
    Args a{};
    for (int i = 0; i < 18; ++i) a.in[i] = (const float*)d_in[i];
    a.out = (float*)d_out; a.ws = (unsigned char*)d_ws;
    for (int j = 0; j < 16; ++j) a.inv16[j] = pow(500000.0, -(double)j / 16.0);
    for (int j = 0; j < 128; ++j) a.inv128[j] = pow(10000.0, -(double)j / 128.0);
    for (int h = 0; h < 8; ++h) a.lg2g[h] = (float)log2(1.0 - ldexp(1.0, -5 - h));
#if ONE_LAUNCH
    a.ph_lo = 0; a.ph_hi = NPHASE;
    void* kargs[] = {&a};
    hipError_t e = hipLaunchCooperativeKernel((const void*)trunk_fwd, dim3(grid), dim3(NTHREADS), kargs, LDS_BYTES, stream);
    if (e != hipSuccess) fprintf(stderr, "kernel_launch: cooperative launch failed: %s (grid %d)\n", hipGetErrorString(e), grid);
#else
    for (int p = 0; p < NPHASE; ++p) {
        if (!phase_exists(p)) continue;
        a.ph_lo = p; a.ph_hi = p + 1;
        hipLaunchKernelGGL(trunk_fwd, dim3(grid), dim3(NTHREADS), LDS_BYTES, stream, a);
    }
#endif
}
```

```cpp
#include <hip/hip_runtime.h>
#include <hip/hip_cooperative_groups.h>
#include <cstdio>
#include <cstdint>
#include <cmath>
namespace cg = cooperative_groups;

#ifndef ONE_LAUNCH
#define ONE_LAUNCH 1
#endif
#ifndef MOBA_MFMA
#define MOBA_MFMA 1
#endif
#ifndef NSA_MFMA
#define NSA_MFMA 1
#endif

#define LAS __attribute__((address_space(3)))
typedef _Float16 h16;
typedef _Float16 h16x2 __attribute__((ext_vector_type(2)));
typedef _Float16 h16x4 __attribute__((ext_vector_type(4)));
typedef _Float16 h16x8 __attribute__((ext_vector_type(8)));
typedef float f32x2 __attribute__((ext_vector_type(2)));
typedef float f32x4 __attribute__((ext_vector_type(4)));
typedef unsigned u32x4 __attribute__((ext_vector_type(4)));

constexpr int S = 8192, D = 2048, DEPTH = 4;
constexpr float EPS = 1e-6f;
constexpr float NEGF = -1e30f, BIGF = 1e30f;
constexpr int NSA_NP = 7424;
constexpr int NC = 511;

constexpr size_t MiB = 1u << 20;
constexpr size_t WS_CTL = 0, CTL_ZERO_BYTES = 1 * MiB;
constexpr size_t WS_MODP = 1 * MiB;
constexpr size_t WS_KMEAN = 4 * MiB + 512 * 1024;
constexpr size_t WS_CMPB = 2 * MiB + 512 * 1024;
constexpr size_t WS_GATES = 3 * MiB;
constexpr size_t WS_KCMP = 5 * MiB;
constexpr size_t WS_VCMP = 5 * MiB + 512 * 1024;
constexpr size_t WS_ROPE16 = 6 * MiB;
constexpr size_t WS_ROPE128 = 7 * MiB;
constexpr size_t WS_WTIN = 16 * MiB;
constexpr size_t WS_WTOUT = 64 * MiB;
constexpr size_t WS_W1T = 72 * MiB;
constexpr size_t WS_H = 80 * MiB;
constexpr size_t WS_P = 112 * MiB;
constexpr size_t WS_QKV = 304 * MiB;
constexpr size_t WS_OZ = 496 * MiB;
constexpr size_t WS_Y = 560 * MiB;
constexpr size_t WS_OR = 624 * MiB;
constexpr size_t WS_END = 752 * MiB;

constexpr int LDS_BYTES = 147456;
constexpr int MISC_OFF = 135168;
constexpr int NTHREADS = 512;

struct Args {
    const float* in[18];
    float* out;
    unsigned char* ws;
    double inv16[16];
    double inv128[128];
    float lg2g[8];
    int ph_lo, ph_hi;
};

#define XB_TMO      128
#define XB_XCNT(j)  (256  + 64 * (j))
#define XB_XSUB(j)  (1280 + 64 * (j))
#define XB_XGEN(j)  (2304 + 64 * (j))
#define XB_TOP      3328
#define XB_TOPGEN   3392
#define XCD_BAR_WORDS 3456
#define XB_SPIN_CAP (1u << 24)
constexpr int CW_BAR = 4096;

__device__ __forceinline__ unsigned xb_ld(unsigned* p)              { return __hip_atomic_load(p, __ATOMIC_RELAXED, __HIP_MEMORY_SCOPE_AGENT); }
__device__ __forceinline__ unsigned xb_add(unsigned* p, unsigned v) { return __hip_atomic_fetch_add(p, v, __ATOMIC_RELAXED, __HIP_MEMORY_SCOPE_AGENT); }
__device__ __forceinline__ unsigned xb_xcc_id() { return (unsigned)__builtin_amdgcn_s_getreg((3 << 11) | 20) & 0xFu; }
#define XB_SPIN(cond, bar) do { unsigned _sp = 0; while (cond) { __builtin_amdgcn_s_sleep(1); \
    if ((++_sp & 255u) == 0u) { if (xb_ld(&(bar)[XB_TMO])) break; if (_sp > XB_SPIN_CAP) { atomicAdd(&(bar)[XB_TMO], 1u); break; } } } } while (0)

struct XcdBarrier { unsigned* bar; unsigned x; volatile LAS unsigned* st; };

__device__ __forceinline__ XcdBarrier xcd_barrier_post(unsigned* bar, volatile LAS unsigned* st) {
    XcdBarrier b; b.bar = bar; b.x = xb_xcc_id(); b.st = st;
    if (threadIdx.x == 0) (void)xb_add(&bar[XB_XCNT(b.x)], 1u);
    return b;
}
__device__ __forceinline__ void xcd_barrier_complete(unsigned* bar, unsigned x, unsigned& nloc, unsigned& nx) {
    const unsigned G = gridDim.x * gridDim.y * gridDim.z;
    unsigned sum, cnt, mine, sp = 0u;
    for (;;) {
        sum = 0u; cnt = 0u; mine = 0u;
#pragma unroll
        for (unsigned j = 0; j < 16; ++j) { const unsigned c = xb_ld(&bar[XB_XCNT(j)]); sum += c; cnt += (c > 0u) ? 1u : 0u; mine = (j == x) ? c : mine; }
        if (sum == G) break;
        __builtin_amdgcn_s_sleep(1);
        if ((++sp & 255u) == 0u) { if (xb_ld(&bar[XB_TMO])) break; if (sp > XB_SPIN_CAP) { atomicAdd(&bar[XB_TMO], 1u); break; } }
    }
    nloc = mine > 0u ? mine : 1u; nx = cnt > 0u ? cnt : 1u;
}
__device__ __forceinline__ void xcd_barrier(const XcdBarrier& b) {
    asm volatile("s_waitcnt vmcnt(0)" ::: "memory");
    __syncthreads();
    if (threadIdx.x == 0) {
        unsigned* bar = b.bar;
        __builtin_amdgcn_s_waitcnt(0);
        unsigned nloc = b.st[0], nx = b.st[1];
        if (nloc == 0u) { xcd_barrier_complete(bar, b.x, nloc, nx); b.st[0] = nloc; b.st[1] = nx; }
        const unsigned old = xb_add(&bar[XB_XSUB(b.x)], 1u);
        const unsigned gen = old / nloc;
        if (old + 1u == (gen + 1u) * nloc) {
            __builtin_amdgcn_fence(__ATOMIC_RELEASE, "agent");
            asm volatile("s_waitcnt vmcnt(0)" ::: "memory");
            const unsigned og = xb_add(&bar[XB_TOP], 1u);
            const unsigned tg = og / nx;
            if (og + 1u == (tg + 1u) * nx) xb_add(&bar[XB_TOPGEN], 1u);
            else XB_SPIN(xb_ld(&bar[XB_TOPGEN]) == tg, bar);
            __builtin_amdgcn_fence(__ATOMIC_ACQUIRE, "agent");
            xb_add(&bar[XB_XGEN(b.x)], 1u);
            asm volatile("s_waitcnt vmcnt(0)" ::: "memory");
        } else {
            XB_SPIN(xb_ld(&bar[XB_XGEN(b.x)]) == gen, bar);
            __builtin_amdgcn_fence(__ATOMIC_ACQUIRE, "agent");
            asm volatile("s_waitcnt vmcnt(0)" ::: "memory");
        }
    }
    __syncthreads();
}

__device__ __forceinline__ float silu_f(float x) { return x / (1.f + __expf(-x)); }
__device__ __forceinline__ float sigmoid_f(float x) { return 1.f / (1.f + __expf(-x)); }

namespace pg8 {
constexpr int BM = 256, BK = 64, HALF = 128, HTB = HALF * BK * 2, STAGE_BYTES = 8 * HTB, NXCD = 8, WGM = 8;
__host__ __device__ __forceinline__ int lds_byte(int r, int c) { const int st = (r >> 4) * 2 + (c >> 5), rr = r & 15, cc = c & 31, ob = rr * 64 + cc * 2; return st * 1024 + (ob ^ (((ob >> 9) & 1) << 5)); }
__host__ __device__ __forceinline__ void stage_rc(int b, int& R, int& C) { const int st = b / 1024, sb = b % 1024, swz = sb ^ (((sb >> 9) & 1) << 5); R = (st >> 1) * 16 + swz / 64; C = (st & 1) * 32 + (swz % 64) / 2; }
__host__ __device__ __forceinline__ int perm32(int rho) { const int n = rho >> 4, i = rho & 15; return 8 * (i >> 2) + 4 * n + (i & 3); }

struct Unit { int pm, pn; };
struct Gemm { const h16* A; const h16* Bt; int M, N, K, lda, ldb; };

struct StaticOrder {
    int nM, nN, nwg, G, c;
    __host__ __device__ void init(int M, int N, int G_, int c_) { nM = M / BM; nN = N / BM; nwg = nM * nN; G = G_; c = c_; }
    __host__ __device__ bool next(int i, Unit& u) const {
        const long L = (long)i * G + c; if (L >= nwg) return false;
        int wgid = (int)L; { const int q = nwg / NXCD, r = nwg % NXCD, xcd = wgid % NXCD, off = wgid / NXCD; wgid = (xcd < r ? xcd * (q + 1) : r * (q + 1) + (xcd - r) * q) + off; }
        const int nig = WGM * nN, gid = wgid / nig, fm = gid * WGM, gsz = (nM - fm) < WGM ? (nM - fm) : WGM;
        u.pm = fm + ((wgid % nig) % gsz); u.pn = (wgid % nig) / gsz; return true;
    }
    __device__ __forceinline__ void a_ready(const Unit&) const {}
    __device__ __forceinline__ void done(const Unit&) const {}
};

struct OneUnit {
    int pm, pn, have;
    __device__ bool next(int i, Unit& u) const { if (i != 0 || !have) return false; u.pm = pm; u.pn = pn; return true; }
    __device__ __forceinline__ void a_ready(const Unit&) const {}
    __device__ __forceinline__ void done(const Unit&) const {}
};
struct EpiStore {
    static constexpr bool PERM = true, AFTER_DRAIN = false;
    void* O; int ldc; int f32out;
    __device__ __forceinline__ void operator()(const f32x4 (&acc)[2][2][4][2], const Unit& u, int wr, int wc, int fr, int fq) const {
        const int row0 = u.pm * BM + wr * 64 + fr, col0 = u.pn * BM + wc * 32 + 8 * fq;
#pragma unroll
        for (int ai = 0; ai < 2; ++ai)
#pragma unroll
            for (int m = 0; m < 4; ++m) {
                const size_t roff = (size_t)(row0 + ai * HALF + m * 16) * ldc + col0;
#pragma unroll
                for (int bj = 0; bj < 2; ++bj) {
                    const f32x4 v0 = acc[ai][bj][m][0], v1 = acc[ai][bj][m][1];
                    if (f32out) {
                        float* p = (float*)O + roff + bj * HALF;
                        *(f32x4*)p = v0; *(f32x4*)(p + 4) = v1;
                    } else {
                        h16x8 w; w[0] = (h16)v0[0]; w[1] = (h16)v0[1]; w[2] = (h16)v0[2]; w[3] = (h16)v0[3]; w[4] = (h16)v1[0]; w[5] = (h16)v1[1]; w[6] = (h16)v1[2]; w[7] = (h16)v1[3];
                        *(h16x8*)((h16*)O + roff + bj * HALF) = w;
                    }
                }
            }
    }
};


template <int KIND  > struct EpiProj {
    static constexpr bool PERM = true, AFTER_DRAIN = false;
    unsigned char* ws;
    __device__ __forceinline__ static void st8(h16* p, const float (&v)[8]) { h16x8 w;
#pragma unroll
        for (int i = 0; i < 8; ++i) w[i] = (h16)v[i];
        *(h16x8*)p = w; }
    __device__ __forceinline__ void operator()(const f32x4 (&acc)[2][2][4][2], const Unit& u, int wr, int wc, int fr, int fq) const {
        const int pn = u.pn, d0 = 32 * wc + 8 * fq;
        h16* QKV = (h16*)(ws + WS_QKV);
        const f32x2* r16 = (const f32x2*)(ws + WS_ROPE16); const f32x2* r128 = (const f32x2*)(ws + WS_ROPE128);
        float ksum[2][8];
#pragma unroll
        for (int bj = 0; bj < 2; ++bj)
#pragma unroll
            for (int i = 0; i < 8; ++i) ksum[bj][i] = 0.f;
        int mode;
        float scale = 1.f; h16* base = QKV; int ld = 0;
        bool want_ksum = false;
        if (KIND == 0) {
            const int sect = pn >> 3;
            if (sect == 0) { mode = 0; scale = 0.08838834764831845f; base = QKV + (size_t)(2 * (pn & 7)) * S * 128; }
            else if (sect == 1) { mode = 0; want_ksum = true; base = QKV + (size_t)16 * S * 128 + (size_t)(2 * (pn & 7)) * S * 128; }
            else if (sect == 2) { mode = 1; base = QKV + (size_t)32 * S * 128 + (size_t)(2 * (pn & 7)) * S * 128; }
            else { mode = 2; base = QKV + (size_t)48 * S * 128 + (pn & 7) * 256; ld = 2048; }
        } else if (KIND == 1) {
            if (pn < 8) { mode = 0; scale = 0.08838834764831845f; base = QKV + (size_t)(2 * pn) * S * 128; }
            else if (pn < 20) { const int ti = (pn - 8) >> 1; mode = (ti & 1) ? 1 : 0; base = QKV + (size_t)16 * S * 128 + ((size_t)ti * 4 + 2 * ((pn - 8) & 1)) * S * 128; }
            else if (pn < 28) { mode = 2; base = (h16*)(ws + WS_QKV + 96 * MiB) + (pn - 20) * 256; ld = 2048; }
            else mode = 3;
        } else {
            if (pn < 8) { mode = 4; base = QKV + (size_t)pn * S * 256; }
            else if (pn < 16) { mode = 4; scale = 0.0625f; base = QKV + (size_t)8 * S * 256 + (size_t)(pn - 8) * S * 256; }
            else if (pn < 32) { mode = 5; base = QKV + (size_t)16 * S * 256 + (size_t)((pn - 16) >> 1) * S * 512 + ((pn - 16) & 1) * 256; }
            else { mode = 2; base = QKV + (size_t)16 * S * 256 + (size_t)8 * S * 512 + (pn - 32) * 256; ld = 4096; }
        }
#pragma unroll
        for (int ai = 0; ai < 2; ++ai)
#pragma unroll
            for (int m = 0; m < 4; ++m) {
                const int t = u.pm * BM + ai * HALF + wr * 64 + m * 16 + fr;
                float v[2][8];
#pragma unroll
                for (int bj = 0; bj < 2; ++bj)
#pragma unroll
                    for (int i = 0; i < 8; ++i) v[bj][i] = acc[ai][bj][m][i >> 2][i & 3];
                if (mode == 0) {
                    if (wc == 0) {
                        const f32x2* cs = r16 + (size_t)t * 16 + 8 * (fq & 1);
#pragma unroll
                        for (int bj = 0; bj < 2; ++bj)
#pragma unroll
                            for (int i = 0; i < 8; ++i) { const float o = __shfl_xor(v[bj][i], 32); const f32x2 c = cs[i];
                                v[bj][i] = (fq < 2) ? (v[bj][i] * c[0] - o * c[1]) : (o * c[1] + v[bj][i] * c[0]); }
                    }
#pragma unroll
                    for (int bj = 0; bj < 2; ++bj) {
#pragma unroll
                        for (int i = 0; i < 8; ++i) { v[bj][i] *= scale; ksum[bj][i] += v[bj][i]; }
                        st8(base + ((size_t)bj * S + t) * 128 + d0, v[bj]);
                    }
                } else if (mode == 1) {
#pragma unroll
                    for (int bj = 0; bj < 2; ++bj) st8(base + ((size_t)bj * S + t) * 128 + d0, v[bj]);
                } else if (mode == 2) {
#pragma unroll
                    for (int bj = 0; bj < 2; ++bj) {
#pragma unroll
                        for (int i = 0; i < 8; ++i) v[bj][i] = silu_f(v[bj][i]);
                        st8(base + (size_t)t * ld + 128 * bj + d0, v[bj]);
                    }
                } else if (mode == 3) {
                    if (d0 < 48) { float* gp = (float*)(ws + WS_GATES) + (size_t)t * 48 + d0;
#pragma unroll
                        for (int i = 0; i < 8; ++i) gp[i] = sigmoid_f(v[0][i]); }
                } else if (mode == 4) {
                    const f32x2* cs = r128 + (size_t)t * 128 + d0;
#pragma unroll
                    for (int i = 0; i < 8; ++i) { const f32x2 c = cs[i]; const float x1 = v[0][i], x2 = v[1][i];
                        v[0][i] = (x1 * c[0] - x2 * c[1]) * scale; v[1][i] = (x1 * c[1] + x2 * c[0]) * scale; }
                    st8(base + (size_t)t * 256 + d0, v[0]); st8(base + (size_t)t * 256 + 128 + d0, v[1]);
                } else {
#pragma unroll
                    for (int bj = 0; bj < 2; ++bj) st8(base + (size_t)t * 512 + 128 * bj + d0, v[bj]);
                }
            }
        if (KIND == 0 && want_ksum) {
#pragma unroll
            for (int bj = 0; bj < 2; ++bj)
#pragma unroll
                for (int i = 0; i < 8; ++i) { float x = ksum[bj][i]; x += __shfl_xor(x, 1); x += __shfl_xor(x, 2); x += __shfl_xor(x, 4); x += __shfl_xor(x, 8); ksum[bj][i] = x; }
            if (fr == 0) { float* km = (float*)(ws + WS_KMEAN) + (size_t)wr * 65536;
#pragma unroll
                for (int bj = 0; bj < 2; ++bj)
#pragma unroll
                    for (int i = 0; i < 8; ++i) km[((size_t)(2 * (pn & 7) + bj) * 32 + u.pm) * 128 + d0 + i] = ksum[bj][i] * (1.0f / 256.0f); }
        }
    }
};

template <class Epi, class Sched, bool ALIGN_EPI = false, bool SP2 = false>
__device__ __forceinline__ void gemm_phase(LAS unsigned char* lds, const Gemm g, const Sched& S, const Epi& E) {
    const int tid = threadIdx.x, wid = __builtin_amdgcn_readfirstlane(tid >> 6), lane = tid & 63, wr = wid >> 2, wc = wid & 3, fr = lane & 15, fq = lane >> 4;
    const int K = g.K, nt = K / BK;
    unsigned voffA[2], voffB[2];
#pragma unroll
    for (int i = 0; i < 2; ++i) { int R, C; stage_rc(tid * 16 + i * 8192, R, C); const int Rb = Epi::PERM ? ((R & ~31) + perm32(R & 31)) : R;
        voffA[i] = (unsigned)(R * g.lda + C) * 2u; voffB[i] = (unsigned)(Rb * g.ldb + C) * 2u; }
    const size_t kstep = (size_t)(BK * 2);
    const size_t hstepA = (size_t)HALF * g.lda * 2, hstepB = (size_t)HALF * g.ldb * 2;
    const size_t tstepA = 2 * hstepA, tstepB = 2 * hstepB;
    const unsigned ldsw = (unsigned)wid * 1024u;
    const int aoff = lds_byte(wr * 64 + fr, fq * 8), boff = lds_byte(wc * 32 + fr, fq * 8);
#define PG8_SA(b, h) (((b) * 2 + (h)) * HTB)
#define PG8_SB(b, h) ((4 + (b) * 2 + (h)) * HTB)
#define PG8_STAGE(bufoff, gbase, voff) do { _Pragma("unroll") for (int _i = 0; _i < 2; ++_i) \
        __builtin_amdgcn_global_load_lds((const unsigned*)((const char*)(gbase) + (voff)[_i]), (LAS unsigned*)(lds + (bufoff) + ldsw + _i * 8192), 16, 0, 0); } while (0)
#define PG8_LDA(dst, b, h) do { _Pragma("unroll") for (int m = 0; m < 4; ++m) _Pragma("unroll") for (int k = 0; k < 2; ++k) dst[m][k] = *(const LAS h16x8*)(lds + PG8_SA(b, h) + aoff + m * 2048 + k * 1024); } while (0)
#define PG8_LDB(dst, b, h) do { _Pragma("unroll") for (int n = 0; n < 2; ++n) _Pragma("unroll") for (int k = 0; k < 2; ++k) dst[n][k] = *(const LAS h16x8*)(lds + PG8_SB(b, h) + boff + n * 2048 + k * 1024); } while (0)
#define PG8_MMA(ai, bj, At, Bt) do { __builtin_amdgcn_s_setprio(1); _Pragma("unroll") for (int m = 0; m < 4; ++m) _Pragma("unroll") for (int n = 0; n < 2; ++n) _Pragma("unroll") for (int k = 0; k < 2; ++k) \
        acc[ai][bj][m][n] = __builtin_amdgcn_mfma_f32_16x16x32_f16(Bt[n][k], At[m][k], acc[ai][bj][m][n], 0, 0, 0); __builtin_amdgcn_s_setprio(0); } while (0)
#define PG8_WAIT_V(n) asm volatile("s_waitcnt vmcnt(" #n ")" ::: "memory")
#define PG8_WAIT_L(n) asm volatile("s_waitcnt lgkmcnt(" #n ")" ::: "memory")
#define PG8_BAR __builtin_amdgcn_s_barrier()
#define PG8_SCHED __builtin_amdgcn_sched_barrier(0)
    Unit cur, nxt; int ui = 0;
    if (!S.next(0, cur)) return;
    f32x4 acc[2][2][4][2];
#pragma unroll
    for (int a = 0; a < 2; ++a)
#pragma unroll
        for (int b = 0; b < 2; ++b)
#pragma unroll
            for (int m = 0; m < 4; ++m)
#pragma unroll
                for (int n = 0; n < 2; ++n) acc[a][b][m][n] = (f32x4){0.f, 0.f, 0.f, 0.f};
    h16x8 At[4][2], B0[2][2], B1[2][2];
    const char* cA = (const char*)g.A + (size_t)cur.pm * tstepA; const char* cB = (const char*)g.Bt + (size_t)cur.pn * tstepB;
    S.a_ready(cur);
    if constexpr (SP2) {
        PG8_STAGE(PG8_SB(0, 0), cB, voffB); PG8_STAGE(PG8_SB(0, 1), cB + hstepB, voffB); PG8_STAGE(PG8_SA(0, 0), cA, voffA); PG8_STAGE(PG8_SA(0, 1), cA + hstepA, voffA);
        if (wr == 1) PG8_BAR;
        PG8_WAIT_V(2); PG8_BAR;
        PG8_STAGE(PG8_SB(1, 0), cB + kstep, voffB); PG8_STAGE(PG8_SA(1, 0), cA + kstep, voffA); PG8_STAGE(PG8_SB(1, 1), cB + hstepB + kstep, voffB);
        PG8_WAIT_V(6); PG8_BAR;
    } else {
        PG8_STAGE(PG8_SB(0, 0), cB, voffB); PG8_STAGE(PG8_SA(0, 0), cA, voffA); PG8_STAGE(PG8_SB(0, 1), cB + hstepB, voffB); PG8_STAGE(PG8_SA(0, 1), cA + hstepA, voffA);
        if (wr == 1) PG8_BAR;
        PG8_WAIT_V(4); PG8_BAR;
        PG8_STAGE(PG8_SB(1, 0), cB + kstep, voffB); PG8_STAGE(PG8_SA(1, 0), cA + kstep, voffA); PG8_STAGE(PG8_SB(1, 1), cB + hstepB + kstep, voffB);
        PG8_WAIT_V(6); PG8_BAR;
    }
    for (;;) {
        const bool has_next = S.next(ui + 1, nxt);
        const char* nA = has_next ? (const char*)g.A + (size_t)nxt.pm * tstepA : cA; const char* nB = has_next ? (const char*)g.Bt + (size_t)nxt.pn * tstepB : cB;
        for (int t = 0; t < nt; t += 2) {
            const bool last = (t == nt - 2);
            const char* a1 = cA + (size_t)(t + 1) * kstep;
            const char* a2 = last ? nA : cA + (size_t)(t + 2) * kstep; const char* b2 = last ? nB : cB + (size_t)(t + 2) * kstep;
            const char* a3 = a2 + kstep; const char* b3 = b2 + kstep;
            if (last && has_next) S.a_ready(nxt);
            if constexpr (SP2) {
            PG8_LDB(B0, 0, 0); PG8_LDB(B1, 0, 1); PG8_SCHED; PG8_LDA(At, 0, 0); PG8_STAGE(PG8_SA(1, 1), a1 + hstepA, voffA);
            PG8_WAIT_V(8); PG8_WAIT_L(0); PG8_BAR; PG8_MMA(0, 0, At, B0); PG8_MMA(0, 1, At, B1); PG8_BAR; PG8_SCHED;
            PG8_LDA(At, 0, 1); PG8_STAGE(PG8_SB(0, 0), b2, voffB); PG8_STAGE(PG8_SB(0, 1), b2 + hstepB, voffB); PG8_STAGE(PG8_SA(0, 0), a2, voffA);
            PG8_WAIT_V(8); PG8_WAIT_L(0); PG8_BAR; PG8_MMA(1, 0, At, B0); PG8_MMA(1, 1, At, B1); PG8_BAR; PG8_SCHED;
            PG8_LDB(B0, 1, 0); PG8_LDB(B1, 1, 1); PG8_SCHED; PG8_LDA(At, 1, 0); PG8_STAGE(PG8_SA(0, 1), a2 + hstepA, voffA);
            PG8_WAIT_V(8); PG8_WAIT_L(0); PG8_BAR; PG8_MMA(0, 0, At, B0); PG8_MMA(0, 1, At, B1); PG8_BAR; PG8_SCHED;
            PG8_LDA(At, 1, 1); PG8_STAGE(PG8_SB(1, 0), b3, voffB); PG8_STAGE(PG8_SB(1, 1), b3 + hstepB, voffB); PG8_STAGE(PG8_SA(1, 0), a3, voffA);
            PG8_WAIT_V(8); PG8_WAIT_L(0); PG8_BAR; PG8_MMA(1, 0, At, B0); PG8_MMA(1, 1, At, B1); PG8_BAR; PG8_SCHED;
            } else {
            PG8_LDB(B0, 0, 0); PG8_SCHED; PG8_LDA(At, 0, 0); PG8_STAGE(PG8_SA(1, 1), a1 + hstepA, voffA);
            PG8_WAIT_L(8); PG8_BAR; PG8_WAIT_L(0); PG8_MMA(0, 0, At, B0); PG8_BAR; PG8_SCHED;
            PG8_LDB(B1, 0, 1); PG8_STAGE(PG8_SB(0, 0), b2, voffB);
            PG8_BAR; PG8_WAIT_L(0); PG8_MMA(0, 1, At, B1); PG8_BAR;
            PG8_LDA(At, 0, 1); PG8_STAGE(PG8_SA(0, 0), a2, voffA);
            PG8_BAR; PG8_WAIT_L(0); PG8_MMA(1, 0, At, B0); PG8_BAR; PG8_SCHED;
            PG8_STAGE(PG8_SB(0, 1), b2 + hstepB, voffB);
            PG8_WAIT_V(6); PG8_BAR; PG8_MMA(1, 1, At, B1); PG8_BAR;
            PG8_LDB(B0, 1, 0); PG8_SCHED; PG8_LDA(At, 1, 0); PG8_STAGE(PG8_SA(0, 1), a2 + hstepA, voffA);
            PG8_WAIT_L(8); PG8_BAR; PG8_WAIT_L(0); PG8_MMA(0, 0, At, B0); PG8_BAR; PG8_SCHED;
            PG8_LDB(B1, 1, 1); PG8_STAGE(PG8_SB(1, 0), b3, voffB);
            PG8_BAR; PG8_WAIT_L(0); PG8_MMA(0, 1, At, B1); PG8_BAR;
            PG8_LDA(At, 1, 1); PG8_STAGE(PG8_SA(1, 0), a3, voffA);
            PG8_BAR; PG8_WAIT_L(0); PG8_MMA(1, 0, At, B0); PG8_BAR; PG8_SCHED;
            PG8_STAGE(PG8_SB(1, 1), b3 + hstepB, voffB);
            PG8_WAIT_V(6); PG8_BAR; PG8_MMA(1, 1, At, B1); PG8_BAR;
            }
        }
        if constexpr (ALIGN_EPI) { if (wr == 0) PG8_BAR; }
        if constexpr (!Epi::AFTER_DRAIN) { E(acc, cur, wr, wc, fr, fq); S.done(cur); }
        if (!has_next) break;
#pragma unroll
        for (int a = 0; a < 2; ++a)
#pragma unroll
            for (int b = 0; b < 2; ++b)
#pragma unroll
                for (int m = 0; m < 4; ++m)
#pragma unroll
                    for (int n = 0; n < 2; ++n) acc[a][b][m][n] = (f32x4){0.f, 0.f, 0.f, 0.f};
        cur = nxt; cA = nA; cB = nB; ++ui;
        if constexpr (ALIGN_EPI) { if (wr == 1) PG8_BAR; }
    }
    PG8_WAIT_V(0);
    if constexpr (!ALIGN_EPI) { if (wr == 0) PG8_BAR; }
    PG8_BAR;
#undef PG8_SA
#undef PG8_SB
#undef PG8_STAGE
#undef PG8_LDA
#undef PG8_LDB
#undef PG8_MMA
#undef PG8_WAIT_V
#undef PG8_WAIT_L
#undef PG8_BAR
#undef PG8_SCHED
}
}

struct Frame {
    float* out;
    unsigned char* ws;
    char* lds;
    int tid, lane, wave, G, bid;
};

__device__ __forceinline__ float wave_sum(float v) {
#pragma unroll
    for (int o = 32; o >= 1; o >>= 1) v += __shfl_xor(v, o);
    return v;
}
__device__ __forceinline__ float wave_max(float v) {
#pragma unroll
    for (int o = 32; o >= 1; o >>= 1) v = fmaxf(v, __shfl_xor(v, o));
    return v;
}
__device__ __forceinline__ void wave_lds_fence() { __builtin_amdgcn_wave_barrier(); asm volatile("s_waitcnt lgkmcnt(0)" ::: "memory"); __builtin_amdgcn_wave_barrier(); }

__device__ __forceinline__ void sincos_d(double x, float& c, float& s) {
    const double TWO_OVER_PI = 0.63661977236758134308;
    const double PIO2_HI = 1.57079632679489655800e+00, PIO2_LO = 6.12323399573676603587e-17;
    const double q = __builtin_rint(x * TWO_OVER_PI);
    double y = __builtin_fma(-q, PIO2_HI, x); y = __builtin_fma(-q, PIO2_LO, y);
    const double y2 = y * y;
    double sp = 1.0 / 6227020800.0;
    sp = sp * y2 - 1.0 / 39916800.0; sp = sp * y2 + 1.0 / 362880.0; sp = sp * y2 - 1.0 / 5040.0; sp = sp * y2 + 1.0 / 120.0; sp = sp * y2 - 1.0 / 6.0; sp = sp * y2 * y + y;
    double cp = -1.0 / 87178291200.0;
    cp = cp * y2 + 1.0 / 479001600.0; cp = cp * y2 - 1.0 / 3628800.0; cp = cp * y2 + 1.0 / 40320.0; cp = cp * y2 - 1.0 / 720.0; cp = cp * y2 + 1.0 / 24.0; cp = cp * y2 - 0.5; cp = cp * y2 + 1.0;
    const long long qi = (long long)q; const int quad = (int)(qi & 3);
    double sv, cv;
    if (quad == 0) { sv = sp; cv = cp; } else if (quad == 1) { sv = cp; cv = -sp; } else if (quad == 2) { sv = -sp; cv = -cp; } else { sv = -cp; cv = sp; }
    c = (float)cv; s = (float)sv;
}

__device__ __forceinline__ int nsa_src_col(int n) { return n < 5120 ? n : (n < 7168 ? n + 48 : (n < 7216 ? n - 2048 : -1)); }
__device__ __forceinline__ void conv_transpose(const Frame& F, const float* W, int K, int Nsrc, h16* Wt, int Npad, int mapmode, int item0, int& items_done) {
    float* tile = (float*)F.lds;
    const int tk_n = K / 64, tn_n = Npad / 128, ntiles = tk_n * tn_n;
    f32x4 v[4];
#define CV_LOAD(it_) do { const int tk_ = (it_) / tn_n, tn_ = (it_) % tn_n; _Pragma("unroll") for (int i = 0; i < 4; ++i) { \
        const int idx = F.tid + i * NTHREADS, k = idx >> 5, n4 = (idx & 31) * 4; const int nn = tn_ * 128 + n4; const int src = mapmode ? nsa_src_col(nn) : nn; \
        v[i] = (f32x4){0.f, 0.f, 0.f, 0.f}; if (src >= 0 && src + 3 < Nsrc) v[i] = *(const f32x4*)(W + (size_t)(tk_ * 64 + k) * Nsrc + src); } } while (0)
    if (F.bid < ntiles) CV_LOAD(F.bid);
    for (int it = F.bid; it < ntiles; it += F.G) {
        const int tk = it / tn_n, tn = it % tn_n;
        __syncthreads();
#pragma unroll
        for (int i = 0; i < 4; ++i) {
            const int idx = F.tid + i * NTHREADS, k = idx >> 5, n4 = (idx & 31) * 4;
            tile[k * 129 + n4] = v[i][0]; tile[k * 129 + n4 + 1] = v[i][1]; tile[k * 129 + n4 + 2] = v[i][2]; tile[k * 129 + n4 + 3] = v[i][3];
        }
        if (it + F.G < ntiles) CV_LOAD(it + F.G);
        __syncthreads();
#pragma unroll
        for (int i = 0; i < 4; ++i) {
            const int idx = F.tid + i * NTHREADS, n = idx >> 4, k4 = (idx & 15) * 4;
            h16x4 o; o[0] = (h16)tile[k4 * 129 + n]; o[1] = (h16)tile[(k4 + 1) * 129 + n]; o[2] = (h16)tile[(k4 + 2) * 129 + n]; o[3] = (h16)tile[(k4 + 3) * 129 + n];
            *(h16x4*)(Wt + (size_t)(tn * 128 + n) * K + tk * 64 + k4) = o;
        }
    }
#undef CV_LOAD
    __syncthreads();
}
__device__ __forceinline__ void conv_layer_weights(const Frame& F, const Args& A, int L) {
    const int kind = L % 3, j = L / 3; int dummy = 0;
    h16* wtin = (h16*)(F.ws + WS_WTIN); h16* wtout = (h16*)(F.ws + WS_WTOUT);
    if (kind == 0) {
        conv_transpose(F, A.in[7] + (size_t)j * 2048 * 8192, 2048, 8192, wtin, 8192, 0, 0, dummy);
        conv_transpose(F, A.in[8] + (size_t)j * 2048 * 2048, 2048, 2048, wtout, 2048, 0, 0, dummy);
    } else if (kind == 1) {
        conv_transpose(F, A.in[9], 2048, 7216, wtin, NSA_NP, 1, 0, dummy);
        conv_transpose(F, A.in[10], 2048, 2048, wtout, 2048, 0, 0, dummy);
        conv_transpose(F, A.in[12], 4096, 256, (h16*)(F.ws + WS_W1T), 256, 0, 0, dummy);
        conv_transpose(F, A.in[14], 4096, 256, (h16*)(F.ws + WS_W1T) + (size_t)256 * 4096, 256, 0, 0, dummy);
    } else {
        conv_transpose(F, A.in[16], 2048, 12288, wtin, 12288, 0, 0, dummy);
        conv_transpose(F, A.in[17], 4096, 2048, wtout, 2048, 0, 0, dummy);
    }
}

__device__ __forceinline__ void phase_prologue(const Frame& F, const Args& A) {
    {
        float* modp = (float*)(F.ws + WS_MODP);
        const float* c = A.in[1]; const float* aw = A.in[3];
        float* sc = (float*)F.lds;
        __syncthreads();
        for (int i = F.tid; i < 2048; i += NTHREADS) sc[i] = silu_f(c[i]);
        __syncthreads();
        for (int it = F.bid; it < 192; it += F.G) {
            const int layer = it / 48, r = it % 48, slice = r / 3, nch = r % 3, n = nch * 2048 + F.tid * 4;
            const float* w = aw + (size_t)layer * 2048 * 6144 + (size_t)(slice * 128) * 6144 + n;
            f32x4 a0 = (f32x4){0.f, 0.f, 0.f, 0.f}, a1 = a0;
#pragma unroll 8
            for (int k = 0; k < 128; k += 2) {
                a0 += *(const f32x4*)(w + (size_t)k * 6144) * sc[slice * 128 + k];
                a1 += *(const f32x4*)(w + (size_t)(k + 1) * 6144) * sc[slice * 128 + k + 1];
            }
            *(f32x4*)(modp + (size_t)(slice * 4 + layer) * 6144 + n) = a0 + a1;
        }
        __syncthreads();
    }
    {
        const int* pos = (const int*)A.in[2];
        f32x2* r16 = (f32x2*)(F.ws + WS_ROPE16); f32x2* r128 = (f32x2*)(F.ws + WS_ROPE128);
        for (int idx = F.bid * NTHREADS + F.tid; idx < S * 16; idx += F.G * NTHREADS) {
            const int t = idx >> 4, j = idx & 15; float cs, sn; sincos_d((double)pos[t] * A.inv16[j], cs, sn); r16[idx] = (f32x2){cs, sn};
        }
        for (int idx = F.bid * NTHREADS + F.tid; idx < S * 128; idx += F.G * NTHREADS) {
            const int t = idx >> 7, j = idx & 127; float cs, sn; sincos_d((double)pos[t] * A.inv128[j], cs, sn); r128[idx] = (f32x2){cs, sn};
        }
    }
    if (F.bid >= F.G - 16) {
        const int slice = F.bid - (F.G - 16), kv = F.tid >> 8, j = F.tid & 255; const float* w1 = (kv ? A.in[14] : A.in[12]) + (size_t)slice * 256 * 256; const float* pe = A.in[11] + slice * 256;
        float a0 = 0.f, a1 = 0.f;
#pragma unroll 8
        for (int i = 0; i < 256; i += 2) { a0 += pe[i] * w1[(size_t)i * 256 + j]; a1 += pe[i + 1] * w1[(size_t)(i + 1) * 256 + j]; }
        ((float*)(F.ws + WS_CMPB))[slice * 512 + F.tid] = a0 + a1;
    }
    conv_layer_weights(F, A, 0);
}

__device__ __forceinline__ void phase_norm(const Frame& F, const Args& A, int Lprev, int Lnext) {
    float* modl = (float*)F.lds;
    const float* modp = (const float*)(F.ws + WS_MODP); const float* ab = A.in[4];
    __syncthreads();
    for (int i = F.tid; i < 6144; i += NTHREADS) {
        const int which = i >> 11, col = i & 2047;
        int layer, mcol;
        if (which == 0) { layer = Lprev; mcol = 4096 + col; } else if (which == 1) { layer = Lnext; mcol = 2048 + col; } else { layer = Lnext; mcol = col; }
        float v = 0.f;
        if (layer >= 0) { v = ab[layer * 6144 + mcol];
#pragma unroll
            for (int s = 0; s < 16; ++s) v += modp[(size_t)(s * 4 + layer) * 6144 + mcol]; }
        modl[i] = v;
    }
    __syncthreads();
    const float* xin = (Lprev <= 0) ? A.in[0] : F.out;
    const float* Y = (const float*)(F.ws + WS_Y);
    h16* H = (h16*)(F.ws + WS_H);
    const float* npost = A.in[6] + (Lprev >= 0 ? Lprev : 0) * 2048;
    const float* npre = A.in[5] + (Lnext >= 0 ? Lnext : 0) * 2048;
    for (int t = F.bid * 8 + F.wave; t < S; t += F.G * 8) {
        f32x4 x[8];
#pragma unroll
        for (int i = 0; i < 8; ++i) x[i] = *(const f32x4*)(xin + (size_t)t * D + i * 256 + F.lane * 4);
        if (Lprev >= 0) {
            f32x4 y[8]; float ss = 0.f;
#pragma unroll
            for (int i = 0; i < 8; ++i) { y[i] = *(const f32x4*)(Y + (size_t)t * D + i * 256 + F.lane * 4); ss += y[i][0] * y[i][0] + y[i][1] * y[i][1] + y[i][2] * y[i][2] + y[i][3] * y[i][3]; }
            ss = wave_sum(ss);
            const float r = 1.0f / sqrtf(ss * (1.0f / D) + EPS);
#pragma unroll
            for (int i = 0; i < 8; ++i) {
                const int col = i * 256 + F.lane * 4;
                const f32x4 g = *(const f32x4*)(npost + col); const f32x4 gt = *(const f32x4*)(modl + col);
#pragma unroll
                for (int e = 0; e < 4; ++e) x[i][e] += gt[e] * (y[i][e] * r * g[e]);
                *(f32x4*)(F.out + (size_t)t * D + col) = x[i];
            }
        }
        if (Lnext >= 0) {
            float ss = 0.f;
#pragma unroll
            for (int i = 0; i < 8; ++i) ss += x[i][0] * x[i][0] + x[i][1] * x[i][1] + x[i][2] * x[i][2] + x[i][3] * x[i][3];
            ss = wave_sum(ss);
            const float r = 1.0f / sqrtf(ss * (1.0f / D) + EPS);
#pragma unroll
            for (int i = 0; i < 8; ++i) {
                const int col = i * 256 + F.lane * 4;
                const f32x4 g = *(const f32x4*)(npre + col); const f32x4 sc = *(const f32x4*)(modl + 2048 + col); const f32x4 sh = *(const f32x4*)(modl + 4096 + col);
                h16x4 hv;
#pragma unroll
                for (int e = 0; e < 4; ++e) hv[e] = (h16)((x[i][e] * r * g[e]) * (1.0f + sc[e]) + sh[e]);
                *(h16x4*)(H + (size_t)t * D + col) = hv;
            }
        }
    }
    if (Lnext > 0) conv_layer_weights(F, A, Lnext);
}

__device__ __forceinline__ void phase_nsa_cmp_a(const Frame& F) {
    const int u = F.bid, have = u < 64, kv = (u >> 5) & 1, mt = (u >> 2) & 7, kp = u & 3;
    const h16* A = (const h16*)(F.ws + WS_QKV) + (size_t)16 * S * 128 + (size_t)kv * 4 * S * 128 + kp * 1024;
    const h16* Bt = (const h16*)(F.ws + WS_W1T) + (size_t)kv * 256 * 4096 + kp * 1024;
    pg8::Gemm g{A, Bt, 2048, 256, 1024, 2048, 4096}; pg8::OneUnit So{mt, 0, have};
    pg8::EpiStore E{(float*)(F.ws + WS_OR) + (size_t)(kv * 4 + kp) * 2048 * 256, 256, 1};
    pg8::gemm_phase<pg8::EpiStore, pg8::OneUnit, true, true>((LAS unsigned char*)F.lds, g, So, E);
}
__device__ __forceinline__ void phase_nsa_cmp_b(const Frame& F, const Args& A) {
    float* hid = (float*)F.lds;
    const float* part = (const float*)(F.ws + WS_OR); const float* b1 = (const float*)(F.ws + WS_CMPB);
    for (int it = F.bid; it < 256; it += F.G) {
        const int kv = it >> 7, r0 = (it & 127) * 16;
        const float* W2 = kv ? A.in[15] : A.in[13];
        h16* dst = (h16*)(F.ws + (kv ? WS_VCMP : WS_KCMP));
        __syncthreads();
        for (int i = F.tid; i < 16 * 256; i += NTHREADS) {
            const int r = r0 + (i >> 8), j = i & 255; float v = 0.f;
#pragma unroll
            for (int sl = 0; sl < 16; ++sl) v += b1[sl * 512 + kv * 256 + j];
#pragma unroll
            for (int kp = 0; kp < 4; ++kp) v += part[((size_t)(kv * 4 + kp) * 2048 + r) * 256 + j];
            hid[i] = silu_f(v);
        }
        __syncthreads();
        const int d = F.tid & 127, rq = F.tid >> 7;
        float a[4] = {0.f, 0.f, 0.f, 0.f};
#pragma unroll 4
        for (int j = 0; j < 256; ++j) { const float w = W2[j * 128 + d];
#pragma unroll
            for (int e = 0; e < 4; ++e) a[e] += hid[(rq * 4 + e) * 256 + j] * w; }
#pragma unroll
        for (int e = 0; e < 4; ++e) { const int r = r0 + rq * 4 + e; dst[(size_t)r * 128 + d] = ((r & 511) < NC) ? (h16)a[e] : (h16)0.f; }
    }
}

namespace fa {
typedef float f32x16 __attribute__((ext_vector_type(16)));
typedef unsigned u32x2 __attribute__((ext_vector_type(2)));
constexpr float LOG2E = 1.4426950408889634f;
constexpr int KROW = 272, VROW = 320;
constexpr int KT_BYTES = 64 * KROW, BUF_BYTES = KT_BYTES + 64 * VROW;
typedef short s16x4v __attribute__((__vector_size__(4 * sizeof(short))));
constexpr int LDS_IMP = 2 * BUF_BYTES;
constexpr int LDS_SELW = LDS_IMP + 32768;
constexpr int LDS_SV = LDS_SELW + 1024;
static_assert(LDS_SV + 4096 <= MISC_OFF, "attention LDS map");

struct Stage { u32x4 k[2], v[2]; };
__device__ __forceinline__ void stage_load(Stage& st, const h16* Kg, const h16* VTg, int j, int tid) {
    asm volatile("" : "+v"(tid));
#pragma unroll
    for (int i = 0; i < 2; ++i) { const int idx = tid + 512 * i;
        st.k[i] = *(const u32x4*)(Kg + (size_t)(j * 64 + (idx >> 4)) * 128 + (idx & 15) * 8);
        st.v[i] = *(const u32x4*)(VTg + (size_t)(j * 64 + (idx >> 4)) * 128 + (idx & 15) * 8); }
}
__device__ __forceinline__ void stage_write(const Stage& st, LAS unsigned char* buf, int tid) {
    asm volatile("" : "+v"(tid));
#pragma unroll
    for (int i = 0; i < 2; ++i) { const int idx = tid + 512 * i;
        *(LAS u32x4*)(buf + (idx >> 4) * KROW + (idx & 15) * 16) = st.k[i];
        *(LAS u32x4*)(buf + KT_BYTES + (idx >> 4) * VROW + (idx & 15) * 16) = st.v[i]; }
}

template <int MODE>
__device__ __forceinline__ void tile_compute(const LAS unsigned char* buf, int j, const h16x8 (&qf)[8], f32x16 (&o)[4], float& m, float& l,
                                             bool on, int lo, int hi, int lane, float inv_l, LAS float* imp_q) {
    const int r31 = lane & 31, h = lane >> 5, k0 = j * 64;
    const bool need = on && (k0 <= hi) && (k0 + 63 >= lo);
    if (__ballot(need) == 0ull) return;
    f32x16 s0, s1;
#pragma unroll
    for (int r = 0; r < 16; ++r) { s0[r] = 0.f; s1[r] = 0.f; }
    const LAS unsigned char* kp = buf + r31 * KROW + h * 16;
    {
        h16x8 ka[2][4];
#pragma unroll
        for (int e = 0; e < 2; ++e) { ka[0][2 * e] = *(const LAS h16x8*)(kp + e * 32); ka[0][2 * e + 1] = *(const LAS h16x8*)(kp + 32 * KROW + e * 32); }
#pragma unroll
        for (int g = 0; g < 4; ++g) {
            if (g < 3) {
#pragma unroll
                for (int e = 0; e < 2; ++e) { ka[(g + 1) & 1][2 * e] = *(const LAS h16x8*)(kp + (2 * (g + 1) + e) * 32); ka[(g + 1) & 1][2 * e + 1] = *(const LAS h16x8*)(kp + 32 * KROW + (2 * (g + 1) + e) * 32); }
            }
#pragma unroll
            for (int e = 0; e < 2; ++e) {
                s0 = __builtin_amdgcn_mfma_f32_32x32x16_f16(ka[g & 1][2 * e], qf[2 * g + e], s0, 0, 0, 0);
                s1 = __builtin_amdgcn_mfma_f32_32x32x16_f16(ka[g & 1][2 * e + 1], qf[2 * g + e], s1, 0, 0, 0);
            }
            __builtin_amdgcn_sched_barrier(0);
        }
    }
    const bool full = (k0 >= lo) && (k0 + 63 <= hi);
    const bool simple = (__ballot(on && !full) == 0ull);
    float tm;
    if (simple) {
        tm = fmaxf(s0[0], s1[0]);
#pragma unroll
        for (int r = 1; r < 16; ++r) tm = fmaxf(tm, fmaxf(s0[r], s1[r]));
        if (!on) tm = NEGF;
    } else {
        tm = NEGF;
#pragma unroll
        for (int r = 0; r < 16; ++r) {
            const int key0 = k0 + (r & 3) + 8 * (r >> 2) + 4 * h, key1 = key0 + 32;
            const bool v0 = on && key0 >= lo && key0 <= hi, v1 = on && key1 >= lo && key1 <= hi;
            s0[r] = v0 ? s0[r] : NEGF; s1[r] = v1 ? s1[r] : NEGF;
            tm = fmaxf(tm, fmaxf(s0[r], s1[r]));
        }
    }
    const float tmax = (tm > 0.5f * NEGF) ? tm * LOG2E : NEGF;
    if (MODE != 2) {
        const float tmx = fmaxf(tmax, __shfl_xor(tmax, 32));
        const float m_new = fmaxf(m, tmx);
        const float alpha = __builtin_amdgcn_exp2f(m - m_new);
        const float off = (simple && !on) ? BIGF : m_new;
        float sum = 0.f;
#pragma unroll
        for (int r = 0; r < 16; ++r) {
            s0[r] = __builtin_amdgcn_exp2f(__builtin_fmaf(s0[r], LOG2E, -off));
            s1[r] = __builtin_amdgcn_exp2f(__builtin_fmaf(s1[r], LOG2E, -off));
            sum += s0[r] + s1[r];
        }
        l = l * alpha + sum;
        const bool grew = m_new > m; m = m_new;
        if (MODE == 1) return;
        if (__ballot(grew) != 0ull) {
#pragma unroll
            for (int dt = 0; dt < 4; ++dt) o[dt] = o[dt] * alpha;
        }
    } else {
        const float off = (simple && !on) ? BIGF : m;
#pragma unroll
        for (int r = 0; r < 16; ++r) {
            s0[r] = __builtin_amdgcn_exp2f(__builtin_fmaf(s0[r], LOG2E, -off)) * inv_l;
            s1[r] = __builtin_amdgcn_exp2f(__builtin_fmaf(s1[r], LOG2E, -off)) * inv_l;
        }
#pragma unroll
        for (int c = 0; c < 4; ++c) {
            const int sa = 16 * j + 2 * c + h, sb = sa + 8;
            const float a0 = s0[4 * c] + s0[4 * c + 1] + s0[4 * c + 2] + 0.5f * s0[4 * c + 3], b0 = 0.5f * s0[4 * c + 3];
            const float a1 = s1[4 * c] + s1[4 * c + 1] + s1[4 * c + 2] + 0.5f * s1[4 * c + 3], b1 = 0.5f * s1[4 * c + 3];
            (void)__hip_atomic_fetch_add(imp_q + sa, a0, __ATOMIC_RELAXED, __HIP_MEMORY_SCOPE_WORKGROUP); if (sa + 1 < 128) (void)__hip_atomic_fetch_add(imp_q + sa + 1, b0, __ATOMIC_RELAXED, __HIP_MEMORY_SCOPE_WORKGROUP);
            (void)__hip_atomic_fetch_add(imp_q + sb, a1, __ATOMIC_RELAXED, __HIP_MEMORY_SCOPE_WORKGROUP); if (sb + 1 < 128) (void)__hip_atomic_fetch_add(imp_q + sb + 1, b1, __ATOMIC_RELAXED, __HIP_MEMORY_SCOPE_WORKGROUP);
        }
    }
    h16x8 pb[2][2];
#pragma unroll
    for (int sp = 0; sp < 2; ++sp)
#pragma unroll
        for (int jj = 0; jj < 8; ++jj) { pb[0][sp][jj] = (h16)s0[8 * sp + jj]; pb[1][sp][jj] = (h16)s1[8 * sp + jj]; }
    const LAS unsigned char* vbase = buf + KT_BYTES + (4 * h + ((lane & 15) >> 2)) * VROW + (16 * ((lane >> 4) & 1) + 4 * (lane & 3)) * 2;
    {
        s16x4v vr[2][8];
#pragma unroll
        for (int f = 0; f < 4; ++f) { const LAS unsigned char* vp = vbase + 16 * f * VROW;
            vr[0][2 * f] = __builtin_amdgcn_ds_read_tr16_b64_v4i16((LAS s16x4v*)vp); vr[0][2 * f + 1] = __builtin_amdgcn_ds_read_tr16_b64_v4i16((LAS s16x4v*)(vp + 8 * VROW)); }
#pragma unroll
        for (int dt = 0; dt < 4; ++dt) {
            if (dt < 3) {
#pragma unroll
                for (int f = 0; f < 4; ++f) { const LAS unsigned char* vp = vbase + 16 * f * VROW + 64 * (dt + 1);
                    vr[(dt + 1) & 1][2 * f] = __builtin_amdgcn_ds_read_tr16_b64_v4i16((LAS s16x4v*)vp); vr[(dt + 1) & 1][2 * f + 1] = __builtin_amdgcn_ds_read_tr16_b64_v4i16((LAS s16x4v*)(vp + 8 * VROW)); }
            }
#pragma unroll
            for (int f = 0; f < 4; ++f) {
                const h16x4 l4 = __builtin_bit_cast(h16x4, vr[dt & 1][2 * f]), h4 = __builtin_bit_cast(h16x4, vr[dt & 1][2 * f + 1]);
                h16x8 va; va[0] = l4[0]; va[1] = l4[1]; va[2] = l4[2]; va[3] = l4[3]; va[4] = h4[0]; va[5] = h4[1]; va[6] = h4[2]; va[7] = h4[3];
                o[dt] = __builtin_amdgcn_mfma_f32_32x32x16_f16(va, pb[f >> 1][f & 1], o[dt], 0, 0, 0);
            }
            __builtin_amdgcn_sched_barrier(0);
        }
    }
}

template <int MODE, class OnFn>
__device__ __forceinline__ void stream(LAS unsigned char* lds, const h16* Kg, const h16* VTg, int jlo, int jhi, const h16x8 (&qf)[8],
                                       f32x16 (&o)[4], float& m, float& l, int lo, int hi, const OnFn& on_fn, int tid, int lane, float inv_l, LAS float* imp_q) {
    if (jlo >= jhi) return;
    Stage st;
    stage_load(st, Kg, VTg, jlo, tid);
    stage_write(st, lds, tid);
    __syncthreads();
    for (int j = jlo; j < jhi; ++j) {
        const int cur = (j - jlo) & 1;
        if (j + 1 < jhi) stage_load(st, Kg, VTg, j + 1, tid);
        tile_compute<MODE>(lds + cur * BUF_BYTES, j, qf, o, m, l, on_fn(j), lo, hi, lane, inv_l, imp_q);
        if (j + 1 < jhi) stage_write(st, lds + (cur ^ 1) * BUF_BYTES, tid);
        __syncthreads();
    }
}

__device__ __forceinline__ void load_q(h16x8 (&qf)[8], const h16* qrow, int h) {
#pragma unroll
    for (int s = 0; s < 8; ++s) qf[s] = *(const h16x8*)(qrow + 16 * s + 8 * h);
}
__device__ __forceinline__ void zero_o(f32x16 (&o)[4]) {
#pragma unroll
    for (int dt = 0; dt < 4; ++dt)
#pragma unroll
        for (int r = 0; r < 16; ++r) o[dt][r] = 0.f;
}
}

struct MobaOn { unsigned selmask; int b; __device__ __forceinline__ bool operator()(int j) const { const int jb = j >> 2; return jb == b ? true : (((selmask >> jb) & 1u) != 0u); } };
__device__ __forceinline__ void phase_moba_attn_mfma(const Frame& F) {
    const h16* Q = (const h16*)(F.ws + WS_QKV); const h16* K = Q + (size_t)16 * S * 128; const h16* VT = K + (size_t)16 * S * 128; const h16* Z = VT + (size_t)16 * S * 128;
    const float* kmean = (const float*)(F.ws + WS_KMEAN);
    h16* OZ = (h16*)(F.ws + WS_OZ);
    LAS unsigned char* lds = (LAS unsigned char*)F.lds;
    const int lane = F.lane, r31 = lane & 31, h = lane >> 5;
    for (int it = F.bid; it < 256; it += F.G) {
        const int head = it >> 4, pi = it & 15;
#pragma unroll 1
        for (int half = 0; half < 2; ++half) {
            const int b = half ? 31 - pi : pi;
            const int t = b * 256 + F.wave * 32 + r31;
            h16x8 qf[8]; fa::load_q(qf, Q + ((size_t)head * S + t) * 128, h);
            float v0 = NEGF, v1 = NEGF, v2 = NEGF; int i0 = -1, i1 = -1, i2 = -1;
            for (int jb = 0; jb < b; ++jb) {
                const float* km = kmean + ((size_t)head * 32 + jb) * 128 + 8 * h;
                float d = 0.f;
#pragma unroll
                for (int s = 0; s < 8; ++s) { const f32x4 ka = *(const f32x4*)(km + 16 * s) + *(const f32x4*)(km + 65536 + 16 * s), kb = *(const f32x4*)(km + 16 * s + 4) + *(const f32x4*)(km + 65536 + 16 * s + 4);
                    d += (float)qf[s][0] * ka[0] + (float)qf[s][1] * ka[1] + (float)qf[s][2] * ka[2] + (float)qf[s][3] * ka[3] + (float)qf[s][4] * kb[0] + (float)qf[s][5] * kb[1] + (float)qf[s][6] * kb[2] + (float)qf[s][7] * kb[3]; }
                d += __shfl_xor(d, 32);
                if (d > v0) { v2 = v1; i2 = i1; v1 = v0; i1 = i0; v0 = d; i0 = jb; }
                else if (d > v1) { v2 = v1; i2 = i1; v1 = d; i1 = jb; }
                else if (d > v2) { v2 = d; i2 = jb; }
            }
            MobaOn on; on.b = b; on.selmask = (i0 >= 0 ? 1u << i0 : 0u) | (i1 >= 0 ? 1u << i1 : 0u) | (i2 >= 0 ? 1u << i2 : 0u);
            fa::f32x16 o[4]; fa::zero_o(o); float m = NEGF, l = 0.f;
            fa::stream<0>(lds, K + (size_t)head * S * 128, VT + (size_t)head * S * 128, 0, 4 * b + 4, qf, o, m, l, 0, t, on, F.tid, lane, 0.f, (LAS float*)nullptr);
            l += __shfl_xor(l, 32);
            const float inv = 1.0f / fmaxf(l, 1e-30f);
#pragma unroll
            for (int dt = 0; dt < 4; ++dt)
#pragma unroll
                for (int c = 0; c < 4; ++c) {
                    const int d = 32 * dt + 8 * c + 4 * h; const size_t off = (size_t)t * 2048 + head * 128 + d;
                    const h16x4 zz = *(const h16x4*)(Z + off); h16x4 ov;
#pragma unroll
                    for (int e = 0; e < 4; ++e) ov[e] = (h16)(o[dt][4 * c + e] * inv * (float)zz[e]);
                    *(h16x4*)(OZ + off) = ov;
                }
        }
    }
}

struct AllOn { __device__ __forceinline__ bool operator()(int) const { return true; } };
struct SelOn { const LAS unsigned* w; __device__ __forceinline__ bool operator()(int j) const { return ((w[j >> 5] >> (j & 31)) & 1u) != 0u; } };
__device__ __forceinline__ void phase_nsa_attn_mfma(const Frame& F) {
    const h16* Q = (const h16*)(F.ws + WS_QKV); const h16* KVb = Q + (size_t)16 * S * 128;
    const h16* Z = (const h16*)(F.ws + WS_QKV + 96 * MiB);
    const float* gates = (const float*)(F.ws + WS_GATES);
    const h16* KCMP = (const h16*)(F.ws + WS_KCMP); const h16* VCMPT = (const h16*)(F.ws + WS_VCMP);
    h16* OZ = (h16*)(F.ws + WS_OZ);
    LAS unsigned char* lds = (LAS unsigned char*)F.lds;
    LAS float* imp = (LAS float*)(lds + fa::LDS_IMP); LAS unsigned* selw = (LAS unsigned*)(lds + fa::LDS_SELW); LAS float* sv = (LAS float*)(lds + fa::LDS_SV) + F.wave * 128;
    const int lane = F.lane, r31 = lane & 31, h = lane >> 5, hh = F.wave & 3, qsub = F.wave >> 2;
    for (int it = F.bid; it < 256; it += F.G) {
        const int g = it >> 6, pi = it & 63, head = 4 * g + hh;
#pragma unroll 1
        for (int half = 0; half < 2; ++half) {
            const int c64 = half ? 127 - pi : pi;
            const int ql = 32 * qsub + r31, t = c64 * 64 + ql;
            h16x8 qf[8]; fa::load_q(qf, Q + ((size_t)head * S + t) * 128, h);
            fa::f32x16 o[4]; float m, l;
            for (int i = F.tid; i < 64 * 128; i += NTHREADS) imp[i] = 0.f;
            const int nval = (t >= 31) ? (((t - 31) >> 4) + 1 < NC ? ((t - 31) >> 4) + 1 : NC) : 0;
            const int tl = c64 * 64 + 63; const int nval_max = (tl >= 31) ? (((tl - 31) >> 4) + 1 < NC ? ((tl - 31) >> 4) + 1 : NC) : 0;
            const int jc = (nval_max + 63) >> 6;
            fa::zero_o(o); m = NEGF; l = 0.f;
            fa::stream<1>(lds, KCMP + (size_t)g * 512 * 128, VCMPT + (size_t)g * 512 * 128, 0, jc, qf, o, m, l, 0, nval - 1, AllOn(), F.tid, lane, 0.f, (LAS float*)nullptr);
            l += __shfl_xor(l, 32);
            { const float invl = 1.0f / fmaxf(l, 1e-30f); float l2 = 0.f;
              fa::stream<2>(lds, KCMP + (size_t)g * 512 * 128, VCMPT + (size_t)g * 512 * 128, 0, jc, qf, o, m, l2, 0, nval - 1, AllOn(), F.tid, lane, invl, imp + ql * 128); }
            const float g0 = gates[(size_t)t * 48 + head * 3 + 0];
#pragma unroll
            for (int dt = 0; dt < 4; ++dt)
#pragma unroll
                for (int c = 0; c < 4; ++c) { h16x4 ov;
#pragma unroll
                    for (int e = 0; e < 4; ++e) ov[e] = (h16)(o[dt][4 * c + e] * g0);
                    *(h16x4*)(OZ + (size_t)t * 2048 + head * 128 + 32 * dt + 8 * c + 4 * h) = ov; }
            __syncthreads();
            for (int qq = 0; qq < 8; ++qq) {
                const int q = F.wave * 8 + qq;
                float myv[2];
#pragma unroll
                for (int c = 0; c < 2; ++c) { const int s = lane + 64 * c; const bool valid = s <= c64, forced = (s == 0) || (s == c64) || (s == c64 - 1);
                    myv[c] = valid ? (forced ? BIGF : imp[q * 128 + s]) : NEGF; sv[s] = myv[c]; }
                wave_lds_fence();
                int rank0 = 0, rank1 = 0;
                for (int s2 = 0; s2 < 128; ++s2) { const float v2 = sv[s2];
                    rank0 += (v2 > myv[0] || (v2 == myv[0] && s2 < lane)) ? 1 : 0; rank1 += (v2 > myv[1] || (v2 == myv[1] && s2 < lane + 64)) ? 1 : 0; }
                const unsigned long long m0 = __ballot(rank0 < 16 && lane <= c64), m1 = __ballot(rank1 < 16 && (lane + 64) <= c64);
                if (lane == 0) { selw[q * 4 + 0] = (unsigned)m0; selw[q * 4 + 1] = (unsigned)(m0 >> 32); selw[q * 4 + 2] = (unsigned)m1; selw[q * 4 + 3] = (unsigned)(m1 >> 32); }
                wave_lds_fence();
            }
            __syncthreads();
            SelOn son; son.w = selw + ql * 4;
            fa::zero_o(o); m = NEGF; l = 0.f;
            fa::stream<0>(lds, KVb + ((size_t)2 * 4 + g) * S * 128, KVb + ((size_t)3 * 4 + g) * S * 128, 0, c64 + 1, qf, o, m, l, 0, t, son, F.tid, lane, 0.f, (LAS float*)nullptr);
            l += __shfl_xor(l, 32);
            { const float sc = gates[(size_t)t * 48 + head * 3 + 1] / fmaxf(l, 1e-30f);
#pragma unroll
              for (int dt = 0; dt < 4; ++dt)
#pragma unroll
                  for (int c = 0; c < 4; ++c) { h16* p = OZ + (size_t)t * 2048 + head * 128 + 32 * dt + 8 * c + 4 * h; const h16x4 pv = *(const h16x4*)p; h16x4 ov;
#pragma unroll
                      for (int e = 0; e < 4; ++e) ov[e] = (h16)((float)pv[e] + o[dt][4 * c + e] * sc);
                      *(h16x4*)p = ov; } }
            fa::zero_o(o); m = NEGF; l = 0.f;
            fa::stream<0>(lds, KVb + ((size_t)4 * 4 + g) * S * 128, KVb + ((size_t)5 * 4 + g) * S * 128, (c64 >= 8 ? c64 - 8 : 0), c64 + 1, qf, o, m, l, t - 511, t, AllOn(), F.tid, lane, 0.f, (LAS float*)nullptr);
            l += __shfl_xor(l, 32);
            const float sc2 = gates[(size_t)t * 48 + head * 3 + 2] / fmaxf(l, 1e-30f);
#pragma unroll
            for (int dt = 0; dt < 4; ++dt)
#pragma unroll
                for (int c = 0; c < 4; ++c) {
                    const int d = 32 * dt + 8 * c + 4 * h; const size_t off = (size_t)t * 2048 + head * 128 + d;
                    const h16x4 zz = *(const h16x4*)(Z + off); const h16x4 pv = *(const h16x4*)(OZ + off); h16x4 ov;
#pragma unroll
                    for (int e = 0; e < 4; ++e) ov[e] = (h16)(((float)pv[e] + o[dt][4 * c + e] * sc2) * (float)zz[e]);
                    *(h16x4*)(OZ + off) = ov;
                }
        }
    }
}

namespace rt {
typedef float f32x16 __attribute__((ext_vector_type(16)));
typedef short s16x4v __attribute__((__vector_size__(4 * sizeof(short))));
constexpr int SP = 144, STILE = 128 * SP;
constexpr int VP = 1088, VTILE = 32 * VP;
__device__ __forceinline__ h16x8 tr16(const LAS unsigned char* p0, const LAS unsigned char* p1) {
    const s16x4v a = __builtin_amdgcn_ds_read_tr16_b64_v4i16((LAS s16x4v*)p0), b = __builtin_amdgcn_ds_read_tr16_b64_v4i16((LAS s16x4v*)p1);
    const h16x4 x = __builtin_bit_cast(h16x4, a), y = __builtin_bit_cast(h16x4, b);
    h16x8 r; r[0] = x[0]; r[1] = x[1]; r[2] = x[2]; r[3] = x[3]; r[4] = y[0]; r[5] = y[1]; r[6] = y[2]; r[7] = y[3]; return r;
}
}
__device__ __forceinline__ void phase_ret_scan_mfma(const Frame& F, const Args& A) {
    const h16* RQ = (const h16*)(F.ws + WS_QKV); const h16* RK = RQ + (size_t)8 * S * 256; const h16* RV = RK + (size_t)8 * S * 256;
    h16* ST = (h16*)(F.ws + WS_P);
    LAS unsigned char* lds = (LAS unsigned char*)F.lds;
    const int lane = F.lane, g = lane >> 4, q = (lane & 15) >> 2, p = lane & 3, mr = F.wave >> 1, nc0 = (F.wave & 1) * 2;
    for (int it = F.bid; it < 256; it += F.G) {
        const int h = it >> 5, dk0 = ((it >> 3) & 3) * 64, dv0 = (it & 7) * 64;
        const float lg = A.lg2g[h], carry = __builtin_amdgcn_exp2f(128.f * lg);
        f32x4 acc[2] = {(f32x4){0.f, 0.f, 0.f, 0.f}, (f32x4){0.f, 0.f, 0.f, 0.f}};
        u32x4 kreg[2], vreg[2];
#define RT_LOAD(c) do { int tid_ = F.tid; asm volatile("" : "+v"(tid_)); _Pragma("unroll") for (int i = 0; i < 2; ++i) { const int idx = tid_ + 512 * i, row = idx >> 3, c16 = idx & 7; \
            kreg[i] = *(const u32x4*)(RK + ((size_t)h * S + (c) * 128 + row) * 256 + dk0 + c16 * 8); vreg[i] = *(const u32x4*)(RV + ((size_t)h * S + (c) * 128 + row) * 512 + dv0 + c16 * 8); } } while (0)
#define RT_WRITE(b) do { int tid_ = F.tid; asm volatile("" : "+v"(tid_)); _Pragma("unroll") for (int i = 0; i < 2; ++i) { const int idx = tid_ + 512 * i, row = idx >> 3, c16 = idx & 7; \
            const float w = __builtin_amdgcn_exp2f((float)(127 - row) * lg); h16x8 kk = __builtin_bit_cast(h16x8, kreg[i]); \
            _Pragma("unroll") for (int e = 0; e < 8; ++e) kk[e] = (h16)((float)kk[e] * w); \
            *(LAS h16x8*)(lds + (b) * 2 * rt::STILE + row * rt::SP + c16 * 16) = kk; *(LAS u32x4*)(lds + (b) * 2 * rt::STILE + rt::STILE + row * rt::SP + c16 * 16) = vreg[i]; } } while (0)
        __syncthreads();
        RT_LOAD(0); RT_WRITE(0);
        __syncthreads();
        for (int c = 0; c < 64; ++c) {
            const int cur = c & 1;
#pragma unroll
            for (int n = 0; n < 2; ++n) { h16x4 o; o[0] = (h16)acc[n][0]; o[1] = (h16)acc[n][1]; o[2] = (h16)acc[n][2]; o[3] = (h16)acc[n][3];
                *(h16x4*)(ST + (((size_t)(h * 64 + c)) * 512 + dv0 + 16 * (nc0 + n) + (lane & 15)) * 256 + dk0 + 16 * mr + 4 * g) = o; }
            if (c + 1 < 64) RT_LOAD(c + 1);
            acc[0] = acc[0] * carry; acc[1] = acc[1] * carry;
            const LAS unsigned char* kt = lds + cur * 2 * rt::STILE + (8 * g + q) * rt::SP + (16 * mr + 4 * p) * 2;
            const LAS unsigned char* vt = lds + cur * 2 * rt::STILE + rt::STILE + (8 * g + q) * rt::SP + (16 * nc0 + 4 * p) * 2;
#pragma unroll
            for (int ks = 0; ks < 4; ++ks) {
                const h16x8 a = rt::tr16(kt + 32 * ks * rt::SP, kt + (32 * ks + 4) * rt::SP);
                const h16x8 b0 = rt::tr16(vt + 32 * ks * rt::SP, vt + (32 * ks + 4) * rt::SP);
                const h16x8 b1 = rt::tr16(vt + 32 * ks * rt::SP + 32, vt + (32 * ks + 4) * rt::SP + 32);
                acc[0] = __builtin_amdgcn_mfma_f32_16x16x32_f16(a, b0, acc[0], 0, 0, 0);
                acc[1] = __builtin_amdgcn_mfma_f32_16x16x32_f16(a, b1, acc[1], 0, 0, 0);
            }
            if (c + 1 < 64) RT_WRITE(cur ^ 1);
            __syncthreads();
        }
#undef RT_LOAD
#undef RT_WRITE
    }
}

__device__ __forceinline__ void phase_ret_out_mfma(const Frame& F, const Args& A) {
    const h16* RQ = (const h16*)(F.ws + WS_QKV); const h16* RK = RQ + (size_t)8 * S * 256; const h16* RV = RK + (size_t)8 * S * 256; const h16* RG = RV + (size_t)8 * S * 512;
    const h16* ST = (const h16*)(F.ws + WS_P);
    h16* OZ = (h16*)(F.ws + WS_OZ);
    LAS unsigned char* lds = (LAS unsigned char*)F.lds;
    LAS float* stats = (LAS float*)(lds + 2 * rt::VTILE);
    const int lane = F.lane, r31 = lane & 31, hh = lane >> 5, itl = F.wave & 3, dvh = F.wave >> 2;
    for (int it = F.bid; it < 512; it += F.G) {
        const int h = it >> 6, c = it & 63, il = 32 * itl + r31, tok = c * 128 + il;
        const float lg = A.lg2g[h];
        rt::f32x16 acc[8];
#pragma unroll
        for (int r = 0; r < 8; ++r)
#pragma unroll
            for (int e = 0; e < 16; ++e) acc[r][e] = 0.f;
        const h16* qrow = RQ + ((size_t)h * S + tok) * 256 + 8 * hh;
        u32x4 vreg[4];
#define RO_LOAD(jt) do { int tid_ = F.tid; asm volatile("" : "+v"(tid_)); _Pragma("unroll") for (int i = 0; i < 4; ++i) { const int idx = tid_ + 512 * i; \
            vreg[i] = *(const u32x4*)(RV + ((size_t)h * S + c * 128 + 32 * (jt) + (idx >> 6)) * 512 + (idx & 63) * 8); } } while (0)
#define RO_WRITE(b) do { int tid_ = F.tid; asm volatile("" : "+v"(tid_)); _Pragma("unroll") for (int i = 0; i < 4; ++i) { const int idx = tid_ + 512 * i; \
            *(LAS u32x4*)(lds + (b) * rt::VTILE + (idx >> 6) * rt::VP + (idx & 63) * 16) = vreg[i]; } } while (0)
        __syncthreads();
        RO_LOAD(0);
        {
            const h16* srow = ST + (((size_t)(h * 64 + c)) * 512 + dvh * 256 + r31) * 256 + 8 * hh;
#pragma unroll 2
            for (int ks = 0; ks < 16; ++ks) {
                const h16x8 qf = *(const h16x8*)(qrow + 16 * ks);
#pragma unroll
                for (int r = 0; r < 8; ++r) { const h16x8 a = *(const h16x8*)(srow + (size_t)r * 32 * 256 + 16 * ks); acc[r] = __builtin_amdgcn_mfma_f32_32x32x16_f16(a, qf, acc[r], 0, 0, 0); }
            }
            const float rdec = __builtin_amdgcn_exp2f((float)(il + 1) * lg);
#pragma unroll
            for (int r = 0; r < 8; ++r) acc[r] = acc[r] * rdec;
        }
        RO_WRITE(0);
        __syncthreads();
        for (int jt = 0; jt < 4; ++jt) {
            const int cur = jt & 1;
            if (jt + 1 < 4) RO_LOAD(jt + 1);
            if (jt <= itl) {
                rt::f32x16 sT;
#pragma unroll
                for (int e = 0; e < 16; ++e) sT[e] = 0.f;
                const h16* krow = RK + ((size_t)h * S + c * 128 + 32 * jt + r31) * 256 + 8 * hh;
#pragma unroll 4
                for (int ks = 0; ks < 16; ++ks) sT = __builtin_amdgcn_mfma_f32_32x32x16_f16(*(const h16x8*)(krow + 16 * ks), *(const h16x8*)(qrow + 16 * ks), sT, 0, 0, 0);
                h16x8 pb[2];
#pragma unroll
                for (int e = 0; e < 16; ++e) { const int kl = 32 * jt + (e & 3) + 8 * (e >> 2) + 4 * hh, df = il - kl;
                    const float pv = (df >= 0) ? sT[e] * __builtin_amdgcn_exp2f((float)df * lg) : 0.f; pb[e >> 3][e & 7] = (h16)pv; }
                const LAS unsigned char* vbase = lds + cur * rt::VTILE + (4 * hh + ((lane & 15) >> 2)) * rt::VP + (dvh * 256 + 16 * ((lane >> 4) & 1) + 4 * (lane & 3)) * 2;
#pragma unroll
                for (int r = 0; r < 8; ++r) {
#pragma unroll
                    for (int sp = 0; sp < 2; ++sp) { const LAS unsigned char* vp = vbase + 16 * sp * rt::VP + 64 * r;
                        acc[r] = __builtin_amdgcn_mfma_f32_32x32x16_f16(rt::tr16(vp, vp + 8 * rt::VP), pb[sp], acc[r], 0, 0, 0); }
                    if (r & 1) __builtin_amdgcn_sched_barrier(0);
                }
            }
            if (jt + 1 < 4) RO_WRITE(cur ^ 1);
            __syncthreads();
        }
#undef RO_LOAD
#undef RO_WRITE
        float s1 = 0.f, s2 = 0.f;
#pragma unroll
        for (int r = 0; r < 8; ++r)
#pragma unroll
            for (int e = 0; e < 16; ++e) { s1 += acc[r][e]; s2 += acc[r][e] * acc[r][e]; }
        s1 += __shfl_xor(s1, 32); s2 += __shfl_xor(s2, 32);
        if (hh == 0) { stats[(F.wave * 32 + r31) * 2] = s1; stats[(F.wave * 32 + r31) * 2 + 1] = s2; }
        __syncthreads();
        s1 += stats[((F.wave ^ 4) * 32 + r31) * 2]; s2 += stats[((F.wave ^ 4) * 32 + r31) * 2 + 1];
        const float mu = s1 * (1.0f / 512.0f), var = fmaxf(s2 * (1.0f / 512.0f) - mu * mu, 0.f), rs = 1.0f / sqrtf(var + EPS);
#pragma unroll
        for (int r = 0; r < 8; ++r)
#pragma unroll
            for (int cq = 0; cq < 4; ++cq) {
                const size_t off = (size_t)tok * 4096 + h * 512 + dvh * 256 + 32 * r + 8 * cq + 4 * hh;
                const h16x4 gv = *(const h16x4*)(RG + off); h16x4 ov;
#pragma unroll
                for (int e = 0; e < 4; ++e) ov[e] = (h16)((float)gv[e] * ((acc[r][4 * cq + e] - mu) * rs));
                *(h16x4*)(OZ + off) = ov;
            }
    }
}

template <int KIND>
__device__ __forceinline__ void phase_gemm_proj(const Frame& F, int N) {
    pg8::Gemm g{(const h16*)(F.ws + WS_H), (const h16*)(F.ws + WS_WTIN), S, N, 2048, 2048, 2048}; pg8::StaticOrder So; So.init(S, N, F.G, F.bid);
    pg8::EpiProj<KIND> E{F.ws};
    pg8::gemm_phase<pg8::EpiProj<KIND>, pg8::StaticOrder, true, true>((LAS unsigned char*)F.lds, g, So, E);
}
__device__ __forceinline__ void phase_gemm(const Frame& F, const h16* A, const h16* Bt, int N, int K, void* O, int ldc, int f32out) {
    pg8::Gemm g{A, Bt, S, N, K, K, K}; pg8::StaticOrder So; So.init(S, N, F.G, F.bid);
    pg8::EpiStore E{O, ldc, f32out};
    pg8::gemm_phase<pg8::EpiStore, pg8::StaticOrder, true, true>((LAS unsigned char*)F.lds, g, So, E);
}

constexpr int NPHASE = 2 + 8 * DEPTH;
__host__ __device__ inline bool phase_exists(int p) {
    if (p < 2) return true;
    const int L = (p - 2) / 8, s = (p - 2) % 8, kind = L % 3;
    if (s == 7) return false;
    if (s == 1) return kind == 1;
    if (s == 2) return kind != 0;
    if (s == 4) return false;
    return true;
}

__global__ void __launch_bounds__(NTHREADS, 2) trunk_fwd(Args args) {
    extern __shared__ __attribute__((aligned(16))) unsigned char lds_raw[];
    Frame F;
    F.out = args.out; F.ws = args.ws; F.lds = (char*)lds_raw;
    F.tid = threadIdx.x; F.lane = F.tid & 63; F.wave = __builtin_amdgcn_readfirstlane(F.tid >> 6); F.G = gridDim.x; F.bid = blockIdx.x;
    volatile LAS unsigned* misc = (volatile LAS unsigned*)((LAS unsigned char*)lds_raw + MISC_OFF);
    if (F.tid < 16) misc[F.tid] = 0u;
    __syncthreads();
    XcdBarrier bar; bar.bar = (unsigned*)(F.ws + WS_CTL) + CW_BAR; bar.x = 0; bar.st = misc;
#if ONE_LAUNCH
    bar = xcd_barrier_post((unsigned*)(F.ws + WS_CTL) + CW_BAR, misc);
    cg::grid_group grid = cg::this_grid();
#endif
    const int lo = args.ph_lo, hi = args.ph_hi;
#if ONE_LAUNCH
    grid.sync();
#define SEAM(p) do { if ((p) > lo) xcd_barrier(bar); } while (0)
#else
#define SEAM(p) do { } while (0)
#endif
#define IN(p) (lo <= (p) && (p) < hi)
#ifndef PHMASK
#define PHMASK 0xFFFF
#endif
#define EN(b) ((PHMASK >> (b)) & 1)
#ifndef PROBE_DUP
#define PROBE_DUP 0
#endif
#define DUP(b, call) do { if ((PROBE_DUP >> (b)) & 1) { if (ONE_LAUNCH) xcd_barrier(bar); call; } } while (0)
    if (EN(0) && IN(0)) { SEAM(0); phase_prologue(F, args); }
    if (EN(1) && IN(1)) { SEAM(1); phase_norm(F, args, -1, 0); }
#define LAYER(L) do { \
        constexpr int kind = (L) % 3, base = 2 + 8 * (L); \
        constexpr int Nin = kind == 0 ? 8192 : (kind == 1 ? NSA_NP : 12288); \
        constexpr int Kout = kind == 2 ? 4096 : 2048; \
        if (EN(2) && IN(base + 0)) { SEAM(base + 0); phase_gemm_proj<kind>(F, Nin); } \
        if (EN(6) && kind == 1 && IN(base + 1)) { SEAM(base + 1); phase_nsa_cmp_a(F); } \
        if (kind != 0 && IN(base + 2)) { SEAM(base + 2); if (EN(6) && kind == 1) { phase_nsa_cmp_b(F, args); } else if (EN(7) && kind == 2) { phase_ret_scan_mfma(F, args); } } \
        if (IN(base + 3)) { SEAM(base + 3); if (EN(8) && kind == 0) { phase_moba_attn_mfma(F); DUP(8, phase_moba_attn_mfma(F)); } else if (EN(9) && kind == 1) { phase_nsa_attn_mfma(F); DUP(9, phase_nsa_attn_mfma(F)); } else if (EN(10) && kind == 2) { phase_ret_out_mfma(F, args); } } \
        if (EN(2) && IN(base + 5)) { SEAM(base + 5); phase_gemm(F, (const h16*)(F.ws + WS_OZ), (const h16*)(F.ws + WS_WTOUT), 2048, Kout, F.ws + WS_Y, 2048, 1); } \
        if (EN(1) && IN(base + 6)) { SEAM(base + 6); phase_norm(F, args, (L), (L) + 1 < DEPTH ? (L) + 1 : -1); } \
    } while (0)
    LAYER(0); LAYER(1); LAYER(2); LAYER(3);
#undef LAYER
#undef EN
#undef DUP
#undef IN
#undef SEAM
}

extern "C" void kernel_launch(void* const* d_in, const int* in_sizes, int n_in, void* d_out, int out_size, void* d_ws, size_t ws_size, hipStream_t stream) {
    static int grid = 0;
    if (grid == 0) {
        if (n_in != 18 || out_size != S * D || ws_size < WS_END) { fprintf(stderr, "kernel_launch: unexpected shapes (n_in %d, out %d, ws %zu)\n", n_in, out_size, ws_size); grid = -1; return; }
        int dev = 0, cus = 0, per_cu = 0;
        if (hipGetDevice(&dev) != hipSuccess || hipDeviceGetAttribute(&cus, hipDeviceAttributeMultiprocessorCount, dev) != hipSuccess) { grid = -1; return; }
        if (hipFuncSetAttribute((const void*)trunk_fwd, hipFuncAttributeMaxDynamicSharedMemorySize, LDS_BYTES) != hipSuccess) { fprintf(stderr, "kernel_launch: hipFuncSetAttribute failed\n"); grid = -1; return; }
        if (hipOccupancyMaxActiveBlocksPerMultiprocessor(&per_cu, (const void*)trunk_fwd, NTHREADS, LDS_BYTES) != hipSuccess || per_cu < 1) { fprintf(stderr, "kernel_launch: occupancy query says %d\n", per_cu); per_cu = 1; }
        (void)hipGetLastError();
        grid = cus;
    }
    if (grid < 0) return;
    (void)hipMemsetAsync((char*)d_ws + WS_CTL, 0, CTL_ZERO_BYTES, stream);
    Args a{};
    for (int i = 0; i < 18; ++i) a.in[i] = (const float*)d_in[i];
    a.out = (float*)d_out; a.ws = (unsigned char*)d_ws;
    for (int j = 0; j < 16; ++j) a.inv16[j] = pow(500000.0, -(double)j / 16.0);
    for (int j = 0; j < 128; ++j) a.inv128[j] = pow(10000.0, -(double)j / 128.0);
    for (int h = 0; h < 8; ++h) a.lg2g[h] = (float)log2(1.0 - ldexp(1.0, -5 - h));
#if ONE_LAUNCH
    a.ph_lo = 0; a.ph_hi = NPHASE;
    void* kargs[] = {&a};
    hipError_t e = hipLaunchCooperativeKernel((const void*)trunk_fwd, dim3(grid), dim3(NTHREADS), kargs, LDS_BYTES, stream);
    if (e != hipSuccess) fprintf(stderr, "kernel_launch: cooperative launch failed: %s (grid %d)\n", hipGetErrorString(e), grid);
#else
    for (int p = 0; p < NPHASE; ++p) {
        if (!phase_exists(p)) continue;
        a.ph_lo = p; a.ph_hi = p + 1;
        hipLaunchKernelGGL(trunk_fwd, dim3(grid), dim3(NTHREADS), LDS_BYTES, stream, a);
    }
#endif
}
```

```cpp
#include <hip/hip_runtime.h>
#include <hip/hip_cooperative_groups.h>
#include <cstdio>
#include <cstdint>
#include <cmath>
namespace cg = cooperative_groups;

#ifndef ONE_LAUNCH
#define ONE_LAUNCH 1
#endif
#ifndef MOBA_SPARSE
#define MOBA_SPARSE 1
#endif
#ifndef MOBA_MFMA
#define MOBA_MFMA 1
#endif
#ifndef NSA_MFMA
#define NSA_MFMA 1
#endif

#define LAS __attribute__((address_space(3)))
typedef _Float16 h16;
typedef _Float16 h16x2 __attribute__((ext_vector_type(2)));
typedef _Float16 h16x4 __attribute__((ext_vector_type(4)));
typedef _Float16 h16x8 __attribute__((ext_vector_type(8)));
typedef float f32x2 __attribute__((ext_vector_type(2)));
typedef float f32x4 __attribute__((ext_vector_type(4)));
typedef unsigned u32x4 __attribute__((ext_vector_type(4)));

constexpr int S = 8192, D = 2048, DEPTH = 4;
constexpr float EPS = 1e-6f;
constexpr float NEGF = -1e30f, BIGF = 1e30f;
constexpr int NSA_NP = 7424;
constexpr int NC = 511;

constexpr size_t MiB = 1u << 20;
constexpr size_t WS_CTL = 0, CTL_ZERO_BYTES = 1 * MiB;
constexpr size_t WS_MODP = 1 * MiB;
constexpr size_t WS_KMEAN = 4 * MiB + 512 * 1024;
constexpr size_t WS_CMPB = 2 * MiB + 512 * 1024;
constexpr size_t WS_GATES = 3 * MiB;
constexpr size_t WS_KCMP = 5 * MiB;
constexpr size_t WS_VCMP = 5 * MiB + 512 * 1024;
constexpr size_t WS_ROPE16 = 6 * MiB;
constexpr size_t WS_ROPE128 = 7 * MiB;
constexpr size_t WS_WTIN = 16 * MiB;
constexpr size_t WS_WTOUT = 64 * MiB;
constexpr size_t WS_W1T = 72 * MiB;
constexpr size_t WS_H = 80 * MiB;
constexpr size_t WS_P = 112 * MiB;
constexpr size_t WS_QKV = 304 * MiB;
constexpr size_t WS_OZ = 496 * MiB;
constexpr size_t WS_Y = 560 * MiB;
constexpr size_t WS_OR = 624 * MiB;
constexpr size_t WS_END = 752 * MiB;

constexpr int LDS_BYTES = 147456;
constexpr int MISC_OFF = 135168;
constexpr int NTHREADS = 512;

struct Args {
    const float* in[18];
    float* out;
    unsigned char* ws;
    double inv16[16];
    double inv128[128];
    float lg2g[8];
    int ph_lo, ph_hi;
};

#define XB_TMO      128
#define XB_XCNT(j)  (256  + 64 * (j))
#define XB_XSUB(j)  (1280 + 64 * (j))
#define XB_XGEN(j)  (2304 + 64 * (j))
#define XB_TOP      3328
#define XB_TOPGEN   3392
#define XCD_BAR_WORDS 3456
#define XB_SPIN_CAP (1u << 24)
constexpr int CW_BAR = 4096;

__device__ __forceinline__ unsigned xb_ld(unsigned* p)              { return __hip_atomic_load(p, __ATOMIC_RELAXED, __HIP_MEMORY_SCOPE_AGENT); }
__device__ __forceinline__ unsigned xb_add(unsigned* p, unsigned v) { return __hip_atomic_fetch_add(p, v, __ATOMIC_RELAXED, __HIP_MEMORY_SCOPE_AGENT); }
__device__ __forceinline__ unsigned xb_xcc_id() { return (unsigned)__builtin_amdgcn_s_getreg((3 << 11) | 20) & 0xFu; }
#define XB_SPIN(cond, bar) do { unsigned _sp = 0; while (cond) { __builtin_amdgcn_s_sleep(1); \
    if ((++_sp & 255u) == 0u) { if (xb_ld(&(bar)[XB_TMO])) break; if (_sp > XB_SPIN_CAP) { atomicAdd(&(bar)[XB_TMO], 1u); break; } } } } while (0)

struct XcdBarrier { unsigned* bar; unsigned x; volatile LAS unsigned* st; };

__device__ __forceinline__ XcdBarrier xcd_barrier_post(unsigned* bar, volatile LAS unsigned* st) {
    XcdBarrier b; b.bar = bar; b.x = xb_xcc_id(); b.st = st;
    if (threadIdx.x == 0) (void)xb_add(&bar[XB_XCNT(b.x)], 1u);
    return b;
}
__device__ __forceinline__ void xcd_barrier_complete(unsigned* bar, unsigned x, unsigned& nloc, unsigned& nx) {
    const unsigned G = gridDim.x * gridDim.y * gridDim.z;
    unsigned sum, cnt, mine, sp = 0u;
    for (;;) {
        sum = 0u; cnt = 0u; mine = 0u;
#pragma unroll
        for (unsigned j = 0; j < 16; ++j) { const unsigned c = xb_ld(&bar[XB_XCNT(j)]); sum += c; cnt += (c > 0u) ? 1u : 0u; mine = (j == x) ? c : mine; }
        if (sum == G) break;
        __builtin_amdgcn_s_sleep(1);
        if ((++sp & 255u) == 0u) { if (xb_ld(&bar[XB_TMO])) break; if (sp > XB_SPIN_CAP) { atomicAdd(&bar[XB_TMO], 1u); break; } }
    }
    nloc = mine > 0u ? mine : 1u; nx = cnt > 0u ? cnt : 1u;
}
__device__ __forceinline__ void xcd_barrier(const XcdBarrier& b) {
    asm volatile("s_waitcnt vmcnt(0)" ::: "memory");
    __syncthreads();
    if (threadIdx.x == 0) {
        unsigned* bar = b.bar;
        __builtin_amdgcn_s_waitcnt(0);
        unsigned nloc = b.st[0], nx = b.st[1];
        if (nloc == 0u) { xcd_barrier_complete(bar, b.x, nloc, nx); b.st[0] = nloc; b.st[1] = nx; }
        const unsigned old = xb_add(&bar[XB_XSUB(b.x)], 1u);
        const unsigned gen = old / nloc;
        if (old + 1u == (gen + 1u) * nloc) {
            __builtin_amdgcn_fence(__ATOMIC_RELEASE, "agent");
            asm volatile("s_waitcnt vmcnt(0)" ::: "memory");
            const unsigned og = xb_add(&bar[XB_TOP], 1u);
            const unsigned tg = og / nx;
            if (og + 1u == (tg + 1u) * nx) xb_add(&bar[XB_TOPGEN], 1u);
            else XB_SPIN(xb_ld(&bar[XB_TOPGEN]) == tg, bar);
            __builtin_amdgcn_fence(__ATOMIC_ACQUIRE, "agent");
            xb_add(&bar[XB_XGEN(b.x)], 1u);
            asm volatile("s_waitcnt vmcnt(0)" ::: "memory");
        } else {
            XB_SPIN(xb_ld(&bar[XB_XGEN(b.x)]) == gen, bar);
            __builtin_amdgcn_fence(__ATOMIC_ACQUIRE, "agent");
            asm volatile("s_waitcnt vmcnt(0)" ::: "memory");
        }
    }
    __syncthreads();
}

__device__ __forceinline__ float silu_f(float x) { return x / (1.f + __expf(-x)); }
__device__ __forceinline__ float sigmoid_f(float x) { return 1.f / (1.f + __expf(-x)); }

namespace pg8 {
constexpr int BM = 256, BK = 64, HALF = 128, HTB = HALF * BK * 2, STAGE_BYTES = 8 * HTB, NXCD = 8, WGM = 8;
__host__ __device__ __forceinline__ int lds_byte(int r, int c) { const int st = (r >> 4) * 2 + (c >> 5), rr = r & 15, cc = c & 31, ob = rr * 64 + cc * 2; return st * 1024 + (ob ^ (((ob >> 9) & 1) << 5)); }
__host__ __device__ __forceinline__ void stage_rc(int b, int& R, int& C) { const int st = b / 1024, sb = b % 1024, swz = sb ^ (((sb >> 9) & 1) << 5); R = (st >> 1) * 16 + swz / 64; C = (st & 1) * 32 + (swz % 64) / 2; }
__host__ __device__ __forceinline__ int perm32(int rho) { const int n = rho >> 4, i = rho & 15; return 8 * (i >> 2) + 4 * n + (i & 3); }

struct Unit { int pm, pn; };
struct Gemm { const h16* A; const h16* Bt; int M, N, K, lda, ldb; };

struct StaticOrder {
    int nM, nN, nwg, G, c;
    __host__ __device__ void init(int M, int N, int G_, int c_) { nM = M / BM; nN = N / BM; nwg = nM * nN; G = G_; c = c_; }
    __host__ __device__ bool next(int i, Unit& u) const {
        const long L = (long)i * G + c; if (L >= nwg) return false;
        int wgid = (int)L; { const int q = nwg / NXCD, r = nwg % NXCD, xcd = wgid % NXCD, off = wgid / NXCD; wgid = (xcd < r ? xcd * (q + 1) : r * (q + 1) + (xcd - r) * q) + off; }
        const int nig = WGM * nN, gid = wgid / nig, fm = gid * WGM, gsz = (nM - fm) < WGM ? (nM - fm) : WGM;
        u.pm = fm + ((wgid % nig) % gsz); u.pn = (wgid % nig) / gsz; return true;
    }
    __device__ __forceinline__ void a_ready(const Unit&) const {}
    __device__ __forceinline__ void done(const Unit&) const {}
};

struct OneUnit {
    int pm, pn, have;
    __device__ bool next(int i, Unit& u) const { if (i != 0 || !have) return false; u.pm = pm; u.pn = pn; return true; }
    __device__ __forceinline__ void a_ready(const Unit&) const {}
    __device__ __forceinline__ void done(const Unit&) const {}
};
struct EpiStore {
    static constexpr bool PERM = true, AFTER_DRAIN = false;
    void* O; int ldc; int f32out;
    __device__ __forceinline__ void operator()(const f32x4 (&acc)[2][2][4][2], const Unit& u, int wr, int wc, int fr, int fq) const {
        const int row0 = u.pm * BM + wr * 64 + fr, col0 = u.pn * BM + wc * 32 + 8 * fq;
#pragma unroll
        for (int ai = 0; ai < 2; ++ai)
#pragma unroll
            for (int m = 0; m < 4; ++m) {
                const size_t roff = (size_t)(row0 + ai * HALF + m * 16) * ldc + col0;
#pragma unroll
                for (int bj = 0; bj < 2; ++bj) {
                    const f32x4 v0 = acc[ai][bj][m][0], v1 = acc[ai][bj][m][1];
                    if (f32out) {
                        float* p = (float*)O + roff + bj * HALF;
                        *(f32x4*)p = v0; *(f32x4*)(p + 4) = v1;
                    } else {
                        h16x8 w; w[0] = (h16)v0[0]; w[1] = (h16)v0[1]; w[2] = (h16)v0[2]; w[3] = (h16)v0[3]; w[4] = (h16)v1[0]; w[5] = (h16)v1[1]; w[6] = (h16)v1[2]; w[7] = (h16)v1[3];
                        *(h16x8*)((h16*)O + roff + bj * HALF) = w;
                    }
                }
            }
    }
};


template <int KIND  > struct EpiProj {
    static constexpr bool PERM = true, AFTER_DRAIN = false;
    unsigned char* ws;
    __device__ __forceinline__ static void st8(h16* p, const float (&v)[8]) { h16x8 w;
#pragma unroll
        for (int i = 0; i < 8; ++i) w[i] = (h16)v[i];
        *(h16x8*)p = w; }
    __device__ __forceinline__ void operator()(const f32x4 (&acc)[2][2][4][2], const Unit& u, int wr, int wc, int fr, int fq) const {
        const int pn = u.pn, d0 = 32 * wc + 8 * fq;
        h16* QKV = (h16*)(ws + WS_QKV);
        const f32x2* r16 = (const f32x2*)(ws + WS_ROPE16); const f32x2* r128 = (const f32x2*)(ws + WS_ROPE128);
        float ksum[2][8];
#pragma unroll
        for (int bj = 0; bj < 2; ++bj)
#pragma unroll
            for (int i = 0; i < 8; ++i) ksum[bj][i] = 0.f;
        int mode;
        float scale = 1.f; h16* base = QKV; int ld = 0;
        bool want_ksum = false;
        if (KIND == 0) {
            const int sect = pn >> 3;
            if (sect == 0) { mode = 0; scale = 0.08838834764831845f; base = QKV + (size_t)(2 * (pn & 7)) * S * 128; }
            else if (sect == 1) { mode = 0; want_ksum = true; base = QKV + (size_t)16 * S * 128 + (size_t)(2 * (pn & 7)) * S * 128; }
            else if (sect == 2) { mode = 1; base = QKV + (size_t)32 * S * 128 + (size_t)(2 * (pn & 7)) * S * 128; }
            else { mode = 2; base = QKV + (size_t)48 * S * 128 + (pn & 7) * 256; ld = 2048; }
        } else if (KIND == 1) {
            if (pn < 8) { mode = 0; scale = 0.08838834764831845f; base = QKV + (size_t)(2 * pn) * S * 128; }
            else if (pn < 20) { const int ti = (pn - 8) >> 1; mode = (ti & 1) ? 1 : 0; base = QKV + (size_t)16 * S * 128 + ((size_t)ti * 4 + 2 * ((pn - 8) & 1)) * S * 128; }
            else if (pn < 28) { mode = 2; base = (h16*)(ws + WS_QKV + 96 * MiB) + (pn - 20) * 256; ld = 2048; }
            else mode = 3;
        } else {
            if (pn < 8) { mode = 4; base = QKV + (size_t)pn * S * 256; }
            else if (pn < 16) { mode = 4; scale = 0.0625f; base = QKV + (size_t)8 * S * 256 + (size_t)(pn - 8) * S * 256; }
            else if (pn < 32) { mode = 5; base = QKV + (size_t)16 * S * 256 + (size_t)((pn - 16) >> 1) * S * 512 + ((pn - 16) & 1) * 256; }
            else { mode = 2; base = QKV + (size_t)16 * S * 256 + (size_t)8 * S * 512 + (pn - 32) * 256; ld = 4096; }
        }
#pragma unroll
        for (int ai = 0; ai < 2; ++ai)
#pragma unroll
            for (int m = 0; m < 4; ++m) {
                const int t = u.pm * BM + ai * HALF + wr * 64 + m * 16 + fr;
                float v[2][8];
#pragma unroll
                for (int bj = 0; bj < 2; ++bj)
#pragma unroll
                    for (int i = 0; i < 8; ++i) v[bj][i] = acc[ai][bj][m][i >> 2][i & 3];
                if (mode == 0) {
                    if (wc == 0) {
                        const f32x2* cs = r16 + (size_t)t * 16 + 8 * (fq & 1);
#pragma unroll
                        for (int bj = 0; bj < 2; ++bj)
#pragma unroll
                            for (int i = 0; i < 8; ++i) { const float o = __shfl_xor(v[bj][i], 32); const f32x2 c = cs[i];
                                v[bj][i] = (fq < 2) ? (v[bj][i] * c[0] - o * c[1]) : (o * c[1] + v[bj][i] * c[0]); }
                    }
#pragma unroll
                    for (int bj = 0; bj < 2; ++bj) {
#pragma unroll
                        for (int i = 0; i < 8; ++i) { v[bj][i] *= scale; ksum[bj][i] += v[bj][i]; }
                        st8(base + ((size_t)bj * S + t) * 128 + d0, v[bj]);
                    }
                } else if (mode == 1) {
#pragma unroll
                    for (int bj = 0; bj < 2; ++bj) st8(base + ((size_t)bj * S + t) * 128 + d0, v[bj]);
                } else if (mode == 2) {
#pragma unroll
                    for (int bj = 0; bj < 2; ++bj) {
#pragma unroll
                        for (int i = 0; i < 8; ++i) v[bj][i] = silu_f(v[bj][i]);
                        st8(base + (size_t)t * ld + 128 * bj + d0, v[bj]);
                    }
                } else if (mode == 3) {
                    if (d0 < 48) { float* gp = (float*)(ws + WS_GATES) + (size_t)t * 48 + d0;
#pragma unroll
                        for (int i = 0; i < 8; ++i) gp[i] = sigmoid_f(v[0][i]); }
                } else if (mode == 4) {
                    const f32x2* cs = r128 + (size_t)t * 128 + d0;
#pragma unroll
                    for (int i = 0; i < 8; ++i) { const f32x2 c = cs[i]; const float x1 = v[0][i], x2 = v[1][i];
                        v[0][i] = (x1 * c[0] - x2 * c[1]) * scale; v[1][i] = (x1 * c[1] + x2 * c[0]) * scale; }
                    st8(base + (size_t)t * 256 + d0, v[0]); st8(base + (size_t)t * 256 + 128 + d0, v[1]);
                } else {
#pragma unroll
                    for (int bj = 0; bj < 2; ++bj) st8(base + (size_t)t * 512 + 128 * bj + d0, v[bj]);
                }
            }
        if (KIND == 0 && want_ksum) {
#pragma unroll
            for (int bj = 0; bj < 2; ++bj)
#pragma unroll
                for (int i = 0; i < 8; ++i) { float x = ksum[bj][i]; x += __shfl_xor(x, 1); x += __shfl_xor(x, 2); x += __shfl_xor(x, 4); x += __shfl_xor(x, 8); ksum[bj][i] = x; }
            if (fr == 0) { float* km = (float*)(ws + WS_KMEAN) + (size_t)wr * 65536;
#pragma unroll
                for (int bj = 0; bj < 2; ++bj)
#pragma unroll
                    for (int i = 0; i < 8; ++i) km[((size_t)(2 * (pn & 7) + bj) * 32 + u.pm) * 128 + d0 + i] = ksum[bj][i] * (1.0f / 256.0f); }
        }
    }
};

template <class Epi, class Sched, bool ALIGN_EPI = false, bool SP2 = false>
__device__ __forceinline__ void gemm_phase(LAS unsigned char* lds, const Gemm g, const Sched& S, const Epi& E) {
    const int tid = threadIdx.x, wid = __builtin_amdgcn_readfirstlane(tid >> 6), lane = tid & 63, wr = wid >> 2, wc = wid & 3, fr = lane & 15, fq = lane >> 4;
    const int K = g.K, nt = K / BK;
    unsigned voffA[2], voffB[2];
#pragma unroll
    for (int i = 0; i < 2; ++i) { int R, C; stage_rc(tid * 16 + i * 8192, R, C); const int Rb = Epi::PERM ? ((R & ~31) + perm32(R & 31)) : R;
        voffA[i] = (unsigned)(R * g.lda + C) * 2u; voffB[i] = (unsigned)(Rb * g.ldb + C) * 2u; }
    const size_t kstep = (size_t)(BK * 2);
    const size_t hstepA = (size_t)HALF * g.lda * 2, hstepB = (size_t)HALF * g.ldb * 2;
    const size_t tstepA = 2 * hstepA, tstepB = 2 * hstepB;
    const unsigned ldsw = (unsigned)wid * 1024u;
    const int aoff = lds_byte(wr * 64 + fr, fq * 8), boff = lds_byte(wc * 32 + fr, fq * 8);
#define PG8_SA(b, h) (((b) * 2 + (h)) * HTB)
#define PG8_SB(b, h) ((4 + (b) * 2 + (h)) * HTB)
#define PG8_STAGE(bufoff, gbase, voff) do { _Pragma("unroll") for (int _i = 0; _i < 2; ++_i) \
        __builtin_amdgcn_global_load_lds((const unsigned*)((const char*)(gbase) + (voff)[_i]), (LAS unsigned*)(lds + (bufoff) + ldsw + _i * 8192), 16, 0, 0); } while (0)
#define PG8_LDA(dst, b, h) do { _Pragma("unroll") for (int m = 0; m < 4; ++m) _Pragma("unroll") for (int k = 0; k < 2; ++k) dst[m][k] = *(const LAS h16x8*)(lds + PG8_SA(b, h) + aoff + m * 2048 + k * 1024); } while (0)
#define PG8_LDB(dst, b, h) do { _Pragma("unroll") for (int n = 0; n < 2; ++n) _Pragma("unroll") for (int k = 0; k < 2; ++k) dst[n][k] = *(const LAS h16x8*)(lds + PG8_SB(b, h) + boff + n * 2048 + k * 1024); } while (0)
#define PG8_MMA(ai, bj, At, Bt) do { __builtin_amdgcn_s_setprio(1); _Pragma("unroll") for (int m = 0; m < 4; ++m) _Pragma("unroll") for (int n = 0; n < 2; ++n) _Pragma("unroll") for (int k = 0; k < 2; ++k) \
        acc[ai][bj][m][n] = __builtin_amdgcn_mfma_f32_16x16x32_f16(Bt[n][k], At[m][k], acc[ai][bj][m][n], 0, 0, 0); __builtin_amdgcn_s_setprio(0); } while (0)
#define PG8_WAIT_V(n) asm volatile("s_waitcnt vmcnt(" #n ")" ::: "memory")
#define PG8_WAIT_L(n) asm volatile("s_waitcnt lgkmcnt(" #n ")" ::: "memory")
#define PG8_BAR __builtin_amdgcn_s_barrier()
#define PG8_SCHED __builtin_amdgcn_sched_barrier(0)
    Unit cur, nxt; int ui = 0;
    if (!S.next(0, cur)) return;
    f32x4 acc[2][2][4][2];
#pragma unroll
    for (int a = 0; a < 2; ++a)
#pragma unroll
        for (int b = 0; b < 2; ++b)
#pragma unroll
            for (int m = 0; m < 4; ++m)
#pragma unroll
                for (int n = 0; n < 2; ++n) acc[a][b][m][n] = (f32x4){0.f, 0.f, 0.f, 0.f};
    h16x8 At[4][2], B0[2][2], B1[2][2];
    const char* cA = (const char*)g.A + (size_t)cur.pm * tstepA; const char* cB = (const char*)g.Bt + (size_t)cur.pn * tstepB;
    S.a_ready(cur);
    if constexpr (SP2) {
        PG8_STAGE(PG8_SB(0, 0), cB, voffB); PG8_STAGE(PG8_SB(0, 1), cB + hstepB, voffB); PG8_STAGE(PG8_SA(0, 0), cA, voffA); PG8_STAGE(PG8_SA(0, 1), cA + hstepA, voffA);
        if (wr == 1) PG8_BAR;
        PG8_WAIT_V(2); PG8_BAR;
        PG8_STAGE(PG8_SB(1, 0), cB + kstep, voffB); PG8_STAGE(PG8_SA(1, 0), cA + kstep, voffA); PG8_STAGE(PG8_SB(1, 1), cB + hstepB + kstep, voffB);
        PG8_WAIT_V(6); PG8_BAR;
    } else {
        PG8_STAGE(PG8_SB(0, 0), cB, voffB); PG8_STAGE(PG8_SA(0, 0), cA, voffA); PG8_STAGE(PG8_SB(0, 1), cB + hstepB, voffB); PG8_STAGE(PG8_SA(0, 1), cA + hstepA, voffA);
        if (wr == 1) PG8_BAR;
        PG8_WAIT_V(4); PG8_BAR;
        PG8_STAGE(PG8_SB(1, 0), cB + kstep, voffB); PG8_STAGE(PG8_SA(1, 0), cA + kstep, voffA); PG8_STAGE(PG8_SB(1, 1), cB + hstepB + kstep, voffB);
        PG8_WAIT_V(6); PG8_BAR;
    }
    for (;;) {
        const bool has_next = S.next(ui + 1, nxt);
        const char* nA = has_next ? (const char*)g.A + (size_t)nxt.pm * tstepA : cA; const char* nB = has_next ? (const char*)g.Bt + (size_t)nxt.pn * tstepB : cB;
        for (int t = 0; t < nt; t += 2) {
            const bool last = (t == nt - 2);
            const char* a1 = cA + (size_t)(t + 1) * kstep;
            const char* a2 = last ? nA : cA + (size_t)(t + 2) * kstep; const char* b2 = last ? nB : cB + (size_t)(t + 2) * kstep;
            const char* a3 = a2 + kstep; const char* b3 = b2 + kstep;
            if (last && has_next) S.a_ready(nxt);
            if constexpr (SP2) {
            PG8_LDB(B0, 0, 0); PG8_LDB(B1, 0, 1); PG8_SCHED; PG8_LDA(At, 0, 0); PG8_STAGE(PG8_SA(1, 1), a1 + hstepA, voffA);
            PG8_WAIT_V(8); PG8_WAIT_L(0); PG8_BAR; PG8_MMA(0, 0, At, B0); PG8_MMA(0, 1, At, B1); PG8_BAR; PG8_SCHED;
            PG8_LDA(At, 0, 1); PG8_STAGE(PG8_SB(0, 0), b2, voffB); PG8_STAGE(PG8_SB(0, 1), b2 + hstepB, voffB); PG8_STAGE(PG8_SA(0, 0), a2, voffA);
            PG8_WAIT_V(8); PG8_WAIT_L(0); PG8_BAR; PG8_MMA(1, 0, At, B0); PG8_MMA(1, 1, At, B1); PG8_BAR; PG8_SCHED;
            PG8_LDB(B0, 1, 0); PG8_LDB(B1, 1, 1); PG8_SCHED; PG8_LDA(At, 1, 0); PG8_STAGE(PG8_SA(0, 1), a2 + hstepA, voffA);
            PG8_WAIT_V(8); PG8_WAIT_L(0); PG8_BAR; PG8_MMA(0, 0, At, B0); PG8_MMA(0, 1, At, B1); PG8_BAR; PG8_SCHED;
            PG8_LDA(At, 1, 1); PG8_STAGE(PG8_SB(1, 0), b3, voffB); PG8_STAGE(PG8_SB(1, 1), b3 + hstepB, voffB); PG8_STAGE(PG8_SA(1, 0), a3, voffA);
            PG8_WAIT_V(8); PG8_WAIT_L(0); PG8_BAR; PG8_MMA(1, 0, At, B0); PG8_MMA(1, 1, At, B1); PG8_BAR; PG8_SCHED;
            } else {
            PG8_LDB(B0, 0, 0); PG8_SCHED; PG8_LDA(At, 0, 0); PG8_STAGE(PG8_SA(1, 1), a1 + hstepA, voffA);
            PG8_WAIT_L(8); PG8_BAR; PG8_WAIT_L(0); PG8_MMA(0, 0, At, B0); PG8_BAR; PG8_SCHED;
            PG8_LDB(B1, 0, 1); PG8_STAGE(PG8_SB(0, 0), b2, voffB);
            PG8_BAR; PG8_WAIT_L(0); PG8_MMA(0, 1, At, B1); PG8_BAR;
            PG8_LDA(At, 0, 1); PG8_STAGE(PG8_SA(0, 0), a2, voffA);
            PG8_BAR; PG8_WAIT_L(0); PG8_MMA(1, 0, At, B0); PG8_BAR; PG8_SCHED;
            PG8_STAGE(PG8_SB(0, 1), b2 + hstepB, voffB);
            PG8_WAIT_V(6); PG8_BAR; PG8_MMA(1, 1, At, B1); PG8_BAR;
            PG8_LDB(B0, 1, 0); PG8_SCHED; PG8_LDA(At, 1, 0); PG8_STAGE(PG8_SA(0, 1), a2 + hstepA, voffA);
            PG8_WAIT_L(8); PG8_BAR; PG8_WAIT_L(0); PG8_MMA(0, 0, At, B0); PG8_BAR; PG8_SCHED;
            PG8_LDB(B1, 1, 1); PG8_STAGE(PG8_SB(1, 0), b3, voffB);
            PG8_BAR; PG8_WAIT_L(0); PG8_MMA(0, 1, At, B1); PG8_BAR;
            PG8_LDA(At, 1, 1); PG8_STAGE(PG8_SA(1, 0), a3, voffA);
            PG8_BAR; PG8_WAIT_L(0); PG8_MMA(1, 0, At, B0); PG8_BAR; PG8_SCHED;
            PG8_STAGE(PG8_SB(1, 1), b3 + hstepB, voffB);
            PG8_WAIT_V(6); PG8_BAR; PG8_MMA(1, 1, At, B1); PG8_BAR;
            }
        }
        if constexpr (ALIGN_EPI) { if (wr == 0) PG8_BAR; }
        if constexpr (!Epi::AFTER_DRAIN) { E(acc, cur, wr, wc, fr, fq); S.done(cur); }
        if (!has_next) break;
#pragma unroll
        for (int a = 0; a < 2; ++a)
#pragma unroll
            for (int b = 0; b < 2; ++b)
#pragma unroll
                for (int m = 0; m < 4; ++m)
#pragma unroll
                    for (int n = 0; n < 2; ++n) acc[a][b][m][n] = (f32x4){0.f, 0.f, 0.f, 0.f};
        cur = nxt; cA = nA; cB = nB; ++ui;
        if constexpr (ALIGN_EPI) { if (wr == 1) PG8_BAR; }
    }
    PG8_WAIT_V(0);
    if constexpr (!ALIGN_EPI) { if (wr == 0) PG8_BAR; }
    PG8_BAR;
#undef PG8_SA
#undef PG8_SB
#undef PG8_STAGE
#undef PG8_LDA
#undef PG8_LDB
#undef PG8_MMA
#undef PG8_WAIT_V
#undef PG8_WAIT_L
#undef PG8_BAR
#undef PG8_SCHED
}
}

struct Frame {
    float* out;
    unsigned char* ws;
    char* lds;
    int tid, lane, wave, G, bid;
};

__device__ __forceinline__ float wave_sum(float v) {
#pragma unroll
    for (int o = 32; o >= 1; o >>= 1) v += __shfl_xor(v, o);
    return v;
}
__device__ __forceinline__ float wave_max(float v) {
#pragma unroll
    for (int o = 32; o >= 1; o >>= 1) v = fmaxf(v, __shfl_xor(v, o));
    return v;
}
__device__ __forceinline__ void wave_lds_fence() { __builtin_amdgcn_wave_barrier(); asm volatile("s_waitcnt lgkmcnt(0)" ::: "memory"); __builtin_amdgcn_wave_barrier(); }

__device__ __forceinline__ void sincos_d(double x, float& c, float& s) {
    const double TWO_OVER_PI = 0.63661977236758134308;
    const double PIO2_HI = 1.57079632679489655800e+00, PIO2_LO = 6.12323399573676603587e-17;
    const double q = __builtin_rint(x * TWO_OVER_PI);
    double y = __builtin_fma(-q, PIO2_HI, x); y = __builtin_fma(-q, PIO2_LO, y);
    const double y2 = y * y;
    double sp = 1.0 / 6227020800.0;
    sp = sp * y2 - 1.0 / 39916800.0; sp = sp * y2 + 1.0 / 362880.0; sp = sp * y2 - 1.0 / 5040.0; sp = sp * y2 + 1.0 / 120.0; sp = sp * y2 - 1.0 / 6.0; sp = sp * y2 * y + y;
    double cp = -1.0 / 87178291200.0;
    cp = cp * y2 + 1.0 / 479001600.0; cp = cp * y2 - 1.0 / 3628800.0; cp = cp * y2 + 1.0 / 40320.0; cp = cp * y2 - 1.0 / 720.0; cp = cp * y2 + 1.0 / 24.0; cp = cp * y2 - 0.5; cp = cp * y2 + 1.0;
    const long long qi = (long long)q; const int quad = (int)(qi & 3);
    double sv, cv;
    if (quad == 0) { sv = sp; cv = cp; } else if (quad == 1) { sv = cp; cv = -sp; } else if (quad == 2) { sv = -sp; cv = -cp; } else { sv = -cp; cv = sp; }
    c = (float)cv; s = (float)sv;
}

__device__ __forceinline__ int nsa_src_col(int n) { return n < 5120 ? n : (n < 7168 ? n + 48 : (n < 7216 ? n - 2048 : -1)); }
__device__ __forceinline__ void conv_transpose(const Frame& F, const float* W, int K, int Nsrc, h16* Wt, int Npad, int mapmode, int item0, int& items_done) {
    float* tile = (float*)F.lds;
    const int tk_n = K / 64, tn_n = Npad / 128, ntiles = tk_n * tn_n;
    f32x4 v[4];
#define CV_LOAD(it_) do { const int tk_ = (it_) / tn_n, tn_ = (it_) % tn_n; _Pragma("unroll") for (int i = 0; i < 4; ++i) { \
        const int idx = F.tid + i * NTHREADS, k = idx >> 5, n4 = (idx & 31) * 4; const int nn = tn_ * 128 + n4; const int src = mapmode ? nsa_src_col(nn) : nn; \
        v[i] = (f32x4){0.f, 0.f, 0.f, 0.f}; if (src >= 0 && src + 3 < Nsrc) v[i] = *(const f32x4*)(W + (size_t)(tk_ * 64 + k) * Nsrc + src); } } while (0)
    if (F.bid < ntiles) CV_LOAD(F.bid);
    for (int it = F.bid; it < ntiles; it += F.G) {
        const int tk = it / tn_n, tn = it % tn_n;
        __syncthreads();
#pragma unroll
        for (int i = 0; i < 4; ++i) {
            const int idx = F.tid + i * NTHREADS, k = idx >> 5, n4 = (idx & 31) * 4;
            tile[k * 129 + n4] = v[i][0]; tile[k * 129 + n4 + 1] = v[i][1]; tile[k * 129 + n4 + 2] = v[i][2]; tile[k * 129 + n4 + 3] = v[i][3];
        }
        if (it + F.G < ntiles) CV_LOAD(it + F.G);
        __syncthreads();
#pragma unroll
        for (int i = 0; i < 4; ++i) {
            const int idx = F.tid + i * NTHREADS, n = idx >> 4, k4 = (idx & 15) * 4;
            h16x4 o; o[0] = (h16)tile[k4 * 129 + n]; o[1] = (h16)tile[(k4 + 1) * 129 + n]; o[2] = (h16)tile[(k4 + 2) * 129 + n]; o[3] = (h16)tile[(k4 + 3) * 129 + n];
            *(h16x4*)(Wt + (size_t)(tn * 128 + n) * K + tk * 64 + k4) = o;
        }
    }
#undef CV_LOAD
    __syncthreads();
}
__device__ __forceinline__ void conv_layer_weights(const Frame& F, const Args& A, int L) {
    const int kind = L % 3, j = L / 3; int dummy = 0;
    h16* wtin = (h16*)(F.ws + WS_WTIN); h16* wtout = (h16*)(F.ws + WS_WTOUT);
    if (kind == 0) {
        conv_transpose(F, A.in[7] + (size_t)j * 2048 * 8192, 2048, 8192, wtin, 8192, 0, 0, dummy);
        conv_transpose(F, A.in[8] + (size_t)j * 2048 * 2048, 2048, 2048, wtout, 2048, 0, 0, dummy);
    } else if (kind == 1) {
        conv_transpose(F, A.in[9], 2048, 7216, wtin, NSA_NP, 1, 0, dummy);
        conv_transpose(F, A.in[10], 2048, 2048, wtout, 2048, 0, 0, dummy);
        conv_transpose(F, A.in[12], 4096, 256, (h16*)(F.ws + WS_W1T), 256, 0, 0, dummy);
        conv_transpose(F, A.in[14], 4096, 256, (h16*)(F.ws + WS_W1T) + (size_t)256 * 4096, 256, 0, 0, dummy);
    } else {
        conv_transpose(F, A.in[16], 2048, 12288, wtin, 12288, 0, 0, dummy);
        conv_transpose(F, A.in[17], 4096, 2048, wtout, 2048, 0, 0, dummy);
    }
}

__device__ __forceinline__ void phase_prologue(const Frame& F, const Args& A) {
    {
        float* modp = (float*)(F.ws + WS_MODP);
        const float* c = A.in[1]; const float* aw = A.in[3];
        float* sc = (float*)F.lds;
        __syncthreads();
        for (int i = F.tid; i < 2048; i += NTHREADS) sc[i] = silu_f(c[i]);
        __syncthreads();
        for (int it = F.bid; it < 192; it += F.G) {
            const int layer = it / 48, r = it % 48, slice = r / 3, nch = r % 3, n = nch * 2048 + F.tid * 4;
            const float* w = aw + (size_t)layer * 2048 * 6144 + (size_t)(slice * 128) * 6144 + n;
            f32x4 a0 = (f32x4){0.f, 0.f, 0.f, 0.f}, a1 = a0;
#pragma unroll 8
            for (int k = 0; k < 128; k += 2) {
                a0 += *(const f32x4*)(w + (size_t)k * 6144) * sc[slice * 128 + k];
                a1 += *(const f32x4*)(w + (size_t)(k + 1) * 6144) * sc[slice * 128 + k + 1];
            }
            *(f32x4*)(modp + (size_t)(slice * 4 + layer) * 6144 + n) = a0 + a1;
        }
        __syncthreads();
    }
    {
        const int* pos = (const int*)A.in[2];
        f32x2* r16 = (f32x2*)(F.ws + WS_ROPE16); f32x2* r128 = (f32x2*)(F.ws + WS_ROPE128);
        for (int idx = F.bid * NTHREADS + F.tid; idx < S * 16; idx += F.G * NTHREADS) {
            const int t = idx >> 4, j = idx & 15; float cs, sn; sincos_d((double)pos[t] * A.inv16[j], cs, sn); r16[idx] = (f32x2){cs, sn};
        }
        for (int idx = F.bid * NTHREADS + F.tid; idx < S * 128; idx += F.G * NTHREADS) {
            const int t = idx >> 7, j = idx & 127; float cs, sn; sincos_d((double)pos[t] * A.inv128[j], cs, sn); r128[idx] = (f32x2){cs, sn};
        }
    }
    if (F.bid >= F.G - 16) {
        const int slice = F.bid - (F.G - 16), kv = F.tid >> 8, j = F.tid & 255; const float* w1 = (kv ? A.in[14] : A.in[12]) + (size_t)slice * 256 * 256; const float* pe = A.in[11] + slice * 256;
        float a0 = 0.f, a1 = 0.f;
#pragma unroll 8
        for (int i = 0; i < 256; i += 2) { a0 += pe[i] * w1[(size_t)i * 256 + j]; a1 += pe[i + 1] * w1[(size_t)(i + 1) * 256 + j]; }
        ((float*)(F.ws + WS_CMPB))[slice * 512 + F.tid] = a0 + a1;
    }
    conv_layer_weights(F, A, 0);
}

__device__ __forceinline__ void phase_norm(const Frame& F, const Args& A, int Lprev, int Lnext) {
    float* modl = (float*)F.lds;
    const float* modp = (const float*)(F.ws + WS_MODP); const float* ab = A.in[4];
    __syncthreads();
    for (int i = F.tid; i < 6144; i += NTHREADS) {
        const int which = i >> 11, col = i & 2047;
        int layer, mcol;
        if (which == 0) { layer = Lprev; mcol = 4096 + col; } else if (which == 1) { layer = Lnext; mcol = 2048 + col; } else { layer = Lnext; mcol = col; }
        float v = 0.f;
        if (layer >= 0) { v = ab[layer * 6144 + mcol];
#pragma unroll
            for (int s = 0; s < 16; ++s) v += modp[(size_t)(s * 4 + layer) * 6144 + mcol]; }
        modl[i] = v;
    }
    __syncthreads();
    const float* xin = (Lprev <= 0) ? A.in[0] : F.out;
    const float* Y = (const float*)(F.ws + WS_Y);
    h16* H = (h16*)(F.ws + WS_H);
    const float* npost = A.in[6] + (Lprev >= 0 ? Lprev : 0) * 2048;
    const float* npre = A.in[5] + (Lnext >= 0 ? Lnext : 0) * 2048;
    for (int t = F.bid * 8 + F.wave; t < S; t += F.G * 8) {
        f32x4 x[8];
#pragma unroll
        for (int i = 0; i < 8; ++i) x[i] = *(const f32x4*)(xin + (size_t)t * D + i * 256 + F.lane * 4);
        if (Lprev >= 0) {
            f32x4 y[8]; float ss = 0.f;
#pragma unroll
            for (int i = 0; i < 8; ++i) { y[i] = *(const f32x4*)(Y + (size_t)t * D + i * 256 + F.lane * 4); ss += y[i][0] * y[i][0] + y[i][1] * y[i][1] + y[i][2] * y[i][2] + y[i][3] * y[i][3]; }
            ss = wave_sum(ss);
            const float r = 1.0f / sqrtf(ss * (1.0f / D) + EPS);
#pragma unroll
            for (int i = 0; i < 8; ++i) {
                const int col = i * 256 + F.lane * 4;
                const f32x4 g = *(const f32x4*)(npost + col); const f32x4 gt = *(const f32x4*)(modl + col);
#pragma unroll
                for (int e = 0; e < 4; ++e) x[i][e] += gt[e] * (y[i][e] * r * g[e]);
                *(f32x4*)(F.out + (size_t)t * D + col) = x[i];
            }
        }
        if (Lnext >= 0) {
            float ss = 0.f;
#pragma unroll
            for (int i = 0; i < 8; ++i) ss += x[i][0] * x[i][0] + x[i][1] * x[i][1] + x[i][2] * x[i][2] + x[i][3] * x[i][3];
            ss = wave_sum(ss);
            const float r = 1.0f / sqrtf(ss * (1.0f / D) + EPS);
#pragma unroll
            for (int i = 0; i < 8; ++i) {
                const int col = i * 256 + F.lane * 4;
                const f32x4 g = *(const f32x4*)(npre + col); const f32x4 sc = *(const f32x4*)(modl + 2048 + col); const f32x4 sh = *(const f32x4*)(modl + 4096 + col);
                h16x4 hv;
#pragma unroll
                for (int e = 0; e < 4; ++e) hv[e] = (h16)((x[i][e] * r * g[e]) * (1.0f + sc[e]) + sh[e]);
                *(h16x4*)(H + (size_t)t * D + col) = hv;
            }
        }
    }
    if (Lnext > 0) conv_layer_weights(F, A, Lnext);
}

__device__ __forceinline__ void phase_nsa_cmp_a(const Frame& F) {
    const int u = F.bid, have = u < 64, kv = (u >> 5) & 1, mt = (u >> 2) & 7, kp = u & 3;
    const h16* A = (const h16*)(F.ws + WS_QKV) + (size_t)16 * S * 128 + (size_t)kv * 4 * S * 128 + kp * 1024;
    const h16* Bt = (const h16*)(F.ws + WS_W1T) + (size_t)kv * 256 * 4096 + kp * 1024;
    pg8::Gemm g{A, Bt, 2048, 256, 1024, 2048, 4096}; pg8::OneUnit So{mt, 0, have};
    pg8::EpiStore E{(float*)(F.ws + WS_OR) + (size_t)(kv * 4 + kp) * 2048 * 256, 256, 1};
    pg8::gemm_phase<pg8::EpiStore, pg8::OneUnit, true, true>((LAS unsigned char*)F.lds, g, So, E);
}
__device__ __forceinline__ void phase_nsa_cmp_b(const Frame& F, const Args& A) {
    float* hid = (float*)F.lds;
    const float* part = (const float*)(F.ws + WS_OR); const float* b1 = (const float*)(F.ws + WS_CMPB);
    for (int it = F.bid; it < 256; it += F.G) {
        const int kv = it >> 7, r0 = (it & 127) * 16;
        const float* W2 = kv ? A.in[15] : A.in[13];
        h16* dst = (h16*)(F.ws + (kv ? WS_VCMP : WS_KCMP));
        __syncthreads();
        for (int i = F.tid; i < 16 * 256; i += NTHREADS) {
            const int r = r0 + (i >> 8), j = i & 255; float v = 0.f;
#pragma unroll
            for (int sl = 0; sl < 16; ++sl) v += b1[sl * 512 + kv * 256 + j];
#pragma unroll
            for (int kp = 0; kp < 4; ++kp) v += part[((size_t)(kv * 4 + kp) * 2048 + r) * 256 + j];
            hid[i] = silu_f(v);
        }
        __syncthreads();
        const int d = F.tid & 127, rq = F.tid >> 7;
        float a[4] = {0.f, 0.f, 0.f, 0.f};
#pragma unroll 4
        for (int j = 0; j < 256; ++j) { const float w = W2[j * 128 + d];
#pragma unroll
            for (int e = 0; e < 4; ++e) a[e] += hid[(rq * 4 + e) * 256 + j] * w; }
#pragma unroll
        for (int e = 0; e < 4; ++e) { const int r = r0 + rq * 4 + e; dst[(size_t)r * 128 + d] = ((r & 511) < NC) ? (h16)a[e] : (h16)0.f; }
    }
}

namespace fa {
typedef float f32x16 __attribute__((ext_vector_type(16)));
typedef unsigned u32x2 __attribute__((ext_vector_type(2)));
constexpr float LOG2E = 1.4426950408889634f;
constexpr int KROW = 272, VROW = 320;
constexpr int KT_BYTES = 64 * KROW, BUF_BYTES = KT_BYTES + 64 * VROW;
typedef short s16x4v __attribute__((__vector_size__(4 * sizeof(short))));
constexpr int LDS_IMP = 2 * BUF_BYTES;
constexpr int LDS_SELW = LDS_IMP + 32768;
constexpr int LDS_SV = LDS_SELW + 1024;
static_assert(LDS_SV + 4096 <= MISC_OFF, "attention LDS map");

struct Stage { u32x4 k[2], v[2]; };
__device__ __forceinline__ void stage_load(Stage& st, const h16* Kg, const h16* VTg, int j, int tid) {
    asm volatile("" : "+v"(tid));
#pragma unroll
    for (int i = 0; i < 2; ++i) { const int idx = tid + 512 * i;
        st.k[i] = *(const u32x4*)(Kg + (size_t)(j * 64 + (idx >> 4)) * 128 + (idx & 15) * 8);
        st.v[i] = *(const u32x4*)(VTg + (size_t)(j * 64 + (idx >> 4)) * 128 + (idx & 15) * 8); }
}
__device__ __forceinline__ void stage_write(const Stage& st, LAS unsigned char* buf, int tid) {
    asm volatile("" : "+v"(tid));
#pragma unroll
    for (int i = 0; i < 2; ++i) { const int idx = tid + 512 * i;
        *(LAS u32x4*)(buf + (idx >> 4) * KROW + (idx & 15) * 16) = st.k[i];
        *(LAS u32x4*)(buf + KT_BYTES + (idx >> 4) * VROW + (idx & 15) * 16) = st.v[i]; }
}

template <int MODE>
__device__ __forceinline__ void tile_compute(const LAS unsigned char* buf, int j, const h16x8 (&qf)[8], f32x16 (&o)[4], float& m, float& l,
                                             bool on, int lo, int hi, int lane, float inv_l, LAS float* imp_q) {
    const int r31 = lane & 31, h = lane >> 5, k0 = j * 64;
    const bool need = on && (k0 <= hi) && (k0 + 63 >= lo);
    if (__ballot(need) == 0ull) return;
    f32x16 s0, s1;
#pragma unroll
    for (int r = 0; r < 16; ++r) { s0[r] = 0.f; s1[r] = 0.f; }
    const LAS unsigned char* kp = buf + r31 * KROW + h * 16;
    {
        h16x8 ka[2][4];
#pragma unroll
        for (int e = 0; e < 2; ++e) { ka[0][2 * e] = *(const LAS h16x8*)(kp + e * 32); ka[0][2 * e + 1] = *(const LAS h16x8*)(kp + 32 * KROW + e * 32); }
#pragma unroll
        for (int g = 0; g < 4; ++g) {
            if (g < 3) {
#pragma unroll
                for (int e = 0; e < 2; ++e) { ka[(g + 1) & 1][2 * e] = *(const LAS h16x8*)(kp + (2 * (g + 1) + e) * 32); ka[(g + 1) & 1][2 * e + 1] = *(const LAS h16x8*)(kp + 32 * KROW + (2 * (g + 1) + e) * 32); }
            }
#pragma unroll
            for (int e = 0; e < 2; ++e) {
                s0 = __builtin_amdgcn_mfma_f32_32x32x16_f16(ka[g & 1][2 * e], qf[2 * g + e], s0, 0, 0, 0);
                s1 = __builtin_amdgcn_mfma_f32_32x32x16_f16(ka[g & 1][2 * e + 1], qf[2 * g + e], s1, 0, 0, 0);
            }
            __builtin_amdgcn_sched_barrier(0);
        }
    }
    const bool full = (k0 >= lo) && (k0 + 63 <= hi);
    const bool simple = (__ballot(on && !full) == 0ull);
    float tm;
    if (simple) {
        tm = fmaxf(s0[0], s1[0]);
#pragma unroll
        for (int r = 1; r < 16; ++r) tm = fmaxf(tm, fmaxf(s0[r], s1[r]));
        if (!on) tm = NEGF;
    } else {
        tm = NEGF;
#pragma unroll
        for (int r = 0; r < 16; ++r) {
            const int key0 = k0 + (r & 3) + 8 * (r >> 2) + 4 * h, key1 = key0 + 32;
            const bool v0 = on && key0 >= lo && key0 <= hi, v1 = on && key1 >= lo && key1 <= hi;
            s0[r] = v0 ? s0[r] : NEGF; s1[r] = v1 ? s1[r] : NEGF;
            tm = fmaxf(tm, fmaxf(s0[r], s1[r]));
        }
    }
    const float tmax = (tm > 0.5f * NEGF) ? tm * LOG2E : NEGF;
    if (MODE != 2) {
        const float tmx = fmaxf(tmax, __shfl_xor(tmax, 32));
        const float m_new = fmaxf(m, tmx);
        const float alpha = __builtin_amdgcn_exp2f(m - m_new);
        const float off = (simple && !on) ? BIGF : m_new;
        float sum = 0.f;
#pragma unroll
        for (int r = 0; r < 16; ++r) {
            s0[r] = __builtin_amdgcn_exp2f(__builtin_fmaf(s0[r], LOG2E, -off));
            s1[r] = __builtin_amdgcn_exp2f(__builtin_fmaf(s1[r], LOG2E, -off));
            sum += s0[r] + s1[r];
        }
        l = l * alpha + sum;
        const bool grew = m_new > m; m = m_new;
        if (MODE == 1) return;
        if (__ballot(grew) != 0ull) {
#pragma unroll
            for (int dt = 0; dt < 4; ++dt) o[dt] = o[dt] * alpha;
        }
    } else {
        const float off = (simple && !on) ? BIGF : m;
#pragma unroll
        for (int r = 0; r < 16; ++r) {
            s0[r] = __builtin_amdgcn_exp2f(__builtin_fmaf(s0[r], LOG2E, -off)) * inv_l;
            s1[r] = __builtin_amdgcn_exp2f(__builtin_fmaf(s1[r], LOG2E, -off)) * inv_l;
        }
#pragma unroll
        for (int c = 0; c < 4; ++c) {
            const int sa = 16 * j + 2 * c + h, sb = sa + 8;
            const float a0 = s0[4 * c] + s0[4 * c + 1] + s0[4 * c + 2] + 0.5f * s0[4 * c + 3], b0 = 0.5f * s0[4 * c + 3];
            const float a1 = s1[4 * c] + s1[4 * c + 1] + s1[4 * c + 2] + 0.5f * s1[4 * c + 3], b1 = 0.5f * s1[4 * c + 3];
            (void)__hip_atomic_fetch_add(imp_q + sa, a0, __ATOMIC_RELAXED, __HIP_MEMORY_SCOPE_WORKGROUP); if (sa + 1 < 128) (void)__hip_atomic_fetch_add(imp_q + sa + 1, b0, __ATOMIC_RELAXED, __HIP_MEMORY_SCOPE_WORKGROUP);
            (void)__hip_atomic_fetch_add(imp_q + sb, a1, __ATOMIC_RELAXED, __HIP_MEMORY_SCOPE_WORKGROUP); if (sb + 1 < 128) (void)__hip_atomic_fetch_add(imp_q + sb + 1, b1, __ATOMIC_RELAXED, __HIP_MEMORY_SCOPE_WORKGROUP);
        }
    }
    h16x8 pb[2][2];
#pragma unroll
    for (int sp = 0; sp < 2; ++sp)
#pragma unroll
        for (int jj = 0; jj < 8; ++jj) { pb[0][sp][jj] = (h16)s0[8 * sp + jj]; pb[1][sp][jj] = (h16)s1[8 * sp + jj]; }
    const LAS unsigned char* vbase = buf + KT_BYTES + (4 * h + ((lane & 15) >> 2)) * VROW + (16 * ((lane >> 4) & 1) + 4 * (lane & 3)) * 2;
    {
        s16x4v vr[2][8];
#pragma unroll
        for (int f = 0; f < 4; ++f) { const LAS unsigned char* vp = vbase + 16 * f * VROW;
            vr[0][2 * f] = __builtin_amdgcn_ds_read_tr16_b64_v4i16((LAS s16x4v*)vp); vr[0][2 * f + 1] = __builtin_amdgcn_ds_read_tr16_b64_v4i16((LAS s16x4v*)(vp + 8 * VROW)); }
#pragma unroll
        for (int dt = 0; dt < 4; ++dt) {
            if (dt < 3) {
#pragma unroll
                for (int f = 0; f < 4; ++f) { const LAS unsigned char* vp = vbase + 16 * f * VROW + 64 * (dt + 1);
                    vr[(dt + 1) & 1][2 * f] = __builtin_amdgcn_ds_read_tr16_b64_v4i16((LAS s16x4v*)vp); vr[(dt + 1) & 1][2 * f + 1] = __builtin_amdgcn_ds_read_tr16_b64_v4i16((LAS s16x4v*)(vp + 8 * VROW)); }
            }
#pragma unroll
            for (int f = 0; f < 4; ++f) {
                const h16x4 l4 = __builtin_bit_cast(h16x4, vr[dt & 1][2 * f]), h4 = __builtin_bit_cast(h16x4, vr[dt & 1][2 * f + 1]);
                h16x8 va; va[0] = l4[0]; va[1] = l4[1]; va[2] = l4[2]; va[3] = l4[3]; va[4] = h4[0]; va[5] = h4[1]; va[6] = h4[2]; va[7] = h4[3];
                o[dt] = __builtin_amdgcn_mfma_f32_32x32x16_f16(va, pb[f >> 1][f & 1], o[dt], 0, 0, 0);
            }
            __builtin_amdgcn_sched_barrier(0);
        }
    }
}

template <int MODE, class OnFn>
__device__ __forceinline__ void stream(LAS unsigned char* lds, const h16* Kg, const h16* VTg, int jlo, int jhi, const h16x8 (&qf)[8],
                                       f32x16 (&o)[4], float& m, float& l, int lo, int hi, const OnFn& on_fn, int tid, int lane, float inv_l, LAS float* imp_q) {
    if (jlo >= jhi) return;
    Stage st;
    stage_load(st, Kg, VTg, jlo, tid);
    stage_write(st, lds, tid);
    __syncthreads();
    for (int j = jlo; j < jhi; ++j) {
        const int cur = (j - jlo) & 1;
        if (j + 1 < jhi) stage_load(st, Kg, VTg, j + 1, tid);
        tile_compute<MODE>(lds + cur * BUF_BYTES, j, qf, o, m, l, on_fn(j), lo, hi, lane, inv_l, imp_q);
        if (j + 1 < jhi) stage_write(st, lds + (cur ^ 1) * BUF_BYTES, tid);
        __syncthreads();
    }
}

__device__ __forceinline__ void load_q(h16x8 (&qf)[8], const h16* qrow, int h) {
#pragma unroll
    for (int s = 0; s < 8; ++s) qf[s] = *(const h16x8*)(qrow + 16 * s + 8 * h);
}
__device__ __forceinline__ void zero_o(f32x16 (&o)[4]) {
#pragma unroll
    for (int dt = 0; dt < 4; ++dt)
#pragma unroll
        for (int r = 0; r < 16; ++r) o[dt][r] = 0.f;
}
}

struct MobaOn { unsigned selmask; int b; __device__ __forceinline__ bool operator()(int j) const { const int jb = j >> 2; return jb == b ? true : (((selmask >> jb) & 1u) != 0u); } };
__device__ __forceinline__ void phase_moba_attn_mfma(const Frame& F) {
    const h16* Q = (const h16*)(F.ws + WS_QKV); const h16* K = Q + (size_t)16 * S * 128; const h16* VT = K + (size_t)16 * S * 128; const h16* Z = VT + (size_t)16 * S * 128;
    const float* kmean = (const float*)(F.ws + WS_KMEAN);
    h16* OZ = (h16*)(F.ws + WS_OZ);
    LAS unsigned char* lds = (LAS unsigned char*)F.lds;
    const int lane = F.lane, r31 = lane & 31, h = lane >> 5;
    for (int it = F.bid; it < 256; it += F.G) {
        const int head = it >> 4, pi = it & 15;
#pragma unroll 1
        for (int half = 0; half < 2; ++half) {
            const int b = half ? 31 - pi : pi;
            const int t = b * 256 + F.wave * 32 + r31;
            h16x8 qf[8]; fa::load_q(qf, Q + ((size_t)head * S + t) * 128, h);
            LAS float* kml = (LAS float*)(lds + 2 * fa::BUF_BYTES);
            __syncthreads();
            for (int i = F.tid; i < b * 32; i += NTHREADS) { const float* km = kmean + (size_t)head * 32 * 128 + i * 4; *(LAS f32x4*)(kml + i * 4) = *(const f32x4*)km + *(const f32x4*)(km + 65536); }
            __syncthreads();
            float v0 = NEGF, v1 = NEGF, v2 = NEGF; int i0 = -1, i1 = -1, i2 = -1;
            for (int jb = 0; jb < b; ++jb) {
                const LAS float* km = kml + jb * 128 + 8 * h;
                float d = 0.f;
#pragma unroll
                for (int s = 0; s < 8; ++s) { const f32x4 ka = *(const LAS f32x4*)(km + 16 * s), kb = *(const LAS f32x4*)(km + 16 * s + 4);
                    d += (float)qf[s][0] * ka[0] + (float)qf[s][1] * ka[1] + (float)qf[s][2] * ka[2] + (float)qf[s][3] * ka[3] + (float)qf[s][4] * kb[0] + (float)qf[s][5] * kb[1] + (float)qf[s][6] * kb[2] + (float)qf[s][7] * kb[3]; }
                d += __shfl_xor(d, 32);
                if (d > v0) { v2 = v1; i2 = i1; v1 = v0; i1 = i0; v0 = d; i0 = jb; }
                else if (d > v1) { v2 = v1; i2 = i1; v1 = d; i1 = jb; }
                else if (d > v2) { v2 = d; i2 = jb; }
            }
            MobaOn on; on.b = b; on.selmask = (i0 >= 0 ? 1u << i0 : 0u) | (i1 >= 0 ? 1u << i1 : 0u) | (i2 >= 0 ? 1u << i2 : 0u);
            fa::f32x16 o[4]; fa::zero_o(o); float m = NEGF, l = 0.f;
            fa::stream<0>(lds, K + (size_t)head * S * 128, VT + (size_t)head * S * 128, 0, 4 * b + 4, qf, o, m, l, 0, t, on, F.tid, lane, 0.f, (LAS float*)nullptr);
            l += __shfl_xor(l, 32);
            const float inv = 1.0f / fmaxf(l, 1e-30f);
#pragma unroll
            for (int dt = 0; dt < 4; ++dt)
#pragma unroll
                for (int c = 0; c < 4; ++c) {
                    const int d = 32 * dt + 8 * c + 4 * h; const size_t off = (size_t)t * 2048 + head * 128 + d;
                    const h16x4 zz = *(const h16x4*)(Z + off); h16x4 ov;
#pragma unroll
                    for (int e = 0; e < 4; ++e) ov[e] = (h16)(o[dt][4 * c + e] * inv * (float)zz[e]);
                    *(h16x4*)(OZ + off) = ov;
                }
        }
    }
}

constexpr size_t WS_MLIST = WS_P;
constexpr size_t WS_MPO = WS_P + 16 * MiB;
constexpr size_t WS_MPML = WS_P + 144 * MiB;
constexpr int CW_MCNT = 8192;
struct ValidOn { bool v; __device__ __forceinline__ bool operator()(int) const { return v; } };

__device__ __forceinline__ void phase_moba_gate(const Frame& F, int jl) {
    const h16* Q = (const h16*)(F.ws + WS_QKV);
    const float* kmean = (const float*)(F.ws + WS_KMEAN);
    unsigned* cnt = (unsigned*)(F.ws + WS_CTL) + CW_MCNT + jl * 512;
    unsigned* list = (unsigned*)(F.ws + WS_MLIST);
    LAS unsigned char* lds = (LAS unsigned char*)F.lds;
    LAS float* kml = (LAS float*)lds;
    const int lane = F.lane, r31 = lane & 31, h = lane >> 5;
    for (int it = F.bid; it < 496; it += F.G) {
        const int head = it / 31, b = it % 31 + 1;
        const int t = b * 256 + F.wave * 32 + r31;
        h16x8 qf[8]; fa::load_q(qf, Q + ((size_t)head * S + t) * 128, h);
        __syncthreads();
        for (int i = F.tid; i < b * 32; i += NTHREADS) { const float* km = kmean + (size_t)head * 32 * 128 + i * 4; *(LAS f32x4*)(kml + i * 4) = *(const f32x4*)km + *(const f32x4*)(km + 65536); }
        __syncthreads();
        float v0 = NEGF, v1 = NEGF, v2 = NEGF; int i0 = -1, i1 = -1, i2 = -1;
        for (int jb = 0; jb < b; ++jb) {
            const LAS float* km = kml + jb * 128 + 8 * h;
            float d = 0.f;
#pragma unroll
            for (int s = 0; s < 8; ++s) { const f32x4 ka = *(const LAS f32x4*)(km + 16 * s), kb = *(const LAS f32x4*)(km + 16 * s + 4);
                d += (float)qf[s][0] * ka[0] + (float)qf[s][1] * ka[1] + (float)qf[s][2] * ka[2] + (float)qf[s][3] * ka[3] + (float)qf[s][4] * kb[0] + (float)qf[s][5] * kb[1] + (float)qf[s][6] * kb[2] + (float)qf[s][7] * kb[3]; }
            d += __shfl_xor(d, 32);
            if (d > v0) { v2 = v1; i2 = i1; v1 = v0; i1 = i0; v0 = d; i0 = jb; }
            else if (d > v1) { v2 = v1; i2 = i1; v1 = d; i1 = jb; }
            else if (d > v2) { v2 = d; i2 = jb; }
        }
        const unsigned long long below = (lane == 0) ? 0ull : (~0ull >> (64 - lane));
        for (int jb = 0; jb < b; ++jb) {
            const bool sel = (h == 0) && (i0 == jb || i1 == jb || i2 == jb);
            const unsigned long long mk = __ballot(sel);
            if (mk != 0ull) {
                unsigned base = 0u;
                if (lane == 0) base = __hip_atomic_fetch_add(cnt + head * 32 + jb, (unsigned)__popcll(mk), __ATOMIC_RELAXED, __HIP_MEMORY_SCOPE_AGENT);
                base = __shfl(base, 0);
                if (sel) { const unsigned slot = (i0 == jb) ? 0u : ((i1 == jb) ? 1u : 2u);
                    list[((size_t)head * 32 + jb) * 8192 + base + __popcll(mk & below)] = (unsigned)t | (slot << 16); }
            }
        }
    }
}

__device__ __forceinline__ void phase_moba_attn_sparse(const Frame& F, int jl) {
    const h16* Q = (const h16*)(F.ws + WS_QKV); const h16* K = Q + (size_t)16 * S * 128; const h16* V = K + (size_t)16 * S * 128;
    const unsigned* cnt = (const unsigned*)(F.ws + WS_CTL) + CW_MCNT + jl * 512;
    const unsigned* list = (const unsigned*)(F.ws + WS_MLIST);
    h16* PO = (h16*)(F.ws + WS_MPO); float* PML = (float*)(F.ws + WS_MPML);
    LAS unsigned char* lds = (LAS unsigned char*)F.lds;
    LAS unsigned* pre = (LAS unsigned*)(lds + 2 * fa::BUF_BYTES);
    LAS unsigned* wsum = pre + 520;
    const int lane = F.lane, r31 = lane & 31, h = lane >> 5;
    __syncthreads();
    { const unsigned n = cnt[F.tid]; const unsigned u = (n + 255u) >> 8; unsigned x = u;
#pragma unroll
      for (int o = 1; o < 64; o <<= 1) { const unsigned y = __shfl_up(x, o); if (lane >= o) x += y; }
      if (lane == 63) wsum[F.wave] = x;
      __syncthreads();
      unsigned off = 0u;
      for (int w = 0; w < F.wave; ++w) off += wsum[w];
      pre[F.tid] = off + x - u;
      if (F.tid == NTHREADS - 1) pre[512] = off + x;
      __syncthreads(); }
    const int U = 512 + (int)pre[512];
    for (int u = F.bid; u < U; u += F.G) {
        int head, jt0, slot = 3, t; bool valid = true;
        if (u < 512) { head = u >> 5; const int b = u & 31; jt0 = 4 * b; t = b * 256 + F.wave * 32 + r31; }
        else {
            const unsigned gq = (unsigned)(u - 512);
            int lo_ = 0, hi_ = 512;
            while (hi_ - lo_ > 1) { const int mid = (lo_ + hi_) >> 1; if (pre[mid] <= gq) lo_ = mid; else hi_ = mid; }
            const int i = lo_; head = i >> 5; jt0 = 4 * (i & 31);
            const unsigned e = (gq - pre[i]) * 256u + F.wave * 32 + r31, n = cnt[i];
            valid = e < n;
            const unsigned ent = valid ? list[(size_t)i * 8192 + e] : 0u;
            t = (int)(ent & 0xFFFFu); slot = (int)(ent >> 16);
        }
        h16x8 qf[8]; fa::load_q(qf, Q + ((size_t)head * S + t) * 128, h);
        fa::f32x16 o[4]; fa::zero_o(o); float m = NEGF, l = 0.f;
        ValidOn on; on.v = valid;
        fa::stream<0>(lds, K + (size_t)head * S * 128, V + (size_t)head * S * 128, jt0, jt0 + 4, qf, o, m, l, 0, (u < 512) ? t : S, on, F.tid, lane, 0.f, (LAS float*)nullptr);
        l += __shfl_xor(l, 32);
        if (valid) {
            const float inv = 1.0f / fmaxf(l, 1e-30f);
            const size_t pidx = ((size_t)t * 16 + head) * 4 + slot;
#pragma unroll
            for (int dt = 0; dt < 4; ++dt)
#pragma unroll
                for (int c = 0; c < 4; ++c) { h16x4 ov;
#pragma unroll
                    for (int e = 0; e < 4; ++e) ov[e] = (h16)(o[dt][4 * c + e] * inv);
                    *(h16x4*)(PO + pidx * 128 + 32 * dt + 8 * c + 4 * h) = ov; }
            if (h == 0) *(f32x2*)(PML + pidx * 2) = (f32x2){m, l};
        }
    }
}

__device__ __forceinline__ void phase_moba_merge(const Frame& F) {
    const h16* Z = (const h16*)(F.ws + WS_QKV) + (size_t)48 * S * 128;
    const h16* PO = (const h16*)(F.ws + WS_MPO); const float* PML = (const float*)(F.ws + WS_MPML);
    h16* OZ = (h16*)(F.ws + WS_OZ);
    const int sub = F.lane >> 4, dc = (F.lane & 15) * 8;
    for (int p0 = (F.bid * 8 + F.wave) * 4; p0 < S * 16; p0 += F.G * 8 * 4) {
        const int pr = p0 + sub, t = pr >> 4, head = pr & 15, nsel = (t >> 8) < 3 ? (t >> 8) : 3;
        const f32x4 ml01 = *(const f32x4*)(PML + (size_t)pr * 8), ml23 = *(const f32x4*)(PML + (size_t)pr * 8 + 4);
        const float m3 = ml23[2], l3 = ml23[3];
        const float m0 = nsel > 0 ? ml01[0] : NEGF, m1 = nsel > 1 ? ml01[2] : NEGF, m2 = nsel > 2 ? ml23[0] : NEGF;
        const float M = fmaxf(fmaxf(m0, m1), fmaxf(m2, m3));
        const float w0 = nsel > 0 ? ml01[1] * __builtin_amdgcn_exp2f(m0 - M) : 0.f, w1 = nsel > 1 ? ml01[3] * __builtin_amdgcn_exp2f(m1 - M) : 0.f;
        const float w2 = nsel > 2 ? ml23[1] * __builtin_amdgcn_exp2f(m2 - M) : 0.f, w3 = l3 * __builtin_amdgcn_exp2f(m3 - M);
        const float inv = 1.0f / fmaxf((w0 + w1) + (w2 + w3), 1e-30f);
        const h16* po = PO + (size_t)pr * 512 + dc;
        float acc[8];
        { const h16x8 x = *(const h16x8*)(po + 384);
#pragma unroll
          for (int e = 0; e < 8; ++e) acc[e] = w3 * (float)x[e]; }
        if (nsel > 0) { const h16x8 x = *(const h16x8*)(po);
#pragma unroll
          for (int e = 0; e < 8; ++e) acc[e] += w0 * (float)x[e]; }
        if (nsel > 1) { const h16x8 x = *(const h16x8*)(po + 128);
#pragma unroll
          for (int e = 0; e < 8; ++e) acc[e] += w1 * (float)x[e]; }
        if (nsel > 2) { const h16x8 x = *(const h16x8*)(po + 256);
#pragma unroll
          for (int e = 0; e < 8; ++e) acc[e] += w2 * (float)x[e]; }
        const size_t off = (size_t)t * 2048 + head * 128 + dc;
        const h16x8 zz = *(const h16x8*)(Z + off); h16x8 ov;
#pragma unroll
        for (int e = 0; e < 8; ++e) ov[e] = (h16)(acc[e] * inv * (float)zz[e]);
        *(h16x8*)(OZ + off) = ov;
    }
}

struct AllOn { __device__ __forceinline__ bool operator()(int) const { return true; } };
struct SelOn { const LAS unsigned* w; __device__ __forceinline__ bool operator()(int j) const { return ((w[j >> 5] >> (j & 31)) & 1u) != 0u; } };
__device__ __forceinline__ void phase_nsa_attn_mfma(const Frame& F) {
    const h16* Q = (const h16*)(F.ws + WS_QKV); const h16* KVb = Q + (size_t)16 * S * 128;
    const h16* Z = (const h16*)(F.ws + WS_QKV + 96 * MiB);
    const float* gates = (const float*)(F.ws + WS_GATES);
    const h16* KCMP = (const h16*)(F.ws + WS_KCMP); const h16* VCMPT = (const h16*)(F.ws + WS_VCMP);
    h16* OZ = (h16*)(F.ws + WS_OZ);
    LAS unsigned char* lds = (LAS unsigned char*)F.lds;
    LAS float* imp = (LAS float*)(lds + fa::LDS_IMP); LAS unsigned* selw = (LAS unsigned*)(lds + fa::LDS_SELW); LAS float* sv = (LAS float*)(lds + fa::LDS_SV) + F.wave * 128;
    const int lane = F.lane, r31 = lane & 31, h = lane >> 5, hh = F.wave & 3, qsub = F.wave >> 2;
    for (int it = F.bid; it < 256; it += F.G) {
        const int g = it >> 6, pi = it & 63, head = 4 * g + hh;
#pragma unroll 1
        for (int half = 0; half < 2; ++half) {
            const int c64 = half ? 127 - pi : pi;
            const int ql = 32 * qsub + r31, t = c64 * 64 + ql;
            h16x8 qf[8]; fa::load_q(qf, Q + ((size_t)head * S + t) * 128, h);
            fa::f32x16 o[4]; float m, l;
            for (int i = F.tid; i < 64 * 128; i += NTHREADS) imp[i] = 0.f;
            const int nval = (t >= 31) ? (((t - 31) >> 4) + 1 < NC ? ((t - 31) >> 4) + 1 : NC) : 0;
            const int tl = c64 * 64 + 63; const int nval_max = (tl >= 31) ? (((tl - 31) >> 4) + 1 < NC ? ((tl - 31) >> 4) + 1 : NC) : 0;
            const int jc = (nval_max + 63) >> 6;
            fa::zero_o(o); m = NEGF; l = 0.f;
            fa::stream<1>(lds, KCMP + (size_t)g * 512 * 128, VCMPT + (size_t)g * 512 * 128, 0, jc, qf, o, m, l, 0, nval - 1, AllOn(), F.tid, lane, 0.f, (LAS float*)nullptr);
            l += __shfl_xor(l, 32);
            { const float invl = 1.0f / fmaxf(l, 1e-30f); float l2 = 0.f;
              fa::stream<2>(lds, KCMP + (size_t)g * 512 * 128, VCMPT + (size_t)g * 512 * 128, 0, jc, qf, o, m, l2, 0, nval - 1, AllOn(), F.tid, lane, invl, imp + ql * 128); }
            const float g0 = gates[(size_t)t * 48 + head * 3 + 0];
#pragma unroll
            for (int dt = 0; dt < 4; ++dt)
#pragma unroll
                for (int c = 0; c < 4; ++c) { h16x4 ov;
#pragma unroll
                    for (int e = 0; e < 4; ++e) ov[e] = (h16)(o[dt][4 * c + e] * g0);
                    *(h16x4*)(OZ + (size_t)t * 2048 + head * 128 + 32 * dt + 8 * c + 4 * h) = ov; }
            __syncthreads();
            for (int qq = 0; qq < 8; ++qq) {
                const int q = F.wave * 8 + qq;
                float myv[2];
#pragma unroll
                for (int c = 0; c < 2; ++c) { const int s = lane + 64 * c; const bool valid = s <= c64, forced = (s == 0) || (s == c64) || (s == c64 - 1);
                    myv[c] = valid ? (forced ? BIGF : imp[q * 128 + s]) : NEGF; sv[s] = myv[c]; }
                wave_lds_fence();
                int rank0 = 0, rank1 = 0;
                for (int s2 = 0; s2 < 128; ++s2) { const float v2 = sv[s2];
                    rank0 += (v2 > myv[0] || (v2 == myv[0] && s2 < lane)) ? 1 : 0; rank1 += (v2 > myv[1] || (v2 == myv[1] && s2 < lane + 64)) ? 1 : 0; }
                const unsigned long long m0 = __ballot(rank0 < 16 && lane <= c64), m1 = __ballot(rank1 < 16 && (lane + 64) <= c64);
                if (lane == 0) { selw[q * 4 + 0] = (unsigned)m0; selw[q * 4 + 1] = (unsigned)(m0 >> 32); selw[q * 4 + 2] = (unsigned)m1; selw[q * 4 + 3] = (unsigned)(m1 >> 32); }
                wave_lds_fence();
            }
            __syncthreads();
            SelOn son; son.w = selw + ql * 4;
            fa::zero_o(o); m = NEGF; l = 0.f;
            fa::stream<0>(lds, KVb + ((size_t)2 * 4 + g) * S * 128, KVb + ((size_t)3 * 4 + g) * S * 128, 0, c64 + 1, qf, o, m, l, 0, t, son, F.tid, lane, 0.f, (LAS float*)nullptr);
            l += __shfl_xor(l, 32);
            { const float sc = gates[(size_t)t * 48 + head * 3 + 1] / fmaxf(l, 1e-30f);
#pragma unroll
              for (int dt = 0; dt < 4; ++dt)
#pragma unroll
                  for (int c = 0; c < 4; ++c) { h16* p = OZ + (size_t)t * 2048 + head * 128 + 32 * dt + 8 * c + 4 * h; const h16x4 pv = *(const h16x4*)p; h16x4 ov;
#pragma unroll
                      for (int e = 0; e < 4; ++e) ov[e] = (h16)((float)pv[e] + o[dt][4 * c + e] * sc);
                      *(h16x4*)p = ov; } }
            fa::zero_o(o); m = NEGF; l = 0.f;
            fa::stream<0>(lds, KVb + ((size_t)4 * 4 + g) * S * 128, KVb + ((size_t)5 * 4 + g) * S * 128, (c64 >= 8 ? c64 - 8 : 0), c64 + 1, qf, o, m, l, t - 511, t, AllOn(), F.tid, lane, 0.f, (LAS float*)nullptr);
            l += __shfl_xor(l, 32);
            const float sc2 = gates[(size_t)t * 48 + head * 3 + 2] / fmaxf(l, 1e-30f);
#pragma unroll
            for (int dt = 0; dt < 4; ++dt)
#pragma unroll
                for (int c = 0; c < 4; ++c) {
                    const int d = 32 * dt + 8 * c + 4 * h; const size_t off = (size_t)t * 2048 + head * 128 + d;
                    const h16x4 zz = *(const h16x4*)(Z + off); const h16x4 pv = *(const h16x4*)(OZ + off); h16x4 ov;
#pragma unroll
                    for (int e = 0; e < 4; ++e) ov[e] = (h16)(((float)pv[e] + o[dt][4 * c + e] * sc2) * (float)zz[e]);
                    *(h16x4*)(OZ + off) = ov;
                }
        }
    }
}

namespace rt {
typedef float f32x16 __attribute__((ext_vector_type(16)));
typedef short s16x4v __attribute__((__vector_size__(4 * sizeof(short))));
constexpr int SP = 144, STILE = 128 * SP;
constexpr int VP = 1088, VTILE = 32 * VP;
__device__ __forceinline__ h16x8 tr16(const LAS unsigned char* p0, const LAS unsigned char* p1) {
    const s16x4v a = __builtin_amdgcn_ds_read_tr16_b64_v4i16((LAS s16x4v*)p0), b = __builtin_amdgcn_ds_read_tr16_b64_v4i16((LAS s16x4v*)p1);
    const h16x4 x = __builtin_bit_cast(h16x4, a), y = __builtin_bit_cast(h16x4, b);
    h16x8 r; r[0] = x[0]; r[1] = x[1]; r[2] = x[2]; r[3] = x[3]; r[4] = y[0]; r[5] = y[1]; r[6] = y[2]; r[7] = y[3]; return r;
}
}
__device__ __forceinline__ void phase_ret_scan_mfma(const Frame& F, const Args& A) {
    const h16* RQ = (const h16*)(F.ws + WS_QKV); const h16* RK = RQ + (size_t)8 * S * 256; const h16* RV = RK + (size_t)8 * S * 256;
    h16* ST = (h16*)(F.ws + WS_P);
    LAS unsigned char* lds = (LAS unsigned char*)F.lds;
    const int lane = F.lane, g = lane >> 4, q = (lane & 15) >> 2, p = lane & 3, mr = F.wave >> 1, nc0 = (F.wave & 1) * 2;
    for (int it = F.bid; it < 256; it += F.G) {
        const int h = it >> 5, dk0 = ((it >> 3) & 3) * 64, dv0 = (it & 7) * 64;
        const float lg = A.lg2g[h], carry = __builtin_amdgcn_exp2f(128.f * lg);
        f32x4 acc[2] = {(f32x4){0.f, 0.f, 0.f, 0.f}, (f32x4){0.f, 0.f, 0.f, 0.f}};
        u32x4 kreg[2], vreg[2];
#define RT_LOAD(c) do { int tid_ = F.tid; asm volatile("" : "+v"(tid_)); _Pragma("unroll") for (int i = 0; i < 2; ++i) { const int idx = tid_ + 512 * i, row = idx >> 3, c16 = idx & 7; \
            kreg[i] = *(const u32x4*)(RK + ((size_t)h * S + (c) * 128 + row) * 256 + dk0 + c16 * 8); vreg[i] = *(const u32x4*)(RV + ((size_t)h * S + (c) * 128 + row) * 512 + dv0 + c16 * 8); } } while (0)
#define RT_WRITE(b) do { int tid_ = F.tid; asm volatile("" : "+v"(tid_)); _Pragma("unroll") for (int i = 0; i < 2; ++i) { const int idx = tid_ + 512 * i, row = idx >> 3, c16 = idx & 7; \
            const float w = __builtin_amdgcn_exp2f((float)(127 - row) * lg); h16x8 kk = __builtin_bit_cast(h16x8, kreg[i]); \
            _Pragma("unroll") for (int e = 0; e < 8; ++e) kk[e] = (h16)((float)kk[e] * w); \
            *(LAS h16x8*)(lds + (b) * 2 * rt::STILE + row * rt::SP + c16 * 16) = kk; *(LAS u32x4*)(lds + (b) * 2 * rt::STILE + rt::STILE + row * rt::SP + c16 * 16) = vreg[i]; } } while (0)
        __syncthreads();
        RT_LOAD(0); RT_WRITE(0);
        __syncthreads();
        for (int c = 0; c < 64; ++c) {
            const int cur = c & 1;
#pragma unroll
            for (int n = 0; n < 2; ++n) { h16x4 o; o[0] = (h16)acc[n][0]; o[1] = (h16)acc[n][1]; o[2] = (h16)acc[n][2]; o[3] = (h16)acc[n][3];
                *(h16x4*)(ST + (((size_t)(h * 64 + c)) * 512 + dv0 + 16 * (nc0 + n) + (lane & 15)) * 256 + dk0 + 16 * mr + 4 * g) = o; }
            if (c + 1 < 64) RT_LOAD(c + 1);
            acc[0] = acc[0] * carry; acc[1] = acc[1] * carry;
            const LAS unsigned char* kt = lds + cur * 2 * rt::STILE + (8 * g + q) * rt::SP + (16 * mr + 4 * p) * 2;
            const LAS unsigned char* vt = lds + cur * 2 * rt::STILE + rt::STILE + (8 * g + q) * rt::SP + (16 * nc0 + 4 * p) * 2;
#pragma unroll
            for (int ks = 0; ks < 4; ++ks) {
                const h16x8 a = rt::tr16(kt + 32 * ks * rt::SP, kt + (32 * ks + 4) * rt::SP);
                const h16x8 b0 = rt::tr16(vt + 32 * ks * rt::SP, vt + (32 * ks + 4) * rt::SP);
                const h16x8 b1 = rt::tr16(vt + 32 * ks * rt::SP + 32, vt + (32 * ks + 4) * rt::SP + 32);
                acc[0] = __builtin_amdgcn_mfma_f32_16x16x32_f16(a, b0, acc[0], 0, 0, 0);
                acc[1] = __builtin_amdgcn_mfma_f32_16x16x32_f16(a, b1, acc[1], 0, 0, 0);
            }
            if (c + 1 < 64) RT_WRITE(cur ^ 1);
            __syncthreads();
        }
#undef RT_LOAD
#undef RT_WRITE
    }
}

__device__ __forceinline__ void phase_ret_out_mfma(const Frame& F, const Args& A) {
    const h16* RQ = (const h16*)(F.ws + WS_QKV); const h16* RK = RQ + (size_t)8 * S * 256; const h16* RV = RK + (size_t)8 * S * 256; const h16* RG = RV + (size_t)8 * S * 512;
    const h16* ST = (const h16*)(F.ws + WS_P);
    h16* OZ = (h16*)(F.ws + WS_OZ);
    LAS unsigned char* lds = (LAS unsigned char*)F.lds;
    LAS float* stats = (LAS float*)(lds + 2 * rt::VTILE);
    const int lane = F.lane, r31 = lane & 31, hh = lane >> 5, itl = F.wave & 3, dvh = F.wave >> 2;
    for (int it = F.bid; it < 512; it += F.G) {
        const int h = it >> 6, c = it & 63, il = 32 * itl + r31, tok = c * 128 + il;
        const float lg = A.lg2g[h];
        rt::f32x16 acc[8];
#pragma unroll
        for (int r = 0; r < 8; ++r)
#pragma unroll
            for (int e = 0; e < 16; ++e) acc[r][e] = 0.f;
        const h16* qrow = RQ + ((size_t)h * S + tok) * 256 + 8 * hh;
        u32x4 vreg[4];
#define RO_LOAD(jt) do { int tid_ = F.tid; asm volatile("" : "+v"(tid_)); _Pragma("unroll") for (int i = 0; i < 4; ++i) { const int idx = tid_ + 512 * i; \
            vreg[i] = *(const u32x4*)(RV + ((size_t)h * S + c * 128 + 32 * (jt) + (idx >> 6)) * 512 + (idx & 63) * 8); } } while (0)
#define RO_WRITE(b) do { int tid_ = F.tid; asm volatile("" : "+v"(tid_)); _Pragma("unroll") for (int i = 0; i < 4; ++i) { const int idx = tid_ + 512 * i; \
            *(LAS u32x4*)(lds + (b) * rt::VTILE + (idx >> 6) * rt::VP + (idx & 63) * 16) = vreg[i]; } } while (0)
        __syncthreads();
        RO_LOAD(0);
        {
            const h16* srow = ST + (((size_t)(h * 64 + c)) * 512 + dvh * 256 + r31) * 256 + 8 * hh;
#pragma unroll 2
            for (int ks = 0; ks < 16; ++ks) {
                const h16x8 qf = *(const h16x8*)(qrow + 16 * ks);
#pragma unroll
                for (int r = 0; r < 8; ++r) { const h16x8 a = *(const h16x8*)(srow + (size_t)r * 32 * 256 + 16 * ks); acc[r] = __builtin_amdgcn_mfma_f32_32x32x16_f16(a, qf, acc[r], 0, 0, 0); }
            }
            const float rdec = __builtin_amdgcn_exp2f((float)(il + 1) * lg);
#pragma unroll
            for (int r = 0; r < 8; ++r) acc[r] = acc[r] * rdec;
        }
        RO_WRITE(0);
        __syncthreads();
        for (int jt = 0; jt < 4; ++jt) {
            const int cur = jt & 1;
            if (jt + 1 < 4) RO_LOAD(jt + 1);
            if (jt <= itl) {
                rt::f32x16 sT;
#pragma unroll
                for (int e = 0; e < 16; ++e) sT[e] = 0.f;
                const h16* krow = RK + ((size_t)h * S + c * 128 + 32 * jt + r31) * 256 + 8 * hh;
#pragma unroll 4
                for (int ks = 0; ks < 16; ++ks) sT = __builtin_amdgcn_mfma_f32_32x32x16_f16(*(const h16x8*)(krow + 16 * ks), *(const h16x8*)(qrow + 16 * ks), sT, 0, 0, 0);
                h16x8 pb[2];
#pragma unroll
                for (int e = 0; e < 16; ++e) { const int kl = 32 * jt + (e & 3) + 8 * (e >> 2) + 4 * hh, df = il - kl;
                    const float pv = (df >= 0) ? sT[e] * __builtin_amdgcn_exp2f((float)df * lg) : 0.f; pb[e >> 3][e & 7] = (h16)pv; }
                const LAS unsigned char* vbase = lds + cur * rt::VTILE + (4 * hh + ((lane & 15) >> 2)) * rt::VP + (dvh * 256 + 16 * ((lane >> 4) & 1) + 4 * (lane & 3)) * 2;
#pragma unroll
                for (int r = 0; r < 8; ++r) {
#pragma unroll
                    for (int sp = 0; sp < 2; ++sp) { const LAS unsigned char* vp = vbase + 16 * sp * rt::VP + 64 * r;
                        acc[r] = __builtin_amdgcn_mfma_f32_32x32x16_f16(rt::tr16(vp, vp + 8 * rt::VP), pb[sp], acc[r], 0, 0, 0); }
                    if (r & 1) __builtin_amdgcn_sched_barrier(0);
                }
            }
            if (jt + 1 < 4) RO_WRITE(cur ^ 1);
            __syncthreads();
        }
#undef RO_LOAD
#undef RO_WRITE
        float s1 = 0.f, s2 = 0.f;
#pragma unroll
        for (int r = 0; r < 8; ++r)
#pragma unroll
            for (int e = 0; e < 16; ++e) { s1 += acc[r][e]; s2 += acc[r][e] * acc[r][e]; }
        s1 += __shfl_xor(s1, 32); s2 += __shfl_xor(s2, 32);
        if (hh == 0) { stats[(F.wave * 32 + r31) * 2] = s1; stats[(F.wave * 32 + r31) * 2 + 1] = s2; }
        __syncthreads();
        s1 += stats[((F.wave ^ 4) * 32 + r31) * 2]; s2 += stats[((F.wave ^ 4) * 32 + r31) * 2 + 1];
        const float mu = s1 * (1.0f / 512.0f), var = fmaxf(s2 * (1.0f / 512.0f) - mu * mu, 0.f), rs = 1.0f / sqrtf(var + EPS);
#pragma unroll
        for (int r = 0; r < 8; ++r)
#pragma unroll
            for (int cq = 0; cq < 4; ++cq) {
                const size_t off = (size_t)tok * 4096 + h * 512 + dvh * 256 + 32 * r + 8 * cq + 4 * hh;
                const h16x4 gv = *(const h16x4*)(RG + off); h16x4 ov;
#pragma unroll
                for (int e = 0; e < 4; ++e) ov[e] = (h16)((float)gv[e] * ((acc[r][4 * cq + e] - mu) * rs));
                *(h16x4*)(OZ + off) = ov;
            }
    }
}

template <int KIND>
__device__ __forceinline__ void phase_gemm_proj(const Frame& F, int N) {
    pg8::Gemm g{(const h16*)(F.ws + WS_H), (const h16*)(F.ws + WS_WTIN), S, N, 2048, 2048, 2048}; pg8::StaticOrder So; So.init(S, N, F.G, F.bid);
    pg8::EpiProj<KIND> E{F.ws};
    pg8::gemm_phase<pg8::EpiProj<KIND>, pg8::StaticOrder, true, true>((LAS unsigned char*)F.lds, g, So, E);
}
__device__ __forceinline__ void phase_gemm(const Frame& F, const h16* A, const h16* Bt, int N, int K, void* O, int ldc, int f32out) {
    pg8::Gemm g{A, Bt, S, N, K, K, K}; pg8::StaticOrder So; So.init(S, N, F.G, F.bid);
    pg8::EpiStore E{O, ldc, f32out};
    pg8::gemm_phase<pg8::EpiStore, pg8::StaticOrder, true, true>((LAS unsigned char*)F.lds, g, So, E);
}

constexpr int NPHASE = 2 + 8 * DEPTH;
__host__ __device__ inline bool phase_exists(int p) {
    if (p < 2) return true;
    const int L = (p - 2) / 8, s = (p - 2) % 8, kind = L % 3;
    if (s == 7) return false;
    if (s == 1) return kind == 1 || (kind == 0 && MOBA_SPARSE);
    if (s == 2) return kind != 0 || MOBA_SPARSE;
    if (s == 4) return false;
    return true;
}

__global__ void __launch_bounds__(NTHREADS, 2) trunk_fwd(Args args) {
    extern __shared__ __attribute__((aligned(16))) unsigned char lds_raw[];
    Frame F;
    F.out = args.out; F.ws = args.ws; F.lds = (char*)lds_raw;
    F.tid = threadIdx.x; F.lane = F.tid & 63; F.wave = __builtin_amdgcn_readfirstlane(F.tid >> 6); F.G = gridDim.x; F.bid = blockIdx.x;
    volatile LAS unsigned* misc = (volatile LAS unsigned*)((LAS unsigned char*)lds_raw + MISC_OFF);
    if (F.tid < 16) misc[F.tid] = 0u;
    __syncthreads();
    XcdBarrier bar; bar.bar = (unsigned*)(F.ws + WS_CTL) + CW_BAR; bar.x = 0; bar.st = misc;
#if ONE_LAUNCH
    bar = xcd_barrier_post((unsigned*)(F.ws + WS_CTL) + CW_BAR, misc);
    cg::grid_group grid = cg::this_grid();
#endif
    const int lo = args.ph_lo, hi = args.ph_hi;
#if ONE_LAUNCH
    grid.sync();
#define SEAM(p) do { if ((p) > lo) xcd_barrier(bar); } while (0)
#else
#define SEAM(p) do { } while (0)
#endif
#define IN(p) (lo <= (p) && (p) < hi)
#ifndef PHMASK
#define PHMASK 0xFFFF
#endif
#define EN(b) ((PHMASK >> (b)) & 1)
#ifndef PROBE_DUP
#define PROBE_DUP 0
#endif
#define DUP(b, call) do { if ((PROBE_DUP >> (b)) & 1) { if (ONE_LAUNCH) xcd_barrier(bar); call; } } while (0)
    if (EN(0) && IN(0)) { SEAM(0); phase_prologue(F, args); }
    if (EN(1) && IN(1)) { SEAM(1); phase_norm(F, args, -1, 0); }
#define LAYER(L) do { \
        constexpr int kind = (L) % 3, base = 2 + 8 * (L); \
        constexpr int Nin = kind == 0 ? 8192 : (kind == 1 ? NSA_NP : 12288); \
        constexpr int Kout = kind == 2 ? 4096 : 2048; \
        if (EN(2) && IN(base + 0)) { SEAM(base + 0); phase_gemm_proj<kind>(F, Nin); } \
        if (EN(6) && kind == 1 && IN(base + 1)) { SEAM(base + 1); phase_nsa_cmp_a(F); } \
        if (EN(8) && kind == 0 && MOBA_SPARSE && IN(base + 1)) { SEAM(base + 1); phase_moba_gate(F, (L) / 3); } \
        if (EN(8) && kind == 0 && MOBA_SPARSE && IN(base + 2)) { SEAM(base + 2); phase_moba_attn_sparse(F, (L) / 3); } \
        if (kind != 0 && IN(base + 2)) { SEAM(base + 2); if (EN(6) && kind == 1) { phase_nsa_cmp_b(F, args); } else if (EN(7) && kind == 2) { phase_ret_scan_mfma(F, args); } } \
        if (IN(base + 3)) { SEAM(base + 3); if (EN(8) && kind == 0) { if (MOBA_SPARSE) phase_moba_merge(F); else phase_moba_attn_mfma(F); } else if (EN(9) && kind == 1) { phase_nsa_attn_mfma(F); DUP(9, phase_nsa_attn_mfma(F)); } else if (EN(10) && kind == 2) { phase_ret_out_mfma(F, args); } } \
        if (EN(2) && IN(base + 5)) { SEAM(base + 5); phase_gemm(F, (const h16*)(F.ws + WS_OZ), (const h16*)(F.ws + WS_WTOUT), 2048, Kout, F.ws + WS_Y, 2048, 1); } \
        if (EN(1) && IN(base + 6)) { SEAM(base + 6); phase_norm(F, args, (L), (L) + 1 < DEPTH ? (L) + 1 : -1); } \
    } while (0)
    LAYER(0); LAYER(1); LAYER(2); LAYER(3);
#undef LAYER
#undef EN
#undef DUP
#undef IN
#undef SEAM
}

extern "C" void kernel_launch(void* const* d_in, const int* in_sizes, int n_in, void* d_out, int out_size, void* d_ws, size_t ws_size, hipStream_t stream) {
    static int grid = 0;
    if (grid == 0) {
        if (n_in != 18 || out_size != S * D || ws_size < WS_END) { fprintf(stderr, "kernel_launch: unexpected shapes (n_in %d, out %d, ws %zu)\n", n_in, out_size, ws_size); grid = -1; return; }
        int dev = 0, cus = 0, per_cu = 0;
        if (hipGetDevice(&dev) != hipSuccess || hipDeviceGetAttribute(&cus, hipDeviceAttributeMultiprocessorCount, dev) != hipSuccess) { grid = -1; return; }
        if (hipFuncSetAttribute((const void*)trunk_fwd, hipFuncAttributeMaxDynamicSharedMemorySize, LDS_BYTES) != hipSuccess) { fprintf(stderr, "kernel_launch: hipFuncSetAttribute failed\n"); grid = -1; return; }
        if (hipOccupancyMaxActiveBlocksPerMultiprocessor(&per_cu, (const void*)trunk_fwd, NTHREADS, LDS_BYTES) != hipSuccess || per_cu < 1) { fprintf(stderr, "kernel_launch: occupancy query says %d\n", per_cu); per_cu = 1; }
        (void)hipGetLastError();
        grid = cus;
    }
    if (grid < 0) return;
    (void)hipMemsetAsync((char*)d_ws + WS_CTL, 0, CTL_ZERO_BYTES, stream);
    Args a{};
    for (int i = 0; i < 18; ++i) a.in[i] = (const float*)d_in[i];
    a.out = (float*)d_out; a.ws = (unsigned char*)d_ws;
    for (int j = 0; j < 16; ++j) a.inv16[j] = pow(500000.0, -(double)j / 16.0);
    for (int j = 0; j < 128; ++j) a.inv128[j] = pow(10000.0, -(double)j / 128.0);
    for (int h = 0; h < 8; ++h) a.lg2g[h] = (float)log2(1.0 - ldexp(1.0, -5 - h));
#if ONE_LAUNCH
    a.ph_lo = 0; a.ph_hi = NPHASE;
    void* kargs[] = {&a};
    hipError_t e = hipLaunchCooperativeKernel((const void*)trunk_fwd, dim3(grid), dim3(NTHREADS), kargs, LDS_BYTES, stream);
    if (e != hipSuccess) fprintf(stderr, "kernel_launch: cooperative launch failed: %s (grid %d)\n", hipGetErrorString(e), grid);
#else
    for (int p = 0; p < NPHASE; ++p) {
        if (!phase_exists(p)) continue;
        a.ph_lo = p; a.ph_hi = p + 1;
        hipLaunchKernelGGL(trunk_fwd, dim3(grid), dim3(NTHREADS), LDS_BYTES, stream, a);
    }
#endif
}
```

```cpp
#include <hip/hip_runtime.h>
#include <hip/hip_cooperative_groups.h>
#include <cstdio>
#include <cstdint>
#include <cmath>
namespace cg = cooperative_groups;

#ifndef ONE_LAUNCH
#define ONE_LAUNCH 1
#endif
#ifndef MOBA_SPARSE
#define MOBA_SPARSE 1
#endif
#ifndef MOBA_MFMA
#define MOBA_MFMA 1
#endif
#ifndef NSA_MFMA
#define NSA_MFMA 1
#endif

#define LAS __attribute__((address_space(3)))
typedef _Float16 h16;
typedef _Float16 h16x2 __attribute__((ext_vector_type(2)));
typedef _Float16 h16x4 __attribute__((ext_vector_type(4)));
typedef _Float16 h16x8 __attribute__((ext_vector_type(8)));
typedef float f32x2 __attribute__((ext_vector_type(2)));
typedef float f32x4 __attribute__((ext_vector_type(4)));
typedef unsigned u32x4 __attribute__((ext_vector_type(4)));

constexpr int S = 8192, D = 2048, DEPTH = 4;
constexpr float EPS = 1e-6f;
constexpr float NEGF = -1e30f, BIGF = 1e30f;
constexpr int NSA_NP = 7424;
constexpr int NC = 511;

constexpr size_t MiB = 1u << 20;
constexpr size_t WS_CTL = 0, CTL_ZERO_BYTES = 1 * MiB;
constexpr size_t WS_MODP = 1 * MiB;
constexpr size_t WS_KMEAN = 4 * MiB + 512 * 1024;
constexpr size_t WS_CMPB = 2 * MiB + 512 * 1024;
constexpr size_t WS_GATES = 3 * MiB;
constexpr size_t WS_KCMP = 5 * MiB;
constexpr size_t WS_VCMP = 5 * MiB + 512 * 1024;
constexpr size_t WS_ROPE16 = 6 * MiB;
constexpr size_t WS_ROPE128 = 7 * MiB;
constexpr size_t WS_WTIN = 16 * MiB;
constexpr size_t WS_WTOUT = 64 * MiB;
constexpr size_t WS_W1T = 72 * MiB;
constexpr size_t WS_H = 80 * MiB;
constexpr size_t WS_P = 112 * MiB;
constexpr size_t WS_QKV = 304 * MiB;
constexpr size_t WS_OZ = 496 * MiB;
constexpr size_t WS_Y = 560 * MiB;
constexpr size_t WS_OR = 624 * MiB;
constexpr size_t WS_END = 752 * MiB;

constexpr int LDS_BYTES = 147456;
constexpr int MISC_OFF = 135168;
constexpr int NTHREADS = 512;

struct Args {
    const float* in[18];
    float* out;
    unsigned char* ws;
    double inv16[16];
    double inv128[128];
    float lg2g[8];
    int ph_lo, ph_hi;
};

#define XB_TMO      128
#define XB_XCNT(j)  (256  + 64 * (j))
#define XB_XSUB(j)  (1280 + 64 * (j))
#define XB_XGEN(j)  (2304 + 64 * (j))
#define XB_TOP      3328
#define XB_TOPGEN   3392
#define XCD_BAR_WORDS 3456
#define XB_SPIN_CAP (1u << 24)
constexpr int CW_BAR = 4096;

__device__ __forceinline__ unsigned xb_ld(unsigned* p)              { return __hip_atomic_load(p, __ATOMIC_RELAXED, __HIP_MEMORY_SCOPE_AGENT); }
__device__ __forceinline__ unsigned xb_add(unsigned* p, unsigned v) { return __hip_atomic_fetch_add(p, v, __ATOMIC_RELAXED, __HIP_MEMORY_SCOPE_AGENT); }
__device__ __forceinline__ unsigned xb_xcc_id() { return (unsigned)__builtin_amdgcn_s_getreg((3 << 11) | 20) & 0xFu; }
#define XB_SPIN(cond, bar) do { unsigned _sp = 0; while (cond) { __builtin_amdgcn_s_sleep(1); \
    if ((++_sp & 255u) == 0u) { if (xb_ld(&(bar)[XB_TMO])) break; if (_sp > XB_SPIN_CAP) { atomicAdd(&(bar)[XB_TMO], 1u); break; } } } } while (0)

struct XcdBarrier { unsigned* bar; unsigned x; volatile LAS unsigned* st; };

__device__ __forceinline__ XcdBarrier xcd_barrier_post(unsigned* bar, volatile LAS unsigned* st) {
    XcdBarrier b; b.bar = bar; b.x = xb_xcc_id(); b.st = st;
    if (threadIdx.x == 0) (void)xb_add(&bar[XB_XCNT(b.x)], 1u);
    return b;
}
__device__ __forceinline__ void xcd_barrier_complete(unsigned* bar, unsigned x, unsigned& nloc, unsigned& nx) {
    const unsigned G = gridDim.x * gridDim.y * gridDim.z;
    unsigned sum, cnt, mine, sp = 0u;
    for (;;) {
        sum = 0u; cnt = 0u; mine = 0u;
#pragma unroll
        for (unsigned j = 0; j < 16; ++j) { const unsigned c = xb_ld(&bar[XB_XCNT(j)]); sum += c; cnt += (c > 0u) ? 1u : 0u; mine = (j == x) ? c : mine; }
        if (sum == G) break;
        __builtin_amdgcn_s_sleep(1);
        if ((++sp & 255u) == 0u) { if (xb_ld(&bar[XB_TMO])) break; if (sp > XB_SPIN_CAP) { atomicAdd(&bar[XB_TMO], 1u); break; } }
    }
    nloc = mine > 0u ? mine : 1u; nx = cnt > 0u ? cnt : 1u;
}
__device__ __forceinline__ void xcd_barrier(const XcdBarrier& b) {
    asm volatile("s_waitcnt vmcnt(0)" ::: "memory");
    __syncthreads();
    if (threadIdx.x == 0) {
        unsigned* bar = b.bar;
        __builtin_amdgcn_s_waitcnt(0);
        unsigned nloc = b.st[0], nx = b.st[1];
        if (nloc == 0u) { xcd_barrier_complete(bar, b.x, nloc, nx); b.st[0] = nloc; b.st[1] = nx; }
        const unsigned old = xb_add(&bar[XB_XSUB(b.x)], 1u);
        const unsigned gen = old / nloc;
        if (old + 1u == (gen + 1u) * nloc) {
            __builtin_amdgcn_fence(__ATOMIC_RELEASE, "agent");
            asm volatile("s_waitcnt vmcnt(0)" ::: "memory");
            const unsigned og = xb_add(&bar[XB_TOP], 1u);
            const unsigned tg = og / nx;
            if (og + 1u == (tg + 1u) * nx) xb_add(&bar[XB_TOPGEN], 1u);
            else XB_SPIN(xb_ld(&bar[XB_TOPGEN]) == tg, bar);
            __builtin_amdgcn_fence(__ATOMIC_ACQUIRE, "agent");
            xb_add(&bar[XB_XGEN(b.x)], 1u);
            asm volatile("s_waitcnt vmcnt(0)" ::: "memory");
        } else {
            XB_SPIN(xb_ld(&bar[XB_XGEN(b.x)]) == gen, bar);
            __builtin_amdgcn_fence(__ATOMIC_ACQUIRE, "agent");
            asm volatile("s_waitcnt vmcnt(0)" ::: "memory");
        }
    }
    __syncthreads();
}

__device__ __forceinline__ float silu_f(float x) { return x / (1.f + __expf(-x)); }
__device__ __forceinline__ float sigmoid_f(float x) { return 1.f / (1.f + __expf(-x)); }

namespace pg8 {
constexpr int BM = 256, BK = 64, HALF = 128, HTB = HALF * BK * 2, STAGE_BYTES = 8 * HTB, NXCD = 8, WGM = 8;
__host__ __device__ __forceinline__ int lds_byte(int r, int c) { const int st = (r >> 4) * 2 + (c >> 5), rr = r & 15, cc = c & 31, ob = rr * 64 + cc * 2; return st * 1024 + (ob ^ (((ob >> 9) & 1) << 5)); }
__host__ __device__ __forceinline__ void stage_rc(int b, int& R, int& C) { const int st = b / 1024, sb = b % 1024, swz = sb ^ (((sb >> 9) & 1) << 5); R = (st >> 1) * 16 + swz / 64; C = (st & 1) * 32 + (swz % 64) / 2; }
__host__ __device__ __forceinline__ int perm32(int rho) { const int n = rho >> 4, i = rho & 15; return 8 * (i >> 2) + 4 * n + (i & 3); }

struct Unit { int pm, pn; };
struct Gemm { const h16* A; const h16* Bt; int M, N, K, lda, ldb; };

struct StaticOrder {
    int nM, nN, nwg, G, c;
    __host__ __device__ void init(int M, int N, int G_, int c_) { nM = M / BM; nN = N / BM; nwg = nM * nN; G = G_; c = c_; }
    __host__ __device__ bool next(int i, Unit& u) const {
        const long L = (long)i * G + c; if (L >= nwg) return false;
        int wgid = (int)L; { const int q = nwg / NXCD, r = nwg % NXCD, xcd = wgid % NXCD, off = wgid / NXCD; wgid = (xcd < r ? xcd * (q + 1) : r * (q + 1) + (xcd - r) * q) + off; }
        const int nig = WGM * nN, gid = wgid / nig, fm = gid * WGM, gsz = (nM - fm) < WGM ? (nM - fm) : WGM;
        u.pm = fm + ((wgid % nig) % gsz); u.pn = (wgid % nig) / gsz; return true;
    }
    __device__ __forceinline__ void a_ready(const Unit&) const {}
    __device__ __forceinline__ void done(const Unit&) const {}
};

struct OneUnit {
    int pm, pn, have;
    __device__ bool next(int i, Unit& u) const { if (i != 0 || !have) return false; u.pm = pm; u.pn = pn; return true; }
    __device__ __forceinline__ void a_ready(const Unit&) const {}
    __device__ __forceinline__ void done(const Unit&) const {}
};
struct EpiStore {
    static constexpr bool PERM = true, AFTER_DRAIN = false;
    void* O; int ldc; int f32out;
    __device__ __forceinline__ void operator()(const f32x4 (&acc)[2][2][4][2], const Unit& u, int wr, int wc, int fr, int fq) const {
        const int row0 = u.pm * BM + wr * 64 + fr, col0 = u.pn * BM + wc * 32 + 8 * fq;
#pragma unroll
        for (int ai = 0; ai < 2; ++ai)
#pragma unroll
            for (int m = 0; m < 4; ++m) {
                const size_t roff = (size_t)(row0 + ai * HALF + m * 16) * ldc + col0;
#pragma unroll
                for (int bj = 0; bj < 2; ++bj) {
                    const f32x4 v0 = acc[ai][bj][m][0], v1 = acc[ai][bj][m][1];
                    if (f32out) {
                        float* p = (float*)O + roff + bj * HALF;
                        *(f32x4*)p = v0; *(f32x4*)(p + 4) = v1;
                    } else {
                        h16x8 w; w[0] = (h16)v0[0]; w[1] = (h16)v0[1]; w[2] = (h16)v0[2]; w[3] = (h16)v0[3]; w[4] = (h16)v1[0]; w[5] = (h16)v1[1]; w[6] = (h16)v1[2]; w[7] = (h16)v1[3];
                        *(h16x8*)((h16*)O + roff + bj * HALF) = w;
                    }
                }
            }
    }
};


template <int KIND  > struct EpiProj {
    static constexpr bool PERM = true, AFTER_DRAIN = false;
    unsigned char* ws;
    __device__ __forceinline__ static void st8(h16* p, const float (&v)[8]) { h16x8 w;
#pragma unroll
        for (int i = 0; i < 8; ++i) w[i] = (h16)v[i];
        *(h16x8*)p = w; }
    __device__ __forceinline__ void operator()(const f32x4 (&acc)[2][2][4][2], const Unit& u, int wr, int wc, int fr, int fq) const {
        const int pn = u.pn, d0 = 32 * wc + 8 * fq;
        h16* QKV = (h16*)(ws + WS_QKV);
        const f32x2* r16 = (const f32x2*)(ws + WS_ROPE16); const f32x2* r128 = (const f32x2*)(ws + WS_ROPE128);
        float ksum[2][8];
#pragma unroll
        for (int bj = 0; bj < 2; ++bj)
#pragma unroll
            for (int i = 0; i < 8; ++i) ksum[bj][i] = 0.f;
        int mode;
        float scale = 1.f; h16* base = QKV; int ld = 0;
        bool want_ksum = false;
        if (KIND == 0) {
            const int sect = pn >> 3;
            if (sect == 0) { mode = 0; scale = 0.08838834764831845f * 1.4426950408889634f  ; base = QKV + (size_t)(2 * (pn & 7)) * S * 128; }
            else if (sect == 1) { mode = 0; want_ksum = true; base = QKV + (size_t)16 * S * 128 + (size_t)(2 * (pn & 7)) * S * 128; }
            else if (sect == 2) { mode = 1; base = QKV + (size_t)32 * S * 128 + (size_t)(2 * (pn & 7)) * S * 128; }
            else { mode = 2; base = QKV + (size_t)48 * S * 128 + (pn & 7) * 256; ld = 2048; }
        } else if (KIND == 1) {
            if (pn < 8) { mode = 0; scale = 0.08838834764831845f * 1.4426950408889634f  ; base = QKV + (size_t)(2 * pn) * S * 128; }
            else if (pn < 20) { const int ti = (pn - 8) >> 1; mode = (ti & 1) ? 1 : 0; base = QKV + (size_t)16 * S * 128 + ((size_t)ti * 4 + 2 * ((pn - 8) & 1)) * S * 128; }
            else if (pn < 28) { mode = 2; base = (h16*)(ws + WS_QKV + 96 * MiB) + (pn - 20) * 256; ld = 2048; }
            else mode = 3;
        } else {
            if (pn < 8) { mode = 4; base = QKV + (size_t)pn * S * 256; }
            else if (pn < 16) { mode = 4; scale = 0.0625f; base = QKV + (size_t)8 * S * 256 + (size_t)(pn - 8) * S * 256; }
            else if (pn < 32) { mode = 5; base = QKV + (size_t)16 * S * 256 + (size_t)((pn - 16) >> 1) * S * 512 + ((pn - 16) & 1) * 256; }
            else { mode = 2; base = QKV + (size_t)16 * S * 256 + (size_t)8 * S * 512 + (pn - 32) * 256; ld = 4096; }
        }
#pragma unroll
        for (int ai = 0; ai < 2; ++ai)
#pragma unroll
            for (int m = 0; m < 4; ++m) {
                const int t = u.pm * BM + ai * HALF + wr * 64 + m * 16 + fr;
                float v[2][8];
#pragma unroll
                for (int bj = 0; bj < 2; ++bj)
#pragma unroll
                    for (int i = 0; i < 8; ++i) v[bj][i] = acc[ai][bj][m][i >> 2][i & 3];
                if (mode == 0) {
                    if (wc == 0) {
                        const f32x2* cs = r16 + (size_t)t * 16 + 8 * (fq & 1);
#pragma unroll
                        for (int bj = 0; bj < 2; ++bj)
#pragma unroll
                            for (int i = 0; i < 8; ++i) { const float o = __shfl_xor(v[bj][i], 32); const f32x2 c = cs[i];
                                v[bj][i] = (fq < 2) ? (v[bj][i] * c[0] - o * c[1]) : (o * c[1] + v[bj][i] * c[0]); }
                    }
#pragma unroll
                    for (int bj = 0; bj < 2; ++bj) {
#pragma unroll
                        for (int i = 0; i < 8; ++i) { v[bj][i] *= scale; ksum[bj][i] += v[bj][i]; }
                        st8(base + ((size_t)bj * S + t) * 128 + d0, v[bj]);
                    }
                } else if (mode == 1) {
#pragma unroll
                    for (int bj = 0; bj < 2; ++bj) st8(base + ((size_t)bj * S + t) * 128 + d0, v[bj]);
                } else if (mode == 2) {
#pragma unroll
                    for (int bj = 0; bj < 2; ++bj) {
#pragma unroll
                        for (int i = 0; i < 8; ++i) v[bj][i] = silu_f(v[bj][i]);
                        st8(base + (size_t)t * ld + 128 * bj + d0, v[bj]);
                    }
                } else if (mode == 3) {
                    if (d0 < 48) { float* gp = (float*)(ws + WS_GATES) + (size_t)t * 48 + d0;
#pragma unroll
                        for (int i = 0; i < 8; ++i) gp[i] = sigmoid_f(v[0][i]); }
                } else if (mode == 4) {
                    const f32x2* cs = r128 + (size_t)t * 128 + d0;
#pragma unroll
                    for (int i = 0; i < 8; ++i) { const f32x2 c = cs[i]; const float x1 = v[0][i], x2 = v[1][i];
                        v[0][i] = (x1 * c[0] - x2 * c[1]) * scale; v[1][i] = (x1 * c[1] + x2 * c[0]) * scale; }
                    st8(base + (size_t)t * 256 + d0, v[0]); st8(base + (size_t)t * 256 + 128 + d0, v[1]);
                } else {
#pragma unroll
                    for (int bj = 0; bj < 2; ++bj) st8(base + (size_t)t * 512 + 128 * bj + d0, v[bj]);
                }
            }
        if (KIND == 0 && want_ksum) {
#pragma unroll
            for (int bj = 0; bj < 2; ++bj)
#pragma unroll
                for (int i = 0; i < 8; ++i) { float x = ksum[bj][i]; x += __shfl_xor(x, 1); x += __shfl_xor(x, 2); x += __shfl_xor(x, 4); x += __shfl_xor(x, 8); ksum[bj][i] = x; }
            if (fr == 0) { float* km = (float*)(ws + WS_KMEAN) + (size_t)wr * 65536;
#pragma unroll
                for (int bj = 0; bj < 2; ++bj)
#pragma unroll
                    for (int i = 0; i < 8; ++i) km[((size_t)(2 * (pn & 7) + bj) * 32 + u.pm) * 128 + d0 + i] = ksum[bj][i] * (1.0f / 256.0f); }
        }
    }
};

template <class Epi, class Sched, bool ALIGN_EPI = false, bool SP2 = false>
__device__ __forceinline__ void gemm_phase(LAS unsigned char* lds, const Gemm g, const Sched& S, const Epi& E) {
    const int tid = threadIdx.x, wid = __builtin_amdgcn_readfirstlane(tid >> 6), lane = tid & 63, wr = wid >> 2, wc = wid & 3, fr = lane & 15, fq = lane >> 4;
    const int K = g.K, nt = K / BK;
    unsigned voffA[2], voffB[2];
#pragma unroll
    for (int i = 0; i < 2; ++i) { int R, C; stage_rc(tid * 16 + i * 8192, R, C); const int Rb = Epi::PERM ? ((R & ~31) + perm32(R & 31)) : R;
        voffA[i] = (unsigned)(R * g.lda + C) * 2u; voffB[i] = (unsigned)(Rb * g.ldb + C) * 2u; }
    const size_t kstep = (size_t)(BK * 2);
    const size_t hstepA = (size_t)HALF * g.lda * 2, hstepB = (size_t)HALF * g.ldb * 2;
    const size_t tstepA = 2 * hstepA, tstepB = 2 * hstepB;
    const unsigned ldsw = (unsigned)wid * 1024u;
    const int aoff = lds_byte(wr * 64 + fr, fq * 8), boff = lds_byte(wc * 32 + fr, fq * 8);
#define PG8_SA(b, h) (((b) * 2 + (h)) * HTB)
#define PG8_SB(b, h) ((4 + (b) * 2 + (h)) * HTB)
#define PG8_STAGE(bufoff, gbase, voff) do { _Pragma("unroll") for (int _i = 0; _i < 2; ++_i) \
        __builtin_amdgcn_global_load_lds((const unsigned*)((const char*)(gbase) + (voff)[_i]), (LAS unsigned*)(lds + (bufoff) + ldsw + _i * 8192), 16, 0, 0); } while (0)
#define PG8_LDA(dst, b, h) do { _Pragma("unroll") for (int m = 0; m < 4; ++m) _Pragma("unroll") for (int k = 0; k < 2; ++k) dst[m][k] = *(const LAS h16x8*)(lds + PG8_SA(b, h) + aoff + m * 2048 + k * 1024); } while (0)
#define PG8_LDB(dst, b, h) do { _Pragma("unroll") for (int n = 0; n < 2; ++n) _Pragma("unroll") for (int k = 0; k < 2; ++k) dst[n][k] = *(const LAS h16x8*)(lds + PG8_SB(b, h) + boff + n * 2048 + k * 1024); } while (0)
#define PG8_MMA(ai, bj, At, Bt) do { __builtin_amdgcn_s_setprio(1); _Pragma("unroll") for (int m = 0; m < 4; ++m) _Pragma("unroll") for (int n = 0; n < 2; ++n) _Pragma("unroll") for (int k = 0; k < 2; ++k) \
        acc[ai][bj][m][n] = __builtin_amdgcn_mfma_f32_16x16x32_f16(Bt[n][k], At[m][k], acc[ai][bj][m][n], 0, 0, 0); __builtin_amdgcn_s_setprio(0); } while (0)
#define PG8_WAIT_V(n) asm volatile("s_waitcnt vmcnt(" #n ")" ::: "memory")
#define PG8_WAIT_L(n) asm volatile("s_waitcnt lgkmcnt(" #n ")" ::: "memory")
#define PG8_BAR __builtin_amdgcn_s_barrier()
#define PG8_SCHED __builtin_amdgcn_sched_barrier(0)
    Unit cur, nxt; int ui = 0;
    if (!S.next(0, cur)) return;
    f32x4 acc[2][2][4][2];
#pragma unroll
    for (int a = 0; a < 2; ++a)
#pragma unroll
        for (int b = 0; b < 2; ++b)
#pragma unroll
            for (int m = 0; m < 4; ++m)
#pragma unroll
                for (int n = 0; n < 2; ++n) acc[a][b][m][n] = (f32x4){0.f, 0.f, 0.f, 0.f};
    h16x8 At[4][2], B0[2][2], B1[2][2];
    const char* cA = (const char*)g.A + (size_t)cur.pm * tstepA; const char* cB = (const char*)g.Bt + (size_t)cur.pn * tstepB;
    S.a_ready(cur);
    if constexpr (SP2) {
        PG8_STAGE(PG8_SB(0, 0), cB, voffB); PG8_STAGE(PG8_SB(0, 1), cB + hstepB, voffB); PG8_STAGE(PG8_SA(0, 0), cA, voffA); PG8_STAGE(PG8_SA(0, 1), cA + hstepA, voffA);
        if (wr == 1) PG8_BAR;
        PG8_WAIT_V(2); PG8_BAR;
        PG8_STAGE(PG8_SB(1, 0), cB + kstep, voffB); PG8_STAGE(PG8_SA(1, 0), cA + kstep, voffA); PG8_STAGE(PG8_SB(1, 1), cB + hstepB + kstep, voffB);
        PG8_WAIT_V(6); PG8_BAR;
    } else {
        PG8_STAGE(PG8_SB(0, 0), cB, voffB); PG8_STAGE(PG8_SA(0, 0), cA, voffA); PG8_STAGE(PG8_SB(0, 1), cB + hstepB, voffB); PG8_STAGE(PG8_SA(0, 1), cA + hstepA, voffA);
        if (wr == 1) PG8_BAR;
        PG8_WAIT_V(4); PG8_BAR;
        PG8_STAGE(PG8_SB(1, 0), cB + kstep, voffB); PG8_STAGE(PG8_SA(1, 0), cA + kstep, voffA); PG8_STAGE(PG8_SB(1, 1), cB + hstepB + kstep, voffB);
        PG8_WAIT_V(6); PG8_BAR;
    }
    for (;;) {
        const bool has_next = S.next(ui + 1, nxt);
        const char* nA = has_next ? (const char*)g.A + (size_t)nxt.pm * tstepA : cA; const char* nB = has_next ? (const char*)g.Bt + (size_t)nxt.pn * tstepB : cB;
        for (int t = 0; t < nt; t += 2) {
            const bool last = (t == nt - 2);
            const char* a1 = cA + (size_t)(t + 1) * kstep;
            const char* a2 = last ? nA : cA + (size_t)(t + 2) * kstep; const char* b2 = last ? nB : cB + (size_t)(t + 2) * kstep;
            const char* a3 = a2 + kstep; const char* b3 = b2 + kstep;
            if (last && has_next) S.a_ready(nxt);
            if constexpr (SP2) {
            PG8_LDB(B0, 0, 0); PG8_LDB(B1, 0, 1); PG8_SCHED; PG8_LDA(At, 0, 0); PG8_STAGE(PG8_SA(1, 1), a1 + hstepA, voffA);
            PG8_WAIT_V(8); PG8_WAIT_L(0); PG8_BAR; PG8_MMA(0, 0, At, B0); PG8_MMA(0, 1, At, B1); PG8_BAR; PG8_SCHED;
            PG8_LDA(At, 0, 1); PG8_STAGE(PG8_SB(0, 0), b2, voffB); PG8_STAGE(PG8_SB(0, 1), b2 + hstepB, voffB); PG8_STAGE(PG8_SA(0, 0), a2, voffA);
            PG8_WAIT_V(8); PG8_WAIT_L(0); PG8_BAR; PG8_MMA(1, 0, At, B0); PG8_MMA(1, 1, At, B1); PG8_BAR; PG8_SCHED;
            PG8_LDB(B0, 1, 0); PG8_LDB(B1, 1, 1); PG8_SCHED; PG8_LDA(At, 1, 0); PG8_STAGE(PG8_SA(0, 1), a2 + hstepA, voffA);
            PG8_WAIT_V(8); PG8_WAIT_L(0); PG8_BAR; PG8_MMA(0, 0, At, B0); PG8_MMA(0, 1, At, B1); PG8_BAR; PG8_SCHED;
            PG8_LDA(At, 1, 1); PG8_STAGE(PG8_SB(1, 0), b3, voffB); PG8_STAGE(PG8_SB(1, 1), b3 + hstepB, voffB); PG8_STAGE(PG8_SA(1, 0), a3, voffA);
            PG8_WAIT_V(8); PG8_WAIT_L(0); PG8_BAR; PG8_MMA(1, 0, At, B0); PG8_MMA(1, 1, At, B1); PG8_BAR; PG8_SCHED;
            } else {
            PG8_LDB(B0, 0, 0); PG8_SCHED; PG8_LDA(At, 0, 0); PG8_STAGE(PG8_SA(1, 1), a1 + hstepA, voffA);
            PG8_WAIT_L(8); PG8_BAR; PG8_WAIT_L(0); PG8_MMA(0, 0, At, B0); PG8_BAR; PG8_SCHED;
            PG8_LDB(B1, 0, 1); PG8_STAGE(PG8_SB(0, 0), b2, voffB);
            PG8_BAR; PG8_WAIT_L(0); PG8_MMA(0, 1, At, B1); PG8_BAR;
            PG8_LDA(At, 0, 1); PG8_STAGE(PG8_SA(0, 0), a2, voffA);
            PG8_BAR; PG8_WAIT_L(0); PG8_MMA(1, 0, At, B0); PG8_BAR; PG8_SCHED;
            PG8_STAGE(PG8_SB(0, 1), b2 + hstepB, voffB);
            PG8_WAIT_V(6); PG8_BAR; PG8_MMA(1, 1, At, B1); PG8_BAR;
            PG8_LDB(B0, 1, 0); PG8_SCHED; PG8_LDA(At, 1, 0); PG8_STAGE(PG8_SA(0, 1), a2 + hstepA, voffA);
            PG8_WAIT_L(8); PG8_BAR; PG8_WAIT_L(0); PG8_MMA(0, 0, At, B0); PG8_BAR; PG8_SCHED;
            PG8_LDB(B1, 1, 1); PG8_STAGE(PG8_SB(1, 0), b3, voffB);
            PG8_BAR; PG8_WAIT_L(0); PG8_MMA(0, 1, At, B1); PG8_BAR;
            PG8_LDA(At, 1, 1); PG8_STAGE(PG8_SA(1, 0), a3, voffA);
            PG8_BAR; PG8_WAIT_L(0); PG8_MMA(1, 0, At, B0); PG8_BAR; PG8_SCHED;
            PG8_STAGE(PG8_SB(1, 1), b3 + hstepB, voffB);
            PG8_WAIT_V(6); PG8_BAR; PG8_MMA(1, 1, At, B1); PG8_BAR;
            }
        }
        if constexpr (ALIGN_EPI) { if (wr == 0) PG8_BAR; }
        if constexpr (!Epi::AFTER_DRAIN) { E(acc, cur, wr, wc, fr, fq); S.done(cur); }
        if (!has_next) break;
#pragma unroll
        for (int a = 0; a < 2; ++a)
#pragma unroll
            for (int b = 0; b < 2; ++b)
#pragma unroll
                for (int m = 0; m < 4; ++m)
#pragma unroll
                    for (int n = 0; n < 2; ++n) acc[a][b][m][n] = (f32x4){0.f, 0.f, 0.f, 0.f};
        cur = nxt; cA = nA; cB = nB; ++ui;
        if constexpr (ALIGN_EPI) { if (wr == 1) PG8_BAR; }
    }
    PG8_WAIT_V(0);
    if constexpr (!ALIGN_EPI) { if (wr == 0) PG8_BAR; }
    PG8_BAR;
#undef PG8_SA
#undef PG8_SB
#undef PG8_STAGE
#undef PG8_LDA
#undef PG8_LDB
#undef PG8_MMA
#undef PG8_WAIT_V
#undef PG8_WAIT_L
#undef PG8_BAR
#undef PG8_SCHED
}
}

struct Frame {
    float* out;
    unsigned char* ws;
    char* lds;
    int tid, lane, wave, G, bid;
};

__device__ __forceinline__ float wave_sum(float v) {
#pragma unroll
    for (int o = 32; o >= 1; o >>= 1) v += __shfl_xor(v, o);
    return v;
}
__device__ __forceinline__ float wave_max(float v) {
#pragma unroll
    for (int o = 32; o >= 1; o >>= 1) v = fmaxf(v, __shfl_xor(v, o));
    return v;
}
__device__ __forceinline__ void wave_lds_fence() { __builtin_amdgcn_wave_barrier(); asm volatile("s_waitcnt lgkmcnt(0)" ::: "memory"); __builtin_amdgcn_wave_barrier(); }

__device__ __forceinline__ void sincos_d(double x, float& c, float& s) {
    const double TWO_OVER_PI = 0.63661977236758134308;
    const double PIO2_HI = 1.57079632679489655800e+00, PIO2_LO = 6.12323399573676603587e-17;
    const double q = __builtin_rint(x * TWO_OVER_PI);
    double y = __builtin_fma(-q, PIO2_HI, x); y = __builtin_fma(-q, PIO2_LO, y);
    const double y2 = y * y;
    double sp = 1.0 / 6227020800.0;
    sp = sp * y2 - 1.0 / 39916800.0; sp = sp * y2 + 1.0 / 362880.0; sp = sp * y2 - 1.0 / 5040.0; sp = sp * y2 + 1.0 / 120.0; sp = sp * y2 - 1.0 / 6.0; sp = sp * y2 * y + y;
    double cp = -1.0 / 87178291200.0;
    cp = cp * y2 + 1.0 / 479001600.0; cp = cp * y2 - 1.0 / 3628800.0; cp = cp * y2 + 1.0 / 40320.0; cp = cp * y2 - 1.0 / 720.0; cp = cp * y2 + 1.0 / 24.0; cp = cp * y2 - 0.5; cp = cp * y2 + 1.0;
    const long long qi = (long long)q; const int quad = (int)(qi & 3);
    double sv, cv;
    if (quad == 0) { sv = sp; cv = cp; } else if (quad == 1) { sv = cp; cv = -sp; } else if (quad == 2) { sv = -sp; cv = -cp; } else { sv = -cp; cv = sp; }
    c = (float)cv; s = (float)sv;
}

__device__ __forceinline__ int nsa_src_col(int n) { return n < 5120 ? n : (n < 7168 ? n + 48 : (n < 7216 ? n - 2048 : -1)); }
__device__ __forceinline__ void conv_transpose(const Frame& F, const float* W, int K, int Nsrc, h16* Wt, int Npad, int mapmode, int item0, int& items_done) {
    float* tile = (float*)F.lds;
    const int tk_n = K / 64, tn_n = Npad / 128, ntiles = tk_n * tn_n;
    f32x4 v[4];
#define CV_LOAD(it_) do { const int tk_ = (it_) / tn_n, tn_ = (it_) % tn_n; _Pragma("unroll") for (int i = 0; i < 4; ++i) { \
        const int idx = F.tid + i * NTHREADS, k = idx >> 5, n4 = (idx & 31) * 4; const int nn = tn_ * 128 + n4; const int src = mapmode ? nsa_src_col(nn) : nn; \
        v[i] = (f32x4){0.f, 0.f, 0.f, 0.f}; if (src >= 0 && src + 3 < Nsrc) v[i] = *(const f32x4*)(W + (size_t)(tk_ * 64 + k) * Nsrc + src); } } while (0)
    if (F.bid < ntiles) CV_LOAD(F.bid);
    for (int it = F.bid; it < ntiles; it += F.G) {
        const int tk = it / tn_n, tn = it % tn_n;
        __syncthreads();
#pragma unroll
        for (int i = 0; i < 4; ++i) {
            const int idx = F.tid + i * NTHREADS, k = idx >> 5, n4 = (idx & 31) * 4;
            tile[k * 129 + n4] = v[i][0]; tile[k * 129 + n4 + 1] = v[i][1]; tile[k * 129 + n4 + 2] = v[i][2]; tile[k * 129 + n4 + 3] = v[i][3];
        }
        if (it + F.G < ntiles) CV_LOAD(it + F.G);
        __syncthreads();
#pragma unroll
        for (int i = 0; i < 4; ++i) {
            const int idx = F.tid + i * NTHREADS, n = idx >> 4, k4 = (idx & 15) * 4;
            h16x4 o; o[0] = (h16)tile[k4 * 129 + n]; o[1] = (h16)tile[(k4 + 1) * 129 + n]; o[2] = (h16)tile[(k4 + 2) * 129 + n]; o[3] = (h16)tile[(k4 + 3) * 129 + n];
            *(h16x4*)(Wt + (size_t)(tn * 128 + n) * K + tk * 64 + k4) = o;
        }
    }
#undef CV_LOAD
    __syncthreads();
}
__device__ __forceinline__ void conv_layer_weights(const Frame& F, const Args& A, int L) {
    const int kind = L % 3, j = L / 3; int dummy = 0;
    h16* wtin = (h16*)(F.ws + WS_WTIN); h16* wtout = (h16*)(F.ws + WS_WTOUT);
    if (kind == 0) {
        conv_transpose(F, A.in[7] + (size_t)j * 2048 * 8192, 2048, 8192, wtin, 8192, 0, 0, dummy);
        conv_transpose(F, A.in[8] + (size_t)j * 2048 * 2048, 2048, 2048, wtout, 2048, 0, 0, dummy);
    } else if (kind == 1) {
        conv_transpose(F, A.in[9], 2048, 7216, wtin, NSA_NP, 1, 0, dummy);
        conv_transpose(F, A.in[10], 2048, 2048, wtout, 2048, 0, 0, dummy);
        conv_transpose(F, A.in[12], 4096, 256, (h16*)(F.ws + WS_W1T), 256, 0, 0, dummy);
        conv_transpose(F, A.in[14], 4096, 256, (h16*)(F.ws + WS_W1T) + (size_t)256 * 4096, 256, 0, 0, dummy);
    } else {
        conv_transpose(F, A.in[16], 2048, 12288, wtin, 12288, 0, 0, dummy);
        conv_transpose(F, A.in[17], 4096, 2048, wtout, 2048, 0, 0, dummy);
    }
}

__device__ __forceinline__ void phase_prologue(const Frame& F, const Args& A) {
    {
        float* modp = (float*)(F.ws + WS_MODP);
        const float* c = A.in[1]; const float* aw = A.in[3];
        float* sc = (float*)F.lds;
        __syncthreads();
        for (int i = F.tid; i < 2048; i += NTHREADS) sc[i] = silu_f(c[i]);
        __syncthreads();
        for (int it = F.bid; it < 192; it += F.G) {
            const int layer = it / 48, r = it % 48, slice = r / 3, nch = r % 3, n = nch * 2048 + F.tid * 4;
            const float* w = aw + (size_t)layer * 2048 * 6144 + (size_t)(slice * 128) * 6144 + n;
            f32x4 a0 = (f32x4){0.f, 0.f, 0.f, 0.f}, a1 = a0;
#pragma unroll 8
            for (int k = 0; k < 128; k += 2) {
                a0 += *(const f32x4*)(w + (size_t)k * 6144) * sc[slice * 128 + k];
                a1 += *(const f32x4*)(w + (size_t)(k + 1) * 6144) * sc[slice * 128 + k + 1];
            }
            *(f32x4*)(modp + (size_t)(slice * 4 + layer) * 6144 + n) = a0 + a1;
        }
        __syncthreads();
    }
    {
        const int* pos = (const int*)A.in[2];
        f32x2* r16 = (f32x2*)(F.ws + WS_ROPE16); f32x2* r128 = (f32x2*)(F.ws + WS_ROPE128);
        for (int idx = F.bid * NTHREADS + F.tid; idx < S * 16; idx += F.G * NTHREADS) {
            const int t = idx >> 4, j = idx & 15; float cs, sn; sincos_d((double)pos[t] * A.inv16[j], cs, sn); r16[idx] = (f32x2){cs, sn};
        }
        for (int idx = F.bid * NTHREADS + F.tid; idx < S * 128; idx += F.G * NTHREADS) {
            const int t = idx >> 7, j = idx & 127; float cs, sn; sincos_d((double)pos[t] * A.inv128[j], cs, sn); r128[idx] = (f32x2){cs, sn};
        }
    }
    if (F.bid >= F.G - 16) {
        const int slice = F.bid - (F.G - 16), kv = F.tid >> 8, j = F.tid & 255; const float* w1 = (kv ? A.in[14] : A.in[12]) + (size_t)slice * 256 * 256; const float* pe = A.in[11] + slice * 256;
        float a0 = 0.f, a1 = 0.f;
#pragma unroll 8
        for (int i = 0; i < 256; i += 2) { a0 += pe[i] * w1[(size_t)i * 256 + j]; a1 += pe[i + 1] * w1[(size_t)(i + 1) * 256 + j]; }
        ((float*)(F.ws + WS_CMPB))[slice * 512 + F.tid] = a0 + a1;
    }
    conv_layer_weights(F, A, 0);
}

__device__ __forceinline__ void phase_norm(const Frame& F, const Args& A, int Lprev, int Lnext) {
    float* modl = (float*)F.lds;
    const float* modp = (const float*)(F.ws + WS_MODP); const float* ab = A.in[4];
    __syncthreads();
    for (int i = F.tid; i < 6144; i += NTHREADS) {
        const int which = i >> 11, col = i & 2047;
        int layer, mcol;
        if (which == 0) { layer = Lprev; mcol = 4096 + col; } else if (which == 1) { layer = Lnext; mcol = 2048 + col; } else { layer = Lnext; mcol = col; }
        float v = 0.f;
        if (layer >= 0) { v = ab[layer * 6144 + mcol];
#pragma unroll
            for (int s = 0; s < 16; ++s) v += modp[(size_t)(s * 4 + layer) * 6144 + mcol]; }
        modl[i] = v;
    }
    __syncthreads();
    const float* xin = (Lprev <= 0) ? A.in[0] : F.out;
    const h16* Y = (const h16*)(F.ws + WS_Y);
    h16* H = (h16*)(F.ws + WS_H);
    const float* npost = A.in[6] + (Lprev >= 0 ? Lprev : 0) * 2048;
    const float* npre = A.in[5] + (Lnext >= 0 ? Lnext : 0) * 2048;
    for (int t = F.bid * 8 + F.wave; t < S; t += F.G * 8) {
        f32x4 x[8];
#pragma unroll
        for (int i = 0; i < 8; ++i) x[i] = *(const f32x4*)(xin + (size_t)t * D + i * 256 + F.lane * 4);
        if (Lprev >= 0) {
            f32x4 y[8]; float ss = 0.f;
#pragma unroll
            for (int i = 0; i < 8; ++i) { const h16x4 yh = *(const h16x4*)(Y + (size_t)t * D + i * 256 + F.lane * 4); y[i] = (f32x4){(float)yh[0], (float)yh[1], (float)yh[2], (float)yh[3]}; ss += y[i][0] * y[i][0] + y[i][1] * y[i][1] + y[i][2] * y[i][2] + y[i][3] * y[i][3]; }
            ss = wave_sum(ss);
            const float r = 1.0f / sqrtf(ss * (1.0f / D) + EPS);
#pragma unroll
            for (int i = 0; i < 8; ++i) {
                const int col = i * 256 + F.lane * 4;
                const f32x4 g = *(const f32x4*)(npost + col); const f32x4 gt = *(const f32x4*)(modl + col);
#pragma unroll
                for (int e = 0; e < 4; ++e) x[i][e] += gt[e] * (y[i][e] * r * g[e]);
                *(f32x4*)(F.out + (size_t)t * D + col) = x[i];
            }
        }
        if (Lnext >= 0) {
            float ss = 0.f;
#pragma unroll
            for (int i = 0; i < 8; ++i) ss += x[i][0] * x[i][0] + x[i][1] * x[i][1] + x[i][2] * x[i][2] + x[i][3] * x[i][3];
            ss = wave_sum(ss);
            const float r = 1.0f / sqrtf(ss * (1.0f / D) + EPS);
#pragma unroll
            for (int i = 0; i < 8; ++i) {
                const int col = i * 256 + F.lane * 4;
                const f32x4 g = *(const f32x4*)(npre + col); const f32x4 sc = *(const f32x4*)(modl + 2048 + col); const f32x4 sh = *(const f32x4*)(modl + 4096 + col);
                h16x4 hv;
#pragma unroll
                for (int e = 0; e < 4; ++e) hv[e] = (h16)((x[i][e] * r * g[e]) * (1.0f + sc[e]) + sh[e]);
                *(h16x4*)(H + (size_t)t * D + col) = hv;
            }
        }
    }
    if (Lnext > 0) conv_layer_weights(F, A, Lnext);
}

__device__ __forceinline__ void phase_nsa_cmp_a(const Frame& F) {
    const int u = F.bid, have = u < 64, kv = (u >> 5) & 1, mt = (u >> 2) & 7, kp = u & 3;
    const h16* A = (const h16*)(F.ws + WS_QKV) + (size_t)16 * S * 128 + (size_t)kv * 4 * S * 128 + kp * 1024;
    const h16* Bt = (const h16*)(F.ws + WS_W1T) + (size_t)kv * 256 * 4096 + kp * 1024;
    pg8::Gemm g{A, Bt, 2048, 256, 1024, 2048, 4096}; pg8::OneUnit So{mt, 0, have};
    pg8::EpiStore E{(float*)(F.ws + WS_OR) + (size_t)(kv * 4 + kp) * 2048 * 256, 256, 1};
    pg8::gemm_phase<pg8::EpiStore, pg8::OneUnit, true, true>((LAS unsigned char*)F.lds, g, So, E);
}
__device__ __forceinline__ void phase_nsa_cmp_b(const Frame& F, const Args& A) {
    float* hid = (float*)F.lds;
    const float* part = (const float*)(F.ws + WS_OR); const float* b1 = (const float*)(F.ws + WS_CMPB);
    for (int it = F.bid; it < 256; it += F.G) {
        const int kv = it >> 7, r0 = (it & 127) * 16;
        const float* W2 = kv ? A.in[15] : A.in[13];
        h16* dst = (h16*)(F.ws + (kv ? WS_VCMP : WS_KCMP));
        __syncthreads();
        for (int i = F.tid; i < 16 * 256; i += NTHREADS) {
            const int r = r0 + (i >> 8), j = i & 255; float v = 0.f;
#pragma unroll
            for (int sl = 0; sl < 16; ++sl) v += b1[sl * 512 + kv * 256 + j];
#pragma unroll
            for (int kp = 0; kp < 4; ++kp) v += part[((size_t)(kv * 4 + kp) * 2048 + r) * 256 + j];
            hid[i] = silu_f(v);
        }
        __syncthreads();
        const int d = F.tid & 127, rq = F.tid >> 7;
        float a[4] = {0.f, 0.f, 0.f, 0.f};
#pragma unroll 4
        for (int j = 0; j < 256; ++j) { const float w = W2[j * 128 + d];
#pragma unroll
            for (int e = 0; e < 4; ++e) a[e] += hid[(rq * 4 + e) * 256 + j] * w; }
#pragma unroll
        for (int e = 0; e < 4; ++e) { const int r = r0 + rq * 4 + e; dst[(size_t)r * 128 + d] = ((r & 511) < NC) ? (h16)a[e] : (h16)0.f; }
    }
}

namespace fa {
typedef float f32x16 __attribute__((ext_vector_type(16)));
typedef unsigned u32x2 __attribute__((ext_vector_type(2)));
constexpr float LOG2E = 1.4426950408889634f;
constexpr float MASKV = -3.0e38f;
constexpr int KROW = 272, VROW = 320;
constexpr int KT_BYTES = 64 * KROW, BUF_BYTES = KT_BYTES + 64 * VROW;
typedef short s16x4v __attribute__((__vector_size__(4 * sizeof(short))));
constexpr int LDS_IMP = 2 * BUF_BYTES;
constexpr int LDS_SELW = LDS_IMP + 32768;
constexpr int LDS_SV = LDS_SELW + 1024;
static_assert(LDS_SV + 4096 <= MISC_OFF, "attention LDS map");

struct Stage { u32x4 k[2], v[2]; };
__device__ __forceinline__ void stage_load(Stage& st, const h16* Kg, const h16* VTg, int j, int tid) {
    asm volatile("" : "+v"(tid));
#pragma unroll
    for (int i = 0; i < 2; ++i) { const int idx = tid + 512 * i;
        st.k[i] = *(const u32x4*)(Kg + (size_t)(j * 64 + (idx >> 4)) * 128 + (idx & 15) * 8);
        st.v[i] = *(const u32x4*)(VTg + (size_t)(j * 64 + (idx >> 4)) * 128 + (idx & 15) * 8); }
}
__device__ __forceinline__ void stage_write(const Stage& st, LAS unsigned char* buf, int tid) {
    asm volatile("" : "+v"(tid));
#pragma unroll
    for (int i = 0; i < 2; ++i) { const int idx = tid + 512 * i;
        *(LAS u32x4*)(buf + (idx >> 4) * KROW + (idx & 15) * 16) = st.k[i];
        *(LAS u32x4*)(buf + KT_BYTES + (idx >> 4) * VROW + (idx & 15) * 16) = st.v[i]; }
}

template <int MODE>
__device__ __forceinline__ void tile_compute(const LAS unsigned char* buf, int j, const h16x8 (&qf)[8], f32x16 (&o)[4], float& m, float& l,
                                             bool on, int lo, int hi, int lane, float inv_l, LAS float* imp_q) {
    const int r31 = lane & 31, h = lane >> 5, k0 = j * 64;
    const bool need = on && (k0 <= hi) && (k0 + 63 >= lo);
    if (__ballot(need) == 0ull) return;
    f32x16 s0, s1;
#pragma unroll
    for (int r = 0; r < 16; ++r) { s0[r] = 0.f; s1[r] = 0.f; }
    const LAS unsigned char* kp = buf + r31 * KROW + h * 16;
    {
        h16x8 ka[2][4];
#pragma unroll
        for (int e = 0; e < 2; ++e) { ka[0][2 * e] = *(const LAS h16x8*)(kp + e * 32); ka[0][2 * e + 1] = *(const LAS h16x8*)(kp + 32 * KROW + e * 32); }
#pragma unroll
        for (int g = 0; g < 4; ++g) {
            if (g < 3) {
#pragma unroll
                for (int e = 0; e < 2; ++e) { ka[(g + 1) & 1][2 * e] = *(const LAS h16x8*)(kp + (2 * (g + 1) + e) * 32); ka[(g + 1) & 1][2 * e + 1] = *(const LAS h16x8*)(kp + 32 * KROW + (2 * (g + 1) + e) * 32); }
            }
#pragma unroll
            for (int e = 0; e < 2; ++e) {
                s0 = __builtin_amdgcn_mfma_f32_32x32x16_f16(ka[g & 1][2 * e], qf[2 * g + e], s0, 0, 0, 0);
                s1 = __builtin_amdgcn_mfma_f32_32x32x16_f16(ka[g & 1][2 * e + 1], qf[2 * g + e], s1, 0, 0, 0);
            }
            __builtin_amdgcn_sched_barrier(0);
        }
    }
    const bool full = (k0 >= lo) && (k0 + 63 <= hi);
    const bool simple = (__ballot(on && !full) == 0ull);
    if (!simple) {
#pragma unroll
        for (int r = 0; r < 16; ++r) {
            const int key0 = k0 + (r & 3) + 8 * (r >> 2) + 4 * h, key1 = key0 + 32;
            const bool v0 = on && key0 >= lo && key0 <= hi, v1 = on && key1 >= lo && key1 <= hi;
            s0[r] = v0 ? s0[r] : MASKV; s1[r] = v1 ? s1[r] : MASKV;
        }
    }
    float tm;
    {
        float t8[8];
#pragma unroll
        for (int r = 0; r < 8; ++r) t8[r] = fmaxf(fmaxf(s0[2 * r], s0[2 * r + 1]), fmaxf(s1[2 * r], s1[2 * r + 1]));
        tm = fmaxf(fmaxf(fmaxf(t8[0], t8[1]), fmaxf(t8[2], t8[3])), fmaxf(fmaxf(t8[4], t8[5]), fmaxf(t8[6], t8[7])));
    }
    const float tmax = ((simple && !on) || !(tm > 0.5f * NEGF)) ? NEGF : tm;
    if (MODE != 2) {
        const float tmx = fmaxf(tmax, __shfl_xor(tmax, 32));
        const float m_new = fmaxf(m, tmx);
        const float alpha = __builtin_amdgcn_exp2f(m - m_new);
        const float off = (simple && !on) ? BIGF : m_new;
        float sum0 = 0.f, sum1 = 0.f;
#pragma unroll
        for (int r = 0; r < 16; ++r) {
            s0[r] = __builtin_amdgcn_exp2f(s0[r] - off);
            s1[r] = __builtin_amdgcn_exp2f(s1[r] - off);
            sum0 += s0[r]; sum1 += s1[r];
        }
        l = l * alpha + (sum0 + sum1);
        const bool grew = m_new > m; m = m_new;
        if (MODE == 1) return;
        if (__ballot(grew) != 0ull) {
#pragma unroll
            for (int dt = 0; dt < 4; ++dt) o[dt] = o[dt] * alpha;
        }
    } else {
        const float off = (simple && !on) ? BIGF : m;
#pragma unroll
        for (int r = 0; r < 16; ++r) {
            s0[r] = __builtin_amdgcn_exp2f(s0[r] - off) * inv_l;
            s1[r] = __builtin_amdgcn_exp2f(s1[r] - off) * inv_l;
        }
#pragma unroll
        for (int c = 0; c < 4; ++c) {
            const int sa = 16 * j + 2 * c + h, sb = sa + 8;
            const float a0 = s0[4 * c] + s0[4 * c + 1] + s0[4 * c + 2] + 0.5f * s0[4 * c + 3], b0 = 0.5f * s0[4 * c + 3];
            const float a1 = s1[4 * c] + s1[4 * c + 1] + s1[4 * c + 2] + 0.5f * s1[4 * c + 3], b1 = 0.5f * s1[4 * c + 3];
            (void)__hip_atomic_fetch_add(imp_q + sa, a0, __ATOMIC_RELAXED, __HIP_MEMORY_SCOPE_WORKGROUP); if (sa + 1 < 128) (void)__hip_atomic_fetch_add(imp_q + sa + 1, b0, __ATOMIC_RELAXED, __HIP_MEMORY_SCOPE_WORKGROUP);
            (void)__hip_atomic_fetch_add(imp_q + sb, a1, __ATOMIC_RELAXED, __HIP_MEMORY_SCOPE_WORKGROUP); if (sb + 1 < 128) (void)__hip_atomic_fetch_add(imp_q + sb + 1, b1, __ATOMIC_RELAXED, __HIP_MEMORY_SCOPE_WORKGROUP);
        }
    }
    h16x8 pb[2][2];
#pragma unroll
    for (int sp = 0; sp < 2; ++sp)
#pragma unroll
        for (int jj = 0; jj < 8; ++jj) { pb[0][sp][jj] = (h16)s0[8 * sp + jj]; pb[1][sp][jj] = (h16)s1[8 * sp + jj]; }
    const LAS unsigned char* vbase = buf + KT_BYTES + (4 * h + ((lane & 15) >> 2)) * VROW + (16 * ((lane >> 4) & 1) + 4 * (lane & 3)) * 2;
    {
        s16x4v vr[2][8];
#pragma unroll
        for (int f = 0; f < 4; ++f) { const LAS unsigned char* vp = vbase + 16 * f * VROW;
            vr[0][2 * f] = __builtin_amdgcn_ds_read_tr16_b64_v4i16((LAS s16x4v*)vp); vr[0][2 * f + 1] = __builtin_amdgcn_ds_read_tr16_b64_v4i16((LAS s16x4v*)(vp + 8 * VROW)); }
#pragma unroll
        for (int dt = 0; dt < 4; ++dt) {
            if (dt < 3) {
#pragma unroll
                for (int f = 0; f < 4; ++f) { const LAS unsigned char* vp = vbase + 16 * f * VROW + 64 * (dt + 1);
                    vr[(dt + 1) & 1][2 * f] = __builtin_amdgcn_ds_read_tr16_b64_v4i16((LAS s16x4v*)vp); vr[(dt + 1) & 1][2 * f + 1] = __builtin_amdgcn_ds_read_tr16_b64_v4i16((LAS s16x4v*)(vp + 8 * VROW)); }
            }
#pragma unroll
            for (int f = 0; f < 4; ++f) {
                const h16x4 l4 = __builtin_bit_cast(h16x4, vr[dt & 1][2 * f]), h4 = __builtin_bit_cast(h16x4, vr[dt & 1][2 * f + 1]);
                h16x8 va; va[0] = l4[0]; va[1] = l4[1]; va[2] = l4[2]; va[3] = l4[3]; va[4] = h4[0]; va[5] = h4[1]; va[6] = h4[2]; va[7] = h4[3];
                o[dt] = __builtin_amdgcn_mfma_f32_32x32x16_f16(va, pb[f >> 1][f & 1], o[dt], 0, 0, 0);
            }
            __builtin_amdgcn_sched_barrier(0);
        }
    }
}

template <int MODE, class OnFn>
__device__ __forceinline__ void stream(LAS unsigned char* lds, const h16* Kg, const h16* VTg, int jlo, int jhi, const h16x8 (&qf)[8],
                                       f32x16 (&o)[4], float& m, float& l, int lo, int hi, const OnFn& on_fn, int tid, int lane, float inv_l, LAS float* imp_q) {
    if (jlo >= jhi) return;
    Stage st;
    stage_load(st, Kg, VTg, jlo, tid);
    stage_write(st, lds, tid);
    __syncthreads();
    for (int j = jlo; j < jhi; ++j) {
        const int cur = (j - jlo) & 1;
        if (j + 1 < jhi) stage_load(st, Kg, VTg, j + 1, tid);
        tile_compute<MODE>(lds + cur * BUF_BYTES, j, qf, o, m, l, on_fn(j), lo, hi, lane, inv_l, imp_q);
        if (j + 1 < jhi) stage_write(st, lds + (cur ^ 1) * BUF_BYTES, tid);
        __syncthreads();
    }
}

__device__ __forceinline__ void load_q(h16x8 (&qf)[8], const h16* qrow, int h) {
#pragma unroll
    for (int s = 0; s < 8; ++s) qf[s] = *(const h16x8*)(qrow + 16 * s + 8 * h);
}
__device__ __forceinline__ void zero_o(f32x16 (&o)[4]) {
#pragma unroll
    for (int dt = 0; dt < 4; ++dt)
#pragma unroll
        for (int r = 0; r < 16; ++r) o[dt][r] = 0.f;
}
}

struct MobaOn { unsigned selmask; int b; __device__ __forceinline__ bool operator()(int j) const { const int jb = j >> 2; return jb == b ? true : (((selmask >> jb) & 1u) != 0u); } };
__device__ __forceinline__ void phase_moba_attn_mfma(const Frame& F) {
    const h16* Q = (const h16*)(F.ws + WS_QKV); const h16* K = Q + (size_t)16 * S * 128; const h16* VT = K + (size_t)16 * S * 128; const h16* Z = VT + (size_t)16 * S * 128;
    const float* kmean = (const float*)(F.ws + WS_KMEAN);
    h16* OZ = (h16*)(F.ws + WS_OZ);
    LAS unsigned char* lds = (LAS unsigned char*)F.lds;
    const int lane = F.lane, r31 = lane & 31, h = lane >> 5;
    for (int it = F.bid; it < 256; it += F.G) {
        const int head = it >> 4, pi = it & 15;
#pragma unroll 1
        for (int half = 0; half < 2; ++half) {
            const int b = half ? 31 - pi : pi;
            const int t = b * 256 + F.wave * 32 + r31;
            h16x8 qf[8]; fa::load_q(qf, Q + ((size_t)head * S + t) * 128, h);
            LAS float* kml = (LAS float*)(lds + 2 * fa::BUF_BYTES);
            __syncthreads();
            for (int i = F.tid; i < b * 32; i += NTHREADS) { const float* km = kmean + (size_t)head * 32 * 128 + i * 4; *(LAS f32x4*)(kml + i * 4) = *(const f32x4*)km + *(const f32x4*)(km + 65536); }
            __syncthreads();
            float v0 = NEGF, v1 = NEGF, v2 = NEGF; int i0 = -1, i1 = -1, i2 = -1;
            for (int jb = 0; jb < b; ++jb) {
                const LAS float* km = kml + jb * 128 + 8 * h;
                float d = 0.f;
#pragma unroll
                for (int s = 0; s < 8; ++s) { const f32x4 ka = *(const LAS f32x4*)(km + 16 * s), kb = *(const LAS f32x4*)(km + 16 * s + 4);
                    d += (float)qf[s][0] * ka[0] + (float)qf[s][1] * ka[1] + (float)qf[s][2] * ka[2] + (float)qf[s][3] * ka[3] + (float)qf[s][4] * kb[0] + (float)qf[s][5] * kb[1] + (float)qf[s][6] * kb[2] + (float)qf[s][7] * kb[3]; }
                d += __shfl_xor(d, 32);
                if (d > v0) { v2 = v1; i2 = i1; v1 = v0; i1 = i0; v0 = d; i0 = jb; }
                else if (d > v1) { v2 = v1; i2 = i1; v1 = d; i1 = jb; }
                else if (d > v2) { v2 = d; i2 = jb; }
            }
            MobaOn on; on.b = b; on.selmask = (i0 >= 0 ? 1u << i0 : 0u) | (i1 >= 0 ? 1u << i1 : 0u) | (i2 >= 0 ? 1u << i2 : 0u);
            fa::f32x16 o[4]; fa::zero_o(o); float m = NEGF, l = 0.f;
            fa::stream<0>(lds, K + (size_t)head * S * 128, VT + (size_t)head * S * 128, 0, 4 * b + 4, qf, o, m, l, 0, t, on, F.tid, lane, 0.f, (LAS float*)nullptr);
            l += __shfl_xor(l, 32);
            const float inv = 1.0f / fmaxf(l, 1e-30f);
#pragma unroll
            for (int dt = 0; dt < 4; ++dt)
#pragma unroll
                for (int c = 0; c < 4; ++c) {
                    const int d = 32 * dt + 8 * c + 4 * h; const size_t off = (size_t)t * 2048 + head * 128 + d;
                    const h16x4 zz = *(const h16x4*)(Z + off); h16x4 ov;
#pragma unroll
                    for (int e = 0; e < 4; ++e) ov[e] = (h16)(o[dt][4 * c + e] * inv * (float)zz[e]);
                    *(h16x4*)(OZ + off) = ov;
                }
        }
    }
}

constexpr size_t WS_MLIST = WS_P;
constexpr size_t WS_MPO = WS_P + 16 * MiB;
constexpr size_t WS_MPML = WS_P + 144 * MiB;
constexpr int CW_MCNT = 8192;
struct ValidOn { bool v; __device__ __forceinline__ bool operator()(int) const { return v; } };

__device__ __forceinline__ void phase_moba_gate(const Frame& F, int jl) {
    const h16* Q = (const h16*)(F.ws + WS_QKV);
    const float* kmean = (const float*)(F.ws + WS_KMEAN);
    unsigned* cnt = (unsigned*)(F.ws + WS_CTL) + CW_MCNT + jl * 512;
    unsigned* list = (unsigned*)(F.ws + WS_MLIST);
    LAS unsigned char* lds = (LAS unsigned char*)F.lds;
    LAS float* kml = (LAS float*)lds;
    const int lane = F.lane, r31 = lane & 31, h = lane >> 5;
    for (int it = F.bid; it < 496; it += F.G) {
        const int head = it / 31, b = it % 31 + 1;
        const int t = b * 256 + F.wave * 32 + r31;
        h16x8 qf[8]; fa::load_q(qf, Q + ((size_t)head * S + t) * 128, h);
        __syncthreads();
        for (int i = F.tid; i < b * 32; i += NTHREADS) { const float* km = kmean + (size_t)head * 32 * 128 + i * 4; *(LAS f32x4*)(kml + i * 4) = *(const f32x4*)km + *(const f32x4*)(km + 65536); }
        __syncthreads();
        float v0 = NEGF, v1 = NEGF, v2 = NEGF; int i0 = -1, i1 = -1, i2 = -1;
        for (int jb = 0; jb < b; ++jb) {
            const LAS float* km = kml + jb * 128 + 8 * h;
            float d = 0.f;
#pragma unroll
            for (int s = 0; s < 8; ++s) { const f32x4 ka = *(const LAS f32x4*)(km + 16 * s), kb = *(const LAS f32x4*)(km + 16 * s + 4);
                d += (float)qf[s][0] * ka[0] + (float)qf[s][1] * ka[1] + (float)qf[s][2] * ka[2] + (float)qf[s][3] * ka[3] + (float)qf[s][4] * kb[0] + (float)qf[s][5] * kb[1] + (float)qf[s][6] * kb[2] + (float)qf[s][7] * kb[3]; }
            d += __shfl_xor(d, 32);
            if (d > v0) { v2 = v1; i2 = i1; v1 = v0; i1 = i0; v0 = d; i0 = jb; }
            else if (d > v1) { v2 = v1; i2 = i1; v1 = d; i1 = jb; }
            else if (d > v2) { v2 = d; i2 = jb; }
        }
        const unsigned long long below = (lane == 0) ? 0ull : (~0ull >> (64 - lane));
        for (int jb = 0; jb < b; ++jb) {
            const bool sel = (h == 0) && (i0 == jb || i1 == jb || i2 == jb);
            const unsigned long long mk = __ballot(sel);
            if (mk != 0ull) {
                unsigned base = 0u;
                if (lane == 0) base = __hip_atomic_fetch_add(cnt + head * 32 + jb, (unsigned)__popcll(mk), __ATOMIC_RELAXED, __HIP_MEMORY_SCOPE_AGENT);
                base = __shfl(base, 0);
                if (sel) { const unsigned slot = (i0 == jb) ? 0u : ((i1 == jb) ? 1u : 2u);
                    list[((size_t)head * 32 + jb) * 8192 + base + __popcll(mk & below)] = (unsigned)t | (slot << 16); }
            }
        }
    }
}

__device__ __forceinline__ void phase_moba_attn_sparse(const Frame& F, int jl) {
    const h16* Q = (const h16*)(F.ws + WS_QKV); const h16* K = Q + (size_t)16 * S * 128; const h16* V = K + (size_t)16 * S * 128;
    const unsigned* cnt = (const unsigned*)(F.ws + WS_CTL) + CW_MCNT + jl * 512;
    const unsigned* list = (const unsigned*)(F.ws + WS_MLIST);
    h16* PO = (h16*)(F.ws + WS_MPO); float* PML = (float*)(F.ws + WS_MPML);
    LAS unsigned char* lds = (LAS unsigned char*)F.lds;
    LAS unsigned* pre = (LAS unsigned*)(lds + 2 * fa::BUF_BYTES);
    LAS unsigned* wsum = pre + 520;
    const int lane = F.lane, r31 = lane & 31, h = lane >> 5;
    __syncthreads();
    { const unsigned n = cnt[F.tid]; const unsigned u = (n + 255u) >> 8; unsigned x = u;
#pragma unroll
      for (int o = 1; o < 64; o <<= 1) { const unsigned y = __shfl_up(x, o); if (lane >= o) x += y; }
      if (lane == 63) wsum[F.wave] = x;
      __syncthreads();
      unsigned off = 0u;
      for (int w = 0; w < F.wave; ++w) off += wsum[w];
      pre[F.tid] = off + x - u;
      if (F.tid == NTHREADS - 1) pre[512] = off + x;
      __syncthreads(); }
    const int U = 512 + (int)pre[512];
    for (int u = F.bid; u < U; u += F.G) {
        int head, jt0, slot = 3, t; bool valid = true;
        if (u < 512) { head = u >> 5; const int b = u & 31; jt0 = 4 * b; t = b * 256 + F.wave * 32 + r31; }
        else {
            const unsigned gq = (unsigned)(u - 512);
            int lo_ = 0, hi_ = 512;
            while (hi_ - lo_ > 1) { const int mid = (lo_ + hi_) >> 1; if (pre[mid] <= gq) lo_ = mid; else hi_ = mid; }
            const int i = lo_; head = i >> 5; jt0 = 4 * (i & 31);
            const unsigned e = (gq - pre[i]) * 256u + F.wave * 32 + r31, n = cnt[i];
            valid = e < n;
            const unsigned ent = valid ? list[(size_t)i * 8192 + e] : 0u;
            t = (int)(ent & 0xFFFFu); slot = (int)(ent >> 16);
        }
        h16x8 qf[8]; fa::load_q(qf, Q + ((size_t)head * S + t) * 128, h);
        fa::f32x16 o[4]; fa::zero_o(o); float m = NEGF, l = 0.f;
        ValidOn on; on.v = valid;
        fa::stream<0>(lds, K + (size_t)head * S * 128, V + (size_t)head * S * 128, jt0, jt0 + 4, qf, o, m, l, 0, (u < 512) ? t : S, on, F.tid, lane, 0.f, (LAS float*)nullptr);
        l += __shfl_xor(l, 32);
        if (valid) {
            const float inv = 1.0f / fmaxf(l, 1e-30f);
            const size_t pidx = ((size_t)t * 16 + head) * 4 + slot;
#pragma unroll
            for (int dt = 0; dt < 4; ++dt)
#pragma unroll
                for (int c = 0; c < 4; ++c) { h16x4 ov;
#pragma unroll
                    for (int e = 0; e < 4; ++e) ov[e] = (h16)(o[dt][4 * c + e] * inv);
                    *(h16x4*)(PO + pidx * 128 + 32 * dt + 8 * c + 4 * h) = ov; }
            if (h == 0) *(f32x2*)(PML + pidx * 2) = (f32x2){m, l};
        }
    }
}

__device__ __forceinline__ void phase_moba_merge(const Frame& F) {
    const h16* Z = (const h16*)(F.ws + WS_QKV) + (size_t)48 * S * 128;
    const h16* PO = (const h16*)(F.ws + WS_MPO); const float* PML = (const float*)(F.ws + WS_MPML);
    h16* OZ = (h16*)(F.ws + WS_OZ);
    const int sub = F.lane >> 4, dc = (F.lane & 15) * 8;
    for (int p0 = (F.bid * 8 + F.wave) * 4; p0 < S * 16; p0 += F.G * 8 * 4) {
        const int pr = p0 + sub, t = pr >> 4, head = pr & 15, nsel = (t >> 8) < 3 ? (t >> 8) : 3;
        const f32x4 ml01 = *(const f32x4*)(PML + (size_t)pr * 8), ml23 = *(const f32x4*)(PML + (size_t)pr * 8 + 4);
        const float m3 = ml23[2], l3 = ml23[3];
        const float m0 = nsel > 0 ? ml01[0] : NEGF, m1 = nsel > 1 ? ml01[2] : NEGF, m2 = nsel > 2 ? ml23[0] : NEGF;
        const float M = fmaxf(fmaxf(m0, m1), fmaxf(m2, m3));
        const float w0 = nsel > 0 ? ml01[1] * __builtin_amdgcn_exp2f(m0 - M) : 0.f, w1 = nsel > 1 ? ml01[3] * __builtin_amdgcn_exp2f(m1 - M) : 0.f;
        const float w2 = nsel > 2 ? ml23[1] * __builtin_amdgcn_exp2f(m2 - M) : 0.f, w3 = l3 * __builtin_amdgcn_exp2f(m3 - M);
        const float inv = 1.0f / fmaxf((w0 + w1) + (w2 + w3), 1e-30f);
        const h16* po = PO + (size_t)pr * 512 + dc;
        float acc[8];
        { const h16x8 x = *(const h16x8*)(po + 384);
#pragma unroll
          for (int e = 0; e < 8; ++e) acc[e] = w3 * (float)x[e]; }
        if (nsel > 0) { const h16x8 x = *(const h16x8*)(po);
#pragma unroll
          for (int e = 0; e < 8; ++e) acc[e] += w0 * (float)x[e]; }
        if (nsel > 1) { const h16x8 x = *(const h16x8*)(po + 128);
#pragma unroll
          for (int e = 0; e < 8; ++e) acc[e] += w1 * (float)x[e]; }
        if (nsel > 2) { const h16x8 x = *(const h16x8*)(po + 256);
#pragma unroll
          for (int e = 0; e < 8; ++e) acc[e] += w2 * (float)x[e]; }
        const size_t off = (size_t)t * 2048 + head * 128 + dc;
        const h16x8 zz = *(const h16x8*)(Z + off); h16x8 ov;
#pragma unroll
        for (int e = 0; e < 8; ++e) ov[e] = (h16)(acc[e] * inv * (float)zz[e]);
        *(h16x8*)(OZ + off) = ov;
    }
}

struct AllOn { __device__ __forceinline__ bool operator()(int) const { return true; } };
struct SelOn { const LAS unsigned* w; __device__ __forceinline__ bool operator()(int j) const { return ((w[j >> 5] >> (j & 31)) & 1u) != 0u; } };
__device__ __forceinline__ void phase_nsa_attn_mfma(const Frame& F) {
    const h16* Q = (const h16*)(F.ws + WS_QKV); const h16* KVb = Q + (size_t)16 * S * 128;
    const h16* Z = (const h16*)(F.ws + WS_QKV + 96 * MiB);
    const float* gates = (const float*)(F.ws + WS_GATES);
    const h16* KCMP = (const h16*)(F.ws + WS_KCMP); const h16* VCMPT = (const h16*)(F.ws + WS_VCMP);
    h16* OZ = (h16*)(F.ws + WS_OZ);
    LAS unsigned char* lds = (LAS unsigned char*)F.lds;
    LAS float* imp = (LAS float*)(lds + fa::LDS_IMP); LAS unsigned* selw = (LAS unsigned*)(lds + fa::LDS_SELW); LAS float* sv = (LAS float*)(lds + fa::LDS_SV) + F.wave * 128;
    const int lane = F.lane, r31 = lane & 31, h = lane >> 5, hh = F.wave & 3, qsub = F.wave >> 2;
    for (int it = F.bid; it < 256; it += F.G) {
        const int g = it >> 6, pi = it & 63, head = 4 * g + hh;
#pragma unroll 1
        for (int half = 0; half < 2; ++half) {
            const int c64 = half ? 127 - pi : pi;
            const int ql = 32 * qsub + r31, t = c64 * 64 + ql;
            h16x8 qf[8]; fa::load_q(qf, Q + ((size_t)head * S + t) * 128, h);
            fa::f32x16 o[4]; float m, l;
            for (int i = F.tid; i < 64 * 128; i += NTHREADS) imp[i] = 0.f;
            const int nval = (t >= 31) ? (((t - 31) >> 4) + 1 < NC ? ((t - 31) >> 4) + 1 : NC) : 0;
            const int tl = c64 * 64 + 63; const int nval_max = (tl >= 31) ? (((tl - 31) >> 4) + 1 < NC ? ((tl - 31) >> 4) + 1 : NC) : 0;
            const int jc = (nval_max + 63) >> 6;
            fa::zero_o(o); m = NEGF; l = 0.f;
            fa::stream<1>(lds, KCMP + (size_t)g * 512 * 128, VCMPT + (size_t)g * 512 * 128, 0, jc, qf, o, m, l, 0, nval - 1, AllOn(), F.tid, lane, 0.f, (LAS float*)nullptr);
            l += __shfl_xor(l, 32);
            { const float invl = 1.0f / fmaxf(l, 1e-30f); float l2 = 0.f;
              fa::stream<2>(lds, KCMP + (size_t)g * 512 * 128, VCMPT + (size_t)g * 512 * 128, 0, jc, qf, o, m, l2, 0, nval - 1, AllOn(), F.tid, lane, invl, imp + ql * 128); }
            const float g0 = gates[(size_t)t * 48 + head * 3 + 0];
#pragma unroll
            for (int dt = 0; dt < 4; ++dt)
#pragma unroll
                for (int c = 0; c < 4; ++c) { h16x4 ov;
#pragma unroll
                    for (int e = 0; e < 4; ++e) ov[e] = (h16)(o[dt][4 * c + e] * g0);
                    *(h16x4*)(OZ + (size_t)t * 2048 + head * 128 + 32 * dt + 8 * c + 4 * h) = ov; }
            __syncthreads();
            for (int qq = 0; qq < 8; ++qq) {
                const int q = F.wave * 8 + qq;
                float myv[2];
#pragma unroll
                for (int c = 0; c < 2; ++c) { const int s = lane + 64 * c; const bool valid = s <= c64, forced = (s == 0) || (s == c64) || (s == c64 - 1);
                    myv[c] = valid ? (forced ? BIGF : imp[q * 128 + s]) : NEGF; sv[s] = myv[c]; }
                wave_lds_fence();
                int rank0 = 0, rank1 = 0;
                for (int s2 = 0; s2 < 128; ++s2) { const float v2 = sv[s2];
                    rank0 += (v2 > myv[0] || (v2 == myv[0] && s2 < lane)) ? 1 : 0; rank1 += (v2 > myv[1] || (v2 == myv[1] && s2 < lane + 64)) ? 1 : 0; }
                const unsigned long long m0 = __ballot(rank0 < 16 && lane <= c64), m1 = __ballot(rank1 < 16 && (lane + 64) <= c64);
                if (lane == 0) { selw[q * 4 + 0] = (unsigned)m0; selw[q * 4 + 1] = (unsigned)(m0 >> 32); selw[q * 4 + 2] = (unsigned)m1; selw[q * 4 + 3] = (unsigned)(m1 >> 32); }
                wave_lds_fence();
            }
            __syncthreads();
            SelOn son; son.w = selw + ql * 4;
            fa::zero_o(o); m = NEGF; l = 0.f;
            fa::stream<0>(lds, KVb + ((size_t)2 * 4 + g) * S * 128, KVb + ((size_t)3 * 4 + g) * S * 128, 0, c64 + 1, qf, o, m, l, 0, t, son, F.tid, lane, 0.f, (LAS float*)nullptr);
            l += __shfl_xor(l, 32);
            { const float sc = gates[(size_t)t * 48 + head * 3 + 1] / fmaxf(l, 1e-30f);
#pragma unroll
              for (int dt = 0; dt < 4; ++dt)
#pragma unroll
                  for (int c = 0; c < 4; ++c) { h16* p = OZ + (size_t)t * 2048 + head * 128 + 32 * dt + 8 * c + 4 * h; const h16x4 pv = *(const h16x4*)p; h16x4 ov;
#pragma unroll
                      for (int e = 0; e < 4; ++e) ov[e] = (h16)((float)pv[e] + o[dt][4 * c + e] * sc);
                      *(h16x4*)p = ov; } }
            fa::zero_o(o); m = NEGF; l = 0.f;
            fa::stream<0>(lds, KVb + ((size_t)4 * 4 + g) * S * 128, KVb + ((size_t)5 * 4 + g) * S * 128, (c64 >= 8 ? c64 - 8 : 0), c64 + 1, qf, o, m, l, t - 511, t, AllOn(), F.tid, lane, 0.f, (LAS float*)nullptr);
            l += __shfl_xor(l, 32);
            const float sc2 = gates[(size_t)t * 48 + head * 3 + 2] / fmaxf(l, 1e-30f);
#pragma unroll
            for (int dt = 0; dt < 4; ++dt)
#pragma unroll
                for (int c = 0; c < 4; ++c) {
                    const int d = 32 * dt + 8 * c + 4 * h; const size_t off = (size_t)t * 2048 + head * 128 + d;
                    const h16x4 zz = *(const h16x4*)(Z + off); const h16x4 pv = *(const h16x4*)(OZ + off); h16x4 ov;
#pragma unroll
                    for (int e = 0; e < 4; ++e) ov[e] = (h16)(((float)pv[e] + o[dt][4 * c + e] * sc2) * (float)zz[e]);
                    *(h16x4*)(OZ + off) = ov;
                }
        }
    }
}

namespace rt {
typedef float f32x16 __attribute__((ext_vector_type(16)));
typedef short s16x4v __attribute__((__vector_size__(4 * sizeof(short))));
constexpr int SP = 144, STILE = 128 * SP;
constexpr int VP = 1088, VTILE = 32 * VP;
__device__ __forceinline__ h16x8 tr16(const LAS unsigned char* p0, const LAS unsigned char* p1) {
    const s16x4v a = __builtin_amdgcn_ds_read_tr16_b64_v4i16((LAS s16x4v*)p0), b = __builtin_amdgcn_ds_read_tr16_b64_v4i16((LAS s16x4v*)p1);
    const h16x4 x = __builtin_bit_cast(h16x4, a), y = __builtin_bit_cast(h16x4, b);
    h16x8 r; r[0] = x[0]; r[1] = x[1]; r[2] = x[2]; r[3] = x[3]; r[4] = y[0]; r[5] = y[1]; r[6] = y[2]; r[7] = y[3]; return r;
}
}
__device__ __forceinline__ void phase_ret_scan_mfma(const Frame& F, const Args& A) {
    const h16* RQ = (const h16*)(F.ws + WS_QKV); const h16* RK = RQ + (size_t)8 * S * 256; const h16* RV = RK + (size_t)8 * S * 256;
    h16* ST = (h16*)(F.ws + WS_P);
    LAS unsigned char* lds = (LAS unsigned char*)F.lds;
    const int lane = F.lane, g = lane >> 4, q = (lane & 15) >> 2, p = lane & 3, mr = F.wave >> 1, nc0 = (F.wave & 1) * 2;
    for (int it = F.bid; it < 256; it += F.G) {
        const int h = it >> 5, dk0 = ((it >> 3) & 3) * 64, dv0 = (it & 7) * 64;
        const float lg = A.lg2g[h], carry = __builtin_amdgcn_exp2f(128.f * lg);
        f32x4 acc[2] = {(f32x4){0.f, 0.f, 0.f, 0.f}, (f32x4){0.f, 0.f, 0.f, 0.f}};
        u32x4 kreg[2], vreg[2];
#define RT_LOAD(c) do { int tid_ = F.tid; asm volatile("" : "+v"(tid_)); _Pragma("unroll") for (int i = 0; i < 2; ++i) { const int idx = tid_ + 512 * i, row = idx >> 3, c16 = idx & 7; \
            kreg[i] = *(const u32x4*)(RK + ((size_t)h * S + (c) * 128 + row) * 256 + dk0 + c16 * 8); vreg[i] = *(const u32x4*)(RV + ((size_t)h * S + (c) * 128 + row) * 512 + dv0 + c16 * 8); } } while (0)
#define RT_WRITE(b) do { int tid_ = F.tid; asm volatile("" : "+v"(tid_)); _Pragma("unroll") for (int i = 0; i < 2; ++i) { const int idx = tid_ + 512 * i, row = idx >> 3, c16 = idx & 7; \
            const float w = __builtin_amdgcn_exp2f((float)(127 - row) * lg); h16x8 kk = __builtin_bit_cast(h16x8, kreg[i]); \
            _Pragma("unroll") for (int e = 0; e < 8; ++e) kk[e] = (h16)((float)kk[e] * w); \
            *(LAS h16x8*)(lds + (b) * 2 * rt::STILE + row * rt::SP + c16 * 16) = kk; *(LAS u32x4*)(lds + (b) * 2 * rt::STILE + rt::STILE + row * rt::SP + c16 * 16) = vreg[i]; } } while (0)
        __syncthreads();
        RT_LOAD(0); RT_WRITE(0);
        __syncthreads();
        for (int c = 0; c < 64; ++c) {
            const int cur = c & 1;
#pragma unroll
            for (int n = 0; n < 2; ++n) { h16x4 o; o[0] = (h16)acc[n][0]; o[1] = (h16)acc[n][1]; o[2] = (h16)acc[n][2]; o[3] = (h16)acc[n][3];
                *(h16x4*)(ST + (((size_t)(h * 64 + c)) * 512 + dv0 + 16 * (nc0 + n) + (lane & 15)) * 256 + dk0 + 16 * mr + 4 * g) = o; }
            if (c + 1 < 64) RT_LOAD(c + 1);
            acc[0] = acc[0] * carry; acc[1] = acc[1] * carry;
            const LAS unsigned char* kt = lds + cur * 2 * rt::STILE + (8 * g + q) * rt::SP + (16 * mr + 4 * p) * 2;
            const LAS unsigned char* vt = lds + cur * 2 * rt::STILE + rt::STILE + (8 * g + q) * rt::SP + (16 * nc0 + 4 * p) * 2;
#pragma unroll
            for (int ks = 0; ks < 4; ++ks) {
                const h16x8 a = rt::tr16(kt + 32 * ks * rt::SP, kt + (32 * ks + 4) * rt::SP);
                const h16x8 b0 = rt::tr16(vt + 32 * ks * rt::SP, vt + (32 * ks + 4) * rt::SP);
                const h16x8 b1 = rt::tr16(vt + 32 * ks * rt::SP + 32, vt + (32 * ks + 4) * rt::SP + 32);
                acc[0] = __builtin_amdgcn_mfma_f32_16x16x32_f16(a, b0, acc[0], 0, 0, 0);
                acc[1] = __builtin_amdgcn_mfma_f32_16x16x32_f16(a, b1, acc[1], 0, 0, 0);
            }
            if (c + 1 < 64) RT_WRITE(cur ^ 1);
            __syncthreads();
        }
#undef RT_LOAD
#undef RT_WRITE
    }
}

__device__ __forceinline__ void phase_ret_out_mfma(const Frame& F, const Args& A) {
    const h16* RQ = (const h16*)(F.ws + WS_QKV); const h16* RK = RQ + (size_t)8 * S * 256; const h16* RV = RK + (size_t)8 * S * 256; const h16* RG = RV + (size_t)8 * S * 512;
    const h16* ST = (const h16*)(F.ws + WS_P);
    h16* OZ = (h16*)(F.ws + WS_OZ);
    LAS unsigned char* lds = (LAS unsigned char*)F.lds;
    LAS float* stats = (LAS float*)(lds + 2 * rt::VTILE);
    const int lane = F.lane, r31 = lane & 31, hh = lane >> 5, itl = F.wave & 3, dvh = F.wave >> 2;
    for (int it = F.bid; it < 512; it += F.G) {
        const int h = it >> 6, c = it & 63, il = 32 * itl + r31, tok = c * 128 + il;
        const float lg = A.lg2g[h];
        rt::f32x16 acc[8];
#pragma unroll
        for (int r = 0; r < 8; ++r)
#pragma unroll
            for (int e = 0; e < 16; ++e) acc[r][e] = 0.f;
        const h16* qrow = RQ + ((size_t)h * S + tok) * 256 + 8 * hh;
        u32x4 vreg[4];
#define RO_LOAD(jt) do { int tid_ = F.tid; asm volatile("" : "+v"(tid_)); _Pragma("unroll") for (int i = 0; i < 4; ++i) { const int idx = tid_ + 512 * i; \
            vreg[i] = *(const u32x4*)(RV + ((size_t)h * S + c * 128 + 32 * (jt) + (idx >> 6)) * 512 + (idx & 63) * 8); } } while (0)
#define RO_WRITE(b) do { int tid_ = F.tid; asm volatile("" : "+v"(tid_)); _Pragma("unroll") for (int i = 0; i < 4; ++i) { const int idx = tid_ + 512 * i; \
            *(LAS u32x4*)(lds + (b) * rt::VTILE + (idx >> 6) * rt::VP + (idx & 63) * 16) = vreg[i]; } } while (0)
        __syncthreads();
        RO_LOAD(0);
        {
            const h16* srow = ST + (((size_t)(h * 64 + c)) * 512 + dvh * 256 + r31) * 256 + 8 * hh;
#pragma unroll 2
            for (int ks = 0; ks < 16; ++ks) {
                const h16x8 qf = *(const h16x8*)(qrow + 16 * ks);
#pragma unroll
                for (int r = 0; r < 8; ++r) { const h16x8 a = *(const h16x8*)(srow + (size_t)r * 32 * 256 + 16 * ks); acc[r] = __builtin_amdgcn_mfma_f32_32x32x16_f16(a, qf, acc[r], 0, 0, 0); }
            }
            const float rdec = __builtin_amdgcn_exp2f((float)(il + 1) * lg);
#pragma unroll
            for (int r = 0; r < 8; ++r) acc[r] = acc[r] * rdec;
        }
        RO_WRITE(0);
        __syncthreads();
        for (int jt = 0; jt < 4; ++jt) {
            const int cur = jt & 1;
            if (jt + 1 < 4) RO_LOAD(jt + 1);
            if (jt <= itl) {
                rt::f32x16 sT;
#pragma unroll
                for (int e = 0; e < 16; ++e) sT[e] = 0.f;
                const h16* krow = RK + ((size_t)h * S + c * 128 + 32 * jt + r31) * 256 + 8 * hh;
#pragma unroll 4
                for (int ks = 0; ks < 16; ++ks) sT = __builtin_amdgcn_mfma_f32_32x32x16_f16(*(const h16x8*)(krow + 16 * ks), *(const h16x8*)(qrow + 16 * ks), sT, 0, 0, 0);
                h16x8 pb[2];
#pragma unroll
                for (int e = 0; e < 16; ++e) { const int kl = 32 * jt + (e & 3) + 8 * (e >> 2) + 4 * hh, df = il - kl;
                    const float pv = (df >= 0) ? sT[e] * __builtin_amdgcn_exp2f((float)df * lg) : 0.f; pb[e >> 3][e & 7] = (h16)pv; }
                const LAS unsigned char* vbase = lds + cur * rt::VTILE + (4 * hh + ((lane & 15) >> 2)) * rt::VP + (dvh * 256 + 16 * ((lane >> 4) & 1) + 4 * (lane & 3)) * 2;
#pragma unroll
                for (int r = 0; r < 8; ++r) {
#pragma unroll
                    for (int sp = 0; sp < 2; ++sp) { const LAS unsigned char* vp = vbase + 16 * sp * rt::VP + 64 * r;
                        acc[r] = __builtin_amdgcn_mfma_f32_32x32x16_f16(rt::tr16(vp, vp + 8 * rt::VP), pb[sp], acc[r], 0, 0, 0); }
                    if (r & 1) __builtin_amdgcn_sched_barrier(0);
                }
            }
            if (jt + 1 < 4) RO_WRITE(cur ^ 1);
            __syncthreads();
        }
#undef RO_LOAD
#undef RO_WRITE
        float s1 = 0.f, s2 = 0.f;
#pragma unroll
        for (int r = 0; r < 8; ++r)
#pragma unroll
            for (int e = 0; e < 16; ++e) { s1 += acc[r][e]; s2 += acc[r][e] * acc[r][e]; }
        s1 += __shfl_xor(s1, 32); s2 += __shfl_xor(s2, 32);
        if (hh == 0) { stats[(F.wave * 32 + r31) * 2] = s1; stats[(F.wave * 32 + r31) * 2 + 1] = s2; }
        __syncthreads();
        s1 += stats[((F.wave ^ 4) * 32 + r31) * 2]; s2 += stats[((F.wave ^ 4) * 32 + r31) * 2 + 1];
        const float mu = s1 * (1.0f / 512.0f), var = fmaxf(s2 * (1.0f / 512.0f) - mu * mu, 0.f), rs = 1.0f / sqrtf(var + EPS);
#pragma unroll
        for (int r = 0; r < 8; ++r)
#pragma unroll
            for (int cq = 0; cq < 4; ++cq) {
                const size_t off = (size_t)tok * 4096 + h * 512 + dvh * 256 + 32 * r + 8 * cq + 4 * hh;
                const h16x4 gv = *(const h16x4*)(RG + off); h16x4 ov;
#pragma unroll
                for (int e = 0; e < 4; ++e) ov[e] = (h16)((float)gv[e] * ((acc[r][4 * cq + e] - mu) * rs));
                *(h16x4*)(OZ + off) = ov;
            }
    }
}

template <int KIND>
__device__ __forceinline__ void phase_gemm_proj(const Frame& F, int N) {
    pg8::Gemm g{(const h16*)(F.ws + WS_H), (const h16*)(F.ws + WS_WTIN), S, N, 2048, 2048, 2048}; pg8::StaticOrder So; So.init(S, N, F.G, F.bid);
    pg8::EpiProj<KIND> E{F.ws};
    pg8::gemm_phase<pg8::EpiProj<KIND>, pg8::StaticOrder, true, true>((LAS unsigned char*)F.lds, g, So, E);
}
__device__ __forceinline__ void phase_gemm(const Frame& F, const h16* A, const h16* Bt, int N, int K, void* O, int ldc, int f32out) {
    pg8::Gemm g{A, Bt, S, N, K, K, K}; pg8::StaticOrder So; So.init(S, N, F.G, F.bid);
    pg8::EpiStore E{O, ldc, f32out};
    pg8::gemm_phase<pg8::EpiStore, pg8::StaticOrder, true, true>((LAS unsigned char*)F.lds, g, So, E);
}

constexpr int NPHASE = 2 + 8 * DEPTH;
__host__ __device__ inline bool phase_exists(int p) {
    if (p < 2) return true;
    const int L = (p - 2) / 8, s = (p - 2) % 8, kind = L % 3;
    if (s == 7) return false;
    if (s == 1) return kind == 1 || (kind == 0 && MOBA_SPARSE);
    if (s == 2) return kind != 0 || MOBA_SPARSE;
    if (s == 4) return false;
    return true;
}

__global__ void __launch_bounds__(NTHREADS, 2) trunk_fwd(Args args) {
    extern __shared__ __attribute__((aligned(16))) unsigned char lds_raw[];
    Frame F;
    F.out = args.out; F.ws = args.ws; F.lds = (char*)lds_raw;
    F.tid = threadIdx.x; F.lane = F.tid & 63; F.wave = __builtin_amdgcn_readfirstlane(F.tid >> 6); F.G = gridDim.x; F.bid = blockIdx.x;
    volatile LAS unsigned* misc = (volatile LAS unsigned*)((LAS unsigned char*)lds_raw + MISC_OFF);
    if (F.tid < 16) misc[F.tid] = 0u;
    __syncthreads();
    XcdBarrier bar; bar.bar = (unsigned*)(F.ws + WS_CTL) + CW_BAR; bar.x = 0; bar.st = misc;
#if ONE_LAUNCH
    bar = xcd_barrier_post((unsigned*)(F.ws + WS_CTL) + CW_BAR, misc);
    cg::grid_group grid = cg::this_grid();
#endif
    const int lo = args.ph_lo, hi = args.ph_hi;
#if ONE_LAUNCH
    grid.sync();
#define SEAM(p) do { if ((p) > lo) xcd_barrier(bar); } while (0)
#else
#define SEAM(p) do { } while (0)
#endif
#define IN(p) (lo <= (p) && (p) < hi)
#ifndef PHMASK
#define PHMASK 0xFFFF
#endif
#define EN(b) ((PHMASK >> (b)) & 1)
#ifndef PROBE_DUP
#define PROBE_DUP 0
#endif
#define DUP(b, call) do { if ((PROBE_DUP >> (b)) & 1) { if (ONE_LAUNCH) xcd_barrier(bar); call; } } while (0)
    if (EN(0) && IN(0)) { SEAM(0); phase_prologue(F, args); }
    if (EN(1) && IN(1)) { SEAM(1); phase_norm(F, args, -1, 0); }
#define LAYER(L) do { \
        constexpr int kind = (L) % 3, base = 2 + 8 * (L); \
        constexpr int Nin = kind == 0 ? 8192 : (kind == 1 ? NSA_NP : 12288); \
        constexpr int Kout = kind == 2 ? 4096 : 2048; \
        if (EN(2) && IN(base + 0)) { SEAM(base + 0); phase_gemm_proj<kind>(F, Nin); } \
        if (EN(6) && kind == 1 && IN(base + 1)) { SEAM(base + 1); phase_nsa_cmp_a(F); } \
        if (EN(8) && kind == 0 && MOBA_SPARSE && IN(base + 1)) { SEAM(base + 1); phase_moba_gate(F, (L) / 3); } \
        if (EN(8) && kind == 0 && MOBA_SPARSE && IN(base + 2)) { SEAM(base + 2); phase_moba_attn_sparse(F, (L) / 3); } \
        if (kind != 0 && IN(base + 2)) { SEAM(base + 2); if (EN(6) && kind == 1) { phase_nsa_cmp_b(F, args); } else if (EN(7) && kind == 2) { phase_ret_scan_mfma(F, args); } } \
        if (IN(base + 3)) { SEAM(base + 3); if (EN(8) && kind == 0) { if (MOBA_SPARSE) phase_moba_merge(F); else phase_moba_attn_mfma(F); } else if (EN(9) && kind == 1) { phase_nsa_attn_mfma(F); DUP(9, phase_nsa_attn_mfma(F)); } else if (EN(10) && kind == 2) { phase_ret_out_mfma(F, args); } } \
        if (EN(2) && IN(base + 5)) { SEAM(base + 5); phase_gemm(F, (const h16*)(F.ws + WS_OZ), (const h16*)(F.ws + WS_WTOUT), 2048, Kout, F.ws + WS_Y, 2048, 0); } \
        if (EN(1) && IN(base + 6)) { SEAM(base + 6); phase_norm(F, args, (L), (L) + 1 < DEPTH ? (L) + 1 : -1); } \
    } while (0)
    LAYER(0); LAYER(1); LAYER(2); LAYER(3);
#undef LAYER
#undef EN
#undef DUP
#undef IN
#undef SEAM
}

extern "C" void kernel_launch(void* const* d_in, const int* in_sizes, int n_in, void* d_out, int out_size, void* d_ws, size_t ws_size, hipStream_t stream) {
    static int grid = 0;
    if (grid == 0) {
        if (n_in != 18 || out_size != S * D || ws_size < WS_END) { fprintf(stderr, "kernel_launch: unexpected shapes (n_in %d, out %d, ws %zu)\n", n_in, out_size, ws_size); grid = -1; return; }
        int dev = 0, cus = 0, per_cu = 0;
        if (hipGetDevice(&dev) != hipSuccess || hipDeviceGetAttribute(&cus, hipDeviceAttributeMultiprocessorCount, dev) != hipSuccess) { grid = -1; return; }
        if (hipFuncSetAttribute((const void*)trunk_fwd, hipFuncAttributeMaxDynamicSharedMemorySize, LDS_BYTES) != hipSuccess) { fprintf(stderr, "kernel_launch: hipFuncSetAttribute failed\n"); grid = -1; return; }
        if (hipOccupancyMaxActiveBlocksPerMultiprocessor(&per_cu, (const void*)trunk_fwd, NTHREADS, LDS_BYTES) != hipSuccess || per_cu < 1) { fprintf(stderr, "kernel_launch: occupancy query says %d\n", per_cu); per_cu = 1; }
        (void)hipGetLastError();
        grid = cus;
    }
    if (grid < 0) return;
    (void)hipMemsetAsync((char*)d_ws + WS_CTL, 0, CTL_ZERO_BYTES, stream);
    Args a{};
    for (int i = 0; i < 18; ++i) a.in[i] = (const float*)d_in[i];
    a.out = (float*)d_out; a.ws = (unsigned char*)d_ws;
    for (int j = 0; j < 16; ++j) a.inv16[j] = pow(500000.0, -(double)j / 16.0);
    for (int j = 0; j < 128; ++j) a.inv128[j] = pow(10000.0, -(double)j / 128.0);
    for (int h = 0; h < 8; ++h) a.lg2g[h] = (float)log2(1.0 - ldexp(1.0, -5 - h));
#if ONE_LAUNCH
    a.ph_lo = 0; a.ph_hi = NPHASE;
    void* kargs[] = {&a};
    hipError_t e = hipLaunchCooperativeKernel((const void*)trunk_fwd, dim3(grid), dim3(NTHREADS), kargs, LDS_BYTES, stream);
    if (e != hipSuccess) fprintf(stderr, "kernel_launch: cooperative launch failed: %s (grid %d)\n", hipGetErrorString(e), grid);
#else
    for (int p = 0; p < NPHASE; ++p) {
        if (!phase_exists(p)) continue;
        a.ph_lo = p; a.ph_hi = p + 1;
        hipLaunchKernelGGL(trunk_fwd, dim3(grid), dim3(NTHREADS), LDS_BYTES, stream, a);
    }
#endif
}
```

```cpp
#include <hip/hip_runtime.h>
#include <hip/hip_cooperative_groups.h>
#include <cstdio>
#include <cstdint>
#include <cmath>
namespace cg = cooperative_groups;

#ifndef ONE_LAUNCH
#define ONE_LAUNCH 1
#endif
#ifndef MOBA_SPARSE
#define MOBA_SPARSE 1
#endif
#ifndef MOBA_MFMA
#define MOBA_MFMA 1
#endif
#ifndef NSA_MFMA
#define NSA_MFMA 1
#endif

#define LAS __attribute__((address_space(3)))
typedef _Float16 h16;
typedef _Float16 h16x2 __attribute__((ext_vector_type(2)));
typedef _Float16 h16x4 __attribute__((ext_vector_type(4)));
typedef _Float16 h16x8 __attribute__((ext_vector_type(8)));
typedef float f32x2 __attribute__((ext_vector_type(2)));
typedef float f32x4 __attribute__((ext_vector_type(4)));
typedef unsigned u32x4 __attribute__((ext_vector_type(4)));

constexpr int S = 8192, D = 2048, DEPTH = 4;
constexpr float EPS = 1e-6f;
constexpr float NEGF = -1e30f, BIGF = 1e30f;
constexpr int NSA_NP = 7424;
constexpr int NC = 511;

constexpr size_t MiB = 1u << 20;
constexpr size_t WS_CTL = 0, CTL_ZERO_BYTES = 1 * MiB;
constexpr size_t WS_MODP = 1 * MiB;
constexpr size_t WS_KMEAN = 4 * MiB + 512 * 1024;
constexpr size_t WS_CMPB = 2 * MiB + 512 * 1024;
constexpr size_t WS_GATES = 3 * MiB;
constexpr size_t WS_KCMP = 5 * MiB;
constexpr size_t WS_VCMP = 5 * MiB + 512 * 1024;
constexpr size_t WS_ROPE16 = 6 * MiB;
constexpr size_t WS_ROPE128 = 7 * MiB;
constexpr size_t WS_WTIN = 16 * MiB;
constexpr size_t WS_WTOUT = 64 * MiB;
constexpr size_t WS_W1T = 72 * MiB;
constexpr size_t WS_H = 80 * MiB;
constexpr size_t WS_P = 112 * MiB;
constexpr size_t WS_QKV = 304 * MiB;
constexpr size_t WS_OZ = 496 * MiB;
constexpr size_t WS_Y = 560 * MiB;
constexpr size_t WS_OR = 624 * MiB;
constexpr size_t WS_END = 752 * MiB;

constexpr int LDS_BYTES = 147456;
constexpr int MISC_OFF = 135168;
constexpr int NTHREADS = 512;

struct Args {
    const float* in[18];
    float* out;
    unsigned char* ws;
    double inv16[16];
    double inv128[128];
    float lg2g[8];
    int ph_lo, ph_hi;
};

#define XB_TMO      128
#define XB_XCNT(j)  (256  + 64 * (j))
#define XB_XSUB(j)  (1280 + 64 * (j))
#define XB_XGEN(j)  (2304 + 64 * (j))
#define XB_TOP      3328
#define XB_TOPGEN   3392
#define XCD_BAR_WORDS 3456
#define XB_SPIN_CAP (1u << 24)
constexpr int CW_BAR = 4096;

__device__ __forceinline__ unsigned xb_ld(unsigned* p)              { return __hip_atomic_load(p, __ATOMIC_RELAXED, __HIP_MEMORY_SCOPE_AGENT); }
__device__ __forceinline__ unsigned xb_add(unsigned* p, unsigned v) { return __hip_atomic_fetch_add(p, v, __ATOMIC_RELAXED, __HIP_MEMORY_SCOPE_AGENT); }
__device__ __forceinline__ unsigned xb_xcc_id() { return (unsigned)__builtin_amdgcn_s_getreg((3 << 11) | 20) & 0xFu; }
#define XB_SPIN(cond, bar) do { unsigned _sp = 0; while (cond) { __builtin_amdgcn_s_sleep(1); \
    if ((++_sp & 255u) == 0u) { if (xb_ld(&(bar)[XB_TMO])) break; if (_sp > XB_SPIN_CAP) { atomicAdd(&(bar)[XB_TMO], 1u); break; } } } } while (0)

struct XcdBarrier { unsigned* bar; unsigned x; volatile LAS unsigned* st; };

__device__ __forceinline__ XcdBarrier xcd_barrier_post(unsigned* bar, volatile LAS unsigned* st) {
    XcdBarrier b; b.bar = bar; b.x = xb_xcc_id(); b.st = st;
    if (threadIdx.x == 0) (void)xb_add(&bar[XB_XCNT(b.x)], 1u);
    return b;
}
__device__ __forceinline__ void xcd_barrier_complete(unsigned* bar, unsigned x, unsigned& nloc, unsigned& nx) {
    const unsigned G = gridDim.x * gridDim.y * gridDim.z;
    unsigned sum, cnt, mine, sp = 0u;
    for (;;) {
        sum = 0u; cnt = 0u; mine = 0u;
#pragma unroll
        for (unsigned j = 0; j < 16; ++j) { const unsigned c = xb_ld(&bar[XB_XCNT(j)]); sum += c; cnt += (c > 0u) ? 1u : 0u; mine = (j == x) ? c : mine; }
        if (sum == G) break;
        __builtin_amdgcn_s_sleep(1);
        if ((++sp & 255u) == 0u) { if (xb_ld(&bar[XB_TMO])) break; if (sp > XB_SPIN_CAP) { atomicAdd(&bar[XB_TMO], 1u); break; } }
    }
    nloc = mine > 0u ? mine : 1u; nx = cnt > 0u ? cnt : 1u;
}
__device__ __forceinline__ void xcd_barrier(const XcdBarrier& b) {
    asm volatile("s_waitcnt vmcnt(0)" ::: "memory");
    __syncthreads();
    if (threadIdx.x == 0) {
        unsigned* bar = b.bar;
        __builtin_amdgcn_s_waitcnt(0);
        unsigned nloc = b.st[0], nx = b.st[1];
        if (nloc == 0u) { xcd_barrier_complete(bar, b.x, nloc, nx); b.st[0] = nloc; b.st[1] = nx; }
        const unsigned old = xb_add(&bar[XB_XSUB(b.x)], 1u);
        const unsigned gen = old / nloc;
        if (old + 1u == (gen + 1u) * nloc) {
            __builtin_amdgcn_fence(__ATOMIC_RELEASE, "agent");
            asm volatile("s_waitcnt vmcnt(0)" ::: "memory");
            const unsigned og = xb_add(&bar[XB_TOP], 1u);
            const unsigned tg = og / nx;
            if (og + 1u == (tg + 1u) * nx) xb_add(&bar[XB_TOPGEN], 1u);
            else XB_SPIN(xb_ld(&bar[XB_TOPGEN]) == tg, bar);
            __builtin_amdgcn_fence(__ATOMIC_ACQUIRE, "agent");
            xb_add(&bar[XB_XGEN(b.x)], 1u);
            asm volatile("s_waitcnt vmcnt(0)" ::: "memory");
        } else {
            XB_SPIN(xb_ld(&bar[XB_XGEN(b.x)]) == gen, bar);
            __builtin_amdgcn_fence(__ATOMIC_ACQUIRE, "agent");
            asm volatile("s_waitcnt vmcnt(0)" ::: "memory");
        }
    }
    __syncthreads();
}

__device__ __forceinline__ float silu_f(float x) { return x / (1.f + __expf(-x)); }
__device__ __forceinline__ float sigmoid_f(float x) { return 1.f / (1.f + __expf(-x)); }

namespace pg8 {
constexpr int BM = 256, BK = 64, HALF = 128, HTB = HALF * BK * 2, STAGE_BYTES = 8 * HTB, NXCD = 8, WGM = 8;
__host__ __device__ __forceinline__ int lds_byte(int r, int c) { const int st = (r >> 4) * 2 + (c >> 5), rr = r & 15, cc = c & 31, ob = rr * 64 + cc * 2; return st * 1024 + (ob ^ (((ob >> 9) & 1) << 5)); }
__host__ __device__ __forceinline__ void stage_rc(int b, int& R, int& C) { const int st = b / 1024, sb = b % 1024, swz = sb ^ (((sb >> 9) & 1) << 5); R = (st >> 1) * 16 + swz / 64; C = (st & 1) * 32 + (swz % 64) / 2; }
__host__ __device__ __forceinline__ int perm32(int rho) { const int n = rho >> 4, i = rho & 15; return 8 * (i >> 2) + 4 * n + (i & 3); }

struct Unit { int pm, pn; };
struct Gemm { const h16* A; const h16* Bt; int M, N, K, lda, ldb; };

struct StaticOrder {
    int nM, nN, nwg, G, c;
    __host__ __device__ void init(int M, int N, int G_, int c_) { nM = M / BM; nN = N / BM; nwg = nM * nN; G = G_; c = c_; }
    __host__ __device__ bool next(int i, Unit& u) const {
        const long L = (long)i * G + c; if (L >= nwg) return false;
        int wgid = (int)L; { const int q = nwg / NXCD, r = nwg % NXCD, xcd = wgid % NXCD, off = wgid / NXCD; wgid = (xcd < r ? xcd * (q + 1) : r * (q + 1) + (xcd - r) * q) + off; }
        const int nig = WGM * nN, gid = wgid / nig, fm = gid * WGM, gsz = (nM - fm) < WGM ? (nM - fm) : WGM;
        u.pm = fm + ((wgid % nig) % gsz); u.pn = (wgid % nig) / gsz; return true;
    }
    __device__ __forceinline__ void a_ready(const Unit&) const {}
    __device__ __forceinline__ void done(const Unit&) const {}
};

struct OneUnit {
    int pm, pn, have;
    __device__ bool next(int i, Unit& u) const { if (i != 0 || !have) return false; u.pm = pm; u.pn = pn; return true; }
    __device__ __forceinline__ void a_ready(const Unit&) const {}
    __device__ __forceinline__ void done(const Unit&) const {}
};
struct EpiStore {
    static constexpr bool PERM = true, AFTER_DRAIN = false;
    void* O; int ldc; int f32out;
    __device__ __forceinline__ void operator()(const f32x4 (&acc)[2][2][4][2], const Unit& u, int wr, int wc, int fr, int fq) const {
        const int row0 = u.pm * BM + wr * 64 + fr, col0 = u.pn * BM + wc * 32 + 8 * fq;
#pragma unroll
        for (int ai = 0; ai < 2; ++ai)
#pragma unroll
            for (int m = 0; m < 4; ++m) {
                const size_t roff = (size_t)(row0 + ai * HALF + m * 16) * ldc + col0;
#pragma unroll
                for (int bj = 0; bj < 2; ++bj) {
                    const f32x4 v0 = acc[ai][bj][m][0], v1 = acc[ai][bj][m][1];
                    if (f32out) {
                        float* p = (float*)O + roff + bj * HALF;
                        *(f32x4*)p = v0; *(f32x4*)(p + 4) = v1;
                    } else {
                        h16x8 w; w[0] = (h16)v0[0]; w[1] = (h16)v0[1]; w[2] = (h16)v0[2]; w[3] = (h16)v0[3]; w[4] = (h16)v1[0]; w[5] = (h16)v1[1]; w[6] = (h16)v1[2]; w[7] = (h16)v1[3];
                        *(h16x8*)((h16*)O + roff + bj * HALF) = w;
                    }
                }
            }
    }
};


template <int KIND  > struct EpiProj {
    static constexpr bool PERM = true, AFTER_DRAIN = false;
    unsigned char* ws;
    __device__ __forceinline__ static void st8(h16* p, const float (&v)[8]) { h16x8 w;
#pragma unroll
        for (int i = 0; i < 8; ++i) w[i] = (h16)v[i];
        *(h16x8*)p = w; }
    __device__ __forceinline__ void operator()(const f32x4 (&acc)[2][2][4][2], const Unit& u, int wr, int wc, int fr, int fq) const {
        const int pn = u.pn, d0 = 32 * wc + 8 * fq;
        h16* QKV = (h16*)(ws + WS_QKV);
        const f32x2* r16 = (const f32x2*)(ws + WS_ROPE16); const f32x2* r128 = (const f32x2*)(ws + WS_ROPE128);
        float ksum[2][8];
#pragma unroll
        for (int bj = 0; bj < 2; ++bj)
#pragma unroll
            for (int i = 0; i < 8; ++i) ksum[bj][i] = 0.f;
        int mode;
        float scale = 1.f; h16* base = QKV; int ld = 0;
        bool want_ksum = false;
        if (KIND == 0) {
            const int sect = pn >> 3;
            if (sect == 0) { mode = 0; scale = 0.08838834764831845f * 1.4426950408889634f  ; base = QKV + (size_t)(2 * (pn & 7)) * S * 128; }
            else if (sect == 1) { mode = 0; want_ksum = true; base = QKV + (size_t)16 * S * 128 + (size_t)(2 * (pn & 7)) * S * 128; }
            else if (sect == 2) { mode = 1; base = QKV + (size_t)32 * S * 128 + (size_t)(2 * (pn & 7)) * S * 128; }
            else { mode = 2; base = QKV + (size_t)48 * S * 128 + (pn & 7) * 256; ld = 2048; }
        } else if (KIND == 1) {
            if (pn < 8) { mode = 0; scale = 0.08838834764831845f * 1.4426950408889634f  ; base = QKV + (size_t)(2 * pn) * S * 128; }
            else if (pn < 20) { const int ti = (pn - 8) >> 1; mode = (ti & 1) ? 1 : 0; base = QKV + (size_t)16 * S * 128 + ((size_t)ti * 4 + 2 * ((pn - 8) & 1)) * S * 128; }
            else if (pn < 28) { mode = 2; base = (h16*)(ws + WS_QKV + 96 * MiB) + (pn - 20) * 256; ld = 2048; }
            else mode = 3;
        } else {
            if (pn < 8) { mode = 4; base = QKV + (size_t)pn * S * 256; }
            else if (pn < 16) { mode = 4; scale = 0.0625f; base = QKV + (size_t)8 * S * 256 + (size_t)(pn - 8) * S * 256; }
            else if (pn < 32) { mode = 5; base = QKV + (size_t)16 * S * 256 + (size_t)((pn - 16) >> 1) * S * 512 + ((pn - 16) & 1) * 256; }
            else { mode = 2; base = QKV + (size_t)16 * S * 256 + (size_t)8 * S * 512 + (pn - 32) * 256; ld = 4096; }
        }
#pragma unroll
        for (int ai = 0; ai < 2; ++ai)
#pragma unroll
            for (int m = 0; m < 4; ++m) {
                const int t = u.pm * BM + ai * HALF + wr * 64 + m * 16 + fr;
                float v[2][8];
#pragma unroll
                for (int bj = 0; bj < 2; ++bj)
#pragma unroll
                    for (int i = 0; i < 8; ++i) v[bj][i] = acc[ai][bj][m][i >> 2][i & 3];
                if (mode == 0) {
                    if (wc == 0) {
                        const f32x2* cs = r16 + (size_t)t * 16 + 8 * (fq & 1);
#pragma unroll
                        for (int bj = 0; bj < 2; ++bj)
#pragma unroll
                            for (int i = 0; i < 8; ++i) { const float o = __shfl_xor(v[bj][i], 32); const f32x2 c = cs[i];
                                v[bj][i] = (fq < 2) ? (v[bj][i] * c[0] - o * c[1]) : (o * c[1] + v[bj][i] * c[0]); }
                    }
#pragma unroll
                    for (int bj = 0; bj < 2; ++bj) {
#pragma unroll
                        for (int i = 0; i < 8; ++i) { v[bj][i] *= scale; ksum[bj][i] += v[bj][i]; }
                        st8(base + ((size_t)bj * S + t) * 128 + d0, v[bj]);
                    }
                } else if (mode == 1) {
#pragma unroll
                    for (int bj = 0; bj < 2; ++bj) st8(base + ((size_t)bj * S + t) * 128 + d0, v[bj]);
                } else if (mode == 2) {
#pragma unroll
                    for (int bj = 0; bj < 2; ++bj) {
#pragma unroll
                        for (int i = 0; i < 8; ++i) v[bj][i] = silu_f(v[bj][i]);
                        st8(base + (size_t)t * ld + 128 * bj + d0, v[bj]);
                    }
                } else if (mode == 3) {
                    if (d0 < 48) { float* gp = (float*)(ws + WS_GATES) + (size_t)t * 48 + d0;
#pragma unroll
                        for (int i = 0; i < 8; ++i) gp[i] = sigmoid_f(v[0][i]); }
                } else if (mode == 4) {
                    const f32x2* cs = r128 + (size_t)t * 128 + d0;
#pragma unroll
                    for (int i = 0; i < 8; ++i) { const f32x2 c = cs[i]; const float x1 = v[0][i], x2 = v[1][i];
                        v[0][i] = (x1 * c[0] - x2 * c[1]) * scale; v[1][i] = (x1 * c[1] + x2 * c[0]) * scale; }
                    st8(base + (size_t)t * 256 + d0, v[0]); st8(base + (size_t)t * 256 + 128 + d0, v[1]);
                } else {
#pragma unroll
                    for (int bj = 0; bj < 2; ++bj) st8(base + (size_t)t * 512 + 128 * bj + d0, v[bj]);
                }
            }
        if (KIND == 0 && want_ksum) {
#pragma unroll
            for (int bj = 0; bj < 2; ++bj)
#pragma unroll
                for (int i = 0; i < 8; ++i) { float x = ksum[bj][i]; x += __shfl_xor(x, 1); x += __shfl_xor(x, 2); x += __shfl_xor(x, 4); x += __shfl_xor(x, 8); ksum[bj][i] = x; }
            if (fr == 0) { float* km = (float*)(ws + WS_KMEAN) + (size_t)wr * 65536;
#pragma unroll
                for (int bj = 0; bj < 2; ++bj)
#pragma unroll
                    for (int i = 0; i < 8; ++i) km[((size_t)(2 * (pn & 7) + bj) * 32 + u.pm) * 128 + d0 + i] = ksum[bj][i] * (1.0f / 256.0f); }
        }
    }
};

template <class Epi, class Sched, bool ALIGN_EPI = false, bool SP2 = false>
__device__ __forceinline__ void gemm_phase(LAS unsigned char* lds, const Gemm g, const Sched& S, const Epi& E) {
    const int tid = threadIdx.x, wid = __builtin_amdgcn_readfirstlane(tid >> 6), lane = tid & 63, wr = wid >> 2, wc = wid & 3, fr = lane & 15, fq = lane >> 4;
    const int K = g.K, nt = K / BK;
    unsigned voffA[2], voffB[2];
#pragma unroll
    for (int i = 0; i < 2; ++i) { int R, C; stage_rc(tid * 16 + i * 8192, R, C); const int Rb = Epi::PERM ? ((R & ~31) + perm32(R & 31)) : R;
        voffA[i] = (unsigned)(R * g.lda + C) * 2u; voffB[i] = (unsigned)(Rb * g.ldb + C) * 2u; }
    const size_t kstep = (size_t)(BK * 2);
    const size_t hstepA = (size_t)HALF * g.lda * 2, hstepB = (size_t)HALF * g.ldb * 2;
    const size_t tstepA = 2 * hstepA, tstepB = 2 * hstepB;
    const unsigned ldsw = (unsigned)wid * 1024u;
    const int aoff = lds_byte(wr * 64 + fr, fq * 8), boff = lds_byte(wc * 32 + fr, fq * 8);
#define PG8_SA(b, h) (((b) * 2 + (h)) * HTB)
#define PG8_SB(b, h) ((4 + (b) * 2 + (h)) * HTB)
#define PG8_STAGE(bufoff, gbase, voff) do { _Pragma("unroll") for (int _i = 0; _i < 2; ++_i) \
        __builtin_amdgcn_global_load_lds((const unsigned*)((const char*)(gbase) + (voff)[_i]), (LAS unsigned*)(lds + (bufoff) + ldsw + _i * 8192), 16, 0, 0); } while (0)
#define PG8_LDA(dst, b, h) do { _Pragma("unroll") for (int m = 0; m < 4; ++m) _Pragma("unroll") for (int k = 0; k < 2; ++k) dst[m][k] = *(const LAS h16x8*)(lds + PG8_SA(b, h) + aoff + m * 2048 + k * 1024); } while (0)
#define PG8_LDB(dst, b, h) do { _Pragma("unroll") for (int n = 0; n < 2; ++n) _Pragma("unroll") for (int k = 0; k < 2; ++k) dst[n][k] = *(const LAS h16x8*)(lds + PG8_SB(b, h) + boff + n * 2048 + k * 1024); } while (0)
#define PG8_MMA(ai, bj, At, Bt) do { __builtin_amdgcn_s_setprio(1); _Pragma("unroll") for (int m = 0; m < 4; ++m) _Pragma("unroll") for (int n = 0; n < 2; ++n) _Pragma("unroll") for (int k = 0; k < 2; ++k) \
        acc[ai][bj][m][n] = __builtin_amdgcn_mfma_f32_16x16x32_f16(Bt[n][k], At[m][k], acc[ai][bj][m][n], 0, 0, 0); __builtin_amdgcn_s_setprio(0); } while (0)
#define PG8_WAIT_V(n) asm volatile("s_waitcnt vmcnt(" #n ")" ::: "memory")
#define PG8_WAIT_L(n) asm volatile("s_waitcnt lgkmcnt(" #n ")" ::: "memory")
#define PG8_BAR __builtin_amdgcn_s_barrier()
#define PG8_SCHED __builtin_amdgcn_sched_barrier(0)
    Unit cur, nxt; int ui = 0;
    if (!S.next(0, cur)) return;
    f32x4 acc[2][2][4][2];
#pragma unroll
    for (int a = 0; a < 2; ++a)
#pragma unroll
        for (int b = 0; b < 2; ++b)
#pragma unroll
            for (int m = 0; m < 4; ++m)
#pragma unroll
                for (int n = 0; n < 2; ++n) acc[a][b][m][n] = (f32x4){0.f, 0.f, 0.f, 0.f};
    h16x8 At[4][2], B0[2][2], B1[2][2];
    const char* cA = (const char*)g.A + (size_t)cur.pm * tstepA; const char* cB = (const char*)g.Bt + (size_t)cur.pn * tstepB;
    S.a_ready(cur);
    if constexpr (SP2) {
        PG8_STAGE(PG8_SB(0, 0), cB, voffB); PG8_STAGE(PG8_SB(0, 1), cB + hstepB, voffB); PG8_STAGE(PG8_SA(0, 0), cA, voffA); PG8_STAGE(PG8_SA(0, 1), cA + hstepA, voffA);
        if (wr == 1) PG8_BAR;
        PG8_WAIT_V(2); PG8_BAR;
        PG8_STAGE(PG8_SB(1, 0), cB + kstep, voffB); PG8_STAGE(PG8_SA(1, 0), cA + kstep, voffA); PG8_STAGE(PG8_SB(1, 1), cB + hstepB + kstep, voffB);
        PG8_WAIT_V(6); PG8_BAR;
    } else {
        PG8_STAGE(PG8_SB(0, 0), cB, voffB); PG8_STAGE(PG8_SA(0, 0), cA, voffA); PG8_STAGE(PG8_SB(0, 1), cB + hstepB, voffB); PG8_STAGE(PG8_SA(0, 1), cA + hstepA, voffA);
        if (wr == 1) PG8_BAR;
        PG8_WAIT_V(4); PG8_BAR;
        PG8_STAGE(PG8_SB(1, 0), cB + kstep, voffB); PG8_STAGE(PG8_SA(1, 0), cA + kstep, voffA); PG8_STAGE(PG8_SB(1, 1), cB + hstepB + kstep, voffB);
        PG8_WAIT_V(6); PG8_BAR;
    }
    for (;;) {
        const bool has_next = S.next(ui + 1, nxt);
        const char* nA = has_next ? (const char*)g.A + (size_t)nxt.pm * tstepA : cA; const char* nB = has_next ? (const char*)g.Bt + (size_t)nxt.pn * tstepB : cB;
        for (int t = 0; t < nt; t += 2) {
            const bool last = (t == nt - 2);
            const char* a1 = cA + (size_t)(t + 1) * kstep;
            const char* a2 = last ? nA : cA + (size_t)(t + 2) * kstep; const char* b2 = last ? nB : cB + (size_t)(t + 2) * kstep;
            const char* a3 = a2 + kstep; const char* b3 = b2 + kstep;
            if (last && has_next) S.a_ready(nxt);
            if constexpr (SP2) {
            PG8_LDB(B0, 0, 0); PG8_LDB(B1, 0, 1); PG8_SCHED; PG8_LDA(At, 0, 0); PG8_STAGE(PG8_SA(1, 1), a1 + hstepA, voffA);
            PG8_WAIT_V(8); PG8_WAIT_L(0); PG8_BAR; PG8_MMA(0, 0, At, B0); PG8_MMA(0, 1, At, B1); PG8_BAR; PG8_SCHED;
            PG8_LDA(At, 0, 1); PG8_STAGE(PG8_SB(0, 0), b2, voffB); PG8_STAGE(PG8_SB(0, 1), b2 + hstepB, voffB); PG8_STAGE(PG8_SA(0, 0), a2, voffA);
            PG8_WAIT_V(8); PG8_WAIT_L(0); PG8_BAR; PG8_MMA(1, 0, At, B0); PG8_MMA(1, 1, At, B1); PG8_BAR; PG8_SCHED;
            PG8_LDB(B0, 1, 0); PG8_LDB(B1, 1, 1); PG8_SCHED; PG8_LDA(At, 1, 0); PG8_STAGE(PG8_SA(0, 1), a2 + hstepA, voffA);
            PG8_WAIT_V(8); PG8_WAIT_L(0); PG8_BAR; PG8_MMA(0, 0, At, B0); PG8_MMA(0, 1, At, B1); PG8_BAR; PG8_SCHED;
            PG8_LDA(At, 1, 1); PG8_STAGE(PG8_SB(1, 0), b3, voffB); PG8_STAGE(PG8_SB(1, 1), b3 + hstepB, voffB); PG8_STAGE(PG8_SA(1, 0), a3, voffA);
            PG8_WAIT_V(8); PG8_WAIT_L(0); PG8_BAR; PG8_MMA(1, 0, At, B0); PG8_MMA(1, 1, At, B1); PG8_BAR; PG8_SCHED;
            } else {
            PG8_LDB(B0, 0, 0); PG8_SCHED; PG8_LDA(At, 0, 0); PG8_STAGE(PG8_SA(1, 1), a1 + hstepA, voffA);
            PG8_WAIT_L(8); PG8_BAR; PG8_WAIT_L(0); PG8_MMA(0, 0, At, B0); PG8_BAR; PG8_SCHED;
            PG8_LDB(B1, 0, 1); PG8_STAGE(PG8_SB(0, 0), b2, voffB);
            PG8_BAR; PG8_WAIT_L(0); PG8_MMA(0, 1, At, B1); PG8_BAR;
            PG8_LDA(At, 0, 1); PG8_STAGE(PG8_SA(0, 0), a2, voffA);
            PG8_BAR; PG8_WAIT_L(0); PG8_MMA(1, 0, At, B0); PG8_BAR; PG8_SCHED;
            PG8_STAGE(PG8_SB(0, 1), b2 + hstepB, voffB);
            PG8_WAIT_V(6); PG8_BAR; PG8_MMA(1, 1, At, B1); PG8_BAR;
            PG8_LDB(B0, 1, 0); PG8_SCHED; PG8_LDA(At, 1, 0); PG8_STAGE(PG8_SA(0, 1), a2 + hstepA, voffA);
            PG8_WAIT_L(8); PG8_BAR; PG8_WAIT_L(0); PG8_MMA(0, 0, At, B0); PG8_BAR; PG8_SCHED;
            PG8_LDB(B1, 1, 1); PG8_STAGE(PG8_SB(1, 0), b3, voffB);
            PG8_BAR; PG8_WAIT_L(0); PG8_MMA(0, 1, At, B1); PG8_BAR;
            PG8_LDA(At, 1, 1); PG8_STAGE(PG8_SA(1, 0), a3, voffA);
            PG8_BAR; PG8_WAIT_L(0); PG8_MMA(1, 0, At, B0); PG8_BAR; PG8_SCHED;
            PG8_STAGE(PG8_SB(1, 1), b3 + hstepB, voffB);
            PG8_WAIT_V(6); PG8_BAR; PG8_MMA(1, 1, At, B1); PG8_BAR;
            }
        }
        if constexpr (ALIGN_EPI) { if (wr == 0) PG8_BAR; }
        if constexpr (!Epi::AFTER_DRAIN) { E(acc, cur, wr, wc, fr, fq); S.done(cur); }
        if (!has_next) break;
#pragma unroll
        for (int a = 0; a < 2; ++a)
#pragma unroll
            for (int b = 0; b < 2; ++b)
#pragma unroll
                for (int m = 0; m < 4; ++m)
#pragma unroll
                    for (int n = 0; n < 2; ++n) acc[a][b][m][n] = (f32x4){0.f, 0.f, 0.f, 0.f};
        cur = nxt; cA = nA; cB = nB; ++ui;
        if constexpr (ALIGN_EPI) { if (wr == 1) PG8_BAR; }
    }
    PG8_WAIT_V(0);
    if constexpr (!ALIGN_EPI) { if (wr == 0) PG8_BAR; }
    PG8_BAR;
#undef PG8_SA
#undef PG8_SB
#undef PG8_STAGE
#undef PG8_LDA
#undef PG8_LDB
#undef PG8_MMA
#undef PG8_WAIT_V
#undef PG8_WAIT_L
#undef PG8_BAR
#undef PG8_SCHED
}
}

struct Frame {
    float* out;
    unsigned char* ws;
    char* lds;
    int tid, lane, wave, G, bid;
};

__device__ __forceinline__ float wave_sum(float v) {
#pragma unroll
    for (int o = 32; o >= 1; o >>= 1) v += __shfl_xor(v, o);
    return v;
}
__device__ __forceinline__ float wave_max(float v) {
#pragma unroll
    for (int o = 32; o >= 1; o >>= 1) v = fmaxf(v, __shfl_xor(v, o));
    return v;
}
__device__ __forceinline__ void wave_lds_fence() { __builtin_amdgcn_wave_barrier(); asm volatile("s_waitcnt lgkmcnt(0)" ::: "memory"); __builtin_amdgcn_wave_barrier(); }

__device__ __forceinline__ void sincos_d(double x, float& c, float& s) {
    const double TWO_OVER_PI = 0.63661977236758134308;
    const double PIO2_HI = 1.57079632679489655800e+00, PIO2_LO = 6.12323399573676603587e-17;
    const double q = __builtin_rint(x * TWO_OVER_PI);
    double y = __builtin_fma(-q, PIO2_HI, x); y = __builtin_fma(-q, PIO2_LO, y);
    const double y2 = y * y;
    double sp = 1.0 / 6227020800.0;
    sp = sp * y2 - 1.0 / 39916800.0; sp = sp * y2 + 1.0 / 362880.0; sp = sp * y2 - 1.0 / 5040.0; sp = sp * y2 + 1.0 / 120.0; sp = sp * y2 - 1.0 / 6.0; sp = sp * y2 * y + y;
    double cp = -1.0 / 87178291200.0;
    cp = cp * y2 + 1.0 / 479001600.0; cp = cp * y2 - 1.0 / 3628800.0; cp = cp * y2 + 1.0 / 40320.0; cp = cp * y2 - 1.0 / 720.0; cp = cp * y2 + 1.0 / 24.0; cp = cp * y2 - 0.5; cp = cp * y2 + 1.0;
    const long long qi = (long long)q; const int quad = (int)(qi & 3);
    double sv, cv;
    if (quad == 0) { sv = sp; cv = cp; } else if (quad == 1) { sv = cp; cv = -sp; } else if (quad == 2) { sv = -sp; cv = -cp; } else { sv = -cp; cv = sp; }
    c = (float)cv; s = (float)sv;
}

__device__ __forceinline__ int nsa_src_col(int n) { return n < 5120 ? n : (n < 7168 ? n + 48 : (n < 7216 ? n - 2048 : -1)); }
__device__ __forceinline__ void conv_transpose(const Frame& F, const float* W, int K, int Nsrc, h16* Wt, int Npad, int mapmode, int item0, int& items_done) {
    float* tile = (float*)F.lds;
    const int tk_n = K / 64, tn_n = Npad / 128, ntiles = tk_n * tn_n;
    f32x4 v[4];
#define CV_LOAD(it_) do { const int tk_ = (it_) / tn_n, tn_ = (it_) % tn_n; _Pragma("unroll") for (int i = 0; i < 4; ++i) { \
        const int idx = F.tid + i * NTHREADS, k = idx >> 5, n4 = (idx & 31) * 4; const int nn = tn_ * 128 + n4; const int src = mapmode ? nsa_src_col(nn) : nn; \
        v[i] = (f32x4){0.f, 0.f, 0.f, 0.f}; if (src >= 0 && src + 3 < Nsrc) v[i] = *(const f32x4*)(W + (size_t)(tk_ * 64 + k) * Nsrc + src); } } while (0)
    if (F.bid < ntiles) CV_LOAD(F.bid);
    for (int it = F.bid; it < ntiles; it += F.G) {
        const int tk = it / tn_n, tn = it % tn_n;
        __syncthreads();
#pragma unroll
        for (int i = 0; i < 4; ++i) {
            const int idx = F.tid + i * NTHREADS, k = idx >> 5, n4 = (idx & 31) * 4;
            tile[k * 129 + n4] = v[i][0]; tile[k * 129 + n4 + 1] = v[i][1]; tile[k * 129 + n4 + 2] = v[i][2]; tile[k * 129 + n4 + 3] = v[i][3];
        }
        if (it + F.G < ntiles) CV_LOAD(it + F.G);
        __syncthreads();
#pragma unroll
        for (int i = 0; i < 4; ++i) {
            const int idx = F.tid + i * NTHREADS, n = idx >> 4, k4 = (idx & 15) * 4;
            h16x4 o; o[0] = (h16)tile[k4 * 129 + n]; o[1] = (h16)tile[(k4 + 1) * 129 + n]; o[2] = (h16)tile[(k4 + 2) * 129 + n]; o[3] = (h16)tile[(k4 + 3) * 129 + n];
            *(h16x4*)(Wt + (size_t)(tn * 128 + n) * K + tk * 64 + k4) = o;
        }
    }
#undef CV_LOAD
    __syncthreads();
}
__device__ __forceinline__ void conv_layer_weights(const Frame& F, const Args& A, int L) {
    const int kind = L % 3, j = L / 3; int dummy = 0;
    h16* wtin = (h16*)(F.ws + WS_WTIN); h16* wtout = (h16*)(F.ws + WS_WTOUT);
    if (kind == 0) {
        conv_transpose(F, A.in[7] + (size_t)j * 2048 * 8192, 2048, 8192, wtin, 8192, 0, 0, dummy);
        conv_transpose(F, A.in[8] + (size_t)j * 2048 * 2048, 2048, 2048, wtout, 2048, 0, 0, dummy);
    } else if (kind == 1) {
        conv_transpose(F, A.in[9], 2048, 7216, wtin, NSA_NP, 1, 0, dummy);
        conv_transpose(F, A.in[10], 2048, 2048, wtout, 2048, 0, 0, dummy);
        conv_transpose(F, A.in[12], 4096, 256, (h16*)(F.ws + WS_W1T), 256, 0, 0, dummy);
        conv_transpose(F, A.in[14], 4096, 256, (h16*)(F.ws + WS_W1T) + (size_t)256 * 4096, 256, 0, 0, dummy);
    } else {
        conv_transpose(F, A.in[16], 2048, 12288, wtin, 12288, 0, 0, dummy);
        conv_transpose(F, A.in[17], 4096, 2048, wtout, 2048, 0, 0, dummy);
    }
}

__device__ __forceinline__ void phase_prologue(const Frame& F, const Args& A) {
    {
        float* modp = (float*)(F.ws + WS_MODP);
        const float* c = A.in[1]; const float* aw = A.in[3];
        float* sc = (float*)F.lds;
        __syncthreads();
        for (int i = F.tid; i < 2048; i += NTHREADS) sc[i] = silu_f(c[i]);
        __syncthreads();
        for (int it = F.bid; it < 192; it += F.G) {
            const int layer = it / 48, r = it % 48, slice = r / 3, nch = r % 3, n = nch * 2048 + F.tid * 4;
            const float* w = aw + (size_t)layer * 2048 * 6144 + (size_t)(slice * 128) * 6144 + n;
            f32x4 a0 = (f32x4){0.f, 0.f, 0.f, 0.f}, a1 = a0;
#pragma unroll 8
            for (int k = 0; k < 128; k += 2) {
                a0 += *(const f32x4*)(w + (size_t)k * 6144) * sc[slice * 128 + k];
                a1 += *(const f32x4*)(w + (size_t)(k + 1) * 6144) * sc[slice * 128 + k + 1];
            }
            *(f32x4*)(modp + (size_t)(slice * 4 + layer) * 6144 + n) = a0 + a1;
        }
        __syncthreads();
    }
    {
        const int* pos = (const int*)A.in[2];
        f32x2* r16 = (f32x2*)(F.ws + WS_ROPE16); f32x2* r128 = (f32x2*)(F.ws + WS_ROPE128);
        for (int idx = F.bid * NTHREADS + F.tid; idx < S * 16; idx += F.G * NTHREADS) {
            const int t = idx >> 4, j = idx & 15; float cs, sn; sincos_d((double)pos[t] * A.inv16[j], cs, sn); r16[idx] = (f32x2){cs, sn};
        }
        for (int idx = F.bid * NTHREADS + F.tid; idx < S * 128; idx += F.G * NTHREADS) {
            const int t = idx >> 7, j = idx & 127; float cs, sn; sincos_d((double)pos[t] * A.inv128[j], cs, sn); r128[idx] = (f32x2){cs, sn};
        }
    }
    if (F.bid >= F.G - 16) {
        const int slice = F.bid - (F.G - 16), kv = F.tid >> 8, j = F.tid & 255; const float* w1 = (kv ? A.in[14] : A.in[12]) + (size_t)slice * 256 * 256; const float* pe = A.in[11] + slice * 256;
        float a0 = 0.f, a1 = 0.f;
#pragma unroll 8
        for (int i = 0; i < 256; i += 2) { a0 += pe[i] * w1[(size_t)i * 256 + j]; a1 += pe[i + 1] * w1[(size_t)(i + 1) * 256 + j]; }
        ((float*)(F.ws + WS_CMPB))[slice * 512 + F.tid] = a0 + a1;
    }
    conv_layer_weights(F, A, 0);
}

__device__ __forceinline__ void phase_norm(const Frame& F, const Args& A, int Lprev, int Lnext) {
    float* modl = (float*)F.lds;
    const float* modp = (const float*)(F.ws + WS_MODP); const float* ab = A.in[4];
    __syncthreads();
    for (int i = F.tid; i < 6144; i += NTHREADS) {
        const int which = i >> 11, col = i & 2047;
        int layer, mcol;
        if (which == 0) { layer = Lprev; mcol = 4096 + col; } else if (which == 1) { layer = Lnext; mcol = 2048 + col; } else { layer = Lnext; mcol = col; }
        float v = 0.f;
        if (layer >= 0) { v = ab[layer * 6144 + mcol];
#pragma unroll
            for (int s = 0; s < 16; ++s) v += modp[(size_t)(s * 4 + layer) * 6144 + mcol]; }
        modl[i] = v;
    }
    __syncthreads();
    const float* xin = (Lprev <= 0) ? A.in[0] : F.out;
    const h16* Y = (const h16*)(F.ws + WS_Y);
    h16* H = (h16*)(F.ws + WS_H);
    const float* npost = A.in[6] + (Lprev >= 0 ? Lprev : 0) * 2048;
    const float* npre = A.in[5] + (Lnext >= 0 ? Lnext : 0) * 2048;
    for (int t = F.bid * 8 + F.wave; t < S; t += F.G * 8) {
        f32x4 x[8];
#pragma unroll
        for (int i = 0; i < 8; ++i) x[i] = *(const f32x4*)(xin + (size_t)t * D + i * 256 + F.lane * 4);
        if (Lprev >= 0) {
            f32x4 y[8]; float ss = 0.f;
#pragma unroll
            for (int i = 0; i < 8; ++i) { const h16x4 yh = *(const h16x4*)(Y + (size_t)t * D + i * 256 + F.lane * 4); y[i] = (f32x4){(float)yh[0], (float)yh[1], (float)yh[2], (float)yh[3]}; ss += y[i][0] * y[i][0] + y[i][1] * y[i][1] + y[i][2] * y[i][2] + y[i][3] * y[i][3]; }
            ss = wave_sum(ss);
            const float r = 1.0f / sqrtf(ss * (1.0f / D) + EPS);
#pragma unroll
            for (int i = 0; i < 8; ++i) {
                const int col = i * 256 + F.lane * 4;
                const f32x4 g = *(const f32x4*)(npost + col); const f32x4 gt = *(const f32x4*)(modl + col);
#pragma unroll
                for (int e = 0; e < 4; ++e) x[i][e] += gt[e] * (y[i][e] * r * g[e]);
                *(f32x4*)(F.out + (size_t)t * D + col) = x[i];
            }
        }
        if (Lnext >= 0) {
            float ss = 0.f;
#pragma unroll
            for (int i = 0; i < 8; ++i) ss += x[i][0] * x[i][0] + x[i][1] * x[i][1] + x[i][2] * x[i][2] + x[i][3] * x[i][3];
            ss = wave_sum(ss);
            const float r = 1.0f / sqrtf(ss * (1.0f / D) + EPS);
#pragma unroll
            for (int i = 0; i < 8; ++i) {
                const int col = i * 256 + F.lane * 4;
                const f32x4 g = *(const f32x4*)(npre + col); const f32x4 sc = *(const f32x4*)(modl + 2048 + col); const f32x4 sh = *(const f32x4*)(modl + 4096 + col);
                h16x4 hv;
#pragma unroll
                for (int e = 0; e < 4; ++e) hv[e] = (h16)((x[i][e] * r * g[e]) * (1.0f + sc[e]) + sh[e]);
                *(h16x4*)(H + (size_t)t * D + col) = hv;
            }
        }
    }
    if (Lnext > 0) conv_layer_weights(F, A, Lnext);
}

__device__ __forceinline__ void phase_nsa_cmp_a(const Frame& F) {
    const int u = F.bid, have = u < 64, kv = (u >> 5) & 1, mt = (u >> 2) & 7, kp = u & 3;
    const h16* A = (const h16*)(F.ws + WS_QKV) + (size_t)16 * S * 128 + (size_t)kv * 4 * S * 128 + kp * 1024;
    const h16* Bt = (const h16*)(F.ws + WS_W1T) + (size_t)kv * 256 * 4096 + kp * 1024;
    pg8::Gemm g{A, Bt, 2048, 256, 1024, 2048, 4096}; pg8::OneUnit So{mt, 0, have};
    pg8::EpiStore E{(float*)(F.ws + WS_OR) + (size_t)(kv * 4 + kp) * 2048 * 256, 256, 1};
    pg8::gemm_phase<pg8::EpiStore, pg8::OneUnit, true, true>((LAS unsigned char*)F.lds, g, So, E);
}
__device__ __forceinline__ void phase_nsa_cmp_b(const Frame& F, const Args& A) {
    float* hid = (float*)F.lds;
    const float* part = (const float*)(F.ws + WS_OR); const float* b1 = (const float*)(F.ws + WS_CMPB);
    for (int it = F.bid; it < 256; it += F.G) {
        const int kv = it >> 7, r0 = (it & 127) * 16;
        const float* W2 = kv ? A.in[15] : A.in[13];
        h16* dst = (h16*)(F.ws + (kv ? WS_VCMP : WS_KCMP));
        __syncthreads();
        for (int i = F.tid; i < 16 * 256; i += NTHREADS) {
            const int r = r0 + (i >> 8), j = i & 255; float v = 0.f;
#pragma unroll
            for (int sl = 0; sl < 16; ++sl) v += b1[sl * 512 + kv * 256 + j];
#pragma unroll
            for (int kp = 0; kp < 4; ++kp) v += part[((size_t)(kv * 4 + kp) * 2048 + r) * 256 + j];
            hid[i] = silu_f(v);
        }
        __syncthreads();
        const int d = F.tid & 127, rq = F.tid >> 7;
        float a[4] = {0.f, 0.f, 0.f, 0.f};
#pragma unroll 4
        for (int j = 0; j < 256; ++j) { const float w = W2[j * 128 + d];
#pragma unroll
            for (int e = 0; e < 4; ++e) a[e] += hid[(rq * 4 + e) * 256 + j] * w; }
#pragma unroll
        for (int e = 0; e < 4; ++e) { const int r = r0 + rq * 4 + e; dst[(size_t)r * 128 + d] = ((r & 511) < NC) ? (h16)a[e] : (h16)0.f; }
    }
}

namespace fa {
typedef float f32x16 __attribute__((ext_vector_type(16)));
typedef unsigned u32x2 __attribute__((ext_vector_type(2)));
constexpr float LOG2E = 1.4426950408889634f;
constexpr float MASKV = -3.0e38f;
constexpr int KROW = 256, VROW = 256;
constexpr int KT_BYTES = 64 * KROW, BUF_BYTES = KT_BYTES + 64 * VROW;
typedef short s16x4v __attribute__((__vector_size__(4 * sizeof(short))));
constexpr int LDS_IMP = 2 * BUF_BYTES;
constexpr int LDS_SELW = LDS_IMP + 32768;
constexpr int LDS_SV = LDS_SELW + 1024;
static_assert(LDS_SV + 4096 <= MISC_OFF, "attention LDS map");

__device__ __forceinline__ void stage_dma(LAS unsigned char* buf, const h16* Kg, const h16* Vg, int j, int wave, int lane) {
    asm volatile("" : "+v"(lane));
#pragma unroll
    for (int i = 0; i < 2; ++i) {
        const int o = wave * 2048 + i * 1024, row = (o >> 8) + (lane >> 4), p = lane & 15;
        const h16* ks = Kg + (size_t)(j * 64 + row) * 128 + (p ^ (row & 15)) * 8;
        const h16* vs = Vg + (size_t)(j * 64 + row) * 128 + (p ^ ((row & 3) << 2)) * 8;
        __builtin_amdgcn_global_load_lds((const unsigned*)ks, (LAS unsigned*)(buf + o), 16, 0, 0);
        __builtin_amdgcn_global_load_lds((const unsigned*)vs, (LAS unsigned*)(buf + KT_BYTES + o), 16, 0, 0);
    }
}

template <int MODE>
__device__ __forceinline__ void tile_compute(const LAS unsigned char* buf, int j, const h16x8 (&qf)[8], f32x16 (&o)[4], float& m, float& l,
                                             bool on, int lo, int hi, int lane, float inv_l, LAS float* imp_q) {
    const int r31 = lane & 31, h = lane >> 5, k0 = j * 64;
    const bool need = on && (k0 <= hi) && (k0 + 63 >= lo);
    if (__ballot(need) == 0ull) return;
    f32x16 s0, s1;
#pragma unroll
    for (int r = 0; r < 16; ++r) { s0[r] = 0.f; s1[r] = 0.f; }
    const LAS unsigned char* kp = buf + r31 * KROW;
    const int ksw = r31 & 15;
    {
        h16x8 ka[2][4];
#pragma unroll
        for (int e = 0; e < 2; ++e) { const int po = (((2 * e + h) ^ ksw) << 4); ka[0][2 * e] = *(const LAS h16x8*)(kp + po); ka[0][2 * e + 1] = *(const LAS h16x8*)(kp + 32 * KROW + po); }
#pragma unroll
        for (int g = 0; g < 4; ++g) {
            if (g < 3) {
#pragma unroll
                for (int e = 0; e < 2; ++e) { const int po = (((2 * (2 * (g + 1) + e) + h) ^ ksw) << 4); ka[(g + 1) & 1][2 * e] = *(const LAS h16x8*)(kp + po); ka[(g + 1) & 1][2 * e + 1] = *(const LAS h16x8*)(kp + 32 * KROW + po); }
            }
#pragma unroll
            for (int e = 0; e < 2; ++e) {
                s0 = __builtin_amdgcn_mfma_f32_32x32x16_f16(ka[g & 1][2 * e], qf[2 * g + e], s0, 0, 0, 0);
                s1 = __builtin_amdgcn_mfma_f32_32x32x16_f16(ka[g & 1][2 * e + 1], qf[2 * g + e], s1, 0, 0, 0);
            }
            __builtin_amdgcn_sched_barrier(0);
        }
    }
    const bool full = (k0 >= lo) && (k0 + 63 <= hi);
    const bool simple = (__ballot(on && !full) == 0ull);
    if (!simple) {
#pragma unroll
        for (int r = 0; r < 16; ++r) {
            const int key0 = k0 + (r & 3) + 8 * (r >> 2) + 4 * h, key1 = key0 + 32;
            const bool v0 = on && key0 >= lo && key0 <= hi, v1 = on && key1 >= lo && key1 <= hi;
            s0[r] = v0 ? s0[r] : MASKV; s1[r] = v1 ? s1[r] : MASKV;
        }
    }
    float tm;
    {
        float t8[8];
#pragma unroll
        for (int r = 0; r < 8; ++r) t8[r] = fmaxf(fmaxf(s0[2 * r], s0[2 * r + 1]), fmaxf(s1[2 * r], s1[2 * r + 1]));
        tm = fmaxf(fmaxf(fmaxf(t8[0], t8[1]), fmaxf(t8[2], t8[3])), fmaxf(fmaxf(t8[4], t8[5]), fmaxf(t8[6], t8[7])));
    }
    const float tmax = ((simple && !on) || !(tm > 0.5f * NEGF)) ? NEGF : tm;
    if (MODE != 2) {
        const float tmx = fmaxf(tmax, __shfl_xor(tmax, 32));
        const float m_new = fmaxf(m, tmx);
        const float alpha = __builtin_amdgcn_exp2f(m - m_new);
        const float off = (simple && !on) ? BIGF : m_new;
        float sum0 = 0.f, sum1 = 0.f;
#pragma unroll
        for (int r = 0; r < 16; ++r) {
            s0[r] = __builtin_amdgcn_exp2f(s0[r] - off);
            s1[r] = __builtin_amdgcn_exp2f(s1[r] - off);
            sum0 += s0[r]; sum1 += s1[r];
        }
        l = l * alpha + (sum0 + sum1);
        const bool grew = m_new > m; m = m_new;
        if (MODE == 1) return;
        if (__ballot(grew) != 0ull) {
#pragma unroll
            for (int dt = 0; dt < 4; ++dt) o[dt] = o[dt] * alpha;
        }
    } else {
        const float off = (simple && !on) ? BIGF : m;
#pragma unroll
        for (int r = 0; r < 16; ++r) {
            s0[r] = __builtin_amdgcn_exp2f(s0[r] - off) * inv_l;
            s1[r] = __builtin_amdgcn_exp2f(s1[r] - off) * inv_l;
        }
#pragma unroll
        for (int c = 0; c < 4; ++c) {
            const int sa = 16 * j + 2 * c + h, sb = sa + 8;
            const float a0 = s0[4 * c] + s0[4 * c + 1] + s0[4 * c + 2] + 0.5f * s0[4 * c + 3], b0 = 0.5f * s0[4 * c + 3];
            const float a1 = s1[4 * c] + s1[4 * c + 1] + s1[4 * c + 2] + 0.5f * s1[4 * c + 3], b1 = 0.5f * s1[4 * c + 3];
            (void)__hip_atomic_fetch_add(imp_q + sa, a0, __ATOMIC_RELAXED, __HIP_MEMORY_SCOPE_WORKGROUP); if (sa + 1 < 128) (void)__hip_atomic_fetch_add(imp_q + sa + 1, b0, __ATOMIC_RELAXED, __HIP_MEMORY_SCOPE_WORKGROUP);
            (void)__hip_atomic_fetch_add(imp_q + sb, a1, __ATOMIC_RELAXED, __HIP_MEMORY_SCOPE_WORKGROUP); if (sb + 1 < 128) (void)__hip_atomic_fetch_add(imp_q + sb + 1, b1, __ATOMIC_RELAXED, __HIP_MEMORY_SCOPE_WORKGROUP);
        }
    }
    h16x8 pb[2][2];
#pragma unroll
    for (int sp = 0; sp < 2; ++sp)
#pragma unroll
        for (int jj = 0; jj < 8; ++jj) { pb[0][sp][jj] = (h16)s0[8 * sp + jj]; pb[1][sp][jj] = (h16)s1[8 * sp + jj]; }
    const int vq = (lane & 15) >> 2;
    const LAS unsigned char* vrow = buf + KT_BYTES + (4 * h + vq) * VROW + ((2 * ((lane >> 4) & 1) + ((lane & 3) >> 1)) << 4) + 8 * (lane & 1);
    {
        s16x4v vr[2][8];
#pragma unroll
        for (int f = 0; f < 4; ++f) { const LAS unsigned char* vp = vrow + 16 * f * VROW + ((0 ^ vq) << 6);
            vr[0][2 * f] = __builtin_amdgcn_ds_read_tr16_b64_v4i16((LAS s16x4v*)vp); vr[0][2 * f + 1] = __builtin_amdgcn_ds_read_tr16_b64_v4i16((LAS s16x4v*)(vp + 8 * VROW)); }
#pragma unroll
        for (int dt = 0; dt < 4; ++dt) {
            if (dt < 3) {
#pragma unroll
                for (int f = 0; f < 4; ++f) { const LAS unsigned char* vp = vrow + 16 * f * VROW + (((dt + 1) ^ vq) << 6);
                    vr[(dt + 1) & 1][2 * f] = __builtin_amdgcn_ds_read_tr16_b64_v4i16((LAS s16x4v*)vp); vr[(dt + 1) & 1][2 * f + 1] = __builtin_amdgcn_ds_read_tr16_b64_v4i16((LAS s16x4v*)(vp + 8 * VROW)); }
            }
#pragma unroll
            for (int f = 0; f < 4; ++f) {
                const h16x4 l4 = __builtin_bit_cast(h16x4, vr[dt & 1][2 * f]), h4 = __builtin_bit_cast(h16x4, vr[dt & 1][2 * f + 1]);
                h16x8 va; va[0] = l4[0]; va[1] = l4[1]; va[2] = l4[2]; va[3] = l4[3]; va[4] = h4[0]; va[5] = h4[1]; va[6] = h4[2]; va[7] = h4[3];
                o[dt] = __builtin_amdgcn_mfma_f32_32x32x16_f16(va, pb[f >> 1][f & 1], o[dt], 0, 0, 0);
            }
            __builtin_amdgcn_sched_barrier(0);
        }
    }
}

template <int MODE, class OnFn>
__device__ __forceinline__ void stream(LAS unsigned char* lds, const h16* Kg, const h16* VTg, int jlo, int jhi, const h16x8 (&qf)[8],
                                       f32x16 (&o)[4], float& m, float& l, int lo, int hi, const OnFn& on_fn, int tid, int lane, float inv_l, LAS float* imp_q) {
    if (jlo >= jhi) return;
    const int wave = __builtin_amdgcn_readfirstlane(tid >> 6);
    stage_dma(lds, Kg, VTg, jlo, wave, lane);
    __syncthreads();
    for (int j = jlo; j < jhi; ++j) {
        const int cur = (j - jlo) & 1;
        if (j + 1 < jhi) stage_dma(lds + (cur ^ 1) * BUF_BYTES, Kg, VTg, j + 1, wave, lane);
        tile_compute<MODE>(lds + cur * BUF_BYTES, j, qf, o, m, l, on_fn(j), lo, hi, lane, inv_l, imp_q);
        __syncthreads();
    }
}

__device__ __forceinline__ void load_q(h16x8 (&qf)[8], const h16* qrow, int h) {
#pragma unroll
    for (int s = 0; s < 8; ++s) qf[s] = *(const h16x8*)(qrow + 16 * s + 8 * h);
}
__device__ __forceinline__ void zero_o(f32x16 (&o)[4]) {
#pragma unroll
    for (int dt = 0; dt < 4; ++dt)
#pragma unroll
        for (int r = 0; r < 16; ++r) o[dt][r] = 0.f;
}
}

struct MobaOn { unsigned selmask; int b; __device__ __forceinline__ bool operator()(int j) const { const int jb = j >> 2; return jb == b ? true : (((selmask >> jb) & 1u) != 0u); } };
__device__ __forceinline__ void phase_moba_attn_mfma(const Frame& F) {
    const h16* Q = (const h16*)(F.ws + WS_QKV); const h16* K = Q + (size_t)16 * S * 128; const h16* VT = K + (size_t)16 * S * 128; const h16* Z = VT + (size_t)16 * S * 128;
    const float* kmean = (const float*)(F.ws + WS_KMEAN);
    h16* OZ = (h16*)(F.ws + WS_OZ);
    LAS unsigned char* lds = (LAS unsigned char*)F.lds;
    const int lane = F.lane, r31 = lane & 31, h = lane >> 5;
    for (int it = F.bid; it < 256; it += F.G) {
        const int head = it >> 4, pi = it & 15;
#pragma unroll 1
        for (int half = 0; half < 2; ++half) {
            const int b = half ? 31 - pi : pi;
            const int t = b * 256 + F.wave * 32 + r31;
            h16x8 qf[8]; fa::load_q(qf, Q + ((size_t)head * S + t) * 128, h);
            LAS float* kml = (LAS float*)(lds + 2 * fa::BUF_BYTES);
            __syncthreads();
            for (int i = F.tid; i < b * 32; i += NTHREADS) { const float* km = kmean + (size_t)head * 32 * 128 + i * 4; *(LAS f32x4*)(kml + i * 4) = *(const f32x4*)km + *(const f32x4*)(km + 65536); }
            __syncthreads();
            float v0 = NEGF, v1 = NEGF, v2 = NEGF; int i0 = -1, i1 = -1, i2 = -1;
            for (int jb = 0; jb < b; ++jb) {
                const LAS float* km = kml + jb * 128 + 8 * h;
                float d = 0.f;
#pragma unroll
                for (int s = 0; s < 8; ++s) { const f32x4 ka = *(const LAS f32x4*)(km + 16 * s), kb = *(const LAS f32x4*)(km + 16 * s + 4);
                    d += (float)qf[s][0] * ka[0] + (float)qf[s][1] * ka[1] + (float)qf[s][2] * ka[2] + (float)qf[s][3] * ka[3] + (float)qf[s][4] * kb[0] + (float)qf[s][5] * kb[1] + (float)qf[s][6] * kb[2] + (float)qf[s][7] * kb[3]; }
                d += __shfl_xor(d, 32);
                if (d > v0) { v2 = v1; i2 = i1; v1 = v0; i1 = i0; v0 = d; i0 = jb; }
                else if (d > v1) { v2 = v1; i2 = i1; v1 = d; i1 = jb; }
                else if (d > v2) { v2 = d; i2 = jb; }
            }
            MobaOn on; on.b = b; on.selmask = (i0 >= 0 ? 1u << i0 : 0u) | (i1 >= 0 ? 1u << i1 : 0u) | (i2 >= 0 ? 1u << i2 : 0u);
            fa::f32x16 o[4]; fa::zero_o(o); float m = NEGF, l = 0.f;
            fa::stream<0>(lds, K + (size_t)head * S * 128, VT + (size_t)head * S * 128, 0, 4 * b + 4, qf, o, m, l, 0, t, on, F.tid, lane, 0.f, (LAS float*)nullptr);
            l += __shfl_xor(l, 32);
            const float inv = 1.0f / fmaxf(l, 1e-30f);
#pragma unroll
            for (int dt = 0; dt < 4; ++dt)
#pragma unroll
                for (int c = 0; c < 4; ++c) {
                    const int d = 32 * dt + 8 * c + 4 * h; const size_t off = (size_t)t * 2048 + head * 128 + d;
                    const h16x4 zz = *(const h16x4*)(Z + off); h16x4 ov;
#pragma unroll
                    for (int e = 0; e < 4; ++e) ov[e] = (h16)(o[dt][4 * c + e] * inv * (float)zz[e]);
                    *(h16x4*)(OZ + off) = ov;
                }
        }
    }
}

constexpr size_t WS_MLIST = WS_P;
constexpr size_t WS_MPO = WS_P + 16 * MiB;
constexpr size_t WS_MPML = WS_P + 144 * MiB;
constexpr int CW_MCNT = 8192;
struct ValidOn { bool v; __device__ __forceinline__ bool operator()(int) const { return v; } };

__device__ __forceinline__ void phase_moba_gate(const Frame& F, int jl) {
    const h16* Q = (const h16*)(F.ws + WS_QKV);
    const float* kmean = (const float*)(F.ws + WS_KMEAN);
    unsigned* cnt = (unsigned*)(F.ws + WS_CTL) + CW_MCNT + jl * 512;
    unsigned* list = (unsigned*)(F.ws + WS_MLIST);
    LAS unsigned char* lds = (LAS unsigned char*)F.lds;
    LAS float* kml = (LAS float*)lds;
    const int lane = F.lane, r31 = lane & 31, h = lane >> 5;
    for (int it = F.bid; it < 496; it += F.G) {
        const int head = it / 31, b = it % 31 + 1;
        const int t = b * 256 + F.wave * 32 + r31;
        h16x8 qf[8]; fa::load_q(qf, Q + ((size_t)head * S + t) * 128, h);
        __syncthreads();
        for (int i = F.tid; i < b * 32; i += NTHREADS) { const float* km = kmean + (size_t)head * 32 * 128 + i * 4; *(LAS f32x4*)(kml + i * 4) = *(const f32x4*)km + *(const f32x4*)(km + 65536); }
        __syncthreads();
        float v0 = NEGF, v1 = NEGF, v2 = NEGF; int i0 = -1, i1 = -1, i2 = -1;
        for (int jb = 0; jb < b; ++jb) {
            const LAS float* km = kml + jb * 128 + 8 * h;
            float d = 0.f;
#pragma unroll
            for (int s = 0; s < 8; ++s) { const f32x4 ka = *(const LAS f32x4*)(km + 16 * s), kb = *(const LAS f32x4*)(km + 16 * s + 4);
                d += (float)qf[s][0] * ka[0] + (float)qf[s][1] * ka[1] + (float)qf[s][2] * ka[2] + (float)qf[s][3] * ka[3] + (float)qf[s][4] * kb[0] + (float)qf[s][5] * kb[1] + (float)qf[s][6] * kb[2] + (float)qf[s][7] * kb[3]; }
            d += __shfl_xor(d, 32);
            if (d > v0) { v2 = v1; i2 = i1; v1 = v0; i1 = i0; v0 = d; i0 = jb; }
            else if (d > v1) { v2 = v1; i2 = i1; v1 = d; i1 = jb; }
            else if (d > v2) { v2 = d; i2 = jb; }
        }
        const unsigned long long below = (lane == 0) ? 0ull : (~0ull >> (64 - lane));
        for (int jb = 0; jb < b; ++jb) {
            const bool sel = (h == 0) && (i0 == jb || i1 == jb || i2 == jb);
            const unsigned long long mk = __ballot(sel);
            if (mk != 0ull) {
                unsigned base = 0u;
                if (lane == 0) base = __hip_atomic_fetch_add(cnt + head * 32 + jb, (unsigned)__popcll(mk), __ATOMIC_RELAXED, __HIP_MEMORY_SCOPE_AGENT);
                base = __shfl(base, 0);
                if (sel) { const unsigned slot = (i0 == jb) ? 0u : ((i1 == jb) ? 1u : 2u);
                    list[((size_t)head * 32 + jb) * 8192 + base + __popcll(mk & below)] = (unsigned)t | (slot << 16); }
            }
        }
    }
}

__device__ __forceinline__ void phase_moba_attn_sparse(const Frame& F, int jl) {
    const h16* Q = (const h16*)(F.ws + WS_QKV); const h16* K = Q + (size_t)16 * S * 128; const h16* V = K + (size_t)16 * S * 128;
    const unsigned* cnt = (const unsigned*)(F.ws + WS_CTL) + CW_MCNT + jl * 512;
    const unsigned* list = (const unsigned*)(F.ws + WS_MLIST);
    h16* PO = (h16*)(F.ws + WS_MPO); float* PML = (float*)(F.ws + WS_MPML);
    LAS unsigned char* lds = (LAS unsigned char*)F.lds;
    LAS unsigned* pre = (LAS unsigned*)(lds + 2 * fa::BUF_BYTES);
    LAS unsigned* wsum = pre + 520;
    const int lane = F.lane, r31 = lane & 31, h = lane >> 5;
    __syncthreads();
    { const unsigned n = cnt[F.tid]; const unsigned u = (n + 255u) >> 8; unsigned x = u;
#pragma unroll
      for (int o = 1; o < 64; o <<= 1) { const unsigned y = __shfl_up(x, o); if (lane >= o) x += y; }
      if (lane == 63) wsum[F.wave] = x;
      __syncthreads();
      unsigned off = 0u;
      for (int w = 0; w < F.wave; ++w) off += wsum[w];
      pre[F.tid] = off + x - u;
      if (F.tid == NTHREADS - 1) pre[512] = off + x;
      __syncthreads(); }
    const int U = 512 + (int)pre[512];
    for (int u = F.bid; u < U; u += F.G) {
        int head, jt0, slot = 3, t; bool valid = true;
        if (u < 512) { head = u >> 5; const int b = u & 31; jt0 = 4 * b; t = b * 256 + F.wave * 32 + r31; }
        else {
            const unsigned gq = (unsigned)(u - 512);
            int lo_ = 0, hi_ = 512;
            while (hi_ - lo_ > 1) { const int mid = (lo_ + hi_) >> 1; if (pre[mid] <= gq) lo_ = mid; else hi_ = mid; }
            const int i = lo_; head = i >> 5; jt0 = 4 * (i & 31);
            const unsigned e = (gq - pre[i]) * 256u + F.wave * 32 + r31, n = cnt[i];
            valid = e < n;
            const unsigned ent = valid ? list[(size_t)i * 8192 + e] : 0u;
            t = (int)(ent & 0xFFFFu); slot = (int)(ent >> 16);
        }
        h16x8 qf[8]; fa::load_q(qf, Q + ((size_t)head * S + t) * 128, h);
        fa::f32x16 o[4]; fa::zero_o(o); float m = NEGF, l = 0.f;
        ValidOn on; on.v = valid;
        fa::stream<0>(lds, K + (size_t)head * S * 128, V + (size_t)head * S * 128, jt0, jt0 + 4, qf, o, m, l, 0, (u < 512) ? t : S, on, F.tid, lane, 0.f, (LAS float*)nullptr);
        l += __shfl_xor(l, 32);
        if (valid) {
            const float inv = 1.0f / fmaxf(l, 1e-30f);
            const size_t pidx = ((size_t)t * 16 + head) * 4 + slot;
#pragma unroll
            for (int dt = 0; dt < 4; ++dt)
#pragma unroll
                for (int c = 0; c < 4; ++c) { h16x4 ov;
#pragma unroll
                    for (int e = 0; e < 4; ++e) ov[e] = (h16)(o[dt][4 * c + e] * inv);
                    *(h16x4*)(PO + pidx * 128 + 32 * dt + 8 * c + 4 * h) = ov; }
            if (h == 0) *(f32x2*)(PML + pidx * 2) = (f32x2){m, l};
        }
    }
}

__device__ __forceinline__ void phase_moba_merge(const Frame& F) {
    const h16* Z = (const h16*)(F.ws + WS_QKV) + (size_t)48 * S * 128;
    const h16* PO = (const h16*)(F.ws + WS_MPO); const float* PML = (const float*)(F.ws + WS_MPML);
    h16* OZ = (h16*)(F.ws + WS_OZ);
    const int sub = F.lane >> 4, dc = (F.lane & 15) * 8;
    for (int p0 = (F.bid * 8 + F.wave) * 4; p0 < S * 16; p0 += F.G * 8 * 4) {
        const int pr = p0 + sub, t = pr >> 4, head = pr & 15, nsel = (t >> 8) < 3 ? (t >> 8) : 3;
        const f32x4 ml01 = *(const f32x4*)(PML + (size_t)pr * 8), ml23 = *(const f32x4*)(PML + (size_t)pr * 8 + 4);
        const float m3 = ml23[2], l3 = ml23[3];
        const float m0 = nsel > 0 ? ml01[0] : NEGF, m1 = nsel > 1 ? ml01[2] : NEGF, m2 = nsel > 2 ? ml23[0] : NEGF;
        const float M = fmaxf(fmaxf(m0, m1), fmaxf(m2, m3));
        const float w0 = nsel > 0 ? ml01[1] * __builtin_amdgcn_exp2f(m0 - M) : 0.f, w1 = nsel > 1 ? ml01[3] * __builtin_amdgcn_exp2f(m1 - M) : 0.f;
        const float w2 = nsel > 2 ? ml23[1] * __builtin_amdgcn_exp2f(m2 - M) : 0.f, w3 = l3 * __builtin_amdgcn_exp2f(m3 - M);
        const float inv = 1.0f / fmaxf((w0 + w1) + (w2 + w3), 1e-30f);
        const h16* po = PO + (size_t)pr * 512 + dc;
        float acc[8];
        { const h16x8 x = *(const h16x8*)(po + 384);
#pragma unroll
          for (int e = 0; e < 8; ++e) acc[e] = w3 * (float)x[e]; }
        if (nsel > 0) { const h16x8 x = *(const h16x8*)(po);
#pragma unroll
          for (int e = 0; e < 8; ++e) acc[e] += w0 * (float)x[e]; }
        if (nsel > 1) { const h16x8 x = *(const h16x8*)(po + 128);
#pragma unroll
          for (int e = 0; e < 8; ++e) acc[e] += w1 * (float)x[e]; }
        if (nsel > 2) { const h16x8 x = *(const h16x8*)(po + 256);
#pragma unroll
          for (int e = 0; e < 8; ++e) acc[e] += w2 * (float)x[e]; }
        const size_t off = (size_t)t * 2048 + head * 128 + dc;
        const h16x8 zz = *(const h16x8*)(Z + off); h16x8 ov;
#pragma unroll
        for (int e = 0; e < 8; ++e) ov[e] = (h16)(acc[e] * inv * (float)zz[e]);
        *(h16x8*)(OZ + off) = ov;
    }
}

struct AllOn { __device__ __forceinline__ bool operator()(int) const { return true; } };
struct SelOn { const LAS unsigned* w; __device__ __forceinline__ bool operator()(int j) const { return ((w[j >> 5] >> (j & 31)) & 1u) != 0u; } };
__device__ __forceinline__ void phase_nsa_attn_mfma(const Frame& F) {
    const h16* Q = (const h16*)(F.ws + WS_QKV); const h16* KVb = Q + (size_t)16 * S * 128;
    const h16* Z = (const h16*)(F.ws + WS_QKV + 96 * MiB);
    const float* gates = (const float*)(F.ws + WS_GATES);
    const h16* KCMP = (const h16*)(F.ws + WS_KCMP); const h16* VCMPT = (const h16*)(F.ws + WS_VCMP);
    h16* OZ = (h16*)(F.ws + WS_OZ);
    LAS unsigned char* lds = (LAS unsigned char*)F.lds;
    LAS float* imp = (LAS float*)(lds + fa::LDS_IMP); LAS unsigned* selw = (LAS unsigned*)(lds + fa::LDS_SELW); LAS float* sv = (LAS float*)(lds + fa::LDS_SV) + F.wave * 128;
    const int lane = F.lane, r31 = lane & 31, h = lane >> 5, hh = F.wave & 3, qsub = F.wave >> 2;
    for (int it = F.bid; it < 256; it += F.G) {
        const int g = it >> 6, pi = it & 63, head = 4 * g + hh;
#pragma unroll 1
        for (int half = 0; half < 2; ++half) {
            const int c64 = half ? 127 - pi : pi;
            const int ql = 32 * qsub + r31, t = c64 * 64 + ql;
            h16x8 qf[8]; fa::load_q(qf, Q + ((size_t)head * S + t) * 128, h);
            fa::f32x16 o[4]; float m, l;
            for (int i = F.tid; i < 64 * 128; i += NTHREADS) imp[i] = 0.f;
            const int nval = (t >= 31) ? (((t - 31) >> 4) + 1 < NC ? ((t - 31) >> 4) + 1 : NC) : 0;
            const int tl = c64 * 64 + 63; const int nval_max = (tl >= 31) ? (((tl - 31) >> 4) + 1 < NC ? ((tl - 31) >> 4) + 1 : NC) : 0;
            const int jc = (nval_max + 63) >> 6;
            fa::zero_o(o); m = NEGF; l = 0.f;
            fa::stream<1>(lds, KCMP + (size_t)g * 512 * 128, VCMPT + (size_t)g * 512 * 128, 0, jc, qf, o, m, l, 0, nval - 1, AllOn(), F.tid, lane, 0.f, (LAS float*)nullptr);
            l += __shfl_xor(l, 32);
            { const float invl = 1.0f / fmaxf(l, 1e-30f); float l2 = 0.f;
              fa::stream<2>(lds, KCMP + (size_t)g * 512 * 128, VCMPT + (size_t)g * 512 * 128, 0, jc, qf, o, m, l2, 0, nval - 1, AllOn(), F.tid, lane, invl, imp + ql * 128); }
            const float g0 = gates[(size_t)t * 48 + head * 3 + 0];
#pragma unroll
            for (int dt = 0; dt < 4; ++dt)
#pragma unroll
                for (int c = 0; c < 4; ++c) { h16x4 ov;
#pragma unroll
                    for (int e = 0; e < 4; ++e) ov[e] = (h16)(o[dt][4 * c + e] * g0);
                    *(h16x4*)(OZ + (size_t)t * 2048 + head * 128 + 32 * dt + 8 * c + 4 * h) = ov; }
            __syncthreads();
            for (int qq = 0; qq < 8; ++qq) {
                const int q = F.wave * 8 + qq;
                float myv[2];
#pragma unroll
                for (int c = 0; c < 2; ++c) { const int s = lane + 64 * c; const bool valid = s <= c64, forced = (s == 0) || (s == c64) || (s == c64 - 1);
                    myv[c] = valid ? (forced ? BIGF : imp[q * 128 + s]) : NEGF; sv[s] = myv[c]; }
                wave_lds_fence();
                int rank0 = 0, rank1 = 0;
                for (int s2 = 0; s2 < 128; ++s2) { const float v2 = sv[s2];
                    rank0 += (v2 > myv[0] || (v2 == myv[0] && s2 < lane)) ? 1 : 0; rank1 += (v2 > myv[1] || (v2 == myv[1] && s2 < lane + 64)) ? 1 : 0; }
                const unsigned long long m0 = __ballot(rank0 < 16 && lane <= c64), m1 = __ballot(rank1 < 16 && (lane + 64) <= c64);
                if (lane == 0) { selw[q * 4 + 0] = (unsigned)m0; selw[q * 4 + 1] = (unsigned)(m0 >> 32); selw[q * 4 + 2] = (unsigned)m1; selw[q * 4 + 3] = (unsigned)(m1 >> 32); }
                wave_lds_fence();
            }
            __syncthreads();
            SelOn son; son.w = selw + ql * 4;
            fa::zero_o(o); m = NEGF; l = 0.f;
            fa::stream<0>(lds, KVb + ((size_t)2 * 4 + g) * S * 128, KVb + ((size_t)3 * 4 + g) * S * 128, 0, c64 + 1, qf, o, m, l, 0, t, son, F.tid, lane, 0.f, (LAS float*)nullptr);
            l += __shfl_xor(l, 32);
            { const float sc = gates[(size_t)t * 48 + head * 3 + 1] / fmaxf(l, 1e-30f);
#pragma unroll
              for (int dt = 0; dt < 4; ++dt)
#pragma unroll
                  for (int c = 0; c < 4; ++c) { h16* p = OZ + (size_t)t * 2048 + head * 128 + 32 * dt + 8 * c + 4 * h; const h16x4 pv = *(const h16x4*)p; h16x4 ov;
#pragma unroll
                      for (int e = 0; e < 4; ++e) ov[e] = (h16)((float)pv[e] + o[dt][4 * c + e] * sc);
                      *(h16x4*)p = ov; } }
            fa::zero_o(o); m = NEGF; l = 0.f;
            fa::stream<0>(lds, KVb + ((size_t)4 * 4 + g) * S * 128, KVb + ((size_t)5 * 4 + g) * S * 128, (c64 >= 8 ? c64 - 8 : 0), c64 + 1, qf, o, m, l, t - 511, t, AllOn(), F.tid, lane, 0.f, (LAS float*)nullptr);
            l += __shfl_xor(l, 32);
            const float sc2 = gates[(size_t)t * 48 + head * 3 + 2] / fmaxf(l, 1e-30f);
#pragma unroll
            for (int dt = 0; dt < 4; ++dt)
#pragma unroll
                for (int c = 0; c < 4; ++c) {
                    const int d = 32 * dt + 8 * c + 4 * h; const size_t off = (size_t)t * 2048 + head * 128 + d;
                    const h16x4 zz = *(const h16x4*)(Z + off); const h16x4 pv = *(const h16x4*)(OZ + off); h16x4 ov;
#pragma unroll
                    for (int e = 0; e < 4; ++e) ov[e] = (h16)(((float)pv[e] + o[dt][4 * c + e] * sc2) * (float)zz[e]);
                    *(h16x4*)(OZ + off) = ov;
                }
        }
    }
}

namespace rt {
typedef float f32x16 __attribute__((ext_vector_type(16)));
typedef short s16x4v __attribute__((__vector_size__(4 * sizeof(short))));
constexpr int SP = 144, STILE = 128 * SP;
constexpr int VP = 1088, VTILE = 32 * VP;
constexpr int KP = 528, KTILE = 32 * KP, OTILE = VTILE + KTILE;
__device__ __forceinline__ h16x8 tr16(const LAS unsigned char* p0, const LAS unsigned char* p1) {
    const s16x4v a = __builtin_amdgcn_ds_read_tr16_b64_v4i16((LAS s16x4v*)p0), b = __builtin_amdgcn_ds_read_tr16_b64_v4i16((LAS s16x4v*)p1);
    const h16x4 x = __builtin_bit_cast(h16x4, a), y = __builtin_bit_cast(h16x4, b);
    h16x8 r; r[0] = x[0]; r[1] = x[1]; r[2] = x[2]; r[3] = x[3]; r[4] = y[0]; r[5] = y[1]; r[6] = y[2]; r[7] = y[3]; return r;
}
}
__device__ __forceinline__ void phase_ret_scan_mfma(const Frame& F, const Args& A) {
    const h16* RQ = (const h16*)(F.ws + WS_QKV); const h16* RK = RQ + (size_t)8 * S * 256; const h16* RV = RK + (size_t)8 * S * 256;
    h16* ST = (h16*)(F.ws + WS_P);
    LAS unsigned char* lds = (LAS unsigned char*)F.lds;
    const int lane = F.lane, g = lane >> 4, q = (lane & 15) >> 2, p = lane & 3, mr = F.wave >> 1, nc0 = (F.wave & 1) * 2;
    for (int it = F.bid; it < 256; it += F.G) {
        const int h = it >> 5, dk0 = ((it >> 3) & 3) * 64, dv0 = (it & 7) * 64;
        const float lg = A.lg2g[h], carry = __builtin_amdgcn_exp2f(128.f * lg);
        f32x4 acc[2] = {(f32x4){0.f, 0.f, 0.f, 0.f}, (f32x4){0.f, 0.f, 0.f, 0.f}};
        u32x4 kreg[2], vreg[2];
#define RT_LOAD(c) do { int tid_ = F.tid; asm volatile("" : "+v"(tid_)); _Pragma("unroll") for (int i = 0; i < 2; ++i) { const int idx = tid_ + 512 * i, row = idx >> 3, c16 = idx & 7; \
            kreg[i] = *(const u32x4*)(RK + ((size_t)h * S + (c) * 128 + row) * 256 + dk0 + c16 * 8); vreg[i] = *(const u32x4*)(RV + ((size_t)h * S + (c) * 128 + row) * 512 + dv0 + c16 * 8); } } while (0)
#define RT_WRITE(b) do { int tid_ = F.tid; asm volatile("" : "+v"(tid_)); _Pragma("unroll") for (int i = 0; i < 2; ++i) { const int idx = tid_ + 512 * i, row = idx >> 3, c16 = idx & 7; \
            const float w = __builtin_amdgcn_exp2f((float)(127 - row) * lg); h16x8 kk = __builtin_bit_cast(h16x8, kreg[i]); \
            _Pragma("unroll") for (int e = 0; e < 8; ++e) kk[e] = (h16)((float)kk[e] * w); \
            *(LAS h16x8*)(lds + (b) * 2 * rt::STILE + row * rt::SP + c16 * 16) = kk; *(LAS u32x4*)(lds + (b) * 2 * rt::STILE + rt::STILE + row * rt::SP + c16 * 16) = vreg[i]; } } while (0)
        __syncthreads();
        RT_LOAD(0); RT_WRITE(0);
        __syncthreads();
        for (int c = 0; c < 64; ++c) {
            const int cur = c & 1;
#pragma unroll
            for (int n = 0; n < 2; ++n) { h16x4 o; o[0] = (h16)acc[n][0]; o[1] = (h16)acc[n][1]; o[2] = (h16)acc[n][2]; o[3] = (h16)acc[n][3];
                *(h16x4*)(ST + (((size_t)(h * 64 + c)) * 512 + dv0 + 16 * (nc0 + n) + (lane & 15)) * 256 + dk0 + 16 * mr + 4 * g) = o; }
            if (c + 1 < 64) RT_LOAD(c + 1);
            acc[0] = acc[0] * carry; acc[1] = acc[1] * carry;
            const LAS unsigned char* kt = lds + cur * 2 * rt::STILE + (8 * g + q) * rt::SP + (16 * mr + 4 * p) * 2;
            const LAS unsigned char* vt = lds + cur * 2 * rt::STILE + rt::STILE + (8 * g + q) * rt::SP + (16 * nc0 + 4 * p) * 2;
#pragma unroll
            for (int ks = 0; ks < 4; ++ks) {
                const h16x8 a = rt::tr16(kt + 32 * ks * rt::SP, kt + (32 * ks + 4) * rt::SP);
                const h16x8 b0 = rt::tr16(vt + 32 * ks * rt::SP, vt + (32 * ks + 4) * rt::SP);
                const h16x8 b1 = rt::tr16(vt + 32 * ks * rt::SP + 32, vt + (32 * ks + 4) * rt::SP + 32);
                acc[0] = __builtin_amdgcn_mfma_f32_16x16x32_f16(a, b0, acc[0], 0, 0, 0);
                acc[1] = __builtin_amdgcn_mfma_f32_16x16x32_f16(a, b1, acc[1], 0, 0, 0);
            }
            if (c + 1 < 64) RT_WRITE(cur ^ 1);
            __syncthreads();
        }
#undef RT_LOAD
#undef RT_WRITE
    }
}

__device__ __forceinline__ void phase_ret_out_mfma(const Frame& F, const Args& A) {
    const h16* RQ = (const h16*)(F.ws + WS_QKV); const h16* RK = RQ + (size_t)8 * S * 256; const h16* RV = RK + (size_t)8 * S * 256; const h16* RG = RV + (size_t)8 * S * 512;
    const h16* ST = (const h16*)(F.ws + WS_P);
    h16* OZ = (h16*)(F.ws + WS_OZ);
    LAS unsigned char* lds = (LAS unsigned char*)F.lds;
    LAS float* stats = (LAS float*)(lds + 2 * rt::OTILE);
    const int lane = F.lane, r31 = lane & 31, hh = lane >> 5, itl = F.wave & 3, dvh = F.wave >> 2;
    for (int it = F.bid; it < 512; it += F.G) {
        const int h = it >> 6, c = it & 63, il = 32 * itl + r31, tok = c * 128 + il;
        const float lg = A.lg2g[h];
        rt::f32x16 acc[8];
#pragma unroll
        for (int r = 0; r < 8; ++r)
#pragma unroll
            for (int e = 0; e < 16; ++e) acc[r][e] = 0.f;
        const h16* qrow = RQ + ((size_t)h * S + tok) * 256 + 8 * hh;
        u32x4 vreg[4], kreg2[2];
#define RO_LOAD(jt) do { int tid_ = F.tid; asm volatile("" : "+v"(tid_)); _Pragma("unroll") for (int i = 0; i < 2; ++i) { const int idx = tid_ + 512 * i; \
            kreg2[i] = *(const u32x4*)(RK + ((size_t)h * S + c * 128 + 32 * (jt) + (idx >> 5)) * 256 + (idx & 31) * 8); } \
            _Pragma("unroll") for (int i = 0; i < 4; ++i) { const int idx = tid_ + 512 * i; \
            vreg[i] = *(const u32x4*)(RV + ((size_t)h * S + c * 128 + 32 * (jt) + (idx >> 6)) * 512 + (idx & 63) * 8); } } while (0)
#define RO_WRITE(b) do { int tid_ = F.tid; asm volatile("" : "+v"(tid_)); _Pragma("unroll") for (int i = 0; i < 2; ++i) { const int idx = tid_ + 512 * i; \
            *(LAS u32x4*)(lds + (b) * rt::OTILE + rt::VTILE + (idx >> 5) * rt::KP + (idx & 31) * 16) = kreg2[i]; } \
            _Pragma("unroll") for (int i = 0; i < 4; ++i) { const int idx = tid_ + 512 * i; \
            *(LAS u32x4*)(lds + (b) * rt::OTILE + (idx >> 6) * rt::VP + (idx & 63) * 16) = vreg[i]; } } while (0)
        {
            constexpr int SLP = 80, SLB = 512 * SLP;
            const h16* sbase = ST + ((size_t)(h * 64 + c)) * 512 * 256;
            u32x4 sreg[4];
#define RS_LOAD(q_) do { int tid_ = F.tid; asm volatile("" : "+v"(tid_)); _Pragma("unroll") for (int i = 0; i < 4; ++i) { const int idx = tid_ + 512 * i; \
                sreg[i] = *(const u32x4*)(sbase + (size_t)(idx >> 2) * 256 + (q_) * 32 + (idx & 3) * 8); } } while (0)
#define RS_WRITE(b_) do { int tid_ = F.tid; asm volatile("" : "+v"(tid_)); _Pragma("unroll") for (int i = 0; i < 4; ++i) { const int idx = tid_ + 512 * i; \
                *(LAS u32x4*)(lds + (b_) * SLB + (idx >> 2) * SLP + (idx & 3) * 16) = sreg[i]; } } while (0)
            __syncthreads();
            RS_LOAD(0); RS_WRITE(0);
            __syncthreads();
            for (int q = 0; q < 8; ++q) {
                if (q + 1 < 8) RS_LOAD(q + 1);
                const LAS unsigned char* sl = lds + (q & 1) * SLB + (dvh * 256 + r31) * SLP + hh * 16;
#pragma unroll
                for (int k2 = 0; k2 < 2; ++k2) {
                    const h16x8 qf = *(const h16x8*)(qrow + 32 * q + 16 * k2);
#pragma unroll
                    for (int r = 0; r < 8; ++r) { const h16x8 a = *(const LAS h16x8*)(sl + r * 32 * SLP + k2 * 32); acc[r] = __builtin_amdgcn_mfma_f32_32x32x16_f16(a, qf, acc[r], 0, 0, 0); }
                }
                if (q + 1 < 8) RS_WRITE((q + 1) & 1);
                __syncthreads();
            }
#undef RS_LOAD
#undef RS_WRITE
            const float rdec = __builtin_amdgcn_exp2f((float)(il + 1) * lg);
#pragma unroll
            for (int r = 0; r < 8; ++r) acc[r] = acc[r] * rdec;
        }
        RO_LOAD(0);
        RO_WRITE(0);
        __syncthreads();
        for (int jt = 0; jt < 4; ++jt) {
            const int cur = jt & 1;
            if (jt + 1 < 4) RO_LOAD(jt + 1);
            if (jt <= itl) {
                rt::f32x16 sT;
#pragma unroll
                for (int e = 0; e < 16; ++e) sT[e] = 0.f;
                const LAS unsigned char* krow = lds + cur * rt::OTILE + rt::VTILE + r31 * rt::KP + hh * 16;
#pragma unroll 4
                for (int ks = 0; ks < 16; ++ks) sT = __builtin_amdgcn_mfma_f32_32x32x16_f16(*(const LAS h16x8*)(krow + 32 * ks), *(const h16x8*)(qrow + 16 * ks), sT, 0, 0, 0);
                h16x8 pb[2];
#pragma unroll
                for (int e = 0; e < 16; ++e) { const int kl = 32 * jt + (e & 3) + 8 * (e >> 2) + 4 * hh, df = il - kl;
                    const float pv = (df >= 0) ? sT[e] * __builtin_amdgcn_exp2f((float)df * lg) : 0.f; pb[e >> 3][e & 7] = (h16)pv; }
                const LAS unsigned char* vbase = lds + cur * rt::OTILE + (4 * hh + ((lane & 15) >> 2)) * rt::VP + (dvh * 256 + 16 * ((lane >> 4) & 1) + 4 * (lane & 3)) * 2;
#pragma unroll
                for (int r = 0; r < 8; ++r) {
#pragma unroll
                    for (int sp = 0; sp < 2; ++sp) { const LAS unsigned char* vp = vbase + 16 * sp * rt::VP + 64 * r;
                        acc[r] = __builtin_amdgcn_mfma_f32_32x32x16_f16(rt::tr16(vp, vp + 8 * rt::VP), pb[sp], acc[r], 0, 0, 0); }
                    if (r & 1) __builtin_amdgcn_sched_barrier(0);
                }
            }
            if (jt + 1 < 4) RO_WRITE(cur ^ 1);
            __syncthreads();
        }
#undef RO_LOAD
#undef RO_WRITE
        float s1 = 0.f, s2 = 0.f;
#pragma unroll
        for (int r = 0; r < 8; ++r)
#pragma unroll
            for (int e = 0; e < 16; ++e) { s1 += acc[r][e]; s2 += acc[r][e] * acc[r][e]; }
        s1 += __shfl_xor(s1, 32); s2 += __shfl_xor(s2, 32);
        if (hh == 0) { stats[(F.wave * 32 + r31) * 2] = s1; stats[(F.wave * 32 + r31) * 2 + 1] = s2; }
        __syncthreads();
        s1 += stats[((F.wave ^ 4) * 32 + r31) * 2]; s2 += stats[((F.wave ^ 4) * 32 + r31) * 2 + 1];
        const float mu = s1 * (1.0f / 512.0f), var = fmaxf(s2 * (1.0f / 512.0f) - mu * mu, 0.f), rs = 1.0f / sqrtf(var + EPS);
#pragma unroll
        for (int r = 0; r < 8; ++r)
#pragma unroll
            for (int cq = 0; cq < 4; ++cq) {
                const size_t off = (size_t)tok * 4096 + h * 512 + dvh * 256 + 32 * r + 8 * cq + 4 * hh;
                const h16x4 gv = *(const h16x4*)(RG + off); h16x4 ov;
#pragma unroll
                for (int e = 0; e < 4; ++e) ov[e] = (h16)((float)gv[e] * ((acc[r][4 * cq + e] - mu) * rs));
                *(h16x4*)(OZ + off) = ov;
            }
    }
}

template <int KIND>
__device__ __forceinline__ void phase_gemm_proj(const Frame& F, int N) {
    pg8::Gemm g{(const h16*)(F.ws + WS_H), (const h16*)(F.ws + WS_WTIN), S, N, 2048, 2048, 2048}; pg8::StaticOrder So; So.init(S, N, F.G, F.bid);
    pg8::EpiProj<KIND> E{F.ws};
    pg8::gemm_phase<pg8::EpiProj<KIND>, pg8::StaticOrder, true, true>((LAS unsigned char*)F.lds, g, So, E);
}
__device__ __forceinline__ void phase_gemm(const Frame& F, const h16* A, const h16* Bt, int N, int K, void* O, int ldc, int f32out) {
    pg8::Gemm g{A, Bt, S, N, K, K, K}; pg8::StaticOrder So; So.init(S, N, F.G, F.bid);
    pg8::EpiStore E{O, ldc, f32out};
    pg8::gemm_phase<pg8::EpiStore, pg8::StaticOrder, true, true>((LAS unsigned char*)F.lds, g, So, E);
}

constexpr int NPHASE = 2 + 8 * DEPTH;
__host__ __device__ inline bool phase_exists(int p) {
    if (p < 2) return true;
    const int L = (p - 2) / 8, s = (p - 2) % 8, kind = L % 3;
    if (s == 7) return false;
    if (s == 1) return kind == 1 || (kind == 0 && MOBA_SPARSE);
    if (s == 2) return kind != 0 || MOBA_SPARSE;
    if (s == 4) return false;
    return true;
}

__global__ void __launch_bounds__(NTHREADS, 2) trunk_fwd(Args args) {
    extern __shared__ __attribute__((aligned(16))) unsigned char lds_raw[];
    Frame F;
    F.out = args.out; F.ws = args.ws; F.lds = (char*)lds_raw;
    F.tid = threadIdx.x; F.lane = F.tid & 63; F.wave = __builtin_amdgcn_readfirstlane(F.tid >> 6); F.G = gridDim.x; F.bid = blockIdx.x;
    volatile LAS unsigned* misc = (volatile LAS unsigned*)((LAS unsigned char*)lds_raw + MISC_OFF);
    if (F.tid < 16) misc[F.tid] = 0u;
    __syncthreads();
    XcdBarrier bar; bar.bar = (unsigned*)(F.ws + WS_CTL) + CW_BAR; bar.x = 0; bar.st = misc;
#if ONE_LAUNCH
    bar = xcd_barrier_post((unsigned*)(F.ws + WS_CTL) + CW_BAR, misc);
    cg::grid_group grid = cg::this_grid();
#endif
    const int lo = args.ph_lo, hi = args.ph_hi;
#if ONE_LAUNCH
    grid.sync();
#define SEAM(p) do { if ((p) > lo) xcd_barrier(bar); } while (0)
#else
#define SEAM(p) do { } while (0)
#endif
#define IN(p) (lo <= (p) && (p) < hi)
#ifndef PHMASK
#define PHMASK 0xFFFF
#endif
#define EN(b) ((PHMASK >> (b)) & 1)
#ifndef PROBE_DUP
#define PROBE_DUP 0
#endif
#define DUP(b, call) do { if ((PROBE_DUP >> (b)) & 1) { if (ONE_LAUNCH) xcd_barrier(bar); call; } } while (0)
    if (EN(0) && IN(0)) { SEAM(0); phase_prologue(F, args); }
    if (EN(1) && IN(1)) { SEAM(1); phase_norm(F, args, -1, 0); }
#define LAYER(L) do { \
        constexpr int kind = (L) % 3, base = 2 + 8 * (L); \
        constexpr int Nin = kind == 0 ? 8192 : (kind == 1 ? NSA_NP : 12288); \
        constexpr int Kout = kind == 2 ? 4096 : 2048; \
        if (EN(2) && IN(base + 0)) { SEAM(base + 0); phase_gemm_proj<kind>(F, Nin); } \
        if (EN(6) && kind == 1 && IN(base + 1)) { SEAM(base + 1); phase_nsa_cmp_a(F); } \
        if (EN(8) && kind == 0 && MOBA_SPARSE && IN(base + 1)) { SEAM(base + 1); phase_moba_gate(F, (L) / 3); } \
        if (EN(8) && kind == 0 && MOBA_SPARSE && IN(base + 2)) { SEAM(base + 2); phase_moba_attn_sparse(F, (L) / 3); } \
        if (kind != 0 && IN(base + 2)) { SEAM(base + 2); if (EN(6) && kind == 1) { phase_nsa_cmp_b(F, args); } else if (EN(7) && kind == 2) { phase_ret_scan_mfma(F, args); } } \
        if (IN(base + 3)) { SEAM(base + 3); if (EN(8) && kind == 0) { if (MOBA_SPARSE) phase_moba_merge(F); else phase_moba_attn_mfma(F); } else if (EN(9) && kind == 1) { phase_nsa_attn_mfma(F); DUP(9, phase_nsa_attn_mfma(F)); } else if (EN(10) && kind == 2) { phase_ret_out_mfma(F, args); } } \
        if (EN(2) && IN(base + 5)) { SEAM(base + 5); phase_gemm(F, (const h16*)(F.ws + WS_OZ), (const h16*)(F.ws + WS_WTOUT), 2048, Kout, F.ws + WS_Y, 2048, 0); } \
        if (EN(1) && IN(base + 6)) { SEAM(base + 6); phase_norm(F, args, (L), (L) + 1 < DEPTH ? (L) + 1 : -1); } \
    } while (0)
    LAYER(0); LAYER(1); LAYER(2); LAYER(3);
#undef LAYER
#undef EN
#undef DUP
#undef IN
#undef SEAM
}

extern "C" void kernel_launch(void* const* d_in, const int* in_sizes, int n_in, void* d_out, int out_size, void* d_ws, size_t ws_size, hipStream_t stream) {
    static int grid = 0;
    if (grid == 0) {
        if (n_in != 18 || out_size != S * D || ws_size < WS_END) { fprintf(stderr, "kernel_launch: unexpected shapes (n_in %d, out %d, ws %zu)\n", n_in, out_size, ws_size); grid = -1; return; }
        int dev = 0, cus = 0, per_cu = 0;
        if (hipGetDevice(&dev) != hipSuccess || hipDeviceGetAttribute(&cus, hipDeviceAttributeMultiprocessorCount, dev) != hipSuccess) { grid = -1; return; }
        if (hipFuncSetAttribute((const void*)trunk_fwd, hipFuncAttributeMaxDynamicSharedMemorySize, LDS_BYTES) != hipSuccess) { fprintf(stderr, "kernel_launch: hipFuncSetAttribute failed\n"); grid = -1; return; }
        if (hipOccupancyMaxActiveBlocksPerMultiprocessor(&per_cu, (const void*)trunk_fwd, NTHREADS, LDS_BYTES) != hipSuccess || per_cu < 1) { fprintf(stderr, "kernel_launch: occupancy query says %d\n", per_cu); per_cu = 1; }
        (void)hipGetLastError();
        grid = cus;
    }
    if (grid < 0) return;
    (void)hipMemsetAsync((char*)d_ws + WS_CTL, 0, CTL_ZERO_BYTES, stream);
    Args a{};
    for (int i = 0; i < 18; ++i) a.in[i] = (const float*)d_in[i];
    a.out = (float*)d_out; a.ws = (unsigned char*)d_ws;
    for (int j = 0; j < 16; ++j) a.inv16[j] = pow(500000.0, -(double)j / 16.0);
    for (int j = 0; j < 128; ++j) a.inv128[j] = pow(10000.0, -(double)j / 128.0);
    for (int h = 0; h < 8; ++h) a.lg2g[h] = (float)log2(1.0 - ldexp(1.0, -5 - h));
#if ONE_LAUNCH
    a.ph_lo = 0; a.ph_hi = NPHASE;
    void* kargs[] = {&a};
    hipError_t e = hipLaunchCooperativeKernel((const void*)trunk_fwd, dim3(grid), dim3(NTHREADS), kargs, LDS_BYTES, stream);
    if (e != hipSuccess) fprintf(stderr, "kernel_launch: cooperative launch failed: %s (grid %d)\n", hipGetErrorString(e), grid);
#else
    for (int p = 0; p < NPHASE; ++p) {
        if (!phase_exists(p)) continue;
        a.ph_lo = p; a.ph_hi = p + 1;
        hipLaunchKernelGGL(trunk_fwd, dim3(grid), dim3(NTHREADS), LDS_BYTES, stream, a);
    }
#endif
}
```

```cpp
#include <hip/hip_runtime.h>
#include <hip/hip_cooperative_groups.h>
#include <cstdio>
#include <cstdint>
#include <cmath>
namespace cg = cooperative_groups;

#ifndef ONE_LAUNCH
#define ONE_LAUNCH 1
#endif
#ifndef MOBA_SPARSE
#define MOBA_SPARSE 1
#endif
#ifndef MOBA_MFMA
#define MOBA_MFMA 1
#endif
#ifndef NSA_MFMA
#define NSA_MFMA 1
#endif

#define LAS __attribute__((address_space(3)))
typedef _Float16 h16;
typedef _Float16 h16x2 __attribute__((ext_vector_type(2)));
typedef _Float16 h16x4 __attribute__((ext_vector_type(4)));
typedef _Float16 h16x8 __attribute__((ext_vector_type(8)));
typedef float f32x2 __attribute__((ext_vector_type(2)));
typedef float f32x4 __attribute__((ext_vector_type(4)));
typedef unsigned u32x4 __attribute__((ext_vector_type(4)));

constexpr int S = 8192, D = 2048, DEPTH = 4;
constexpr float EPS = 1e-6f;
constexpr float NEGF = -1e30f, BIGF = 1e30f;
constexpr int NSA_NP = 7424;
constexpr int NC = 511;

constexpr size_t MiB = 1u << 20;
constexpr size_t WS_CTL = 0, CTL_ZERO_BYTES = 1 * MiB;
constexpr size_t WS_MODP = 1 * MiB;
constexpr size_t WS_KMEAN = 4 * MiB + 512 * 1024;
constexpr size_t WS_CMPB = 2 * MiB + 512 * 1024;
constexpr size_t WS_MODF = 2 * MiB + 640 * 1024;
constexpr size_t WS_GATES = 3 * MiB;
constexpr size_t WS_KCMP = 5 * MiB;
constexpr size_t WS_VCMP = 5 * MiB + 512 * 1024;
constexpr size_t WS_ROPE16 = 6 * MiB;
constexpr size_t WS_ROPE128 = 7 * MiB;
constexpr size_t WS_WTIN = 16 * MiB;
constexpr size_t WS_WTOUT = 64 * MiB;
constexpr size_t WS_W1T = 72 * MiB;
constexpr size_t WS_H = 80 * MiB;
constexpr size_t WS_P = 112 * MiB;
constexpr size_t WS_QKV = 304 * MiB;
constexpr size_t WS_OZ = 496 * MiB;
constexpr size_t WS_Y = 560 * MiB;
constexpr size_t WS_OR = 624 * MiB;
constexpr size_t WS_END = 752 * MiB;

constexpr int LDS_BYTES = 147456;
constexpr int MISC_OFF = 135168;
constexpr int NTHREADS = 512;

struct Args {
    const float* in[18];
    float* out;
    unsigned char* ws;
    double inv16[16];
    double inv128[128];
    float lg2g[8];
    int ph_lo, ph_hi;
};

#define XB_TMO      128
#define XB_XCNT(j)  (256  + 64 * (j))
#define XB_XSUB(j)  (1280 + 64 * (j))
#define XB_XGEN(j)  (2304 + 64 * (j))
#define XB_TOP      3328
#define XB_TOPGEN   3392
#define XCD_BAR_WORDS 3456
#define XB_SPIN_CAP (1u << 24)
constexpr int CW_BAR = 4096;

__device__ __forceinline__ unsigned xb_ld(unsigned* p)              { return __hip_atomic_load(p, __ATOMIC_RELAXED, __HIP_MEMORY_SCOPE_AGENT); }
__device__ __forceinline__ unsigned xb_add(unsigned* p, unsigned v) { return __hip_atomic_fetch_add(p, v, __ATOMIC_RELAXED, __HIP_MEMORY_SCOPE_AGENT); }
__device__ __forceinline__ unsigned xb_xcc_id() { return (unsigned)__builtin_amdgcn_s_getreg((3 << 11) | 20) & 0xFu; }
#define XB_SPIN(cond, bar) do { unsigned _sp = 0; while (cond) { __builtin_amdgcn_s_sleep(1); \
    if ((++_sp & 255u) == 0u) { if (xb_ld(&(bar)[XB_TMO])) break; if (_sp > XB_SPIN_CAP) { atomicAdd(&(bar)[XB_TMO], 1u); break; } } } } while (0)

struct XcdBarrier { unsigned* bar; unsigned x; volatile LAS unsigned* st; };

__device__ __forceinline__ XcdBarrier xcd_barrier_post(unsigned* bar, volatile LAS unsigned* st) {
    XcdBarrier b; b.bar = bar; b.x = xb_xcc_id(); b.st = st;
    if (threadIdx.x == 0) (void)xb_add(&bar[XB_XCNT(b.x)], 1u);
    return b;
}
__device__ __forceinline__ void xcd_barrier_complete(unsigned* bar, unsigned x, unsigned& nloc, unsigned& nx) {
    const unsigned G = gridDim.x * gridDim.y * gridDim.z;
    unsigned sum, cnt, mine, sp = 0u;
    for (;;) {
        sum = 0u; cnt = 0u; mine = 0u;
#pragma unroll
        for (unsigned j = 0; j < 16; ++j) { const unsigned c = xb_ld(&bar[XB_XCNT(j)]); sum += c; cnt += (c > 0u) ? 1u : 0u; mine = (j == x) ? c : mine; }
        if (sum == G) break;
        __builtin_amdgcn_s_sleep(1);
        if ((++sp & 255u) == 0u) { if (xb_ld(&bar[XB_TMO])) break; if (sp > XB_SPIN_CAP) { atomicAdd(&bar[XB_TMO], 1u); break; } }
    }
    nloc = mine > 0u ? mine : 1u; nx = cnt > 0u ? cnt : 1u;
}
__device__ __forceinline__ void xcd_barrier(const XcdBarrier& b) {
    asm volatile("s_waitcnt vmcnt(0)" ::: "memory");
    __syncthreads();
    if (threadIdx.x == 0) {
        unsigned* bar = b.bar;
        __builtin_amdgcn_s_waitcnt(0);
        unsigned nloc = b.st[0], nx = b.st[1];
        if (nloc == 0u) { xcd_barrier_complete(bar, b.x, nloc, nx); b.st[0] = nloc; b.st[1] = nx; }
        const unsigned old = xb_add(&bar[XB_XSUB(b.x)], 1u);
        const unsigned gen = old / nloc;
        if (old + 1u == (gen + 1u) * nloc) {
            __builtin_amdgcn_fence(__ATOMIC_RELEASE, "agent");
            asm volatile("s_waitcnt vmcnt(0)" ::: "memory");
            const unsigned og = xb_add(&bar[XB_TOP], 1u);
            const unsigned tg = og / nx;
            if (og + 1u == (tg + 1u) * nx) xb_add(&bar[XB_TOPGEN], 1u);
            else XB_SPIN(xb_ld(&bar[XB_TOPGEN]) == tg, bar);
            __builtin_amdgcn_fence(__ATOMIC_ACQUIRE, "agent");
            xb_add(&bar[XB_XGEN(b.x)], 1u);
            asm volatile("s_waitcnt vmcnt(0)" ::: "memory");
        } else {
            XB_SPIN(xb_ld(&bar[XB_XGEN(b.x)]) == gen, bar);
            __builtin_amdgcn_fence(__ATOMIC_ACQUIRE, "agent");
            asm volatile("s_waitcnt vmcnt(0)" ::: "memory");
        }
    }
    __syncthreads();
}

__device__ __forceinline__ float silu_f(float x) { return x / (1.f + __expf(-x)); }
__device__ __forceinline__ float sigmoid_f(float x) { return 1.f / (1.f + __expf(-x)); }

namespace pg8 {
constexpr int BM = 256, BK = 64, HALF = 128, HTB = HALF * BK * 2, STAGE_BYTES = 8 * HTB, NXCD = 8, WGM = 8;
__host__ __device__ __forceinline__ int lds_byte(int r, int c) { const int st = (r >> 4) * 2 + (c >> 5), rr = r & 15, cc = c & 31, ob = rr * 64 + cc * 2; return st * 1024 + (ob ^ (((ob >> 9) & 1) << 5)); }
__host__ __device__ __forceinline__ void stage_rc(int b, int& R, int& C) { const int st = b / 1024, sb = b % 1024, swz = sb ^ (((sb >> 9) & 1) << 5); R = (st >> 1) * 16 + swz / 64; C = (st & 1) * 32 + (swz % 64) / 2; }
__host__ __device__ __forceinline__ int perm32(int rho) { const int n = rho >> 4, i = rho & 15; return 8 * (i >> 2) + 4 * n + (i & 3); }

struct Unit { int pm, pn; };
struct Gemm { const h16* A; const h16* Bt; int M, N, K, lda, ldb; };

struct StaticOrder {
    int nM, nN, nwg, G, c;
    __host__ __device__ void init(int M, int N, int G_, int c_) { nM = M / BM; nN = N / BM; nwg = nM * nN; G = G_; c = c_; }
    __host__ __device__ bool next(int i, Unit& u) const {
        const long L = (long)i * G + c; if (L >= nwg) return false;
        int wgid = (int)L; { const int q = nwg / NXCD, r = nwg % NXCD, xcd = wgid % NXCD, off = wgid / NXCD; wgid = (xcd < r ? xcd * (q + 1) : r * (q + 1) + (xcd - r) * q) + off; }
        const int nig = WGM * nN, gid = wgid / nig, fm = gid * WGM, gsz = (nM - fm) < WGM ? (nM - fm) : WGM;
        u.pm = fm + ((wgid % nig) % gsz); u.pn = (wgid % nig) / gsz; return true;
    }
    __device__ __forceinline__ void a_ready(const Unit&) const {}
    __device__ __forceinline__ void done(const Unit&) const {}
};

struct OneUnit {
    int pm, pn, have;
    __device__ bool next(int i, Unit& u) const { if (i != 0 || !have) return false; u.pm = pm; u.pn = pn; return true; }
    __device__ __forceinline__ void a_ready(const Unit&) const {}
    __device__ __forceinline__ void done(const Unit&) const {}
};
struct EpiStore {
    static constexpr bool PERM = true, AFTER_DRAIN = false;
    void* O; int ldc; int f32out;
    __device__ __forceinline__ void operator()(const f32x4 (&acc)[2][2][4][2], const Unit& u, int wr, int wc, int fr, int fq) const {
        const int row0 = u.pm * BM + wr * 64 + fr, col0 = u.pn * BM + wc * 32 + 8 * fq;
#pragma unroll
        for (int ai = 0; ai < 2; ++ai)
#pragma unroll
            for (int m = 0; m < 4; ++m) {
                const size_t roff = (size_t)(row0 + ai * HALF + m * 16) * ldc + col0;
#pragma unroll
                for (int bj = 0; bj < 2; ++bj) {
                    const f32x4 v0 = acc[ai][bj][m][0], v1 = acc[ai][bj][m][1];
                    if (f32out) {
                        float* p = (float*)O + roff + bj * HALF;
                        *(f32x4*)p = v0; *(f32x4*)(p + 4) = v1;
                    } else {
                        h16x8 w; w[0] = (h16)v0[0]; w[1] = (h16)v0[1]; w[2] = (h16)v0[2]; w[3] = (h16)v0[3]; w[4] = (h16)v1[0]; w[5] = (h16)v1[1]; w[6] = (h16)v1[2]; w[7] = (h16)v1[3];
                        *(h16x8*)((h16*)O + roff + bj * HALF) = w;
                    }
                }
            }
    }
};


template <int KIND  > struct EpiProj {
    static constexpr bool PERM = true, AFTER_DRAIN = false;
    unsigned char* ws;
    __device__ __forceinline__ static void st8(h16* p, const float (&v)[8]) { h16x8 w;
#pragma unroll
        for (int i = 0; i < 8; ++i) w[i] = (h16)v[i];
        *(h16x8*)p = w; }
    __device__ __forceinline__ void operator()(const f32x4 (&acc)[2][2][4][2], const Unit& u, int wr, int wc, int fr, int fq) const {
        const int pn = u.pn, d0 = 32 * wc + 8 * fq;
        h16* QKV = (h16*)(ws + WS_QKV);
        const f32x2* r16 = (const f32x2*)(ws + WS_ROPE16); const f32x2* r128 = (const f32x2*)(ws + WS_ROPE128);
        float ksum[2][8];
#pragma unroll
        for (int bj = 0; bj < 2; ++bj)
#pragma unroll
            for (int i = 0; i < 8; ++i) ksum[bj][i] = 0.f;
        int mode;
        float scale = 1.f; h16* base = QKV; int ld = 0;
        bool want_ksum = false;
        if (KIND == 0) {
            const int sect = pn >> 3;
            if (sect == 0) { mode = 0; scale = 0.08838834764831845f * 1.4426950408889634f  ; base = QKV + (size_t)(2 * (pn & 7)) * S * 128; }
            else if (sect == 1) { mode = 0; want_ksum = true; base = QKV + (size_t)16 * S * 128 + (size_t)(2 * (pn & 7)) * S * 128; }
            else if (sect == 2) { mode = 1; base = QKV + (size_t)32 * S * 128 + (size_t)(2 * (pn & 7)) * S * 128; }
            else { mode = 2; base = QKV + (size_t)48 * S * 128 + (pn & 7) * 256; ld = 2048; }
        } else if (KIND == 1) {
            if (pn < 8) { mode = 0; scale = 0.08838834764831845f * 1.4426950408889634f  ; base = QKV + (size_t)(2 * pn) * S * 128; }
            else if (pn < 20) { const int ti = (pn - 8) >> 1; mode = (ti & 1) ? 1 : 0; base = QKV + (size_t)16 * S * 128 + ((size_t)ti * 4 + 2 * ((pn - 8) & 1)) * S * 128; }
            else if (pn < 28) { mode = 2; base = (h16*)(ws + WS_QKV + 96 * MiB) + (pn - 20) * 256; ld = 2048; }
            else mode = 3;
        } else {
            if (pn < 8) { mode = 4; base = QKV + (size_t)pn * S * 256; }
            else if (pn < 16) { mode = 4; scale = 0.0625f; base = QKV + (size_t)8 * S * 256 + (size_t)(pn - 8) * S * 256; }
            else if (pn < 32) { mode = 5; base = QKV + (size_t)16 * S * 256 + (size_t)((pn - 16) >> 1) * S * 512 + ((pn - 16) & 1) * 256; }
            else { mode = 2; base = QKV + (size_t)16 * S * 256 + (size_t)8 * S * 512 + (pn - 32) * 256; ld = 4096; }
        }
#pragma unroll
        for (int ai = 0; ai < 2; ++ai)
#pragma unroll
            for (int m = 0; m < 4; ++m) {
                const int t = u.pm * BM + ai * HALF + wr * 64 + m * 16 + fr;
                float v[2][8];
#pragma unroll
                for (int bj = 0; bj < 2; ++bj)
#pragma unroll
                    for (int i = 0; i < 8; ++i) v[bj][i] = acc[ai][bj][m][i >> 2][i & 3];
                if (mode == 0) {
                    if (wc == 0) {
                        const f32x2* cs = r16 + (size_t)t * 16 + 8 * (fq & 1);
#pragma unroll
                        for (int bj = 0; bj < 2; ++bj)
#pragma unroll
                            for (int i = 0; i < 8; ++i) { const float o = __shfl_xor(v[bj][i], 32); const f32x2 c = cs[i];
                                v[bj][i] = (fq < 2) ? (v[bj][i] * c[0] - o * c[1]) : (o * c[1] + v[bj][i] * c[0]); }
                    }
#pragma unroll
                    for (int bj = 0; bj < 2; ++bj) {
#pragma unroll
                        for (int i = 0; i < 8; ++i) { v[bj][i] *= scale; ksum[bj][i] += v[bj][i]; }
                        st8(base + ((size_t)bj * S + t) * 128 + d0, v[bj]);
                    }
                } else if (mode == 1) {
#pragma unroll
                    for (int bj = 0; bj < 2; ++bj) st8(base + ((size_t)bj * S + t) * 128 + d0, v[bj]);
                } else if (mode == 2) {
#pragma unroll
                    for (int bj = 0; bj < 2; ++bj) {
#pragma unroll
                        for (int i = 0; i < 8; ++i) v[bj][i] = silu_f(v[bj][i]);
                        st8(base + (size_t)t * ld + 128 * bj + d0, v[bj]);
                    }
                } else if (mode == 3) {
                    if (d0 < 48) { float* gp = (float*)(ws + WS_GATES) + (size_t)t * 48 + d0;
#pragma unroll
                        for (int i = 0; i < 8; ++i) gp[i] = sigmoid_f(v[0][i]); }
                } else if (mode == 4) {
                    const f32x2* cs = r128 + (size_t)t * 128 + d0;
#pragma unroll
                    for (int i = 0; i < 8; ++i) { const f32x2 c = cs[i]; const float x1 = v[0][i], x2 = v[1][i];
                        v[0][i] = (x1 * c[0] - x2 * c[1]) * scale; v[1][i] = (x1 * c[1] + x2 * c[0]) * scale; }
                    st8(base + (size_t)t * 256 + d0, v[0]); st8(base + (size_t)t * 256 + 128 + d0, v[1]);
                } else {
#pragma unroll
                    for (int bj = 0; bj < 2; ++bj) st8(base + (size_t)t * 512 + 128 * bj + d0, v[bj]);
                }
            }
        if (KIND == 0 && want_ksum) {
#pragma unroll
            for (int bj = 0; bj < 2; ++bj)
#pragma unroll
                for (int i = 0; i < 8; ++i) { float x = ksum[bj][i]; x += __shfl_xor(x, 1); x += __shfl_xor(x, 2); x += __shfl_xor(x, 4); x += __shfl_xor(x, 8); ksum[bj][i] = x; }
            if (fr == 0) { float* km = (float*)(ws + WS_KMEAN) + (size_t)wr * 65536;
#pragma unroll
                for (int bj = 0; bj < 2; ++bj)
#pragma unroll
                    for (int i = 0; i < 8; ++i) km[((size_t)(2 * (pn & 7) + bj) * 32 + u.pm) * 128 + d0 + i] = ksum[bj][i] * (1.0f / 256.0f); }
        }
    }
};

template <class Epi, class Sched, bool ALIGN_EPI = false, bool SP2 = false>
__device__ __forceinline__ void gemm_phase(LAS unsigned char* lds, const Gemm g, const Sched& S, const Epi& E) {
    const int tid = threadIdx.x, wid = __builtin_amdgcn_readfirstlane(tid >> 6), lane = tid & 63, wr = wid >> 2, wc = wid & 3, fr = lane & 15, fq = lane >> 4;
    const int K = g.K, nt = K / BK;
    unsigned voffA[2], voffB[2];
#pragma unroll
    for (int i = 0; i < 2; ++i) { int R, C; stage_rc(tid * 16 + i * 8192, R, C); const int Rb = Epi::PERM ? ((R & ~31) + perm32(R & 31)) : R;
        voffA[i] = (unsigned)(R * g.lda + C) * 2u; voffB[i] = (unsigned)(Rb * g.ldb + C) * 2u; }
    const size_t kstep = (size_t)(BK * 2);
    const size_t hstepA = (size_t)HALF * g.lda * 2, hstepB = (size_t)HALF * g.ldb * 2;
    const size_t tstepA = 2 * hstepA, tstepB = 2 * hstepB;
    const unsigned ldsw = (unsigned)wid * 1024u;
    const int aoff = lds_byte(wr * 64 + fr, fq * 8), boff = lds_byte(wc * 32 + fr, fq * 8);
#define PG8_SA(b, h) (((b) * 2 + (h)) * HTB)
#define PG8_SB(b, h) ((4 + (b) * 2 + (h)) * HTB)
#define PG8_STAGE(bufoff, gbase, voff) do { _Pragma("unroll") for (int _i = 0; _i < 2; ++_i) \
        __builtin_amdgcn_global_load_lds((const unsigned*)((const char*)(gbase) + (voff)[_i]), (LAS unsigned*)(lds + (bufoff) + ldsw + _i * 8192), 16, 0, 0); } while (0)
#define PG8_LDA(dst, b, h) do { _Pragma("unroll") for (int m = 0; m < 4; ++m) _Pragma("unroll") for (int k = 0; k < 2; ++k) dst[m][k] = *(const LAS h16x8*)(lds + PG8_SA(b, h) + aoff + m * 2048 + k * 1024); } while (0)
#define PG8_LDB(dst, b, h) do { _Pragma("unroll") for (int n = 0; n < 2; ++n) _Pragma("unroll") for (int k = 0; k < 2; ++k) dst[n][k] = *(const LAS h16x8*)(lds + PG8_SB(b, h) + boff + n * 2048 + k * 1024); } while (0)
#define PG8_MMA(ai, bj, At, Bt) do { __builtin_amdgcn_s_setprio(1); _Pragma("unroll") for (int m = 0; m < 4; ++m) _Pragma("unroll") for (int n = 0; n < 2; ++n) _Pragma("unroll") for (int k = 0; k < 2; ++k) \
        acc[ai][bj][m][n] = __builtin_amdgcn_mfma_f32_16x16x32_f16(Bt[n][k], At[m][k], acc[ai][bj][m][n], 0, 0, 0); __builtin_amdgcn_s_setprio(0); } while (0)
#define PG8_WAIT_V(n) asm volatile("s_waitcnt vmcnt(" #n ")" ::: "memory")
#define PG8_WAIT_L(n) asm volatile("s_waitcnt lgkmcnt(" #n ")" ::: "memory")
#define PG8_BAR __builtin_amdgcn_s_barrier()
#define PG8_SCHED __builtin_amdgcn_sched_barrier(0)
    Unit cur, nxt; int ui = 0;
    if (!S.next(0, cur)) return;
    f32x4 acc[2][2][4][2];
#pragma unroll
    for (int a = 0; a < 2; ++a)
#pragma unroll
        for (int b = 0; b < 2; ++b)
#pragma unroll
            for (int m = 0; m < 4; ++m)
#pragma unroll
                for (int n = 0; n < 2; ++n) acc[a][b][m][n] = (f32x4){0.f, 0.f, 0.f, 0.f};
    h16x8 At[4][2], B0[2][2], B1[2][2];
    const char* cA = (const char*)g.A + (size_t)cur.pm * tstepA; const char* cB = (const char*)g.Bt + (size_t)cur.pn * tstepB;
    S.a_ready(cur);
    if constexpr (SP2) {
        PG8_STAGE(PG8_SB(0, 0), cB, voffB); PG8_STAGE(PG8_SB(0, 1), cB + hstepB, voffB); PG8_STAGE(PG8_SA(0, 0), cA, voffA); PG8_STAGE(PG8_SA(0, 1), cA + hstepA, voffA);
        if (wr == 1) PG8_BAR;
        PG8_WAIT_V(2); PG8_BAR;
        PG8_STAGE(PG8_SB(1, 0), cB + kstep, voffB); PG8_STAGE(PG8_SA(1, 0), cA + kstep, voffA); PG8_STAGE(PG8_SB(1, 1), cB + hstepB + kstep, voffB);
        PG8_WAIT_V(6); PG8_BAR;
    } else {
        PG8_STAGE(PG8_SB(0, 0), cB, voffB); PG8_STAGE(PG8_SA(0, 0), cA, voffA); PG8_STAGE(PG8_SB(0, 1), cB + hstepB, voffB); PG8_STAGE(PG8_SA(0, 1), cA + hstepA, voffA);
        if (wr == 1) PG8_BAR;
        PG8_WAIT_V(4); PG8_BAR;
        PG8_STAGE(PG8_SB(1, 0), cB + kstep, voffB); PG8_STAGE(PG8_SA(1, 0), cA + kstep, voffA); PG8_STAGE(PG8_SB(1, 1), cB + hstepB + kstep, voffB);
        PG8_WAIT_V(6); PG8_BAR;
    }
    for (;;) {
        const bool has_next = S.next(ui + 1, nxt);
        const char* nA = has_next ? (const char*)g.A + (size_t)nxt.pm * tstepA : cA; const char* nB = has_next ? (const char*)g.Bt + (size_t)nxt.pn * tstepB : cB;
        for (int t = 0; t < nt; t += 2) {
            const bool last = (t == nt - 2);
            const char* a1 = cA + (size_t)(t + 1) * kstep;
            const char* a2 = last ? nA : cA + (size_t)(t + 2) * kstep; const char* b2 = last ? nB : cB + (size_t)(t + 2) * kstep;
            const char* a3 = a2 + kstep; const char* b3 = b2 + kstep;
            if (last && has_next) S.a_ready(nxt);
            if constexpr (SP2) {
            PG8_LDB(B0, 0, 0); PG8_LDB(B1, 0, 1); PG8_SCHED; PG8_LDA(At, 0, 0); PG8_STAGE(PG8_SA(1, 1), a1 + hstepA, voffA);
            PG8_WAIT_V(8); PG8_WAIT_L(0); PG8_BAR; PG8_MMA(0, 0, At, B0); PG8_MMA(0, 1, At, B1); PG8_BAR; PG8_SCHED;
            PG8_LDA(At, 0, 1); PG8_STAGE(PG8_SB(0, 0), b2, voffB); PG8_STAGE(PG8_SB(0, 1), b2 + hstepB, voffB); PG8_STAGE(PG8_SA(0, 0), a2, voffA);
            PG8_WAIT_V(8); PG8_WAIT_L(0); PG8_BAR; PG8_MMA(1, 0, At, B0); PG8_MMA(1, 1, At, B1); PG8_BAR; PG8_SCHED;
            PG8_LDB(B0, 1, 0); PG8_LDB(B1, 1, 1); PG8_SCHED; PG8_LDA(At, 1, 0); PG8_STAGE(PG8_SA(0, 1), a2 + hstepA, voffA);
            PG8_WAIT_V(8); PG8_WAIT_L(0); PG8_BAR; PG8_MMA(0, 0, At, B0); PG8_MMA(0, 1, At, B1); PG8_BAR; PG8_SCHED;
            PG8_LDA(At, 1, 1); PG8_STAGE(PG8_SB(1, 0), b3, voffB); PG8_STAGE(PG8_SB(1, 1), b3 + hstepB, voffB); PG8_STAGE(PG8_SA(1, 0), a3, voffA);
            PG8_WAIT_V(8); PG8_WAIT_L(0); PG8_BAR; PG8_MMA(1, 0, At, B0); PG8_MMA(1, 1, At, B1); PG8_BAR; PG8_SCHED;
            } else {
            PG8_LDB(B0, 0, 0); PG8_SCHED; PG8_LDA(At, 0, 0); PG8_STAGE(PG8_SA(1, 1), a1 + hstepA, voffA);
            PG8_WAIT_L(8); PG8_BAR; PG8_WAIT_L(0); PG8_MMA(0, 0, At, B0); PG8_BAR; PG8_SCHED;
            PG8_LDB(B1, 0, 1); PG8_STAGE(PG8_SB(0, 0), b2, voffB);
            PG8_BAR; PG8_WAIT_L(0); PG8_MMA(0, 1, At, B1); PG8_BAR;
            PG8_LDA(At, 0, 1); PG8_STAGE(PG8_SA(0, 0), a2, voffA);
            PG8_BAR; PG8_WAIT_L(0); PG8_MMA(1, 0, At, B0); PG8_BAR; PG8_SCHED;
            PG8_STAGE(PG8_SB(0, 1), b2 + hstepB, voffB);
            PG8_WAIT_V(6); PG8_BAR; PG8_MMA(1, 1, At, B1); PG8_BAR;
            PG8_LDB(B0, 1, 0); PG8_SCHED; PG8_LDA(At, 1, 0); PG8_STAGE(PG8_SA(0, 1), a2 + hstepA, voffA);
            PG8_WAIT_L(8); PG8_BAR; PG8_WAIT_L(0); PG8_MMA(0, 0, At, B0); PG8_BAR; PG8_SCHED;
            PG8_LDB(B1, 1, 1); PG8_STAGE(PG8_SB(1, 0), b3, voffB);
            PG8_BAR; PG8_WAIT_L(0); PG8_MMA(0, 1, At, B1); PG8_BAR;
            PG8_LDA(At, 1, 1); PG8_STAGE(PG8_SA(1, 0), a3, voffA);
            PG8_BAR; PG8_WAIT_L(0); PG8_MMA(1, 0, At, B0); PG8_BAR; PG8_SCHED;
            PG8_STAGE(PG8_SB(1, 1), b3 + hstepB, voffB);
            PG8_WAIT_V(6); PG8_BAR; PG8_MMA(1, 1, At, B1); PG8_BAR;
            }
        }
        if constexpr (ALIGN_EPI) { if (wr == 0) PG8_BAR; }
        if constexpr (!Epi::AFTER_DRAIN) { E(acc, cur, wr, wc, fr, fq); S.done(cur); }
        if (!has_next) break;
#pragma unroll
        for (int a = 0; a < 2; ++a)
#pragma unroll
            for (int b = 0; b < 2; ++b)
#pragma unroll
                for (int m = 0; m < 4; ++m)
#pragma unroll
                    for (int n = 0; n < 2; ++n) acc[a][b][m][n] = (f32x4){0.f, 0.f, 0.f, 0.f};
        cur = nxt; cA = nA; cB = nB; ++ui;
        if constexpr (ALIGN_EPI) { if (wr == 1) PG8_BAR; }
    }
    PG8_WAIT_V(0);
    if constexpr (!ALIGN_EPI) { if (wr == 0) PG8_BAR; }
    PG8_BAR;
#undef PG8_SA
#undef PG8_SB
#undef PG8_STAGE
#undef PG8_LDA
#undef PG8_LDB
#undef PG8_MMA
#undef PG8_WAIT_V
#undef PG8_WAIT_L
#undef PG8_BAR
#undef PG8_SCHED
}
}

struct Frame {
    float* out;
    unsigned char* ws;
    char* lds;
    int tid, lane, wave, G, bid;
};

__device__ __forceinline__ float wave_sum(float v) {
#pragma unroll
    for (int o = 32; o >= 1; o >>= 1) v += __shfl_xor(v, o);
    return v;
}
__device__ __forceinline__ float wave_max(float v) {
#pragma unroll
    for (int o = 32; o >= 1; o >>= 1) v = fmaxf(v, __shfl_xor(v, o));
    return v;
}
__device__ __forceinline__ void wave_lds_fence() { __builtin_amdgcn_wave_barrier(); asm volatile("s_waitcnt lgkmcnt(0)" ::: "memory"); __builtin_amdgcn_wave_barrier(); }

__device__ __forceinline__ void sincos_d(double x, float& c, float& s) {
    const double TWO_OVER_PI = 0.63661977236758134308;
    const double PIO2_HI = 1.57079632679489655800e+00, PIO2_LO = 6.12323399573676603587e-17;
    const double q = __builtin_rint(x * TWO_OVER_PI);
    double y = __builtin_fma(-q, PIO2_HI, x); y = __builtin_fma(-q, PIO2_LO, y);
    const double y2 = y * y;
    double sp = 1.0 / 6227020800.0;
    sp = sp * y2 - 1.0 / 39916800.0; sp = sp * y2 + 1.0 / 362880.0; sp = sp * y2 - 1.0 / 5040.0; sp = sp * y2 + 1.0 / 120.0; sp = sp * y2 - 1.0 / 6.0; sp = sp * y2 * y + y;
    double cp = -1.0 / 87178291200.0;
    cp = cp * y2 + 1.0 / 479001600.0; cp = cp * y2 - 1.0 / 3628800.0; cp = cp * y2 + 1.0 / 40320.0; cp = cp * y2 - 1.0 / 720.0; cp = cp * y2 + 1.0 / 24.0; cp = cp * y2 - 0.5; cp = cp * y2 + 1.0;
    const long long qi = (long long)q; const int quad = (int)(qi & 3);
    double sv, cv;
    if (quad == 0) { sv = sp; cv = cp; } else if (quad == 1) { sv = cp; cv = -sp; } else if (quad == 2) { sv = -sp; cv = -cp; } else { sv = -cp; cv = sp; }
    c = (float)cv; s = (float)sv;
}

__device__ __forceinline__ int nsa_src_col(int n) { return n < 5120 ? n : (n < 7168 ? n + 48 : (n < 7216 ? n - 2048 : -1)); }
__device__ __forceinline__ void conv_transpose(const Frame& F, const float* W, int K, int Nsrc, h16* Wt, int Npad, int mapmode, int item0, int& items_done) {
    float* tile = (float*)F.lds;
    const int tk_n = K / 64, tn_n = Npad / 128, ntiles = tk_n * tn_n;
    f32x4 v[4];
#define CV_LOAD(it_) do { const int tk_ = (it_) / tn_n, tn_ = (it_) % tn_n; _Pragma("unroll") for (int i = 0; i < 4; ++i) { \
        const int idx = F.tid + i * NTHREADS, k = idx >> 5, n4 = (idx & 31) * 4; const int nn = tn_ * 128 + n4; const int src = mapmode ? nsa_src_col(nn) : nn; \
        v[i] = (f32x4){0.f, 0.f, 0.f, 0.f}; if (src >= 0 && src + 3 < Nsrc) v[i] = *(const f32x4*)(W + (size_t)(tk_ * 64 + k) * Nsrc + src); } } while (0)
    if (F.bid < ntiles) CV_LOAD(F.bid);
    for (int it = F.bid; it < ntiles; it += F.G) {
        const int tk = it / tn_n, tn = it % tn_n;
        __syncthreads();
#pragma unroll
        for (int i = 0; i < 4; ++i) {
            const int idx = F.tid + i * NTHREADS, k = idx >> 5, n4 = (idx & 31) * 4;
            tile[k * 129 + n4] = v[i][0]; tile[k * 129 + n4 + 1] = v[i][1]; tile[k * 129 + n4 + 2] = v[i][2]; tile[k * 129 + n4 + 3] = v[i][3];
        }
        if (it + F.G < ntiles) CV_LOAD(it + F.G);
        __syncthreads();
#pragma unroll
        for (int i = 0; i < 4; ++i) {
            const int idx = F.tid + i * NTHREADS, n = idx >> 4, k4 = (idx & 15) * 4;
            h16x4 o; o[0] = (h16)tile[k4 * 129 + n]; o[1] = (h16)tile[(k4 + 1) * 129 + n]; o[2] = (h16)tile[(k4 + 2) * 129 + n]; o[3] = (h16)tile[(k4 + 3) * 129 + n];
            *(h16x4*)(Wt + (size_t)(tn * 128 + n) * K + tk * 64 + k4) = o;
        }
    }
#undef CV_LOAD
    __syncthreads();
}
__device__ __forceinline__ void conv_layer_weights(const Frame& F, const Args& A, int L) {
    const int kind = L % 3, j = L / 3; int dummy = 0;
    h16* wtin = (h16*)(F.ws + WS_WTIN); h16* wtout = (h16*)(F.ws + WS_WTOUT);
    if (kind == 0) {
        conv_transpose(F, A.in[7] + (size_t)j * 2048 * 8192, 2048, 8192, wtin, 8192, 0, 0, dummy);
        conv_transpose(F, A.in[8] + (size_t)j * 2048 * 2048, 2048, 2048, wtout, 2048, 0, 0, dummy);
    } else if (kind == 1) {
        conv_transpose(F, A.in[9], 2048, 7216, wtin, NSA_NP, 1, 0, dummy);
        conv_transpose(F, A.in[10], 2048, 2048, wtout, 2048, 0, 0, dummy);
        conv_transpose(F, A.in[12], 4096, 256, (h16*)(F.ws + WS_W1T), 256, 0, 0, dummy);
        conv_transpose(F, A.in[14], 4096, 256, (h16*)(F.ws + WS_W1T) + (size_t)256 * 4096, 256, 0, 0, dummy);
    } else {
        conv_transpose(F, A.in[16], 2048, 12288, wtin, 12288, 0, 0, dummy);
        conv_transpose(F, A.in[17], 4096, 2048, wtout, 2048, 0, 0, dummy);
    }
}

__device__ __forceinline__ void phase_prologue(const Frame& F, const Args& A) {
    {
        float* modp = (float*)(F.ws + WS_MODP);
        const float* c = A.in[1]; const float* aw = A.in[3];
        float* sc = (float*)F.lds;
        __syncthreads();
        for (int i = F.tid; i < 2048; i += NTHREADS) sc[i] = silu_f(c[i]);
        __syncthreads();
        for (int it = F.bid; it < 192; it += F.G) {
            const int layer = it / 48, r = it % 48, slice = r / 3, nch = r % 3, n = nch * 2048 + F.tid * 4;
            const float* w = aw + (size_t)layer * 2048 * 6144 + (size_t)(slice * 128) * 6144 + n;
            f32x4 a0 = (f32x4){0.f, 0.f, 0.f, 0.f}, a1 = a0;
#pragma unroll 8
            for (int k = 0; k < 128; k += 2) {
                a0 += *(const f32x4*)(w + (size_t)k * 6144) * sc[slice * 128 + k];
                a1 += *(const f32x4*)(w + (size_t)(k + 1) * 6144) * sc[slice * 128 + k + 1];
            }
            *(f32x4*)(modp + (size_t)(slice * 4 + layer) * 6144 + n) = a0 + a1;
        }
        __syncthreads();
    }
    {
        const int* pos = (const int*)A.in[2];
        f32x2* r16 = (f32x2*)(F.ws + WS_ROPE16); f32x2* r128 = (f32x2*)(F.ws + WS_ROPE128);
        for (int idx = F.bid * NTHREADS + F.tid; idx < S * 16; idx += F.G * NTHREADS) {
            const int t = idx >> 4, j = idx & 15; float cs, sn; sincos_d((double)pos[t] * A.inv16[j], cs, sn); r16[idx] = (f32x2){cs, sn};
        }
        for (int idx = F.bid * NTHREADS + F.tid; idx < S * 128; idx += F.G * NTHREADS) {
            const int t = idx >> 7, j = idx & 127; float cs, sn; sincos_d((double)pos[t] * A.inv128[j], cs, sn); r128[idx] = (f32x2){cs, sn};
        }
    }
    if (F.bid >= F.G - 16) {
        const int slice = F.bid - (F.G - 16), kv = F.tid >> 8, j = F.tid & 255; const float* w1 = (kv ? A.in[14] : A.in[12]) + (size_t)slice * 256 * 256; const float* pe = A.in[11] + slice * 256;
        float a0 = 0.f, a1 = 0.f;
#pragma unroll 8
        for (int i = 0; i < 256; i += 2) { a0 += pe[i] * w1[(size_t)i * 256 + j]; a1 += pe[i + 1] * w1[(size_t)(i + 1) * 256 + j]; }
        ((float*)(F.ws + WS_CMPB))[slice * 512 + F.tid] = a0 + a1;
    }
    conv_layer_weights(F, A, 0);
}

__device__ __forceinline__ void phase_norm(const Frame& F, const Args& A, int Lprev, int Lnext) {
    float* modl = (float*)F.lds;
    const float* modp = (const float*)(F.ws + WS_MODP); const float* ab = A.in[4];
    __syncthreads();
    float* modf = (float*)(F.ws + WS_MODF);
    for (int i = F.tid; i < 6144; i += NTHREADS) {
        const int which = i >> 11, col = i & 2047;
        int layer, mcol;
        if (which == 0) { layer = Lprev; mcol = 4096 + col; } else if (which == 1) { layer = Lnext; mcol = 2048 + col; } else { layer = Lnext; mcol = col; }
        float v = 0.f;
        if (layer >= 0) {
            if (Lprev >= 0) v = modf[layer * 6144 + mcol];
            else { v = ab[layer * 6144 + mcol];
#pragma unroll
                for (int s = 0; s < 16; ++s) v += modp[(size_t)(s * 4 + layer) * 6144 + mcol]; }
        }
        modl[i] = v;
    }
    if (Lprev < 0) {
        for (int e = F.bid * NTHREADS + F.tid; e < 4 * 6144; e += F.G * NTHREADS) {
            float v = ab[e];
#pragma unroll
            for (int s = 0; s < 16; ++s) v += modp[(size_t)s * 4 * 6144 + e];
            modf[e] = v;
        }
    }
    __syncthreads();
    const float* xin = (Lprev <= 0) ? A.in[0] : F.out;
    const h16* Y = (const h16*)(F.ws + WS_Y);
    h16* H = (h16*)(F.ws + WS_H);
    const float* npost = A.in[6] + (Lprev >= 0 ? Lprev : 0) * 2048;
    const float* npre = A.in[5] + (Lnext >= 0 ? Lnext : 0) * 2048;
    for (int t = F.bid * 8 + F.wave; t < S; t += F.G * 8) {
        f32x4 x[8];
#pragma unroll
        for (int i = 0; i < 8; ++i) x[i] = *(const f32x4*)(xin + (size_t)t * D + i * 256 + F.lane * 4);
        if (Lprev >= 0) {
            f32x4 y[8]; float ss = 0.f;
#pragma unroll
            for (int i = 0; i < 8; ++i) { const h16x4 yh = *(const h16x4*)(Y + (size_t)t * D + i * 256 + F.lane * 4); y[i] = (f32x4){(float)yh[0], (float)yh[1], (float)yh[2], (float)yh[3]}; ss += y[i][0] * y[i][0] + y[i][1] * y[i][1] + y[i][2] * y[i][2] + y[i][3] * y[i][3]; }
            ss = wave_sum(ss);
            const float r = 1.0f / sqrtf(ss * (1.0f / D) + EPS);
#pragma unroll
            for (int i = 0; i < 8; ++i) {
                const int col = i * 256 + F.lane * 4;
                const f32x4 g = *(const f32x4*)(npost + col); const f32x4 gt = *(const f32x4*)(modl + col);
#pragma unroll
                for (int e = 0; e < 4; ++e) x[i][e] += gt[e] * (y[i][e] * r * g[e]);
                *(f32x4*)(F.out + (size_t)t * D + col) = x[i];
            }
        }
        if (Lnext >= 0) {
            float ss = 0.f;
#pragma unroll
            for (int i = 0; i < 8; ++i) ss += x[i][0] * x[i][0] + x[i][1] * x[i][1] + x[i][2] * x[i][2] + x[i][3] * x[i][3];
            ss = wave_sum(ss);
            const float r = 1.0f / sqrtf(ss * (1.0f / D) + EPS);
#pragma unroll
            for (int i = 0; i < 8; ++i) {
                const int col = i * 256 + F.lane * 4;
                const f32x4 g = *(const f32x4*)(npre + col); const f32x4 sc = *(const f32x4*)(modl + 2048 + col); const f32x4 sh = *(const f32x4*)(modl + 4096 + col);
                h16x4 hv;
#pragma unroll
                for (int e = 0; e < 4; ++e) hv[e] = (h16)((x[i][e] * r * g[e]) * (1.0f + sc[e]) + sh[e]);
                *(h16x4*)(H + (size_t)t * D + col) = hv;
            }
        }
    }
    if (Lnext > 0) conv_layer_weights(F, A, Lnext);
}

__device__ __forceinline__ void phase_nsa_cmp_a(const Frame& F) {
    const int u = F.bid, have = u < 64, kv = (u >> 5) & 1, mt = (u >> 2) & 7, kp = u & 3;
    const h16* A = (const h16*)(F.ws + WS_QKV) + (size_t)16 * S * 128 + (size_t)kv * 4 * S * 128 + kp * 1024;
    const h16* Bt = (const h16*)(F.ws + WS_W1T) + (size_t)kv * 256 * 4096 + kp * 1024;
    pg8::Gemm g{A, Bt, 2048, 256, 1024, 2048, 4096}; pg8::OneUnit So{mt, 0, have};
    pg8::EpiStore E{(float*)(F.ws + WS_OR) + (size_t)(kv * 4 + kp) * 2048 * 256, 256, 1};
    pg8::gemm_phase<pg8::EpiStore, pg8::OneUnit, true, true>((LAS unsigned char*)F.lds, g, So, E);
}
__device__ __forceinline__ void phase_nsa_cmp_b(const Frame& F, const Args& A) {
    float* hid = (float*)F.lds;
    const float* part = (const float*)(F.ws + WS_OR); const float* b1 = (const float*)(F.ws + WS_CMPB);
    for (int it = F.bid; it < 256; it += F.G) {
        const int kv = it >> 7, r0 = (it & 127) * 16;
        const float* W2 = kv ? A.in[15] : A.in[13];
        h16* dst = (h16*)(F.ws + (kv ? WS_VCMP : WS_KCMP));
        __syncthreads();
        for (int i = F.tid; i < 16 * 256; i += NTHREADS) {
            const int r = r0 + (i >> 8), j = i & 255; float v = 0.f;
#pragma unroll
            for (int sl = 0; sl < 16; ++sl) v += b1[sl * 512 + kv * 256 + j];
#pragma unroll
            for (int kp = 0; kp < 4; ++kp) v += part[((size_t)(kv * 4 + kp) * 2048 + r) * 256 + j];
            hid[i] = silu_f(v);
        }
        __syncthreads();
        const int d = F.tid & 127, rq = F.tid >> 7;
        float a[4] = {0.f, 0.f, 0.f, 0.f};
#pragma unroll 4
        for (int j = 0; j < 256; ++j) { const float w = W2[j * 128 + d];
#pragma unroll
            for (int e = 0; e < 4; ++e) a[e] += hid[(rq * 4 + e) * 256 + j] * w; }
#pragma unroll
        for (int e = 0; e < 4; ++e) { const int r = r0 + rq * 4 + e; dst[(size_t)r * 128 + d] = ((r & 511) < NC) ? (h16)a[e] : (h16)0.f; }
    }
}

namespace fa {
typedef float f32x16 __attribute__((ext_vector_type(16)));
typedef unsigned u32x2 __attribute__((ext_vector_type(2)));
constexpr float LOG2E = 1.4426950408889634f;
constexpr float MASKV = -3.0e38f;
constexpr int KROW = 256, VROW = 256;
constexpr int KT_BYTES = 64 * KROW, BUF_BYTES = KT_BYTES + 64 * VROW;
typedef short s16x4v __attribute__((__vector_size__(4 * sizeof(short))));
constexpr int LDS_IMP = 2 * BUF_BYTES;
constexpr int LDS_SELW = LDS_IMP + 32768;
constexpr int LDS_SV = LDS_SELW + 1024;
static_assert(LDS_SV + 4096 <= MISC_OFF, "attention LDS map");

__device__ __forceinline__ void stage_dma(LAS unsigned char* buf, const h16* Kg, const h16* Vg, int j, int wave, int lane) {
    asm volatile("" : "+v"(lane));
#pragma unroll
    for (int i = 0; i < 2; ++i) {
        const int o = wave * 2048 + i * 1024, row = (o >> 8) + (lane >> 4), p = lane & 15;
        const h16* ks = Kg + (size_t)(j * 64 + row) * 128 + (p ^ (row & 15)) * 8;
        const h16* vs = Vg + (size_t)(j * 64 + row) * 128 + (p ^ ((row & 3) << 2)) * 8;
        __builtin_amdgcn_global_load_lds((const unsigned*)ks, (LAS unsigned*)(buf + o), 16, 0, 0);
        __builtin_amdgcn_global_load_lds((const unsigned*)vs, (LAS unsigned*)(buf + KT_BYTES + o), 16, 0, 0);
    }
}

template <int MODE>
__device__ __forceinline__ void tile_compute(const LAS unsigned char* buf, int j, const h16x8 (&qf)[8], f32x16 (&o)[4], float& m, float& l,
                                             bool on, int lo, int hi, int lane, float inv_l, LAS float* imp_q) {
    const int r31 = lane & 31, h = lane >> 5, k0 = j * 64;
    const bool need = on && (k0 <= hi) && (k0 + 63 >= lo);
    if (__ballot(need) == 0ull) return;
    f32x16 s0, s1;
#pragma unroll
    for (int r = 0; r < 16; ++r) { s0[r] = 0.f; s1[r] = 0.f; }
    const LAS unsigned char* kp = buf + r31 * KROW;
    const int ksw = r31 & 15;
    {
        h16x8 ka[2][4];
#pragma unroll
        for (int e = 0; e < 2; ++e) { const int po = (((2 * e + h) ^ ksw) << 4); ka[0][2 * e] = *(const LAS h16x8*)(kp + po); ka[0][2 * e + 1] = *(const LAS h16x8*)(kp + 32 * KROW + po); }
#pragma unroll
        for (int g = 0; g < 4; ++g) {
            if (g < 3) {
#pragma unroll
                for (int e = 0; e < 2; ++e) { const int po = (((2 * (2 * (g + 1) + e) + h) ^ ksw) << 4); ka[(g + 1) & 1][2 * e] = *(const LAS h16x8*)(kp + po); ka[(g + 1) & 1][2 * e + 1] = *(const LAS h16x8*)(kp + 32 * KROW + po); }
            }
#pragma unroll
            for (int e = 0; e < 2; ++e) {
                s0 = __builtin_amdgcn_mfma_f32_32x32x16_f16(ka[g & 1][2 * e], qf[2 * g + e], s0, 0, 0, 0);
                s1 = __builtin_amdgcn_mfma_f32_32x32x16_f16(ka[g & 1][2 * e + 1], qf[2 * g + e], s1, 0, 0, 0);
            }
            __builtin_amdgcn_sched_barrier(0);
        }
    }
    const bool full = (k0 >= lo) && (k0 + 63 <= hi);
    const bool simple = (__ballot(on && !full) == 0ull);
    if (!simple) {
#pragma unroll
        for (int r = 0; r < 16; ++r) {
            const int key0 = k0 + (r & 3) + 8 * (r >> 2) + 4 * h, key1 = key0 + 32;
            const bool v0 = on && key0 >= lo && key0 <= hi, v1 = on && key1 >= lo && key1 <= hi;
            s0[r] = v0 ? s0[r] : MASKV; s1[r] = v1 ? s1[r] : MASKV;
        }
    }
    float tm;
    {
        float t8[8];
#pragma unroll
        for (int r = 0; r < 8; ++r) t8[r] = fmaxf(fmaxf(s0[2 * r], s0[2 * r + 1]), fmaxf(s1[2 * r], s1[2 * r + 1]));
        tm = fmaxf(fmaxf(fmaxf(t8[0], t8[1]), fmaxf(t8[2], t8[3])), fmaxf(fmaxf(t8[4], t8[5]), fmaxf(t8[6], t8[7])));
    }
    const float tmax = ((simple && !on) || !(tm > 0.5f * NEGF)) ? NEGF : tm;
    if (MODE != 2) {
        const float tmx = fmaxf(tmax, __shfl_xor(tmax, 32));
        const float m_new = fmaxf(m, tmx);
        const float alpha = __builtin_amdgcn_exp2f(m - m_new);
        const float off = (simple && !on) ? BIGF : m_new;
        float sum0 = 0.f, sum1 = 0.f;
#pragma unroll
        for (int r = 0; r < 16; ++r) {
            s0[r] = __builtin_amdgcn_exp2f(s0[r] - off);
            s1[r] = __builtin_amdgcn_exp2f(s1[r] - off);
            sum0 += s0[r]; sum1 += s1[r];
        }
        l = l * alpha + (sum0 + sum1);
        const bool grew = m_new > m; m = m_new;
        if (MODE == 1) return;
        if (__ballot(grew) != 0ull) {
#pragma unroll
            for (int dt = 0; dt < 4; ++dt) o[dt] = o[dt] * alpha;
        }
    } else {
        const float off = (simple && !on) ? BIGF : m;
#pragma unroll
        for (int r = 0; r < 16; ++r) {
            s0[r] = __builtin_amdgcn_exp2f(s0[r] - off) * inv_l;
            s1[r] = __builtin_amdgcn_exp2f(s1[r] - off) * inv_l;
        }
#pragma unroll
        for (int c = 0; c < 4; ++c) {
            const int sa = 16 * j + 2 * c + h, sb = sa + 8;
            const float a0 = s0[4 * c] + s0[4 * c + 1] + s0[4 * c + 2] + 0.5f * s0[4 * c + 3], b0 = 0.5f * s0[4 * c + 3];
            const float a1 = s1[4 * c] + s1[4 * c + 1] + s1[4 * c + 2] + 0.5f * s1[4 * c + 3], b1 = 0.5f * s1[4 * c + 3];
            (void)__hip_atomic_fetch_add(imp_q + sa, a0, __ATOMIC_RELAXED, __HIP_MEMORY_SCOPE_WORKGROUP); if (sa + 1 < 128) (void)__hip_atomic_fetch_add(imp_q + sa + 1, b0, __ATOMIC_RELAXED, __HIP_MEMORY_SCOPE_WORKGROUP);
            (void)__hip_atomic_fetch_add(imp_q + sb, a1, __ATOMIC_RELAXED, __HIP_MEMORY_SCOPE_WORKGROUP); if (sb + 1 < 128) (void)__hip_atomic_fetch_add(imp_q + sb + 1, b1, __ATOMIC_RELAXED, __HIP_MEMORY_SCOPE_WORKGROUP);
        }
    }
    h16x8 pb[2][2];
#pragma unroll
    for (int sp = 0; sp < 2; ++sp)
#pragma unroll
        for (int jj = 0; jj < 8; ++jj) { pb[0][sp][jj] = (h16)s0[8 * sp + jj]; pb[1][sp][jj] = (h16)s1[8 * sp + jj]; }
    const int vq = (lane & 15) >> 2;
    const LAS unsigned char* vrow = buf + KT_BYTES + (4 * h + vq) * VROW + ((2 * ((lane >> 4) & 1) + ((lane & 3) >> 1)) << 4) + 8 * (lane & 1);
    {
        s16x4v vr[2][8];
#pragma unroll
        for (int f = 0; f < 4; ++f) { const LAS unsigned char* vp = vrow + 16 * f * VROW + ((0 ^ vq) << 6);
            vr[0][2 * f] = __builtin_amdgcn_ds_read_tr16_b64_v4i16((LAS s16x4v*)vp); vr[0][2 * f + 1] = __builtin_amdgcn_ds_read_tr16_b64_v4i16((LAS s16x4v*)(vp + 8 * VROW)); }
#pragma unroll
        for (int dt = 0; dt < 4; ++dt) {
            if (dt < 3) {
#pragma unroll
                for (int f = 0; f < 4; ++f) { const LAS unsigned char* vp = vrow + 16 * f * VROW + (((dt + 1) ^ vq) << 6);
                    vr[(dt + 1) & 1][2 * f] = __builtin_amdgcn_ds_read_tr16_b64_v4i16((LAS s16x4v*)vp); vr[(dt + 1) & 1][2 * f + 1] = __builtin_amdgcn_ds_read_tr16_b64_v4i16((LAS s16x4v*)(vp + 8 * VROW)); }
            }
#pragma unroll
            for (int f = 0; f < 4; ++f) {
                const h16x4 l4 = __builtin_bit_cast(h16x4, vr[dt & 1][2 * f]), h4 = __builtin_bit_cast(h16x4, vr[dt & 1][2 * f + 1]);
                h16x8 va; va[0] = l4[0]; va[1] = l4[1]; va[2] = l4[2]; va[3] = l4[3]; va[4] = h4[0]; va[5] = h4[1]; va[6] = h4[2]; va[7] = h4[3];
                o[dt] = __builtin_amdgcn_mfma_f32_32x32x16_f16(va, pb[f >> 1][f & 1], o[dt], 0, 0, 0);
            }
            __builtin_amdgcn_sched_barrier(0);
        }
    }
}

template <int MODE, class OnFn>
__device__ __forceinline__ void stream(LAS unsigned char* lds, const h16* Kg, const h16* VTg, int jlo, int jhi, const h16x8 (&qf)[8],
                                       f32x16 (&o)[4], float& m, float& l, int lo, int hi, const OnFn& on_fn, int tid, int lane, float inv_l, LAS float* imp_q) {
    if (jlo >= jhi) return;
    const int wave = __builtin_amdgcn_readfirstlane(tid >> 6);
    stage_dma(lds, Kg, VTg, jlo, wave, lane);
    __syncthreads();
    for (int j = jlo; j < jhi; ++j) {
        const int cur = (j - jlo) & 1;
        if (j + 1 < jhi) stage_dma(lds + (cur ^ 1) * BUF_BYTES, Kg, VTg, j + 1, wave, lane);
        tile_compute<MODE>(lds + cur * BUF_BYTES, j, qf, o, m, l, on_fn(j), lo, hi, lane, inv_l, imp_q);
        __syncthreads();
    }
}

__device__ __forceinline__ void load_q(h16x8 (&qf)[8], const h16* qrow, int h) {
#pragma unroll
    for (int s = 0; s < 8; ++s) qf[s] = *(const h16x8*)(qrow + 16 * s + 8 * h);
}
__device__ __forceinline__ void zero_o(f32x16 (&o)[4]) {
#pragma unroll
    for (int dt = 0; dt < 4; ++dt)
#pragma unroll
        for (int r = 0; r < 16; ++r) o[dt][r] = 0.f;
}
}

struct MobaOn { unsigned selmask; int b; __device__ __forceinline__ bool operator()(int j) const { const int jb = j >> 2; return jb == b ? true : (((selmask >> jb) & 1u) != 0u); } };
__device__ __forceinline__ void phase_moba_attn_mfma(const Frame& F) {
    const h16* Q = (const h16*)(F.ws + WS_QKV); const h16* K = Q + (size_t)16 * S * 128; const h16* VT = K + (size_t)16 * S * 128; const h16* Z = VT + (size_t)16 * S * 128;
    const float* kmean = (const float*)(F.ws + WS_KMEAN);
    h16* OZ = (h16*)(F.ws + WS_OZ);
    LAS unsigned char* lds = (LAS unsigned char*)F.lds;
    const int lane = F.lane, r31 = lane & 31, h = lane >> 5;
    for (int it = F.bid; it < 256; it += F.G) {
        const int head = it >> 4, pi = it & 15;
#pragma unroll 1
        for (int half = 0; half < 2; ++half) {
            const int b = half ? 31 - pi : pi;
            const int t = b * 256 + F.wave * 32 + r31;
            h16x8 qf[8]; fa::load_q(qf, Q + ((size_t)head * S + t) * 128, h);
            LAS float* kml = (LAS float*)(lds + 2 * fa::BUF_BYTES);
            __syncthreads();
            for (int i = F.tid; i < b * 32; i += NTHREADS) { const float* km = kmean + (size_t)head * 32 * 128 + i * 4; *(LAS f32x4*)(kml + i * 4) = *(const f32x4*)km + *(const f32x4*)(km + 65536); }
            __syncthreads();
            float v0 = NEGF, v1 = NEGF, v2 = NEGF; int i0 = -1, i1 = -1, i2 = -1;
            for (int jb = 0; jb < b; ++jb) {
                const LAS float* km = kml + jb * 128 + 8 * h;
                float d = 0.f;
#pragma unroll
                for (int s = 0; s < 8; ++s) { const f32x4 ka = *(const LAS f32x4*)(km + 16 * s), kb = *(const LAS f32x4*)(km + 16 * s + 4);
                    d += (float)qf[s][0] * ka[0] + (float)qf[s][1] * ka[1] + (float)qf[s][2] * ka[2] + (float)qf[s][3] * ka[3] + (float)qf[s][4] * kb[0] + (float)qf[s][5] * kb[1] + (float)qf[s][6] * kb[2] + (float)qf[s][7] * kb[3]; }
                d += __shfl_xor(d, 32);
                if (d > v0) { v2 = v1; i2 = i1; v1 = v0; i1 = i0; v0 = d; i0 = jb; }
                else if (d > v1) { v2 = v1; i2 = i1; v1 = d; i1 = jb; }
                else if (d > v2) { v2 = d; i2 = jb; }
            }
            MobaOn on; on.b = b; on.selmask = (i0 >= 0 ? 1u << i0 : 0u) | (i1 >= 0 ? 1u << i1 : 0u) | (i2 >= 0 ? 1u << i2 : 0u);
            fa::f32x16 o[4]; fa::zero_o(o); float m = NEGF, l = 0.f;
            fa::stream<0>(lds, K + (size_t)head * S * 128, VT + (size_t)head * S * 128, 0, 4 * b + 4, qf, o, m, l, 0, t, on, F.tid, lane, 0.f, (LAS float*)nullptr);
            l += __shfl_xor(l, 32);
            const float inv = 1.0f / fmaxf(l, 1e-30f);
#pragma unroll
            for (int dt = 0; dt < 4; ++dt)
#pragma unroll
                for (int c = 0; c < 4; ++c) {
                    const int d = 32 * dt + 8 * c + 4 * h; const size_t off = (size_t)t * 2048 + head * 128 + d;
                    const h16x4 zz = *(const h16x4*)(Z + off); h16x4 ov;
#pragma unroll
                    for (int e = 0; e < 4; ++e) ov[e] = (h16)(o[dt][4 * c + e] * inv * (float)zz[e]);
                    *(h16x4*)(OZ + off) = ov;
                }
        }
    }
}

constexpr size_t WS_MLIST = WS_P;
constexpr size_t WS_MPO = WS_P + 16 * MiB;
constexpr size_t WS_MPML = WS_P + 144 * MiB;
constexpr int CW_MCNT = 8192;
struct ValidOn { bool v; __device__ __forceinline__ bool operator()(int) const { return v; } };

__device__ __forceinline__ void phase_moba_gate(const Frame& F, int jl) {
    const h16* Q = (const h16*)(F.ws + WS_QKV);
    const float* kmean = (const float*)(F.ws + WS_KMEAN);
    unsigned* cnt = (unsigned*)(F.ws + WS_CTL) + CW_MCNT + jl * 512;
    unsigned* list = (unsigned*)(F.ws + WS_MLIST);
    LAS unsigned char* lds = (LAS unsigned char*)F.lds;
    LAS float* kml = (LAS float*)lds;
    const int lane = F.lane, r31 = lane & 31, h = lane >> 5;
    for (int it = F.bid; it < 496; it += F.G) {
        const int head = it / 31, b = it % 31 + 1;
        const int t = b * 256 + F.wave * 32 + r31;
        h16x8 qf[8]; fa::load_q(qf, Q + ((size_t)head * S + t) * 128, h);
        __syncthreads();
        for (int i = F.tid; i < b * 32; i += NTHREADS) { const float* km = kmean + (size_t)head * 32 * 128 + i * 4; *(LAS f32x4*)(kml + i * 4) = *(const f32x4*)km + *(const f32x4*)(km + 65536); }
        __syncthreads();
        float v0 = NEGF, v1 = NEGF, v2 = NEGF; int i0 = -1, i1 = -1, i2 = -1;
        for (int jb = 0; jb < b; ++jb) {
            const LAS float* km = kml + jb * 128 + 8 * h;
            float d = 0.f;
#pragma unroll
            for (int s = 0; s < 8; ++s) { const f32x4 ka = *(const LAS f32x4*)(km + 16 * s), kb = *(const LAS f32x4*)(km + 16 * s + 4);
                d += (float)qf[s][0] * ka[0] + (float)qf[s][1] * ka[1] + (float)qf[s][2] * ka[2] + (float)qf[s][3] * ka[3] + (float)qf[s][4] * kb[0] + (float)qf[s][5] * kb[1] + (float)qf[s][6] * kb[2] + (float)qf[s][7] * kb[3]; }
            d += __shfl_xor(d, 32);
            if (d > v0) { v2 = v1; i2 = i1; v1 = v0; i1 = i0; v0 = d; i0 = jb; }
            else if (d > v1) { v2 = v1; i2 = i1; v1 = d; i1 = jb; }
            else if (d > v2) { v2 = d; i2 = jb; }
        }
        const unsigned long long below = (lane == 0) ? 0ull : (~0ull >> (64 - lane));
        unsigned cntv = 0u; int rk0 = 0, rk1 = 0, rk2 = 0;
        for (int jb = 0; jb < b; ++jb) {
            const bool s0_ = (h == 0) && (i0 == jb), s1_ = (h == 0) && (i1 == jb), s2_ = (h == 0) && (i2 == jb);
            const unsigned long long mk = __ballot(s0_ || s1_ || s2_);
            const int rk = __popcll(mk & below);
            if (s0_) rk0 = rk; if (s1_) rk1 = rk; if (s2_) rk2 = rk;
            if (lane == jb) cntv = (unsigned)__popcll(mk);
        }
        unsigned base = 0u;
        if (lane < b && cntv != 0u) base = __hip_atomic_fetch_add(cnt + head * 32 + lane, cntv, __ATOMIC_RELAXED, __HIP_MEMORY_SCOPE_AGENT);
        const unsigned b0 = __shfl(base, i0 >= 0 ? i0 : 0), b1 = __shfl(base, i1 >= 0 ? i1 : 0), b2 = __shfl(base, i2 >= 0 ? i2 : 0);
        if (h == 0) {
            if (i0 >= 0) list[((size_t)head * 32 + i0) * 8192 + b0 + rk0] = (unsigned)t;
            if (i1 >= 0) list[((size_t)head * 32 + i1) * 8192 + b1 + rk1] = (unsigned)t | (1u << 16);
            if (i2 >= 0) list[((size_t)head * 32 + i2) * 8192 + b2 + rk2] = (unsigned)t | (2u << 16);
        }
    }
}

__device__ __forceinline__ void phase_moba_attn_sparse(const Frame& F, int jl) {
    const h16* Q = (const h16*)(F.ws + WS_QKV); const h16* K = Q + (size_t)16 * S * 128; const h16* V = K + (size_t)16 * S * 128;
    const unsigned* cnt = (const unsigned*)(F.ws + WS_CTL) + CW_MCNT + jl * 512;
    const unsigned* list = (const unsigned*)(F.ws + WS_MLIST);
    h16* PO = (h16*)(F.ws + WS_MPO); float* PML = (float*)(F.ws + WS_MPML);
    LAS unsigned char* lds = (LAS unsigned char*)F.lds;
    LAS unsigned* pre = (LAS unsigned*)(lds + 2 * fa::BUF_BYTES);
    LAS unsigned* wsum = pre + 520;
    const int lane = F.lane, r31 = lane & 31, h = lane >> 5;
    __syncthreads();
    { const unsigned n = cnt[F.tid]; const unsigned u = (n + 255u) >> 8; unsigned x = u;
#pragma unroll
      for (int o = 1; o < 64; o <<= 1) { const unsigned y = __shfl_up(x, o); if (lane >= o) x += y; }
      if (lane == 63) wsum[F.wave] = x;
      __syncthreads();
      unsigned off = 0u;
      for (int w = 0; w < F.wave; ++w) off += wsum[w];
      pre[F.tid] = off + x - u;
      if (F.tid == NTHREADS - 1) pre[512] = off + x;
      __syncthreads(); }
    const int U = 512 + (int)pre[512];
    for (int u = F.bid; u < U; u += F.G) {
        int head, jt0, slot = 3, t; bool valid = true;
        if (u < 512) { head = u >> 5; const int b = u & 31; jt0 = 4 * b; t = b * 256 + F.wave * 32 + r31; }
        else {
            const unsigned gq = (unsigned)(u - 512);
            int lo_ = 0, hi_ = 512;
            while (hi_ - lo_ > 1) { const int mid = (lo_ + hi_) >> 1; if (pre[mid] <= gq) lo_ = mid; else hi_ = mid; }
            const int i = lo_; head = i >> 5; jt0 = 4 * (i & 31);
            const unsigned e = (gq - pre[i]) * 256u + F.wave * 32 + r31, n = cnt[i];
            valid = e < n;
            const unsigned ent = valid ? list[(size_t)i * 8192 + e] : 0u;
            t = (int)(ent & 0xFFFFu); slot = (int)(ent >> 16);
        }
        h16x8 qf[8]; fa::load_q(qf, Q + ((size_t)head * S + t) * 128, h);
        fa::f32x16 o[4]; fa::zero_o(o); float m = NEGF, l = 0.f;
        ValidOn on; on.v = valid;
        fa::stream<0>(lds, K + (size_t)head * S * 128, V + (size_t)head * S * 128, jt0, jt0 + 4, qf, o, m, l, 0, (u < 512) ? t : S, on, F.tid, lane, 0.f, (LAS float*)nullptr);
        l += __shfl_xor(l, 32);
        if (valid) {
            const float inv = 1.0f / fmaxf(l, 1e-30f);
            const size_t pidx = ((size_t)t * 16 + head) * 4 + slot;
#pragma unroll
            for (int dt = 0; dt < 4; ++dt)
#pragma unroll
                for (int c = 0; c < 4; ++c) { h16x4 ov;
#pragma unroll
                    for (int e = 0; e < 4; ++e) ov[e] = (h16)(o[dt][4 * c + e] * inv);
                    *(h16x4*)(PO + pidx * 128 + 32 * dt + 8 * c + 4 * h) = ov; }
            if (h == 0) *(f32x2*)(PML + pidx * 2) = (f32x2){m, l};
        }
    }
}

__device__ __forceinline__ void phase_moba_merge(const Frame& F) {
    const h16* __restrict__ Z = (const h16*)(F.ws + WS_QKV) + (size_t)48 * S * 128;
    const h16* __restrict__ PO = (const h16*)(F.ws + WS_MPO); const float* __restrict__ PML = (const float*)(F.ws + WS_MPML);
    h16* __restrict__ OZ = (h16*)(F.ws + WS_OZ);
    const int sub = F.lane >> 4, dc = (F.lane & 15) * 8;
    const int stride = F.G * 8 * 4;
    for (int p0 = (F.bid * 8 + F.wave) * 4; p0 < S * 16; p0 += 2 * stride) {
        int pr[2]; bool ok[2]; f32x4 ml01[2], ml23[2]; h16x8 x0[2], x1[2], x2[2], x3[2], zz[2];
#pragma unroll
        for (int u = 0; u < 2; ++u) {
            pr[u] = p0 + u * stride + sub; ok[u] = (p0 + u * stride) < S * 16; if (!ok[u]) pr[u] = sub;
            ml01[u] = *(const f32x4*)(PML + (size_t)pr[u] * 8); ml23[u] = *(const f32x4*)(PML + (size_t)pr[u] * 8 + 4);
            const h16* po = PO + (size_t)pr[u] * 512 + dc;
            x0[u] = *(const h16x8*)(po); x1[u] = *(const h16x8*)(po + 128); x2[u] = *(const h16x8*)(po + 256); x3[u] = *(const h16x8*)(po + 384);
            zz[u] = *(const h16x8*)(Z + (size_t)(pr[u] >> 4) * 2048 + (pr[u] & 15) * 128 + dc);
        }
#pragma unroll
        for (int u = 0; u < 2; ++u) {
            const int t = pr[u] >> 4, head = pr[u] & 15, nsel = (t >> 8) < 3 ? (t >> 8) : 3;
            const float m3 = ml23[u][2], l3 = ml23[u][3];
            const float m0 = nsel > 0 ? ml01[u][0] : NEGF, m1 = nsel > 1 ? ml01[u][2] : NEGF, m2 = nsel > 2 ? ml23[u][0] : NEGF;
            const float M = fmaxf(fmaxf(m0, m1), fmaxf(m2, m3));
            const float w0 = nsel > 0 ? ml01[u][1] * __builtin_amdgcn_exp2f(m0 - M) : 0.f, w1 = nsel > 1 ? ml01[u][3] * __builtin_amdgcn_exp2f(m1 - M) : 0.f;
            const float w2 = nsel > 2 ? ml23[u][1] * __builtin_amdgcn_exp2f(m2 - M) : 0.f, w3 = l3 * __builtin_amdgcn_exp2f(m3 - M);
            const float inv = 1.0f / fmaxf((w0 + w1) + (w2 + w3), 1e-30f);
            h16x8 ov;
#pragma unroll
            for (int e = 0; e < 8; ++e) {
                float a = w3 * (float)x3[u][e];
                a += nsel > 0 ? w0 * (float)x0[u][e] : 0.f; a += nsel > 1 ? w1 * (float)x1[u][e] : 0.f; a += nsel > 2 ? w2 * (float)x2[u][e] : 0.f;
                ov[e] = (h16)(a * inv * (float)zz[u][e]);
            }
            if (ok[u]) *(h16x8*)(OZ + (size_t)t * 2048 + head * 128 + dc) = ov;
        }
    }
}

struct AllOn { __device__ __forceinline__ bool operator()(int) const { return true; } };
struct SelOn { const LAS unsigned* w; __device__ __forceinline__ bool operator()(int j) const { return ((w[j >> 5] >> (j & 31)) & 1u) != 0u; } };
__device__ __forceinline__ void phase_nsa_attn_mfma(const Frame& F) {
    const h16* Q = (const h16*)(F.ws + WS_QKV); const h16* KVb = Q + (size_t)16 * S * 128;
    const h16* Z = (const h16*)(F.ws + WS_QKV + 96 * MiB);
    const float* gates = (const float*)(F.ws + WS_GATES);
    const h16* KCMP = (const h16*)(F.ws + WS_KCMP); const h16* VCMPT = (const h16*)(F.ws + WS_VCMP);
    h16* OZ = (h16*)(F.ws + WS_OZ);
    LAS unsigned char* lds = (LAS unsigned char*)F.lds;
    LAS float* imp = (LAS float*)(lds + fa::LDS_IMP); LAS unsigned* selw = (LAS unsigned*)(lds + fa::LDS_SELW);
    const int lane = F.lane, r31 = lane & 31, h = lane >> 5, hh = F.wave & 3, qsub = F.wave >> 2;
    for (int it = F.bid; it < 256; it += F.G) {
        const int g = it >> 6, pi = it & 63, head = 4 * g + hh;
#pragma unroll 1
        for (int half = 0; half < 2; ++half) {
            const int c64 = half ? 127 - pi : pi;
            const int ql = 32 * qsub + r31, t = c64 * 64 + ql;
            h16x8 qf[8]; fa::load_q(qf, Q + ((size_t)head * S + t) * 128, h);
            fa::f32x16 o[4]; float m, l;
            for (int i = F.tid; i < 64 * 128; i += NTHREADS) imp[i] = 0.f;
            const int nval = (t >= 31) ? (((t - 31) >> 4) + 1 < NC ? ((t - 31) >> 4) + 1 : NC) : 0;
            const int tl = c64 * 64 + 63; const int nval_max = (tl >= 31) ? (((tl - 31) >> 4) + 1 < NC ? ((tl - 31) >> 4) + 1 : NC) : 0;
            const int jc = (nval_max + 63) >> 6;
            fa::zero_o(o); m = NEGF; l = 0.f;
            fa::stream<1>(lds, KCMP + (size_t)g * 512 * 128, VCMPT + (size_t)g * 512 * 128, 0, jc, qf, o, m, l, 0, nval - 1, AllOn(), F.tid, lane, 0.f, (LAS float*)nullptr);
            l += __shfl_xor(l, 32);
            { const float invl = 1.0f / fmaxf(l, 1e-30f); float l2 = 0.f;
              fa::stream<2>(lds, KCMP + (size_t)g * 512 * 128, VCMPT + (size_t)g * 512 * 128, 0, jc, qf, o, m, l2, 0, nval - 1, AllOn(), F.tid, lane, invl, imp + ql * 128); }
            const float g0 = gates[(size_t)t * 48 + head * 3 + 0];
#pragma unroll
            for (int dt = 0; dt < 4; ++dt)
#pragma unroll
                for (int c = 0; c < 4; ++c) { h16x4 ov;
#pragma unroll
                    for (int e = 0; e < 4; ++e) ov[e] = (h16)(o[dt][4 * c + e] * g0);
                    *(h16x4*)(OZ + (size_t)t * 2048 + head * 128 + 32 * dt + 8 * c + 4 * h) = ov; }
            __syncthreads();
            for (int qq = 0; qq < 8; ++qq) {
                const int q = F.wave * 8 + qq;
                unsigned u0, u1;
                { const int s = lane; const bool valid = s <= c64, forced = (s == 0) || (s == c64) || (s == c64 - 1);
                  const unsigned bits = __float_as_uint(valid ? (forced ? BIGF : imp[q * 128 + s]) : NEGF); u0 = bits ^ ((bits >> 31) ? 0xFFFFFFFFu : 0x80000000u); }
                { const int s = lane + 64; const bool valid = s <= c64, forced = (s == c64) || (s == c64 - 1);
                  const unsigned bits = __float_as_uint(valid ? (forced ? BIGF : imp[q * 128 + s]) : NEGF); u1 = bits ^ ((bits >> 31) ? 0xFFFFFFFFu : 0x80000000u); }
                unsigned T = 0u;
                for (int bit = 31; bit >= 0; --bit) {
                    const unsigned trial = T | (1u << bit);
                    const int cnt = __popcll(__ballot(u0 >= trial)) + __popcll(__ballot(u1 >= trial));
                    if (cnt >= 16) T = trial;
                }
                const unsigned long long g0 = __ballot(u0 > T), g1 = __ballot(u1 > T), e0 = __ballot(u0 == T), e1 = __ballot(u1 == T);
                const int need = 16 - (__popcll(g0) + __popcll(g1)), n0 = __popcll(e0);
                const int take0 = need < n0 ? need : n0, take1 = need - take0;
                const unsigned long long below = (lane == 0) ? 0ull : (~0ull >> (64 - lane));
                const unsigned long long se0 = __ballot(((e0 >> lane) & 1ull) && __popcll(e0 & below) < take0), se1 = __ballot(((e1 >> lane) & 1ull) && __popcll(e1 & below) < take1);
                const unsigned long long m0 = __ballot((((g0 | se0) >> lane) & 1ull) && lane <= c64), m1 = __ballot((((g1 | se1) >> lane) & 1ull) && (lane + 64) <= c64);
                if (lane == 0) { selw[q * 4 + 0] = (unsigned)m0; selw[q * 4 + 1] = (unsigned)(m0 >> 32); selw[q * 4 + 2] = (unsigned)m1; selw[q * 4 + 3] = (unsigned)(m1 >> 32); }
            }
            __syncthreads();
            SelOn son; son.w = selw + ql * 4;
            fa::zero_o(o); m = NEGF; l = 0.f;
            fa::stream<0>(lds, KVb + ((size_t)2 * 4 + g) * S * 128, KVb + ((size_t)3 * 4 + g) * S * 128, 0, c64 + 1, qf, o, m, l, 0, t, son, F.tid, lane, 0.f, (LAS float*)nullptr);
            l += __shfl_xor(l, 32);
            { const float sc = gates[(size_t)t * 48 + head * 3 + 1] / fmaxf(l, 1e-30f);
#pragma unroll
              for (int dt = 0; dt < 4; ++dt)
#pragma unroll
                  for (int c = 0; c < 4; ++c) { h16* p = OZ + (size_t)t * 2048 + head * 128 + 32 * dt + 8 * c + 4 * h; const h16x4 pv = *(const h16x4*)p; h16x4 ov;
#pragma unroll
                      for (int e = 0; e < 4; ++e) ov[e] = (h16)((float)pv[e] + o[dt][4 * c + e] * sc);
                      *(h16x4*)p = ov; } }
            fa::zero_o(o); m = NEGF; l = 0.f;
            fa::stream<0>(lds, KVb + ((size_t)4 * 4 + g) * S * 128, KVb + ((size_t)5 * 4 + g) * S * 128, (c64 >= 8 ? c64 - 8 : 0), c64 + 1, qf, o, m, l, t - 511, t, AllOn(), F.tid, lane, 0.f, (LAS float*)nullptr);
            l += __shfl_xor(l, 32);
            const float sc2 = gates[(size_t)t * 48 + head * 3 + 2] / fmaxf(l, 1e-30f);
#pragma unroll
            for (int dt = 0; dt < 4; ++dt)
#pragma unroll
                for (int c = 0; c < 4; ++c) {
                    const int d = 32 * dt + 8 * c + 4 * h; const size_t off = (size_t)t * 2048 + head * 128 + d;
                    const h16x4 zz = *(const h16x4*)(Z + off); const h16x4 pv = *(const h16x4*)(OZ + off); h16x4 ov;
#pragma unroll
                    for (int e = 0; e < 4; ++e) ov[e] = (h16)(((float)pv[e] + o[dt][4 * c + e] * sc2) * (float)zz[e]);
                    *(h16x4*)(OZ + off) = ov;
                }
        }
    }
}

namespace rt {
typedef float f32x16 __attribute__((ext_vector_type(16)));
typedef short s16x4v __attribute__((__vector_size__(4 * sizeof(short))));
constexpr int SP = 144, STILE = 128 * SP;
constexpr int VP = 1088, VTILE = 32 * VP;
constexpr int KP = 528, KTILE = 32 * KP, OTILE = VTILE + KTILE;
__device__ __forceinline__ h16x8 tr16(const LAS unsigned char* p0, const LAS unsigned char* p1) {
    const s16x4v a = __builtin_amdgcn_ds_read_tr16_b64_v4i16((LAS s16x4v*)p0), b = __builtin_amdgcn_ds_read_tr16_b64_v4i16((LAS s16x4v*)p1);
    const h16x4 x = __builtin_bit_cast(h16x4, a), y = __builtin_bit_cast(h16x4, b);
    h16x8 r; r[0] = x[0]; r[1] = x[1]; r[2] = x[2]; r[3] = x[3]; r[4] = y[0]; r[5] = y[1]; r[6] = y[2]; r[7] = y[3]; return r;
}
}
__device__ __forceinline__ void phase_ret_scan_mfma(const Frame& F, const Args& A) {
    const h16* RQ = (const h16*)(F.ws + WS_QKV); const h16* RK = RQ + (size_t)8 * S * 256; const h16* RV = RK + (size_t)8 * S * 256;
    h16* ST = (h16*)(F.ws + WS_P);
    LAS unsigned char* lds = (LAS unsigned char*)F.lds;
    const int lane = F.lane, g = lane >> 4, q = (lane & 15) >> 2, p = lane & 3, mr = F.wave >> 1, nc0 = (F.wave & 1) * 2;
    for (int it = F.bid; it < 256; it += F.G) {
        const int h = it >> 5, dk0 = ((it >> 3) & 3) * 64, dv0 = (it & 7) * 64;
        const float lg = A.lg2g[h], carry = __builtin_amdgcn_exp2f(128.f * lg);
        f32x4 acc[2] = {(f32x4){0.f, 0.f, 0.f, 0.f}, (f32x4){0.f, 0.f, 0.f, 0.f}};
        u32x4 kreg[2], vreg[2];
#define RT_LOAD(c) do { int tid_ = F.tid; asm volatile("" : "+v"(tid_)); _Pragma("unroll") for (int i = 0; i < 2; ++i) { const int idx = tid_ + 512 * i, row = idx >> 3, c16 = idx & 7; \
            kreg[i] = *(const u32x4*)(RK + ((size_t)h * S + (c) * 128 + row) * 256 + dk0 + c16 * 8); vreg[i] = *(const u32x4*)(RV + ((size_t)h * S + (c) * 128 + row) * 512 + dv0 + c16 * 8); } } while (0)
#define RT_WRITE(b) do { int tid_ = F.tid; asm volatile("" : "+v"(tid_)); _Pragma("unroll") for (int i = 0; i < 2; ++i) { const int idx = tid_ + 512 * i, row = idx >> 3, c16 = idx & 7; \
            const float w = __builtin_amdgcn_exp2f((float)(127 - row) * lg); h16x8 kk = __builtin_bit_cast(h16x8, kreg[i]); \
            _Pragma("unroll") for (int e = 0; e < 8; ++e) kk[e] = (h16)((float)kk[e] * w); \
            *(LAS h16x8*)(lds + (b) * 2 * rt::STILE + row * rt::SP + c16 * 16) = kk; *(LAS u32x4*)(lds + (b) * 2 * rt::STILE + rt::STILE + row * rt::SP + c16 * 16) = vreg[i]; } } while (0)
        __syncthreads();
        RT_LOAD(0); RT_WRITE(0);
        __syncthreads();
        for (int c = 0; c < 64; ++c) {
            const int cur = c & 1;
#pragma unroll
            for (int n = 0; n < 2; ++n) { h16x4 o; o[0] = (h16)acc[n][0]; o[1] = (h16)acc[n][1]; o[2] = (h16)acc[n][2]; o[3] = (h16)acc[n][3];
                *(h16x4*)(ST + (((size_t)(h * 64 + c)) * 512 + dv0 + 16 * (nc0 + n) + (lane & 15)) * 256 + dk0 + 16 * mr + 4 * g) = o; }
            if (c + 1 < 64) RT_LOAD(c + 1);
            acc[0] = acc[0] * carry; acc[1] = acc[1] * carry;
            const LAS unsigned char* kt = lds + cur * 2 * rt::STILE + (8 * g + q) * rt::SP + (16 * mr + 4 * p) * 2;
            const LAS unsigned char* vt = lds + cur * 2 * rt::STILE + rt::STILE + (8 * g + q) * rt::SP + (16 * nc0 + 4 * p) * 2;
#pragma unroll
            for (int ks = 0; ks < 4; ++ks) {
                const h16x8 a = rt::tr16(kt + 32 * ks * rt::SP, kt + (32 * ks + 4) * rt::SP);
                const h16x8 b0 = rt::tr16(vt + 32 * ks * rt::SP, vt + (32 * ks + 4) * rt::SP);
                const h16x8 b1 = rt::tr16(vt + 32 * ks * rt::SP + 32, vt + (32 * ks + 4) * rt::SP + 32);
                acc[0] = __builtin_amdgcn_mfma_f32_16x16x32_f16(a, b0, acc[0], 0, 0, 0);
                acc[1] = __builtin_amdgcn_mfma_f32_16x16x32_f16(a, b1, acc[1], 0, 0, 0);
            }
            if (c + 1 < 64) RT_WRITE(cur ^ 1);
            __syncthreads();
        }
#undef RT_LOAD
#undef RT_WRITE
    }
}

__device__ __forceinline__ void phase_ret_out_mfma(const Frame& F, const Args& A) {
    const h16* RQ = (const h16*)(F.ws + WS_QKV); const h16* RK = RQ + (size_t)8 * S * 256; const h16* RV = RK + (size_t)8 * S * 256; const h16* RG = RV + (size_t)8 * S * 512;
    const h16* ST = (const h16*)(F.ws + WS_P);
    h16* OZ = (h16*)(F.ws + WS_OZ);
    LAS unsigned char* lds = (LAS unsigned char*)F.lds;
    LAS float* stats = (LAS float*)(lds + 2 * rt::OTILE);
    const int lane = F.lane, r31 = lane & 31, hh = lane >> 5, itl = F.wave & 3, dvh = F.wave >> 2;
    for (int it = F.bid; it < 512; it += F.G) {
        const int h = it >> 6, c = it & 63, il = 32 * itl + r31, tok = c * 128 + il;
        const float lg = A.lg2g[h];
        rt::f32x16 acc[8];
#pragma unroll
        for (int r = 0; r < 8; ++r)
#pragma unroll
            for (int e = 0; e < 16; ++e) acc[r][e] = 0.f;
        const h16* qrow = RQ + ((size_t)h * S + tok) * 256 + 8 * hh;
        u32x4 vreg[4], kreg2[2];
#define RO_LOAD(jt) do { int tid_ = F.tid; asm volatile("" : "+v"(tid_)); _Pragma("unroll") for (int i = 0; i < 2; ++i) { const int idx = tid_ + 512 * i; \
            kreg2[i] = *(const u32x4*)(RK + ((size_t)h * S + c * 128 + 32 * (jt) + (idx >> 5)) * 256 + (idx & 31) * 8); } \
            _Pragma("unroll") for (int i = 0; i < 4; ++i) { const int idx = tid_ + 512 * i; \
            vreg[i] = *(const u32x4*)(RV + ((size_t)h * S + c * 128 + 32 * (jt) + (idx >> 6)) * 512 + (idx & 63) * 8); } } while (0)
#define RO_WRITE(b) do { int tid_ = F.tid; asm volatile("" : "+v"(tid_)); _Pragma("unroll") for (int i = 0; i < 2; ++i) { const int idx = tid_ + 512 * i; \
            *(LAS u32x4*)(lds + (b) * rt::OTILE + rt::VTILE + (idx >> 5) * rt::KP + (idx & 31) * 16) = kreg2[i]; } \
            _Pragma("unroll") for (int i = 0; i < 4; ++i) { const int idx = tid_ + 512 * i; \
            *(LAS u32x4*)(lds + (b) * rt::OTILE + (idx >> 6) * rt::VP + (idx & 63) * 16) = vreg[i]; } } while (0)
        {
            constexpr int SLP = 80, SLB = 512 * SLP;
            const h16* sbase = ST + ((size_t)(h * 64 + c)) * 512 * 256;
            u32x4 sreg[4];
#define RS_LOAD(q_) do { int tid_ = F.tid; asm volatile("" : "+v"(tid_)); _Pragma("unroll") for (int i = 0; i < 4; ++i) { const int idx = tid_ + 512 * i; \
                sreg[i] = *(const u32x4*)(sbase + (size_t)(idx >> 2) * 256 + (q_) * 32 + (idx & 3) * 8); } } while (0)
#define RS_WRITE(b_) do { int tid_ = F.tid; asm volatile("" : "+v"(tid_)); _Pragma("unroll") for (int i = 0; i < 4; ++i) { const int idx = tid_ + 512 * i; \
                *(LAS u32x4*)(lds + (b_) * SLB + (idx >> 2) * SLP + (idx & 3) * 16) = sreg[i]; } } while (0)
            __syncthreads();
            RS_LOAD(0); RS_WRITE(0);
            __syncthreads();
            for (int q = 0; q < 8; ++q) {
                if (q + 1 < 8) RS_LOAD(q + 1);
                const LAS unsigned char* sl = lds + (q & 1) * SLB + (dvh * 256 + r31) * SLP + hh * 16;
#pragma unroll
                for (int k2 = 0; k2 < 2; ++k2) {
                    const h16x8 qf = *(const h16x8*)(qrow + 32 * q + 16 * k2);
#pragma unroll
                    for (int r = 0; r < 8; ++r) { const h16x8 a = *(const LAS h16x8*)(sl + r * 32 * SLP + k2 * 32); acc[r] = __builtin_amdgcn_mfma_f32_32x32x16_f16(a, qf, acc[r], 0, 0, 0); }
                }
                if (q + 1 < 8) RS_WRITE((q + 1) & 1);
                __syncthreads();
            }
#undef RS_LOAD
#undef RS_WRITE
            const float rdec = __builtin_amdgcn_exp2f((float)(il + 1) * lg);
#pragma unroll
            for (int r = 0; r < 8; ++r) acc[r] = acc[r] * rdec;
        }
        RO_LOAD(0);
        RO_WRITE(0);
        __syncthreads();
        for (int jt = 0; jt < 4; ++jt) {
            const int cur = jt & 1;
            if (jt + 1 < 4) RO_LOAD(jt + 1);
            if (jt <= itl) {
                rt::f32x16 sT;
#pragma unroll
                for (int e = 0; e < 16; ++e) sT[e] = 0.f;
                const LAS unsigned char* krow = lds + cur * rt::OTILE + rt::VTILE + r31 * rt::KP + hh * 16;
#pragma unroll 4
                for (int ks = 0; ks < 16; ++ks) sT = __builtin_amdgcn_mfma_f32_32x32x16_f16(*(const LAS h16x8*)(krow + 32 * ks), *(const h16x8*)(qrow + 16 * ks), sT, 0, 0, 0);
                h16x8 pb[2];
#pragma unroll
                for (int e = 0; e < 16; ++e) { const int kl = 32 * jt + (e & 3) + 8 * (e >> 2) + 4 * hh, df = il - kl;
                    const float pv = (df >= 0) ? sT[e] * __builtin_amdgcn_exp2f((float)df * lg) : 0.f; pb[e >> 3][e & 7] = (h16)pv; }
                const LAS unsigned char* vbase = lds + cur * rt::OTILE + (4 * hh + ((lane & 15) >> 2)) * rt::VP + (dvh * 256 + 16 * ((lane >> 4) & 1) + 4 * (lane & 3)) * 2;
#pragma unroll
                for (int r = 0; r < 8; ++r) {
#pragma unroll
                    for (int sp = 0; sp < 2; ++sp) { const LAS unsigned char* vp = vbase + 16 * sp * rt::VP + 64 * r;
                        acc[r] = __builtin_amdgcn_mfma_f32_32x32x16_f16(rt::tr16(vp, vp + 8 * rt::VP), pb[sp], acc[r], 0, 0, 0); }
                    if (r & 1) __builtin_amdgcn_sched_barrier(0);
                }
            }
            if (jt + 1 < 4) RO_WRITE(cur ^ 1);
            __syncthreads();
        }
#undef RO_LOAD
#undef RO_WRITE
        float s1 = 0.f, s2 = 0.f;
#pragma unroll
        for (int r = 0; r < 8; ++r)
#pragma unroll
            for (int e = 0; e < 16; ++e) { s1 += acc[r][e]; s2 += acc[r][e] * acc[r][e]; }
        s1 += __shfl_xor(s1, 32); s2 += __shfl_xor(s2, 32);
        if (hh == 0) { stats[(F.wave * 32 + r31) * 2] = s1; stats[(F.wave * 32 + r31) * 2 + 1] = s2; }
        __syncthreads();
        s1 += stats[((F.wave ^ 4) * 32 + r31) * 2]; s2 += stats[((F.wave ^ 4) * 32 + r31) * 2 + 1];
        const float mu = s1 * (1.0f / 512.0f), var = fmaxf(s2 * (1.0f / 512.0f) - mu * mu, 0.f), rs = 1.0f / sqrtf(var + EPS);
#pragma unroll
        for (int r = 0; r < 8; ++r)
#pragma unroll
            for (int cq = 0; cq < 4; ++cq) {
                const size_t off = (size_t)tok * 4096 + h * 512 + dvh * 256 + 32 * r + 8 * cq + 4 * hh;
                const h16x4 gv = *(const h16x4*)(RG + off); h16x4 ov;
#pragma unroll
                for (int e = 0; e < 4; ++e) ov[e] = (h16)((float)gv[e] * ((acc[r][4 * cq + e] - mu) * rs));
                *(h16x4*)(OZ + off) = ov;
            }
    }
}

template <int KIND>
__device__ __forceinline__ void phase_gemm_proj(const Frame& F, int N) {
    pg8::Gemm g{(const h16*)(F.ws + WS_H), (const h16*)(F.ws + WS_WTIN), S, N, 2048, 2048, 2048}; pg8::StaticOrder So; So.init(S, N, F.G, F.bid);
    pg8::EpiProj<KIND> E{F.ws};
    pg8::gemm_phase<pg8::EpiProj<KIND>, pg8::StaticOrder, true, true>((LAS unsigned char*)F.lds, g, So, E);
}
__device__ __forceinline__ void phase_gemm(const Frame& F, const h16* A, const h16* Bt, int N, int K, void* O, int ldc, int f32out) {
    pg8::Gemm g{A, Bt, S, N, K, K, K}; pg8::StaticOrder So; So.init(S, N, F.G, F.bid);
    pg8::EpiStore E{O, ldc, f32out};
    pg8::gemm_phase<pg8::EpiStore, pg8::StaticOrder, true, true>((LAS unsigned char*)F.lds, g, So, E);
}

constexpr int NPHASE = 2 + 8 * DEPTH;
__host__ __device__ inline bool phase_exists(int p) {
    if (p < 2) return true;
    const int L = (p - 2) / 8, s = (p - 2) % 8, kind = L % 3;
    if (s == 7) return false;
    if (s == 1) return kind == 1 || (kind == 0 && MOBA_SPARSE);
    if (s == 2) return kind != 0 || MOBA_SPARSE;
    if (s == 4) return false;
    return true;
}

__global__ void __launch_bounds__(NTHREADS, 2) trunk_fwd(Args args) {
    extern __shared__ __attribute__((aligned(16))) unsigned char lds_raw[];
    Frame F;
    F.out = args.out; F.ws = args.ws; F.lds = (char*)lds_raw;
    F.tid = threadIdx.x; F.lane = F.tid & 63; F.wave = __builtin_amdgcn_readfirstlane(F.tid >> 6); F.G = gridDim.x; F.bid = blockIdx.x;
    volatile LAS unsigned* misc = (volatile LAS unsigned*)((LAS unsigned char*)lds_raw + MISC_OFF);
    if (F.tid < 16) misc[F.tid] = 0u;
    __syncthreads();
    XcdBarrier bar; bar.bar = (unsigned*)(F.ws + WS_CTL) + CW_BAR; bar.x = 0; bar.st = misc;
#if ONE_LAUNCH
    bar = xcd_barrier_post((unsigned*)(F.ws + WS_CTL) + CW_BAR, misc);
    cg::grid_group grid = cg::this_grid();
#endif
    const int lo = args.ph_lo, hi = args.ph_hi;
#if ONE_LAUNCH
    grid.sync();
#define SEAM(p) do { if ((p) > lo) xcd_barrier(bar); } while (0)
#else
#define SEAM(p) do { } while (0)
#endif
#define IN(p) (lo <= (p) && (p) < hi)
#ifndef PHMASK
#define PHMASK 0xFFFF
#endif
#define EN(b) ((PHMASK >> (b)) & 1)
#ifndef PROBE_DUP
#define PROBE_DUP 0
#endif
#define DUP(b, call) do { if ((PROBE_DUP >> (b)) & 1) { if (ONE_LAUNCH) xcd_barrier(bar); call; } } while (0)
    if (EN(0) && IN(0)) { SEAM(0); phase_prologue(F, args); }
    if (EN(1) && IN(1)) { SEAM(1); phase_norm(F, args, -1, 0); }
#define LAYER(L) do { \
        constexpr int kind = (L) % 3, base = 2 + 8 * (L); \
        constexpr int Nin = kind == 0 ? 8192 : (kind == 1 ? NSA_NP : 12288); \
        constexpr int Kout = kind == 2 ? 4096 : 2048; \
        if (EN(2) && IN(base + 0)) { SEAM(base + 0); phase_gemm_proj<kind>(F, Nin); } \
        if (EN(6) && kind == 1 && IN(base + 1)) { SEAM(base + 1); phase_nsa_cmp_a(F); } \
        if (EN(8) && kind == 0 && MOBA_SPARSE && IN(base + 1)) { SEAM(base + 1); phase_moba_gate(F, (L) / 3); } \
        if (EN(8) && kind == 0 && MOBA_SPARSE && IN(base + 2)) { SEAM(base + 2); phase_moba_attn_sparse(F, (L) / 3); } \
        if (kind != 0 && IN(base + 2)) { SEAM(base + 2); if (EN(6) && kind == 1) { phase_nsa_cmp_b(F, args); } else if (EN(7) && kind == 2) { phase_ret_scan_mfma(F, args); } } \
        if (IN(base + 3)) { SEAM(base + 3); if (EN(8) && kind == 0) { if (MOBA_SPARSE) phase_moba_merge(F); else phase_moba_attn_mfma(F); } else if (EN(9) && kind == 1) { phase_nsa_attn_mfma(F); DUP(9, phase_nsa_attn_mfma(F)); } else if (EN(10) && kind == 2) { phase_ret_out_mfma(F, args); } } \
        if (EN(2) && IN(base + 5)) { SEAM(base + 5); phase_gemm(F, (const h16*)(F.ws + WS_OZ), (const h16*)(F.ws + WS_WTOUT), 2048, Kout, F.ws + WS_Y, 2048, 0); } \
        if (EN(1) && IN(base + 6)) { SEAM(base + 6); phase_norm(F, args, (L), (L) + 1 < DEPTH ? (L) + 1 : -1); } \
    } while (0)
    LAYER(0); LAYER(1); LAYER(2); LAYER(3);
#undef LAYER
#undef EN
#undef DUP
#undef IN
#undef SEAM
}

extern "C" void kernel_launch(void* const* d_in, const int* in_sizes, int n_in, void* d_out, int out_size, void* d_ws, size_t ws_size, hipStream_t stream) {
    static int grid = 0;
    if (grid == 0) {
        if (n_in != 18 || out_size != S * D || ws_size < WS_END) { fprintf(stderr, "kernel_launch: unexpected shapes (n_in %d, out %d, ws %zu)\n", n_in, out_size, ws_size); grid = -1; return; }
        int dev = 0, cus = 0, per_cu = 0;
        if (hipGetDevice(&dev) != hipSuccess || hipDeviceGetAttribute(&cus, hipDeviceAttributeMultiprocessorCount, dev) != hipSuccess) { grid = -1; return; }
        if (hipFuncSetAttribute((const void*)trunk_fwd, hipFuncAttributeMaxDynamicSharedMemorySize, LDS_BYTES) != hipSuccess) { fprintf(stderr, "kernel_launch: hipFuncSetAttribute failed\n"); grid = -1; return; }
        if (hipOccupancyMaxActiveBlocksPerMultiprocessor(&per_cu, (const void*)trunk_fwd, NTHREADS, LDS_BYTES) != hipSuccess || per_cu < 1) { fprintf(stderr, "kernel_launch: occupancy query says %d\n", per_cu); per_cu = 1; }
        (void)hipGetLastError();
        grid = cus;
    }
    if (grid < 0) return;
    (void)hipMemsetAsync((char*)d_ws + WS_CTL, 0, CTL_ZERO_BYTES, stream);
    Args a{};
    for (int i = 0; i < 18; ++i) a.in[i] = (const float*)d_in[i];
    a.out = (float*)d_out; a.ws = (unsigned char*)d_ws;
    for (int j = 0; j < 16; ++j) a.inv16[j] = pow(500000.0, -(double)j / 16.0);
    for (int j = 0; j < 128; ++j) a.inv128[j] = pow(10000.0, -(double)j / 128.0);
    for (int h = 0; h < 8; ++h) a.lg2g[h] = (float)log2(1.0 - ldexp(1.0, -5 - h));
#if ONE_LAUNCH
    a.ph_lo = 0; a.ph_hi = NPHASE;
    void* kargs[] = {&a};
    hipError_t e = hipLaunchCooperativeKernel((const void*)trunk_fwd, dim3(grid), dim3(NTHREADS), kargs, LDS_BYTES, stream);
    if (e != hipSuccess) fprintf(stderr, "kernel_launch: cooperative launch failed: %s (grid %d)\n", hipGetErrorString(e), grid);
#else
    for (int p = 0; p < NPHASE; ++p) {
        if (!phase_exists(p)) continue;
        a.ph_lo = p; a.ph_hi = p + 1;
        hipLaunchKernelGGL(trunk_fwd, dim3(grid), dim3(NTHREADS), LDS_BYTES, stream, a);
    }
#endif
}
```

```cpp
#include <hip/hip_runtime.h>
#include <hip/hip_cooperative_groups.h>
#include <cstdio>
#include <cstdint>
#include <cmath>
namespace cg = cooperative_groups;

#ifndef ONE_LAUNCH
#define ONE_LAUNCH 1
#endif
#ifndef MOBA_SPARSE
#define MOBA_SPARSE 1
#endif
#ifndef MOBA_MFMA
#define MOBA_MFMA 1
#endif
#ifndef NSA_MFMA
#define NSA_MFMA 1
#endif

#define LAS __attribute__((address_space(3)))
typedef _Float16 h16;
typedef _Float16 h16x2 __attribute__((ext_vector_type(2)));
typedef _Float16 h16x4 __attribute__((ext_vector_type(4)));
typedef _Float16 h16x8 __attribute__((ext_vector_type(8)));
typedef float f32x2 __attribute__((ext_vector_type(2)));
typedef float f32x4 __attribute__((ext_vector_type(4)));
typedef unsigned u32x4 __attribute__((ext_vector_type(4)));

constexpr int S = 8192, D = 2048, DEPTH = 4;
constexpr float EPS = 1e-6f;
constexpr float NEGF = -1e30f, BIGF = 1e30f;
constexpr int NSA_NP = 7424;
constexpr int NC = 511;

constexpr size_t MiB = 1u << 20;
constexpr size_t WS_CTL = 0, CTL_ZERO_BYTES = 1 * MiB;
constexpr size_t WS_MODP = 1 * MiB;
constexpr size_t WS_KMEAN = 4 * MiB + 512 * 1024;
constexpr size_t WS_CMPB = 2 * MiB + 512 * 1024;
constexpr size_t WS_CMPBF = 2 * MiB + 640 * 1024 + 128 * 1024;
constexpr size_t WS_MODF = 2 * MiB + 640 * 1024;
constexpr size_t WS_GATES = 3 * MiB;
constexpr size_t WS_KCMP = 5 * MiB;
constexpr size_t WS_VCMP = 5 * MiB + 512 * 1024;
constexpr size_t WS_ROPE16 = 6 * MiB;
constexpr size_t WS_ROPE128 = 7 * MiB;
constexpr size_t WS_WTIN = 16 * MiB;
constexpr size_t WS_WTOUT = 64 * MiB;
constexpr size_t WS_W1T = 72 * MiB;
constexpr size_t WS_H = 80 * MiB;
constexpr size_t WS_P = 112 * MiB;
constexpr size_t WS_QKV = 304 * MiB;
constexpr size_t WS_OZ = 496 * MiB;
constexpr size_t WS_Y = 560 * MiB;
constexpr size_t WS_OR = 624 * MiB;
constexpr size_t WS_WTIN2 = 656 * MiB;
__host__ __device__ inline int ret_idle_a(int G) { const int nwg = (S / 256) * (NSA_NP / 256), R = (nwg + G - 1) / G; return R * G - nwg; }
__host__ __device__ inline int ret_early_a(int G) { const int n = 16 * ret_idle_a(G); return n < 2048 ? n : 2048; }
__host__ __device__ inline int ret_early_b(int G) { const int n = G > 64 ? 4 * (G - 64) : 0; return n < 1024 ? n : 1024; }
constexpr int RET_TILES = (2048 / 64) * (12288 / 128);
constexpr size_t WS_XS = 720 * MiB;
constexpr size_t WS_SC = 2 * MiB + 832 * 1024;
constexpr size_t WS_MODP1 = 624 * MiB;
constexpr size_t WS_END = 752 * MiB;

constexpr int LDS_BYTES = 147456;
constexpr int MISC_OFF = 135168;
constexpr int NTHREADS = 512;

struct Args {
    const float* in[18];
    float* out;
    unsigned char* ws;
    double inv16[16];
    double inv128[128];
    float lg2g[8];
    int ph_lo, ph_hi;
};

#define XB_TMO      128
#define XB_XCNT(j)  (256  + 64 * (j))
#define XB_XSUB(j)  (1280 + 64 * (j))
#define XB_XGEN(j)  (2304 + 64 * (j))
#define XB_TOP      3328
#define XB_TOPGEN   3392
#define XCD_BAR_WORDS 3456
#define XB_SPIN_CAP (1u << 24)
constexpr int CW_BAR = 4096;

__device__ __forceinline__ unsigned xb_ld(unsigned* p)              { return __hip_atomic_load(p, __ATOMIC_RELAXED, __HIP_MEMORY_SCOPE_AGENT); }
__device__ __forceinline__ unsigned xb_add(unsigned* p, unsigned v) { return __hip_atomic_fetch_add(p, v, __ATOMIC_RELAXED, __HIP_MEMORY_SCOPE_AGENT); }
__device__ __forceinline__ unsigned xb_xcc_id() { return (unsigned)__builtin_amdgcn_s_getreg((3 << 11) | 20) & 0xFu; }
#define XB_SPIN(cond, bar) do { unsigned _sp = 0; while (cond) { __builtin_amdgcn_s_sleep(1); \
    if ((++_sp & 255u) == 0u) { if (xb_ld(&(bar)[XB_TMO])) break; if (_sp > XB_SPIN_CAP) { atomicAdd(&(bar)[XB_TMO], 1u); break; } } } } while (0)

struct XcdBarrier { unsigned* bar; unsigned x; volatile LAS unsigned* st; };

__device__ __forceinline__ XcdBarrier xcd_barrier_post(unsigned* bar, volatile LAS unsigned* st) {
    XcdBarrier b; b.bar = bar; b.x = xb_xcc_id(); b.st = st;
    if (threadIdx.x == 0) (void)xb_add(&bar[XB_XCNT(b.x)], 1u);
    return b;
}
__device__ __forceinline__ void xcd_barrier_complete(unsigned* bar, unsigned x, unsigned& nloc, unsigned& nx) {
    const unsigned G = gridDim.x * gridDim.y * gridDim.z;
    unsigned sum, cnt, mine, sp = 0u;
    for (;;) {
        sum = 0u; cnt = 0u; mine = 0u;
#pragma unroll
        for (unsigned j = 0; j < 16; ++j) { const unsigned c = xb_ld(&bar[XB_XCNT(j)]); sum += c; cnt += (c > 0u) ? 1u : 0u; mine = (j == x) ? c : mine; }
        if (sum == G) break;
        __builtin_amdgcn_s_sleep(1);
        if ((++sp & 255u) == 0u) { if (xb_ld(&bar[XB_TMO])) break; if (sp > XB_SPIN_CAP) { atomicAdd(&bar[XB_TMO], 1u); break; } }
    }
    nloc = mine > 0u ? mine : 1u; nx = cnt > 0u ? cnt : 1u;
}
__device__ __forceinline__ void xcd_barrier(const XcdBarrier& b) {
    asm volatile("s_waitcnt vmcnt(0)" ::: "memory");
    __syncthreads();
    if (threadIdx.x == 0) {
        unsigned* bar = b.bar;
        __builtin_amdgcn_s_waitcnt(0);
        unsigned nloc = b.st[0], nx = b.st[1];
        if (nloc == 0u) { xcd_barrier_complete(bar, b.x, nloc, nx); b.st[0] = nloc; b.st[1] = nx; }
        const unsigned old = xb_add(&bar[XB_XSUB(b.x)], 1u);
        const unsigned gen = old / nloc;
        if (old + 1u == (gen + 1u) * nloc) {
            __builtin_amdgcn_fence(__ATOMIC_RELEASE, "agent");
            asm volatile("s_waitcnt vmcnt(0)" ::: "memory");
            const unsigned og = xb_add(&bar[XB_TOP], 1u);
            const unsigned tg = og / nx;
            if (og + 1u == (tg + 1u) * nx) xb_add(&bar[XB_TOPGEN], 1u);
            else XB_SPIN(xb_ld(&bar[XB_TOPGEN]) == tg, bar);
            __builtin_amdgcn_fence(__ATOMIC_ACQUIRE, "agent");
            xb_add(&bar[XB_XGEN(b.x)], 1u);
            asm volatile("s_waitcnt vmcnt(0)" ::: "memory");
        } else {
            XB_SPIN(xb_ld(&bar[XB_XGEN(b.x)]) == gen, bar);
            __builtin_amdgcn_fence(__ATOMIC_ACQUIRE, "agent");
            asm volatile("s_waitcnt vmcnt(0)" ::: "memory");
        }
    }
    __syncthreads();
}

__device__ __forceinline__ float silu_f(float x) { return x * __builtin_amdgcn_rcpf(1.f + __expf(-x)); }
__device__ __forceinline__ float sigmoid_f(float x) { return __builtin_amdgcn_rcpf(1.f + __expf(-x)); }

namespace pg8 {
constexpr int BM = 256, BK = 64, HALF = 128, HTB = HALF * BK * 2, STAGE_BYTES = 8 * HTB, NXCD = 8, WGM = 8;
__host__ __device__ __forceinline__ int lds_byte(int r, int c) { const int st = (r >> 4) * 2 + (c >> 5), rr = r & 15, cc = c & 31, ob = rr * 64 + cc * 2; return st * 1024 + (ob ^ (((ob >> 9) & 1) << 5)); }
__host__ __device__ __forceinline__ void stage_rc(int b, int& R, int& C) { const int st = b / 1024, sb = b % 1024, swz = sb ^ (((sb >> 9) & 1) << 5); R = (st >> 1) * 16 + swz / 64; C = (st & 1) * 32 + (swz % 64) / 2; }
__host__ __device__ __forceinline__ int perm32(int rho) { const int n = rho >> 4, i = rho & 15; return 8 * (i >> 2) + 4 * n + (i & 3); }

struct Unit { int pm, pn; };
struct Gemm { const h16* A; const h16* Bt; int M, N, K, lda, ldb; };

struct StaticOrder {
    int nM, nN, nwg, G, c;
    __host__ __device__ void init(int M, int N, int G_, int c_) { nM = M / BM; nN = N / BM; nwg = nM * nN; G = G_; c = c_; }
    __host__ __device__ bool next(int i, Unit& u) const {
        const long L = (long)i * G + c; if (L >= nwg) return false;
        int wgid = (int)L; { const int q = nwg / NXCD, r = nwg % NXCD, xcd = wgid % NXCD, off = wgid / NXCD; wgid = (xcd < r ? xcd * (q + 1) : r * (q + 1) + (xcd - r) * q) + off; }
        const int nig = WGM * nN, gid = wgid / nig, fm = gid * WGM, gsz = (nM - fm) < WGM ? (nM - fm) : WGM;
        u.pm = fm + ((wgid % nig) % gsz); u.pn = (wgid % nig) / gsz; return true;
    }
    __device__ __forceinline__ void a_ready(const Unit&) const {}
    __device__ __forceinline__ void done(const Unit&) const {}
};

struct OneUnit {
    int pm, pn, have;
    __device__ bool next(int i, Unit& u) const { if (i != 0 || !have) return false; u.pm = pm; u.pn = pn; return true; }
    __device__ __forceinline__ void a_ready(const Unit&) const {}
    __device__ __forceinline__ void done(const Unit&) const {}
};
struct EpiStore {
    static constexpr bool PERM = true, AFTER_DRAIN = false;
    void* O; int ldc; int f32out;
    __device__ __forceinline__ void operator()(const f32x4 (&acc)[2][2][4][2], const Unit& u, int wr, int wc, int fr, int fq) const {
        const int row0 = u.pm * BM + wr * 64 + fr, col0 = u.pn * BM + wc * 32 + 8 * fq;
#pragma unroll
        for (int ai = 0; ai < 2; ++ai)
#pragma unroll
            for (int m = 0; m < 4; ++m) {
                const size_t roff = (size_t)(row0 + ai * HALF + m * 16) * ldc + col0;
#pragma unroll
                for (int bj = 0; bj < 2; ++bj) {
                    const f32x4 v0 = acc[ai][bj][m][0], v1 = acc[ai][bj][m][1];
                    if (f32out) {
                        float* p = (float*)O + roff + bj * HALF;
                        *(f32x4*)p = v0; *(f32x4*)(p + 4) = v1;
                    } else {
                        h16x8 w; w[0] = (h16)v0[0]; w[1] = (h16)v0[1]; w[2] = (h16)v0[2]; w[3] = (h16)v0[3]; w[4] = (h16)v1[0]; w[5] = (h16)v1[1]; w[6] = (h16)v1[2]; w[7] = (h16)v1[3];
                        *(h16x8*)((h16*)O + roff + bj * HALF) = w;
                    }
                }
            }
    }
};


template <int KIND  > struct EpiProj {
    static constexpr bool PERM = true, AFTER_DRAIN = false;
    unsigned char* ws;
    __device__ __forceinline__ static void st8(h16* p, const float (&v)[8]) { h16x8 w;
#pragma unroll
        for (int i = 0; i < 8; ++i) w[i] = (h16)v[i];
        *(h16x8*)p = w; }
    __device__ __forceinline__ void operator()(const f32x4 (&acc)[2][2][4][2], const Unit& u, int wr, int wc, int fr, int fq) const {
        const int pn = u.pn, d0 = 32 * wc + 8 * fq;
        h16* QKV = (h16*)(ws + WS_QKV);
        const f32x2* r16 = (const f32x2*)(ws + WS_ROPE16); const f32x2* r128 = (const f32x2*)(ws + WS_ROPE128);
        float ksum[2][8];
#pragma unroll
        for (int bj = 0; bj < 2; ++bj)
#pragma unroll
            for (int i = 0; i < 8; ++i) ksum[bj][i] = 0.f;
        int mode;
        float scale = 1.f; h16* base = QKV; int ld = 0;
        bool want_ksum = false;
        if (KIND == 0) {
            const int sect = pn >> 3;
            if (sect == 0) { mode = 0; scale = 0.08838834764831845f * 1.4426950408889634f  ; base = QKV + (size_t)(2 * (pn & 7)) * S * 128; }
            else if (sect == 1) { mode = 0; want_ksum = true; base = QKV + (size_t)16 * S * 128 + (size_t)(2 * (pn & 7)) * S * 128; }
            else if (sect == 2) { mode = 1; base = QKV + (size_t)32 * S * 128 + (size_t)(2 * (pn & 7)) * S * 128; }
            else { mode = 2; base = QKV + (size_t)48 * S * 128 + (pn & 7) * 256; ld = 2048; }
        } else if (KIND == 1) {
            if (pn < 8) { mode = 0; scale = 0.08838834764831845f * 1.4426950408889634f  ; base = QKV + (size_t)(2 * pn) * S * 128; }
            else if (pn < 20) { const int ti = (pn - 8) >> 1; mode = (ti & 1) ? 1 : 0; base = QKV + (size_t)16 * S * 128 + ((size_t)ti * 4 + 2 * ((pn - 8) & 1)) * S * 128; }
            else if (pn < 28) { mode = 2; base = (h16*)(ws + WS_QKV + 96 * MiB) + (pn - 20) * 256; ld = 2048; }
            else mode = 3;
        } else {
            if (pn < 8) { mode = 4; base = QKV + (size_t)pn * S * 256; }
            else if (pn < 16) { mode = 4; scale = 0.0625f; base = QKV + (size_t)8 * S * 256 + (size_t)(pn - 8) * S * 256; }
            else if (pn < 32) { mode = 5; base = QKV + (size_t)16 * S * 256 + (size_t)((pn - 16) >> 1) * S * 512 + ((pn - 16) & 1) * 256; }
            else { mode = 2; base = QKV + (size_t)16 * S * 256 + (size_t)8 * S * 512 + (pn - 32) * 256; ld = 4096; }
        }
        const int trow = u.pm * BM + wr * 64 + fr;
constexpr int EPD = 2;
#define EP_ROW(it) (trow + ((it) >> 2) * HALF + ((it) & 3) * 16)
#define EP_GETV(it) float v[2][8]; _Pragma("unroll") for (int bj = 0; bj < 2; ++bj) _Pragma("unroll") for (int i = 0; i < 8; ++i) v[bj][i] = acc[(it) >> 2][bj][(it) & 3][i >> 2][i & 3];
        if (mode == 0) {
            if (wc == 0) {
                const f32x4* tb = (const f32x4*)(r16 + 8 * (fq & 1));
                f32x4 cn[EPD][4];
#pragma unroll
                for (int p = 0; p < EPD; ++p)
#pragma unroll
                    for (int q = 0; q < 4; ++q) cn[p][q] = tb[(size_t)EP_ROW(p) * 8 + q];
#pragma unroll
                for (int it = 0; it < 8; ++it) {
                    const int t = EP_ROW(it);
                    f32x4 cc[4];
#pragma unroll
                    for (int q = 0; q < 4; ++q) cc[q] = cn[it % EPD][q];
                    if (it + EPD < 8) {
#pragma unroll
                        for (int q = 0; q < 4; ++q) cn[it % EPD][q] = tb[(size_t)EP_ROW(it + EPD) * 8 + q]; }
                    EP_GETV(it)
#pragma unroll
                    for (int bj = 0; bj < 2; ++bj) {
#pragma unroll
                        for (int i = 0; i < 8; ++i) { const float o = __shfl_xor(v[bj][i], 32); const float c0 = cc[i >> 1][2 * (i & 1)], c1 = cc[i >> 1][2 * (i & 1) + 1];
                            v[bj][i] = ((fq < 2) ? (v[bj][i] * c0 - o * c1) : (o * c1 + v[bj][i] * c0)) * scale; ksum[bj][i] += v[bj][i]; }
                        st8(base + ((size_t)bj * S + t) * 128 + d0, v[bj]);
                    }
                }
            } else {
#pragma unroll
                for (int it = 0; it < 8; ++it) { const int t = EP_ROW(it); EP_GETV(it)
#pragma unroll
                    for (int bj = 0; bj < 2; ++bj) {
#pragma unroll
                        for (int i = 0; i < 8; ++i) { v[bj][i] *= scale; ksum[bj][i] += v[bj][i]; }
                        st8(base + ((size_t)bj * S + t) * 128 + d0, v[bj]);
                    } }
            }
        } else if (mode == 1) {
#pragma unroll
            for (int it = 0; it < 8; ++it) { const int t = EP_ROW(it); EP_GETV(it)
#pragma unroll
                for (int bj = 0; bj < 2; ++bj) st8(base + ((size_t)bj * S + t) * 128 + d0, v[bj]); }
        } else if (mode == 2) {
#pragma unroll
            for (int it = 0; it < 8; ++it) { const int t = EP_ROW(it); EP_GETV(it)
#pragma unroll
                for (int bj = 0; bj < 2; ++bj) {
#pragma unroll
                    for (int i = 0; i < 8; ++i) v[bj][i] = silu_f(v[bj][i]);
                    st8(base + (size_t)t * ld + 128 * bj + d0, v[bj]);
                } }
        } else if (mode == 3) {
            if (d0 < 48) {
#pragma unroll
                for (int it = 0; it < 8; ++it) { const int t = EP_ROW(it); float* gp = (float*)(ws + WS_GATES) + (size_t)t * 48 + d0;
                    f32x4 g0, g1;
#pragma unroll
                    for (int i = 0; i < 4; ++i) { g0[i] = sigmoid_f(acc[it >> 2][0][it & 3][0][i]); g1[i] = sigmoid_f(acc[it >> 2][0][it & 3][1][i]); }
                    *(f32x4*)gp = g0; *(f32x4*)(gp + 4) = g1; } }
        } else if (mode == 4) {
            const f32x4* tb = (const f32x4*)(r128 + d0);
            f32x4 cn[EPD][4];
#pragma unroll
            for (int p = 0; p < EPD; ++p)
#pragma unroll
                for (int q = 0; q < 4; ++q) cn[p][q] = tb[(size_t)EP_ROW(p) * 64 + q];
#pragma unroll
            for (int it = 0; it < 8; ++it) {
                const int t = EP_ROW(it);
                f32x4 cc[4];
#pragma unroll
                for (int q = 0; q < 4; ++q) cc[q] = cn[it % EPD][q];
                if (it + EPD < 8) {
#pragma unroll
                    for (int q = 0; q < 4; ++q) cn[it % EPD][q] = tb[(size_t)EP_ROW(it + EPD) * 64 + q]; }
                EP_GETV(it)
#pragma unroll
                for (int i = 0; i < 8; ++i) { const float c0 = cc[i >> 1][2 * (i & 1)], c1 = cc[i >> 1][2 * (i & 1) + 1]; const float x1 = v[0][i], x2 = v[1][i];
                    v[0][i] = (x1 * c0 - x2 * c1) * scale; v[1][i] = (x1 * c1 + x2 * c0) * scale; }
                st8(base + (size_t)t * 256 + d0, v[0]); st8(base + (size_t)t * 256 + 128 + d0, v[1]);
            }
        } else {
#pragma unroll
            for (int it = 0; it < 8; ++it) { const int t = EP_ROW(it); EP_GETV(it)
#pragma unroll
                for (int bj = 0; bj < 2; ++bj) st8(base + (size_t)t * 512 + 128 * bj + d0, v[bj]); }
        }
#undef EP_ROW
#undef EP_GETV
        if (KIND == 0 && want_ksum) {
#pragma unroll
            for (int bj = 0; bj < 2; ++bj)
#pragma unroll
                for (int i = 0; i < 8; ++i) { float x = ksum[bj][i]; x += __shfl_xor(x, 1); x += __shfl_xor(x, 2); x += __shfl_xor(x, 4); x += __shfl_xor(x, 8); ksum[bj][i] = x; }
            if (fr == 0) { float* km = (float*)(ws + WS_KMEAN) + (size_t)wr * 65536;
#pragma unroll
                for (int bj = 0; bj < 2; ++bj)
#pragma unroll
                    for (int i = 0; i < 8; ++i) km[((size_t)(2 * (pn & 7) + bj) * 32 + u.pm) * 128 + d0 + i] = ksum[bj][i] * (1.0f / 256.0f); }
        }
    }
};

template <class Epi, class Sched, bool ALIGN_EPI = false, bool SP2 = false>
__device__ __forceinline__ void gemm_phase(LAS unsigned char* lds, const Gemm g, const Sched& S, const Epi& E) {
    const int tid = threadIdx.x, wid = __builtin_amdgcn_readfirstlane(tid >> 6), lane = tid & 63, wr = wid >> 2, wc = wid & 3, fr = lane & 15, fq = lane >> 4;
    const int K = g.K, nt = K / BK;
    unsigned voffA[2], voffB[2];
#pragma unroll
    for (int i = 0; i < 2; ++i) { int R, C; stage_rc(tid * 16 + i * 8192, R, C); const int Rb = Epi::PERM ? ((R & ~31) + perm32(R & 31)) : R;
        voffA[i] = (unsigned)(R * g.lda + C) * 2u; voffB[i] = (unsigned)(Rb * g.ldb + C) * 2u; }
    const size_t kstep = (size_t)(BK * 2);
    const size_t hstepA = (size_t)HALF * g.lda * 2, hstepB = (size_t)HALF * g.ldb * 2;
    const size_t tstepA = 2 * hstepA, tstepB = 2 * hstepB;
    const unsigned ldsw = (unsigned)wid * 1024u;
    const int aoff = lds_byte(wr * 64 + fr, fq * 8), boff = lds_byte(wc * 32 + fr, fq * 8);
#define PG8_SA(b, h) (((b) * 2 + (h)) * HTB)
#define PG8_SB(b, h) ((4 + (b) * 2 + (h)) * HTB)
#define PG8_STAGE(bufoff, gbase, voff) do { _Pragma("unroll") for (int _i = 0; _i < 2; ++_i) \
        __builtin_amdgcn_global_load_lds((const unsigned*)((const char*)(gbase) + (voff)[_i]), (LAS unsigned*)(lds + (bufoff) + ldsw + _i * 8192), 16, 0, 0); } while (0)
#define PG8_LDA(dst, b, h) do { _Pragma("unroll") for (int m = 0; m < 4; ++m) _Pragma("unroll") for (int k = 0; k < 2; ++k) dst[m][k] = *(const LAS h16x8*)(lds + PG8_SA(b, h) + aoff + m * 2048 + k * 1024); } while (0)
#define PG8_LDB(dst, b, h) do { _Pragma("unroll") for (int n = 0; n < 2; ++n) _Pragma("unroll") for (int k = 0; k < 2; ++k) dst[n][k] = *(const LAS h16x8*)(lds + PG8_SB(b, h) + boff + n * 2048 + k * 1024); } while (0)
#define PG8_MMA(ai, bj, At, Bt) do { __builtin_amdgcn_s_setprio(1); _Pragma("unroll") for (int m = 0; m < 4; ++m) _Pragma("unroll") for (int n = 0; n < 2; ++n) _Pragma("unroll") for (int k = 0; k < 2; ++k) \
        acc[ai][bj][m][n] = __builtin_amdgcn_mfma_f32_16x16x32_f16(Bt[n][k], At[m][k], acc[ai][bj][m][n], 0, 0, 0); __builtin_amdgcn_s_setprio(0); } while (0)
#define PG8_WAIT_V(n) asm volatile("s_waitcnt vmcnt(" #n ")" ::: "memory")
#define PG8_WAIT_L(n) asm volatile("s_waitcnt lgkmcnt(" #n ")" ::: "memory")
#define PG8_BAR __builtin_amdgcn_s_barrier()
#define PG8_SCHED __builtin_amdgcn_sched_barrier(0)
    Unit cur, nxt; int ui = 0;
    if (!S.next(0, cur)) return;
    f32x4 acc[2][2][4][2];
#pragma unroll
    for (int a = 0; a < 2; ++a)
#pragma unroll
        for (int b = 0; b < 2; ++b)
#pragma unroll
            for (int m = 0; m < 4; ++m)
#pragma unroll
                for (int n = 0; n < 2; ++n) acc[a][b][m][n] = (f32x4){0.f, 0.f, 0.f, 0.f};
    h16x8 At[4][2], B0[2][2], B1[2][2];
    const char* cA = (const char*)g.A + (size_t)cur.pm * tstepA; const char* cB = (const char*)g.Bt + (size_t)cur.pn * tstepB;
    S.a_ready(cur);
    if constexpr (SP2) {
        PG8_STAGE(PG8_SB(0, 0), cB, voffB); PG8_STAGE(PG8_SB(0, 1), cB + hstepB, voffB); PG8_STAGE(PG8_SA(0, 0), cA, voffA); PG8_STAGE(PG8_SA(0, 1), cA + hstepA, voffA);
        if (wr == 1) PG8_BAR;
        PG8_WAIT_V(2); PG8_BAR;
        PG8_STAGE(PG8_SB(1, 0), cB + kstep, voffB); PG8_STAGE(PG8_SA(1, 0), cA + kstep, voffA); PG8_STAGE(PG8_SB(1, 1), cB + hstepB + kstep, voffB);
        PG8_WAIT_V(6); PG8_BAR;
    } else {
        PG8_STAGE(PG8_SB(0, 0), cB, voffB); PG8_STAGE(PG8_SA(0, 0), cA, voffA); PG8_STAGE(PG8_SB(0, 1), cB + hstepB, voffB); PG8_STAGE(PG8_SA(0, 1), cA + hstepA, voffA);
        if (wr == 1) PG8_BAR;
        PG8_WAIT_V(4); PG8_BAR;
        PG8_STAGE(PG8_SB(1, 0), cB + kstep, voffB); PG8_STAGE(PG8_SA(1, 0), cA + kstep, voffA); PG8_STAGE(PG8_SB(1, 1), cB + hstepB + kstep, voffB);
        PG8_WAIT_V(6); PG8_BAR;
    }
    for (;;) {
        const bool has_next = S.next(ui + 1, nxt);
        const char* nA = has_next ? (const char*)g.A + (size_t)nxt.pm * tstepA : cA; const char* nB = has_next ? (const char*)g.Bt + (size_t)nxt.pn * tstepB : cB;
        for (int t = 0; t < nt; t += 2) {
            const bool last = (t == nt - 2);
            const char* a1 = cA + (size_t)(t + 1) * kstep;
            const char* a2 = last ? nA : cA + (size_t)(t + 2) * kstep; const char* b2 = last ? nB : cB + (size_t)(t + 2) * kstep;
            const char* a3 = a2 + kstep; const char* b3 = b2 + kstep;
            if (last && has_next) S.a_ready(nxt);
            if constexpr (SP2) {
            PG8_LDB(B0, 0, 0); PG8_LDB(B1, 0, 1); PG8_SCHED; PG8_LDA(At, 0, 0); PG8_STAGE(PG8_SA(1, 1), a1 + hstepA, voffA);
            PG8_WAIT_V(8); PG8_WAIT_L(0); PG8_BAR; PG8_MMA(0, 0, At, B0); PG8_MMA(0, 1, At, B1); PG8_BAR; PG8_SCHED;
            PG8_LDA(At, 0, 1); PG8_STAGE(PG8_SB(0, 0), b2, voffB); PG8_STAGE(PG8_SB(0, 1), b2 + hstepB, voffB); PG8_STAGE(PG8_SA(0, 0), a2, voffA);
            PG8_WAIT_V(8); PG8_WAIT_L(0); PG8_BAR; PG8_MMA(1, 0, At, B0); PG8_MMA(1, 1, At, B1); PG8_BAR; PG8_SCHED;
            PG8_LDB(B0, 1, 0); PG8_LDB(B1, 1, 1); PG8_SCHED; PG8_LDA(At, 1, 0); PG8_STAGE(PG8_SA(0, 1), a2 + hstepA, voffA);
            PG8_WAIT_V(8); PG8_WAIT_L(0); PG8_BAR; PG8_MMA(0, 0, At, B0); PG8_MMA(0, 1, At, B1); PG8_BAR; PG8_SCHED;
            PG8_LDA(At, 1, 1); PG8_STAGE(PG8_SB(1, 0), b3, voffB); PG8_STAGE(PG8_SB(1, 1), b3 + hstepB, voffB); PG8_STAGE(PG8_SA(1, 0), a3, voffA);
            PG8_WAIT_V(8); PG8_WAIT_L(0); PG8_BAR; PG8_MMA(1, 0, At, B0); PG8_MMA(1, 1, At, B1); PG8_BAR; PG8_SCHED;
            } else {
            PG8_LDB(B0, 0, 0); PG8_SCHED; PG8_LDA(At, 0, 0); PG8_STAGE(PG8_SA(1, 1), a1 + hstepA, voffA);
            PG8_WAIT_L(8); PG8_BAR; PG8_WAIT_L(0); PG8_MMA(0, 0, At, B0); PG8_BAR; PG8_SCHED;
            PG8_LDB(B1, 0, 1); PG8_STAGE(PG8_SB(0, 0), b2, voffB);
            PG8_BAR; PG8_WAIT_L(0); PG8_MMA(0, 1, At, B1); PG8_BAR;
            PG8_LDA(At, 0, 1); PG8_STAGE(PG8_SA(0, 0), a2, voffA);
            PG8_BAR; PG8_WAIT_L(0); PG8_MMA(1, 0, At, B0); PG8_BAR; PG8_SCHED;
            PG8_STAGE(PG8_SB(0, 1), b2 + hstepB, voffB);
            PG8_WAIT_V(6); PG8_BAR; PG8_MMA(1, 1, At, B1); PG8_BAR;
            PG8_LDB(B0, 1, 0); PG8_SCHED; PG8_LDA(At, 1, 0); PG8_STAGE(PG8_SA(0, 1), a2 + hstepA, voffA);
            PG8_WAIT_L(8); PG8_BAR; PG8_WAIT_L(0); PG8_MMA(0, 0, At, B0); PG8_BAR; PG8_SCHED;
            PG8_LDB(B1, 1, 1); PG8_STAGE(PG8_SB(1, 0), b3, voffB);
            PG8_BAR; PG8_WAIT_L(0); PG8_MMA(0, 1, At, B1); PG8_BAR;
            PG8_LDA(At, 1, 1); PG8_STAGE(PG8_SA(1, 0), a3, voffA);
            PG8_BAR; PG8_WAIT_L(0); PG8_MMA(1, 0, At, B0); PG8_BAR; PG8_SCHED;
            PG8_STAGE(PG8_SB(1, 1), b3 + hstepB, voffB);
            PG8_WAIT_V(6); PG8_BAR; PG8_MMA(1, 1, At, B1); PG8_BAR;
            }
        }
        if constexpr (ALIGN_EPI) { if (wr == 0) PG8_BAR; }
        if constexpr (!Epi::AFTER_DRAIN) { E(acc, cur, wr, wc, fr, fq); S.done(cur); }
        if (!has_next) break;
#pragma unroll
        for (int a = 0; a < 2; ++a)
#pragma unroll
            for (int b = 0; b < 2; ++b)
#pragma unroll
                for (int m = 0; m < 4; ++m)
#pragma unroll
                    for (int n = 0; n < 2; ++n) acc[a][b][m][n] = (f32x4){0.f, 0.f, 0.f, 0.f};
        cur = nxt; cA = nA; cB = nB; ++ui;
        if constexpr (ALIGN_EPI) { if (wr == 1) PG8_BAR; }
    }
    PG8_WAIT_V(0);
    if constexpr (!ALIGN_EPI) { if (wr == 0) PG8_BAR; }
    PG8_BAR;
#undef PG8_SA
#undef PG8_SB
#undef PG8_STAGE
#undef PG8_LDA
#undef PG8_LDB
#undef PG8_MMA
#undef PG8_WAIT_V
#undef PG8_WAIT_L
#undef PG8_BAR
#undef PG8_SCHED
}
}

struct Frame {
    float* out;
    unsigned char* ws;
    char* lds;
    int tid, lane, wave, G, bid;
    int vcu;
};

__device__ __forceinline__ float wave_sum(float v) {
#pragma unroll
    for (int o = 32; o >= 1; o >>= 1) v += __shfl_xor(v, o);
    return v;
}
__device__ __forceinline__ float wave_max(float v) {
#pragma unroll
    for (int o = 32; o >= 1; o >>= 1) v = fmaxf(v, __shfl_xor(v, o));
    return v;
}
__device__ __forceinline__ void wave_lds_fence() { __builtin_amdgcn_wave_barrier(); asm volatile("s_waitcnt lgkmcnt(0)" ::: "memory"); __builtin_amdgcn_wave_barrier(); }

__device__ __forceinline__ void sincos_d(double x, float& c, float& s) {
    const double TWO_OVER_PI = 0.63661977236758134308;
    const double PIO2_HI = 1.57079632679489655800e+00, PIO2_LO = 6.12323399573676603587e-17;
    const double q = __builtin_rint(x * TWO_OVER_PI);
    double y = __builtin_fma(-q, PIO2_HI, x); y = __builtin_fma(-q, PIO2_LO, y);
    const double y2 = y * y;
    double sp = 1.0 / 6227020800.0;
    sp = sp * y2 - 1.0 / 39916800.0; sp = sp * y2 + 1.0 / 362880.0; sp = sp * y2 - 1.0 / 5040.0; sp = sp * y2 + 1.0 / 120.0; sp = sp * y2 - 1.0 / 6.0; sp = sp * y2 * y + y;
    double cp = -1.0 / 87178291200.0;
    cp = cp * y2 + 1.0 / 479001600.0; cp = cp * y2 - 1.0 / 3628800.0; cp = cp * y2 + 1.0 / 40320.0; cp = cp * y2 - 1.0 / 720.0; cp = cp * y2 + 1.0 / 24.0; cp = cp * y2 - 0.5; cp = cp * y2 + 1.0;
    const long long qi = (long long)q; const int quad = (int)(qi & 3);
    double sv, cv;
    if (quad == 0) { sv = sp; cv = cp; } else if (quad == 1) { sv = cp; cv = -sp; } else if (quad == 2) { sv = -sp; cv = -cp; } else { sv = -cp; cv = sp; }
    c = (float)cv; s = (float)sv;
}

__device__ __forceinline__ int nsa_src_col(int n) { return n < 5120 ? n : (n < 7168 ? n + 48 : (n < 7216 ? n - 2048 : -1)); }
__device__ __forceinline__ void conv_transpose(const Frame& F, const float* W, int K, int Nsrc, h16* Wt, int Npad, int mapmode, int first, int stride, int t_begin = 0, int t_end = -1) {
    float* tile = (float*)F.lds;
    const int tk_n = K / 64, tn_n = Npad / 128, ntiles = (t_end < 0) ? tk_n * tn_n : t_end;
    f32x4 v[4];
#define CV_LOAD(it_) do { const int tk_ = (it_) / tn_n, tn_ = (it_) % tn_n; _Pragma("unroll") for (int i = 0; i < 4; ++i) { \
        const int idx = F.tid + i * NTHREADS, k = idx >> 5, n4 = (idx & 31) * 4; const int nn = tn_ * 128 + n4; const int src = mapmode ? nsa_src_col(nn) : nn; \
        v[i] = (f32x4){0.f, 0.f, 0.f, 0.f}; if (src >= 0 && src + 3 < Nsrc) v[i] = __builtin_nontemporal_load((const f32x4*)(W + (size_t)(tk_ * 64 + k) * Nsrc + src)); } } while (0)
    if (t_begin + first < ntiles) CV_LOAD(t_begin + first);
    for (int it = t_begin + first; it < ntiles; it += stride) {
        const int tk = it / tn_n, tn = it % tn_n;
        __syncthreads();
#pragma unroll
        for (int i = 0; i < 4; ++i) {
            const int idx = F.tid + i * NTHREADS, k = idx >> 5, n4 = (idx & 31) * 4;
            tile[k * 129 + n4] = v[i][0]; tile[k * 129 + n4 + 1] = v[i][1]; tile[k * 129 + n4 + 2] = v[i][2]; tile[k * 129 + n4 + 3] = v[i][3];
        }
        if (it + stride < ntiles) CV_LOAD(it + stride);
        __syncthreads();
#pragma unroll
        for (int i = 0; i < 2; ++i) {
            const int idx = F.tid + i * NTHREADS, n = idx >> 3, k8 = (idx & 7) * 8;
            h16x8 o;
#pragma unroll
            for (int e = 0; e < 8; ++e) o[e] = (h16)tile[(k8 + e) * 129 + n];
            *(h16x8*)(Wt + (size_t)(tn * 128 + n) * K + tk * 64 + k8) = o;
        }
    }
#undef CV_LOAD
    __syncthreads();
}
__device__ __forceinline__ void conv_layer_weights(const Frame& F, const Args& A, int L) {
    const int kind = L % 3, j = L / 3;
    h16* wtin = (h16*)(F.ws + WS_WTIN); h16* wtout = (h16*)(F.ws + WS_WTOUT);
    if (kind == 0) {
        conv_transpose(F, A.in[7] + (size_t)j * 2048 * 8192, 2048, 8192, wtin, 8192, 0, F.bid, F.G);
        conv_transpose(F, A.in[8] + (size_t)j * 2048 * 2048, 2048, 2048, wtout, 2048, 0, F.bid, F.G);
    } else if (kind == 1) {
        conv_transpose(F, A.in[9], 2048, 7216, wtin, NSA_NP, 1, F.bid, F.G);
        conv_transpose(F, A.in[10], 2048, 2048, wtout, 2048, 0, F.bid, F.G);
        conv_transpose(F, A.in[12], 4096, 256, (h16*)(F.ws + WS_W1T), 256, 0, F.bid, F.G);
        conv_transpose(F, A.in[14], 4096, 256, (h16*)(F.ws + WS_W1T) + (size_t)256 * 4096, 256, 0, F.bid, F.G);
    } else {
        conv_transpose(F, A.in[16], 2048, 12288, (h16*)(F.ws + WS_WTIN2), 12288, 0, F.bid, F.G, ret_early_a(F.G) + ret_early_b(F.G));
        conv_transpose(F, A.in[17], 4096, 2048, wtout, 2048, 0, F.bid, F.G);
    }
}

__device__ __forceinline__ void phase_prologue(const Frame& F, const Args& A) {
    {
        float* modp = (float*)(F.ws + WS_MODP);
        const float* c = A.in[1]; const float* aw = A.in[3];
        float* sc = (float*)F.lds;
        __syncthreads();
        for (int i = F.tid; i < 2048; i += NTHREADS) sc[i] = silu_f(c[i]);
        __syncthreads();
        if (F.bid == F.G - 1) { float* scg = (float*)(F.ws + WS_SC); for (int i = F.tid; i < 2048; i += NTHREADS) scg[i] = sc[i]; }
        for (int it = F.bid; it < 48; it += F.G) {
            const int layer = it / 48, r = it % 48, slice = r / 3, nch = r % 3, n = nch * 2048 + F.tid * 4;
            const float* w = aw + (size_t)layer * 2048 * 6144 + (size_t)(slice * 128) * 6144 + n;
            f32x4 a0 = (f32x4){0.f, 0.f, 0.f, 0.f}, a1 = a0;
#pragma unroll 8
            for (int k = 0; k < 128; k += 2) {
                a0 += __builtin_nontemporal_load((const f32x4*)(w + (size_t)k * 6144)) * sc[slice * 128 + k];
                a1 += __builtin_nontemporal_load((const f32x4*)(w + (size_t)(k + 1) * 6144)) * sc[slice * 128 + k + 1];
            }
            *(f32x4*)(modp + (size_t)(slice * 4 + layer) * 6144 + n) = a0 + a1;
        }
        __syncthreads();
    }
    {
        const int* pos = (const int*)A.in[2];
        f32x2* r16 = (f32x2*)(F.ws + WS_ROPE16); f32x2* r128 = (f32x2*)(F.ws + WS_ROPE128);
        for (int idx = (F.bid * NTHREADS + F.tid) * 2; idx < S * 16; idx += F.G * NTHREADS * 2) {
            const int t = idx >> 4, j = idx & 15; float c0, s0, c1, s1; sincos_d((double)pos[t] * A.inv16[j], c0, s0); sincos_d((double)pos[t] * A.inv16[j + 1], c1, s1);
            *(f32x4*)(r16 + idx) = (f32x4){c0, s0, c1, s1};
        }
        for (int idx = (F.bid * NTHREADS + F.tid) * 2; idx < S * 128; idx += F.G * NTHREADS * 2) {
            const int t = idx >> 7, j = idx & 127; float c0, s0, c1, s1; sincos_d((double)pos[t] * A.inv128[j], c0, s0); sincos_d((double)pos[t] * A.inv128[j + 1], c1, s1);
            *(f32x4*)(r128 + idx) = (f32x4){c0, s0, c1, s1};
        }
    }
    if (F.bid >= F.G - 16) {
        const int slice = F.bid - (F.G - 16), kv = F.tid >> 8, j = F.tid & 255; const float* w1 = (kv ? A.in[14] : A.in[12]) + (size_t)slice * 256 * 256; const float* pe = A.in[11] + slice * 256;
        float a0 = 0.f, a1 = 0.f;
#pragma unroll 8
        for (int i = 0; i < 256; i += 2) { a0 += pe[i] * w1[(size_t)i * 256 + j]; a1 += pe[i + 1] * w1[(size_t)(i + 1) * 256 + j]; }
        ((float*)(F.ws + WS_CMPB))[slice * 512 + F.tid] = a0 + a1;
    }
    conv_layer_weights(F, A, 0);
}

__device__ __forceinline__ void phase_norm(const Frame& F, const Args& A, int Lprev, int Lnext) {
    float* modl = (float*)F.lds;
#define NP(col) ((((col) >> 9) << 9) + ((((col) >> 2) & 1) << 8) + ((((col) & 511) >> 3) << 2) + ((col) & 3))
    const float* npost = A.in[6] + (Lprev >= 0 ? Lprev : 0) * 2048;
    const float* npre = A.in[5] + (Lnext >= 0 ? Lnext : 0) * 2048;
    const float* modp = (const float*)(F.ws + WS_MODP); const float* ab = A.in[4];
    __syncthreads();
    float* modf = (float*)(F.ws + WS_MODF);
    for (int i = F.tid; i < 6144; i += NTHREADS) {
        const int which = i >> 11, col = i & 2047;
        int layer, mcol;
        if (which == 0) { layer = Lprev; mcol = 4096 + col; } else if (which == 1) { layer = Lnext; mcol = 2048 + col; } else { layer = Lnext; mcol = col; }
        float v = 0.f;
        if (layer >= 0) {
            if (Lprev >= 0) v = modf[layer * 6144 + mcol];
            else { v = ab[layer * 6144 + mcol];
#pragma unroll
                for (int s = 0; s < 16; ++s) v += modp[(size_t)(s * 4 + layer) * 6144 + mcol]; }
        }
        modl[which * 2048 + NP(col)] = v;
    }
    for (int i = F.tid; i < 2048; i += NTHREADS) { modl[6144 + NP(i)] = npost[i]; modl[8192 + NP(i)] = npre[i]; }
    if (Lprev < 0) {
        for (int e = F.bid * NTHREADS + F.tid; e < 6144; e += F.G * NTHREADS) {
            float v = ab[e];
#pragma unroll
            for (int s = 0; s < 16; ++s) v += modp[(size_t)s * 4 * 6144 + e];
            modf[e] = v;
        }
        if (F.bid == F.G - 1) {
            const float* cb = (const float*)(F.ws + WS_CMPB); float v = 0.f;
#pragma unroll
            for (int s = 0; s < 16; ++s) v += cb[s * 512 + F.tid];
            ((float*)(F.ws + WS_CMPBF))[F.tid] = v;
        }
    }
    __syncthreads();
    const float* xin = A.in[0];
    const h16* Y = (const h16*)(F.ws + WS_Y);
    h16* H = (h16*)(F.ws + WS_H);
    h16* XS = (h16*)(F.ws + WS_XS);
    f32x4 xn[8]; h16x8 yn[4], xhn[4];
#define NORM_LOAD(tt) do { if (Lprev >= 1) { _Pragma("unroll") for (int j = 0; j < 4; ++j) xhn[j] = *(const h16x8*)(XS + (size_t)(tt) * D + j * 512 + F.lane * 8); } \
        else { _Pragma("unroll") for (int i = 0; i < 8; ++i) xn[i] = *(const f32x4*)(xin + (size_t)(tt) * D + (i >> 1) * 512 + F.lane * 8 + (i & 1) * 4); } \
        if (Lprev >= 0) { _Pragma("unroll") for (int j = 0; j < 4; ++j) yn[j] = *(const h16x8*)(Y + (size_t)(tt) * D + j * 512 + F.lane * 8); } } while (0)
    if (F.bid * 8 + F.wave < S) NORM_LOAD(F.bid * 8 + F.wave);
    for (int t = F.bid * 8 + F.wave; t < S; t += F.G * 8) {
        f32x4 x[8]; h16x8 yc[4];
        if (Lprev >= 1) {
#pragma unroll
            for (int j = 0; j < 4; ++j)
#pragma unroll
                for (int e = 0; e < 4; ++e) { x[2 * j][e] = (float)xhn[j][e]; x[2 * j + 1][e] = (float)xhn[j][4 + e]; }
        } else {
#pragma unroll
            for (int i = 0; i < 8; ++i) x[i] = xn[i];
        }
#pragma unroll
        for (int j = 0; j < 4; ++j) yc[j] = yn[j];
        if (t + F.G * 8 < S) NORM_LOAD(t + F.G * 8);
        __builtin_amdgcn_sched_barrier(0);
        if (Lprev >= 0) {
            f32x4 y[8]; float ss = 0.f;
#pragma unroll
            for (int j = 0; j < 4; ++j) { const h16x8 yh = yc[j];
#pragma unroll
                for (int e = 0; e < 4; ++e) { y[2 * j][e] = (float)yh[e]; y[2 * j + 1][e] = (float)yh[4 + e]; }
                ss += y[2 * j][0] * y[2 * j][0] + y[2 * j][1] * y[2 * j][1] + y[2 * j][2] * y[2 * j][2] + y[2 * j][3] * y[2 * j][3]
                    + y[2 * j + 1][0] * y[2 * j + 1][0] + y[2 * j + 1][1] * y[2 * j + 1][1] + y[2 * j + 1][2] * y[2 * j + 1][2] + y[2 * j + 1][3] * y[2 * j + 1][3]; }
            ss = wave_sum(ss);
            const float r = 1.0f / sqrtf(ss * (1.0f / D) + EPS);
#pragma unroll
            for (int i = 0; i < 8; ++i) {
                const int li = (i >> 1) * 512 + (i & 1) * 256 + F.lane * 4;
                const f32x4 g = *(const f32x4*)(modl + 6144 + li); const f32x4 gt = *(const f32x4*)(modl + li);
#pragma unroll
                for (int e = 0; e < 4; ++e) x[i][e] += gt[e] * (y[i][e] * r * g[e]);
                if (Lnext < 0) *(f32x4*)(F.out + (size_t)t * D + (i >> 1) * 512 + F.lane * 8 + (i & 1) * 4) = x[i];
            }
            if (Lnext >= 0) {
#pragma unroll
                for (int j = 0; j < 4; ++j) { h16x8 xv;
#pragma unroll
                    for (int e = 0; e < 4; ++e) { xv[e] = (h16)x[2 * j][e]; xv[4 + e] = (h16)x[2 * j + 1][e]; }
                    *(h16x8*)(XS + (size_t)t * D + j * 512 + F.lane * 8) = xv; }
            }
        }
        if (Lnext >= 0) {
            float ss = 0.f;
#pragma unroll
            for (int i = 0; i < 8; ++i) ss += x[i][0] * x[i][0] + x[i][1] * x[i][1] + x[i][2] * x[i][2] + x[i][3] * x[i][3];
            ss = wave_sum(ss);
            const float r = 1.0f / sqrtf(ss * (1.0f / D) + EPS);
#pragma unroll
            for (int j = 0; j < 4; ++j) {
                h16x8 hv;
#pragma unroll
                for (int hf = 0; hf < 2; ++hf) {
                    const int li = j * 512 + hf * 256 + F.lane * 4;
                    const f32x4 g = *(const f32x4*)(modl + 8192 + li); const f32x4 sc = *(const f32x4*)(modl + 2048 + li); const f32x4 sh = *(const f32x4*)(modl + 4096 + li);
#pragma unroll
                    for (int e = 0; e < 4; ++e) hv[4 * hf + e] = (h16)((x[2 * j + hf][e] * r * g[e]) * (1.0f + sc[e]) + sh[e]);
                }
                *(h16x8*)(H + (size_t)t * D + j * 512 + F.lane * 8) = hv;
            }
        }
    }
#undef NP
#undef NORM_LOAD
    __syncthreads();
    if (Lnext > 0) conv_layer_weights(F, A, Lnext);
}

__device__ __forceinline__ void phase_nsa_cmp_a(const Frame& F, const Args& Ar) {
    if (F.bid >= 64 && F.G > 64) {
        conv_transpose(F, Ar.in[16], 2048, 12288, (h16*)(F.ws + WS_WTIN2), 12288, 0, F.bid - 64, F.G - 64, ret_early_a(F.G), ret_early_a(F.G) + ret_early_b(F.G));
        return;
    }
    const int u = F.bid, have = u < 64, kv = (u >> 5) & 1, mt = (u >> 2) & 7, kp = u & 3;
    const h16* A = (const h16*)(F.ws + WS_QKV) + (size_t)16 * S * 128 + (size_t)kv * 4 * S * 128 + kp * 1024;
    const h16* Bt = (const h16*)(F.ws + WS_W1T) + (size_t)kv * 256 * 4096 + kp * 1024;
    pg8::Gemm g{A, Bt, 2048, 256, 1024, 2048, 4096}; pg8::OneUnit So{mt, 0, have};
    pg8::EpiStore E{(float*)(F.ws + WS_OR) + (size_t)(kv * 4 + kp) * 2048 * 256, 256, 1};
    pg8::gemm_phase<pg8::EpiStore, pg8::OneUnit, true, true>((LAS unsigned char*)F.lds, g, So, E);
}
__device__ __forceinline__ void phase_nsa_cmp_b(const Frame& F, const Args& A) {
    float* hid = (float*)F.lds;
    float* red = hid + 4096;
    const float* part = (const float*)(F.ws + WS_OR); const float* b1 = (const float*)(F.ws + WS_CMPBF);
    for (int it = F.bid; it < 256; it += F.G) {
        const int kv = it >> 7, r0 = (it & 127) * 16;
        const float* W2 = kv ? A.in[15] : A.in[13];
        h16* dst = (h16*)(F.ws + (kv ? WS_VCMP : WS_KCMP));
        __syncthreads();
#pragma unroll
        for (int k = 0; k < 2; ++k) {
            const int i4 = F.tid * 4 + 2048 * k, r = r0 + (i4 >> 8), j = i4 & 255;
            f32x4 v = *(const f32x4*)(b1 + kv * 256 + j);
#pragma unroll
            for (int kp = 0; kp < 4; ++kp) v += *(const f32x4*)(part + ((size_t)(kv * 4 + kp) * 2048 + r) * 256 + j);
#pragma unroll
            for (int e = 0; e < 4; ++e) v[e] = silu_f(v[e]);
            *(f32x4*)(hid + i4) = v;
        }
        __syncthreads();
        const int d4 = (F.lane & 31) * 4, jb = 32 * F.wave + 16 * (F.lane >> 5);
        f32x4 wv[16];
#pragma unroll
        for (int jj = 0; jj < 16; ++jj) wv[jj] = *(const f32x4*)(W2 + (size_t)(jb + jj) * 128 + d4);
#pragma unroll
        for (int row = 0; row < 16; ++row) {
            f32x4 a = (f32x4){0.f, 0.f, 0.f, 0.f};
#pragma unroll
            for (int q = 0; q < 4; ++q) { const f32x4 hq = *(const f32x4*)(hid + row * 256 + jb + 4 * q);
                a += wv[4 * q] * hq[0] + wv[4 * q + 1] * hq[1] + wv[4 * q + 2] * hq[2] + wv[4 * q + 3] * hq[3]; }
#pragma unroll
            for (int e = 0; e < 4; ++e) a[e] += __shfl_xor(a[e], 32);
            if (F.lane < 32) *(f32x4*)(red + (F.wave * 16 + row) * 128 + d4) = a;
        }
        __syncthreads();
        { const int row = F.tid >> 5, dd = (F.tid & 31) * 4, r = r0 + row; f32x4 sm = (f32x4){0.f, 0.f, 0.f, 0.f};
#pragma unroll
          for (int w = 0; w < 8; ++w) sm += *(const f32x4*)(red + (w * 16 + row) * 128 + dd);
          h16x4 o;
#pragma unroll
          for (int e = 0; e < 4; ++e) o[e] = ((r & 511) < NC) ? (h16)sm[e] : (h16)0.f;
          *(h16x4*)(dst + (size_t)r * 128 + dd) = o; }
    }
}

namespace fa {
typedef float f32x16 __attribute__((ext_vector_type(16)));
typedef unsigned u32x2 __attribute__((ext_vector_type(2)));
constexpr float LOG2E = 1.4426950408889634f;
constexpr float MASKV = -3.0e38f;
constexpr int KROW = 256, VROW = 256;
constexpr int KT_BYTES = 64 * KROW, BUF_BYTES = KT_BYTES + 64 * VROW;
typedef short s16x4v __attribute__((__vector_size__(4 * sizeof(short))));
constexpr int LDS_IMP = 2 * BUF_BYTES;
constexpr int LDS_SELW = LDS_IMP + 32768;
constexpr int LDS_SV = LDS_SELW + 1024;
static_assert(LDS_SV + 4096 <= MISC_OFF, "attention LDS map");

__device__ __forceinline__ void stage_dma(LAS unsigned char* buf, const h16* Kg, const h16* Vg, int j, int wave, int lane) {
    asm volatile("" : "+v"(lane));
#pragma unroll
    for (int i = 0; i < 2; ++i) {
        const int o = wave * 2048 + i * 1024, row = (o >> 8) + (lane >> 4), p = lane & 15;
        const h16* ks = Kg + (size_t)(j * 64 + row) * 128 + (p ^ (row & 15)) * 8;
        const h16* vs = Vg + (size_t)(j * 64 + row) * 128 + (p ^ ((row & 3) << 2)) * 8;
        __builtin_amdgcn_global_load_lds((const unsigned*)ks, (LAS unsigned*)(buf + o), 16, 0, 0);
        __builtin_amdgcn_global_load_lds((const unsigned*)vs, (LAS unsigned*)(buf + KT_BYTES + o), 16, 0, 0);
    }
}

template <int MODE>
__device__ __forceinline__ void tile_compute(const LAS unsigned char* buf, int j, const h16x8 (&qf)[8], f32x16 (&o)[4], float& m, float& l,
                                             bool on, int lo, int hi, int lane, float inv_l, LAS float* imp_q) {
    const int r31 = lane & 31, h = lane >> 5, k0 = j * 64;
    const bool need = on && (k0 <= hi) && (k0 + 63 >= lo);
    if (__ballot(need) == 0ull) return;
    const bool full = (k0 >= lo) && (k0 + 63 <= hi);
    const bool simple = (__ballot(on && !full) == 0ull);
    const bool skip = simple && !on;
    const float base = (MODE == 2 || m > 0.5f * NEGF) ? m : 0.f;
    const float init = skip ? -BIGF : -base;
    f32x16 s0, s1;
#pragma unroll
    for (int r = 0; r < 16; ++r) { s0[r] = init; s1[r] = init; }
    const LAS unsigned char* kp = buf + r31 * KROW;
    const int ksw = r31 & 15;
    {
        h16x8 ka[2][4];
#pragma unroll
        for (int e = 0; e < 2; ++e) { const int po = (((2 * e + h) ^ ksw) << 4); ka[0][2 * e] = *(const LAS h16x8*)(kp + po); ka[0][2 * e + 1] = *(const LAS h16x8*)(kp + 32 * KROW + po); }
#pragma unroll
        for (int g = 0; g < 4; ++g) {
            if (g < 3) {
#pragma unroll
                for (int e = 0; e < 2; ++e) { const int po = (((2 * (2 * (g + 1) + e) + h) ^ ksw) << 4); ka[(g + 1) & 1][2 * e] = *(const LAS h16x8*)(kp + po); ka[(g + 1) & 1][2 * e + 1] = *(const LAS h16x8*)(kp + 32 * KROW + po); }
            }
#pragma unroll
            for (int e = 0; e < 2; ++e) {
                s0 = __builtin_amdgcn_mfma_f32_32x32x16_f16(ka[g & 1][2 * e], qf[2 * g + e], s0, 0, 0, 0);
                s1 = __builtin_amdgcn_mfma_f32_32x32x16_f16(ka[g & 1][2 * e + 1], qf[2 * g + e], s1, 0, 0, 0);
            }
            __builtin_amdgcn_sched_barrier(0);
        }
    }
    if (!simple) {
        const int lo_e = lo < 0 ? 0 : lo;
        const unsigned span = (on && hi >= lo_e) ? (unsigned)(hi - lo_e) : 0u;
        const int a0 = (on && hi >= lo_e) ? lo_e - (k0 + 4 * h) : 1000;
#pragma unroll
        for (int r = 0; r < 16; ++r) {
            const int c = (r & 3) + 8 * (r >> 2);
            s0[r] = ((unsigned)(c - a0) <= span) ? s0[r] : MASKV; s1[r] = ((unsigned)(c + 32 - a0) <= span) ? s1[r] : MASKV;
        }
    }
    if (MODE != 2) {
        float tm;
        {
            float c4[4];
#pragma unroll
            for (int c = 0; c < 4; ++c) { const f32x16& sv = (c < 2) ? s0 : s1; const int b8 = 8 * (c & 1);
                float x = fmaxf(fmaxf(sv[b8], sv[b8 + 1]), sv[b8 + 2]); x = fmaxf(fmaxf(x, sv[b8 + 3]), sv[b8 + 4]); x = fmaxf(fmaxf(x, sv[b8 + 5]), sv[b8 + 6]); c4[c] = fmaxf(x, sv[b8 + 7]); }
            tm = fmaxf(fmaxf(fmaxf(c4[0], c4[1]), c4[2]), c4[3]);
        }
        const float tmax = (skip || !(tm > 0.5f * NEGF)) ? NEGF : tm + base;
        const float tmx = fmaxf(tmax, __shfl_xor(tmax, 32));
        const float m_new = (tmx > m + 8.0f) ? tmx : m;
        const float alpha = __builtin_amdgcn_exp2f(m - m_new);
        const float d = skip ? 0.f : (m_new - base);
        if (__ballot(d != 0.f) != 0ull) {
#pragma unroll
            for (int r = 0; r < 16; ++r) { s0[r] -= d; s1[r] -= d; }
        }
        f32x2 sa = (f32x2){0.f, 0.f}, sb = (f32x2){0.f, 0.f};
#pragma unroll
        for (int r = 0; r < 16; ++r) { s0[r] = __builtin_amdgcn_exp2f(s0[r]); s1[r] = __builtin_amdgcn_exp2f(s1[r]); }
#pragma unroll
        for (int r = 0; r < 8; ++r) { sa += (f32x2){s0[2 * r], s0[2 * r + 1]}; sb += (f32x2){s1[2 * r], s1[2 * r + 1]}; }
        l = l * alpha + ((sa[0] + sa[1]) + (sb[0] + sb[1]));
        const bool grew = m_new > m; m = m_new;
        if (MODE == 1) return;
        if (__ballot(grew) != 0ull) {
#pragma unroll
            for (int dt = 0; dt < 4; ++dt) o[dt] = o[dt] * alpha;
        }
    } else {
#pragma unroll
        for (int r = 0; r < 16; ++r) {
            s0[r] = __builtin_amdgcn_exp2f(s0[r]);
            s1[r] = __builtin_amdgcn_exp2f(s1[r]);
        }
#pragma unroll
        for (int c = 0; c < 4; ++c) {
            const int sa = 16 * j + 2 * c + h, sb = sa + 8;
            const float a0 = s0[4 * c] + s0[4 * c + 1] + s0[4 * c + 2] + 0.5f * s0[4 * c + 3], b0 = 0.5f * s0[4 * c + 3];
            const float a1 = s1[4 * c] + s1[4 * c + 1] + s1[4 * c + 2] + 0.5f * s1[4 * c + 3], b1 = 0.5f * s1[4 * c + 3];
            (void)__hip_atomic_fetch_add(imp_q + sa, a0, __ATOMIC_RELAXED, __HIP_MEMORY_SCOPE_WORKGROUP); if (sa + 1 < 128) (void)__hip_atomic_fetch_add(imp_q + sa + 1, b0, __ATOMIC_RELAXED, __HIP_MEMORY_SCOPE_WORKGROUP);
            (void)__hip_atomic_fetch_add(imp_q + sb, a1, __ATOMIC_RELAXED, __HIP_MEMORY_SCOPE_WORKGROUP); if (sb + 1 < 128) (void)__hip_atomic_fetch_add(imp_q + sb + 1, b1, __ATOMIC_RELAXED, __HIP_MEMORY_SCOPE_WORKGROUP);
        }
    }
    h16x8 pb[2][2];
#pragma unroll
    for (int sp = 0; sp < 2; ++sp)
#pragma unroll
        for (int jj = 0; jj < 8; ++jj) { pb[0][sp][jj] = (h16)s0[8 * sp + jj]; pb[1][sp][jj] = (h16)s1[8 * sp + jj]; }
    const int vq = (lane & 15) >> 2;
    const LAS unsigned char* vrow = buf + KT_BYTES + (4 * h + vq) * VROW + ((2 * ((lane >> 4) & 1) + ((lane & 3) >> 1)) << 4) + 8 * (lane & 1);
    {
        s16x4v vr[2][8];
#pragma unroll
        for (int f = 0; f < 4; ++f) { const LAS unsigned char* vp = vrow + 16 * f * VROW + ((0 ^ vq) << 6);
            vr[0][2 * f] = __builtin_amdgcn_ds_read_tr16_b64_v4i16((LAS s16x4v*)vp); vr[0][2 * f + 1] = __builtin_amdgcn_ds_read_tr16_b64_v4i16((LAS s16x4v*)(vp + 8 * VROW)); }
#pragma unroll
        for (int dt = 0; dt < 4; ++dt) {
            if (dt < 3) {
#pragma unroll
                for (int f = 0; f < 4; ++f) { const LAS unsigned char* vp = vrow + 16 * f * VROW + (((dt + 1) ^ vq) << 6);
                    vr[(dt + 1) & 1][2 * f] = __builtin_amdgcn_ds_read_tr16_b64_v4i16((LAS s16x4v*)vp); vr[(dt + 1) & 1][2 * f + 1] = __builtin_amdgcn_ds_read_tr16_b64_v4i16((LAS s16x4v*)(vp + 8 * VROW)); }
            }
#pragma unroll
            for (int f = 0; f < 4; ++f) {
                const h16x4 l4 = __builtin_bit_cast(h16x4, vr[dt & 1][2 * f]), h4 = __builtin_bit_cast(h16x4, vr[dt & 1][2 * f + 1]);
                h16x8 va; va[0] = l4[0]; va[1] = l4[1]; va[2] = l4[2]; va[3] = l4[3]; va[4] = h4[0]; va[5] = h4[1]; va[6] = h4[2]; va[7] = h4[3];
                o[dt] = __builtin_amdgcn_mfma_f32_32x32x16_f16(va, pb[f >> 1][f & 1], o[dt], 0, 0, 0);
            }
            __builtin_amdgcn_sched_barrier(0);
        }
    }
}

template <int MODE, class OnFn>
__device__ __forceinline__ void stream(LAS unsigned char* lds, const h16* Kg, const h16* VTg, int jlo, int jhi, const h16x8 (&qf)[8],
                                       f32x16 (&o)[4], float& m, float& l, int lo, int hi, const OnFn& on_fn, int tid, int lane, float inv_l, LAS float* imp_q, bool first_in_flight = false) {
    if (jlo >= jhi) return;
    const int wave = __builtin_amdgcn_readfirstlane(tid >> 6);
    if (!first_in_flight) stage_dma(lds, Kg, VTg, jlo, wave, lane);
    __syncthreads();
    for (int j = jlo; j < jhi; ++j) {
        const int cur = (j - jlo) & 1;
        if (j + 1 < jhi) stage_dma(lds + (cur ^ 1) * BUF_BYTES, Kg, VTg, j + 1, wave, lane);
        tile_compute<MODE>(lds + cur * BUF_BYTES, j, qf, o, m, l, on_fn(j), lo, hi, lane, inv_l, imp_q);
        __syncthreads();
    }
}

__device__ __forceinline__ void load_q(h16x8 (&qf)[8], const h16* qrow, int h) {
#pragma unroll
    for (int s = 0; s < 8; ++s) qf[s] = *(const h16x8*)(qrow + 16 * s + 8 * h);
}
__device__ __forceinline__ void zero_o(f32x16 (&o)[4]) {
#pragma unroll
    for (int dt = 0; dt < 4; ++dt)
#pragma unroll
        for (int r = 0; r < 16; ++r) o[dt][r] = 0.f;
}
__device__ __forceinline__ h16x8 pack_swap(const f32x16& od, int cp, float sc, float sub = 0.f) {
    h16x4 A, B;
#pragma unroll
    for (int e = 0; e < 4; ++e) { A[e] = (h16)((od[8 * cp + e] - sub) * sc); B[e] = (h16)((od[8 * cp + 4 + e] - sub) * sc); }
    const u32x2 a = __builtin_bit_cast(u32x2, A), b = __builtin_bit_cast(u32x2, B);
    const auto r0 = __builtin_amdgcn_permlane32_swap(a[0], b[0], false, false), r1 = __builtin_amdgcn_permlane32_swap(a[1], b[1], false, false);
    const u32x4 w = (u32x4){r0[0], r1[0], r0[1], r1[1]};
    return __builtin_bit_cast(h16x8, w);
}
}

struct MobaOn { unsigned selmask; int b; __device__ __forceinline__ bool operator()(int j) const { const int jb = j >> 2; return jb == b ? true : (((selmask >> jb) & 1u) != 0u); } };
__device__ __forceinline__ void phase_moba_attn_mfma(const Frame& F) {
    const h16* Q = (const h16*)(F.ws + WS_QKV); const h16* K = Q + (size_t)16 * S * 128; const h16* VT = K + (size_t)16 * S * 128; const h16* Z = VT + (size_t)16 * S * 128;
    const float* kmean = (const float*)(F.ws + WS_KMEAN);
    h16* OZ = (h16*)(F.ws + WS_OZ);
    LAS unsigned char* lds = (LAS unsigned char*)F.lds;
    const int lane = F.lane, r31 = lane & 31, h = lane >> 5;
    for (int it = F.bid; it < 256; it += F.G) {
        const int head = it >> 4, pi = it & 15;
#pragma unroll 1
        for (int half = 0; half < 2; ++half) {
            const int b = half ? 31 - pi : pi;
            const int t = b * 256 + F.wave * 32 + r31;
            h16x8 qf[8]; fa::load_q(qf, Q + ((size_t)head * S + t) * 128, h);
            LAS float* kml = (LAS float*)(lds + 2 * fa::BUF_BYTES);
            __syncthreads();
            for (int i = F.tid; i < b * 32; i += NTHREADS) { const float* km = kmean + (size_t)head * 32 * 128 + i * 4; *(LAS f32x4*)(kml + i * 4) = *(const f32x4*)km + *(const f32x4*)(km + 65536); }
            __syncthreads();
            float v0 = NEGF, v1 = NEGF, v2 = NEGF; int i0 = -1, i1 = -1, i2 = -1;
            for (int jb = 0; jb < b; ++jb) {
                const LAS float* km = kml + jb * 128 + 8 * h;
                float d = 0.f;
#pragma unroll
                for (int s = 0; s < 8; ++s) { const f32x4 ka = *(const LAS f32x4*)(km + 16 * s), kb = *(const LAS f32x4*)(km + 16 * s + 4);
                    d += (float)qf[s][0] * ka[0] + (float)qf[s][1] * ka[1] + (float)qf[s][2] * ka[2] + (float)qf[s][3] * ka[3] + (float)qf[s][4] * kb[0] + (float)qf[s][5] * kb[1] + (float)qf[s][6] * kb[2] + (float)qf[s][7] * kb[3]; }
                d += __shfl_xor(d, 32);
                if (d > v0) { v2 = v1; i2 = i1; v1 = v0; i1 = i0; v0 = d; i0 = jb; }
                else if (d > v1) { v2 = v1; i2 = i1; v1 = d; i1 = jb; }
                else if (d > v2) { v2 = d; i2 = jb; }
            }
            MobaOn on; on.b = b; on.selmask = (i0 >= 0 ? 1u << i0 : 0u) | (i1 >= 0 ? 1u << i1 : 0u) | (i2 >= 0 ? 1u << i2 : 0u);
            fa::f32x16 o[4]; fa::zero_o(o); float m = NEGF, l = 0.f;
            fa::stream<0>(lds, K + (size_t)head * S * 128, VT + (size_t)head * S * 128, 0, 4 * b + 4, qf, o, m, l, 0, t, on, F.tid, lane, 0.f, (LAS float*)nullptr);
            l += __shfl_xor(l, 32);
            const float inv = 1.0f / fmaxf(l, 1e-30f);
#pragma unroll
            for (int dt = 0; dt < 4; ++dt)
#pragma unroll
                for (int c = 0; c < 4; ++c) {
                    const int d = 32 * dt + 8 * c + 4 * h; const size_t off = (size_t)t * 2048 + head * 128 + d;
                    const h16x4 zz = *(const h16x4*)(Z + off); h16x4 ov;
#pragma unroll
                    for (int e = 0; e < 4; ++e) ov[e] = (h16)(o[dt][4 * c + e] * inv * (float)zz[e]);
                    *(h16x4*)(OZ + off) = ov;
                }
        }
    }
}

constexpr size_t WS_MLIST = WS_P;
constexpr size_t WS_MPO = WS_P + 16 * MiB;
constexpr size_t WS_MPML = WS_P + 144 * MiB;
constexpr int CW_MCNT = 8192;
struct ValidOn { bool v; __device__ __forceinline__ bool operator()(int) const { return v; } };

__device__ __forceinline__ void phase_moba_gate(const Frame& F, int jl) {
    const h16* Q = (const h16*)(F.ws + WS_QKV);
    const float* kmean = (const float*)(F.ws + WS_KMEAN);
    unsigned* cnt = (unsigned*)(F.ws + WS_CTL) + CW_MCNT + jl * 512;
    unsigned* list = (unsigned*)(F.ws + WS_MLIST);
    LAS unsigned char* lds = (LAS unsigned char*)F.lds;
    LAS float* kml = (LAS float*)lds;
    const int lane = F.lane, r31 = lane & 31, h = lane >> 5;
    for (int it = F.bid; it < 496; it += F.G) {
        const int head = it / 31, b = it % 31 + 1;
        const int t = b * 256 + F.wave * 32 + r31;
        h16x8 qf[8]; fa::load_q(qf, Q + ((size_t)head * S + t) * 128, h);
        __syncthreads();
        { const int row = F.tid >> 4, ch = F.tid & 15; const float* km = kmean + ((size_t)head * 32 + row) * 128 + ch * 8;
          const f32x4 m0 = *(const f32x4*)km + *(const f32x4*)(km + 65536), m1 = *(const f32x4*)(km + 4) + *(const f32x4*)(km + 4 + 65536);
          h16x8 hi, lo;
#pragma unroll
          for (int e = 0; e < 4; ++e) { hi[e] = (h16)m0[e]; lo[e] = (h16)(m0[e] - (float)hi[e]); hi[4 + e] = (h16)m1[e]; lo[4 + e] = (h16)(m1[e] - (float)hi[4 + e]); }
          const int pos = row * 256 + ((ch ^ (row & 15)) << 4);
          *(LAS h16x8*)(lds + pos) = hi; *(LAS h16x8*)(lds + 8192 + pos) = lo; }
        __syncthreads();
        fa::f32x16 sc;
#pragma unroll
        for (int r = 0; r < 16; ++r) sc[r] = 0.f;
        { const LAS unsigned char* kp = lds + r31 * 256; const int ksw = r31 & 15;
#pragma unroll
          for (int ks = 0; ks < 8; ++ks) { const int po = ((2 * ks + h) ^ ksw) << 4;
              sc = __builtin_amdgcn_mfma_f32_32x32x16_f16(*(const LAS h16x8*)(kp + po), qf[ks], sc, 0, 0, 0);
              sc = __builtin_amdgcn_mfma_f32_32x32x16_f16(*(const LAS h16x8*)(kp + 8192 + po), qf[ks], sc, 0, 0, 0); } }
        float v0 = NEGF, v1 = NEGF, v2 = NEGF; int i0 = -1, i1 = -1, i2 = -1;
#define TOP3_INS(dv, di) do { const float d_ = (dv); const int j_ = (di); \
            if (d_ > v0) { v2 = v1; i2 = i1; v1 = v0; i1 = i0; v0 = d_; i0 = j_; } else if (d_ > v1) { v2 = v1; i2 = i1; v1 = d_; i1 = j_; } else if (d_ > v2) { v2 = d_; i2 = j_; } } while (0)
#pragma unroll
        for (int r = 0; r < 16; ++r) { const int jb = (r & 3) + 8 * (r >> 2) + 4 * h; TOP3_INS(jb < b ? sc[r] : NEGF, jb); }
        { const float p0 = __shfl_xor(v0, 32), p1 = __shfl_xor(v1, 32), p2 = __shfl_xor(v2, 32); const int q0 = __shfl_xor(i0, 32), q1 = __shfl_xor(i1, 32), q2 = __shfl_xor(i2, 32);
          TOP3_INS(p0, q0); TOP3_INS(p1, q1); TOP3_INS(p2, q2); }
#undef TOP3_INS
        const unsigned long long below = (lane == 0) ? 0ull : (~0ull >> (64 - lane));
        unsigned cntv = 0u; int rk0 = 0, rk1 = 0, rk2 = 0;
        for (int jb = 0; jb < b; ++jb) {
            const bool s0_ = (h == 0) && (i0 == jb), s1_ = (h == 0) && (i1 == jb), s2_ = (h == 0) && (i2 == jb);
            const unsigned long long mk = __ballot(s0_ || s1_ || s2_);
            const int rk = __popcll(mk & below);
            if (s0_) rk0 = rk; if (s1_) rk1 = rk; if (s2_) rk2 = rk;
            if (lane == jb) cntv = (unsigned)__popcll(mk);
        }
        unsigned base = 0u;
        if (lane < b && cntv != 0u) base = __hip_atomic_fetch_add(cnt + head * 32 + lane, cntv, __ATOMIC_RELAXED, __HIP_MEMORY_SCOPE_AGENT);
        const unsigned b0 = __shfl(base, i0 >= 0 ? i0 : 0), b1 = __shfl(base, i1 >= 0 ? i1 : 0), b2 = __shfl(base, i2 >= 0 ? i2 : 0);
        if (h == 0) {
            if (i0 >= 0) list[((size_t)head * 32 + i0) * 8192 + b0 + rk0] = (unsigned)t;
            if (i1 >= 0) list[((size_t)head * 32 + i1) * 8192 + b1 + rk1] = (unsigned)t | (1u << 16);
            if (i2 >= 0) list[((size_t)head * 32 + i2) * 8192 + b2 + rk2] = (unsigned)t | (2u << 16);
        }
    }
}

constexpr int CW_MQ = 9216;
constexpr int MR = 4;
__device__ __forceinline__ void phase_moba_attn_sparse(const Frame& F, const Args& Ar, int jl) {
    const h16* Q = (const h16*)(F.ws + WS_QKV); const h16* K = Q + (size_t)16 * S * 128; const h16* V = K + (size_t)16 * S * 128;
    const unsigned* cnt = (const unsigned*)(F.ws + WS_CTL) + CW_MCNT + jl * 512;
    unsigned* qctr = (unsigned*)(F.ws + WS_CTL) + CW_MQ + jl;
    const unsigned* list = (const unsigned*)(F.ws + WS_MLIST);
    h16* PO = (h16*)(F.ws + WS_MPO); float* PML = (float*)(F.ws + WS_MPML);
    LAS unsigned char* lds = (LAS unsigned char*)F.lds;
    LAS unsigned* pre = (LAS unsigned*)(lds + 4 * fa::BUF_BYTES);
    LAS unsigned* wsum = pre + 516;
    LAS unsigned* tick = pre + 524;
    static_assert(4 * fa::BUF_BYTES + 526 * 4 <= MISC_OFF, "block-resident MoBA LDS map");
    const int lane = F.lane, r31 = lane & 31, h = lane >> 5;
    __syncthreads();
    { const unsigned n = cnt[F.tid]; const unsigned nch = (n + 255u) >> 8; const unsigned u = (nch + MR - 1) / MR; unsigned x = u;
#pragma unroll
      for (int o = 1; o < 64; o <<= 1) { const unsigned y = __shfl_up(x, o); if (lane >= o) x += y; }
      if (lane == 63) wsum[F.wave] = x;
      __syncthreads();
      unsigned off = 0u;
      for (int w = 0; w < F.wave; ++w) off += wsum[w];
      pre[F.tid] = off + x - u;
      if (F.tid == NTHREADS - 1) pre[512] = off + x;
      __syncthreads(); }
    const unsigned TG = pre[512], TT = TG + 512u;
    unsigned nxt = 0u;
    if (F.tid == 0) nxt = __hip_atomic_fetch_add(qctr, 1u, __ATOMIC_RELAXED, __HIP_MEMORY_SCOPE_AGENT);
    for (;;) {
        __syncthreads();
        if (F.tid == 0) tick[0] = nxt;
        __syncthreads();
        const unsigned tkx = tick[0];
        const unsigned NM = (jl == 0) ? 576u : 0u;
        const unsigned q5 = tkx / 5u, r5 = tkx - q5 * 5u, mi = 2u * q5 + (r5 == 3u ? 1u : 0u);
        const bool is_mem = (r5 == 1u || r5 == 3u) && mi < NM;
        unsigned nmb = 2u * q5 + (r5 > 1u ? 1u : 0u) + (r5 > 3u ? 1u : 0u); if (nmb > NM) nmb = NM;
        const unsigned tk = tkx - nmb;
        if (!is_mem && tk >= TT && tkx >= (NM * 5u + 1u) / 2u) break;
        if (F.tid == 0) nxt = __hip_atomic_fetch_add(qctr, 1u, __ATOMIC_RELAXED, __HIP_MEMORY_SCOPE_AGENT);
        if (!is_mem && tk >= TT) continue;
        if (is_mem) {
            const int m_ = (int)mi, layer = 1 + m_ / 192, rr = m_ % 192, sl = rr / 3, nch = rr % 3;
            const float* w = Ar.in[3] + (size_t)layer * 2048 * 6144 + (size_t)(sl * 32) * 6144 + nch * 2048 + F.tid * 4;
            const float* scg = (const float*)(F.ws + WS_SC) + sl * 32;
            f32x4 a0 = (f32x4){0.f, 0.f, 0.f, 0.f}, a1 = a0;
#pragma unroll 8
            for (int k = 0; k < 32; k += 2) {
                a0 += __builtin_nontemporal_load((const f32x4*)(w + (size_t)k * 6144)) * scg[k];
                a1 += __builtin_nontemporal_load((const f32x4*)(w + (size_t)(k + 1) * 6144)) * scg[k + 1];
            }
            *(f32x4*)((float*)(F.ws + WS_MODP1) + ((size_t)((layer - 1) * 64 + sl)) * 6144 + nch * 2048 + F.tid * 4) = a0 + a1;
            continue;
        }
        int head, jt0, li, nchunk; unsigned e0;
        if (tk >= TG) { const int u = (int)(tk - TG); head = u >> 5; jt0 = 4 * (u & 31); li = -1; e0 = 0u; nchunk = 1; }
        else { int lo2 = 0, hi2 = 512;
            while (hi2 - lo2 > 1) { const int mid = (lo2 + hi2) >> 1; if (pre[mid] <= tk) lo2 = mid; else hi2 = mid; }
            li = lo2; head = lo2 >> 5; jt0 = 4 * (lo2 & 31);
            const int c0 = (int)(tk - pre[lo2]) * MR, nch = (int)((cnt[li] + 255u) >> 8);
            e0 = (unsigned)c0 * 256u; nchunk = (nch - c0) < MR ? (nch - c0) : MR; }
#pragma unroll
        for (int j = 0; j < 4; ++j) fa::stage_dma(lds + j * fa::BUF_BYTES, K + (size_t)head * S * 128, V + (size_t)head * S * 128, jt0 + j, F.wave, lane);
        __syncthreads();
        for (int ch = 0; ch < nchunk; ++ch) {
            int slot = 3, t; bool valid = true;
            if (li < 0) { t = (jt0 >> 2) * 256 + F.wave * 32 + r31; }
            else {
                const unsigned e = e0 + (unsigned)ch * 256u + F.wave * 32 + r31, n = cnt[li];
                valid = e < n;
                const unsigned ent = valid ? list[(size_t)li * 8192 + e] : 0u;
                t = (int)(ent & 0xFFFFu); slot = (int)(ent >> 16);
            }
            h16x8 qf[8]; fa::load_q(qf, Q + ((size_t)head * S + t) * 128, h);
            fa::f32x16 o[4]; fa::zero_o(o); float m = NEGF, l = 0.f;
            const int hi = (li < 0) ? t : S;
#pragma unroll 1
            for (int j = 0; j < 4; ++j) fa::tile_compute<0>(lds + j * fa::BUF_BYTES, jt0 + j, qf, o, m, l, valid, 0, hi, lane, 0.f, (LAS float*)nullptr);
            l += __shfl_xor(l, 32);
            {
                const float inv = 1.0f / fmaxf(l, 1e-30f);
                const size_t pidx = ((size_t)t * 16 + head) * 4 + slot;
#pragma unroll
                for (int dt = 0; dt < 4; ++dt)
#pragma unroll
                    for (int cp = 0; cp < 2; ++cp) { const h16x8 w = fa::pack_swap(o[dt], cp, inv); if (valid) *(h16x8*)(PO + pidx * 128 + 32 * dt + 16 * cp + 8 * h) = w; }
                if (valid && h == 0) *(f32x2*)(PML + pidx * 2) = (f32x2){m, l};
            }
        }
    }
}

__device__ __forceinline__ void phase_moba_merge(const Frame& F, const Args& Ar, int jl) {
    if (jl == 0) {
        const float* ab = Ar.in[4]; const float* p1b = (const float*)(F.ws + WS_MODP1); float* modf = (float*)(F.ws + WS_MODF);
        for (int e = F.bid * NTHREADS + F.tid; e < 3 * 6144; e += F.G * NTHREADS) {
            const int layer = 1 + e / 6144, col = e % 6144; const float* p1 = p1b + (size_t)(layer - 1) * 64 * 6144 + col;
            float v = ab[layer * 6144 + col];
#pragma unroll 16
            for (int sl = 0; sl < 64; ++sl) v += p1[(size_t)sl * 6144];
            modf[layer * 6144 + col] = v;
        }
    }
    const h16* __restrict__ Z = (const h16*)(F.ws + WS_QKV) + (size_t)48 * S * 128;
    const h16* __restrict__ PO = (const h16*)(F.ws + WS_MPO); const float* __restrict__ PML = (const float*)(F.ws + WS_MPML);
    h16* __restrict__ OZ = (h16*)(F.ws + WS_OZ);
    const int sub = F.lane >> 4, dc = (F.lane & 15) * 8;
    const int stride = F.G * 8 * 4;
    for (int p0 = (F.bid * 8 + F.wave) * 4; p0 < S * 16; p0 += 2 * stride) {
        int pr[2]; bool ok[2]; f32x4 ml01[2], ml23[2]; h16x8 x0[2], x1[2], x2[2], x3[2], zz[2];
#pragma unroll
        for (int u = 0; u < 2; ++u) {
            pr[u] = p0 + u * stride + sub; ok[u] = (p0 + u * stride) < S * 16; if (!ok[u]) pr[u] = sub;
            ml01[u] = *(const f32x4*)(PML + (size_t)pr[u] * 8); ml23[u] = *(const f32x4*)(PML + (size_t)pr[u] * 8 + 4);
            const h16* po = PO + (size_t)pr[u] * 512 + dc;
            x0[u] = *(const h16x8*)(po); x1[u] = *(const h16x8*)(po + 128); x2[u] = *(const h16x8*)(po + 256); x3[u] = *(const h16x8*)(po + 384);
            zz[u] = *(const h16x8*)(Z + (size_t)(pr[u] >> 4) * 2048 + (pr[u] & 15) * 128 + dc);
        }
#pragma unroll
        for (int u = 0; u < 2; ++u) {
            const int t = pr[u] >> 4, head = pr[u] & 15, nsel = (t >> 8) < 3 ? (t >> 8) : 3;
            const float m3 = ml23[u][2], l3 = ml23[u][3];
            const float m0 = nsel > 0 ? ml01[u][0] : NEGF, m1 = nsel > 1 ? ml01[u][2] : NEGF, m2 = nsel > 2 ? ml23[u][0] : NEGF;
            const float M = fmaxf(fmaxf(m0, m1), fmaxf(m2, m3));
            const float w0 = nsel > 0 ? ml01[u][1] * __builtin_amdgcn_exp2f(m0 - M) : 0.f, w1 = nsel > 1 ? ml01[u][3] * __builtin_amdgcn_exp2f(m1 - M) : 0.f;
            const float w2 = nsel > 2 ? ml23[u][1] * __builtin_amdgcn_exp2f(m2 - M) : 0.f, w3 = l3 * __builtin_amdgcn_exp2f(m3 - M);
            const float inv = 1.0f / fmaxf((w0 + w1) + (w2 + w3), 1e-30f);
            h16x8 ov;
#pragma unroll
            for (int e = 0; e < 8; ++e) {
                float a = w3 * (float)x3[u][e];
                a += nsel > 0 ? w0 * (float)x0[u][e] : 0.f; a += nsel > 1 ? w1 * (float)x1[u][e] : 0.f; a += nsel > 2 ? w2 * (float)x2[u][e] : 0.f;
                ov[e] = (h16)(a * inv * (float)zz[u][e]);
            }
            if (ok[u]) *(h16x8*)(OZ + (size_t)t * 2048 + head * 128 + dc) = ov;
        }
    }
}

struct AllOn { __device__ __forceinline__ bool operator()(int) const { return true; } };
struct SelOn { const LAS unsigned* w; __device__ __forceinline__ bool operator()(int j) const { return ((w[j >> 5] >> (j & 31)) & 1u) != 0u; } };
__device__ __forceinline__ void phase_nsa_attn_mfma(const Frame& F) {
    const h16* Q = (const h16*)(F.ws + WS_QKV); const h16* KVb = Q + (size_t)16 * S * 128;
    const h16* Z = (const h16*)(F.ws + WS_QKV + 96 * MiB);
    const float* gates = (const float*)(F.ws + WS_GATES);
    const h16* KCMP = (const h16*)(F.ws + WS_KCMP); const h16* VCMPT = (const h16*)(F.ws + WS_VCMP);
    h16* OZ = (h16*)(F.ws + WS_OZ);
    LAS unsigned char* lds = (LAS unsigned char*)F.lds;
    LAS float* imp = (LAS float*)(lds + fa::LDS_IMP); LAS unsigned* selw = (LAS unsigned*)(lds + fa::LDS_SELW);
    const int lane = F.lane, r31 = lane & 31, h = lane >> 5, hh = r31 >> 3;
    for (int it = F.vcu; it < 256; it += F.G) {
        const int g = it >> 6, pi = it & 63, head = 4 * g + hh;
#pragma unroll 1
        for (int half = 0; half < 2; ++half) {
            const int c64 = half ? 127 - pi : pi;
            const int ql = 8 * F.wave + (r31 & 7), t = c64 * 64 + ql;
            h16x8 qf[8]; fa::load_q(qf, Q + ((size_t)head * S + t) * 128, h);
            fa::f32x16 o[4]; float m, l;
            for (int i = F.tid; i < 64 * 128; i += NTHREADS) imp[i] = 0.f;
            const int nval = (t >= 31) ? (((t - 31) >> 4) + 1 < NC ? ((t - 31) >> 4) + 1 : NC) : 0;
            const int tl = c64 * 64 + 63; const int nval_max = (tl >= 31) ? (((tl - 31) >> 4) + 1 < NC ? ((tl - 31) >> 4) + 1 : NC) : 0;
            const int jc = (nval_max + 63) >> 6;
            fa::zero_o(o); m = NEGF; l = 0.f;
            fa::stream<1>(lds, KCMP + (size_t)g * 512 * 128, VCMPT + (size_t)g * 512 * 128, 0, jc, qf, o, m, l, 0, nval - 1, AllOn(), F.tid, lane, 0.f, (LAS float*)nullptr);
            l += __shfl_xor(l, 32);
            { float mref = m + __builtin_amdgcn_logf(fmaxf(l, 1e-30f)), l2 = 0.f;
              fa::stream<2>(lds, KCMP + (size_t)g * 512 * 128, VCMPT + (size_t)g * 512 * 128, 0, jc, qf, o, mref, l2, 0, nval - 1, AllOn(), F.tid, lane, 0.f, imp + ql * 128); }
            const float g0 = gates[(size_t)t * 48 + head * 3 + 0];
#pragma unroll
            for (int dt = 0; dt < 4; ++dt)
#pragma unroll
                for (int cp = 0; cp < 2; ++cp) *(h16x8*)(OZ + (size_t)t * 2048 + head * 128 + 32 * dt + 16 * cp + 8 * h) = fa::pack_swap(o[dt], cp, g0);
            __syncthreads();
            for (int qq = 0; qq < 8; ++qq) {
                const int q = F.wave * 8 + qq;
                unsigned u0, u1;
                { const int s = lane; const bool valid = s <= c64, forced = (s == 0) || (s == c64) || (s == c64 - 1);
                  const unsigned bits = __float_as_uint(valid ? (forced ? BIGF : imp[q * 128 + s]) : NEGF); u0 = bits ^ ((bits >> 31) ? 0xFFFFFFFFu : 0x80000000u); }
                { const int s = lane + 64; const bool valid = s <= c64, forced = (s == c64) || (s == c64 - 1);
                  const unsigned bits = __float_as_uint(valid ? (forced ? BIGF : imp[q * 128 + s]) : NEGF); u1 = bits ^ ((bits >> 31) ? 0xFFFFFFFFu : 0x80000000u); }
                unsigned T = 0u;
                for (int bit = 31; bit >= 0; --bit) {
                    const unsigned trial = T | (1u << bit);
                    const int cnt = __popcll(__ballot(u0 >= trial)) + __popcll(__ballot(u1 >= trial));
                    if (cnt >= 16) T = trial;
                    if (cnt == 16) { T = trial - 1u; break; }
                }
                const unsigned long long g0 = __ballot(u0 > T), g1 = __ballot(u1 > T), e0 = __ballot(u0 == T), e1 = __ballot(u1 == T);
                const int need = 16 - (__popcll(g0) + __popcll(g1)), n0 = __popcll(e0);
                const int take0 = need < n0 ? need : n0, take1 = need - take0;
                const unsigned long long below = (lane == 0) ? 0ull : (~0ull >> (64 - lane));
                const unsigned long long se0 = __ballot(((e0 >> lane) & 1ull) && __popcll(e0 & below) < take0), se1 = __ballot(((e1 >> lane) & 1ull) && __popcll(e1 & below) < take1);
                const unsigned long long m0 = __ballot((((g0 | se0) >> lane) & 1ull) && lane <= c64), m1 = __ballot((((g1 | se1) >> lane) & 1ull) && (lane + 64) <= c64);
                if (lane == 0) { selw[q * 4 + 0] = (unsigned)m0; selw[q * 4 + 1] = (unsigned)(m0 >> 32); selw[q * 4 + 2] = (unsigned)m1; selw[q * 4 + 3] = (unsigned)(m1 >> 32); }
            }
            __syncthreads();
            SelOn son; son.w = selw + ql * 4;
            fa::zero_o(o); m = NEGF; l = 0.f;
            fa::stream<0>(lds, KVb + ((size_t)2 * 4 + g) * S * 128, KVb + ((size_t)3 * 4 + g) * S * 128, 0, c64 + 1, qf, o, m, l, 0, t, son, F.tid, lane, 0.f, (LAS float*)nullptr);
            l += __shfl_xor(l, 32);
            { const float sc = gates[(size_t)t * 48 + head * 3 + 1] / fmaxf(l, 1e-30f);
#pragma unroll
              for (int dt = 0; dt < 4; ++dt)
#pragma unroll
                  for (int cp = 0; cp < 2; ++cp) { h16* p = OZ + (size_t)t * 2048 + head * 128 + 32 * dt + 16 * cp + 8 * h; const h16x8 pv = *(const h16x8*)p;
                      *(h16x8*)p = pv + fa::pack_swap(o[dt], cp, sc); } }
            fa::zero_o(o); m = NEGF; l = 0.f;
            fa::stream<0>(lds, KVb + ((size_t)4 * 4 + g) * S * 128, KVb + ((size_t)5 * 4 + g) * S * 128, (c64 >= 8 ? c64 - 8 : 0), c64 + 1, qf, o, m, l, t - 511, t, AllOn(), F.tid, lane, 0.f, (LAS float*)nullptr);
            l += __shfl_xor(l, 32);
            const float sc2 = gates[(size_t)t * 48 + head * 3 + 2] / fmaxf(l, 1e-30f);
#pragma unroll
            for (int dt = 0; dt < 4; ++dt)
#pragma unroll
                for (int cp = 0; cp < 2; ++cp) {
                    const int d = 32 * dt + 16 * cp + 8 * h; const size_t off = (size_t)t * 2048 + head * 128 + d;
                    const h16x8 zz = *(const h16x8*)(Z + off); const h16x8 pv = *(const h16x8*)(OZ + off);
                    *(h16x8*)(OZ + off) = (pv + fa::pack_swap(o[dt], cp, sc2)) * zz;
                }
        }
    }
}

namespace rt {
typedef float f32x16 __attribute__((ext_vector_type(16)));
typedef short s16x4v __attribute__((__vector_size__(4 * sizeof(short))));
constexpr int SP = 144, STILE = 128 * SP;
constexpr int VP = 1088, VTILE = 32 * VP;
constexpr int KP = 528, KTILE = 32 * KP, OTILE = VTILE + KTILE;
__device__ __forceinline__ h16x8 tr16(const LAS unsigned char* p0, const LAS unsigned char* p1) {
    const s16x4v a = __builtin_amdgcn_ds_read_tr16_b64_v4i16((LAS s16x4v*)p0), b = __builtin_amdgcn_ds_read_tr16_b64_v4i16((LAS s16x4v*)p1);
    const h16x4 x = __builtin_bit_cast(h16x4, a), y = __builtin_bit_cast(h16x4, b);
    h16x8 r; r[0] = x[0]; r[1] = x[1]; r[2] = x[2]; r[3] = x[3]; r[4] = y[0]; r[5] = y[1]; r[6] = y[2]; r[7] = y[3]; return r;
}
}
__device__ __forceinline__ void phase_ret_scan_mfma(const Frame& F, const Args& A) {
    const h16* RQ = (const h16*)(F.ws + WS_QKV); const h16* RK = RQ + (size_t)8 * S * 256; const h16* RV = RK + (size_t)8 * S * 256;
    h16* ST = (h16*)(F.ws + WS_P);
    LAS unsigned char* lds = (LAS unsigned char*)F.lds;
    const int lane = F.lane, g = lane >> 4, q = (lane & 15) >> 2, p = lane & 3, mr = F.wave >> 1, nc0 = (F.wave & 1) * 2;
    for (int it = F.vcu; it < 256; it += F.G) {
        const int h = it >> 5, dk0 = ((it >> 3) & 3) * 64, dv0 = (it & 7) * 64;
        const float lg = A.lg2g[h], carry = __builtin_amdgcn_exp2f(128.f * lg);
        f32x4 acc[2] = {(f32x4){0.f, 0.f, 0.f, 0.f}, (f32x4){0.f, 0.f, 0.f, 0.f}};
        u32x4 k0r[2], v0r[2], k1r[2], v1r[2], k2r[2], v2r[2];
#define RT_LOAD(kreg, vreg, c) do { int tid_ = F.tid; asm volatile("" : "+v"(tid_)); _Pragma("unroll") for (int i = 0; i < 2; ++i) { const int idx = tid_ + 512 * i, row = idx >> 3, c16 = idx & 7; \
            kreg[i] = *(const u32x4*)(RK + ((size_t)h * S + (c) * 128 + row) * 256 + dk0 + c16 * 8); vreg[i] = *(const u32x4*)(RV + ((size_t)h * S + (c) * 128 + row) * 512 + dv0 + c16 * 8); } } while (0)
#define RT_WRITE(kreg, vreg, b) do { int tid_ = F.tid; asm volatile("" : "+v"(tid_)); _Pragma("unroll") for (int i = 0; i < 2; ++i) { const int idx = tid_ + 512 * i, row = idx >> 3, c16 = idx & 7; \
            const float w = __builtin_amdgcn_exp2f((float)(127 - row) * lg); h16x8 kk = __builtin_bit_cast(h16x8, kreg[i]); \
            _Pragma("unroll") for (int e = 0; e < 8; ++e) kk[e] = (h16)((float)kk[e] * w); \
            *(LAS h16x8*)(lds + (b) * 2 * rt::STILE + row * rt::SP + c16 * 16) = kk; *(LAS u32x4*)(lds + (b) * 2 * rt::STILE + rt::STILE + row * rt::SP + c16 * 16) = vreg[i]; } } while (0)
#define RT_STEP(c, CK, CV, NK, NV) do { \
            { h16x4 oa, ob; _Pragma("unroll") for (int e = 0; e < 4; ++e) { oa[e] = (h16)acc[0][e]; ob[e] = (h16)acc[1][e]; } \
              const fa::u32x2 ua = __builtin_bit_cast(fa::u32x2, oa), ub = __builtin_bit_cast(fa::u32x2, ob); \
              const auto r0 = __builtin_amdgcn_permlane16_swap(ua[0], ub[0], false, false), r1 = __builtin_amdgcn_permlane16_swap(ua[1], ub[1], false, false); \
                \
              *(u32x4*)(ST + (((size_t)(h * 64 + (c))) * 512 + dv0 + 16 * (nc0 + (g & 1)) + (lane & 15)) * 256 + dk0 + 16 * mr + 8 * (g >> 1)) = (u32x4){r0[0], r1[0], r0[1], r1[1]}; } \
            acc[0] = acc[0] * carry; acc[1] = acc[1] * carry; \
            const LAS unsigned char* kt = lds + ((c) & 1) * 2 * rt::STILE + (8 * g + q) * rt::SP + (16 * mr + 4 * p) * 2; \
            const LAS unsigned char* vt = lds + ((c) & 1) * 2 * rt::STILE + rt::STILE + (8 * g + q) * rt::SP + (16 * nc0 + 4 * p) * 2; \
            _Pragma("unroll") for (int ks = 0; ks < 4; ++ks) { \
                const h16x8 a = rt::tr16(kt + 32 * ks * rt::SP, kt + (32 * ks + 4) * rt::SP); \
                const h16x8 b0 = rt::tr16(vt + 32 * ks * rt::SP, vt + (32 * ks + 4) * rt::SP); \
                const h16x8 b1 = rt::tr16(vt + 32 * ks * rt::SP + 32, vt + (32 * ks + 4) * rt::SP + 32); \
                acc[0] = __builtin_amdgcn_mfma_f32_16x16x32_f16(a, b0, acc[0], 0, 0, 0); \
                acc[1] = __builtin_amdgcn_mfma_f32_16x16x32_f16(a, b1, acc[1], 0, 0, 0); } \
            if ((c) + 1 < 64) RT_WRITE(NK, NV, ((c) + 1) & 1); \
            if ((c) + 3 < 64) RT_LOAD(CK, CV, (c) + 3); \
            __syncthreads(); } while (0)
        __syncthreads();
        RT_LOAD(k0r, v0r, 0); RT_WRITE(k0r, v0r, 0);
        RT_LOAD(k1r, v1r, 1); RT_LOAD(k2r, v2r, 2);
        __syncthreads();
        for (int c = 0; c < 63; c += 3) {
            RT_STEP(c, k0r, v0r, k1r, v1r);
            RT_STEP(c + 1, k1r, v1r, k2r, v2r);
            RT_STEP(c + 2, k2r, v2r, k0r, v0r);
        }
        RT_STEP(63, k0r, v0r, k1r, v1r);
#undef RT_STEP
#undef RT_LOAD
#undef RT_WRITE
    }
}

__device__ __forceinline__ void phase_ret_out_mfma(const Frame& F, const Args& A) {
    const h16* RQ = (const h16*)(F.ws + WS_QKV); const h16* RK = RQ + (size_t)8 * S * 256; const h16* RV = RK + (size_t)8 * S * 256; const h16* RG = RV + (size_t)8 * S * 512;
    const h16* ST = (const h16*)(F.ws + WS_P);
    h16* OZ = (h16*)(F.ws + WS_OZ);
    LAS unsigned char* lds = (LAS unsigned char*)F.lds;
    LAS float* stats = (LAS float*)(lds + 2 * rt::OTILE);
    const int lane = F.lane, r31 = lane & 31, hh = lane >> 5, itl = F.wave & 3, dvh = F.wave >> 2;
    for (int it = F.bid; it < 512; it += F.G) {
        const int h = it >> 6, c = it & 63, il = 32 * itl + r31, tok = c * 128 + il;
        const float lg = A.lg2g[h];
        rt::f32x16 acc[8];
#pragma unroll
        for (int r = 0; r < 8; ++r)
#pragma unroll
            for (int e = 0; e < 16; ++e) acc[r][e] = 0.f;
        const h16* qrow = RQ + ((size_t)h * S + tok) * 256 + 8 * hh;
        u32x4 vreg[4], kreg2[2];
#define RO_LOAD(jt) do { int tid_ = F.tid; asm volatile("" : "+v"(tid_)); _Pragma("unroll") for (int i = 0; i < 2; ++i) { const int idx = tid_ + 512 * i; \
            kreg2[i] = *(const u32x4*)(RK + ((size_t)h * S + c * 128 + 32 * (jt) + (idx >> 5)) * 256 + (idx & 31) * 8); } \
            _Pragma("unroll") for (int i = 0; i < 4; ++i) { const int idx = tid_ + 512 * i; \
            vreg[i] = *(const u32x4*)(RV + ((size_t)h * S + c * 128 + 32 * (jt) + (idx >> 6)) * 512 + (idx & 63) * 8); } } while (0)
#define RO_WRITE(b) do { int tid_ = F.tid; asm volatile("" : "+v"(tid_)); _Pragma("unroll") for (int i = 0; i < 2; ++i) { const int idx = tid_ + 512 * i; \
            *(LAS u32x4*)(lds + (b) * rt::OTILE + rt::VTILE + (idx >> 5) * rt::KP + (idx & 31) * 16) = kreg2[i]; } \
            _Pragma("unroll") for (int i = 0; i < 4; ++i) { const int idx = tid_ + 512 * i; \
            *(LAS u32x4*)(lds + (b) * rt::OTILE + (idx >> 6) * rt::VP + (idx & 63) * 16) = vreg[i]; } } while (0)
        {
            constexpr int SLP = 80, SLB = 512 * SLP;
            const h16* sbase = ST + ((size_t)(h * 64 + c)) * 512 * 256;
            u32x4 sreg[4];
#define RS_LOAD(q_) do { int tid_ = F.tid; asm volatile("" : "+v"(tid_)); _Pragma("unroll") for (int i = 0; i < 4; ++i) { const int idx = tid_ + 512 * i; \
                sreg[i] = *(const u32x4*)(sbase + (size_t)(idx >> 2) * 256 + (q_) * 32 + (idx & 3) * 8); } } while (0)
#define RS_WRITE(b_) do { int tid_ = F.tid; asm volatile("" : "+v"(tid_)); _Pragma("unroll") for (int i = 0; i < 4; ++i) { const int idx = tid_ + 512 * i; \
                *(LAS u32x4*)(lds + (b_) * SLB + (idx >> 2) * SLP + (idx & 3) * 16) = sreg[i]; } } while (0)
            __syncthreads();
            RS_LOAD(0); RS_WRITE(0);
            __syncthreads();
            for (int q = 0; q < 8; ++q) {
                if (q + 1 < 8) RS_LOAD(q + 1);
                const LAS unsigned char* sl = lds + (q & 1) * SLB + (dvh * 256 + r31) * SLP + hh * 16;
#pragma unroll
                for (int k2 = 0; k2 < 2; ++k2) {
                    const h16x8 qf = *(const h16x8*)(qrow + 32 * q + 16 * k2);
#pragma unroll
                    for (int r = 0; r < 8; ++r) { const h16x8 a = *(const LAS h16x8*)(sl + r * 32 * SLP + k2 * 32); acc[r] = __builtin_amdgcn_mfma_f32_32x32x16_f16(a, qf, acc[r], 0, 0, 0); }
                }
                if (q + 1 < 8) RS_WRITE((q + 1) & 1);
                __syncthreads();
            }
#undef RS_LOAD
#undef RS_WRITE
            const float rdec = __builtin_amdgcn_exp2f((float)(il + 1) * lg);
#pragma unroll
            for (int r = 0; r < 8; ++r) acc[r] = acc[r] * rdec;
        }
        RO_LOAD(0);
        RO_WRITE(0);
        __syncthreads();
        for (int jt = 0; jt < 4; ++jt) {
            const int cur = jt & 1;
            if (jt + 1 < 4) RO_LOAD(jt + 1);
            if (jt <= itl) {
                rt::f32x16 sT;
#pragma unroll
                for (int e = 0; e < 16; ++e) sT[e] = 0.f;
                const LAS unsigned char* krow = lds + cur * rt::OTILE + rt::VTILE + r31 * rt::KP + hh * 16;
#pragma unroll 4
                for (int ks = 0; ks < 16; ++ks) sT = __builtin_amdgcn_mfma_f32_32x32x16_f16(*(const LAS h16x8*)(krow + 32 * ks), *(const h16x8*)(qrow + 16 * ks), sT, 0, 0, 0);
                h16x8 pb[2];
#pragma unroll
                for (int e = 0; e < 16; ++e) { const int kl = 32 * jt + (e & 3) + 8 * (e >> 2) + 4 * hh, df = il - kl;
                    const float pv = (df >= 0) ? sT[e] * __builtin_amdgcn_exp2f((float)df * lg) : 0.f; pb[e >> 3][e & 7] = (h16)pv; }
                const LAS unsigned char* vbase = lds + cur * rt::OTILE + (4 * hh + ((lane & 15) >> 2)) * rt::VP + (dvh * 256 + 16 * ((lane >> 4) & 1) + 4 * (lane & 3)) * 2;
#pragma unroll
                for (int r = 0; r < 8; ++r) {
#pragma unroll
                    for (int sp = 0; sp < 2; ++sp) { const LAS unsigned char* vp = vbase + 16 * sp * rt::VP + 64 * r;
                        acc[r] = __builtin_amdgcn_mfma_f32_32x32x16_f16(rt::tr16(vp, vp + 8 * rt::VP), pb[sp], acc[r], 0, 0, 0); }
                    if (r & 1) __builtin_amdgcn_sched_barrier(0);
                }
            }
            if (jt + 1 < 4) RO_WRITE(cur ^ 1);
            __syncthreads();
        }
#undef RO_LOAD
#undef RO_WRITE
        float s1 = 0.f, s2 = 0.f;
#pragma unroll
        for (int r = 0; r < 8; ++r)
#pragma unroll
            for (int e = 0; e < 16; ++e) { s1 += acc[r][e]; s2 += acc[r][e] * acc[r][e]; }
        s1 += __shfl_xor(s1, 32); s2 += __shfl_xor(s2, 32);
        if (hh == 0) { stats[(F.wave * 32 + r31) * 2] = s1; stats[(F.wave * 32 + r31) * 2 + 1] = s2; }
        __syncthreads();
        s1 += stats[((F.wave ^ 4) * 32 + r31) * 2]; s2 += stats[((F.wave ^ 4) * 32 + r31) * 2 + 1];
        const float mu = s1 * (1.0f / 512.0f), var = fmaxf(s2 * (1.0f / 512.0f) - mu * mu, 0.f), rs = 1.0f / sqrtf(var + EPS);
#pragma unroll
        for (int r = 0; r < 8; ++r)
#pragma unroll
            for (int cp = 0; cp < 2; ++cp) {
                const size_t off = (size_t)tok * 4096 + h * 512 + dvh * 256 + 32 * r + 16 * cp + 8 * hh;
                const h16x8 gv = *(const h16x8*)(RG + off);
                *(h16x8*)(OZ + off) = gv * fa::pack_swap(acc[r], cp, rs, mu);
            }
    }
}

template <int KIND>
__device__ __forceinline__ void phase_gemm_proj(const Frame& F, const Args& A, int N) {
    pg8::Gemm g{(const h16*)(F.ws + WS_H), (const h16*)(F.ws + (KIND == 2 ? WS_WTIN2 : WS_WTIN)), S, N, 2048, 2048, 2048}; pg8::StaticOrder So; So.init(S, N, F.G, F.bid);
    pg8::EpiProj<KIND> E{F.ws};
    pg8::gemm_phase<pg8::EpiProj<KIND>, pg8::StaticOrder, true, true>((LAS unsigned char*)F.lds, g, So, E);
    if (KIND == 1) {
        const int ni = ret_idle_a(F.G), r = F.bid - (F.G - ni);
        if (ni > 0 && r >= 0) conv_transpose(F, A.in[16], 2048, 12288, (h16*)(F.ws + WS_WTIN2), 12288, 0, r, ni, 0, ret_early_a(F.G));
    }
}
__device__ __forceinline__ void phase_gemm(const Frame& F, const h16* A, const h16* Bt, int N, int K, void* O, int ldc, int f32out) {
    pg8::Gemm g{A, Bt, S, N, K, K, K}; pg8::StaticOrder So; So.init(S, N, F.G, F.bid);
    pg8::EpiStore E{O, ldc, f32out};
    pg8::gemm_phase<pg8::EpiStore, pg8::StaticOrder, true, true>((LAS unsigned char*)F.lds, g, So, E);
}

constexpr int NPHASE = 2 + 8 * DEPTH;
__host__ __device__ inline bool phase_exists(int p) {
    if (p < 2) return true;
    const int L = (p - 2) / 8, s = (p - 2) % 8, kind = L % 3;
    if (s == 7) return false;
    if (s == 1) return kind == 1 || (kind == 0 && MOBA_SPARSE);
    if (s == 2) return kind != 0 || MOBA_SPARSE;
    if (s == 4) return false;
    return true;
}

__global__ void __launch_bounds__(NTHREADS, 2) trunk_fwd(Args args) {
    extern __shared__ __attribute__((aligned(16))) unsigned char lds_raw[];
    Frame F;
    F.out = args.out; F.ws = args.ws; F.lds = (char*)lds_raw;
    F.tid = threadIdx.x; F.lane = F.tid & 63; F.wave = __builtin_amdgcn_readfirstlane(F.tid >> 6); F.G = gridDim.x; F.bid = blockIdx.x;
    F.vcu = (F.G % 8 == 0) ? (F.bid % 8) * (F.G / 8) + F.bid / 8 : F.bid;
    volatile LAS unsigned* misc = (volatile LAS unsigned*)((LAS unsigned char*)lds_raw + MISC_OFF);
    if (F.tid < 16) misc[F.tid] = 0u;
    __syncthreads();
    XcdBarrier bar; bar.bar = (unsigned*)(F.ws + WS_CTL) + CW_BAR; bar.x = 0; bar.st = misc;
#if ONE_LAUNCH
    bar = xcd_barrier_post((unsigned*)(F.ws + WS_CTL) + CW_BAR, misc);
    cg::grid_group grid = cg::this_grid();
#endif
    const int lo = args.ph_lo, hi = args.ph_hi;
#if ONE_LAUNCH
    grid.sync();
#define SEAM(p) do { if ((p) > lo) xcd_barrier(bar); } while (0)
#else
#define SEAM(p) do { } while (0)
#endif
#define IN(p) (lo <= (p) && (p) < hi)
#ifndef PHMASK
#define PHMASK 0xFFFF
#endif
#define EN(b) ((PHMASK >> (b)) & 1)
#ifndef PROBE_DUP
#define PROBE_DUP 0
#endif
#define DUP(b, call) do { if ((PROBE_DUP >> (b)) & 1) { if (ONE_LAUNCH) xcd_barrier(bar); call; } } while (0)
    if (EN(0) && IN(0)) { SEAM(0); phase_prologue(F, args); }
    if (EN(1) && IN(1)) { SEAM(1); phase_norm(F, args, -1, 0); }
#define LAYER(L) do { \
        constexpr int kind = (L) % 3, base = 2 + 8 * (L); \
        constexpr int Nin = kind == 0 ? 8192 : (kind == 1 ? NSA_NP : 12288); \
        constexpr int Kout = kind == 2 ? 4096 : 2048; \
        if (EN(2) && IN(base + 0)) { SEAM(base + 0); phase_gemm_proj<kind>(F, args, Nin); } \
        if (EN(6) && kind == 1 && IN(base + 1)) { SEAM(base + 1); phase_nsa_cmp_a(F, args); } \
        if (EN(8) && kind == 0 && MOBA_SPARSE && IN(base + 1)) { SEAM(base + 1); phase_moba_gate(F, (L) / 3); } \
        if (EN(8) && kind == 0 && MOBA_SPARSE && IN(base + 2)) { SEAM(base + 2); phase_moba_attn_sparse(F, args, (L) / 3); } \
        if (kind != 0 && IN(base + 2)) { SEAM(base + 2); if (EN(6) && kind == 1) { phase_nsa_cmp_b(F, args); } else if (EN(7) && kind == 2) { phase_ret_scan_mfma(F, args); } } \
        if (IN(base + 3)) { SEAM(base + 3); if (EN(8) && kind == 0) { if (MOBA_SPARSE) phase_moba_merge(F, args, (L) / 3); else phase_moba_attn_mfma(F); } else if (EN(9) && kind == 1) { phase_nsa_attn_mfma(F); DUP(9, phase_nsa_attn_mfma(F)); } else if (EN(10) && kind == 2) { phase_ret_out_mfma(F, args); } } \
        if (EN(2) && IN(base + 5)) { SEAM(base + 5); phase_gemm(F, (const h16*)(F.ws + WS_OZ), (const h16*)(F.ws + WS_WTOUT), 2048, Kout, F.ws + WS_Y, 2048, 0); } \
        if (EN(1) && IN(base + 6)) { SEAM(base + 6); phase_norm(F, args, (L), (L) + 1 < DEPTH ? (L) + 1 : -1); } \
    } while (0)
    LAYER(0); LAYER(1); LAYER(2); LAYER(3);
#undef LAYER
#undef EN
#undef DUP
#undef IN
#undef SEAM
}

extern "C" void kernel_launch(void* const* d_in, const int* in_sizes, int n_in, void* d_out, int out_size, void* d_ws, size_t ws_size, hipStream_t stream) {
    static int grid = 0;
    if (grid == 0) {
        if (n_in != 18 || out_size != S * D || ws_size < WS_END) { fprintf(stderr, "kernel_launch: unexpected shapes (n_in %d, out %d, ws %zu)\n", n_in, out_size, ws_size); grid = -1; return; }
        int dev = 0, cus = 0, per_cu = 0;
        if (hipGetDevice(&dev) != hipSuccess || hipDeviceGetAttribute(&cus, hipDeviceAttributeMultiprocessorCount, dev) != hipSuccess) { grid = -1; return; }
        if (hipFuncSetAttribute((const void*)trunk_fwd, hipFuncAttributeMaxDynamicSharedMemorySize, LDS_BYTES) != hipSuccess) { fprintf(stderr, "kernel_launch: hipFuncSetAttribute failed\n"); grid = -1; return; }
        if (hipOccupancyMaxActiveBlocksPerMultiprocessor(&per_cu, (const void*)trunk_fwd, NTHREADS, LDS_BYTES) != hipSuccess || per_cu < 1) { fprintf(stderr, "kernel_launch: occupancy query says %d\n", per_cu); per_cu = 1; }
        (void)hipGetLastError();
        grid = cus;
    }
    if (grid < 0) return;
    (void)hipMemsetAsync((char*)d_ws + WS_CTL, 0, CTL_ZERO_BYTES, stream);
    Args a{};
    for (int i = 0; i < 18; ++i) a.in[i] = (const float*)d_in[i];
    a.out = (float*)d_out; a.ws = (unsigned char*)d_ws;
    for (int j = 0; j < 16; ++j) a.inv16[j] = pow(500000.0, -(double)j / 16.0);
    for (int j = 0; j < 128; ++j) a.inv128[j] = pow(10000.0, -(double)j / 128.0);
    for (int h = 0; h < 8; ++h) a.lg2g[h] = (float)log2(1.0 - ldexp(1.0, -5 - h));
#if ONE_LAUNCH
    a.ph_lo = 0; a.ph_hi = NPHASE;
    void* kargs[] = {&a};
    hipError_t e = hipLaunchCooperativeKernel((const void*)trunk_fwd, dim3(grid), dim3(NTHREADS), kargs, LDS_BYTES, stream);
    if (e != hipSuccess) fprintf(stderr, "kernel_launch: cooperative launch failed: %s (grid %d)\n", hipGetErrorString(e), grid);
#else
    for (int p = 0; p < NPHASE; ++p) {
        if (!phase_exists(p)) continue;
        a.ph_lo = p; a.ph_hi = p + 1;
        hipLaunchKernelGGL(trunk_fwd, dim3(grid), dim3(NTHREADS), LDS_BYTES, stream, a);
    }
#endif
}
```

```cpp
#include <hip/hip_runtime.h>
#include <hip/hip_cooperative_groups.h>
#include <cstdio>
#include <cstdint>
#include <cmath>
namespace cg = cooperative_groups;

#ifndef ONE_LAUNCH
#define ONE_LAUNCH 1
#endif
#ifndef MOBA_SPARSE
#define MOBA_SPARSE 1
#endif
#ifndef MOBA_MFMA
#define MOBA_MFMA 1
#endif
#ifndef NSA_MFMA
#define NSA_MFMA 1
#endif

#define LAS __attribute__((address_space(3)))
typedef _Float16 h16;
typedef _Float16 h16x2 __attribute__((ext_vector_type(2)));
typedef _Float16 h16x4 __attribute__((ext_vector_type(4)));
typedef _Float16 h16x8 __attribute__((ext_vector_type(8)));
typedef float f32x2 __attribute__((ext_vector_type(2)));
typedef float f32x4 __attribute__((ext_vector_type(4)));
typedef unsigned u32x4 __attribute__((ext_vector_type(4)));

constexpr int S = 8192, D = 2048, DEPTH = 4;
constexpr float EPS = 1e-6f;
constexpr float NEGF = -1e30f, BIGF = 1e30f;
constexpr int NSA_NP = 7424;
constexpr int NC = 511;

constexpr size_t MiB = 1u << 20;
constexpr size_t WS_CTL = 0, CTL_ZERO_BYTES = 1 * MiB;
constexpr size_t WS_MODP = 1 * MiB;
constexpr size_t WS_KMEAN = 4 * MiB + 512 * 1024;
constexpr size_t WS_CMPB = 2 * MiB + 512 * 1024;
constexpr size_t WS_CMPBF = 2 * MiB + 640 * 1024 + 128 * 1024;
constexpr size_t WS_MODF = 2 * MiB + 640 * 1024;
constexpr size_t WS_GATES = 3 * MiB;
constexpr size_t WS_KCMP = 5 * MiB;
constexpr size_t WS_VCMP = 5 * MiB + 512 * 1024;
constexpr size_t WS_ROPE16 = 6 * MiB;
constexpr size_t WS_ROPE128 = 7 * MiB;
constexpr size_t WS_WTIN = 16 * MiB;
constexpr size_t WS_WTOUT = 64 * MiB;
constexpr size_t WS_W1T = 72 * MiB;
constexpr size_t WS_H = 80 * MiB;
constexpr size_t WS_P = 112 * MiB;
constexpr size_t WS_QKV = 304 * MiB;
constexpr size_t WS_OZ = 496 * MiB;
constexpr size_t WS_Y = 560 * MiB;
constexpr size_t WS_OR = 624 * MiB;
constexpr size_t WS_WTIN2 = 656 * MiB;
__host__ __device__ inline int ret_idle_a(int G) { const int nwg = (S / 256) * (NSA_NP / 256), R = (nwg + G - 1) / G; return R * G - nwg; }
__host__ __device__ inline int ret_early_a(int G) { const int n = 16 * ret_idle_a(G); return n < 2048 ? n : 2048; }
__host__ __device__ inline int ret_early_b(int G) { const int n = G > 64 ? 4 * (G - 64) : 0; return n < 1024 ? n : 1024; }
constexpr int RET_TILES = (2048 / 64) * (12288 / 128);
constexpr size_t WS_XS = 720 * MiB;
constexpr size_t WS_END = 752 * MiB;

constexpr int LDS_BYTES = 147456;
constexpr int MISC_OFF = 135168;
constexpr int NTHREADS = 512;

struct Args {
    const float* in[18];
    float* out;
    unsigned char* ws;
    double inv16[16];
    double inv128[128];
    float lg2g[8];
    int ph_lo, ph_hi;
};

#define XB_TMO      128
#define XB_XCNT(j)  (256  + 64 * (j))
#define XB_XSUB(j)  (1280 + 64 * (j))
#define XB_XGEN(j)  (2304 + 64 * (j))
#define XB_TOP      3328
#define XB_TOPGEN   3392
#define XCD_BAR_WORDS 3456
#define XB_SPIN_CAP (1u << 24)
constexpr int CW_BAR = 4096;

__device__ __forceinline__ unsigned xb_ld(unsigned* p)              { return __hip_atomic_load(p, __ATOMIC_RELAXED, __HIP_MEMORY_SCOPE_AGENT); }
__device__ __forceinline__ unsigned xb_add(unsigned* p, unsigned v) { return __hip_atomic_fetch_add(p, v, __ATOMIC_RELAXED, __HIP_MEMORY_SCOPE_AGENT); }
__device__ __forceinline__ unsigned xb_xcc_id() { return (unsigned)__builtin_amdgcn_s_getreg((3 << 11) | 20) & 0xFu; }
#define XB_SPIN(cond, bar) do { unsigned _sp = 0; while (cond) { __builtin_amdgcn_s_sleep(1); \
    if ((++_sp & 255u) == 0u) { if (xb_ld(&(bar)[XB_TMO])) break; if (_sp > XB_SPIN_CAP) { atomicAdd(&(bar)[XB_TMO], 1u); break; } } } } while (0)

struct XcdBarrier { unsigned* bar; unsigned x; volatile LAS unsigned* st; };

__device__ __forceinline__ XcdBarrier xcd_barrier_post(unsigned* bar, volatile LAS unsigned* st) {
    XcdBarrier b; b.bar = bar; b.x = xb_xcc_id(); b.st = st;
    if (threadIdx.x == 0) (void)xb_add(&bar[XB_XCNT(b.x)], 1u);
    return b;
}
__device__ __forceinline__ void xcd_barrier_complete(unsigned* bar, unsigned x, unsigned& nloc, unsigned& nx) {
    const unsigned G = gridDim.x * gridDim.y * gridDim.z;
    unsigned sum, cnt, mine, sp = 0u;
    for (;;) {
        sum = 0u; cnt = 0u; mine = 0u;
#pragma unroll
        for (unsigned j = 0; j < 16; ++j) { const unsigned c = xb_ld(&bar[XB_XCNT(j)]); sum += c; cnt += (c > 0u) ? 1u : 0u; mine = (j == x) ? c : mine; }
        if (sum == G) break;
        __builtin_amdgcn_s_sleep(1);
        if ((++sp & 255u) == 0u) { if (xb_ld(&bar[XB_TMO])) break; if (sp > XB_SPIN_CAP) { atomicAdd(&bar[XB_TMO], 1u); break; } }
    }
    nloc = mine > 0u ? mine : 1u; nx = cnt > 0u ? cnt : 1u;
}
__device__ __forceinline__ void xcd_barrier(const XcdBarrier& b) {
    asm volatile("s_waitcnt vmcnt(0)" ::: "memory");
    __syncthreads();
    if (threadIdx.x == 0) {
        unsigned* bar = b.bar;
        __builtin_amdgcn_s_waitcnt(0);
        unsigned nloc = b.st[0], nx = b.st[1];
        if (nloc == 0u) { xcd_barrier_complete(bar, b.x, nloc, nx); b.st[0] = nloc; b.st[1] = nx; }
        const unsigned old = xb_add(&bar[XB_XSUB(b.x)], 1u);
        const unsigned gen = old / nloc;
        if (old + 1u == (gen + 1u) * nloc) {
            __builtin_amdgcn_fence(__ATOMIC_RELEASE, "agent");
            asm volatile("s_waitcnt vmcnt(0)" ::: "memory");
            const unsigned og = xb_add(&bar[XB_TOP], 1u);
            const unsigned tg = og / nx;
            if (og + 1u == (tg + 1u) * nx) xb_add(&bar[XB_TOPGEN], 1u);
            else XB_SPIN(xb_ld(&bar[XB_TOPGEN]) == tg, bar);
            __builtin_amdgcn_fence(__ATOMIC_ACQUIRE, "agent");
            xb_add(&bar[XB_XGEN(b.x)], 1u);
            asm volatile("s_waitcnt vmcnt(0)" ::: "memory");
        } else {
            XB_SPIN(xb_ld(&bar[XB_XGEN(b.x)]) == gen, bar);
            __builtin_amdgcn_fence(__ATOMIC_ACQUIRE, "agent");
            asm volatile("s_waitcnt vmcnt(0)" ::: "memory");
        }
    }
    __syncthreads();
}

__device__ __forceinline__ float silu_f(float x) { return x * __builtin_amdgcn_rcpf(1.f + __expf(-x)); }
__device__ __forceinline__ float sigmoid_f(float x) { return __builtin_amdgcn_rcpf(1.f + __expf(-x)); }

namespace pg8 {
constexpr int BM = 256, BK = 64, HALF = 128, HTB = HALF * BK * 2, STAGE_BYTES = 8 * HTB, NXCD = 8, WGM = 8;
__host__ __device__ __forceinline__ int lds_byte(int r, int c) { const int st = (r >> 4) * 2 + (c >> 5), rr = r & 15, cc = c & 31, ob = rr * 64 + cc * 2; return st * 1024 + (ob ^ (((ob >> 9) & 1) << 5)); }
__host__ __device__ __forceinline__ void stage_rc(int b, int& R, int& C) { const int st = b / 1024, sb = b % 1024, swz = sb ^ (((sb >> 9) & 1) << 5); R = (st >> 1) * 16 + swz / 64; C = (st & 1) * 32 + (swz % 64) / 2; }
__host__ __device__ __forceinline__ int perm32(int rho) { const int n = rho >> 4, i = rho & 15; return 8 * (i >> 2) + 4 * n + (i & 3); }

struct Unit { int pm, pn; };
struct Gemm { const h16* A; const h16* Bt; int M, N, K, lda, ldb; };

struct StaticOrder {
    int nM, nN, nwg, G, c;
    __host__ __device__ void init(int M, int N, int G_, int c_) { nM = M / BM; nN = N / BM; nwg = nM * nN; G = G_; c = c_; }
    __host__ __device__ bool next(int i, Unit& u) const {
        const long L = (long)i * G + c; if (L >= nwg) return false;
        int wgid = (int)L; { const int q = nwg / NXCD, r = nwg % NXCD, xcd = wgid % NXCD, off = wgid / NXCD; wgid = (xcd < r ? xcd * (q + 1) : r * (q + 1) + (xcd - r) * q) + off; }
        const int nig = WGM * nN, gid = wgid / nig, fm = gid * WGM, gsz = (nM - fm) < WGM ? (nM - fm) : WGM;
        u.pm = fm + ((wgid % nig) % gsz); u.pn = (wgid % nig) / gsz; return true;
    }
    __device__ __forceinline__ void a_ready(const Unit&) const {}
    __device__ __forceinline__ void done(const Unit&) const {}
};

struct OneUnit {
    int pm, pn, have;
    __device__ bool next(int i, Unit& u) const { if (i != 0 || !have) return false; u.pm = pm; u.pn = pn; return true; }
    __device__ __forceinline__ void a_ready(const Unit&) const {}
    __device__ __forceinline__ void done(const Unit&) const {}
};
struct EpiStore {
    static constexpr bool PERM = true, AFTER_DRAIN = false;
    void* O; int ldc; int f32out;
    __device__ __forceinline__ void operator()(const f32x4 (&acc)[2][2][4][2], const Unit& u, int wr, int wc, int fr, int fq) const {
        const int row0 = u.pm * BM + wr * 64 + fr, col0 = u.pn * BM + wc * 32 + 8 * fq;
#pragma unroll
        for (int ai = 0; ai < 2; ++ai)
#pragma unroll
            for (int m = 0; m < 4; ++m) {
                const size_t roff = (size_t)(row0 + ai * HALF + m * 16) * ldc + col0;
#pragma unroll
                for (int bj = 0; bj < 2; ++bj) {
                    const f32x4 v0 = acc[ai][bj][m][0], v1 = acc[ai][bj][m][1];
                    if (f32out) {
                        float* p = (float*)O + roff + bj * HALF;
                        *(f32x4*)p = v0; *(f32x4*)(p + 4) = v1;
                    } else {
                        h16x8 w; w[0] = (h16)v0[0]; w[1] = (h16)v0[1]; w[2] = (h16)v0[2]; w[3] = (h16)v0[3]; w[4] = (h16)v1[0]; w[5] = (h16)v1[1]; w[6] = (h16)v1[2]; w[7] = (h16)v1[3];
                        *(h16x8*)((h16*)O + roff + bj * HALF) = w;
                    }
                }
            }
    }
};


template <int KIND  > struct EpiProj {
    static constexpr bool PERM = true, AFTER_DRAIN = false;
    unsigned char* ws;
    __device__ __forceinline__ static void st8(h16* p, const float (&v)[8]) { h16x8 w;
#pragma unroll
        for (int i = 0; i < 8; ++i) w[i] = (h16)v[i];
        *(h16x8*)p = w; }
    __device__ __forceinline__ void operator()(const f32x4 (&acc)[2][2][4][2], const Unit& u, int wr, int wc, int fr, int fq) const {
        const int pn = u.pn, d0 = 32 * wc + 8 * fq;
        h16* QKV = (h16*)(ws + WS_QKV);
        const f32x2* r16 = (const f32x2*)(ws + WS_ROPE16); const f32x2* r128 = (const f32x2*)(ws + WS_ROPE128);
        float ksum[2][8];
#pragma unroll
        for (int bj = 0; bj < 2; ++bj)
#pragma unroll
            for (int i = 0; i < 8; ++i) ksum[bj][i] = 0.f;
        int mode;
        float scale = 1.f; h16* base = QKV; int ld = 0;
        bool want_ksum = false;
        if (KIND == 0) {
            const int sect = pn >> 3;
            if (sect == 0) { mode = 0; scale = 0.08838834764831845f * 1.4426950408889634f  ; base = QKV + (size_t)(2 * (pn & 7)) * S * 128; }
            else if (sect == 1) { mode = 0; want_ksum = true; base = QKV + (size_t)16 * S * 128 + (size_t)(2 * (pn & 7)) * S * 128; }
            else if (sect == 2) { mode = 1; base = QKV + (size_t)32 * S * 128 + (size_t)(2 * (pn & 7)) * S * 128; }
            else { mode = 2; base = QKV + (size_t)48 * S * 128 + (pn & 7) * 256; ld = 2048; }
        } else if (KIND == 1) {
            if (pn < 8) { mode = 0; scale = 0.08838834764831845f * 1.4426950408889634f  ; base = QKV + (size_t)(2 * pn) * S * 128; }
            else if (pn < 20) { const int ti = (pn - 8) >> 1; mode = (ti & 1) ? 1 : 0; base = QKV + (size_t)16 * S * 128 + ((size_t)ti * 4 + 2 * ((pn - 8) & 1)) * S * 128; }
            else if (pn < 28) { mode = 2; base = (h16*)(ws + WS_QKV + 96 * MiB) + (pn - 20) * 256; ld = 2048; }
            else mode = 3;
        } else {
            if (pn < 8) { mode = 4; base = QKV + (size_t)pn * S * 256; }
            else if (pn < 16) { mode = 4; scale = 0.0625f; base = QKV + (size_t)8 * S * 256 + (size_t)(pn - 8) * S * 256; }
            else if (pn < 32) { mode = 5; base = QKV + (size_t)16 * S * 256 + (size_t)((pn - 16) >> 1) * S * 512 + ((pn - 16) & 1) * 256; }
            else { mode = 2; base = QKV + (size_t)16 * S * 256 + (size_t)8 * S * 512 + (pn - 32) * 256; ld = 4096; }
        }
        const int trow = u.pm * BM + wr * 64 + fr;
constexpr int EPD = 2;
#define EP_ROW(it) (trow + ((it) >> 2) * HALF + ((it) & 3) * 16)
#define EP_GETV(it) float v[2][8]; _Pragma("unroll") for (int bj = 0; bj < 2; ++bj) _Pragma("unroll") for (int i = 0; i < 8; ++i) v[bj][i] = acc[(it) >> 2][bj][(it) & 3][i >> 2][i & 3];
        if (mode == 0) {
            if (wc == 0) {
                const f32x4* tb = (const f32x4*)(r16 + 8 * (fq & 1));
                f32x4 cn[EPD][4];
#pragma unroll
                for (int p = 0; p < EPD; ++p)
#pragma unroll
                    for (int q = 0; q < 4; ++q) cn[p][q] = tb[(size_t)EP_ROW(p) * 8 + q];
#pragma unroll
                for (int it = 0; it < 8; ++it) {
                    const int t = EP_ROW(it);
                    f32x4 cc[4];
#pragma unroll
                    for (int q = 0; q < 4; ++q) cc[q] = cn[it % EPD][q];
                    if (it + EPD < 8) {
#pragma unroll
                        for (int q = 0; q < 4; ++q) cn[it % EPD][q] = tb[(size_t)EP_ROW(it + EPD) * 8 + q]; }
                    EP_GETV(it)
#pragma unroll
                    for (int bj = 0; bj < 2; ++bj) {
#pragma unroll
                        for (int i = 0; i < 8; ++i) { const float o = __shfl_xor(v[bj][i], 32); const float c0 = cc[i >> 1][2 * (i & 1)], c1 = cc[i >> 1][2 * (i & 1) + 1];
                            v[bj][i] = ((fq < 2) ? (v[bj][i] * c0 - o * c1) : (o * c1 + v[bj][i] * c0)) * scale; ksum[bj][i] += v[bj][i]; }
                        st8(base + ((size_t)bj * S + t) * 128 + d0, v[bj]);
                    }
                }
            } else {
#pragma unroll
                for (int it = 0; it < 8; ++it) { const int t = EP_ROW(it); EP_GETV(it)
#pragma unroll
                    for (int bj = 0; bj < 2; ++bj) {
#pragma unroll
                        for (int i = 0; i < 8; ++i) { v[bj][i] *= scale; ksum[bj][i] += v[bj][i]; }
                        st8(base + ((size_t)bj * S + t) * 128 + d0, v[bj]);
                    } }
            }
        } else if (mode == 1) {
#pragma unroll
            for (int it = 0; it < 8; ++it) { const int t = EP_ROW(it); EP_GETV(it)
#pragma unroll
                for (int bj = 0; bj < 2; ++bj) st8(base + ((size_t)bj * S + t) * 128 + d0, v[bj]); }
        } else if (mode == 2) {
#pragma unroll
            for (int it = 0; it < 8; ++it) { const int t = EP_ROW(it); EP_GETV(it)
#pragma unroll
                for (int bj = 0; bj < 2; ++bj) {
#pragma unroll
                    for (int i = 0; i < 8; ++i) v[bj][i] = silu_f(v[bj][i]);
                    st8(base + (size_t)t * ld + 128 * bj + d0, v[bj]);
                } }
        } else if (mode == 3) {
            if (d0 < 48) {
#pragma unroll
                for (int it = 0; it < 8; ++it) { const int t = EP_ROW(it); float* gp = (float*)(ws + WS_GATES) + (size_t)t * 48 + d0;
                    f32x4 g0, g1;
#pragma unroll
                    for (int i = 0; i < 4; ++i) { g0[i] = sigmoid_f(acc[it >> 2][0][it & 3][0][i]); g1[i] = sigmoid_f(acc[it >> 2][0][it & 3][1][i]); }
                    *(f32x4*)gp = g0; *(f32x4*)(gp + 4) = g1; } }
        } else if (mode == 4) {
            const f32x4* tb = (const f32x4*)(r128 + d0);
            f32x4 cn[EPD][4];
#pragma unroll
            for (int p = 0; p < EPD; ++p)
#pragma unroll
                for (int q = 0; q < 4; ++q) cn[p][q] = tb[(size_t)EP_ROW(p) * 64 + q];
#pragma unroll
            for (int it = 0; it < 8; ++it) {
                const int t = EP_ROW(it);
                f32x4 cc[4];
#pragma unroll
                for (int q = 0; q < 4; ++q) cc[q] = cn[it % EPD][q];
                if (it + EPD < 8) {
#pragma unroll
                    for (int q = 0; q < 4; ++q) cn[it % EPD][q] = tb[(size_t)EP_ROW(it + EPD) * 64 + q]; }
                EP_GETV(it)
#pragma unroll
                for (int i = 0; i < 8; ++i) { const float c0 = cc[i >> 1][2 * (i & 1)], c1 = cc[i >> 1][2 * (i & 1) + 1]; const float x1 = v[0][i], x2 = v[1][i];
                    v[0][i] = (x1 * c0 - x2 * c1) * scale; v[1][i] = (x1 * c1 + x2 * c0) * scale; }
                st8(base + (size_t)t * 256 + d0, v[0]); st8(base + (size_t)t * 256 + 128 + d0, v[1]);
            }
        } else {
#pragma unroll
            for (int it = 0; it < 8; ++it) { const int t = EP_ROW(it); EP_GETV(it)
#pragma unroll
                for (int bj = 0; bj < 2; ++bj) st8(base + (size_t)t * 512 + 128 * bj + d0, v[bj]); }
        }
#undef EP_ROW
#undef EP_GETV
        if (KIND == 0 && want_ksum) {
#pragma unroll
            for (int bj = 0; bj < 2; ++bj)
#pragma unroll
                for (int i = 0; i < 8; ++i) { float x = ksum[bj][i]; x += __shfl_xor(x, 1); x += __shfl_xor(x, 2); x += __shfl_xor(x, 4); x += __shfl_xor(x, 8); ksum[bj][i] = x; }
            if (fr == 0) { float* km = (float*)(ws + WS_KMEAN) + (size_t)wr * 65536;
#pragma unroll
                for (int bj = 0; bj < 2; ++bj)
#pragma unroll
                    for (int i = 0; i < 8; ++i) km[((size_t)(2 * (pn & 7) + bj) * 32 + u.pm) * 128 + d0 + i] = ksum[bj][i] * (1.0f / 256.0f); }
        }
    }
};

template <class Epi, class Sched, bool ALIGN_EPI = false, bool SP2 = false>
__device__ __forceinline__ void gemm_phase(LAS unsigned char* lds, const Gemm g, const Sched& S, const Epi& E) {
    const int tid = threadIdx.x, wid = __builtin_amdgcn_readfirstlane(tid >> 6), lane = tid & 63, wr = wid >> 2, wc = wid & 3, fr = lane & 15, fq = lane >> 4;
    const int K = g.K, nt = K / BK;
    unsigned voffA[2], voffB[2];
#pragma unroll
    for (int i = 0; i < 2; ++i) { int R, C; stage_rc(tid * 16 + i * 8192, R, C); const int Rb = Epi::PERM ? ((R & ~31) + perm32(R & 31)) : R;
        voffA[i] = (unsigned)(R * g.lda + C) * 2u; voffB[i] = (unsigned)(Rb * g.ldb + C) * 2u; }
    const size_t kstep = (size_t)(BK * 2);
    const size_t hstepA = (size_t)HALF * g.lda * 2, hstepB = (size_t)HALF * g.ldb * 2;
    const size_t tstepA = 2 * hstepA, tstepB = 2 * hstepB;
    const unsigned ldsw = (unsigned)wid * 1024u;
    const int aoff = lds_byte(wr * 64 + fr, fq * 8), boff = lds_byte(wc * 32 + fr, fq * 8);
#define PG8_SA(b, h) (((b) * 2 + (h)) * HTB)
#define PG8_SB(b, h) ((4 + (b) * 2 + (h)) * HTB)
#define PG8_STAGE(bufoff, gbase, voff) do { _Pragma("unroll") for (int _i = 0; _i < 2; ++_i) \
        __builtin_amdgcn_global_load_lds((const unsigned*)((const char*)(gbase) + (voff)[_i]), (LAS unsigned*)(lds + (bufoff) + ldsw + _i * 8192), 16, 0, 0); } while (0)
#define PG8_LDA(dst, b, h) do { _Pragma("unroll") for (int m = 0; m < 4; ++m) _Pragma("unroll") for (int k = 0; k < 2; ++k) dst[m][k] = *(const LAS h16x8*)(lds + PG8_SA(b, h) + aoff + m * 2048 + k * 1024); } while (0)
#define PG8_LDB(dst, b, h) do { _Pragma("unroll") for (int n = 0; n < 2; ++n) _Pragma("unroll") for (int k = 0; k < 2; ++k) dst[n][k] = *(const LAS h16x8*)(lds + PG8_SB(b, h) + boff + n * 2048 + k * 1024); } while (0)
#define PG8_MMA(ai, bj, At, Bt) do { __builtin_amdgcn_s_setprio(1); _Pragma("unroll") for (int m = 0; m < 4; ++m) _Pragma("unroll") for (int n = 0; n < 2; ++n) _Pragma("unroll") for (int k = 0; k < 2; ++k) \
        acc[ai][bj][m][n] = __builtin_amdgcn_mfma_f32_16x16x32_f16(Bt[n][k], At[m][k], acc[ai][bj][m][n], 0, 0, 0); __builtin_amdgcn_s_setprio(0); } while (0)
#define PG8_WAIT_V(n) asm volatile("s_waitcnt vmcnt(" #n ")" ::: "memory")
#define PG8_WAIT_L(n) asm volatile("s_waitcnt lgkmcnt(" #n ")" ::: "memory")
#define PG8_BAR __builtin_amdgcn_s_barrier()
#define PG8_SCHED __builtin_amdgcn_sched_barrier(0)
    Unit cur, nxt; int ui = 0;
    if (!S.next(0, cur)) return;
    f32x4 acc[2][2][4][2];
#pragma unroll
    for (int a = 0; a < 2; ++a)
#pragma unroll
        for (int b = 0; b < 2; ++b)
#pragma unroll
            for (int m = 0; m < 4; ++m)
#pragma unroll
                for (int n = 0; n < 2; ++n) acc[a][b][m][n] = (f32x4){0.f, 0.f, 0.f, 0.f};
    h16x8 At[4][2], B0[2][2], B1[2][2];
    const char* cA = (const char*)g.A + (size_t)cur.pm * tstepA; const char* cB = (const char*)g.Bt + (size_t)cur.pn * tstepB;
    S.a_ready(cur);
    if constexpr (SP2) {
        PG8_STAGE(PG8_SB(0, 0), cB, voffB); PG8_STAGE(PG8_SB(0, 1), cB + hstepB, voffB); PG8_STAGE(PG8_SA(0, 0), cA, voffA); PG8_STAGE(PG8_SA(0, 1), cA + hstepA, voffA);
        if (wr == 1) PG8_BAR;
        PG8_WAIT_V(2); PG8_BAR;
        PG8_STAGE(PG8_SB(1, 0), cB + kstep, voffB); PG8_STAGE(PG8_SA(1, 0), cA + kstep, voffA); PG8_STAGE(PG8_SB(1, 1), cB + hstepB + kstep, voffB);
        PG8_WAIT_V(6); PG8_BAR;
    } else {
        PG8_STAGE(PG8_SB(0, 0), cB, voffB); PG8_STAGE(PG8_SA(0, 0), cA, voffA); PG8_STAGE(PG8_SB(0, 1), cB + hstepB, voffB); PG8_STAGE(PG8_SA(0, 1), cA + hstepA, voffA);
        if (wr == 1) PG8_BAR;
        PG8_WAIT_V(4); PG8_BAR;
        PG8_STAGE(PG8_SB(1, 0), cB + kstep, voffB); PG8_STAGE(PG8_SA(1, 0), cA + kstep, voffA); PG8_STAGE(PG8_SB(1, 1), cB + hstepB + kstep, voffB);
        PG8_WAIT_V(6); PG8_BAR;
    }
    for (;;) {
        const bool has_next = S.next(ui + 1, nxt);
        const char* nA = has_next ? (const char*)g.A + (size_t)nxt.pm * tstepA : cA; const char* nB = has_next ? (const char*)g.Bt + (size_t)nxt.pn * tstepB : cB;
        for (int t = 0; t < nt; t += 2) {
            const bool last = (t == nt - 2);
            const char* a1 = cA + (size_t)(t + 1) * kstep;
            const char* a2 = last ? nA : cA + (size_t)(t + 2) * kstep; const char* b2 = last ? nB : cB + (size_t)(t + 2) * kstep;
            const char* a3 = a2 + kstep; const char* b3 = b2 + kstep;
            if (last && has_next) S.a_ready(nxt);
            if constexpr (SP2) {
            PG8_LDB(B0, 0, 0); PG8_LDB(B1, 0, 1); PG8_SCHED; PG8_LDA(At, 0, 0); PG8_STAGE(PG8_SA(1, 1), a1 + hstepA, voffA);
            PG8_WAIT_V(8); PG8_WAIT_L(0); PG8_BAR; PG8_MMA(0, 0, At, B0); PG8_MMA(0, 1, At, B1); PG8_BAR; PG8_SCHED;
            PG8_LDA(At, 0, 1); PG8_STAGE(PG8_SB(0, 0), b2, voffB); PG8_STAGE(PG8_SB(0, 1), b2 + hstepB, voffB); PG8_STAGE(PG8_SA(0, 0), a2, voffA);
            PG8_WAIT_V(8); PG8_WAIT_L(0); PG8_BAR; PG8_MMA(1, 0, At, B0); PG8_MMA(1, 1, At, B1); PG8_BAR; PG8_SCHED;
            PG8_LDB(B0, 1, 0); PG8_LDB(B1, 1, 1); PG8_SCHED; PG8_LDA(At, 1, 0); PG8_STAGE(PG8_SA(0, 1), a2 + hstepA, voffA);
            PG8_WAIT_V(8); PG8_WAIT_L(0); PG8_BAR; PG8_MMA(0, 0, At, B0); PG8_MMA(0, 1, At, B1); PG8_BAR; PG8_SCHED;
            PG8_LDA(At, 1, 1); PG8_STAGE(PG8_SB(1, 0), b3, voffB); PG8_STAGE(PG8_SB(1, 1), b3 + hstepB, voffB); PG8_STAGE(PG8_SA(1, 0), a3, voffA);
            PG8_WAIT_V(8); PG8_WAIT_L(0); PG8_BAR; PG8_MMA(1, 0, At, B0); PG8_MMA(1, 1, At, B1); PG8_BAR; PG8_SCHED;
            } else {
            PG8_LDB(B0, 0, 0); PG8_SCHED; PG8_LDA(At, 0, 0); PG8_STAGE(PG8_SA(1, 1), a1 + hstepA, voffA);
            PG8_WAIT_L(8); PG8_BAR; PG8_WAIT_L(0); PG8_MMA(0, 0, At, B0); PG8_BAR; PG8_SCHED;
            PG8_LDB(B1, 0, 1); PG8_STAGE(PG8_SB(0, 0), b2, voffB);
            PG8_BAR; PG8_WAIT_L(0); PG8_MMA(0, 1, At, B1); PG8_BAR;
            PG8_LDA(At, 0, 1); PG8_STAGE(PG8_SA(0, 0), a2, voffA);
            PG8_BAR; PG8_WAIT_L(0); PG8_MMA(1, 0, At, B0); PG8_BAR; PG8_SCHED;
            PG8_STAGE(PG8_SB(0, 1), b2 + hstepB, voffB);
            PG8_WAIT_V(6); PG8_BAR; PG8_MMA(1, 1, At, B1); PG8_BAR;
            PG8_LDB(B0, 1, 0); PG8_SCHED; PG8_LDA(At, 1, 0); PG8_STAGE(PG8_SA(0, 1), a2 + hstepA, voffA);
            PG8_WAIT_L(8); PG8_BAR; PG8_WAIT_L(0); PG8_MMA(0, 0, At, B0); PG8_BAR; PG8_SCHED;
            PG8_LDB(B1, 1, 1); PG8_STAGE(PG8_SB(1, 0), b3, voffB);
            PG8_BAR; PG8_WAIT_L(0); PG8_MMA(0, 1, At, B1); PG8_BAR;
            PG8_LDA(At, 1, 1); PG8_STAGE(PG8_SA(1, 0), a3, voffA);
            PG8_BAR; PG8_WAIT_L(0); PG8_MMA(1, 0, At, B0); PG8_BAR; PG8_SCHED;
            PG8_STAGE(PG8_SB(1, 1), b3 + hstepB, voffB);
            PG8_WAIT_V(6); PG8_BAR; PG8_MMA(1, 1, At, B1); PG8_BAR;
            }
        }
        if constexpr (ALIGN_EPI) { if (wr == 0) PG8_BAR; }
        if constexpr (!Epi::AFTER_DRAIN) { E(acc, cur, wr, wc, fr, fq); S.done(cur); }
        if (!has_next) break;
#pragma unroll
        for (int a = 0; a < 2; ++a)
#pragma unroll
            for (int b = 0; b < 2; ++b)
#pragma unroll
                for (int m = 0; m < 4; ++m)
#pragma unroll
                    for (int n = 0; n < 2; ++n) acc[a][b][m][n] = (f32x4){0.f, 0.f, 0.f, 0.f};
        cur = nxt; cA = nA; cB = nB; ++ui;
        if constexpr (ALIGN_EPI) { if (wr == 1) PG8_BAR; }
    }
    PG8_WAIT_V(0);
    if constexpr (!ALIGN_EPI) { if (wr == 0) PG8_BAR; }
    PG8_BAR;
#undef PG8_SA
#undef PG8_SB
#undef PG8_STAGE
#undef PG8_LDA
#undef PG8_LDB
#undef PG8_MMA
#undef PG8_WAIT_V
#undef PG8_WAIT_L
#undef PG8_BAR
#undef PG8_SCHED
}
}

struct Frame {
    float* out;
    unsigned char* ws;
    char* lds;
    int tid, lane, wave, G, bid;
    int vcu;
};

__device__ __forceinline__ float wave_sum(float v) {
#pragma unroll
    for (int o = 32; o >= 1; o >>= 1) v += __shfl_xor(v, o);
    return v;
}
__device__ __forceinline__ float wave_max(float v) {
#pragma unroll
    for (int o = 32; o >= 1; o >>= 1) v = fmaxf(v, __shfl_xor(v, o));
    return v;
}
__device__ __forceinline__ void wave_lds_fence() { __builtin_amdgcn_wave_barrier(); asm volatile("s_waitcnt lgkmcnt(0)" ::: "memory"); __builtin_amdgcn_wave_barrier(); }

__device__ __forceinline__ void sincos_d(double x, float& c, float& s) {
    const double TWO_OVER_PI = 0.63661977236758134308;
    const double PIO2_HI = 1.57079632679489655800e+00, PIO2_LO = 6.12323399573676603587e-17;
    const double q = __builtin_rint(x * TWO_OVER_PI);
    double y = __builtin_fma(-q, PIO2_HI, x); y = __builtin_fma(-q, PIO2_LO, y);
    const double y2 = y * y;
    double sp = 1.0 / 6227020800.0;
    sp = sp * y2 - 1.0 / 39916800.0; sp = sp * y2 + 1.0 / 362880.0; sp = sp * y2 - 1.0 / 5040.0; sp = sp * y2 + 1.0 / 120.0; sp = sp * y2 - 1.0 / 6.0; sp = sp * y2 * y + y;
    double cp = -1.0 / 87178291200.0;
    cp = cp * y2 + 1.0 / 479001600.0; cp = cp * y2 - 1.0 / 3628800.0; cp = cp * y2 + 1.0 / 40320.0; cp = cp * y2 - 1.0 / 720.0; cp = cp * y2 + 1.0 / 24.0; cp = cp * y2 - 0.5; cp = cp * y2 + 1.0;
    const long long qi = (long long)q; const int quad = (int)(qi & 3);
    double sv, cv;
    if (quad == 0) { sv = sp; cv = cp; } else if (quad == 1) { sv = cp; cv = -sp; } else if (quad == 2) { sv = -sp; cv = -cp; } else { sv = -cp; cv = sp; }
    c = (float)cv; s = (float)sv;
}

__device__ __forceinline__ int nsa_src_col(int n) { return n < 5120 ? n : (n < 7168 ? n + 48 : (n < 7216 ? n - 2048 : -1)); }
__device__ __forceinline__ void conv_transpose(const Frame& F, const float* W, int K, int Nsrc, h16* Wt, int Npad, int mapmode, int first, int stride, int t_begin = 0, int t_end = -1) {
    float* tile = (float*)F.lds;
    const int tk_n = K / 64, tn_n = Npad / 128, ntiles = (t_end < 0) ? tk_n * tn_n : t_end;
    f32x4 v[4];
#define CV_LOAD(it_) do { const int tk_ = (it_) / tn_n, tn_ = (it_) % tn_n; _Pragma("unroll") for (int i = 0; i < 4; ++i) { \
        const int idx = F.tid + i * NTHREADS, k = idx >> 5, n4 = (idx & 31) * 4; const int nn = tn_ * 128 + n4; const int src = mapmode ? nsa_src_col(nn) : nn; \
        v[i] = (f32x4){0.f, 0.f, 0.f, 0.f}; if (src >= 0 && src + 3 < Nsrc) v[i] = __builtin_nontemporal_load((const f32x4*)(W + (size_t)(tk_ * 64 + k) * Nsrc + src)); } } while (0)
    if (t_begin + first < ntiles) CV_LOAD(t_begin + first);
    for (int it = t_begin + first; it < ntiles; it += stride) {
        const int tk = it / tn_n, tn = it % tn_n;
        __syncthreads();
#pragma unroll
        for (int i = 0; i < 4; ++i) {
            const int idx = F.tid + i * NTHREADS, k = idx >> 5, n4 = (idx & 31) * 4;
            tile[k * 129 + n4] = v[i][0]; tile[k * 129 + n4 + 1] = v[i][1]; tile[k * 129 + n4 + 2] = v[i][2]; tile[k * 129 + n4 + 3] = v[i][3];
        }
        if (it + stride < ntiles) CV_LOAD(it + stride);
        __syncthreads();
#pragma unroll
        for (int i = 0; i < 2; ++i) {
            const int idx = F.tid + i * NTHREADS, n = idx >> 3, k8 = (idx & 7) * 8;
            h16x8 o;
#pragma unroll
            for (int e = 0; e < 8; ++e) o[e] = (h16)tile[(k8 + e) * 129 + n];
            *(h16x8*)(Wt + (size_t)(tn * 128 + n) * K + tk * 64 + k8) = o;
        }
    }
#undef CV_LOAD
    __syncthreads();
}
__device__ __forceinline__ void conv_layer_weights(const Frame& F, const Args& A, int L) {
    const int kind = L % 3, j = L / 3;
    h16* wtin = (h16*)(F.ws + WS_WTIN); h16* wtout = (h16*)(F.ws + WS_WTOUT);
    if (kind == 0) {
        conv_transpose(F, A.in[7] + (size_t)j * 2048 * 8192, 2048, 8192, wtin, 8192, 0, F.bid, F.G);
        conv_transpose(F, A.in[8] + (size_t)j * 2048 * 2048, 2048, 2048, wtout, 2048, 0, F.bid, F.G);
    } else if (kind == 1) {
        conv_transpose(F, A.in[9], 2048, 7216, wtin, NSA_NP, 1, F.bid, F.G);
        conv_transpose(F, A.in[10], 2048, 2048, wtout, 2048, 0, F.bid, F.G);
        conv_transpose(F, A.in[12], 4096, 256, (h16*)(F.ws + WS_W1T), 256, 0, F.bid, F.G);
        conv_transpose(F, A.in[14], 4096, 256, (h16*)(F.ws + WS_W1T) + (size_t)256 * 4096, 256, 0, F.bid, F.G);
    } else {
        conv_transpose(F, A.in[16], 2048, 12288, (h16*)(F.ws + WS_WTIN2), 12288, 0, F.bid, F.G, ret_early_a(F.G) + ret_early_b(F.G));
        conv_transpose(F, A.in[17], 4096, 2048, wtout, 2048, 0, F.bid, F.G);
    }
}

__device__ __forceinline__ void phase_prologue(const Frame& F, const Args& A) {
    {
        float* modp = (float*)(F.ws + WS_MODP);
        const float* c = A.in[1]; const float* aw = A.in[3];
        float* sc = (float*)F.lds;
        __syncthreads();
        for (int i = F.tid; i < 2048; i += NTHREADS) sc[i] = silu_f(c[i]);
        __syncthreads();
        for (int it = F.bid; it < 192; it += F.G) {
            const int layer = it / 48, r = it % 48, slice = r / 3, nch = r % 3, n = nch * 2048 + F.tid * 4;
            const float* w = aw + (size_t)layer * 2048 * 6144 + (size_t)(slice * 128) * 6144 + n;
            f32x4 a0 = (f32x4){0.f, 0.f, 0.f, 0.f}, a1 = a0;
#pragma unroll 8
            for (int k = 0; k < 128; k += 2) {
                a0 += __builtin_nontemporal_load((const f32x4*)(w + (size_t)k * 6144)) * sc[slice * 128 + k];
                a1 += __builtin_nontemporal_load((const f32x4*)(w + (size_t)(k + 1) * 6144)) * sc[slice * 128 + k + 1];
            }
            *(f32x4*)(modp + (size_t)(slice * 4 + layer) * 6144 + n) = a0 + a1;
        }
        __syncthreads();
    }
    {
        const int* pos = (const int*)A.in[2];
        f32x2* r16 = (f32x2*)(F.ws + WS_ROPE16); f32x2* r128 = (f32x2*)(F.ws + WS_ROPE128);
        for (int idx = (F.bid * NTHREADS + F.tid) * 2; idx < S * 16; idx += F.G * NTHREADS * 2) {
            const int t = idx >> 4, j = idx & 15; float c0, s0, c1, s1; sincos_d((double)pos[t] * A.inv16[j], c0, s0); sincos_d((double)pos[t] * A.inv16[j + 1], c1, s1);
            *(f32x4*)(r16 + idx) = (f32x4){c0, s0, c1, s1};
        }
        for (int idx = (F.bid * NTHREADS + F.tid) * 2; idx < S * 128; idx += F.G * NTHREADS * 2) {
            const int t = idx >> 7, j = idx & 127; float c0, s0, c1, s1; sincos_d((double)pos[t] * A.inv128[j], c0, s0); sincos_d((double)pos[t] * A.inv128[j + 1], c1, s1);
            *(f32x4*)(r128 + idx) = (f32x4){c0, s0, c1, s1};
        }
    }
    if (F.bid >= F.G - 16) {
        const int slice = F.bid - (F.G - 16), kv = F.tid >> 8, j = F.tid & 255; const float* w1 = (kv ? A.in[14] : A.in[12]) + (size_t)slice * 256 * 256; const float* pe = A.in[11] + slice * 256;
        float a0 = 0.f, a1 = 0.f;
#pragma unroll 8
        for (int i = 0; i < 256; i += 2) { a0 += pe[i] * w1[(size_t)i * 256 + j]; a1 += pe[i + 1] * w1[(size_t)(i + 1) * 256 + j]; }
        ((float*)(F.ws + WS_CMPB))[slice * 512 + F.tid] = a0 + a1;
    }
    conv_layer_weights(F, A, 0);
}

__device__ __forceinline__ void phase_norm(const Frame& F, const Args& A, int Lprev, int Lnext) {
    float* modl = (float*)F.lds;
#define NP(col) ((((col) >> 9) << 9) + ((((col) >> 2) & 1) << 8) + ((((col) & 511) >> 3) << 2) + ((col) & 3))
    const float* npost = A.in[6] + (Lprev >= 0 ? Lprev : 0) * 2048;
    const float* npre = A.in[5] + (Lnext >= 0 ? Lnext : 0) * 2048;
    const float* modp = (const float*)(F.ws + WS_MODP); const float* ab = A.in[4];
    __syncthreads();
    float* modf = (float*)(F.ws + WS_MODF);
    for (int i = F.tid; i < 6144; i += NTHREADS) {
        const int which = i >> 11, col = i & 2047;
        int layer, mcol;
        if (which == 0) { layer = Lprev; mcol = 4096 + col; } else if (which == 1) { layer = Lnext; mcol = 2048 + col; } else { layer = Lnext; mcol = col; }
        float v = 0.f;
        if (layer >= 0) {
            if (Lprev >= 0) v = modf[layer * 6144 + mcol];
            else { v = ab[layer * 6144 + mcol];
#pragma unroll
                for (int s = 0; s < 16; ++s) v += modp[(size_t)(s * 4 + layer) * 6144 + mcol]; }
        }
        modl[which * 2048 + NP(col)] = v;
    }
    for (int i = F.tid; i < 2048; i += NTHREADS) { modl[6144 + NP(i)] = npost[i]; modl[8192 + NP(i)] = npre[i]; }
    if (Lprev < 0) {
        for (int e = F.bid * NTHREADS + F.tid; e < 4 * 6144; e += F.G * NTHREADS) {
            float v = ab[e];
#pragma unroll
            for (int s = 0; s < 16; ++s) v += modp[(size_t)s * 4 * 6144 + e];
            modf[e] = v;
        }
        if (F.bid == F.G - 1) {
            const float* cb = (const float*)(F.ws + WS_CMPB); float v = 0.f;
#pragma unroll
            for (int s = 0; s < 16; ++s) v += cb[s * 512 + F.tid];
            ((float*)(F.ws + WS_CMPBF))[F.tid] = v;
        }
    }
    __syncthreads();
    const float* xin = A.in[0];
    const h16* Y = (const h16*)(F.ws + WS_Y);
    h16* H = (h16*)(F.ws + WS_H);
    h16* XS = (h16*)(F.ws + WS_XS);
    f32x4 xn[8]; h16x8 yn[4], xhn[4];
#define NORM_LOAD(tt) do { if (Lprev >= 1) { _Pragma("unroll") for (int j = 0; j < 4; ++j) xhn[j] = *(const h16x8*)(XS + (size_t)(tt) * D + j * 512 + F.lane * 8); } \
        else { _Pragma("unroll") for (int i = 0; i < 8; ++i) xn[i] = *(const f32x4*)(xin + (size_t)(tt) * D + (i >> 1) * 512 + F.lane * 8 + (i & 1) * 4); } \
        if (Lprev >= 0) { _Pragma("unroll") for (int j = 0; j < 4; ++j) yn[j] = *(const h16x8*)(Y + (size_t)(tt) * D + j * 512 + F.lane * 8); } } while (0)
    if (F.bid * 8 + F.wave < S) NORM_LOAD(F.bid * 8 + F.wave);
    for (int t = F.bid * 8 + F.wave; t < S; t += F.G * 8) {
        f32x4 x[8]; h16x8 yc[4];
        if (Lprev >= 1) {
#pragma unroll
            for (int j = 0; j < 4; ++j)
#pragma unroll
                for (int e = 0; e < 4; ++e) { x[2 * j][e] = (float)xhn[j][e]; x[2 * j + 1][e] = (float)xhn[j][4 + e]; }
        } else {
#pragma unroll
            for (int i = 0; i < 8; ++i) x[i] = xn[i];
        }
#pragma unroll
        for (int j = 0; j < 4; ++j) yc[j] = yn[j];
        if (t + F.G * 8 < S) NORM_LOAD(t + F.G * 8);
        __builtin_amdgcn_sched_barrier(0);
        if (Lprev >= 0) {
            f32x4 y[8]; float ss = 0.f;
#pragma unroll
            for (int j = 0; j < 4; ++j) { const h16x8 yh = yc[j];
#pragma unroll
                for (int e = 0; e < 4; ++e) { y[2 * j][e] = (float)yh[e]; y[2 * j + 1][e] = (float)yh[4 + e]; }
                ss += y[2 * j][0] * y[2 * j][0] + y[2 * j][1] * y[2 * j][1] + y[2 * j][2] * y[2 * j][2] + y[2 * j][3] * y[2 * j][3]
                    + y[2 * j + 1][0] * y[2 * j + 1][0] + y[2 * j + 1][1] * y[2 * j + 1][1] + y[2 * j + 1][2] * y[2 * j + 1][2] + y[2 * j + 1][3] * y[2 * j + 1][3]; }
            ss = wave_sum(ss);
            const float r = 1.0f / sqrtf(ss * (1.0f / D) + EPS);
#pragma unroll
            for (int i = 0; i < 8; ++i) {
                const int li = (i >> 1) * 512 + (i & 1) * 256 + F.lane * 4;
                const f32x4 g = *(const f32x4*)(modl + 6144 + li); const f32x4 gt = *(const f32x4*)(modl + li);
#pragma unroll
                for (int e = 0; e < 4; ++e) x[i][e] += gt[e] * (y[i][e] * r * g[e]);
                if (Lnext < 0) *(f32x4*)(F.out + (size_t)t * D + (i >> 1) * 512 + F.lane * 8 + (i & 1) * 4) = x[i];
            }
            if (Lnext >= 0) {
#pragma unroll
                for (int j = 0; j < 4; ++j) { h16x8 xv;
#pragma unroll
                    for (int e = 0; e < 4; ++e) { xv[e] = (h16)x[2 * j][e]; xv[4 + e] = (h16)x[2 * j + 1][e]; }
                    *(h16x8*)(XS + (size_t)t * D + j * 512 + F.lane * 8) = xv; }
            }
        }
        if (Lnext >= 0) {
            float ss = 0.f;
#pragma unroll
            for (int i = 0; i < 8; ++i) ss += x[i][0] * x[i][0] + x[i][1] * x[i][1] + x[i][2] * x[i][2] + x[i][3] * x[i][3];
            ss = wave_sum(ss);
            const float r = 1.0f / sqrtf(ss * (1.0f / D) + EPS);
#pragma unroll
            for (int j = 0; j < 4; ++j) {
                h16x8 hv;
#pragma unroll
                for (int hf = 0; hf < 2; ++hf) {
                    const int li = j * 512 + hf * 256 + F.lane * 4;
                    const f32x4 g = *(const f32x4*)(modl + 8192 + li); const f32x4 sc = *(const f32x4*)(modl + 2048 + li); const f32x4 sh = *(const f32x4*)(modl + 4096 + li);
#pragma unroll
                    for (int e = 0; e < 4; ++e) hv[4 * hf + e] = (h16)((x[2 * j + hf][e] * r * g[e]) * (1.0f + sc[e]) + sh[e]);
                }
                *(h16x8*)(H + (size_t)t * D + j * 512 + F.lane * 8) = hv;
            }
        }
    }
#undef NP
#undef NORM_LOAD
    __syncthreads();
    if (Lnext > 0) conv_layer_weights(F, A, Lnext);
}

__device__ __forceinline__ void phase_nsa_cmp_a(const Frame& F, const Args& Ar) {
    if (F.bid >= 64 && F.G > 64) {
        conv_transpose(F, Ar.in[16], 2048, 12288, (h16*)(F.ws + WS_WTIN2), 12288, 0, F.bid - 64, F.G - 64, ret_early_a(F.G), ret_early_a(F.G) + ret_early_b(F.G));
        return;
    }
    const int u = F.bid, have = u < 64, kv = (u >> 5) & 1, mt = (u >> 2) & 7, kp = u & 3;
    const h16* A = (const h16*)(F.ws + WS_QKV) + (size_t)16 * S * 128 + (size_t)kv * 4 * S * 128 + kp * 1024;
    const h16* Bt = (const h16*)(F.ws + WS_W1T) + (size_t)kv * 256 * 4096 + kp * 1024;
    pg8::Gemm g{A, Bt, 2048, 256, 1024, 2048, 4096}; pg8::OneUnit So{mt, 0, have};
    pg8::EpiStore E{(float*)(F.ws + WS_OR) + (size_t)(kv * 4 + kp) * 2048 * 256, 256, 1};
    pg8::gemm_phase<pg8::EpiStore, pg8::OneUnit, true, true>((LAS unsigned char*)F.lds, g, So, E);
}
__device__ __forceinline__ void phase_nsa_cmp_b(const Frame& F, const Args& A) {
    float* hid = (float*)F.lds;
    float* red = hid + 4096;
    const float* part = (const float*)(F.ws + WS_OR); const float* b1 = (const float*)(F.ws + WS_CMPBF);
    for (int it = F.bid; it < 256; it += F.G) {
        const int kv = it >> 7, r0 = (it & 127) * 16;
        const float* W2 = kv ? A.in[15] : A.in[13];
        h16* dst = (h16*)(F.ws + (kv ? WS_VCMP : WS_KCMP));
        __syncthreads();
#pragma unroll
        for (int k = 0; k < 2; ++k) {
            const int i4 = F.tid * 4 + 2048 * k, r = r0 + (i4 >> 8), j = i4 & 255;
            f32x4 v = *(const f32x4*)(b1 + kv * 256 + j);
#pragma unroll
            for (int kp = 0; kp < 4; ++kp) v += *(const f32x4*)(part + ((size_t)(kv * 4 + kp) * 2048 + r) * 256 + j);
#pragma unroll
            for (int e = 0; e < 4; ++e) v[e] = silu_f(v[e]);
            *(f32x4*)(hid + i4) = v;
        }
        __syncthreads();
        const int d4 = (F.lane & 31) * 4, jb = 32 * F.wave + 16 * (F.lane >> 5);
        f32x4 wv[16];
#pragma unroll
        for (int jj = 0; jj < 16; ++jj) wv[jj] = *(const f32x4*)(W2 + (size_t)(jb + jj) * 128 + d4);
#pragma unroll
        for (int row = 0; row < 16; ++row) {
            f32x4 a = (f32x4){0.f, 0.f, 0.f, 0.f};
#pragma unroll
            for (int q = 0; q < 4; ++q) { const f32x4 hq = *(const f32x4*)(hid + row * 256 + jb + 4 * q);
                a += wv[4 * q] * hq[0] + wv[4 * q + 1] * hq[1] + wv[4 * q + 2] * hq[2] + wv[4 * q + 3] * hq[3]; }
#pragma unroll
            for (int e = 0; e < 4; ++e) a[e] += __shfl_xor(a[e], 32);
            if (F.lane < 32) *(f32x4*)(red + (F.wave * 16 + row) * 128 + d4) = a;
        }
        __syncthreads();
        { const int row = F.tid >> 5, dd = (F.tid & 31) * 4, r = r0 + row; f32x4 sm = (f32x4){0.f, 0.f, 0.f, 0.f};
#pragma unroll
          for (int w = 0; w < 8; ++w) sm += *(const f32x4*)(red + (w * 16 + row) * 128 + dd);
          h16x4 o;
#pragma unroll
          for (int e = 0; e < 4; ++e) o[e] = ((r & 511) < NC) ? (h16)sm[e] : (h16)0.f;
          *(h16x4*)(dst + (size_t)r * 128 + dd) = o; }
    }
}

namespace fa {
typedef float f32x16 __attribute__((ext_vector_type(16)));
typedef unsigned u32x2 __attribute__((ext_vector_type(2)));
constexpr float LOG2E = 1.4426950408889634f;
constexpr float MASKV = -3.0e38f;
constexpr int KROW = 256, VROW = 256;
constexpr int KT_BYTES = 64 * KROW, BUF_BYTES = KT_BYTES + 64 * VROW;
typedef short s16x4v __attribute__((__vector_size__(4 * sizeof(short))));
constexpr int LDS_IMP = 2 * BUF_BYTES;
constexpr int LDS_SELW = 4 * BUF_BYTES;
static_assert(LDS_SELW + 1024 <= MISC_OFF, "attention LDS map");

__device__ __forceinline__ void stage_dma(LAS unsigned char* buf, const h16* Kg, const h16* Vg, int j, int wave, int lane) {
    asm volatile("" : "+v"(lane));
#pragma unroll
    for (int i = 0; i < 2; ++i) {
        const int o = wave * 2048 + i * 1024, row = (o >> 8) + (lane >> 4), p = lane & 15;
        const h16* ks = Kg + (size_t)(j * 64 + row) * 128 + (p ^ (row & 15)) * 8;
        const h16* vs = Vg + (size_t)(j * 64 + row) * 128 + (p ^ ((row & 3) << 2)) * 8;
        __builtin_amdgcn_global_load_lds((const unsigned*)ks, (LAS unsigned*)(buf + o), 16, 0, 0);
        __builtin_amdgcn_global_load_lds((const unsigned*)vs, (LAS unsigned*)(buf + KT_BYTES + o), 16, 0, 0);
    }
}

template <int MODE>
__device__ __forceinline__ void tile_compute(const LAS unsigned char* buf, int j, const h16x8 (&qf)[8], f32x16 (&o)[4], float& m, float& l,
                                             bool on, int lo, int hi, int lane, float inv_l, LAS float* imp_q) {
    const int r31 = lane & 31, h = lane >> 5, k0 = j * 64;
    const bool need = on && (k0 <= hi) && (k0 + 63 >= lo);
    if (__ballot(need) == 0ull) return;
    const bool full = (k0 >= lo) && (k0 + 63 <= hi);
    const bool simple = (__ballot(on && !full) == 0ull);
    const bool skip = simple && !on;
    const float base = (MODE == 2 || m > 0.5f * NEGF) ? m : 0.f;
    const float init = skip ? -BIGF : -base;
    f32x16 s0, s1;
#pragma unroll
    for (int r = 0; r < 16; ++r) { s0[r] = init; s1[r] = init; }
    const LAS unsigned char* kp = buf + r31 * KROW;
    const int ksw = r31 & 15;
    {
        h16x8 ka[2][4];
#pragma unroll
        for (int e = 0; e < 2; ++e) { const int po = (((2 * e + h) ^ ksw) << 4); ka[0][2 * e] = *(const LAS h16x8*)(kp + po); ka[0][2 * e + 1] = *(const LAS h16x8*)(kp + 32 * KROW + po); }
#pragma unroll
        for (int g = 0; g < 4; ++g) {
            if (g < 3) {
#pragma unroll
                for (int e = 0; e < 2; ++e) { const int po = (((2 * (2 * (g + 1) + e) + h) ^ ksw) << 4); ka[(g + 1) & 1][2 * e] = *(const LAS h16x8*)(kp + po); ka[(g + 1) & 1][2 * e + 1] = *(const LAS h16x8*)(kp + 32 * KROW + po); }
            }
#pragma unroll
            for (int e = 0; e < 2; ++e) {
                s0 = __builtin_amdgcn_mfma_f32_32x32x16_f16(ka[g & 1][2 * e], qf[2 * g + e], s0, 0, 0, 0);
                s1 = __builtin_amdgcn_mfma_f32_32x32x16_f16(ka[g & 1][2 * e + 1], qf[2 * g + e], s1, 0, 0, 0);
            }
            __builtin_amdgcn_sched_barrier(0);
        }
    }
    if (!simple) {
        const int lo_e = lo < 0 ? 0 : lo;
        const unsigned span = (on && hi >= lo_e) ? (unsigned)(hi - lo_e) : 0u;
        const int a0 = (on && hi >= lo_e) ? lo_e - (k0 + 4 * h) : 1000;
#pragma unroll
        for (int r = 0; r < 16; ++r) {
            const int c = (r & 3) + 8 * (r >> 2);
            s0[r] = ((unsigned)(c - a0) <= span) ? s0[r] : MASKV; s1[r] = ((unsigned)(c + 32 - a0) <= span) ? s1[r] : MASKV;
        }
    }
    if (MODE != 2) {
        float tm;
        {
            float c4[4];
#pragma unroll
            for (int c = 0; c < 4; ++c) { const f32x16& sv = (c < 2) ? s0 : s1; const int b8 = 8 * (c & 1);
                float x = fmaxf(fmaxf(sv[b8], sv[b8 + 1]), sv[b8 + 2]); x = fmaxf(fmaxf(x, sv[b8 + 3]), sv[b8 + 4]); x = fmaxf(fmaxf(x, sv[b8 + 5]), sv[b8 + 6]); c4[c] = fmaxf(x, sv[b8 + 7]); }
            tm = fmaxf(fmaxf(fmaxf(c4[0], c4[1]), c4[2]), c4[3]);
        }
        const float tmax = (skip || !(tm > 0.5f * NEGF)) ? NEGF : tm + base;
        const float tmx = fmaxf(tmax, __shfl_xor(tmax, 32));
        const float m_new = (tmx > m + 8.0f) ? tmx : m;
        const float alpha = __builtin_amdgcn_exp2f(m - m_new);
        const float d = skip ? 0.f : (m_new - base);
        if (__ballot(d != 0.f) != 0ull) {
#pragma unroll
            for (int r = 0; r < 16; ++r) { s0[r] -= d; s1[r] -= d; }
        }
        f32x2 sa = (f32x2){0.f, 0.f}, sb = (f32x2){0.f, 0.f};
#pragma unroll
        for (int r = 0; r < 16; ++r) { s0[r] = __builtin_amdgcn_exp2f(s0[r]); s1[r] = __builtin_amdgcn_exp2f(s1[r]); }
#pragma unroll
        for (int r = 0; r < 8; ++r) { sa += (f32x2){s0[2 * r], s0[2 * r + 1]}; sb += (f32x2){s1[2 * r], s1[2 * r + 1]}; }
        l = l * alpha + ((sa[0] + sa[1]) + (sb[0] + sb[1]));
        const bool grew = m_new > m; m = m_new;
        if (MODE == 1) return;
        if (__ballot(grew) != 0ull) {
#pragma unroll
            for (int dt = 0; dt < 4; ++dt) o[dt] = o[dt] * alpha;
        }
    } else {
#pragma unroll
        for (int r = 0; r < 16; ++r) {
            s0[r] = __builtin_amdgcn_exp2f(s0[r]);
            s1[r] = __builtin_amdgcn_exp2f(s1[r]);
        }
#pragma unroll
        for (int c = 0; c < 4; ++c) {
            const int sa = 16 * j + 2 * c + h, sb = sa + 8;
            const float a0 = s0[4 * c] + s0[4 * c + 1] + s0[4 * c + 2] + 0.5f * s0[4 * c + 3], b0 = 0.5f * s0[4 * c + 3];
            const float a1 = s1[4 * c] + s1[4 * c + 1] + s1[4 * c + 2] + 0.5f * s1[4 * c + 3], b1 = 0.5f * s1[4 * c + 3];
            (void)__hip_atomic_fetch_add(imp_q + sa, a0, __ATOMIC_RELAXED, __HIP_MEMORY_SCOPE_WORKGROUP); if (sa + 1 < 128) (void)__hip_atomic_fetch_add(imp_q + sa + 1, b0, __ATOMIC_RELAXED, __HIP_MEMORY_SCOPE_WORKGROUP);
            (void)__hip_atomic_fetch_add(imp_q + sb, a1, __ATOMIC_RELAXED, __HIP_MEMORY_SCOPE_WORKGROUP); if (sb + 1 < 128) (void)__hip_atomic_fetch_add(imp_q + sb + 1, b1, __ATOMIC_RELAXED, __HIP_MEMORY_SCOPE_WORKGROUP);
        }
    }
    h16x8 pb[2][2];
#pragma unroll
    for (int sp = 0; sp < 2; ++sp)
#pragma unroll
        for (int jj = 0; jj < 8; ++jj) { pb[0][sp][jj] = (h16)s0[8 * sp + jj]; pb[1][sp][jj] = (h16)s1[8 * sp + jj]; }
    const int vq = (lane & 15) >> 2;
    const LAS unsigned char* vrow = buf + KT_BYTES + (4 * h + vq) * VROW + ((2 * ((lane >> 4) & 1) + ((lane & 3) >> 1)) << 4) + 8 * (lane & 1);
    {
        s16x4v vr[2][8];
#pragma unroll
        for (int f = 0; f < 4; ++f) { const LAS unsigned char* vp = vrow + 16 * f * VROW + ((0 ^ vq) << 6);
            vr[0][2 * f] = __builtin_amdgcn_ds_read_tr16_b64_v4i16((LAS s16x4v*)vp); vr[0][2 * f + 1] = __builtin_amdgcn_ds_read_tr16_b64_v4i16((LAS s16x4v*)(vp + 8 * VROW)); }
#pragma unroll
        for (int dt = 0; dt < 4; ++dt) {
            if (dt < 3) {
#pragma unroll
                for (int f = 0; f < 4; ++f) { const LAS unsigned char* vp = vrow + 16 * f * VROW + (((dt + 1) ^ vq) << 6);
                    vr[(dt + 1) & 1][2 * f] = __builtin_amdgcn_ds_read_tr16_b64_v4i16((LAS s16x4v*)vp); vr[(dt + 1) & 1][2 * f + 1] = __builtin_amdgcn_ds_read_tr16_b64_v4i16((LAS s16x4v*)(vp + 8 * VROW)); }
            }
#pragma unroll
            for (int f = 0; f < 4; ++f) {
                const h16x4 l4 = __builtin_bit_cast(h16x4, vr[dt & 1][2 * f]), h4 = __builtin_bit_cast(h16x4, vr[dt & 1][2 * f + 1]);
                h16x8 va; va[0] = l4[0]; va[1] = l4[1]; va[2] = l4[2]; va[3] = l4[3]; va[4] = h4[0]; va[5] = h4[1]; va[6] = h4[2]; va[7] = h4[3];
                o[dt] = __builtin_amdgcn_mfma_f32_32x32x16_f16(va, pb[f >> 1][f & 1], o[dt], 0, 0, 0);
            }
            __builtin_amdgcn_sched_barrier(0);
        }
    }
}

template <int MODE, class OnFn>
__device__ __forceinline__ void stream(LAS unsigned char* lds, const h16* Kg, const h16* VTg, int jlo, int jhi, const h16x8 (&qf)[8],
                                       f32x16 (&o)[4], float& m, float& l, int lo, int hi, const OnFn& on_fn, int tid, int lane, float inv_l, LAS float* imp_q, bool first_in_flight = false) {
    if (jlo >= jhi) return;
    const int wave = __builtin_amdgcn_readfirstlane(tid >> 6);
    if (!first_in_flight) stage_dma(lds, Kg, VTg, jlo, wave, lane);
    __syncthreads();
    for (int j = jlo; j < jhi; ++j) {
        const int cur = (j - jlo) & 1;
        if (j + 1 < jhi) stage_dma(lds + (cur ^ 1) * BUF_BYTES, Kg, VTg, j + 1, wave, lane);
        tile_compute<MODE>(lds + cur * BUF_BYTES, j, qf, o, m, l, on_fn(j), lo, hi, lane, inv_l, imp_q);
        __syncthreads();
    }
}

template <int MODE, class OnFn>
__device__ __forceinline__ void stream2(LAS unsigned char* lds, const h16* Kg, const h16* VTg, int jlo, int jhi, const h16x8 (&qf)[8],
                                        f32x16 (&o)[4], float& m, float& l, int lo, int hi, const OnFn& on_fn, int tid, int lane) {
    if (jlo >= jhi) return;
    const int wave = __builtin_amdgcn_readfirstlane(tid >> 6);
    stage_dma(lds, Kg, VTg, jlo, wave, lane);
    if (jlo + 1 < jhi) stage_dma(lds + BUF_BYTES, Kg, VTg, jlo + 1, wave, lane);
    __syncthreads();
    for (int j = jlo; j < jhi; j += 2) {
        const int b = ((j - jlo) >> 1) & 1;
        if (j + 2 < jhi) stage_dma(lds + (2 * (b ^ 1)) * BUF_BYTES, Kg, VTg, j + 2, wave, lane);
        if (j + 3 < jhi) stage_dma(lds + (2 * (b ^ 1) + 1) * BUF_BYTES, Kg, VTg, j + 3, wave, lane);
        const int n2 = (j + 1 < jhi) ? 2 : 1;
#pragma unroll 1
        for (int u = 0; u < n2; ++u) tile_compute<MODE>(lds + (2 * b + u) * BUF_BYTES, j + u, qf, o, m, l, on_fn(j + u), lo, hi, lane, 0.f, (LAS float*)nullptr);
        __syncthreads();
    }
}

__device__ __forceinline__ void load_q(h16x8 (&qf)[8], const h16* qrow, int h) {
#pragma unroll
    for (int s = 0; s < 8; ++s) qf[s] = *(const h16x8*)(qrow + 16 * s + 8 * h);
}
__device__ __forceinline__ void zero_o(f32x16 (&o)[4]) {
#pragma unroll
    for (int dt = 0; dt < 4; ++dt)
#pragma unroll
        for (int r = 0; r < 16; ++r) o[dt][r] = 0.f;
}
__device__ __forceinline__ h16x8 pack_swap(const f32x16& od, int cp, float sc, float sub = 0.f) {
    h16x4 A, B;
#pragma unroll
    for (int e = 0; e < 4; ++e) { A[e] = (h16)((od[8 * cp + e] - sub) * sc); B[e] = (h16)((od[8 * cp + 4 + e] - sub) * sc); }
    const u32x2 a = __builtin_bit_cast(u32x2, A), b = __builtin_bit_cast(u32x2, B);
    const auto r0 = __builtin_amdgcn_permlane32_swap(a[0], b[0], false, false), r1 = __builtin_amdgcn_permlane32_swap(a[1], b[1], false, false);
    const u32x4 w = (u32x4){r0[0], r1[0], r0[1], r1[1]};
    return __builtin_bit_cast(h16x8, w);
}
}

struct MobaOn { unsigned selmask; int b; __device__ __forceinline__ bool operator()(int j) const { const int jb = j >> 2; return jb == b ? true : (((selmask >> jb) & 1u) != 0u); } };
__device__ __forceinline__ void phase_moba_attn_mfma(const Frame& F) {
    const h16* Q = (const h16*)(F.ws + WS_QKV); const h16* K = Q + (size_t)16 * S * 128; const h16* VT = K + (size_t)16 * S * 128; const h16* Z = VT + (size_t)16 * S * 128;
    const float* kmean = (const float*)(F.ws + WS_KMEAN);
    h16* OZ = (h16*)(F.ws + WS_OZ);
    LAS unsigned char* lds = (LAS unsigned char*)F.lds;
    const int lane = F.lane, r31 = lane & 31, h = lane >> 5;
    for (int it = F.bid; it < 256; it += F.G) {
        const int head = it >> 4, pi = it & 15;
#pragma unroll 1
        for (int half = 0; half < 2; ++half) {
            const int b = half ? 31 - pi : pi;
            const int t = b * 256 + F.wave * 32 + r31;
            h16x8 qf[8]; fa::load_q(qf, Q + ((size_t)head * S + t) * 128, h);
            LAS float* kml = (LAS float*)(lds + 2 * fa::BUF_BYTES);
            __syncthreads();
            for (int i = F.tid; i < b * 32; i += NTHREADS) { const float* km = kmean + (size_t)head * 32 * 128 + i * 4; *(LAS f32x4*)(kml + i * 4) = *(const f32x4*)km + *(const f32x4*)(km + 65536); }
            __syncthreads();
            float v0 = NEGF, v1 = NEGF, v2 = NEGF; int i0 = -1, i1 = -1, i2 = -1;
            for (int jb = 0; jb < b; ++jb) {
                const LAS float* km = kml + jb * 128 + 8 * h;
                float d = 0.f;
#pragma unroll
                for (int s = 0; s < 8; ++s) { const f32x4 ka = *(const LAS f32x4*)(km + 16 * s), kb = *(const LAS f32x4*)(km + 16 * s + 4);
                    d += (float)qf[s][0] * ka[0] + (float)qf[s][1] * ka[1] + (float)qf[s][2] * ka[2] + (float)qf[s][3] * ka[3] + (float)qf[s][4] * kb[0] + (float)qf[s][5] * kb[1] + (float)qf[s][6] * kb[2] + (float)qf[s][7] * kb[3]; }
                d += __shfl_xor(d, 32);
                if (d > v0) { v2 = v1; i2 = i1; v1 = v0; i1 = i0; v0 = d; i0 = jb; }
                else if (d > v1) { v2 = v1; i2 = i1; v1 = d; i1 = jb; }
                else if (d > v2) { v2 = d; i2 = jb; }
            }
            MobaOn on; on.b = b; on.selmask = (i0 >= 0 ? 1u << i0 : 0u) | (i1 >= 0 ? 1u << i1 : 0u) | (i2 >= 0 ? 1u << i2 : 0u);
            fa::f32x16 o[4]; fa::zero_o(o); float m = NEGF, l = 0.f;
            fa::stream<0>(lds, K + (size_t)head * S * 128, VT + (size_t)head * S * 128, 0, 4 * b + 4, qf, o, m, l, 0, t, on, F.tid, lane, 0.f, (LAS float*)nullptr);
            l += __shfl_xor(l, 32);
            const float inv = 1.0f / fmaxf(l, 1e-30f);
#pragma unroll
            for (int dt = 0; dt < 4; ++dt)
#pragma unroll
                for (int c = 0; c < 4; ++c) {
                    const int d = 32 * dt + 8 * c + 4 * h; const size_t off = (size_t)t * 2048 + head * 128 + d;
                    const h16x4 zz = *(const h16x4*)(Z + off); h16x4 ov;
#pragma unroll
                    for (int e = 0; e < 4; ++e) ov[e] = (h16)(o[dt][4 * c + e] * inv * (float)zz[e]);
                    *(h16x4*)(OZ + off) = ov;
                }
        }
    }
}

constexpr size_t WS_MLIST = WS_P;
constexpr size_t WS_MPO = WS_P + 16 * MiB;
constexpr size_t WS_MPML = WS_P + 144 * MiB;
constexpr int CW_MCNT = 8192;
struct ValidOn { bool v; __device__ __forceinline__ bool operator()(int) const { return v; } };

__device__ __forceinline__ void phase_moba_gate(const Frame& F, int jl) {
    const h16* Q = (const h16*)(F.ws + WS_QKV);
    const float* kmean = (const float*)(F.ws + WS_KMEAN);
    unsigned* cnt = (unsigned*)(F.ws + WS_CTL) + CW_MCNT + jl * 512;
    unsigned* list = (unsigned*)(F.ws + WS_MLIST);
    LAS unsigned char* lds = (LAS unsigned char*)F.lds;
    LAS float* kml = (LAS float*)lds;
    const int lane = F.lane, r31 = lane & 31, h = lane >> 5;
    for (int it = F.bid; it < 496; it += F.G) {
        const int head = it / 31, b = it % 31 + 1;
        const int t = b * 256 + F.wave * 32 + r31;
        h16x8 qf[8]; fa::load_q(qf, Q + ((size_t)head * S + t) * 128, h);
        __syncthreads();
        { const int row = F.tid >> 4, ch = F.tid & 15; const float* km = kmean + ((size_t)head * 32 + row) * 128 + ch * 8;
          const f32x4 m0 = *(const f32x4*)km + *(const f32x4*)(km + 65536), m1 = *(const f32x4*)(km + 4) + *(const f32x4*)(km + 4 + 65536);
          h16x8 hi, lo;
#pragma unroll
          for (int e = 0; e < 4; ++e) { hi[e] = (h16)m0[e]; lo[e] = (h16)(m0[e] - (float)hi[e]); hi[4 + e] = (h16)m1[e]; lo[4 + e] = (h16)(m1[e] - (float)hi[4 + e]); }
          const int pos = row * 256 + ((ch ^ (row & 15)) << 4);
          *(LAS h16x8*)(lds + pos) = hi; *(LAS h16x8*)(lds + 8192 + pos) = lo; }
        __syncthreads();
        fa::f32x16 sc;
#pragma unroll
        for (int r = 0; r < 16; ++r) sc[r] = 0.f;
        { const LAS unsigned char* kp = lds + r31 * 256; const int ksw = r31 & 15;
#pragma unroll
          for (int ks = 0; ks < 8; ++ks) { const int po = ((2 * ks + h) ^ ksw) << 4;
              sc = __builtin_amdgcn_mfma_f32_32x32x16_f16(*(const LAS h16x8*)(kp + po), qf[ks], sc, 0, 0, 0);
              sc = __builtin_amdgcn_mfma_f32_32x32x16_f16(*(const LAS h16x8*)(kp + 8192 + po), qf[ks], sc, 0, 0, 0); } }
        float v0 = NEGF, v1 = NEGF, v2 = NEGF; int i0 = -1, i1 = -1, i2 = -1;
#define TOP3_INS(dv, di) do { const float d_ = (dv); const int j_ = (di); \
            if (d_ > v0) { v2 = v1; i2 = i1; v1 = v0; i1 = i0; v0 = d_; i0 = j_; } else if (d_ > v1) { v2 = v1; i2 = i1; v1 = d_; i1 = j_; } else if (d_ > v2) { v2 = d_; i2 = j_; } } while (0)
#pragma unroll
        for (int r = 0; r < 16; ++r) { const int jb = (r & 3) + 8 * (r >> 2) + 4 * h; TOP3_INS(jb < b ? sc[r] : NEGF, jb); }
        { const float p0 = __shfl_xor(v0, 32), p1 = __shfl_xor(v1, 32), p2 = __shfl_xor(v2, 32); const int q0 = __shfl_xor(i0, 32), q1 = __shfl_xor(i1, 32), q2 = __shfl_xor(i2, 32);
          TOP3_INS(p0, q0); TOP3_INS(p1, q1); TOP3_INS(p2, q2); }
#undef TOP3_INS
        const unsigned long long below = (lane == 0) ? 0ull : (~0ull >> (64 - lane));
        unsigned cntv = 0u; int rk0 = 0, rk1 = 0, rk2 = 0;
        for (int jb = 0; jb < b; ++jb) {
            const bool s0_ = (h == 0) && (i0 == jb), s1_ = (h == 0) && (i1 == jb), s2_ = (h == 0) && (i2 == jb);
            const unsigned long long mk = __ballot(s0_ || s1_ || s2_);
            const int rk = __popcll(mk & below);
            if (s0_) rk0 = rk; if (s1_) rk1 = rk; if (s2_) rk2 = rk;
            if (lane == jb) cntv = (unsigned)__popcll(mk);
        }
        unsigned base = 0u;
        if (lane < b && cntv != 0u) base = __hip_atomic_fetch_add(cnt + head * 32 + lane, cntv, __ATOMIC_RELAXED, __HIP_MEMORY_SCOPE_AGENT);
        const unsigned b0 = __shfl(base, i0 >= 0 ? i0 : 0), b1 = __shfl(base, i1 >= 0 ? i1 : 0), b2 = __shfl(base, i2 >= 0 ? i2 : 0);
        if (h == 0) {
            if (i0 >= 0) list[((size_t)head * 32 + i0) * 8192 + b0 + rk0] = (unsigned)t;
            if (i1 >= 0) list[((size_t)head * 32 + i1) * 8192 + b1 + rk1] = (unsigned)t | (1u << 16);
            if (i2 >= 0) list[((size_t)head * 32 + i2) * 8192 + b2 + rk2] = (unsigned)t | (2u << 16);
        }
    }
}

constexpr int CW_MQ = 9216;
constexpr int MR = 4;
__device__ __forceinline__ void phase_moba_attn_sparse(const Frame& F, int jl) {
    const h16* Q = (const h16*)(F.ws + WS_QKV); const h16* K = Q + (size_t)16 * S * 128; const h16* V = K + (size_t)16 * S * 128;
    const unsigned* cnt = (const unsigned*)(F.ws + WS_CTL) + CW_MCNT + jl * 512;
    unsigned* qctr = (unsigned*)(F.ws + WS_CTL) + CW_MQ + jl;
    const unsigned* list = (const unsigned*)(F.ws + WS_MLIST);
    h16* PO = (h16*)(F.ws + WS_MPO); float* PML = (float*)(F.ws + WS_MPML);
    LAS unsigned char* lds = (LAS unsigned char*)F.lds;
    LAS unsigned* pre = (LAS unsigned*)(lds + 4 * fa::BUF_BYTES);
    LAS unsigned* wsum = pre + 516;
    LAS unsigned* tick = pre + 524;
    static_assert(4 * fa::BUF_BYTES + 526 * 4 <= MISC_OFF, "block-resident MoBA LDS map");
    const int lane = F.lane, r31 = lane & 31, h = lane >> 5;
    __syncthreads();
    { const unsigned n = cnt[F.tid]; const unsigned nch = (n + 255u) >> 8; const unsigned u = (nch + MR - 1) / MR; unsigned x = u;
#pragma unroll
      for (int o = 1; o < 64; o <<= 1) { const unsigned y = __shfl_up(x, o); if (lane >= o) x += y; }
      if (lane == 63) wsum[F.wave] = x;
      __syncthreads();
      unsigned off = 0u;
      for (int w = 0; w < F.wave; ++w) off += wsum[w];
      pre[F.tid] = off + x - u;
      if (F.tid == NTHREADS - 1) pre[512] = off + x;
      __syncthreads(); }
    const unsigned TG = pre[512], TT = TG + 512u;
    unsigned nxt = 0u;
    if (F.tid == 0) nxt = __hip_atomic_fetch_add(qctr, 1u, __ATOMIC_RELAXED, __HIP_MEMORY_SCOPE_AGENT);
    for (;;) {
        __syncthreads();
        if (F.tid == 0) tick[0] = nxt;
        __syncthreads();
        const unsigned tk = tick[0];
        if (tk >= TT) break;
        if (F.tid == 0) nxt = __hip_atomic_fetch_add(qctr, 1u, __ATOMIC_RELAXED, __HIP_MEMORY_SCOPE_AGENT);
        int head, jt0, li, nchunk; unsigned e0;
        if (tk >= TG) { const int u = (int)(tk - TG); head = u >> 5; jt0 = 4 * (u & 31); li = -1; e0 = 0u; nchunk = 1; }
        else { int lo2 = 0, hi2 = 512;
            while (hi2 - lo2 > 1) { const int mid = (lo2 + hi2) >> 1; if (pre[mid] <= tk) lo2 = mid; else hi2 = mid; }
            li = lo2; head = lo2 >> 5; jt0 = 4 * (lo2 & 31);
            const int c0 = (int)(tk - pre[lo2]) * MR, nch = (int)((cnt[li] + 255u) >> 8);
            e0 = (unsigned)c0 * 256u; nchunk = (nch - c0) < MR ? (nch - c0) : MR; }
#pragma unroll
        for (int j = 0; j < 4; ++j) fa::stage_dma(lds + j * fa::BUF_BYTES, K + (size_t)head * S * 128, V + (size_t)head * S * 128, jt0 + j, F.wave, lane);
        __syncthreads();
        for (int ch = 0; ch < nchunk; ++ch) {
            int slot = 3, t; bool valid = true;
            if (li < 0) { t = (jt0 >> 2) * 256 + F.wave * 32 + r31; }
            else {
                const unsigned e = e0 + (unsigned)ch * 256u + F.wave * 32 + r31, n = cnt[li];
                valid = e < n;
                const unsigned ent = valid ? list[(size_t)li * 8192 + e] : 0u;
                t = (int)(ent & 0xFFFFu); slot = (int)(ent >> 16);
            }
            h16x8 qf[8]; fa::load_q(qf, Q + ((size_t)head * S + t) * 128, h);
            fa::f32x16 o[4]; fa::zero_o(o); float m = NEGF, l = 0.f;
            const int hi = (li < 0) ? t : S;
#pragma unroll 1
            for (int j = 0; j < 4; ++j) fa::tile_compute<0>(lds + j * fa::BUF_BYTES, jt0 + j, qf, o, m, l, valid, 0, hi, lane, 0.f, (LAS float*)nullptr);
            l += __shfl_xor(l, 32);
            {
                const float inv = 1.0f / fmaxf(l, 1e-30f);
                const size_t pidx = ((size_t)t * 16 + head) * 4 + slot;
#pragma unroll
                for (int dt = 0; dt < 4; ++dt)
#pragma unroll
                    for (int cp = 0; cp < 2; ++cp) { const h16x8 w = fa::pack_swap(o[dt], cp, inv); if (valid) *(h16x8*)(PO + pidx * 128 + 32 * dt + 16 * cp + 8 * h) = w; }
                if (valid && h == 0) *(f32x2*)(PML + pidx * 2) = (f32x2){m, l};
            }
        }
    }
}

__device__ __forceinline__ void phase_moba_merge(const Frame& F) {
    const h16* __restrict__ Z = (const h16*)(F.ws + WS_QKV) + (size_t)48 * S * 128;
    const h16* __restrict__ PO = (const h16*)(F.ws + WS_MPO); const float* __restrict__ PML = (const float*)(F.ws + WS_MPML);
    h16* __restrict__ OZ = (h16*)(F.ws + WS_OZ);
    const int sub = F.lane >> 4, dc = (F.lane & 15) * 8;
    const int stride = F.G * 8 * 4;
    for (int p0 = (F.bid * 8 + F.wave) * 4; p0 < S * 16; p0 += 2 * stride) {
        int pr[2]; bool ok[2]; f32x4 ml01[2], ml23[2]; h16x8 x0[2], x1[2], x2[2], x3[2], zz[2];
#pragma unroll
        for (int u = 0; u < 2; ++u) {
            pr[u] = p0 + u * stride + sub; ok[u] = (p0 + u * stride) < S * 16; if (!ok[u]) pr[u] = sub;
            ml01[u] = *(const f32x4*)(PML + (size_t)pr[u] * 8); ml23[u] = *(const f32x4*)(PML + (size_t)pr[u] * 8 + 4);
            const h16* po = PO + (size_t)pr[u] * 512 + dc;
            x0[u] = *(const h16x8*)(po); x1[u] = *(const h16x8*)(po + 128); x2[u] = *(const h16x8*)(po + 256); x3[u] = *(const h16x8*)(po + 384);
            zz[u] = *(const h16x8*)(Z + (size_t)(pr[u] >> 4) * 2048 + (pr[u] & 15) * 128 + dc);
        }
#pragma unroll
        for (int u = 0; u < 2; ++u) {
            const int t = pr[u] >> 4, head = pr[u] & 15, nsel = (t >> 8) < 3 ? (t >> 8) : 3;
            const float m3 = ml23[u][2], l3 = ml23[u][3];
            const float m0 = nsel > 0 ? ml01[u][0] : NEGF, m1 = nsel > 1 ? ml01[u][2] : NEGF, m2 = nsel > 2 ? ml23[u][0] : NEGF;
            const float M = fmaxf(fmaxf(m0, m1), fmaxf(m2, m3));
            const float w0 = nsel > 0 ? ml01[u][1] * __builtin_amdgcn_exp2f(m0 - M) : 0.f, w1 = nsel > 1 ? ml01[u][3] * __builtin_amdgcn_exp2f(m1 - M) : 0.f;
            const float w2 = nsel > 2 ? ml23[u][1] * __builtin_amdgcn_exp2f(m2 - M) : 0.f, w3 = l3 * __builtin_amdgcn_exp2f(m3 - M);
            const float inv = 1.0f / fmaxf((w0 + w1) + (w2 + w3), 1e-30f);
            h16x8 ov;
#pragma unroll
            for (int e = 0; e < 8; ++e) {
                float a = w3 * (float)x3[u][e];
                a += nsel > 0 ? w0 * (float)x0[u][e] : 0.f; a += nsel > 1 ? w1 * (float)x1[u][e] : 0.f; a += nsel > 2 ? w2 * (float)x2[u][e] : 0.f;
                ov[e] = (h16)(a * inv * (float)zz[u][e]);
            }
            if (ok[u]) *(h16x8*)(OZ + (size_t)t * 2048 + head * 128 + dc) = ov;
        }
    }
}

struct AllOn { __device__ __forceinline__ bool operator()(int) const { return true; } };
struct SelOn { const LAS unsigned* w; __device__ __forceinline__ bool operator()(int j) const { return ((w[j >> 5] >> (j & 31)) & 1u) != 0u; } };
__device__ __forceinline__ void phase_nsa_attn_mfma(const Frame& F) {
    const h16* Q = (const h16*)(F.ws + WS_QKV); const h16* KVb = Q + (size_t)16 * S * 128;
    const h16* Z = (const h16*)(F.ws + WS_QKV + 96 * MiB);
    const float* gates = (const float*)(F.ws + WS_GATES);
    const h16* KCMP = (const h16*)(F.ws + WS_KCMP); const h16* VCMPT = (const h16*)(F.ws + WS_VCMP);
    h16* OZ = (h16*)(F.ws + WS_OZ);
    LAS unsigned char* lds = (LAS unsigned char*)F.lds;
    LAS float* imp = (LAS float*)(lds + fa::LDS_IMP); LAS unsigned* selw = (LAS unsigned*)(lds + fa::LDS_SELW);
    const int lane = F.lane, r31 = lane & 31, h = lane >> 5, hh = r31 >> 3;
    for (int it = F.vcu; it < 256; it += F.G) {
        const int g = it >> 6, pi = it & 63, head = 4 * g + hh;
#pragma unroll 1
        for (int half = 0; half < 2; ++half) {
            const int c64 = half ? 127 - pi : pi;
            const int ql = 8 * F.wave + (r31 & 7), t = c64 * 64 + ql;
            h16x8 qf[8]; fa::load_q(qf, Q + ((size_t)head * S + t) * 128, h);
            fa::f32x16 o[4]; float m, l;
            for (int i = F.tid; i < 64 * 128; i += NTHREADS) imp[i] = 0.f;
            const int nval = (t >= 31) ? (((t - 31) >> 4) + 1 < NC ? ((t - 31) >> 4) + 1 : NC) : 0;
            const int tl = c64 * 64 + 63; const int nval_max = (tl >= 31) ? (((tl - 31) >> 4) + 1 < NC ? ((tl - 31) >> 4) + 1 : NC) : 0;
            const int jc = (nval_max + 63) >> 6;
            fa::zero_o(o); m = NEGF; l = 0.f;
            fa::stream<1>(lds, KCMP + (size_t)g * 512 * 128, VCMPT + (size_t)g * 512 * 128, 0, jc, qf, o, m, l, 0, nval - 1, AllOn(), F.tid, lane, 0.f, (LAS float*)nullptr);
            l += __shfl_xor(l, 32);
            { float mref = m + __builtin_amdgcn_logf(fmaxf(l, 1e-30f)), l2 = 0.f;
              fa::stream<2>(lds, KCMP + (size_t)g * 512 * 128, VCMPT + (size_t)g * 512 * 128, 0, jc, qf, o, mref, l2, 0, nval - 1, AllOn(), F.tid, lane, 0.f, imp + ql * 128); }
            const float g0 = gates[(size_t)t * 48 + head * 3 + 0];
#pragma unroll
            for (int dt = 0; dt < 4; ++dt)
#pragma unroll
                for (int cp = 0; cp < 2; ++cp) *(h16x8*)(OZ + (size_t)t * 2048 + head * 128 + 32 * dt + 16 * cp + 8 * h) = fa::pack_swap(o[dt], cp, g0);
            __syncthreads();
            for (int qq = 0; qq < 8; ++qq) {
                const int q = F.wave * 8 + qq;
                unsigned u0, u1;
                { const int s = lane; const bool valid = s <= c64, forced = (s == 0) || (s == c64) || (s == c64 - 1);
                  const unsigned bits = __float_as_uint(valid ? (forced ? BIGF : imp[q * 128 + s]) : NEGF); u0 = bits ^ ((bits >> 31) ? 0xFFFFFFFFu : 0x80000000u); }
                { const int s = lane + 64; const bool valid = s <= c64, forced = (s == c64) || (s == c64 - 1);
                  const unsigned bits = __float_as_uint(valid ? (forced ? BIGF : imp[q * 128 + s]) : NEGF); u1 = bits ^ ((bits >> 31) ? 0xFFFFFFFFu : 0x80000000u); }
                unsigned T = 0u;
                for (int bit = 31; bit >= 0; --bit) {
                    const unsigned trial = T | (1u << bit);
                    const int cnt = __popcll(__ballot(u0 >= trial)) + __popcll(__ballot(u1 >= trial));
                    if (cnt >= 16) T = trial;
                    if (cnt == 16) { T = trial - 1u; break; }
                }
                const unsigned long long g0 = __ballot(u0 > T), g1 = __ballot(u1 > T), e0 = __ballot(u0 == T), e1 = __ballot(u1 == T);
                const int need = 16 - (__popcll(g0) + __popcll(g1)), n0 = __popcll(e0);
                const int take0 = need < n0 ? need : n0, take1 = need - take0;
                const unsigned long long below = (lane == 0) ? 0ull : (~0ull >> (64 - lane));
                const unsigned long long se0 = __ballot(((e0 >> lane) & 1ull) && __popcll(e0 & below) < take0), se1 = __ballot(((e1 >> lane) & 1ull) && __popcll(e1 & below) < take1);
                const unsigned long long m0 = __ballot((((g0 | se0) >> lane) & 1ull) && lane <= c64), m1 = __ballot((((g1 | se1) >> lane) & 1ull) && (lane + 64) <= c64);
                if (lane == 0) { selw[q * 4 + 0] = (unsigned)m0; selw[q * 4 + 1] = (unsigned)(m0 >> 32); selw[q * 4 + 2] = (unsigned)m1; selw[q * 4 + 3] = (unsigned)(m1 >> 32); }
            }
            __syncthreads();
            SelOn son; son.w = selw + ql * 4;
            fa::zero_o(o); m = NEGF; l = 0.f;
            fa::stream2<0>(lds, KVb + ((size_t)2 * 4 + g) * S * 128, KVb + ((size_t)3 * 4 + g) * S * 128, 0, c64 + 1, qf, o, m, l, 0, t, son, F.tid, lane);
            l += __shfl_xor(l, 32);
            { const float sc = gates[(size_t)t * 48 + head * 3 + 1] / fmaxf(l, 1e-30f);
#pragma unroll
              for (int dt = 0; dt < 4; ++dt)
#pragma unroll
                  for (int cp = 0; cp < 2; ++cp) { h16* p = OZ + (size_t)t * 2048 + head * 128 + 32 * dt + 16 * cp + 8 * h; const h16x8 pv = *(const h16x8*)p;
                      *(h16x8*)p = pv + fa::pack_swap(o[dt], cp, sc); } }
            fa::zero_o(o); m = NEGF; l = 0.f;
            fa::stream<0>(lds, KVb + ((size_t)4 * 4 + g) * S * 128, KVb + ((size_t)5 * 4 + g) * S * 128, (c64 >= 8 ? c64 - 8 : 0), c64 + 1, qf, o, m, l, t - 511, t, AllOn(), F.tid, lane, 0.f, (LAS float*)nullptr);
            l += __shfl_xor(l, 32);
            const float sc2 = gates[(size_t)t * 48 + head * 3 + 2] / fmaxf(l, 1e-30f);
#pragma unroll
            for (int dt = 0; dt < 4; ++dt)
#pragma unroll
                for (int cp = 0; cp < 2; ++cp) {
                    const int d = 32 * dt + 16 * cp + 8 * h; const size_t off = (size_t)t * 2048 + head * 128 + d;
                    const h16x8 zz = *(const h16x8*)(Z + off); const h16x8 pv = *(const h16x8*)(OZ + off);
                    *(h16x8*)(OZ + off) = (pv + fa::pack_swap(o[dt], cp, sc2)) * zz;
                }
        }
    }
}

namespace rt {
typedef float f32x16 __attribute__((ext_vector_type(16)));
typedef short s16x4v __attribute__((__vector_size__(4 * sizeof(short))));
constexpr int SP = 144, STILE = 128 * SP;
constexpr int VP = 1088, VTILE = 32 * VP;
constexpr int KP = 528, KTILE = 32 * KP, OTILE = VTILE + KTILE;
__device__ __forceinline__ h16x8 tr16(const LAS unsigned char* p0, const LAS unsigned char* p1) {
    const s16x4v a = __builtin_amdgcn_ds_read_tr16_b64_v4i16((LAS s16x4v*)p0), b = __builtin_amdgcn_ds_read_tr16_b64_v4i16((LAS s16x4v*)p1);
    const h16x4 x = __builtin_bit_cast(h16x4, a), y = __builtin_bit_cast(h16x4, b);
    h16x8 r; r[0] = x[0]; r[1] = x[1]; r[2] = x[2]; r[3] = x[3]; r[4] = y[0]; r[5] = y[1]; r[6] = y[2]; r[7] = y[3]; return r;
}
}
__device__ __forceinline__ void phase_ret_scan_mfma(const Frame& F, const Args& A) {
    const h16* RQ = (const h16*)(F.ws + WS_QKV); const h16* RK = RQ + (size_t)8 * S * 256; const h16* RV = RK + (size_t)8 * S * 256;
    h16* ST = (h16*)(F.ws + WS_P);
    LAS unsigned char* lds = (LAS unsigned char*)F.lds;
    const int lane = F.lane, g = lane >> 4, q = (lane & 15) >> 2, p = lane & 3, mr = F.wave >> 1, nc0 = (F.wave & 1) * 2;
    for (int it = F.vcu; it < 256; it += F.G) {
        const int h = it >> 5, dk0 = ((it >> 3) & 3) * 64, dv0 = (it & 7) * 64;
        const float lg = A.lg2g[h], carry = __builtin_amdgcn_exp2f(128.f * lg);
        f32x4 acc[2] = {(f32x4){0.f, 0.f, 0.f, 0.f}, (f32x4){0.f, 0.f, 0.f, 0.f}};
        u32x4 k0r[2], v0r[2], k1r[2], v1r[2], k2r[2], v2r[2];
#define RT_LOAD(kreg, vreg, c) do { int tid_ = F.tid; asm volatile("" : "+v"(tid_)); _Pragma("unroll") for (int i = 0; i < 2; ++i) { const int idx = tid_ + 512 * i, row = idx >> 3, c16 = idx & 7; \
            kreg[i] = *(const u32x4*)(RK + ((size_t)h * S + (c) * 128 + row) * 256 + dk0 + c16 * 8); vreg[i] = *(const u32x4*)(RV + ((size_t)h * S + (c) * 128 + row) * 512 + dv0 + c16 * 8); } } while (0)
#define RT_WRITE(kreg, vreg, b) do { int tid_ = F.tid; asm volatile("" : "+v"(tid_)); _Pragma("unroll") for (int i = 0; i < 2; ++i) { const int idx = tid_ + 512 * i, row = idx >> 3, c16 = idx & 7; \
            const float w = __builtin_amdgcn_exp2f((float)(127 - row) * lg); h16x8 kk = __builtin_bit_cast(h16x8, kreg[i]); \
            _Pragma("unroll") for (int e = 0; e < 8; ++e) kk[e] = (h16)((float)kk[e] * w); \
            *(LAS h16x8*)(lds + (b) * 2 * rt::STILE + row * rt::SP + c16 * 16) = kk; *(LAS u32x4*)(lds + (b) * 2 * rt::STILE + rt::STILE + row * rt::SP + c16 * 16) = vreg[i]; } } while (0)
#define RT_STEP(c, CK, CV, NK, NV) do { \
            { h16x4 oa, ob; _Pragma("unroll") for (int e = 0; e < 4; ++e) { oa[e] = (h16)acc[0][e]; ob[e] = (h16)acc[1][e]; } \
              const fa::u32x2 ua = __builtin_bit_cast(fa::u32x2, oa), ub = __builtin_bit_cast(fa::u32x2, ob); \
              const auto r0 = __builtin_amdgcn_permlane16_swap(ua[0], ub[0], false, false), r1 = __builtin_amdgcn_permlane16_swap(ua[1], ub[1], false, false); \
                \
              *(u32x4*)(ST + (((size_t)(h * 64 + (c))) * 512 + dv0 + 16 * (nc0 + (g & 1)) + (lane & 15)) * 256 + dk0 + 16 * mr + 8 * (g >> 1)) = (u32x4){r0[0], r1[0], r0[1], r1[1]}; } \
            acc[0] = acc[0] * carry; acc[1] = acc[1] * carry; \
            const LAS unsigned char* kt = lds + ((c) & 1) * 2 * rt::STILE + (8 * g + q) * rt::SP + (16 * mr + 4 * p) * 2; \
            const LAS unsigned char* vt = lds + ((c) & 1) * 2 * rt::STILE + rt::STILE + (8 * g + q) * rt::SP + (16 * nc0 + 4 * p) * 2; \
            _Pragma("unroll") for (int ks = 0; ks < 4; ++ks) { \
                const h16x8 a = rt::tr16(kt + 32 * ks * rt::SP, kt + (32 * ks + 4) * rt::SP); \
                const h16x8 b0 = rt::tr16(vt + 32 * ks * rt::SP, vt + (32 * ks + 4) * rt::SP); \
                const h16x8 b1 = rt::tr16(vt + 32 * ks * rt::SP + 32, vt + (32 * ks + 4) * rt::SP + 32); \
                acc[0] = __builtin_amdgcn_mfma_f32_16x16x32_f16(a, b0, acc[0], 0, 0, 0); \
                acc[1] = __builtin_amdgcn_mfma_f32_16x16x32_f16(a, b1, acc[1], 0, 0, 0); } \
            if ((c) + 1 < 64) RT_WRITE(NK, NV, ((c) + 1) & 1); \
            if ((c) + 3 < 64) RT_LOAD(CK, CV, (c) + 3); \
            __syncthreads(); } while (0)
        __syncthreads();
        RT_LOAD(k0r, v0r, 0); RT_WRITE(k0r, v0r, 0);
        RT_LOAD(k1r, v1r, 1); RT_LOAD(k2r, v2r, 2);
        __syncthreads();
        for (int c = 0; c < 63; c += 3) {
            RT_STEP(c, k0r, v0r, k1r, v1r);
            RT_STEP(c + 1, k1r, v1r, k2r, v2r);
            RT_STEP(c + 2, k2r, v2r, k0r, v0r);
        }
        RT_STEP(63, k0r, v0r, k1r, v1r);
#undef RT_STEP
#undef RT_LOAD
#undef RT_WRITE
    }
}

__device__ __forceinline__ void phase_ret_out_mfma(const Frame& F, const Args& A) {
    const h16* RQ = (const h16*)(F.ws + WS_QKV); const h16* RK = RQ + (size_t)8 * S * 256; const h16* RV = RK + (size_t)8 * S * 256; const h16* RG = RV + (size_t)8 * S * 512;
    const h16* ST = (const h16*)(F.ws + WS_P);
    h16* OZ = (h16*)(F.ws + WS_OZ);
    LAS unsigned char* lds = (LAS unsigned char*)F.lds;
    LAS float* stats = (LAS float*)(lds + 2 * rt::OTILE);
    const int lane = F.lane, r31 = lane & 31, hh = lane >> 5, itl = F.wave & 3, dvh = F.wave >> 2;
    for (int it = F.bid; it < 512; it += F.G) {
        const int h = it >> 6, c = it & 63, il = 32 * itl + r31, tok = c * 128 + il;
        const float lg = A.lg2g[h];
        rt::f32x16 acc[8];
#pragma unroll
        for (int r = 0; r < 8; ++r)
#pragma unroll
            for (int e = 0; e < 16; ++e) acc[r][e] = 0.f;
        const h16* qrow = RQ + ((size_t)h * S + tok) * 256 + 8 * hh;
        u32x4 vreg[4], kreg2[2];
#define RO_LOAD(jt) do { int tid_ = F.tid; asm volatile("" : "+v"(tid_)); _Pragma("unroll") for (int i = 0; i < 2; ++i) { const int idx = tid_ + 512 * i; \
            kreg2[i] = *(const u32x4*)(RK + ((size_t)h * S + c * 128 + 32 * (jt) + (idx >> 5)) * 256 + (idx & 31) * 8); } \
            _Pragma("unroll") for (int i = 0; i < 4; ++i) { const int idx = tid_ + 512 * i; \
            vreg[i] = *(const u32x4*)(RV + ((size_t)h * S + c * 128 + 32 * (jt) + (idx >> 6)) * 512 + (idx & 63) * 8); } } while (0)
#define RO_WRITE(b) do { int tid_ = F.tid; asm volatile("" : "+v"(tid_)); _Pragma("unroll") for (int i = 0; i < 2; ++i) { const int idx = tid_ + 512 * i; \
            *(LAS u32x4*)(lds + (b) * rt::OTILE + rt::VTILE + (idx >> 5) * rt::KP + (idx & 31) * 16) = kreg2[i]; } \
            _Pragma("unroll") for (int i = 0; i < 4; ++i) { const int idx = tid_ + 512 * i; \
            *(LAS u32x4*)(lds + (b) * rt::OTILE + (idx >> 6) * rt::VP + (idx & 63) * 16) = vreg[i]; } } while (0)
        {
            constexpr int SLP = 80, SLB = 512 * SLP;
            const h16* sbase = ST + ((size_t)(h * 64 + c)) * 512 * 256;
            u32x4 sreg[4];
#define RS_LOAD(q_) do { int tid_ = F.tid; asm volatile("" : "+v"(tid_)); _Pragma("unroll") for (int i = 0; i < 4; ++i) { const int idx = tid_ + 512 * i; \
                sreg[i] = *(const u32x4*)(sbase + (size_t)(idx >> 2) * 256 + (q_) * 32 + (idx & 3) * 8); } } while (0)
#define RS_WRITE(b_) do { int tid_ = F.tid; asm volatile("" : "+v"(tid_)); _Pragma("unroll") for (int i = 0; i < 4; ++i) { const int idx = tid_ + 512 * i; \
                *(LAS u32x4*)(lds + (b_) * SLB + (idx >> 2) * SLP + (idx & 3) * 16) = sreg[i]; } } while (0)
            __syncthreads();
            RS_LOAD(0); RS_WRITE(0);
            __syncthreads();
            for (int q = 0; q < 8; ++q) {
                if (q + 1 < 8) RS_LOAD(q + 1);
                const LAS unsigned char* sl = lds + (q & 1) * SLB + (dvh * 256 + r31) * SLP + hh * 16;
#pragma unroll
                for (int k2 = 0; k2 < 2; ++k2) {
                    const h16x8 qf = *(const h16x8*)(qrow + 32 * q + 16 * k2);
#pragma unroll
                    for (int r = 0; r < 8; ++r) { const h16x8 a = *(const LAS h16x8*)(sl + r * 32 * SLP + k2 * 32); acc[r] = __builtin_amdgcn_mfma_f32_32x32x16_f16(a, qf, acc[r], 0, 0, 0); }
                }
                if (q + 1 < 8) RS_WRITE((q + 1) & 1);
                __syncthreads();
            }
#undef RS_LOAD
#undef RS_WRITE
            const float rdec = __builtin_amdgcn_exp2f((float)(il + 1) * lg);
#pragma unroll
            for (int r = 0; r < 8; ++r) acc[r] = acc[r] * rdec;
        }
        RO_LOAD(0);
        RO_WRITE(0);
        __syncthreads();
        for (int jt = 0; jt < 4; ++jt) {
            const int cur = jt & 1;
            if (jt + 1 < 4) RO_LOAD(jt + 1);
            if (jt <= itl) {
                rt::f32x16 sT;
#pragma unroll
                for (int e = 0; e < 16; ++e) sT[e] = 0.f;
                const LAS unsigned char* krow = lds + cur * rt::OTILE + rt::VTILE + r31 * rt::KP + hh * 16;
#pragma unroll 4
                for (int ks = 0; ks < 16; ++ks) sT = __builtin_amdgcn_mfma_f32_32x32x16_f16(*(const LAS h16x8*)(krow + 32 * ks), *(const h16x8*)(qrow + 16 * ks), sT, 0, 0, 0);
                h16x8 pb[2];
#pragma unroll
                for (int e = 0; e < 16; ++e) { const int kl = 32 * jt + (e & 3) + 8 * (e >> 2) + 4 * hh, df = il - kl;
                    const float pv = (df >= 0) ? sT[e] * __builtin_amdgcn_exp2f((float)df * lg) : 0.f; pb[e >> 3][e & 7] = (h16)pv; }
                const LAS unsigned char* vbase = lds + cur * rt::OTILE + (4 * hh + ((lane & 15) >> 2)) * rt::VP + (dvh * 256 + 16 * ((lane >> 4) & 1) + 4 * (lane & 3)) * 2;
#pragma unroll
                for (int r = 0; r < 8; ++r) {
#pragma unroll
                    for (int sp = 0; sp < 2; ++sp) { const LAS unsigned char* vp = vbase + 16 * sp * rt::VP + 64 * r;
                        acc[r] = __builtin_amdgcn_mfma_f32_32x32x16_f16(rt::tr16(vp, vp + 8 * rt::VP), pb[sp], acc[r], 0, 0, 0); }
                    if (r & 1) __builtin_amdgcn_sched_barrier(0);
                }
            }
            if (jt + 1 < 4) RO_WRITE(cur ^ 1);
            __syncthreads();
        }
#undef RO_LOAD
#undef RO_WRITE
        float s1 = 0.f, s2 = 0.f;
#pragma unroll
        for (int r = 0; r < 8; ++r)
#pragma unroll
            for (int e = 0; e < 16; ++e) { s1 += acc[r][e]; s2 += acc[r][e] * acc[r][e]; }
        s1 += __shfl_xor(s1, 32); s2 += __shfl_xor(s2, 32);
        if (hh == 0) { stats[(F.wave * 32 + r31) * 2] = s1; stats[(F.wave * 32 + r31) * 2 + 1] = s2; }
        __syncthreads();
        s1 += stats[((F.wave ^ 4) * 32 + r31) * 2]; s2 += stats[((F.wave ^ 4) * 32 + r31) * 2 + 1];
        const float mu = s1 * (1.0f / 512.0f), var = fmaxf(s2 * (1.0f / 512.0f) - mu * mu, 0.f), rs = 1.0f / sqrtf(var + EPS);
#pragma unroll
        for (int r = 0; r < 8; ++r)
#pragma unroll
            for (int cp = 0; cp < 2; ++cp) {
                const size_t off = (size_t)tok * 4096 + h * 512 + dvh * 256 + 32 * r + 16 * cp + 8 * hh;
                const h16x8 gv = *(const h16x8*)(RG + off);
                *(h16x8*)(OZ + off) = gv * fa::pack_swap(acc[r], cp, rs, mu);
            }
    }
}

template <int KIND>
__device__ __forceinline__ void phase_gemm_proj(const Frame& F, const Args& A, int N) {
    pg8::Gemm g{(const h16*)(F.ws + WS_H), (const h16*)(F.ws + (KIND == 2 ? WS_WTIN2 : WS_WTIN)), S, N, 2048, 2048, 2048}; pg8::StaticOrder So; So.init(S, N, F.G, F.bid);
    pg8::EpiProj<KIND> E{F.ws};
    pg8::gemm_phase<pg8::EpiProj<KIND>, pg8::StaticOrder, true, true>((LAS unsigned char*)F.lds, g, So, E);
    if (KIND == 1) {
        const int ni = ret_idle_a(F.G), r = F.bid - (F.G - ni);
        if (ni > 0 && r >= 0) conv_transpose(F, A.in[16], 2048, 12288, (h16*)(F.ws + WS_WTIN2), 12288, 0, r, ni, 0, ret_early_a(F.G));
    }
}
__device__ __forceinline__ void phase_gemm(const Frame& F, const h16* A, const h16* Bt, int N, int K, void* O, int ldc, int f32out) {
    pg8::Gemm g{A, Bt, S, N, K, K, K}; pg8::StaticOrder So; So.init(S, N, F.G, F.bid);
    pg8::EpiStore E{O, ldc, f32out};
    pg8::gemm_phase<pg8::EpiStore, pg8::StaticOrder, true, true>((LAS unsigned char*)F.lds, g, So, E);
}

constexpr int NPHASE = 2 + 8 * DEPTH;
__host__ __device__ inline bool phase_exists(int p) {
    if (p < 2) return true;
    const int L = (p - 2) / 8, s = (p - 2) % 8, kind = L % 3;
    if (s == 7) return false;
    if (s == 1) return kind == 1 || (kind == 0 && MOBA_SPARSE);
    if (s == 2) return kind != 0 || MOBA_SPARSE;
    if (s == 4) return false;
    return true;
}

__global__ void __launch_bounds__(NTHREADS, 2) trunk_fwd(Args args) {
    extern __shared__ __attribute__((aligned(16))) unsigned char lds_raw[];
    Frame F;
    F.out = args.out; F.ws = args.ws; F.lds = (char*)lds_raw;
    F.tid = threadIdx.x; F.lane = F.tid & 63; F.wave = __builtin_amdgcn_readfirstlane(F.tid >> 6); F.G = gridDim.x; F.bid = blockIdx.x;
    F.vcu = (F.G % 8 == 0) ? (F.bid % 8) * (F.G / 8) + F.bid / 8 : F.bid;
    volatile LAS unsigned* misc = (volatile LAS unsigned*)((LAS unsigned char*)lds_raw + MISC_OFF);
    if (F.tid < 16) misc[F.tid] = 0u;
    __syncthreads();
    XcdBarrier bar; bar.bar = (unsigned*)(F.ws + WS_CTL) + CW_BAR; bar.x = 0; bar.st = misc;
#if ONE_LAUNCH
    bar = xcd_barrier_post((unsigned*)(F.ws + WS_CTL) + CW_BAR, misc);
    cg::grid_group grid = cg::this_grid();
#endif
    const int lo = args.ph_lo, hi = args.ph_hi;
#if ONE_LAUNCH
    grid.sync();
#define SEAM(p) do { if ((p) > lo) xcd_barrier(bar); } while (0)
#else
#define SEAM(p) do { } while (0)
#endif
#define IN(p) (lo <= (p) && (p) < hi)
#ifndef PHMASK
#define PHMASK 0xFFFF
#endif
#define EN(b) ((PHMASK >> (b)) & 1)
#ifndef PROBE_DUP
#define PROBE_DUP 0
#endif
#define DUP(b, call) do { if ((PROBE_DUP >> (b)) & 1) { if (ONE_LAUNCH) xcd_barrier(bar); call; } } while (0)
    if (EN(0) && IN(0)) { SEAM(0); phase_prologue(F, args); }
    if (EN(1) && IN(1)) { SEAM(1); phase_norm(F, args, -1, 0); }
#define LAYER(L) do { \
        constexpr int kind = (L) % 3, base = 2 + 8 * (L); \
        constexpr int Nin = kind == 0 ? 8192 : (kind == 1 ? NSA_NP : 12288); \
        constexpr int Kout = kind == 2 ? 4096 : 2048; \
        if (EN(2) && IN(base + 0)) { SEAM(base + 0); phase_gemm_proj<kind>(F, args, Nin); } \
        if (EN(6) && kind == 1 && IN(base + 1)) { SEAM(base + 1); phase_nsa_cmp_a(F, args); } \
        if (EN(8) && kind == 0 && MOBA_SPARSE && IN(base + 1)) { SEAM(base + 1); phase_moba_gate(F, (L) / 3); } \
        if (EN(8) && kind == 0 && MOBA_SPARSE && IN(base + 2)) { SEAM(base + 2); phase_moba_attn_sparse(F, (L) / 3); } \
        if (kind != 0 && IN(base + 2)) { SEAM(base + 2); if (EN(6) && kind == 1) { phase_nsa_cmp_b(F, args); } else if (EN(7) && kind == 2) { phase_ret_scan_mfma(F, args); } } \
        if (IN(base + 3)) { SEAM(base + 3); if (EN(8) && kind == 0) { if (MOBA_SPARSE) phase_moba_merge(F); else phase_moba_attn_mfma(F); } else if (EN(9) && kind == 1) { phase_nsa_attn_mfma(F); DUP(9, phase_nsa_attn_mfma(F)); } else if (EN(10) && kind == 2) { phase_ret_out_mfma(F, args); } } \
        if (EN(2) && IN(base + 5)) { SEAM(base + 5); phase_gemm(F, (const h16*)(F.ws + WS_OZ), (const h16*)(F.ws + WS_WTOUT), 2048, Kout, F.ws + WS_Y, 2048, 0); } \
        if (EN(1) && IN(base + 6)) { SEAM(base + 6); phase_norm(F, args, (L), (L) + 1 < DEPTH ? (L) + 1 : -1); } \
    } while (0)
    LAYER(0); LAYER(1); LAYER(2); LAYER(3);
#undef LAYER
#undef EN
#undef DUP
#undef IN
#undef SEAM
}

extern "C" void kernel_launch(void* const* d_in, const int* in_sizes, int n_in, void* d_out, int out_size, void* d_ws, size_t ws_size, hipStream_t stream) {
    static int grid = 0;
    if (grid == 0) {
        if (n_in != 18 || out_size != S * D || ws_size < WS_END) { fprintf(stderr, "kernel_launch: unexpected shapes (n_in %d, out %d, ws %zu)\n", n_in, out_size, ws_size); grid = -1; return; }
        int dev = 0, cus = 0, per_cu = 0;
        if (hipGetDevice(&dev) != hipSuccess || hipDeviceGetAttribute(&cus, hipDeviceAttributeMultiprocessorCount, dev) != hipSuccess) { grid = -1; return; }
        if (hipFuncSetAttribute((const void*)trunk_fwd, hipFuncAttributeMaxDynamicSharedMemorySize, LDS_BYTES) != hipSuccess) { fprintf(stderr, "kernel_launch: hipFuncSetAttribute failed\n"); grid = -1; return; }
        if (hipOccupancyMaxActiveBlocksPerMultiprocessor(&per_cu, (const void*)trunk_fwd, NTHREADS, LDS_BYTES) != hipSuccess || per_cu < 1) { fprintf(stderr, "kernel_launch: occupancy query says %d\n", per_cu); per_cu = 1; }
        (void)hipGetLastError();
        grid = cus;
    }
    if (grid < 0) return;
    (void)hipMemsetAsync((char*)d_ws + WS_CTL, 0, CTL_ZERO_BYTES, stream);
    Args a{};
    for (int i = 0; i < 18; ++i) a.in[i] = (const float*)d_in[i];
    a.out = (float*)d_out; a.ws = (unsigned char*)d_ws;
    for (int j = 0; j < 16; ++j) a.inv16[j] = pow(500000.0, -(double)j / 16.0);
    for (int j = 0; j < 128; ++j) a.inv128[j] = pow(10000.0, -(double)j / 128.0);
    for (int h = 0; h < 8; ++h) a.lg2g[h] = (float)log2(1.0 - ldexp(1.0, -5 - h));
#if ONE_LAUNCH
    a.ph_lo = 0; a.ph_hi = NPHASE;
    void* kargs[] = {&a};
    hipError_t e = hipLaunchCooperativeKernel((const void*)trunk_fwd, dim3(grid), dim3(NTHREADS), kargs, LDS_BYTES, stream);
    if (e != hipSuccess) fprintf(stderr, "kernel_launch: cooperative launch failed: %s (grid %d)\n", hipGetErrorString(e), grid);
#else
    for (int p = 0; p < NPHASE; ++p) {
        if (!phase_exists(p)) continue;
        a.ph_lo = p; a.ph_hi = p + 1;
        hipLaunchKernelGGL(trunk_fwd, dim3(grid), dim3(NTHREADS), LDS_BYTES, stream, a);
    }
#endif
}
```
